# Optimizing an MI355X kernel written in HIP

```python
import jax
import jax.numpy as jnp
from jax import lax
import numpy as np


D_MODEL = 2048
BATCH = 2
SEQ = 16384
DEPTH = 2

BLOCK = 128
ROPE_THETA = 10000.0
LN_EPS = 1e-5
RMS_EPS = 1e-6
PLE_DIM = 256
SWA_HEADS = 32
SWA_KV_HEADS = 4
SWA_GROUP = SWA_HEADS // SWA_KV_HEADS
SWA_HEAD_DIM = 64
SWA_WINDOW = 128
MLA_HEADS = 16
MLA_NOPE = 128
MLA_ROPE = 64
MLA_V = 128
MLA_LATENT = 512
MLA_SCALE = (MLA_NOPE + MLA_ROPE) ** -0.5
IDX_HEADS = 16
IDX_DIM = 64
IDX_ROPE = 32
DSA_TOPK = 256
DSA_PARTS = (MLA_HEADS * (MLA_NOPE + MLA_ROPE), MLA_LATENT, MLA_ROPE, IDX_HEADS * IDX_DIM, IDX_DIM, IDX_HEADS)
DSA_IN = sum(DSA_PARTS)
DSA_SPLITS = tuple(int(v) for v in np.cumsum(DSA_PARTS)[:-1])
FFN_DIM = 5632
MOE_EXPERTS = 8
MOE_TOP_K = 2
MOE_FFN_DIM = 7168
MOE_BLOCK = 512

kernel_name = 'hybrid_swa_dsa_deepnorm_moe'


def layer_norm(x, g, b):
    xf = x.astype(jnp.float32)
    mu = jnp.mean(xf, axis=-1, keepdims=True)
    var = jnp.mean(jnp.square(xf - mu), axis=-1, keepdims=True)
    return ((xf - mu) * lax.rsqrt(var + LN_EPS) * g + b).astype(x.dtype)


def rms_norm(x, g):
    xf = x.astype(jnp.float32)
    return (xf * lax.rsqrt(jnp.mean(jnp.square(xf), axis=-1, keepdims=True) + RMS_EPS) * g).astype(x.dtype)


def rope(x, pos):
    d = x.shape[-1]
    inv_freq = ROPE_THETA ** (-jnp.arange(0, d, 2, dtype=jnp.float32) / d)
    ang = pos.astype(jnp.float32)[..., None] * inv_freq
    cos = jnp.cos(ang)[:, :, None, :]
    sin = jnp.sin(ang)[:, :, None, :]
    xf = x.astype(jnp.float32)
    x1, x2 = xf[..., : d // 2], xf[..., d // 2:]
    return jnp.concatenate([x1 * cos - x2 * sin, x2 * cos + x1 * sin], axis=-1).astype(x.dtype)


def _to_blocks(a):
    b, s = a.shape[:2]
    return jnp.moveaxis(a.reshape((b, s // BLOCK, BLOCK) + a.shape[2:]), 1, 0)


def _from_blocks(a):
    nb, b, bq = a.shape[:3]
    return jnp.moveaxis(a, 0, 1).reshape((b, nb * bq) + a.shape[3:])


def swa_mixer(x, pos, w_qkv, sinks, w_o):
    b, s, _ = x.shape
    nb = s // BLOCK
    qkv = x @ w_qkv
    q, k, v = jnp.split(qkv, [SWA_HEADS * SWA_HEAD_DIM, (SWA_HEADS + SWA_KV_HEADS) * SWA_HEAD_DIM], axis=-1)
    q = rope(q.reshape(b, s, SWA_HEADS, SWA_HEAD_DIM), pos).reshape(b, s, SWA_KV_HEADS, SWA_GROUP, SWA_HEAD_DIM)
    k = rope(k.reshape(b, s, SWA_KV_HEADS, SWA_HEAD_DIM), pos)
    v = v.reshape(b, s, SWA_KV_HEADS, SWA_HEAD_DIM)

    def band(a):
        ab = a.reshape(b, nb, BLOCK, SWA_KV_HEADS, SWA_HEAD_DIM)
        prev = jnp.concatenate([jnp.zeros_like(ab[:, :1]), ab[:, :-1]], axis=1)
        return jnp.moveaxis(jnp.concatenate([prev, ab], axis=2), 1, 0)

    q_pos = jnp.arange(s).reshape(nb, BLOCK)
    k_pos = q_pos[:, :1] - BLOCK + jnp.arange(2 * BLOCK)[None, :]
    sink = sinks.astype(jnp.float32).reshape(SWA_KV_HEADS, SWA_GROUP)
    scale = SWA_HEAD_DIM ** -0.5

    def attend(args):
        qb, kb, vb, qp, kp = args
        logits = jnp.einsum('bqkgd,bskd->bkgqs', qb, kb).astype(jnp.float32) * scale
        rel = qp[:, None] - kp[None, :]
        allowed = (rel >= 0) & (rel < SWA_WINDOW) & (kp[None, :] >= 0)
        logits = jnp.where(allowed, logits, -jnp.inf)
        sink_col = jnp.broadcast_to(sink[None, :, :, None, None], logits.shape[:-1] + (1,))
        probs = jax.nn.softmax(jnp.concatenate([logits, sink_col], axis=-1), axis=-1)[..., :-1]
        return jnp.einsum('bkgqs,bskd->bqkgd', probs.astype(vb.dtype), vb)

    o = lax.map(attend, (_to_blocks(q), band(k), band(v), q_pos, k_pos))
    o = _from_blocks(o).reshape(b, s, SWA_HEADS * SWA_HEAD_DIM)
    return o @ w_o


def dsa_mixer(x, pos, w_in, kv_norm, w_uk, w_uv, w_o):
    b, s, _ = x.shape
    nb = s // BLOCK
    n_sel = min(DSA_TOPK, s // 4)
    h = x @ w_in
    q, c_kv, k_r, q_i, k_i, w_i = jnp.split(h, DSA_SPLITS, axis=-1)
    q = q.reshape(b, s, MLA_HEADS, MLA_NOPE + MLA_ROPE)
    q_nope = q[..., :MLA_NOPE]
    q_rope = rope(q[..., MLA_NOPE:], pos)
    c_kv = rms_norm(c_kv, kv_norm)
    k_r = rope(k_r[:, :, None, :], pos)[:, :, 0]
    q_i = q_i.reshape(b, s, IDX_HEADS, IDX_DIM)
    q_i = jnp.concatenate([rope(q_i[..., :IDX_ROPE], pos), q_i[..., IDX_ROPE:]], axis=-1)
    k_i = jnp.concatenate([rope(k_i[:, :, None, :IDX_ROPE], pos)[:, :, 0], k_i[..., IDX_ROPE:]], axis=-1)
    w_i = w_i * IDX_HEADS ** -0.5
    key_pos = jnp.arange(s)
    b_ix = jnp.arange(b)[:, None, None]

    def attend(args):
        qn, qr, qi, wi, qp = args
        idx_logits = jnp.einsum('bqhd,bsd->bqhs', qi, k_i).astype(jnp.float32) * IDX_DIM ** -0.5
        score = jnp.einsum('bqh,bqhs->bqs', wi.astype(jnp.float32), jax.nn.relu(idx_logits))
        score = jnp.where(key_pos[None, None, :] <= qp[None, :, None], score, -jnp.inf)
        _, sel = lax.top_k(score, n_sel)
        valid = sel <= qp[None, :, None]
        c_sel = c_kv[b_ix, sel]
        kr_sel = k_r[b_ix, sel]
        q_lat = jnp.einsum('bqhn,hcn->bqhc', qn, w_uk)
        logits = (jnp.einsum('bqhc,bqkc->bqhk', q_lat, c_sel)
                  + jnp.einsum('bqhr,bqkr->bqhk', qr, kr_sel)).astype(jnp.float32) * MLA_SCALE
        logits = jnp.where(valid[:, :, None, :], logits, -jnp.inf)
        probs = jax.nn.softmax(logits, axis=-1).astype(c_sel.dtype)
        o_lat = jnp.einsum('bqhk,bqkc->bqhc', probs, c_sel)
        return jnp.einsum('bqhc,hcv->bqhv', o_lat, w_uv)

    o = lax.map(attend, (_to_blocks(q_nope), _to_blocks(q_rope), _to_blocks(q_i), _to_blocks(w_i),
                         key_pos.reshape(nb, BLOCK)))
    return _from_blocks(o).reshape(b, s, MLA_HEADS * MLA_V) @ w_o


def swiglu(x, w1, w3, w2):
    return (jax.nn.silu(x @ w1) * (x @ w3)) @ w2


def moe_swiglu(h, w_router, w1, w3, w2):
    t, d = h.shape
    n = t * MOE_TOP_K
    logits = (h @ w_router).astype(jnp.float32)
    top_val, top_idx = lax.top_k(logits, MOE_TOP_K)
    gates = jax.nn.softmax(top_val, axis=-1).astype(h.dtype)
    e_flat = top_idx.reshape(n)
    tok_flat = jnp.arange(n, dtype=jnp.int32) // MOE_TOP_K
    g_flat = gates.reshape(n)
    order = jnp.argsort(e_flat)
    e_sorted = e_flat[order]
    counts = jnp.bincount(e_flat, length=MOE_EXPERTS)
    starts = jnp.cumsum(counts) - counts
    padded = (counts + MOE_BLOCK - 1) // MOE_BLOCK * MOE_BLOCK
    pends = jnp.cumsum(padded)
    pstarts = pends - padded
    dest = pstarts[e_sorted] + (jnp.arange(n) - starts[e_sorted])
    n_blocks = (n + MOE_EXPERTS * (MOE_BLOCK - 1) + MOE_BLOCK - 1) // MOE_BLOCK
    n_slots = n_blocks * MOE_BLOCK
    slot_tok = jnp.zeros((n_slots,), jnp.int32).at[dest].set(tok_flat[order])
    slot_gate = jnp.zeros((n_slots,), h.dtype).at[dest].set(g_flat[order])
    blk_start = jnp.arange(n_blocks, dtype=pends.dtype) * MOE_BLOCK
    blk_expert = jnp.minimum(jnp.searchsorted(pends, blk_start, side='right'), MOE_EXPERTS - 1)

    def run_block(args):
        tok, e = args
        xb = h[tok]
        return (jax.nn.silu(xb @ w1[e]) * (xb @ w3[e])) @ w2[e]

    y = lax.map(run_block, (slot_tok.reshape(n_blocks, MOE_BLOCK), blk_expert)).reshape(n_slots, d)
    return jax.ops.segment_sum(y * slot_gate[:, None], slot_tok, num_segments=t)


def setup_inputs(seed: int = 0) -> dict:
    key = jax.random.key(seed)
    ks = jax.random.split(key, 24)
    n_a = (DEPTH + 1) // 2
    n_b = DEPTH // 2
    beta = (8.0 * DEPTH) ** -0.25

    def nrm(k, shape, scale):
        return jax.random.normal(k, shape, jnp.float32) * scale

    qkv_out = (SWA_HEADS + 2 * SWA_KV_HEADS) * SWA_HEAD_DIM
    offset = jax.random.randint(ks[2], (BATCH, 1), 0, 1024, dtype=jnp.int32)
    return {
        'x': nrm(ks[0], (BATCH, SEQ, D_MODEL), 1.0),
        'p': nrm(ks[1], (DEPTH, BATCH, SEQ, PLE_DIM), 1.0),
        'positions': offset + jnp.arange(SEQ, dtype=jnp.int32)[None, :],
        'swa_w_qkv': nrm(ks[3], (n_a, D_MODEL, qkv_out), D_MODEL ** -0.5),
        'swa_sinks': nrm(ks[4], (n_a, SWA_HEADS), 0.5),
        'swa_w_o': nrm(ks[5], (n_a, SWA_HEADS * SWA_HEAD_DIM, D_MODEL), beta * (SWA_HEADS * SWA_HEAD_DIM) ** -0.5),
        'dense_w1': nrm(ks[6], (n_a, D_MODEL, FFN_DIM), D_MODEL ** -0.5),
        'dense_w3': nrm(ks[7], (n_a, D_MODEL, FFN_DIM), D_MODEL ** -0.5),
        'dense_w2': nrm(ks[8], (n_a, FFN_DIM, D_MODEL), beta * FFN_DIM ** -0.5),
        'dsa_w_in': nrm(ks[9], (n_b, D_MODEL, DSA_IN), D_MODEL ** -0.5),
        'dsa_kv_norm': 1.0 + nrm(ks[10], (n_b, MLA_LATENT), 0.02),
        'dsa_w_uk': nrm(ks[11], (n_b, MLA_HEADS, MLA_LATENT, MLA_NOPE), MLA_LATENT ** -0.5),
        'dsa_w_uv': nrm(ks[12], (n_b, MLA_HEADS, MLA_LATENT, MLA_V), MLA_LATENT ** -0.5),
        'dsa_w_o': nrm(ks[13], (n_b, MLA_HEADS * MLA_V, D_MODEL), beta * (MLA_HEADS * MLA_V) ** -0.5),
        'moe_router': nrm(ks[14], (n_b, D_MODEL, MOE_EXPERTS), D_MODEL ** -0.5),
        'moe_w1': nrm(ks[15], (n_b, MOE_EXPERTS, D_MODEL, MOE_FFN_DIM), D_MODEL ** -0.5),
        'moe_w3': nrm(ks[16], (n_b, MOE_EXPERTS, D_MODEL, MOE_FFN_DIM), D_MODEL ** -0.5),
        'moe_w2': nrm(ks[17], (n_b, MOE_EXPERTS, MOE_FFN_DIM, D_MODEL), beta * MOE_FFN_DIM ** -0.5),
        'ln_g': 1.0 + nrm(ks[18], (DEPTH, 2, D_MODEL), 0.02),
        'ln_b': nrm(ks[19], (DEPTH, 2, D_MODEL), 0.02),
        'ple_w_p': nrm(ks[20], (DEPTH, PLE_DIM, D_MODEL), PLE_DIM ** -0.5),
        'ple_w_g': nrm(ks[21], (DEPTH, D_MODEL, D_MODEL), D_MODEL ** -0.5),
    }


def reference(x, p, positions, swa_w_qkv, swa_sinks, swa_w_o, dense_w1, dense_w3, dense_w2,
              dsa_w_in, dsa_kv_norm, dsa_w_uk, dsa_w_uv, dsa_w_o, moe_router, moe_w1, moe_w3, moe_w2,
              ln_g, ln_b, ple_w_p, ple_w_g):
    alpha = (2.0 * DEPTH) ** 0.25
    for i in range(DEPTH):
        j = i // 2
        if i % 2 == 0:
            mix = swa_mixer(x, positions, swa_w_qkv[j], swa_sinks[j], swa_w_o[j])
        else:
            mix = dsa_mixer(x, positions, dsa_w_in[j], dsa_kv_norm[j], dsa_w_uk[j], dsa_w_uv[j], dsa_w_o[j])
        x = layer_norm(alpha * x + mix, ln_g[i, 0], ln_b[i, 0])
        if i % 2 == 0:
            ff = swiglu(x, dense_w1[j], dense_w3[j], dense_w2[j])
        else:
            ff = moe_swiglu(x.reshape(-1, x.shape[-1]), moe_router[j], moe_w1[j], moe_w3[j], moe_w2[j]).reshape(x.shape)
        x = layer_norm(alpha * x + ff, ln_g[i, 1], ln_b[i, 1])
        x = x + jax.nn.sigmoid(x @ ple_w_g[i]) * (p[i] @ ple_w_p[i])
    return x
```

```cpp
#include <hip/hip_runtime.h>
#include <cstdio>
#include <cstdint>

#define LAS __attribute__((address_space(3)))
#define GAS __attribute__((address_space(1)))
typedef unsigned short bf16_t;
typedef short bf16x8 __attribute__((ext_vector_type(8)));
typedef short bf16x4 __attribute__((ext_vector_type(4)));
typedef float f32x2 __attribute__((ext_vector_type(2)));
typedef float f32x4 __attribute__((ext_vector_type(4)));
typedef float f32x16 __attribute__((ext_vector_type(16)));
typedef unsigned u32x2 __attribute__((ext_vector_type(2)));
typedef unsigned u32x4 __attribute__((ext_vector_type(4)));
typedef unsigned long long u64;
typedef int i32x4 __attribute__((ext_vector_type(4)));
typedef int i32x8 __attribute__((ext_vector_type(8)));

constexpr int T = 32768, SEQ = 16384, DM = 2048;
constexpr int FFN = 5632, MFFN = 7168, NEXP = 8;
constexpr int NQKV = 2560, NWIN = 4864;
constexpr float ALPHA = 1.41421356237309515f;
constexpr float LN_EPS = 1e-5f, RMS_EPS = 1e-6f;
constexpr float QSCALE_SWA = 0.18033688011112042f;
constexpr float SCALE2_MLA = 0.10411754627697264f;
constexpr float LOG2E = 1.4426950408889634f;
constexpr int NWAVES = 8, NTHREADS = 512;
constexpr float W13_F8SCALE = 32.0f;
constexpr bool F8_FFN1 = false, F8_FFN2 = true, F8_QKV = true, F8_WO0 = true, F8_WIN = false, F8_WO1 = true;
constexpr bool EPI_ALIGN_RES = true;
constexpr bool SWA_FRAG = true;
constexpr bool F8_LAT = true;
constexpr float QLAT_F8SCALE = 8.0f, OLAT_F8SCALE = 32.0f, WUV_F8SCALE = 16.0f;
constexpr bool F8_WIN_SPLIT = true;
constexpr int WIN_F8_TILES = 14;
constexpr float WQKV_F8SCALE = 32.0f, WIN_F8SCALE = 32.0f, WO_F8SCALE = 64.0f, O0_F8SCALE = 16.0f, O2_F8SCALE = 32.0f;
constexpr float ACT_F8SCALE = 16.0f, W2_F8SCALE = 128.0f;

constexpr size_t MiB = 1u << 20;
constexpr size_t WS_CTL = 0, CTL_ZERO_BYTES = 1 * MiB;
constexpr size_t WS_WQKV = 2 * MiB, WS_WO0 = 12 * MiB, WS_W13 = 20 * MiB, WS_W2 = 64 * MiB, WS_WG0 = 86 * MiB, WS_WG1 = 94 * MiB, WS_WP0 = 102 * MiB, WS_WP1 = 103 * MiB,
                 WS_WIN = 104 * MiB, WS_WUK = 123 * MiB, WS_WUV = 125 * MiB, WS_WO1 = 129 * MiB;
constexpr size_t WS_TAB64 = 137 * MiB, WS_TAB32 = 145 * MiB, WS_PB = 149 * MiB, WS_XBA = 181 * MiB, WS_XBB = 309 * MiB;
constexpr size_t WS_TOKE = 437 * MiB;
constexpr size_t WS_TOKG = WS_TOKE + 256 * 1024;
constexpr size_t WS_TOKL = WS_TOKG + 256 * 1024;
constexpr size_t WS_TOKS = WS_TOKL + 256 * 1024;
constexpr size_t WS_SGATE = WS_TOKS + 256 * 1024;
constexpr size_t WS_WI = 439 * MiB, WS_SEL = 441 * MiB, WS_R = 458 * MiB;
constexpr size_t WS_Q = WS_R, WS_K = WS_R + 128 * MiB, WS_VT = WS_R + 144 * MiB, WS_ACT = WS_R + 160 * MiB, WS_PP0 = WS_R + 512 * MiB, WS_O8 = WS_R + 640 * MiB, WS_XB8 = WS_R + 704 * MiB  , WS_WIN8 = WS_R + 768 * MiB  ;
constexpr size_t WS_QN = WS_R, WS_QR = WS_R + 128 * MiB, WS_CRAW = WS_R + 192 * MiB, WS_KV = WS_R + 256 * MiB, WS_QI = WS_R + 292 * MiB, WS_KIF = WS_R + 356 * MiB,
                 WS_QLAT = WS_R + 360 * MiB, WS_O2 = WS_R + 872 * MiB;
constexpr size_t WS_MW13 = WS_R + 1128 * MiB, WS_MW2 = WS_R + 1352 * MiB, WS_XG = WS_R, WS_SOUT = WS_R + 136 * MiB, WS_ACT2 = WS_R + 404 * MiB  , WS_PP1 = WS_R + 884 * MiB;
constexpr size_t WS_END = WS_R + 1464 * MiB;
constexpr int MAXSLOTS = 67840;
constexpr int CHUNK_TILES = 272;
constexpr int CW_TMO = 0, CW_CNT = 64  , CW_BAR = 4096;

constexpr int LDS_BYTES = 155648;
constexpr int MISC_OFF = 150016;
constexpr int DSA_WBUF = 18688;

typedef __bf16 bf16x2_t __attribute__((ext_vector_type(2)));
__device__ __forceinline__ unsigned cvt_pk_bf16(float lo, float hi) { const f32x2 v = {lo, hi}; return __builtin_bit_cast(unsigned, __builtin_convertvector(v, bf16x2_t)); }
__device__ __forceinline__ float bf2f(unsigned short h) { return __uint_as_float(((unsigned)h) << 16); }
__device__ __forceinline__ float bflo(unsigned w) { return __uint_as_float(w << 16); }
__device__ __forceinline__ float bfhi(unsigned w) { return __uint_as_float(w & 0xffff0000u); }
__device__ __forceinline__ int fresh_lane() { unsigned m = ~0u; asm volatile("" : "+v"(m)); return (int)__builtin_amdgcn_mbcnt_hi(m, __builtin_amdgcn_mbcnt_lo(m, 0u)); }
__device__ __forceinline__ float shx(float v, int o, int lane) { return __int_as_float(__builtin_amdgcn_ds_bpermute((lane ^ o) << 2, __float_as_int(v))); }
__device__ __forceinline__ float wave_sum(float v) {
    const int l = fresh_lane();
#pragma unroll
    for (int o = 1; o < 64; o <<= 1) v += shx(v, o, l);
    return v;
}
__device__ __forceinline__ unsigned pk4_fp8(float a, float b, float c, float d) { unsigned w = 0u; w = (unsigned)__builtin_amdgcn_cvt_pk_fp8_f32(a, b, (int)w, false); w = (unsigned)__builtin_amdgcn_cvt_pk_fp8_f32(c, d, (int)w, true); return w; }
#define LDS_WAIT() asm volatile("s_waitcnt lgkmcnt(0)" ::: "memory")
#define VM_WAIT() asm volatile("s_waitcnt vmcnt(0)" ::: "memory")

namespace pg8 {
constexpr int BM = 256, BK = 64, HALF = 128, HTB = HALF * BK * 2, STAGE_BYTES = 8 * HTB, NXCD = 8, WGM = 8;
__host__ __device__ __forceinline__ int lds_byte(int r, int c) { const int st = (r >> 4) * 2 + (c >> 5), rr = r & 15, cc = c & 31, ob = rr * 64 + cc * 2; return st * 1024 + (ob ^ (((ob >> 9) & 1) << 5)); }
__host__ __device__ __forceinline__ void stage_rc(int b, int& R, int& C) { const int st = b / 1024, sb = b % 1024, swz = sb ^ (((sb >> 9) & 1) << 5); R = (st >> 1) * 16 + swz / 64; C = (st & 1) * 32 + (swz % 64) / 2; }
__host__ __device__ __forceinline__ int perm32(int rho) { const int n = rho >> 4, i = rho & 15; return 8 * (i >> 2) + 4 * n + (i & 3); }

struct Unit { int pm, pn, am, acol, bn; };
struct Gemm { const bf16_t* A; const bf16_t* Bt; int lda, ldb, K; };

constexpr int GRID = 256;
template <int MODE, int NM, int NN> struct GridOrder {
    __device__ __forceinline__ bool next(int i, Unit& u) const {
        constexpr int nwg = NM * NN;
        int L = i * GRID + (int)blockIdx.x;
        if constexpr (MODE == 4) {
            if (i >= 6) { if ((int)blockIdx.x < GRID / 2 || i >= 8) return false; L = 6 * GRID + ((int)blockIdx.x - GRID / 2) * 2 + (i - 6); } }
        if (L >= nwg) return false;
        int wgid = L; { constexpr int q = nwg / NXCD, r = nwg % NXCD; const int xcd = wgid % NXCD, off = wgid / NXCD; wgid = (xcd < r ? xcd * (q + 1) : r * (q + 1) + (xcd - r) * q) + off; }
        constexpr int nig = WGM * NN; const int gid = wgid / nig, fm = gid * WGM, gsz = (NM - fm) < WGM ? (NM - fm) : WGM;
        u.pm = fm + ((wgid % nig) % gsz); u.pn = (wgid % nig) / gsz; u.am = u.pm; u.bn = u.pn;
        u.acol = MODE == 1 ? (u.pn >> 1) * 128 : (MODE == 2 ? u.pn * 1024 : (MODE == 3 ? u.pn * 512 : 0));
        return true;
    }
};
template <int NM, int NN> struct GridOrderSkip {
    int skip;
    __device__ __forceinline__ bool next(int i, Unit& u) const {
        constexpr int nwg = NM * NN; const int nW = GRID - skip, br = (int)blockIdx.x - skip; if (br < 0) return false;
        const int L = i * nW + br; if (L >= nwg) return false;
        int wgid = L; { constexpr int q = nwg / NXCD, r = nwg % NXCD; const int xcd = wgid % NXCD, off = wgid / NXCD; wgid = (xcd < r ? xcd * (q + 1) : r * (q + 1) + (xcd - r) * q) + off; }
        constexpr int nig = WGM * NN; const int gid = wgid / nig, fm = gid * WGM, gsz = (NM - fm) < WGM ? (NM - fm) : WGM;
        u.pm = fm + ((wgid % nig) % gsz); u.pn = (wgid % nig) / gsz; u.am = u.pm; u.bn = u.pn; u.acol = 0;
        return true;
    }
};
template <bool DOWN, int NN> struct MoeOrder {
    int tile0, ntl;
    __device__ __forceinline__ bool next(int i, Unit& u) const {
        int pml, pn;
        if constexpr (!DOWN && NN % 8 == 0) {
            constexpr int NJ = NN / 8; const int x = (int)blockIdx.x & 7, q = i * (GRID / 8) + ((int)blockIdx.x >> 3); if (q >= ntl * NJ) return false;
            const int nfull = ntl >> 3; int m, j;
            if (q < nfull * 8 * NJ) { const int b = q / (8 * NJ), w = q - b * (8 * NJ); m = b * 8 + (w & 7); j = w >> 3; }
            else { const int g = ntl - nfull * 8, w = q - nfull * 8 * NJ; j = w / g; m = nfull * 8 + (w - j * g); }
            pml = m; pn = 8 * j + x;
        } else {
        const int L = i * GRID + (int)blockIdx.x; if (L >= ntl * NN) return false;
        constexpr int nig = WGM * NN; const int wgid = L, gid = wgid / nig, fm = gid * WGM, gsz = (ntl - fm) < WGM ? (ntl - fm) : WGM;
        pml = fm + ((wgid % nig) % gsz); pn = (wgid % nig) / gsz; }
        const int pmg = tile0 + pml;
        const u32x4 t0 = *(const LAS u32x4*)(MISC_OFF + 20 * 4), t1 = *(const LAS u32x4*)(MISC_OFF + 24 * 4);
        int e = (pmg >= (int)t0.x) + (pmg >= (int)t0.y) + (pmg >= (int)t0.z) + (pmg >= (int)t0.w) + (pmg >= (int)t1.x) + (pmg >= (int)t1.y) + (pmg >= (int)t1.z);
        e = __builtin_amdgcn_readfirstlane(e);
        u.pn = pn; u.bn = e * NN + pn; u.acol = 0;
        if (DOWN) { u.pm = pmg; u.am = pml; } else { u.pm = pml; u.am = pmg; }
        return true;
    }
};

__device__ __forceinline__ void stage16_s(const char* gbase, unsigned voff, unsigned lds_dst) { unsigned keep;
    asm volatile("s_mov_b32 %0, m0\n\ts_mov_b32 m0, %3\n\ts_nop 0\n\tglobal_load_lds_dwordx4 %1, %2\n\ts_mov_b32 m0, %0" : "=&s"(keep) : "v"(voff), "s"(gbase), "s"(lds_dst) : "memory"); }
template <class Epi, class Sched, bool FP8 = false, bool ALIGN = true>
__device__ __forceinline__ void gemm_phase(LAS unsigned char* lds, const Gemm g, const Sched& S, const Epi& E, int wave_) {
    int tid_ = wave_ * 64 + fresh_lane(); asm volatile("" : "+v"(tid_));
    const int tid = tid_, wid = __builtin_amdgcn_readfirstlane(tid >> 6), lane = tid & 63, wr = wid >> 2, wc = wid & 3, fr = lane & 15, fq = lane >> 4;
    int K_ = g.K; asm volatile("" : "+s"(K_));
    const int K = K_, nt = K / BK;
    unsigned voffA[2], voffB[2];
#pragma unroll
    for (int i = 0; i < 2; ++i) { int R, C; stage_rc(tid * 16 + i * 8192, R, C); const int Rb = (R & ~31) + perm32(R & 31);
        voffA[i] = (unsigned)(R * g.lda + C) * 2u; voffB[i] = (unsigned)(Rb * g.ldb + C) * 2u; }
    const size_t kstep = (size_t)(BK * 2);
    const size_t hstepA = (size_t)HALF * g.lda * 2, hstepB = (size_t)HALF * g.ldb * 2;
    const unsigned ldsw = (unsigned)wid * 1024u;
    const int aoff = lds_byte(wr * 64 + fr, fq * 8), boff = lds_byte(wc * 32 + fr, fq * 8);
#define PG8_SA(b, h) (((b) * 2 + (h)) * HTB)
#define PG8_SB(b, h) ((4 + (b) * 2 + (h)) * HTB)
#define PG8_STAGE(bufoff, gbase, voff) do { _Pragma("unroll") for (int _i = 0; _i < 2; ++_i) { \
        if constexpr (FP8) stage16_s((const char*)(gbase), (voff)[_i], (unsigned)(size_t)(lds + (bufoff) + ldsw + _i * 8192)); \
        else __builtin_amdgcn_global_load_lds((const unsigned*)((const char*)(gbase) + (voff)[_i]), (LAS unsigned*)(lds + (bufoff) + ldsw + _i * 8192), 16, 0, 0); } } while (0)
#define PG8_LDA(dst, b, h) do { _Pragma("unroll") for (int m = 0; m < 4; ++m) _Pragma("unroll") for (int k = 0; k < 2; ++k) dst[m][k] = *(const LAS bf16x8*)(lds + PG8_SA(b, h) + aoff + m * 2048 + k * 1024); } while (0)
#define PG8_LDB(dst, b, h) do { _Pragma("unroll") for (int n = 0; n < 2; ++n) _Pragma("unroll") for (int k = 0; k < 2; ++k) dst[n][k] = *(const LAS bf16x8*)(lds + PG8_SB(b, h) + boff + n * 2048 + k * 1024); } while (0)
#define PG8_MMA(ai, bj, At, Bt) do { __builtin_amdgcn_s_setprio(1); _Pragma("unroll") for (int m = 0; m < 4; ++m) _Pragma("unroll") for (int n = 0; n < 2; ++n) _Pragma("unroll") for (int k = 0; k < 2; ++k) \
        acc[ai][bj][m][n] = __builtin_amdgcn_mfma_f32_16x16x32_bf16(Bt[n][k], At[m][k], acc[ai][bj][m][n], 0, 0, 0); __builtin_amdgcn_s_setprio(0); } while (0)
#define PG8_LDA8(dst, b, h) do { _Pragma("unroll") for (int m = 0; m < 4; ++m) { const i32x4 lo_ = *(const LAS i32x4*)(lds + PG8_SA(b, h) + aoff + m * 2048), hi_ = *(const LAS i32x4*)(lds + PG8_SA(b, h) + aoff + m * 2048 + 1024); \
        dst[m] = __builtin_shufflevector(lo_, hi_, 0, 1, 2, 3, 4, 5, 6, 7); } } while (0)
#define PG8_LDB8(dst, b, h) do { _Pragma("unroll") for (int n = 0; n < 2; ++n) { const i32x4 lo_ = *(const LAS i32x4*)(lds + PG8_SB(b, h) + boff + n * 2048), hi_ = *(const LAS i32x4*)(lds + PG8_SB(b, h) + boff + n * 2048 + 1024); \
        dst[n] = __builtin_shufflevector(lo_, hi_, 0, 1, 2, 3, 4, 5, 6, 7); } } while (0)
#define PG8_MMA8(ai, bj, At, Bt) do { __builtin_amdgcn_s_setprio(1); _Pragma("unroll") for (int m = 0; m < 4; ++m) _Pragma("unroll") for (int n = 0; n < 2; ++n) \
        acc[ai][bj][m][n] = __builtin_amdgcn_mfma_scale_f32_16x16x128_f8f6f4(Bt[n], At[m], acc[ai][bj][m][n], 0, 0, 0, 0, 0, 0); __builtin_amdgcn_s_setprio(0); } while (0)
#define PG8_WAIT_V(n) asm volatile("s_waitcnt vmcnt(" #n ")" ::: "memory")
#define PG8_WAIT_L(n) asm volatile("s_waitcnt lgkmcnt(" #n ")" ::: "memory")
#define PG8_BAR __builtin_amdgcn_s_barrier()
#define PG8_SCHED __builtin_amdgcn_sched_barrier(0)
#define PG8_ABASE(u) ((const char*)g.A + ((size_t)(u).am * BM * g.lda + (size_t)(u).acol) * 2)
#define PG8_BBASE(u) ((const char*)g.Bt + (size_t)(u).bn * BM * g.ldb * 2)
    Unit cur, nxt; int ui = 0;
    if (!S.next(0, cur)) return;
    f32x4 acc[2][2][4][2];
#pragma unroll
    for (int a = 0; a < 2; ++a)
#pragma unroll
        for (int b = 0; b < 2; ++b)
#pragma unroll
            for (int m = 0; m < 4; ++m)
#pragma unroll
                for (int n = 0; n < 2; ++n) acc[a][b][m][n] = (f32x4){0.f, 0.f, 0.f, 0.f};
    bf16x8 At[4][2], B0[2][2], B1[2][2]; i32x8 At8[4], B08[2], B18[2];
    const char* cA = PG8_ABASE(cur); const char* cB = PG8_BBASE(cur);
    {
        PG8_STAGE(PG8_SB(0, 0), cB, voffB); PG8_STAGE(PG8_SB(0, 1), cB + hstepB, voffB); PG8_STAGE(PG8_SA(0, 0), cA, voffA); PG8_STAGE(PG8_SA(0, 1), cA + hstepA, voffA);
        if (wr == 1) PG8_BAR;
        PG8_WAIT_V(2); PG8_BAR;
        PG8_STAGE(PG8_SB(1, 0), cB + kstep, voffB); PG8_STAGE(PG8_SA(1, 0), cA + kstep, voffA); PG8_STAGE(PG8_SB(1, 1), cB + hstepB + kstep, voffB);
        PG8_WAIT_V(6); PG8_BAR;
    }
    for (;;) {
        const bool has_next = S.next(ui + 1, nxt);
        const char* nA = has_next ? PG8_ABASE(nxt) : cA; const char* nB = has_next ? PG8_BBASE(nxt) : cB;
        for (int t = 0; t < nt; t += 2) {
            const bool last = (t == nt - 2);
            const char* a1 = cA + (size_t)(t + 1) * kstep;
            const char* a2 = last ? nA : cA + (size_t)(t + 2) * kstep; const char* b2 = last ? nB : cB + (size_t)(t + 2) * kstep;
            const char* a3 = a2 + kstep; const char* b3 = b2 + kstep;
            if constexpr (FP8) {
            PG8_LDB8(B08, 0, 0); PG8_LDB8(B18, 0, 1); PG8_SCHED; PG8_LDA8(At8, 0, 0); PG8_STAGE(PG8_SA(1, 1), a1 + hstepA, voffA);
            PG8_WAIT_V(8); PG8_WAIT_L(0); PG8_BAR; PG8_MMA8(0, 0, At8, B08); PG8_MMA8(0, 1, At8, B18); PG8_BAR; PG8_SCHED;
            PG8_LDA8(At8, 0, 1); PG8_STAGE(PG8_SB(0, 0), b2, voffB); PG8_STAGE(PG8_SB(0, 1), b2 + hstepB, voffB); PG8_STAGE(PG8_SA(0, 0), a2, voffA);
            PG8_WAIT_V(8); PG8_WAIT_L(0); PG8_BAR; PG8_MMA8(1, 0, At8, B08); PG8_MMA8(1, 1, At8, B18); PG8_BAR; PG8_SCHED;
            PG8_LDB8(B08, 1, 0); PG8_LDB8(B18, 1, 1); PG8_SCHED; PG8_LDA8(At8, 1, 0); PG8_STAGE(PG8_SA(0, 1), a2 + hstepA, voffA);
            PG8_WAIT_V(8); PG8_WAIT_L(0); PG8_BAR; PG8_MMA8(0, 0, At8, B08); PG8_MMA8(0, 1, At8, B18); PG8_BAR; PG8_SCHED;
            PG8_LDA8(At8, 1, 1); PG8_STAGE(PG8_SB(1, 0), b3, voffB); PG8_STAGE(PG8_SB(1, 1), b3 + hstepB, voffB); PG8_STAGE(PG8_SA(1, 0), a3, voffA);
            PG8_WAIT_V(8); PG8_WAIT_L(0); PG8_BAR; PG8_MMA8(1, 0, At8, B08); PG8_MMA8(1, 1, At8, B18); PG8_BAR; PG8_SCHED;
            } else {
            PG8_LDB(B0, 0, 0); PG8_LDB(B1, 0, 1); PG8_SCHED; PG8_LDA(At, 0, 0); PG8_STAGE(PG8_SA(1, 1), a1 + hstepA, voffA);
            PG8_WAIT_V(8); PG8_WAIT_L(0); PG8_BAR; PG8_MMA(0, 0, At, B0); PG8_MMA(0, 1, At, B1); PG8_BAR; PG8_SCHED;
            PG8_LDA(At, 0, 1); PG8_STAGE(PG8_SB(0, 0), b2, voffB); PG8_STAGE(PG8_SB(0, 1), b2 + hstepB, voffB); PG8_STAGE(PG8_SA(0, 0), a2, voffA);
            PG8_WAIT_V(8); PG8_WAIT_L(0); PG8_BAR; PG8_MMA(1, 0, At, B0); PG8_MMA(1, 1, At, B1); PG8_BAR; PG8_SCHED;
            PG8_LDB(B0, 1, 0); PG8_LDB(B1, 1, 1); PG8_SCHED; PG8_LDA(At, 1, 0); PG8_STAGE(PG8_SA(0, 1), a2 + hstepA, voffA);
            PG8_WAIT_V(8); PG8_WAIT_L(0); PG8_BAR; PG8_MMA(0, 0, At, B0); PG8_MMA(0, 1, At, B1); PG8_BAR; PG8_SCHED;
            PG8_LDA(At, 1, 1); PG8_STAGE(PG8_SB(1, 0), b3, voffB); PG8_STAGE(PG8_SB(1, 1), b3 + hstepB, voffB); PG8_STAGE(PG8_SA(1, 0), a3, voffA);
            PG8_WAIT_V(8); PG8_WAIT_L(0); PG8_BAR; PG8_MMA(1, 0, At, B0); PG8_MMA(1, 1, At, B1); PG8_BAR; PG8_SCHED;
            }
        }
        if constexpr (ALIGN) { if (wr == 0) PG8_BAR; }
        { int fr_ = fr, fq_ = fq; asm volatile("" : "+v"(fr_), "+v"(fq_));
          E(acc, cur, wr, wc, fr_, fq_); }
        if (!has_next) break;
#pragma unroll
        for (int a = 0; a < 2; ++a)
#pragma unroll
            for (int b = 0; b < 2; ++b)
#pragma unroll
                for (int m = 0; m < 4; ++m)
#pragma unroll
                    for (int n = 0; n < 2; ++n) acc[a][b][m][n] = (f32x4){0.f, 0.f, 0.f, 0.f};
        cur = nxt; cA = nA; cB = nB; ++ui;
        if constexpr (ALIGN) { if (wr == 1) PG8_BAR; }
    }
    PG8_WAIT_V(0);
    if constexpr (!ALIGN) { if (wr == 0) PG8_BAR; }
    PG8_BAR;
#undef PG8_SA
#undef PG8_SB
#undef PG8_STAGE
#undef PG8_LDA
#undef PG8_LDB
#undef PG8_MMA
#undef PG8_LDA8
#undef PG8_LDB8
#undef PG8_MMA8
#undef PG8_WAIT_V
#undef PG8_WAIT_L
#undef PG8_BAR
#undef PG8_SCHED
#undef PG8_ABASE
#undef PG8_BBASE
}

#define EPI_ROW(ai, m) (u.pm * BM + (ai) * HALF + wr * 64 + (m) * 16 + fr)
#define EPI_COL(bj) (u.pn * BM + (bj) * HALF + wc * 32 + 8 * fq)
typedef f32x4 AccT[2][2][4][2];

__device__ __forceinline__ void rope4(f32x4& v0, f32x4& v1, const f32x4 cs0, const f32x4 cs1) {
    f32x4 o0, o1;
    o0[0] = v0[0] * cs0[0] - v0[1] * cs0[1]; o0[1] = v0[1] * cs0[0] + v0[0] * cs0[1];
    o0[2] = v0[2] * cs0[2] - v0[3] * cs0[3]; o0[3] = v0[3] * cs0[2] + v0[2] * cs0[3];
    o1[0] = v1[0] * cs1[0] - v1[1] * cs1[1]; o1[1] = v1[1] * cs1[0] + v1[0] * cs1[1];
    o1[2] = v1[2] * cs1[2] - v1[3] * cs1[3]; o1[3] = v1[3] * cs1[2] + v1[2] * cs1[3];
    v0 = o0; v1 = o1;
}
__device__ __forceinline__ u32x4 pack8(const f32x4 v0, const f32x4 v1) { u32x4 w; w.x = cvt_pk_bf16(v0[0], v0[1]); w.y = cvt_pk_bf16(v0[2], v0[3]); w.z = cvt_pk_bf16(v1[0], v1[1]); w.w = cvt_pk_bf16(v1[2], v1[3]); return w; }

__device__ __forceinline__ void unpack8(const u32x4 w, f32x4& a, f32x4& b) { a[0] = bflo(w.x); a[1] = bfhi(w.x); a[2] = bflo(w.y); a[3] = bfhi(w.y); b[0] = bflo(w.z); b[1] = bfhi(w.z); b[2] = bflo(w.w); b[3] = bfhi(w.w); }
__device__ __forceinline__ u32x2 pack8_fp8(const f32x4 v0, const f32x4 v1, float s) { u32x2 w; w.x = pk4_fp8(v0[0] * s, v0[1] * s, v0[2] * s, v0[3] * s); w.y = pk4_fp8(v1[0] * s, v1[1] * s, v1[2] * s, v1[3] * s); return w; }
template <bool OUT8> struct EpiBf16 {
    bf16_t* O; int ldc; float osc;
    __device__ __forceinline__ void operator()(const AccT& acc, const Unit& u, int wr, int wc, int fr, int fq) const {
#pragma unroll
        for (int ai = 0; ai < 2; ++ai)
#pragma unroll
            for (int m = 0; m < 4; ++m) {
#pragma unroll
                for (int bj = 0; bj < 2; ++bj) {
                    if constexpr (OUT8) *(u32x2*)((unsigned char*)O + (size_t)EPI_ROW(ai, m) * ldc + EPI_COL(bj)) = pack8_fp8(acc[ai][bj][m][0], acc[ai][bj][m][1], osc);
                    else *(u32x4*)(O + (size_t)EPI_ROW(ai, m) * ldc + EPI_COL(bj)) = pack8(acc[ai][bj][m][0] * osc, acc[ai][bj][m][1] * osc); } }
    }
};
struct EpiQKV {
    unsigned char* ws; float asc;
    __device__ __forceinline__ void operator()(const AccT& acc, const Unit& u, int wr, int wc, int fr, int fq) const {
        bf16_t* Q = (bf16_t*)(ws + WS_Q); bf16_t* Kb = (bf16_t*)(ws + WS_K); bf16_t* VT = (bf16_t*)(ws + WS_VT); const float* tab64 = (const float*)(ws + WS_TAB64);
        if (u.pn < 9) {
            bf16_t* base = u.pn < 8 ? Q : Kb; const int ldc = u.pn < 8 ? 2048 : 256; const int colt = u.pn < 8 ? u.pn * BM : 0; const float sc = (u.pn < 8 ? QSCALE_SWA : 1.0f) * asc;
#pragma unroll
            for (int ai = 0; ai < 2; ++ai)
#pragma unroll
                for (int m = 0; m < 4; ++m) { const int row = EPI_ROW(ai, m);
#pragma unroll
                    for (int bj = 0; bj < 2; ++bj) { const int cl = bj * HALF + wc * 32 + 8 * fq; const int i0 = (cl & 63) >> 1;
                        const f32x4 cs0 = *(const f32x4*)(tab64 + ((size_t)row * 32 + i0) * 2), cs1 = *(const f32x4*)(tab64 + ((size_t)row * 32 + i0) * 2 + 4);
                        f32x4 v0 = acc[ai][bj][m][0], v1 = acc[ai][bj][m][1]; rope4(v0, v1, cs0, cs1); v0 = v0 * sc; v1 = v1 * sc;
                        if constexpr (SWA_FRAG) {
                            const int b = row >> 14, s = row & (SEQ - 1), hh = (colt + cl) >> 6, c64 = cl & 63, kk = c64 >> 4, hf2 = (c64 >> 3) & 1, nh = u.pn < 8 ? 32 : 4;
                            *(u32x4*)(base + ((((size_t)(b * nh + hh) * 512 + (s >> 5)) * 4 + kk) * 64 + hf2 * 32 + (s & 31)) * 8) = pack8(v0, v1); }
                        else *(u32x4*)(base + (size_t)row * ldc + colt + cl) = pack8(v0, v1); } }
        } else {
#pragma unroll
            for (int ai = 0; ai < 2; ++ai)
#pragma unroll
                for (int m = 0; m < 4; ++m) { const int row = EPI_ROW(ai, m), b = row >> 14, s = row & (SEQ - 1);
#pragma unroll
                    for (int bj = 0; bj < 2; ++bj) { const int cl = bj * HALF + wc * 32 + 8 * fq, kvh = cl >> 6, d0 = cl & 63;
                        const u32x4 w = pack8(acc[ai][bj][m][0] * asc, acc[ai][bj][m][1] * asc);
                        if constexpr (SWA_FRAG) {
                            const int j = s & 31, c = j >> 4, jj = j & 15, hfv = (jj & 7) >> 2, e = (jj & 3) + ((jj >> 3) << 2), mt = d0 >> 5;
                            bf16_t* pf = VT + (((((size_t)(b * 4 + kvh) * 512 + (s >> 5)) * 2 + c) * 2 + mt) * 64 + hfv * 32 + (d0 & 31)) * 8 + e;
                            pf[0] = (bf16_t)(w.x & 0xffff); pf[8] = (bf16_t)(w.x >> 16); pf[16] = (bf16_t)(w.y & 0xffff); pf[24] = (bf16_t)(w.y >> 16);
                            pf[32] = (bf16_t)(w.z & 0xffff); pf[40] = (bf16_t)(w.z >> 16); pf[48] = (bf16_t)(w.w & 0xffff); pf[56] = (bf16_t)(w.w >> 16); }
                        else {
                        bf16_t* p = VT + ((size_t)(b * 4 + kvh) * 64 + d0) * SEQ + s;
                        p[0 * SEQ] = (bf16_t)(w.x & 0xffff); p[1 * SEQ] = (bf16_t)(w.x >> 16); p[2 * SEQ] = (bf16_t)(w.y & 0xffff); p[3 * SEQ] = (bf16_t)(w.y >> 16);
                        p[4 * SEQ] = (bf16_t)(w.z & 0xffff); p[5 * SEQ] = (bf16_t)(w.z >> 16); p[6 * SEQ] = (bf16_t)(w.w & 0xffff); p[7 * SEQ] = (bf16_t)(w.w >> 16); } } }
        }
    }
};
template <bool RES16> struct EpiRes {
    const void* res; bf16_t* out; float sc;
    __device__ __forceinline__ void operator()(const AccT& acc, const Unit& u, int wr, int wc, int fr, int fq) const {
#pragma unroll
        for (int ai = 0; ai < 2; ++ai)
#pragma unroll
            for (int m = 0; m < 4; ++m) { const size_t ro = (size_t)EPI_ROW(ai, m) * DM;
#pragma unroll
                for (int bj = 0; bj < 2; ++bj) { const size_t o = ro + EPI_COL(bj); f32x4 r0, r1;
                    if constexpr (RES16) unpack8(*(const u32x4*)((const bf16_t*)res + o), r0, r1);
                    else { r0 = *(const f32x4*)((const float*)res + o); r1 = *(const f32x4*)((const float*)res + o + 4); }
                    *(u32x4*)(out + o) = pack8(r0 * ALPHA + acc[ai][bj][m][0] * sc, r1 * ALPHA + acc[ai][bj][m][1] * sc); }
                asm volatile("" ::: "memory"); }
    }
};
__device__ __forceinline__ float silu_mul(float g, float uu) { return g * __builtin_amdgcn_rcpf(1.0f + __builtin_amdgcn_exp2f(-g * LOG2E)) * uu; }
template <bool OUT8> struct EpiSwiglu {
    bf16_t* O; int ldc; float sc; float osc;
    __device__ __forceinline__ void operator()(const AccT& acc, const Unit& u, int wr, int wc, int fr, int fq) const {
#pragma unroll
        for (int ai = 0; ai < 2; ++ai)
#pragma unroll
            for (int m = 0; m < 4; ++m) { f32x4 a0, a1;
#pragma unroll
                for (int j = 0; j < 4; ++j) { a0[j] = silu_mul(acc[ai][0][m][0][j] * sc, acc[ai][1][m][0][j] * sc); a1[j] = silu_mul(acc[ai][0][m][1][j] * sc, acc[ai][1][m][1][j] * sc); }
                if constexpr (OUT8) { u32x2 w8; w8.x = pk4_fp8(a0[0] * osc, a0[1] * osc, a0[2] * osc, a0[3] * osc); w8.y = pk4_fp8(a1[0] * osc, a1[1] * osc, a1[2] * osc, a1[3] * osc);
                    *(u32x2*)((unsigned char*)O + (size_t)EPI_ROW(ai, m) * ldc + u.pn * HALF + wc * 32 + 8 * fq) = w8; }
                else *(u32x4*)(O + (size_t)EPI_ROW(ai, m) * ldc + u.pn * HALF + wc * 32 + 8 * fq) = pack8(a0, a1); }
    }
};
struct EpiPle {
    float* outf; unsigned char* ws; int layer;
    __device__ __forceinline__ void operator()(const AccT& acc, const Unit& u, int wr, int wc, int fr, int fq) const {
        const bf16_t* pp = (const bf16_t*)(ws + (layer == 0 ? WS_PP0 : WS_PP1));
        const bf16_t* xres = (const bf16_t*)(ws + (layer == 0 ? WS_XBA : WS_XBB));
#pragma unroll
        for (int ai = 0; ai < 2; ++ai)
#pragma unroll
            for (int m = 0; m < 4; ++m) { const size_t ro = (size_t)EPI_ROW(ai, m) * DM;
#pragma unroll
                for (int bj = 0; bj < 2; ++bj) { const size_t o = ro + EPI_COL(bj);
                    f32x4 r0, r1, p0, p1; unpack8(*(const u32x4*)(xres + o), r0, r1); unpack8(*(const u32x4*)(pp + o), p0, p1);
                    f32x4 s0, s1;
#pragma unroll
                    for (int j = 0; j < 4; ++j) { s0[j] = __builtin_amdgcn_rcpf(1.0f + __builtin_amdgcn_exp2f(-acc[ai][bj][m][0][j] * LOG2E)); s1[j] = __builtin_amdgcn_rcpf(1.0f + __builtin_amdgcn_exp2f(-acc[ai][bj][m][1][j] * LOG2E)); }
                    const f32x4 o0 = r0 + s0 * p0, o1 = r1 + s1 * p1;
                    if (layer == 0) { *(u32x4*)((bf16_t*)(ws + WS_XBB) + o) = pack8(o0, o1);
                                      if constexpr (F8_WIN_SPLIT || F8_WIN) *(u32x2*)(ws + WS_XB8 + o) = pack8_fp8(o0, o1, 1.0f); }
                    else { *(f32x4*)(outf + o) = o0; *(f32x4*)(outf + o + 4) = o1; } }
                asm volatile("" ::: "memory"); }
    }
};
struct EpiWin {
    unsigned char* ws; float asc; int pn0;
    __device__ __forceinline__ void operator()(const AccT& acc, const Unit& u, int wr, int wc, int fr, int fq) const {
        bf16_t* QN = (bf16_t*)(ws + WS_QN); bf16_t* QR = (bf16_t*)(ws + WS_QR); float* CRAW = (float*)(ws + WS_CRAW); bf16_t* KV = (bf16_t*)(ws + WS_KV); bf16_t* QI = (bf16_t*)(ws + WS_QI);
        bf16_t* KIF = (bf16_t*)(ws + WS_KIF); float* WI = (float*)(ws + WS_WI); const float* tab64 = (const float*)(ws + WS_TAB64); const float* tab32 = (const float*)(ws + WS_TAB32);
        const int pn = u.pn + pn0;
#pragma unroll
        for (int ai = 0; ai < 2; ++ai)
#pragma unroll
            for (int m = 0; m < 4; ++m) { const int row = EPI_ROW(ai, m);
#pragma unroll
                for (int bj = 0; bj < 2; ++bj) { const int cl = bj * HALF + wc * 32 + 8 * fq; f32x4 v0 = acc[ai][bj][m][0] * asc, v1 = acc[ai][bj][m][1] * asc;
                    if (pn < 8) { *(u32x4*)(QN + (size_t)row * 2048 + pn * BM + cl) = pack8(v0, v1); }
                    else if (pn < 12) { const int i0 = (cl & 63) >> 1;
                        const f32x4 cs0 = *(const f32x4*)(tab64 + ((size_t)row * 32 + i0) * 2), cs1 = *(const f32x4*)(tab64 + ((size_t)row * 32 + i0) * 2 + 4);
                        rope4(v0, v1, cs0, cs1); if constexpr (F8_LAT) { v0 = v0 * QLAT_F8SCALE; v1 = v1 * QLAT_F8SCALE; }
                        *(u32x4*)(QR + (size_t)row * 1024 + (pn - 8) * BM + cl) = pack8(v0, v1); }
                    else if (pn < 14) { float* p = CRAW + (size_t)row * 512 + (pn - 12) * BM + cl; *(f32x4*)p = v0; *(f32x4*)(p + 4) = v1; }
                    else if (pn == 14) {
                        if (cl < 64) { const int i0 = cl >> 1;
                            const f32x4 cs0 = *(const f32x4*)(tab64 + ((size_t)row * 32 + i0) * 2), cs1 = *(const f32x4*)(tab64 + ((size_t)row * 32 + i0) * 2 + 4);
                            rope4(v0, v1, cs0, cs1); *(u32x4*)(KV + (size_t)row * 576 + 512 + cl) = pack8(v0, v1); }
                        else if (cl < 128) { const int d8 = cl - 64;
                            if (d8 < 32) { const int i0 = d8 >> 1;
                                const f32x4 cs0 = *(const f32x4*)(tab32 + ((size_t)row * 16 + i0) * 2), cs1 = *(const f32x4*)(tab32 + ((size_t)row * 16 + i0) * 2 + 4);
                                rope4(v0, v1, cs0, cs1); }
                            const int b = row >> 14, s = row & (SEQ - 1), blk = s >> 5, j = s & 31, kk = d8 >> 4, hf = (d8 >> 3) & 1;
                            *(u32x4*)(KIF + ((size_t)((b * 512 + blk) * 4 + kk) * 64 + hf * 32 + j) * 8) = pack8(v0, v1); }
                        else if (cl < 144) { float* p = WI + (size_t)row * 16 + (cl - 128); *(f32x4*)p = v0; *(f32x4*)(p + 4) = v1; }
                    } else { const int cq = (pn - 15) * BM + cl, d8 = cq & 63;
                        if (d8 < 32) { const int i0 = d8 >> 1;
                            const f32x4 cs0 = *(const f32x4*)(tab32 + ((size_t)row * 16 + i0) * 2), cs1 = *(const f32x4*)(tab32 + ((size_t)row * 16 + i0) * 2 + 4);
                            rope4(v0, v1, cs0, cs1); }
                        *(u32x4*)(QI + (size_t)row * 1024 + cq) = pack8(v0, v1); }
                } }
    }
};
struct EpiMoeDown {
    unsigned char* ws;
    __device__ __forceinline__ void operator()(const AccT& acc, const Unit& u, int wr, int wc, int fr, int fq) const {
        bf16_t* O = (bf16_t*)(ws + WS_SOUT); const float* gate = (const float*)(ws + WS_SGATE);
#pragma unroll
        for (int ai = 0; ai < 2; ++ai)
#pragma unroll
            for (int m = 0; m < 4; ++m) { const int row = EPI_ROW(ai, m); const float gt = gate[row] * (1.0f / (ACT_F8SCALE * W2_F8SCALE)); bf16_t* rowp = O + (size_t)row * DM;
#pragma unroll
                for (int bj = 0; bj < 2; ++bj) *(u32x4*)(rowp + EPI_COL(bj)) = pack8(acc[ai][bj][m][0] * gt, acc[ai][bj][m][1] * gt); }
    }
};
}

#define XB_TMO      128
#define XB_XCNT(j)  (256  + 64 * (j))
#define XB_XSUB(j)  (1280 + 64 * (j))
#define XB_XGEN(j)  (2304 + 64 * (j))
#define XB_TOP      3328
#define XB_TOPGEN   3392
#define XCD_BAR_WORDS 3456
#define XB_SPIN_CAP (1u << 22)

__device__ __forceinline__ unsigned xb_ld(unsigned* p)              { return __hip_atomic_load(p, __ATOMIC_RELAXED, __HIP_MEMORY_SCOPE_AGENT); }
__device__ __forceinline__ unsigned xb_add(unsigned* p, unsigned v) { return __hip_atomic_fetch_add(p, v, __ATOMIC_RELAXED, __HIP_MEMORY_SCOPE_AGENT); }
__device__ __forceinline__ unsigned xb_xcc_id() { return (unsigned)__builtin_amdgcn_s_getreg((3 << 11) | 20) & 0xFu; }
#define XB_SPIN(cond, bar) do { unsigned _sp = 0; while (cond) { __builtin_amdgcn_s_sleep(1); \
    if ((++_sp & 255u) == 0u) { if (xb_ld(&(bar)[XB_TMO])) break; if (_sp > XB_SPIN_CAP) { atomicAdd(&(bar)[XB_TMO], 1u); break; } } } } while (0)

struct XcdBarrier { unsigned* bar; unsigned x; volatile LAS unsigned* st; };

__device__ __forceinline__ XcdBarrier xcd_barrier_post(unsigned* bar, volatile LAS unsigned* st) {
    XcdBarrier b; b.bar = bar; b.x = xb_xcc_id(); b.st = st;
    if (threadIdx.x == 0) (void)xb_add(&bar[XB_XCNT(b.x)], 1u);
    return b;
}
__device__ __forceinline__ void xcd_barrier_complete(unsigned* bar, unsigned x, unsigned& nloc, unsigned& nx) {
    const unsigned G = gridDim.x * gridDim.y * gridDim.z;
    unsigned sum, cnt, mine, sp = 0u;
    for (;;) {
        sum = 0u; cnt = 0u; mine = 0u;
#pragma unroll
        for (unsigned j = 0; j < 16; ++j) { const unsigned c = xb_ld(&bar[XB_XCNT(j)]); sum += c; cnt += (c > 0u) ? 1u : 0u; mine = (j == x) ? c : mine; }
        if (sum == G) break;
        __builtin_amdgcn_s_sleep(1);
        if ((++sp & 255u) == 0u) { if (xb_ld(&bar[XB_TMO])) break; if (sp > XB_SPIN_CAP) { atomicAdd(&bar[XB_TMO], 1u); break; } }
    }
    nloc = mine > 0u ? mine : 1u; nx = cnt > 0u ? cnt : 1u;
}
__device__ __forceinline__ void xcd_barrier(const XcdBarrier& b, int wave_) {
    asm volatile("s_waitcnt vmcnt(0)" ::: "memory");
    __syncthreads();
    int tl_ = wave_ * 64 + fresh_lane();
    if (tl_ == 0) {
        unsigned* bar = b.bar;
        __builtin_amdgcn_s_waitcnt(0);
        unsigned nloc = b.st[0], nx = b.st[1];
        if (nloc == 0u) { xcd_barrier_complete(bar, b.x, nloc, nx); b.st[0] = nloc; b.st[1] = nx; }
        const unsigned old = xb_add(&bar[XB_XSUB(b.x)], 1u);
        const unsigned gen = old / nloc;
        if (old + 1u == (gen + 1u) * nloc) {
            __builtin_amdgcn_fence(__ATOMIC_RELEASE, "agent");
            asm volatile("s_waitcnt vmcnt(0)" ::: "memory");
            const unsigned og = xb_add(&bar[XB_TOP], 1u);
            const unsigned tg = og / nx;
            if (og + 1u == (tg + 1u) * nx) xb_add(&bar[XB_TOPGEN], 1u);
            else XB_SPIN(xb_ld(&bar[XB_TOPGEN]) == tg, bar);
            __builtin_amdgcn_fence(__ATOMIC_ACQUIRE, "agent");
            xb_add(&bar[XB_XGEN(b.x)], 1u);
            asm volatile("s_waitcnt vmcnt(0)" ::: "memory");
        } else {
            XB_SPIN(xb_ld(&bar[XB_XGEN(b.x)]) == gen, bar);
            __builtin_amdgcn_fence(__ATOMIC_ACQUIRE, "agent");
            asm volatile("s_waitcnt vmcnt(0)" ::: "memory");
        }
    }
    __syncthreads();
}

struct Args { const void* in[22]; float* out; unsigned char* ws; };
struct Frame {
    LAS unsigned char* lds; volatile LAS unsigned* MISC; unsigned* ctl;
    int tid, lane, wave, gw; static constexpr int G = 256;
};
__device__ __forceinline__ void glds16(const void* g, LAS void* l) { __builtin_amdgcn_global_load_lds((const unsigned*)g, (LAS unsigned*)l, 16, 0, 0); }
__device__ __forceinline__ int mbcnt64(u64 m) { return (int)__builtin_amdgcn_mbcnt_hi((unsigned)(m >> 32), __builtin_amdgcn_mbcnt_lo((unsigned)m, 0u)); }

__device__ __forceinline__ int il64(int d) { return d < 32 ? 2 * d : 2 * (d - 32) + 1; }
__device__ __forceinline__ int il32(int d) { return d < 16 ? 2 * d : (d < 32 ? 2 * (d - 16) + 1 : d); }
__device__ __forceinline__ int map_row(int mode, int n) {
    if (mode == 1) return n < 2304 ? (n & ~63) + il64(n & 63) : n;
    if (mode == 2) return ((n >> 7) << 8) + (n & 127);
    if (mode == 3) return ((n >> 7) << 8) + 128 + (n & 127);
    if (mode == 4) {
        if (n < 3072) { const int h = n / 192, r = n - h * 192; return r < 128 ? h * 128 + r : 2048 + h * 64 + il64(r - 128); }
        if (n < 3584) return n;
        if (n < 3648) return 3584 + il64(n - 3584);
        if (n < 4672) { const int j = n - 3648; return 3840 + (j & ~63) + il32(j & 63); }
        if (n < 4736) return 3648 + il32(n - 4672);
        return 3712 + (n - 4736);
    }
    return n;
}
__device__ __forceinline__ void tr_item(const float* __restrict__ W, int N, bf16_t* WT, int ldo, int kofs, int mode, LAS float* scr, int item, int lane, float f8scale = 0.f, int rlo = 0, int rhi = 1 << 30) {
    const int nblk = (N + 63) >> 6, kb = item / nblk, nb = item - kb * nblk, k0 = 64 * kb, n0 = 64 * nb;
    const int nc = n0 + 4 * (lane & 15); const bool okr = nc < N; const float* wp = W + (size_t)(k0 + (lane >> 4)) * N + nc;
    f32x4 v[16];
#pragma unroll
    for (int i = 0; i < 16; ++i) v[i] = okr ? *(const f32x4*)(wp + (size_t)(4 * i) * N) : (f32x4){0.f, 0.f, 0.f, 0.f};
#pragma unroll
    for (int i = 0; i < 16; ++i) { const int k = 4 * i + (lane >> 4); *(LAS f32x4*)(scr + k * 64 + ((4 * (lane & 15) + 4 * (i >> 1)) & 63)) = v[i]; }
    LDS_WAIT();
    const int c = lane & 7;
#pragma unroll
    for (int j = 0; j < 8; ++j) { const int nl = (lane >> 3) + 8 * j, n = n0 + nl; const LAS float* s = scr + (8 * c) * 64 + ((nl + 4 * c) & 63);
        const int orow = map_row(mode, n); const bool okw = n < N && orow >= rlo && orow < rhi;
        if (f8scale > 0.f) { u32x2 o8; o8.x = pk4_fp8(s[0 * 64] * f8scale, s[1 * 64] * f8scale, s[2 * 64] * f8scale, s[3 * 64] * f8scale); o8.y = pk4_fp8(s[4 * 64] * f8scale, s[5 * 64] * f8scale, s[6 * 64] * f8scale, s[7 * 64] * f8scale);
            if (okw) *(u32x2*)((unsigned char*)WT + (size_t)orow * ldo + kofs + k0 + 8 * c) = o8; }
        else {
        u32x4 o; o.x = cvt_pk_bf16(s[0 * 64], s[1 * 64]); o.y = cvt_pk_bf16(s[2 * 64], s[3 * 64]); o.z = cvt_pk_bf16(s[4 * 64], s[5 * 64]); o.w = cvt_pk_bf16(s[6 * 64], s[7 * 64]);
        if (okw) *(u32x4*)(WT + (size_t)orow * ldo + kofs + k0 + 8 * c) = o; } }
    LDS_WAIT();
}
__device__ __forceinline__ void tr_matrix(const Frame& F, const float* W, int K, int N, bf16_t* WT, int ldo, int kofs, int mode, float f8scale = 0.f, int rlo = 0, int rhi = 1 << 30) {
    LAS float* scr = (LAS float*)(F.lds + F.wave * 16384);
    const int nitems = (K >> 6) * ((N + 63) >> 6), NGW = F.G * NWAVES;
    for (int it = F.gw; it < nitems; it += NGW) tr_item(W, N, WT, ldo, kofs, mode, scr, it, F.lane, f8scale, rlo, rhi);
}
__device__ __forceinline__ void cvt_linear(const Frame& F, const float* src, bf16_t* dst, size_t n8) {
    const size_t NT = (size_t)F.G * NTHREADS;
    for (size_t i = (size_t)blockIdx.x * NTHREADS + F.tid; i < n8; i += NT) { const f32x4 a = *(const f32x4*)(src + i * 8), b = *(const f32x4*)(src + i * 8 + 4); *(u32x4*)(dst + i * 8) = pg8::pack8(a, b); }
}
__device__ __forceinline__ void cvt_linear8(const Frame& F, const float* src, unsigned char* dst, size_t n8) {
    const size_t NT = (size_t)F.G * NTHREADS;
    for (size_t i = (size_t)blockIdx.x * NTHREADS + F.tid; i < n8; i += NT) { const f32x4 a = *(const f32x4*)(src + i * 8), b = *(const f32x4*)(src + i * 8 + 4); *(u32x2*)(dst + i * 8) = pg8::pack8_fp8(a, b, 1.0f); }
}
__device__ __forceinline__ void sincos_d(double ang, float& c, float& s) {
    const double n = __builtin_rint(ang * 0.6366197723675814);
    double r = __builtin_fma(-n, 1.5707963267948966, ang); r = __builtin_fma(-n, 6.123233995736766e-17, r);
    const double r2 = r * r;
    const double sp = r * (1.0 + r2 * (-1.0 / 6.0 + r2 * (1.0 / 120.0 + r2 * (-1.0 / 5040.0 + r2 * (1.0 / 362880.0 + r2 * (-1.0 / 39916800.0 + r2 * (1.0 / 6227020800.0)))))));
    const double cp = 1.0 + r2 * (-0.5 + r2 * (1.0 / 24.0 + r2 * (-1.0 / 720.0 + r2 * (1.0 / 40320.0 + r2 * (-1.0 / 3628800.0 + r2 * (1.0 / 479001600.0 + r2 * (-1.0 / 87178291200.0)))))));
    const int q = (int)((long long)n & 3);
    const float sf = (float)sp, cf = (float)cp;
    c = q == 0 ? cf : (q == 1 ? -sf : (q == 2 ? -cf : sf));
    s = q == 0 ? sf : (q == 1 ? cf : (q == 2 ? -sf : -cf));
}
__device__ __forceinline__ void rope_tables(const Frame& F, const int* pos, float* tab64, float* tab32) {
    const int NT = F.G * NTHREADS;
    for (int i = blockIdx.x * NTHREADS + F.tid; i < T * 48; i += NT) {
        const int t = i / 48, f = i - t * 48; const bool is64 = f < 32; const int fi = is64 ? f : f - 32;
        const double base = is64 ? 0.7498942093324559 : 0.5623413251903491;
        double inv = 1.0; for (int k = 0; k < fi; ++k) inv *= base;
        float c, s; sincos_d((double)pos[t] * inv, c, s);
        float* o = is64 ? tab64 + ((size_t)t * 32 + fi) * 2 : tab32 + ((size_t)t * 16 + fi) * 2; o[0] = c; o[1] = s;
    }
}

constexpr int MOE_CONV_ITEMS = 8 * 3 * 3584;
__device__ __forceinline__ void moe_conv_item(const float* w1, const float* w3, const float* w2, unsigned char* ws, LAS float* scr, int it, int lane) {
    const int e = it / (3 * 3584), r = it - e * (3 * 3584), mtx = r / 3584, sub = r - mtx * 3584;
    if (mtx < 2) tr_item((mtx == 0 ? w1 : w3) + (size_t)e * DM * MFFN, MFFN, (bf16_t*)(ws + WS_MW13 + (size_t)e * 2 * MFFN * DM), DM, 0, 2 + mtx, scr, sub, lane, W13_F8SCALE);
    else tr_item(w2 + (size_t)e * MFFN * DM, DM, (bf16_t*)(ws + WS_MW2 + (size_t)e * DM * MFFN), MFFN, 0, 0, scr, sub, lane, W2_F8SCALE);
}

__device__ __forceinline__ unsigned ln_col(int lane, int q) { return 8u * (unsigned)(lane & 63) + 512u * (unsigned)(q >> 1) + 4u * (unsigned)(q & 1); }
__device__ __forceinline__ void ln_load16(f32x4 (&v)[8], const bf16_t* row, int lane) {
#pragma unroll
    for (int j = 0; j < 4; ++j) pg8::unpack8(*(const u32x4*)(row + ln_col(lane, 2 * j)), v[2 * j], v[2 * j + 1]);
}
__device__ __forceinline__ void ln_store16(const f32x4 (&v)[8], bf16_t* row, int lane) {
#pragma unroll
    for (int j = 0; j < 4; ++j) *(u32x4*)(row + ln_col(lane, 2 * j)) = pg8::pack8(v[2 * j], v[2 * j + 1]);
}
__device__ __forceinline__ void ln_store8(const f32x4 (&v)[8], unsigned char* row, int lane) {
#pragma unroll
    for (int j = 0; j < 4; ++j) *(u32x2*)(row + ln_col(lane, 2 * j)) = pg8::pack8_fp8(v[2 * j], v[2 * j + 1], 1.0f);
}
__device__ __forceinline__ void ln_core(f32x4 (&v)[8], const float* g, const float* bb, int lane) {
    float s = 0.f;
#pragma unroll
    for (int j = 0; j < 8; ++j) s += (v[j][0] + v[j][1]) + (v[j][2] + v[j][3]);
    const float mean = wave_sum(s) * (1.0f / DM); float s2 = 0.f;
#pragma unroll
    for (int j = 0; j < 8; ++j) { v[j] = v[j] - mean; s2 += (v[j][0] * v[j][0] + v[j][1] * v[j][1]) + (v[j][2] * v[j][2] + v[j][3] * v[j][3]); }
    const float rstd = 1.0f / sqrtf(wave_sum(s2) * (1.0f / DM) + LN_EPS);
    int l2 = lane; asm volatile("" : "+v"(l2) :: "memory");
#pragma unroll
    for (int j = 0; j < 8; ++j) { const f32x4 gv = *(const f32x4*)(g + ln_col(l2, j)), bv = *(const f32x4*)(bb + ln_col(l2, j)); v[j] = v[j] * rstd * gv + bv; }
}
template <bool OUT8> __device__ __forceinline__ void ln_phase(const Frame& F, const bf16_t* YH, bf16_t* X16, unsigned char* X8, const float* g, const float* bb) {
    const int NGW = F.G * NWAVES;
    for (int m = F.gw; m < T; m += NGW) { f32x4 v[8];
        ln_load16(v, YH + (size_t)m * DM, F.lane); ln_core(v, g, bb, F.lane); ln_store16(v, X16 + (size_t)m * DM, F.lane);
        if constexpr (OUT8) ln_store8(v, X8 + (size_t)m * DM, F.lane); }
}

__device__ __forceinline__ int crow(int r, int hi) { return (r & 3) + 8 * (r >> 2) + 4 * hi; }
template <bool OUT8> __device__ __forceinline__ void swa_phase(const Frame& F, bf16_t* Q, const bf16_t* Kb, const bf16_t* VT, const float* sinks, unsigned char* O8) {
    const int lane = F.lane, l31 = lane & 31, hf = lane >> 5;
    for (int wi = blockIdx.x; wi < 4096; wi += F.G) {
        const int kvh = wi & 3, qsi = (wi >> 2) & 511, b = wi >> 11, h = kvh * 8 + F.wave, q0 = qsi * 32;
        const size_t row0 = (size_t)b * SEQ + q0;
        bf16x8 qf[4];
#pragma unroll
        for (int kk = 0; kk < 4; ++kk) { if constexpr (SWA_FRAG) qf[kk] = *(const bf16x8*)(Q + ((((size_t)(b * 32 + h) * 512 + qsi) * 4 + kk) * 64 + lane) * 8);
            else qf[kk] = *(const bf16x8*)(Q + (row0 + l31) * 2048 + h * 64 + 16 * kk + 8 * hf); }
        f32x16 sc[5];
#pragma unroll
        for (int kt = 0; kt < 5; ++kt) {
            int kpos = q0 - 128 + 32 * kt + l31; kpos = kpos < 0 ? 0 : kpos;
            const bf16_t* kp = Kb + ((size_t)b * SEQ + kpos) * 256 + kvh * 64 + 8 * hf;
            f32x16 a;
#pragma unroll
            for (int r = 0; r < 16; ++r) a[r] = 0.f;
            const int kblk = qsi - 4 + kt < 0 ? 0 : qsi - 4 + kt;
#pragma unroll
            for (int kk = 0; kk < 4; ++kk) { bf16x8 kf; if constexpr (SWA_FRAG) kf = *(const bf16x8*)(Kb + ((((size_t)(b * 4 + kvh) * 512 + kblk) * 4 + kk) * 64 + lane) * 8); else kf = *(const bf16x8*)(kp + 16 * kk);
                a = __builtin_amdgcn_mfma_f32_32x32x16_bf16(kf, qf[kk], a, 0, 0, 0); }
            sc[kt] = a;
        }
        const float sink2 = sinks[h] * LOG2E; const int qpos = q0 + l31;
        float mx = sink2;
#pragma unroll
        for (int kt = 0; kt < 5; ++kt)
#pragma unroll
            for (int r = 0; r < 16; ++r) { const int kpos = q0 - 128 + 32 * kt + crow(r, hf); const bool ok = kpos >= 0 && kpos <= qpos && (qpos - kpos) < 128;
                const float v = ok ? sc[kt][r] : -INFINITY; sc[kt][r] = v; mx = fmaxf(mx, v); }
        mx = fmaxf(mx, shx(mx, 32, lane));
        float sum = 0.f;
#pragma unroll
        for (int kt = 0; kt < 5; ++kt)
#pragma unroll
            for (int r = 0; r < 16; ++r) { const float p = __builtin_amdgcn_exp2f(sc[kt][r] - mx); sc[kt][r] = p; sum += p; }
        sum += shx(sum, 32, lane);
        const float inv = 1.0f / (sum + __builtin_amdgcn_exp2f(sink2 - mx));
        f32x16 o[2];
#pragma unroll
        for (int r = 0; r < 16; ++r) { o[0][r] = 0.f; o[1][r] = 0.f; }
#pragma unroll
        for (int kt = 0; kt < 5; ++kt)
#pragma unroll
            for (int c = 0; c < 2; ++c) {
                bf16x8 pb; { u32x4 w; w.x = cvt_pk_bf16(sc[kt][8 * c + 0], sc[kt][8 * c + 1]); w.y = cvt_pk_bf16(sc[kt][8 * c + 2], sc[kt][8 * c + 3]); w.z = cvt_pk_bf16(sc[kt][8 * c + 4], sc[kt][8 * c + 5]); w.w = cvt_pk_bf16(sc[kt][8 * c + 6], sc[kt][8 * c + 7]); pb = __builtin_bit_cast(bf16x8, w); }
                int kb = q0 - 128 + 32 * kt + 16 * c + 4 * hf; int kb0 = kb < 0 ? 0 : kb, kb1 = kb + 8 < 0 ? 0 : kb + 8;
#pragma unroll
                for (int mt = 0; mt < 2; ++mt) { bf16x8 va;
                    if constexpr (SWA_FRAG) { const int vblk = qsi - 4 + kt < 0 ? 0 : qsi - 4 + kt; va = *(const bf16x8*)(VT + (((((size_t)(b * 4 + kvh) * 512 + vblk) * 2 + c) * 2 + mt) * 64 + lane) * 8); }
                    else { const bf16_t* vp = VT + ((size_t)(b * 4 + kvh) * 64 + 32 * mt + l31) * SEQ;
                    const u32x2 v0 = *(const u32x2*)(vp + kb0), v1 = *(const u32x2*)(vp + kb1); u32x4 w; w.x = v0.x; w.y = v0.y; w.z = v1.x; w.w = v1.y; va = __builtin_bit_cast(bf16x8, w); }
                    o[mt] = __builtin_amdgcn_mfma_f32_32x32x16_bf16(va, pb, o[mt], 0, 0, 0); }
            }
        bf16_t* op = Q + (row0 + l31) * 2048 + h * 64; unsigned char* op8 = O8 + (row0 + l31) * 2048 + h * 64; const float inv8 = inv * O0_F8SCALE;
#pragma unroll
        for (int mt = 0; mt < 2; ++mt)
#pragma unroll
            for (int r4 = 0; r4 < 4; ++r4) {
                if constexpr (OUT8) *(unsigned*)(op8 + 32 * mt + 8 * r4 + 4 * hf) = pk4_fp8(o[mt][4 * r4] * inv8, o[mt][4 * r4 + 1] * inv8, o[mt][4 * r4 + 2] * inv8, o[mt][4 * r4 + 3] * inv8);
                else { u32x2 w; w.x = cvt_pk_bf16(o[mt][4 * r4] * inv, o[mt][4 * r4 + 1] * inv); w.y = cvt_pk_bf16(o[mt][4 * r4 + 2] * inv, o[mt][4 * r4 + 3] * inv);
                *(u32x2*)(op + 32 * mt + 8 * r4 + 4 * hf) = w; } }
    }
}

__device__ __forceinline__ void kvnorm_phase(const Frame& F, const float* CRAW, const float* gk, bf16_t* KV) {
    const int NGW = F.G * NWAVES;
    for (int m = F.gw; m < T; m += NGW) { const float* cr = CRAW + (size_t)m * 512;
        const f32x4 a = *(const f32x4*)(cr + 4 * F.lane), b = *(const f32x4*)(cr + 256 + 4 * F.lane);
        float s = (a[0] * a[0] + a[1] * a[1]) + (a[2] * a[2] + a[3] * a[3]) + (b[0] * b[0] + b[1] * b[1]) + (b[2] * b[2] + b[3] * b[3]);
        const float r = 1.0f / sqrtf(wave_sum(s) * (1.0f / 512.0f) + RMS_EPS);
        const f32x4 ga = *(const f32x4*)(gk + 4 * F.lane), gb = *(const f32x4*)(gk + 256 + 4 * F.lane);
        u32x2 w0, w1; w0.x = cvt_pk_bf16(a[0] * r * ga[0], a[1] * r * ga[1]); w0.y = cvt_pk_bf16(a[2] * r * ga[2], a[3] * r * ga[3]);
        w1.x = cvt_pk_bf16(b[0] * r * gb[0], b[1] * r * gb[1]); w1.y = cvt_pk_bf16(b[2] * r * gb[2], b[3] * r * gb[3]);
        *(u32x2*)(KV + (size_t)m * 576 + 4 * F.lane) = w0; *(u32x2*)(KV + (size_t)m * 576 + 256 + 4 * F.lane) = w1; }
}

__device__ __forceinline__ float relu1(float a) { return __builtin_amdgcn_fmed3f(a, 0.f, 3.0e38f); }
__device__ __forceinline__ unsigned f2key(float f) { const unsigned u = __float_as_uint(f); return u ^ ((unsigned)((int)u >> 31) | 0x80000000u); }
__device__ __forceinline__ float key2f(unsigned k) { const unsigned u = (k & 0x80000000u) ? (k ^ 0x80000000u) : ~k; return __uint_as_float(u); }
__device__ __forceinline__ unsigned compact256(LAS u64* buf, int n, int lane) {
    u64 e[8];
#pragma unroll
    for (int i = 0; i < 8; ++i) e[i] = (lane + 64 * i < n) ? buf[lane + 64 * i] : 0ull;
    unsigned thr = 0u;
    for (int bit = 31; bit >= 0; --bit) {
        const unsigned cand = thr | (1u << bit); int c = 0;
#pragma unroll
        for (int i = 0; i < 8; ++i) c += __popcll(__ballot((unsigned)(e[i] >> 32) >= cand));
        if (c >= 256) thr = cand;
    }
    int ngt = 0;
#pragma unroll
    for (int i = 0; i < 8; ++i) ngt += __popcll(__ballot((unsigned)(e[i] >> 32) > thr));
    int pos_gt = 0, pos_eq = ngt;
#pragma unroll
    for (int i = 0; i < 8; ++i) { const unsigned k = (unsigned)(e[i] >> 32); const bool gt = k > thr, eq = k == thr; const u64 mg = __ballot(gt), me = __ballot(eq);
        if (gt) buf[pos_gt + mbcnt64(mg)] = e[i];
        const int re = pos_eq + mbcnt64(me); if (eq && re < 256) buf[re] = e[i];
        pos_gt += __popcll(mg); pos_eq += __popcll(me); }
    return thr;
}
__device__ __forceinline__ unsigned compact_bound(LAS u64* buf, int n, int lane, unsigned lo, int& n_out) {
    u64 e[8]; unsigned mx = 0u;
#pragma unroll
    for (int i = 0; i < 8; ++i) { e[i] = (lane + 64 * i < n) ? buf[lane + 64 * i] : 0ull; const unsigned k = (unsigned)(e[i] >> 32); mx = k > mx ? k : mx; }
#pragma unroll
    for (int o = 1; o < 64; o <<= 1) { const unsigned t = (unsigned)__builtin_amdgcn_ds_bpermute((lane ^ o) << 2, (int)mx); mx = t > mx ? t : mx; }
    mx = (unsigned)__builtin_amdgcn_readfirstlane((int)mx);
    const unsigned diff = mx ^ lo; const int hb = diff ? 31 - __builtin_clz(diff) : 0;
    unsigned thr = hb >= 31 ? 0u : (lo & ~((2u << hb) - 1u)); int cge = n;
    for (int bit = hb; bit >= 0; --bit) {
        const unsigned cand = thr | (1u << bit); int c = 0;
#pragma unroll
        for (int i = 0; i < 8; ++i) c += __popcll(__ballot((unsigned)(e[i] >> 32) >= cand));
        if (c >= 256) { thr = cand; cge = c; if (c <= 288) break; }
    }
    int pos = 0;
#pragma unroll
    for (int i = 0; i < 8; ++i) { const bool ge = (unsigned)(e[i] >> 32) >= thr && (lane + 64 * i < n); const u64 mg = __ballot(ge);
        if (ge) buf[pos + mbcnt64(mg)] = e[i];
        pos += __popcll(mg); }
    n_out = pos;
    return thr;
}
__device__ __forceinline__ void topk_phase(const Frame& F, const bf16_t* QI, const bf16_t* KIF, const float* WI, unsigned short* SEL) {
    const int lane = F.lane, l31 = lane & 31, hf = lane >> 5, wave = F.wave;
    LAS u64* mybuf = (LAS u64*)F.lds + (size_t)(wave * 4) * 512;
    const unsigned lmask_lt = (1u << l31) - 1u; const int hfm = -hf;
    for (int pu = blockIdx.x; pu < 512; pu += F.G) {
        const int b = pu >> 8, pi = pu & 255;
        for (int half = 0; half < 2; ++half) {
            const int tq = half == 0 ? pi : 511 - pi, q0 = tq * 32, nsteps = tq + 1;
            const size_t trow0 = (size_t)b * SEQ + q0 + 4 * wave;
            bf16x8 aq[2][4]; float wq[2][16];
#pragma unroll
            for (int s = 0; s < 2; ++s) {
                const int qq = 2 * s + ((l31 >> 2) & 1), hd = 4 * (l31 >> 3) + (l31 & 3);
#pragma unroll
                for (int kk = 0; kk < 4; ++kk) aq[s][kk] = *(const bf16x8*)(QI + ((trow0 + qq) * 16 + hd) * 64 + 16 * kk + 8 * hf);
                const float* wp = WI + (trow0 + 2 * s + hf) * 16;
#pragma unroll
                for (int r4 = 0; r4 < 4; ++r4) { const f32x4 w = *(const f32x4*)(wp + 4 * r4); wq[s][4 * r4] = w[0]; wq[s][4 * r4 + 1] = w[1]; wq[s][4 * r4 + 2] = w[2]; wq[s][4 * r4 + 3] = w[3]; }
            }
            float psc0 = 0.f, psc1 = 0.f; int pix0 = 0, pix1 = 0; bool pv0 = false, pv1 = false;
            float thr0 = -INFINITY, thr1 = -INFINITY; int c0 = 0, c1 = 0, c2 = 0, c3 = 0; unsigned b0 = 0x007fffffu, b1 = 0x007fffffu, b2 = 0x007fffffu, b3 = 0x007fffffu;
            const bf16_t* kbase = KIF + (size_t)b * 512 * 4 * 64 * 8 + (size_t)lane * 8;
            bf16x8 k0[4], k1[4], k2[4], k3[4];
#pragma unroll
            for (int kk = 0; kk < 4; ++kk) { k0[kk] = *(const bf16x8*)(kbase + (size_t)(0 * 4 + kk) * 512); k1[kk] = *(const bf16x8*)(kbase + (size_t)((nsteps > 1 ? 1 : 0) * 4 + kk) * 512);
                k2[kk] = *(const bf16x8*)(kbase + (size_t)((nsteps > 2 ? 2 : nsteps - 1) * 4 + kk) * 512); k3[kk] = *(const bf16x8*)(kbase + (size_t)((nsteps > 3 ? 3 : nsteps - 1) * 4 + kk) * 512); }
#define TOPK_STEP(KB, STEP) { const int kidx = 32 * (STEP) + l31; \
    f32x16 a0_, a1_; _Pragma("unroll") for (int r = 0; r < 16; ++r) { a0_[r] = 0.f; a1_[r] = 0.f; } \
    _Pragma("unroll") for (int kk = 0; kk < 4; ++kk) a0_ = __builtin_amdgcn_mfma_f32_32x32x16_bf16(aq[0][kk], KB[kk], a0_, 0, 0, 0); \
    _Pragma("unroll") for (int kk = 0; kk < 4; ++kk) a1_ = __builtin_amdgcn_mfma_f32_32x32x16_bf16(aq[1][kk], KB[kk], a1_, 0, 0, 0); \
    { const int sn_ = (STEP) + 4 < nsteps ? (STEP) + 4 : nsteps - 1; _Pragma("unroll") for (int kk = 0; kk < 4; ++kk) KB[kk] = *(const bf16x8*)(kbase + (size_t)(sn_ * 4 + kk) * 512); }     \
    float sc0_ = 0.f, sc1_ = 0.f; \
    _Pragma("unroll") for (int r = 0; r < 16; ++r) sc0_ = fmaf(wq[0][r], relu1(a0_[r]), sc0_); \
    _Pragma("unroll") for (int r = 0; r < 16; ++r) sc1_ = fmaf(wq[1][r], relu1(a1_[r]), sc1_); \
    const int tql0_ = q0 + 4 * wave + hf; \
    const bool pass0_ = (sc0_ > thr0) && (kidx <= tql0_), pass1_ = (sc1_ > thr1) && (kidx <= tql0_ + 2); \
      \
    if (__ballot((pass0_ && pv0) || (pass1_ && pv1))) { TOPK_FLUSH(); } \
    psc0 = pass0_ ? sc0_ : psc0; pix0 = pass0_ ? kidx : pix0; pv0 = pv0 || pass0_; \
    psc1 = pass1_ ? sc1_ : psc1; pix1 = pass1_ ? kidx : pix1; pv1 = pv1 || pass1_; }
#define TOPK_FLUSH() { const u64 mask0_ = __ballot(pv0), mask1_ = __ballot(pv1); \
        if (mask0_) { const unsigned lo = (unsigned)mask0_, hi = (unsigned)(mask0_ >> 32); const int plo = __popc(lo), phi = __popc(hi); \
          const int rank = mbcnt64(mask0_) - (plo & hfm); const int cm = c0 + ((c1 - c0) & hfm); \
          if (pv0) mybuf[hf * 512 + cm + rank] = ((u64)f2key(psc0) << 32) | (unsigned)pix0; c0 += plo; c1 += phi; } \
        if (mask1_) { const unsigned lo = (unsigned)mask1_, hi = (unsigned)(mask1_ >> 32); const int plo = __popc(lo), phi = __popc(hi); \
          const int rank = mbcnt64(mask1_) - (plo & hfm); const int cm = c2 + ((c3 - c2) & hfm); \
          if (pv1) mybuf[(2 + hf) * 512 + cm + rank] = ((u64)f2key(psc1) << 32) | (unsigned)pix1; c2 += plo; c3 += phi; } \
        pv0 = false; pv1 = false; \
        const int cmx_ = max(max(c0, c1), max(c2, c3)); \
        if (cmx_ > 480) { \
        if (c0 > 480) { b0 = compact_bound(mybuf, c0, lane, b0, c0); const float nt = key2f(b0); thr0 = hf == 0 ? nt : thr0; } \
        if (c1 > 480) { b1 = compact_bound(mybuf + 512, c1, lane, b1, c1); const float nt = key2f(b1); thr0 = hf == 1 ? nt : thr0; } \
        if (c2 > 480) { b2 = compact_bound(mybuf + 1024, c2, lane, b2, c2); const float nt = key2f(b2); thr1 = hf == 0 ? nt : thr1; } \
        if (c3 > 480) { b3 = compact_bound(mybuf + 1536, c3, lane, b3, c3); const float nt = key2f(b3); thr1 = hf == 1 ? nt : thr1; } } }
            for (int st = 0; st < nsteps; st += 4) {
                TOPK_STEP(k0, st);
                if (st + 1 < nsteps) TOPK_STEP(k1, st + 1);
                if (st + 2 < nsteps) TOPK_STEP(k2, st + 2);
                if (st + 3 < nsteps) TOPK_STEP(k3, st + 3);
            }
            TOPK_FLUSH();
#undef TOPK_STEP
#undef TOPK_FLUSH
#pragma unroll
            for (int qi = 0; qi < 4; ++qi) {
                int c = qi == 0 ? c0 : (qi == 1 ? c1 : (qi == 2 ? c2 : c3)); LAS u64* bq = mybuf + qi * 512;
                if (c > 256) { (void)compact256(bq, c, lane); c = 256; }
                LDS_WAIT();
                unsigned short v[4];
#pragma unroll
                for (int j = 0; j < 4; ++j) { const int e = 4 * lane + j; v[j] = e < c ? (unsigned short)(bq[e] & 0xffffull) : (unsigned short)0xffff; }
                u32x2 w; w.x = (unsigned)v[0] | ((unsigned)v[1] << 16); w.y = (unsigned)v[2] | ((unsigned)v[3] << 16);
                *(u32x2*)(SEL + (trow0 + qi) * 256 + 4 * lane) = w;
            }
            LDS_WAIT();
        }
    }
}

__device__ __forceinline__ bf16x4 tr_read16(const LAS unsigned char* p) { return __builtin_bit_cast(bf16x4, __builtin_amdgcn_ds_read_tr16_b64_v4i16((LAS bf16x4*)p)); }
__device__ __forceinline__ void dsa_attn_phase(const Frame& F, const bf16_t* QLAT, bf16_t* OUT, const bf16_t* QR, const bf16_t* KV, const unsigned short* SEL, const float* w1, const float* w3, const float* w2, unsigned char* ws) {
    LAS unsigned char* wb = F.lds + F.wave * DSA_WBUF; LAS unsigned char* tails = wb + 16640;
    const unsigned char* KVb = (const unsigned char*)KV;
    const int NGW = F.G * NWAVES;
    for (int tg = F.gw; tg < T; tg += NGW) {
        int lane = F.lane; asm volatile("" : "+v"(lane));
        const int l15 = lane & 15, g = lane >> 4;
        const int b = tg >> 14, t = tg & (SEQ - 1); const int nvalid = t + 1 < 256 ? t + 1 : 256, nsteps = (nvalid + 15) >> 4;
        bf16x8 qf[18];
#pragma unroll
        for (int kk = 0; kk < 16; ++kk) {
            if constexpr (F8_LAT) { const u32x2 w8 = *(const u32x2*)((const unsigned char*)QLAT + ((size_t)tg * 16 + l15) * 512 + 32 * kk + 8 * g);
                const f32x2 f0 = __builtin_amdgcn_cvt_pk_f32_fp8((int)w8.x, false), f1 = __builtin_amdgcn_cvt_pk_f32_fp8((int)w8.x, true), f2 = __builtin_amdgcn_cvt_pk_f32_fp8((int)w8.y, false), f3 = __builtin_amdgcn_cvt_pk_f32_fp8((int)w8.y, true);
                u32x4 wb16; wb16.x = cvt_pk_bf16(f0[0], f0[1]); wb16.y = cvt_pk_bf16(f1[0], f1[1]); wb16.z = cvt_pk_bf16(f2[0], f2[1]); wb16.w = cvt_pk_bf16(f3[0], f3[1]); qf[kk] = __builtin_bit_cast(bf16x8, wb16); }
            else qf[kk] = *(const bf16x8*)(QLAT + ((size_t)tg * 16 + l15) * 512 + 32 * kk + 8 * g); }
#pragma unroll
        for (int kk = 0; kk < 2; ++kk) qf[16 + kk] = *(const bf16x8*)(QR + ((size_t)tg * 16 + l15) * 64 + 32 * kk + 8 * g);
        float m = -INFINITY, lsum = 0.f; f32x4 O[32];
#pragma unroll
        for (int mt = 0; mt < 32; ++mt) O[mt] = (f32x4){0.f, 0.f, 0.f, 0.f};
        for (int st = 0; st < nsteps; ++st) {
            const int slot = 16 * st + l15;
            int idx = slot < nvalid ? (int)SEL[(size_t)tg * 256 + slot] : 0; idx = idx > t ? 0 : idx;
            const int row = b * SEQ + idx;
            LDS_WAIT();
#pragma unroll
            for (int r = 0; r < 16; ++r) { const int rr = __builtin_amdgcn_readlane(row, r); glds16(KVb + (size_t)rr * 1152 + 16 * lane, wb + r * 1040); }
#pragma unroll
            for (int p = 0; p < 2; ++p) glds16(KVb + (size_t)row * 1152 + 1024 + 16 * (4 * p + g), tails + 1024 * p);
            VM_WAIT();
            f32x4 sacc = (f32x4){0.f, 0.f, 0.f, 0.f};
#pragma unroll
            for (int kk = 0; kk < 16; ++kk) { const bf16x8 a = *(const LAS bf16x8*)(wb + l15 * 1040 + (4 * kk + g) * 16); sacc = __builtin_amdgcn_mfma_f32_16x16x32_bf16(a, qf[kk], sacc, 0, 0, 0); }
#pragma unroll
            for (int kk = 0; kk < 2; ++kk) { const bf16x8 a = *(const LAS bf16x8*)(tails + (4 * kk + g) * 256 + l15 * 16); sacc = __builtin_amdgcn_mfma_f32_16x16x32_bf16(a, qf[16 + kk], sacc, 0, 0, 0); }
            float s[4]; float tmax = -INFINITY;
#pragma unroll
            for (int i = 0; i < 4; ++i) { s[i] = (16 * st + 4 * g + i) < nvalid ? sacc[i] * (F8_LAT ? SCALE2_MLA / QLAT_F8SCALE : SCALE2_MLA) : -INFINITY; tmax = fmaxf(tmax, s[i]); }
            tmax = fmaxf(tmax, shx(tmax, 16, lane)); tmax = fmaxf(tmax, shx(tmax, 32, lane));
            const float mnew = fmaxf(m, tmax); const float alpha = __builtin_amdgcn_exp2f(m - mnew); m = mnew;
            float p[4];
#pragma unroll
            for (int i = 0; i < 4; ++i) p[i] = __builtin_amdgcn_exp2f(s[i] - mnew);
            lsum = lsum * alpha + ((p[0] + p[1]) + (p[2] + p[3]));
            if (__any(alpha != 1.0f)) {
#pragma unroll
                for (int mt = 0; mt < 32; ++mt) O[mt] = O[mt] * alpha;
            }
            u32x2 pw; pw.x = cvt_pk_bf16(p[0], p[1]); pw.y = cvt_pk_bf16(p[2], p[3]); const bf16x4 pb = __builtin_bit_cast(bf16x4, pw);
            const LAS unsigned char* trb = wb + (4 * g + (l15 >> 2)) * 1040 + (lane & 3) * 8;
#pragma unroll
            for (int mt = 0; mt < 32; ++mt) { const bf16x4 a = tr_read16(trb + mt * 32); O[mt] = __builtin_amdgcn_mfma_f32_16x16x16bf16_1k(a, pb, O[mt], 0, 0, 0); }
        }
        float lt = lsum + shx(lsum, 16, lane); lt += shx(lt, 32, lane); const float inv = 1.0f / lt;
        if constexpr (F8_LAT) { unsigned char* op8 = (unsigned char*)OUT + ((size_t)tg * 16 + l15) * 512 + 4 * g; const float inv8 = inv * OLAT_F8SCALE;
#pragma unroll
            for (int mt = 0; mt < 32; ++mt) *(unsigned*)(op8 + 16 * mt) = pk4_fp8(O[mt][0] * inv8, O[mt][1] * inv8, O[mt][2] * inv8, O[mt][3] * inv8); }
        else { bf16_t* op = OUT + ((size_t)tg * 16 + l15) * 512 + 4 * g;
#pragma unroll
        for (int mt = 0; mt < 32; ++mt) { u32x2 w; w.x = cvt_pk_bf16(O[mt][0] * inv, O[mt][1] * inv); w.y = cvt_pk_bf16(O[mt][2] * inv, O[mt][3] * inv); *(u32x2*)(op + 16 * mt) = w; } }
        if (w1) { LDS_WAIT(); int lane2 = F.lane; asm volatile("" : "+v"(lane2));
            for (int k = 0; k < 3; ++k) { const int it = F.gw + NGW * (3 * ((tg - F.gw) / NGW) + k); if (it < MOE_CONV_ITEMS) moe_conv_item(w1, w3, w2, ws, (LAS float*)wb, it, lane2); } }
    }
    LDS_WAIT();
}

__device__ __forceinline__ void ln_router_phase(const Frame& F, const bf16_t* YH, bf16_t* XB, const float* g, const float* bb, const float* wr, int* TOKE, float* TOKG, int* TOKL) {
    LAS float* wl = (LAS float*)F.lds;
    for (int i = F.tid; i < DM * NEXP; i += NTHREADS) { const int d = i >> 3, e = i & 7; wl[e * DM + d] = wr[i]; }
    __syncthreads();
    const int NGW = F.G * NWAVES, lane = F.lane;
    u64 cnt64 = 0ull; int mine = 0;
    int j = 0;
    for (int m = F.gw; m < T; m += NGW, ++j) { f32x4 v[8];
        ln_load16(v, YH + (size_t)m * DM, lane); ln_core(v, g, bb, lane); ln_store8(v, (unsigned char*)XB + (size_t)m * DM, lane);
        float lg[8];
#pragma unroll
        for (int e = 0; e < 8; ++e) { float s = 0.f;
#pragma unroll
            for (int q = 0; q < 8; ++q) { const f32x4 w = *(const LAS f32x4*)(wl + e * DM + ln_col(lane, q)); s += (v[q][0] * w[0] + v[q][1] * w[1]) + (v[q][2] * w[2] + v[q][3] * w[3]); }
            lg[e] = wave_sum(s); }
        int e1 = 0; float v1 = lg[0];
#pragma unroll
        for (int e = 1; e < 8; ++e) if (lg[e] > v1) { v1 = lg[e]; e1 = e; }
        int e2 = -1; float v2 = -INFINITY;
#pragma unroll
        for (int e = 0; e < 8; ++e) if (e != e1 && lg[e] > v2) { v2 = lg[e]; e2 = e; }
        const float g1 = 1.0f / (1.0f + __expf(v2 - v1)), g2 = 1.0f - g1;
        const int r1 = (int)((cnt64 >> (8 * e1)) & 0xffull); cnt64 += 1ull << (8 * e1);
        const int r2 = (int)((cnt64 >> (8 * e2)) & 0xffull); cnt64 += 1ull << (8 * e2);
        if (lane == 0) { TOKE[2 * m] = e1; TOKE[2 * m + 1] = e2; TOKG[2 * m] = g1; TOKG[2 * m + 1] = g2; }
        if (lane == j) mine = e1 | (e2 << 4) | (r1 << 8) | (r2 << 16);
    }
    int basev = 0;
    if (lane < 8) { const unsigned c = (unsigned)((cnt64 >> (8 * lane)) & 0xffull); basev = (int)__hip_atomic_fetch_add(F.ctl + CW_CNT + lane, c, __ATOMIC_RELAXED, __HIP_MEMORY_SCOPE_AGENT); }
    const int e1 = mine & 15, e2 = (mine >> 4) & 15, r1 = (mine >> 8) & 255, r2 = (mine >> 16) & 255;
    const int b1 = __builtin_amdgcn_ds_bpermute(e1 << 2, basev), b2 = __builtin_amdgcn_ds_bpermute(e2 << 2, basev);
    if (lane < j) { const int m = F.gw + NGW * lane; TOKL[2 * m] = b1 + r1; TOKL[2 * m + 1] = b2 + r2; }
    __syncthreads();
}
__device__ __forceinline__ void moe_tiles(const Frame& F) {
    if (F.tid == 0) { int acc = 0;
        for (int e = 0; e < 8; ++e) { const unsigned c = __hip_atomic_load(F.ctl + CW_CNT + e, __ATOMIC_RELAXED, __HIP_MEMORY_SCOPE_AGENT); F.MISC[32 + e] = c; F.MISC[40 + e] = (unsigned)acc; acc += (int)((c + 255u) >> 8); F.MISC[20 + e] = (unsigned)acc; }
        F.MISC[28] = (unsigned)acc; }
    __syncthreads();
}
__device__ __forceinline__ void moe_gather_phase(const Frame& F, const bf16_t* XB, const int* TOKE, const float* TOKG, const int* TOKL, int* TOKS, float* SGATE, bf16_t* XG) {
    const int NGW = F.G * NWAVES, lane = F.lane;
    for (int m = F.gw; m < T; m += NGW) {
        const u32x4* src = (const u32x4*)((const unsigned char*)XB + (size_t)m * DM);
        const u32x4 a0 = src[lane], a1 = src[64 + lane];
#pragma unroll
        for (int k = 0; k < 2; ++k) { const int e = TOKE[2 * m + k], li = TOKL[2 * m + k]; const int slot = (int)F.MISC[40 + e] * 256 + li;
            u32x4* dst = (u32x4*)((unsigned char*)XG + (size_t)slot * DM); dst[lane] = a0; dst[64 + lane] = a1;
            if (lane == 0) { TOKS[2 * m + k] = slot; SGATE[slot] = TOKG[2 * m + k]; } }
    }
    for (int it = F.gw; it < 8 * 256; it += NGW) { const int e = it >> 8, r = it & 255; const int c = (int)F.MISC[32 + e]; const int ntile = (c + 255) >> 8; const int row = c + r;
        if (row < ntile * 256) { const int slot = (int)F.MISC[40 + e] * 256 + row; u32x4* dst = (u32x4*)((unsigned char*)XG + (size_t)slot * DM); const u32x4 z = {0u, 0u, 0u, 0u};
            dst[lane] = z; dst[64 + lane] = z; if (lane == 0) SGATE[slot] = 0.f; } }
}
__device__ __forceinline__ void moe_combine_ln_phase(const Frame& F, const bf16_t* YH, bf16_t* XB, const bf16_t* SOUT, const int* TOKS, const float* g1, const float* bb1, const float* g, const float* bb) {
    const int NGW = F.G * NWAVES, lane = F.lane;
    for (int m = F.gw; m < T; m += NGW) { f32x4 v[8];
        const bf16_t* s0 = SOUT + (size_t)TOKS[2 * m] * DM; const bf16_t* s1 = SOUT + (size_t)TOKS[2 * m + 1] * DM;
        ln_load16(v, YH + (size_t)m * DM, lane);
        ln_core(v, g1, bb1, lane);
#pragma unroll
        for (int j = 0; j < 4; ++j) { f32x4 a0, a1, c0, c1; pg8::unpack8(*(const u32x4*)(s0 + ln_col(lane, 2 * j)), a0, a1); pg8::unpack8(*(const u32x4*)(s1 + ln_col(lane, 2 * j)), c0, c1);
            v[2 * j] = v[2 * j] * ALPHA + (a0 + c0); v[2 * j + 1] = v[2 * j + 1] * ALPHA + (a1 + c1); }
        ln_core(v, g, bb, lane); ln_store16(v, XB + (size_t)m * DM, lane); }
}

#ifndef PHASES
#define PHASES 0xFFFFFFFFu
#endif
#define PH(k) if constexpr ((PHASES >> (k)) & 1u)
#ifndef DBL
#define DBL 0u
#endif
#define DB(k) if constexpr ((DBL >> (k)) & 1u)
__global__ void __launch_bounds__(NTHREADS, 2) mega_fwd(Args args) {
    extern __shared__ __attribute__((aligned(16))) unsigned char lds_raw[];
    Frame F;
    F.lds = (LAS unsigned char*)lds_raw; F.MISC = (volatile LAS unsigned*)(F.lds + MISC_OFF);
    F.tid = threadIdx.x; F.lane = F.tid & 63; F.wave = __builtin_amdgcn_readfirstlane(F.tid >> 6); F.gw = blockIdx.x * NWAVES + F.wave;
    unsigned char* ws = args.ws;
    F.ctl = (unsigned*)(ws + WS_CTL);
    if (F.tid < 64) F.MISC[F.tid] = 0u;
    __syncthreads();
    XcdBarrier bar = xcd_barrier_post(F.ctl + CW_BAR, F.MISC + 8);
#define REFRESH() do { F.lane = fresh_lane(); F.tid = F.wave * 64 + F.lane; } while (0)
#define GRID_BAR() do { xcd_barrier(bar, F.wave); REFRESH(); } while (0)
#define YH ((bf16_t*)args.out)
#define bx ((int)blockIdx.x)
#define WSP(T_, off) ((T_*)(ws + (off)))

    PH(0) {
        { LAS float* scr = (LAS float*)(F.lds + F.wave * 16384);
          constexpr int I_QKV = 32 * 40, I_SQ = 32 * 32, I_W13 = 32 * 88, I_W2 = 88 * 32, I_WP = 4 * 32, I_WIN = 32 * 75, I_WUV = 256;
          constexpr int I_TOTAL = I_QKV + I_SQ + 2 * I_W13 + I_W2 + 2 * I_SQ + 2 * I_WP + (F8_WIN_SPLIT ? 2 : 1) * I_WIN + I_SQ + I_WUV;
          for (int it = F.gw; it < I_TOTAL; it += F.G * NWAVES) {
              int r = it; bool hit = false; const float* W = nullptr; int N = 0, ldo = 0, kofs = 0, mode = 0, rlo = 0, rhi = 1 << 30; unsigned char* WT = nullptr; float f8 = 0.f;
#define PSEG(cnt, Wp, Nn, WTp, ld, md, f8v, lo, hi) if (!hit) { if (r < (cnt)) { W = (Wp); N = (Nn); WT = (unsigned char*)(WTp); ldo = (ld); mode = (md); f8 = (f8v); rlo = (lo); rhi = (hi); hit = true; } else r -= (cnt); }
              PSEG(I_QKV, (const float*)args.in[3], NQKV, ws + WS_WQKV, DM, 1, F8_QKV ? WQKV_F8SCALE : 0.f, 0, 1 << 30)
              PSEG(I_SQ, (const float*)args.in[5], DM, ws + WS_WO0, DM, 0, F8_WO0 ? WO_F8SCALE : 0.f, 0, 1 << 30)
              PSEG(I_W13, (const float*)args.in[6], FFN, ws + WS_W13, DM, 2, F8_FFN1 ? W13_F8SCALE : 0.f, 0, 1 << 30)
              PSEG(I_W13, (const float*)args.in[7], FFN, ws + WS_W13, DM, 3, F8_FFN1 ? W13_F8SCALE : 0.f, 0, 1 << 30)
              PSEG(I_W2, (const float*)args.in[8], DM, ws + WS_W2, FFN, 0, F8_FFN2 ? W2_F8SCALE : 0.f, 0, 1 << 30)
              PSEG(I_SQ, (const float*)args.in[21], DM, ws + WS_WG0, DM, 0, 0.f, 0, 1 << 30)
              PSEG(I_SQ, (const float*)args.in[21] + (size_t)DM * DM, DM, ws + WS_WG1, DM, 0, 0.f, 0, 1 << 30)
              PSEG(I_WP, (const float*)args.in[20], DM, ws + WS_WP0, 256, 0, 0.f, 0, 1 << 30)
              PSEG(I_WP, (const float*)args.in[20] + (size_t)256 * DM, DM, ws + WS_WP1, 256, 0, 0.f, 0, 1 << 30)
              if constexpr (F8_WIN_SPLIT) { PSEG(I_WIN, (const float*)args.in[9], 4752, ws + WS_WIN8, DM, 4, WIN_F8SCALE, 0, WIN_F8_TILES * 256)
                                            PSEG(I_WIN, (const float*)args.in[9], 4752, ws + WS_WIN, DM, 4, 0.f, WIN_F8_TILES * 256, NWIN) }
              else { PSEG(I_WIN, (const float*)args.in[9], 4752, ws + WS_WIN, DM, 4, F8_WIN ? WIN_F8SCALE : 0.f, 0, 1 << 30) }
              PSEG(I_SQ, (const float*)args.in[13], DM, ws + WS_WO1, DM, 0, F8_WO1 ? WO_F8SCALE : 0.f, 0, 1 << 30)
              if (!hit) { const int h = r >> 4; r &= 15;
                  W = (const float*)args.in[12] + (size_t)h * 512 * 128; N = 128; WT = ws + WS_WUV + (size_t)h * 128 * 1024 * (F8_LAT ? 1 : 2); ldo = 1024; kofs = 512 * (h & 1); f8 = F8_LAT ? WUV_F8SCALE : 0.f; }
#undef PSEG
              tr_item(W, N, (bf16_t*)WT, ldo, kofs, mode, scr, r, F.lane, f8, rlo, rhi); } }
        { bf16_t* wuv = WSP(bf16_t, WS_WUV); const u32x4 z = {0u, 0u, 0u, 0u};
          for (int i = bx * NTHREADS + F.tid; i < 2048 * 64; i += F.G * NTHREADS) { const int n = i >> 6, c8 = i & 63; const int h = n >> 7;
              if constexpr (F8_LAT) { if (c8 < 32) *(u32x4*)((unsigned char*)wuv + (size_t)n * 1024 + 512 * ((h & 1) ^ 1) + 16 * c8) = z; }
              else *(u32x4*)(wuv + (size_t)n * 1024 + 512 * ((h & 1) ^ 1) + 8 * c8) = z; } }
        cvt_linear(F, (const float*)args.in[11], WSP(bf16_t, WS_WUK), (size_t)16 * 512 * 128 / 8);
        if constexpr (F8_QKV) cvt_linear8(F, (const float*)args.in[0], WSP(unsigned char, WS_XBA), (size_t)T * DM / 8); else cvt_linear(F, (const float*)args.in[0], WSP(bf16_t, WS_XBA), (size_t)T * DM / 8);
        cvt_linear(F, (const float*)args.in[1], WSP(bf16_t, WS_PB), (size_t)2 * T * 256 / 8);
        rope_tables(F, (const int*)args.in[2], WSP(float, WS_TAB64), WSP(float, WS_TAB32));
    }
    GRID_BAR();
    PH(1) {
        constexpr int KD = F8_QKV ? DM / 2 : DM;
        pg8::Gemm g{WSP(bf16_t, WS_XBA), WSP(bf16_t, WS_WQKV), KD, KD, KD}; pg8::GridOrder<0, T / 256, NQKV / 256> S;
        pg8::EpiQKV E{ws, F8_QKV ? 1.0f / WQKV_F8SCALE : 1.0f}; pg8::gemm_phase<pg8::EpiQKV, pg8::GridOrder<0, T / 256, NQKV / 256>, F8_QKV>(F.lds, g, S, E, F.wave);
    }
    GRID_BAR();
    PH(2) swa_phase<F8_WO0>(F, WSP(bf16_t, WS_Q), WSP(bf16_t, WS_K), WSP(bf16_t, WS_VT), (const float*)args.in[4], WSP(unsigned char, WS_O8));
    GRID_BAR();
    PH(3) {
        constexpr int KD = F8_WO0 ? DM / 2 : DM;
        pg8::Gemm g{F8_WO0 ? WSP(bf16_t, WS_O8) : WSP(bf16_t, WS_Q), WSP(bf16_t, WS_WO0), KD, KD, KD}; pg8::GridOrder<0, T / 256, DM / 256> S;
        pg8::EpiRes<false> E{args.in[0], YH, F8_WO0 ? 1.0f / (O0_F8SCALE * WO_F8SCALE) : 1.0f}; pg8::gemm_phase<pg8::EpiRes<false>, pg8::GridOrder<0, T / 256, DM / 256>, F8_WO0, EPI_ALIGN_RES>(F.lds, g, S, E, F.wave);
    }
    GRID_BAR();
    PH(4) ln_phase<F8_FFN1>(F, YH, WSP(bf16_t, WS_XBB), WSP(unsigned char, WS_XBA), (const float*)args.in[18], (const float*)args.in[19]);
    GRID_BAR();
    PH(5) {
        constexpr int KD = F8_FFN1 ? DM / 2 : DM;
        pg8::Gemm g{F8_FFN1 ? WSP(bf16_t, WS_XBA) : WSP(bf16_t, WS_XBB), WSP(bf16_t, WS_W13), KD, KD, KD}; pg8::GridOrder<0, T / 256, 2 * FFN / 256> S;
        pg8::EpiSwiglu<F8_FFN2> E{WSP(bf16_t, WS_ACT), FFN, F8_FFN1 ? 1.0f / W13_F8SCALE : 1.0f, ACT_F8SCALE}; pg8::gemm_phase<pg8::EpiSwiglu<F8_FFN2>, pg8::GridOrder<0, T / 256, 2 * FFN / 256>, F8_FFN1>(F.lds, g, S, E, F.wave);
    }
    GRID_BAR();
    PH(6) {
        constexpr int KD = F8_FFN2 ? FFN / 2 : FFN;
        pg8::Gemm g{WSP(bf16_t, WS_ACT), WSP(bf16_t, WS_W2), KD, KD, KD}; pg8::GridOrder<0, T / 256, DM / 256> S;
        pg8::EpiRes<true> E{WSP(bf16_t, WS_XBB), YH, F8_FFN2 ? 1.0f / (ACT_F8SCALE * W2_F8SCALE) : 1.0f}; pg8::gemm_phase<pg8::EpiRes<true>, pg8::GridOrder<0, T / 256, DM / 256>, F8_FFN2, EPI_ALIGN_RES>(F.lds, g, S, E, F.wave);
    }
    GRID_BAR();
    PH(7) ln_phase<false>(F, YH, WSP(bf16_t, WS_XBA), nullptr, (const float*)args.in[18] + DM, (const float*)args.in[19] + DM);
    REFRESH();
    PH(7) {
        pg8::Gemm g{WSP(bf16_t, WS_PB), WSP(bf16_t, WS_WP0), 256, 256, 256}; pg8::GridOrder<0, T / 256, DM / 256> S;
        pg8::EpiBf16<false> E{WSP(bf16_t, WS_PP0), DM, 1.0f}; pg8::gemm_phase(F.lds, g, S, E, F.wave);
    }
    GRID_BAR();
    PH(8) {
        pg8::Gemm g{WSP(bf16_t, WS_XBA), WSP(bf16_t, WS_WG0), DM, DM, DM}; pg8::GridOrder<0, T / 256, DM / 256> S;
        pg8::EpiPle E{nullptr, ws, 0}; pg8::gemm_phase<pg8::EpiPle, pg8::GridOrder<0, T / 256, DM / 256>, false, EPI_ALIGN_RES>(F.lds, g, S, E, F.wave);
    }
    GRID_BAR();
    PH(9) {
        if constexpr (F8_WIN_SPLIT) {
            { static_assert((T / 256) * WIN_F8_TILES == 7 * pg8::GRID && (T / 256) * (NWIN / 256 - WIN_F8_TILES) == 5 * pg8::GRID / 2, "uneven deal: 7 rounds of e4m3 units, 2.5 rounds of bf16 units");
              pg8::Gemm g{WSP(bf16_t, WS_XB8), WSP(bf16_t, WS_WIN8), DM / 2, DM / 2, DM / 2}; pg8::GridOrder<4, T / 256, WIN_F8_TILES> S;
              pg8::EpiWin E{ws, 1.0f / WIN_F8SCALE, 0}; pg8::gemm_phase<pg8::EpiWin, pg8::GridOrder<4, T / 256, WIN_F8_TILES>, true>(F.lds, g, S, E, F.wave); }
            REFRESH();
            { pg8::Gemm g{WSP(bf16_t, WS_XBB), WSP(bf16_t, WS_WIN) + (size_t)WIN_F8_TILES * 256 * DM, DM, DM, DM}; pg8::GridOrder<0, T / 256, NWIN / 256 - WIN_F8_TILES> S;
              pg8::EpiWin E{ws, 1.0f, WIN_F8_TILES}; pg8::gemm_phase<pg8::EpiWin, pg8::GridOrder<0, T / 256, NWIN / 256 - WIN_F8_TILES>, false>(F.lds, g, S, E, F.wave); }
        } else {
        constexpr int KD = F8_WIN ? DM / 2 : DM;
        pg8::Gemm g{WSP(bf16_t, WS_XBB), WSP(bf16_t, WS_WIN), KD, KD, KD}; pg8::GridOrder<0, T / 256, NWIN / 256> S;
        pg8::EpiWin E{ws, F8_WIN ? 1.0f / WIN_F8SCALE : 1.0f, 0}; pg8::gemm_phase<pg8::EpiWin, pg8::GridOrder<0, T / 256, NWIN / 256>, F8_WIN>(F.lds, g, S, E, F.wave);
        }
    }
    GRID_BAR();
    PH(10) kvnorm_phase(F, WSP(float, WS_CRAW), (const float*)args.in[10], WSP(bf16_t, WS_KV));
    REFRESH();
    PH(11) {
        pg8::Gemm g{WSP(bf16_t, WS_QN), WSP(bf16_t, WS_WUK), DM, 128, 128}; pg8::GridOrder<1, T / 256, 8192 / 256> S;
        pg8::EpiBf16<F8_LAT> E{WSP(bf16_t, WS_QLAT), 8192, F8_LAT ? QLAT_F8SCALE : 1.0f}; pg8::gemm_phase(F.lds, g, S, E, F.wave);
    }
    REFRESH();
    DB(12) { topk_phase(F, WSP(bf16_t, WS_QI), WSP(bf16_t, WS_KIF), WSP(float, WS_WI), WSP(unsigned short, WS_SEL)); REFRESH(); }
    PH(12) topk_phase(F, WSP(bf16_t, WS_QI), WSP(bf16_t, WS_KIF), WSP(float, WS_WI), WSP(unsigned short, WS_SEL));
    GRID_BAR();
    PH(13) dsa_attn_phase(F, WSP(bf16_t, WS_QLAT), WSP(bf16_t, WS_QLAT), WSP(bf16_t, WS_QR), WSP(bf16_t, WS_KV), WSP(unsigned short, WS_SEL), (const float*)args.in[15], (const float*)args.in[16], (const float*)args.in[17], ws);
    GRID_BAR();
    PH(14) {
        constexpr float dsc = F8_LAT ? 1.0f / (OLAT_F8SCALE * WUV_F8SCALE) : 1.0f;
        pg8::Gemm g{WSP(bf16_t, WS_QLAT), WSP(bf16_t, WS_WUV), F8_LAT ? 4096 : 8192, F8_LAT ? 512 : 1024, F8_LAT ? 512 : 1024}; pg8::GridOrder<F8_LAT ? 3 : 2, T / 256, DM / 256> S;
        pg8::EpiBf16<F8_WO1> E{WSP(bf16_t, WS_O2), DM, (F8_WO1 ? O2_F8SCALE : 1.0f) * dsc}; pg8::gemm_phase<pg8::EpiBf16<F8_WO1>, pg8::GridOrder<F8_LAT ? 3 : 2, T / 256, DM / 256>, F8_LAT>(F.lds, g, S, E, F.wave);
    }
    GRID_BAR();
    PH(15) {
        constexpr int KD = F8_WO1 ? DM / 2 : DM;
        pg8::Gemm g{WSP(bf16_t, WS_O2), WSP(bf16_t, WS_WO1), KD, KD, KD}; pg8::GridOrder<0, T / 256, DM / 256> S;
        pg8::EpiRes<true> E{WSP(bf16_t, WS_XBB), YH, F8_WO1 ? 1.0f / (O2_F8SCALE * WO_F8SCALE) : 1.0f}; pg8::gemm_phase<pg8::EpiRes<true>, pg8::GridOrder<0, T / 256, DM / 256>, F8_WO1, EPI_ALIGN_RES>(F.lds, g, S, E, F.wave);
    }
    GRID_BAR();
    PH(16) ln_router_phase(F, YH, WSP(bf16_t, WS_XBA), (const float*)args.in[18] + 2 * DM, (const float*)args.in[19] + 2 * DM, (const float*)args.in[14], WSP(int, WS_TOKE), WSP(float, WS_TOKG), WSP(int, WS_TOKL));
    REFRESH();
    GRID_BAR();
    PH(18) moe_tiles(F);
    REFRESH();
    PH(18) moe_gather_phase(F, WSP(bf16_t, WS_XBA), WSP(int, WS_TOKE), WSP(float, WS_TOKG), WSP(int, WS_TOKL), WSP(int, WS_TOKS), WSP(float, WS_SGATE), WSP(bf16_t, WS_XG));
    GRID_BAR();
    PH(19) {
        const int NTL = __builtin_amdgcn_readfirstlane((int)F.MISC[28]);
        {
            pg8::MoeOrder<false, 2 * MFFN / 256> S; S.tile0 = 0; S.ntl = NTL;
            pg8::Gemm g{WSP(bf16_t, WS_XG), WSP(bf16_t, WS_MW13), DM / 2, DM / 2, DM / 2};
            pg8::EpiSwiglu<true> E{WSP(bf16_t, WS_ACT2), MFFN, 1.0f / W13_F8SCALE, ACT_F8SCALE}; pg8::gemm_phase<pg8::EpiSwiglu<true>, pg8::MoeOrder<false, 2 * MFFN / 256>, true>(F.lds, g, S, E, F.wave);
        }
        GRID_BAR();
        {
            pg8::MoeOrder<true, DM / 256> S; S.tile0 = 0; S.ntl = NTL;
            pg8::Gemm g{WSP(bf16_t, WS_ACT2), WSP(bf16_t, WS_MW2), MFFN / 2, MFFN / 2, MFFN / 2};
            pg8::EpiMoeDown E{ws}; pg8::gemm_phase<pg8::EpiMoeDown, pg8::MoeOrder<true, DM / 256>, true>(F.lds, g, S, E, F.wave);
        }
        REFRESH();
        {
            pg8::GridOrderSkip<T / 256, DM / 256> S; S.skip = (NTL * (DM / 256)) % pg8::GRID;
            pg8::Gemm g{WSP(bf16_t, WS_PB) + (size_t)T * 256, WSP(bf16_t, WS_WP1), 256, 256, 256};
            pg8::EpiBf16<false> E{WSP(bf16_t, WS_PP1), DM, 1.0f}; pg8::gemm_phase(F.lds, g, S, E, F.wave);
        }
        GRID_BAR();
    }
    PH(20) moe_combine_ln_phase(F, YH, WSP(bf16_t, WS_XBB), WSP(bf16_t, WS_SOUT), WSP(int, WS_TOKS), (const float*)args.in[18] + 2 * DM, (const float*)args.in[19] + 2 * DM, (const float*)args.in[18] + 3 * DM, (const float*)args.in[19] + 3 * DM);
    GRID_BAR();
    PH(21) {
        pg8::Gemm g{WSP(bf16_t, WS_XBB), WSP(bf16_t, WS_WG1), DM, DM, DM}; pg8::GridOrder<0, T / 256, DM / 256> S;
        pg8::EpiPle E{args.out, ws, 1}; pg8::gemm_phase<pg8::EpiPle, pg8::GridOrder<0, T / 256, DM / 256>, false, EPI_ALIGN_RES>(F.lds, g, S, E, F.wave);
    }
}

#undef YH
#undef bx
extern "C" void kernel_launch(void* const* d_in, const int* in_sizes, int n_in, void* d_out, int out_size, void* d_ws, size_t ws_size, hipStream_t stream) {
    static int grid = 0;
    if (grid == 0) {
        if (n_in != 22 || out_size != T * DM || ws_size < WS_END) { fprintf(stderr, "kernel_launch: unexpected problem (n_in %d, out %d, ws %zu < %zu)\n", n_in, out_size, ws_size, (size_t)WS_END); grid = -1; return; }
        int dev = 0, cus = 0;
        if (hipGetDevice(&dev) != hipSuccess || hipDeviceGetAttribute(&cus, hipDeviceAttributeMultiprocessorCount, dev) != hipSuccess) { grid = -1; return; }
        if (hipFuncSetAttribute((const void*)mega_fwd, hipFuncAttributeMaxDynamicSharedMemorySize, LDS_BYTES) != hipSuccess) { fprintf(stderr, "kernel_launch: hipFuncSetAttribute failed\n"); grid = -1; return; }
        int per_cu = 0;
        if (hipOccupancyMaxActiveBlocksPerMultiprocessor(&per_cu, (const void*)mega_fwd, NTHREADS, LDS_BYTES) != hipSuccess || per_cu < 1) { fprintf(stderr, "kernel_launch: occupancy query says %d\n", per_cu); }
        (void)hipGetLastError();
        if (cus != pg8::GRID) { fprintf(stderr, "kernel_launch: built for %d CUs, device has %d\n", pg8::GRID, cus); grid = -1; return; }
        grid = cus;
    }
    if (grid < 0) return;
    (void)hipMemsetAsync((char*)d_ws + WS_CTL, 0, CTL_ZERO_BYTES, stream);
    Args a{};
    for (int i = 0; i < 22; ++i) a.in[i] = d_in[i];
    a.out = (float*)d_out; a.ws = (unsigned char*)d_ws;
    hipLaunchKernelGGL(mega_fwd, dim3(grid), dim3(NTHREADS), LDS_BYTES, stream, a);
}
```

```cpp
#include <hip/hip_runtime.h>
#include <cstdio>
#include <cstdint>

#define LAS __attribute__((address_space(3)))
#define GAS __attribute__((address_space(1)))
typedef unsigned short bf16_t;
typedef short bf16x8 __attribute__((ext_vector_type(8)));
typedef short bf16x4 __attribute__((ext_vector_type(4)));
typedef float f32x2 __attribute__((ext_vector_type(2)));
typedef float f32x4 __attribute__((ext_vector_type(4)));
typedef float f32x16 __attribute__((ext_vector_type(16)));
typedef unsigned u32x2 __attribute__((ext_vector_type(2)));
typedef unsigned u32x4 __attribute__((ext_vector_type(4)));
typedef unsigned long long u64;
typedef int i32x4 __attribute__((ext_vector_type(4)));
typedef int i32x8 __attribute__((ext_vector_type(8)));

constexpr int T = 32768, SEQ = 16384, DM = 2048;
constexpr int FFN = 5632, MFFN = 7168, NEXP = 8;
constexpr int NQKV = 2560, NWIN = 4864;
constexpr float ALPHA = 1.41421356237309515f;
constexpr float LN_EPS = 1e-5f, RMS_EPS = 1e-6f;
constexpr float QSCALE_SWA = 0.18033688011112042f;
constexpr float SCALE2_MLA = 0.10411754627697264f;
constexpr float LOG2E = 1.4426950408889634f;
constexpr int NWAVES = 8, NTHREADS = 512;
constexpr float W13_F8SCALE = 32.0f;
constexpr bool F8_FFN1 = true, F8_FFN2 = true, F8_QKV = true, F8_WO0 = true, F8_WIN = false, F8_WO1 = true;
constexpr bool EPI_ALIGN_RES = true;
constexpr bool SWA_FRAG = true;
constexpr bool F8_LAT = true;
constexpr float QLAT_F8SCALE = 8.0f, OLAT_F8SCALE = 32.0f, WUV_F8SCALE = 16.0f;
constexpr bool F8_WIN_SPLIT = true;
constexpr int WIN_F8_TILES = 14;
constexpr float WQKV_F8SCALE = 32.0f, WIN_F8SCALE = 32.0f, WO_F8SCALE = 64.0f, O0_F8SCALE = 16.0f, O2_F8SCALE = 32.0f;
constexpr float ACT_F8SCALE = 16.0f, W2_F8SCALE = 128.0f;

constexpr size_t MiB = 1u << 20;
constexpr size_t WS_CTL = 0, CTL_ZERO_BYTES = 1 * MiB;
constexpr size_t WS_WQKV = 2 * MiB, WS_WO0 = 12 * MiB, WS_W13 = 20 * MiB, WS_W2 = 64 * MiB, WS_WG0 = 86 * MiB, WS_WG1 = 94 * MiB, WS_WP0 = 102 * MiB, WS_WP1 = 103 * MiB,
                 WS_WIN = 104 * MiB, WS_WUK = 123 * MiB, WS_WUV = 125 * MiB, WS_WO1 = 129 * MiB;
constexpr size_t WS_TAB64 = 137 * MiB, WS_TAB32 = 145 * MiB, WS_PB = 149 * MiB, WS_XBA = 181 * MiB, WS_XBB = 309 * MiB;
constexpr size_t WS_TOKE = 437 * MiB;
constexpr size_t WS_TOKG = WS_TOKE + 256 * 1024;
constexpr size_t WS_TOKL = WS_TOKG + 256 * 1024;
constexpr size_t WS_TOKS = WS_TOKL + 256 * 1024;
constexpr size_t WS_SGATE = WS_TOKS + 256 * 1024;
constexpr size_t WS_WI = 439 * MiB, WS_SEL = 441 * MiB, WS_R = 458 * MiB;
constexpr size_t WS_Q = WS_R, WS_K = WS_R + 128 * MiB, WS_VT = WS_R + 144 * MiB, WS_ACT = WS_R + 160 * MiB, WS_PP0 = WS_R + 512 * MiB, WS_O8 = WS_R + 640 * MiB, WS_XB8 = WS_R + 704 * MiB  , WS_WIN8 = WS_R + 768 * MiB  ;
constexpr size_t WS_QN = WS_R, WS_QR = WS_R + 128 * MiB, WS_CRAW = WS_R + 192 * MiB, WS_KV = WS_R + 256 * MiB, WS_QI = WS_R + 292 * MiB, WS_KIF = WS_R + 356 * MiB,
                 WS_QLAT = WS_R + 360 * MiB, WS_O2 = WS_R + 872 * MiB;
constexpr size_t WS_MW13 = WS_R + 1128 * MiB, WS_MW2 = WS_R + 1352 * MiB, WS_XG = WS_R, WS_SOUT = WS_R + 136 * MiB, WS_ACT2 = WS_R + 404 * MiB  , WS_PP1 = WS_R + 884 * MiB;
constexpr size_t WS_END = WS_R + 1464 * MiB;
constexpr int MAXSLOTS = 67840;
constexpr int CHUNK_TILES = 272;
constexpr int CW_TMO = 0, CW_CNT = 64  , CW_BAR = 4096;

constexpr int LDS_BYTES = 155648;
constexpr int MISC_OFF = 150016;
constexpr int DSA_WBUF = 18688;

typedef __bf16 bf16x2_t __attribute__((ext_vector_type(2)));
__device__ __forceinline__ unsigned cvt_pk_bf16(float lo, float hi) { const f32x2 v = {lo, hi}; return __builtin_bit_cast(unsigned, __builtin_convertvector(v, bf16x2_t)); }
__device__ __forceinline__ float bf2f(unsigned short h) { return __uint_as_float(((unsigned)h) << 16); }
__device__ __forceinline__ float bflo(unsigned w) { return __uint_as_float(w << 16); }
__device__ __forceinline__ float bfhi(unsigned w) { return __uint_as_float(w & 0xffff0000u); }
__device__ __forceinline__ int fresh_lane() { unsigned m = ~0u; asm volatile("" : "+v"(m)); return (int)__builtin_amdgcn_mbcnt_hi(m, __builtin_amdgcn_mbcnt_lo(m, 0u)); }
__device__ __forceinline__ float shx(float v, int o, int lane) { return __int_as_float(__builtin_amdgcn_ds_bpermute((lane ^ o) << 2, __float_as_int(v))); }
__device__ __forceinline__ float wave_sum(float v) {
    const int l = fresh_lane();
#pragma unroll
    for (int o = 1; o < 64; o <<= 1) v += shx(v, o, l);
    return v;
}
__device__ __forceinline__ unsigned pk4_fp8(float a, float b, float c, float d) { unsigned w = 0u; w = (unsigned)__builtin_amdgcn_cvt_pk_fp8_f32(a, b, (int)w, false); w = (unsigned)__builtin_amdgcn_cvt_pk_fp8_f32(c, d, (int)w, true); return w; }
#define LDS_WAIT() asm volatile("s_waitcnt lgkmcnt(0)" ::: "memory")
#define VM_WAIT() asm volatile("s_waitcnt vmcnt(0)" ::: "memory")

namespace pg8 {
constexpr int BM = 256, BK = 64, HALF = 128, HTB = HALF * BK * 2, STAGE_BYTES = 8 * HTB, NXCD = 8, WGM = 8;
__host__ __device__ __forceinline__ int lds_byte(int r, int c) { const int st = (r >> 4) * 2 + (c >> 5), rr = r & 15, cc = c & 31, ob = rr * 64 + cc * 2; return st * 1024 + (ob ^ (((ob >> 9) & 1) << 5)); }
__host__ __device__ __forceinline__ void stage_rc(int b, int& R, int& C) { const int st = b / 1024, sb = b % 1024, swz = sb ^ (((sb >> 9) & 1) << 5); R = (st >> 1) * 16 + swz / 64; C = (st & 1) * 32 + (swz % 64) / 2; }
__host__ __device__ __forceinline__ int perm32(int rho) { const int n = rho >> 4, i = rho & 15; return 8 * (i >> 2) + 4 * n + (i & 3); }

struct Unit { int pm, pn, am, acol, bn; };
struct Gemm { const bf16_t* A; const bf16_t* Bt; int lda, ldb, K; };

constexpr int GRID = 256;
template <int MODE, int NM, int NN> struct GridOrder {
    __device__ __forceinline__ bool next(int i, Unit& u) const {
        constexpr int nwg = NM * NN;
        int L = i * GRID + (int)blockIdx.x;
        if constexpr (MODE == 4) {
            if (i >= 6) { if ((int)blockIdx.x < GRID / 2 || i >= 8) return false; L = 6 * GRID + ((int)blockIdx.x - GRID / 2) * 2 + (i - 6); } }
        if (L >= nwg) return false;
        int wgid = L; { constexpr int q = nwg / NXCD, r = nwg % NXCD; const int xcd = wgid % NXCD, off = wgid / NXCD; wgid = (xcd < r ? xcd * (q + 1) : r * (q + 1) + (xcd - r) * q) + off; }
        constexpr int nig = WGM * NN; const int gid = wgid / nig, fm = gid * WGM, gsz = (NM - fm) < WGM ? (NM - fm) : WGM;
        u.pm = fm + ((wgid % nig) % gsz); u.pn = (wgid % nig) / gsz; u.am = u.pm; u.bn = u.pn;
        u.acol = MODE == 1 ? (u.pn >> 1) * 128 : (MODE == 2 ? u.pn * 1024 : (MODE == 3 ? u.pn * 512 : 0));
        return true;
    }
};
template <int NM, int NN> struct GridOrderSkip {
    int skip;
    __device__ __forceinline__ bool next(int i, Unit& u) const {
        constexpr int nwg = NM * NN; const int nW = GRID - skip, br = (int)blockIdx.x - skip; if (br < 0) return false;
        const int L = i * nW + br; if (L >= nwg) return false;
        int wgid = L; { constexpr int q = nwg / NXCD, r = nwg % NXCD; const int xcd = wgid % NXCD, off = wgid / NXCD; wgid = (xcd < r ? xcd * (q + 1) : r * (q + 1) + (xcd - r) * q) + off; }
        constexpr int nig = WGM * NN; const int gid = wgid / nig, fm = gid * WGM, gsz = (NM - fm) < WGM ? (NM - fm) : WGM;
        u.pm = fm + ((wgid % nig) % gsz); u.pn = (wgid % nig) / gsz; u.am = u.pm; u.bn = u.pn; u.acol = 0;
        return true;
    }
};
template <bool DOWN, int NN> struct MoeOrder {
    int tile0, ntl;
    __device__ __forceinline__ bool next(int i, Unit& u) const {
        int pml, pn;
        if constexpr (!DOWN && NN % 8 == 0) {
            constexpr int NJ = NN / 8; const int x = (int)blockIdx.x & 7, q = i * (GRID / 8) + ((int)blockIdx.x >> 3); if (q >= ntl * NJ) return false;
            const int nfull = ntl >> 3; int m, j;
            if (q < nfull * 8 * NJ) { const int b = q / (8 * NJ), w = q - b * (8 * NJ); m = b * 8 + (w & 7); j = w >> 3; }
            else { const int g = ntl - nfull * 8, w = q - nfull * 8 * NJ; j = w / g; m = nfull * 8 + (w - j * g); }
            pml = m; pn = 8 * j + x;
        } else {
        const int L = i * GRID + (int)blockIdx.x; if (L >= ntl * NN) return false;
        constexpr int nig = WGM * NN; const int wgid = L, gid = wgid / nig, fm = gid * WGM, gsz = (ntl - fm) < WGM ? (ntl - fm) : WGM;
        pml = fm + ((wgid % nig) % gsz); pn = (wgid % nig) / gsz; }
        const int pmg = tile0 + pml;
        const u32x4 t0 = *(const LAS u32x4*)(MISC_OFF + 20 * 4), t1 = *(const LAS u32x4*)(MISC_OFF + 24 * 4);
        int e = (pmg >= (int)t0.x) + (pmg >= (int)t0.y) + (pmg >= (int)t0.z) + (pmg >= (int)t0.w) + (pmg >= (int)t1.x) + (pmg >= (int)t1.y) + (pmg >= (int)t1.z);
        e = __builtin_amdgcn_readfirstlane(e);
        u.pn = pn; u.bn = e * NN + pn; u.acol = 0;
        if (DOWN) { u.pm = pmg; u.am = pml; } else { u.pm = pml; u.am = pmg; }
        return true;
    }
};

__device__ __forceinline__ void stage16_s(const char* gbase, unsigned voff, unsigned lds_dst) { unsigned keep;
    asm volatile("s_mov_b32 %0, m0\n\ts_mov_b32 m0, %3\n\ts_nop 0\n\tglobal_load_lds_dwordx4 %1, %2\n\ts_mov_b32 m0, %0" : "=&s"(keep) : "v"(voff), "s"(gbase), "s"(lds_dst) : "memory"); }
template <class Epi, class Sched, bool FP8 = false, bool ALIGN = true>
__device__ __forceinline__ void gemm_phase(LAS unsigned char* lds, const Gemm g, const Sched& S, const Epi& E, int wave_) {
    int tid_ = wave_ * 64 + fresh_lane(); asm volatile("" : "+v"(tid_));
    const int tid = tid_, wid = __builtin_amdgcn_readfirstlane(tid >> 6), lane = tid & 63, wr = wid >> 2, wc = wid & 3, fr = lane & 15, fq = lane >> 4;
    int K_ = g.K; asm volatile("" : "+s"(K_));
    const int K = K_, nt = K / BK;
    unsigned voffA[2], voffB[2];
#pragma unroll
    for (int i = 0; i < 2; ++i) { int R, C; stage_rc(tid * 16 + i * 8192, R, C); const int Rb = (R & ~31) + perm32(R & 31);
        voffA[i] = (unsigned)(R * g.lda + C) * 2u; voffB[i] = (unsigned)(Rb * g.ldb + C) * 2u; }
    const size_t kstep = (size_t)(BK * 2);
    const size_t hstepA = (size_t)HALF * g.lda * 2, hstepB = (size_t)HALF * g.ldb * 2;
    const unsigned ldsw = (unsigned)wid * 1024u;
    const int aoff = lds_byte(wr * 64 + fr, fq * 8), boff = lds_byte(wc * 32 + fr, fq * 8);
#define PG8_SA(b, h) (((b) * 2 + (h)) * HTB)
#define PG8_SB(b, h) ((4 + (b) * 2 + (h)) * HTB)
#define PG8_STAGE(bufoff, gbase, voff) do { _Pragma("unroll") for (int _i = 0; _i < 2; ++_i) { \
        if constexpr (FP8) stage16_s((const char*)(gbase), (voff)[_i], (unsigned)(size_t)(lds + (bufoff) + ldsw + _i * 8192)); \
        else __builtin_amdgcn_global_load_lds((const unsigned*)((const char*)(gbase) + (voff)[_i]), (LAS unsigned*)(lds + (bufoff) + ldsw + _i * 8192), 16, 0, 0); } } while (0)
#define PG8_LDA(dst, b, h) do { _Pragma("unroll") for (int m = 0; m < 4; ++m) _Pragma("unroll") for (int k = 0; k < 2; ++k) dst[m][k] = *(const LAS bf16x8*)(lds + PG8_SA(b, h) + aoff + m * 2048 + k * 1024); } while (0)
#define PG8_LDB(dst, b, h) do { _Pragma("unroll") for (int n = 0; n < 2; ++n) _Pragma("unroll") for (int k = 0; k < 2; ++k) dst[n][k] = *(const LAS bf16x8*)(lds + PG8_SB(b, h) + boff + n * 2048 + k * 1024); } while (0)
#define PG8_MMA(ai, bj, At, Bt) do { __builtin_amdgcn_s_setprio(1); _Pragma("unroll") for (int m = 0; m < 4; ++m) _Pragma("unroll") for (int n = 0; n < 2; ++n) _Pragma("unroll") for (int k = 0; k < 2; ++k) \
        acc[ai][bj][m][n] = __builtin_amdgcn_mfma_f32_16x16x32_bf16(Bt[n][k], At[m][k], acc[ai][bj][m][n], 0, 0, 0); __builtin_amdgcn_s_setprio(0); } while (0)
#define PG8_LDA8(dst, b, h) do { _Pragma("unroll") for (int m = 0; m < 4; ++m) { const i32x4 lo_ = *(const LAS i32x4*)(lds + PG8_SA(b, h) + aoff + m * 2048), hi_ = *(const LAS i32x4*)(lds + PG8_SA(b, h) + aoff + m * 2048 + 1024); \
        dst[m] = __builtin_shufflevector(lo_, hi_, 0, 1, 2, 3, 4, 5, 6, 7); } } while (0)
#define PG8_LDB8(dst, b, h) do { _Pragma("unroll") for (int n = 0; n < 2; ++n) { const i32x4 lo_ = *(const LAS i32x4*)(lds + PG8_SB(b, h) + boff + n * 2048), hi_ = *(const LAS i32x4*)(lds + PG8_SB(b, h) + boff + n * 2048 + 1024); \
        dst[n] = __builtin_shufflevector(lo_, hi_, 0, 1, 2, 3, 4, 5, 6, 7); } } while (0)
#define PG8_MMA8(ai, bj, At, Bt) do { __builtin_amdgcn_s_setprio(1); _Pragma("unroll") for (int m = 0; m < 4; ++m) _Pragma("unroll") for (int n = 0; n < 2; ++n) \
        acc[ai][bj][m][n] = __builtin_amdgcn_mfma_scale_f32_16x16x128_f8f6f4(Bt[n], At[m], acc[ai][bj][m][n], 0, 0, 0, 0, 0, 0); __builtin_amdgcn_s_setprio(0); } while (0)
#define PG8_WAIT_V(n) asm volatile("s_waitcnt vmcnt(" #n ")" ::: "memory")
#define PG8_WAIT_L(n) asm volatile("s_waitcnt lgkmcnt(" #n ")" ::: "memory")
#define PG8_BAR __builtin_amdgcn_s_barrier()
#define PG8_SCHED __builtin_amdgcn_sched_barrier(0)
#define PG8_ABASE(u) ((const char*)g.A + ((size_t)(u).am * BM * g.lda + (size_t)(u).acol) * 2)
#define PG8_BBASE(u) ((const char*)g.Bt + (size_t)(u).bn * BM * g.ldb * 2)
    Unit cur, nxt; int ui = 0;
    if (!S.next(0, cur)) return;
    f32x4 acc[2][2][4][2];
#pragma unroll
    for (int a = 0; a < 2; ++a)
#pragma unroll
        for (int b = 0; b < 2; ++b)
#pragma unroll
            for (int m = 0; m < 4; ++m)
#pragma unroll
                for (int n = 0; n < 2; ++n) acc[a][b][m][n] = (f32x4){0.f, 0.f, 0.f, 0.f};
    bf16x8 At[4][2], B0[2][2], B1[2][2]; i32x8 At8[4], B08[2], B18[2];
    const char* cA = PG8_ABASE(cur); const char* cB = PG8_BBASE(cur);
    {
        PG8_STAGE(PG8_SB(0, 0), cB, voffB); PG8_STAGE(PG8_SB(0, 1), cB + hstepB, voffB); PG8_STAGE(PG8_SA(0, 0), cA, voffA); PG8_STAGE(PG8_SA(0, 1), cA + hstepA, voffA);
        if (wr == 1) PG8_BAR;
        PG8_WAIT_V(2); PG8_BAR;
        PG8_STAGE(PG8_SB(1, 0), cB + kstep, voffB); PG8_STAGE(PG8_SA(1, 0), cA + kstep, voffA); PG8_STAGE(PG8_SB(1, 1), cB + hstepB + kstep, voffB);
        PG8_WAIT_V(6); PG8_BAR;
    }
    for (;;) {
        const bool has_next = S.next(ui + 1, nxt);
        const char* nA = has_next ? PG8_ABASE(nxt) : cA; const char* nB = has_next ? PG8_BBASE(nxt) : cB;
        for (int t = 0; t < nt; t += 2) {
            const bool last = (t == nt - 2);
            const char* a1 = cA + (size_t)(t + 1) * kstep;
            const char* a2 = last ? nA : cA + (size_t)(t + 2) * kstep; const char* b2 = last ? nB : cB + (size_t)(t + 2) * kstep;
            const char* a3 = a2 + kstep; const char* b3 = b2 + kstep;
            if constexpr (FP8) {
            PG8_LDB8(B08, 0, 0); PG8_LDB8(B18, 0, 1); PG8_SCHED; PG8_LDA8(At8, 0, 0); PG8_STAGE(PG8_SA(1, 1), a1 + hstepA, voffA);
            PG8_WAIT_V(8); PG8_WAIT_L(0); PG8_BAR; PG8_MMA8(0, 0, At8, B08); PG8_MMA8(0, 1, At8, B18); PG8_BAR; PG8_SCHED;
            PG8_LDA8(At8, 0, 1); PG8_STAGE(PG8_SB(0, 0), b2, voffB); PG8_STAGE(PG8_SB(0, 1), b2 + hstepB, voffB); PG8_STAGE(PG8_SA(0, 0), a2, voffA);
            PG8_WAIT_V(8); PG8_WAIT_L(0); PG8_BAR; PG8_MMA8(1, 0, At8, B08); PG8_MMA8(1, 1, At8, B18); PG8_BAR; PG8_SCHED;
            PG8_LDB8(B08, 1, 0); PG8_LDB8(B18, 1, 1); PG8_SCHED; PG8_LDA8(At8, 1, 0); PG8_STAGE(PG8_SA(0, 1), a2 + hstepA, voffA);
            PG8_WAIT_V(8); PG8_WAIT_L(0); PG8_BAR; PG8_MMA8(0, 0, At8, B08); PG8_MMA8(0, 1, At8, B18); PG8_BAR; PG8_SCHED;
            PG8_LDA8(At8, 1, 1); PG8_STAGE(PG8_SB(1, 0), b3, voffB); PG8_STAGE(PG8_SB(1, 1), b3 + hstepB, voffB); PG8_STAGE(PG8_SA(1, 0), a3, voffA);
            PG8_WAIT_V(8); PG8_WAIT_L(0); PG8_BAR; PG8_MMA8(1, 0, At8, B08); PG8_MMA8(1, 1, At8, B18); PG8_BAR; PG8_SCHED;
            } else {
            PG8_LDB(B0, 0, 0); PG8_LDB(B1, 0, 1); PG8_SCHED; PG8_LDA(At, 0, 0); PG8_STAGE(PG8_SA(1, 1), a1 + hstepA, voffA);
            PG8_WAIT_V(8); PG8_WAIT_L(0); PG8_BAR; PG8_MMA(0, 0, At, B0); PG8_MMA(0, 1, At, B1); PG8_BAR; PG8_SCHED;
            PG8_LDA(At, 0, 1); PG8_STAGE(PG8_SB(0, 0), b2, voffB); PG8_STAGE(PG8_SB(0, 1), b2 + hstepB, voffB); PG8_STAGE(PG8_SA(0, 0), a2, voffA);
            PG8_WAIT_V(8); PG8_WAIT_L(0); PG8_BAR; PG8_MMA(1, 0, At, B0); PG8_MMA(1, 1, At, B1); PG8_BAR; PG8_SCHED;
            PG8_LDB(B0, 1, 0); PG8_LDB(B1, 1, 1); PG8_SCHED; PG8_LDA(At, 1, 0); PG8_STAGE(PG8_SA(0, 1), a2 + hstepA, voffA);
            PG8_WAIT_V(8); PG8_WAIT_L(0); PG8_BAR; PG8_MMA(0, 0, At, B0); PG8_MMA(0, 1, At, B1); PG8_BAR; PG8_SCHED;
            PG8_LDA(At, 1, 1); PG8_STAGE(PG8_SB(1, 0), b3, voffB); PG8_STAGE(PG8_SB(1, 1), b3 + hstepB, voffB); PG8_STAGE(PG8_SA(1, 0), a3, voffA);
            PG8_WAIT_V(8); PG8_WAIT_L(0); PG8_BAR; PG8_MMA(1, 0, At, B0); PG8_MMA(1, 1, At, B1); PG8_BAR; PG8_SCHED;
            }
        }
        if constexpr (ALIGN) { if (wr == 0) PG8_BAR; }
        { int fr_ = fr, fq_ = fq; asm volatile("" : "+v"(fr_), "+v"(fq_));
          E(acc, cur, wr, wc, fr_, fq_); }
        if (!has_next) break;
#pragma unroll
        for (int a = 0; a < 2; ++a)
#pragma unroll
            for (int b = 0; b < 2; ++b)
#pragma unroll
                for (int m = 0; m < 4; ++m)
#pragma unroll
                    for (int n = 0; n < 2; ++n) acc[a][b][m][n] = (f32x4){0.f, 0.f, 0.f, 0.f};
        cur = nxt; cA = nA; cB = nB; ++ui;
        if constexpr (ALIGN) { if (wr == 1) PG8_BAR; }
    }
    PG8_WAIT_V(0);
    if constexpr (!ALIGN) { if (wr == 0) PG8_BAR; }
    PG8_BAR;
#undef PG8_SA
#undef PG8_SB
#undef PG8_STAGE
#undef PG8_LDA
#undef PG8_LDB
#undef PG8_MMA
#undef PG8_LDA8
#undef PG8_LDB8
#undef PG8_MMA8
#undef PG8_WAIT_V
#undef PG8_WAIT_L
#undef PG8_BAR
#undef PG8_SCHED
#undef PG8_ABASE
#undef PG8_BBASE
}

#define EPI_ROW(ai, m) (u.pm * BM + (ai) * HALF + wr * 64 + (m) * 16 + fr)
#define EPI_COL(bj) (u.pn * BM + (bj) * HALF + wc * 32 + 8 * fq)
typedef f32x4 AccT[2][2][4][2];

__device__ __forceinline__ void rope4(f32x4& v0, f32x4& v1, const f32x4 cs0, const f32x4 cs1) {
    f32x4 o0, o1;
    o0[0] = v0[0] * cs0[0] - v0[1] * cs0[1]; o0[1] = v0[1] * cs0[0] + v0[0] * cs0[1];
    o0[2] = v0[2] * cs0[2] - v0[3] * cs0[3]; o0[3] = v0[3] * cs0[2] + v0[2] * cs0[3];
    o1[0] = v1[0] * cs1[0] - v1[1] * cs1[1]; o1[1] = v1[1] * cs1[0] + v1[0] * cs1[1];
    o1[2] = v1[2] * cs1[2] - v1[3] * cs1[3]; o1[3] = v1[3] * cs1[2] + v1[2] * cs1[3];
    v0 = o0; v1 = o1;
}
__device__ __forceinline__ u32x4 pack8(const f32x4 v0, const f32x4 v1) { u32x4 w; w.x = cvt_pk_bf16(v0[0], v0[1]); w.y = cvt_pk_bf16(v0[2], v0[3]); w.z = cvt_pk_bf16(v1[0], v1[1]); w.w = cvt_pk_bf16(v1[2], v1[3]); return w; }

__device__ __forceinline__ void unpack8(const u32x4 w, f32x4& a, f32x4& b) { a[0] = bflo(w.x); a[1] = bfhi(w.x); a[2] = bflo(w.y); a[3] = bfhi(w.y); b[0] = bflo(w.z); b[1] = bfhi(w.z); b[2] = bflo(w.w); b[3] = bfhi(w.w); }
__device__ __forceinline__ u32x2 pack8_fp8(const f32x4 v0, const f32x4 v1, float s) { u32x2 w; w.x = pk4_fp8(v0[0] * s, v0[1] * s, v0[2] * s, v0[3] * s); w.y = pk4_fp8(v1[0] * s, v1[1] * s, v1[2] * s, v1[3] * s); return w; }
template <bool OUT8> struct EpiBf16 {
    bf16_t* O; int ldc; float osc;
    __device__ __forceinline__ void operator()(const AccT& acc, const Unit& u, int wr, int wc, int fr, int fq) const {
#pragma unroll
        for (int ai = 0; ai < 2; ++ai)
#pragma unroll
            for (int m = 0; m < 4; ++m) {
#pragma unroll
                for (int bj = 0; bj < 2; ++bj) {
                    if constexpr (OUT8) *(u32x2*)((unsigned char*)O + (size_t)EPI_ROW(ai, m) * ldc + EPI_COL(bj)) = pack8_fp8(acc[ai][bj][m][0], acc[ai][bj][m][1], osc);
                    else *(u32x4*)(O + (size_t)EPI_ROW(ai, m) * ldc + EPI_COL(bj)) = pack8(acc[ai][bj][m][0] * osc, acc[ai][bj][m][1] * osc); } }
    }
};
struct EpiQKV {
    unsigned char* ws; float asc;
    __device__ __forceinline__ void operator()(const AccT& acc, const Unit& u, int wr, int wc, int fr, int fq) const {
        bf16_t* Q = (bf16_t*)(ws + WS_Q); bf16_t* Kb = (bf16_t*)(ws + WS_K); bf16_t* VT = (bf16_t*)(ws + WS_VT); const float* tab64 = (const float*)(ws + WS_TAB64);
        if (u.pn < 9) {
            bf16_t* base = u.pn < 8 ? Q : Kb; const int ldc = u.pn < 8 ? 2048 : 256; const int colt = u.pn < 8 ? u.pn * BM : 0; const float sc = (u.pn < 8 ? QSCALE_SWA : 1.0f) * asc;
#pragma unroll
            for (int ai = 0; ai < 2; ++ai)
#pragma unroll
                for (int m = 0; m < 4; ++m) { const int row = EPI_ROW(ai, m);
#pragma unroll
                    for (int bj = 0; bj < 2; ++bj) { const int cl = bj * HALF + wc * 32 + 8 * fq; const int i0 = (cl & 63) >> 1;
                        const f32x4 cs0 = *(const f32x4*)(tab64 + ((size_t)row * 32 + i0) * 2), cs1 = *(const f32x4*)(tab64 + ((size_t)row * 32 + i0) * 2 + 4);
                        f32x4 v0 = acc[ai][bj][m][0], v1 = acc[ai][bj][m][1]; rope4(v0, v1, cs0, cs1); v0 = v0 * sc; v1 = v1 * sc;
                        if constexpr (SWA_FRAG) {
                            const int b = row >> 14, s = row & (SEQ - 1), hh = (colt + cl) >> 6, c64 = cl & 63, kk = c64 >> 4, hf2 = (c64 >> 3) & 1, nh = u.pn < 8 ? 32 : 4;
                            *(u32x4*)(base + ((((size_t)(b * nh + hh) * 512 + (s >> 5)) * 4 + kk) * 64 + hf2 * 32 + (s & 31)) * 8) = pack8(v0, v1); }
                        else *(u32x4*)(base + (size_t)row * ldc + colt + cl) = pack8(v0, v1); } }
        } else {
#pragma unroll
            for (int ai = 0; ai < 2; ++ai)
#pragma unroll
                for (int m = 0; m < 4; ++m) { const int row = EPI_ROW(ai, m), b = row >> 14, s = row & (SEQ - 1);
#pragma unroll
                    for (int bj = 0; bj < 2; ++bj) { const int cl = bj * HALF + wc * 32 + 8 * fq, kvh = cl >> 6, d0 = cl & 63;
                        const u32x4 w = pack8(acc[ai][bj][m][0] * asc, acc[ai][bj][m][1] * asc);
                        if constexpr (SWA_FRAG) {
                            const int j = s & 31, c = j >> 4, jj = j & 15, hfv = (jj & 7) >> 2, e = (jj & 3) + ((jj >> 3) << 2), mt = d0 >> 5;
                            bf16_t* pf = VT + (((((size_t)(b * 4 + kvh) * 512 + (s >> 5)) * 2 + c) * 2 + mt) * 64 + hfv * 32 + (d0 & 31)) * 8 + e;
                            pf[0] = (bf16_t)(w.x & 0xffff); pf[8] = (bf16_t)(w.x >> 16); pf[16] = (bf16_t)(w.y & 0xffff); pf[24] = (bf16_t)(w.y >> 16);
                            pf[32] = (bf16_t)(w.z & 0xffff); pf[40] = (bf16_t)(w.z >> 16); pf[48] = (bf16_t)(w.w & 0xffff); pf[56] = (bf16_t)(w.w >> 16); }
                        else {
                        bf16_t* p = VT + ((size_t)(b * 4 + kvh) * 64 + d0) * SEQ + s;
                        p[0 * SEQ] = (bf16_t)(w.x & 0xffff); p[1 * SEQ] = (bf16_t)(w.x >> 16); p[2 * SEQ] = (bf16_t)(w.y & 0xffff); p[3 * SEQ] = (bf16_t)(w.y >> 16);
                        p[4 * SEQ] = (bf16_t)(w.z & 0xffff); p[5 * SEQ] = (bf16_t)(w.z >> 16); p[6 * SEQ] = (bf16_t)(w.w & 0xffff); p[7 * SEQ] = (bf16_t)(w.w >> 16); } } }
        }
    }
};
template <int RES16> struct EpiRes {
    const void* res; bf16_t* out; float sc; const float* stats; const float* lg; const float* lb;
    __device__ __forceinline__ void operator()(const AccT& acc, const Unit& u, int wr, int wc, int fr, int fq) const {
#pragma unroll
        for (int ai = 0; ai < 2; ++ai)
#pragma unroll
            for (int m = 0; m < 4; ++m) { const size_t ro = (size_t)EPI_ROW(ai, m) * DM;
#pragma unroll
                for (int bj = 0; bj < 2; ++bj) { const size_t o = ro + EPI_COL(bj); f32x4 r0, r1;
                    if constexpr (RES16 == 2) { unpack8(*(const u32x4*)((const bf16_t*)res + o), r0, r1); const f32x2 st = *(const f32x2*)(stats + 2 * (size_t)EPI_ROW(ai, m)); const int c = EPI_COL(bj);
                        r0 = (r0 - st[0]) * st[1] * *(const f32x4*)(lg + c) + *(const f32x4*)(lb + c); r1 = (r1 - st[0]) * st[1] * *(const f32x4*)(lg + c + 4) + *(const f32x4*)(lb + c + 4); }
                    else if constexpr (RES16 == 1) unpack8(*(const u32x4*)((const bf16_t*)res + o), r0, r1);
                    else { r0 = *(const f32x4*)((const float*)res + o); r1 = *(const f32x4*)((const float*)res + o + 4); }
                    *(u32x4*)(out + o) = pack8(r0 * ALPHA + acc[ai][bj][m][0] * sc, r1 * ALPHA + acc[ai][bj][m][1] * sc); }
                asm volatile("" ::: "memory"); }
    }
};
__device__ __forceinline__ float silu_mul(float g, float uu) { return g * __builtin_amdgcn_rcpf(1.0f + __builtin_amdgcn_exp2f(-g * LOG2E)) * uu; }
template <bool OUT8> struct EpiSwiglu {
    bf16_t* O; int ldc; float sc; float osc;
    __device__ __forceinline__ void operator()(const AccT& acc, const Unit& u, int wr, int wc, int fr, int fq) const {
#pragma unroll
        for (int ai = 0; ai < 2; ++ai)
#pragma unroll
            for (int m = 0; m < 4; ++m) { f32x4 a0, a1;
#pragma unroll
                for (int j = 0; j < 4; ++j) { a0[j] = silu_mul(acc[ai][0][m][0][j] * sc, acc[ai][1][m][0][j] * sc); a1[j] = silu_mul(acc[ai][0][m][1][j] * sc, acc[ai][1][m][1][j] * sc); }
                if constexpr (OUT8) { u32x2 w8; w8.x = pk4_fp8(a0[0] * osc, a0[1] * osc, a0[2] * osc, a0[3] * osc); w8.y = pk4_fp8(a1[0] * osc, a1[1] * osc, a1[2] * osc, a1[3] * osc);
                    *(u32x2*)((unsigned char*)O + (size_t)EPI_ROW(ai, m) * ldc + u.pn * HALF + wc * 32 + 8 * fq) = w8; }
                else *(u32x4*)(O + (size_t)EPI_ROW(ai, m) * ldc + u.pn * HALF + wc * 32 + 8 * fq) = pack8(a0, a1); }
    }
};
struct EpiPle {
    float* outf; unsigned char* ws; int layer;
    __device__ __forceinline__ void operator()(const AccT& acc, const Unit& u, int wr, int wc, int fr, int fq) const {
        const bf16_t* pp = (const bf16_t*)(ws + (layer == 0 ? WS_PP0 : WS_PP1));
        const bf16_t* xres = (const bf16_t*)(ws + (layer == 0 ? WS_XBA : WS_XBB));
#pragma unroll
        for (int ai = 0; ai < 2; ++ai)
#pragma unroll
            for (int m = 0; m < 4; ++m) { const size_t ro = (size_t)EPI_ROW(ai, m) * DM;
#pragma unroll
                for (int bj = 0; bj < 2; ++bj) { const size_t o = ro + EPI_COL(bj);
                    f32x4 r0, r1, p0, p1; unpack8(*(const u32x4*)(xres + o), r0, r1); unpack8(*(const u32x4*)(pp + o), p0, p1);
                    f32x4 s0, s1;
#pragma unroll
                    for (int j = 0; j < 4; ++j) { s0[j] = __builtin_amdgcn_rcpf(1.0f + __builtin_amdgcn_exp2f(-acc[ai][bj][m][0][j] * LOG2E)); s1[j] = __builtin_amdgcn_rcpf(1.0f + __builtin_amdgcn_exp2f(-acc[ai][bj][m][1][j] * LOG2E)); }
                    const f32x4 o0 = r0 + s0 * p0, o1 = r1 + s1 * p1;
                    if (layer == 0) { *(u32x4*)((bf16_t*)(ws + WS_XBB) + o) = pack8(o0, o1);
                                      if constexpr (F8_WIN_SPLIT || F8_WIN) *(u32x2*)(ws + WS_XB8 + o) = pack8_fp8(o0, o1, 1.0f); }
                    else { *(f32x4*)(outf + o) = o0; *(f32x4*)(outf + o + 4) = o1; } }
                asm volatile("" ::: "memory"); }
    }
};
struct EpiWin {
    unsigned char* ws; float asc; int pn0;
    __device__ __forceinline__ void operator()(const AccT& acc, const Unit& u, int wr, int wc, int fr, int fq) const {
        bf16_t* QN = (bf16_t*)(ws + WS_QN); bf16_t* QR = (bf16_t*)(ws + WS_QR); float* CRAW = (float*)(ws + WS_CRAW); bf16_t* KV = (bf16_t*)(ws + WS_KV); bf16_t* QI = (bf16_t*)(ws + WS_QI);
        bf16_t* KIF = (bf16_t*)(ws + WS_KIF); float* WI = (float*)(ws + WS_WI); const float* tab64 = (const float*)(ws + WS_TAB64); const float* tab32 = (const float*)(ws + WS_TAB32);
        const int pn = u.pn + pn0;
#pragma unroll
        for (int ai = 0; ai < 2; ++ai)
#pragma unroll
            for (int m = 0; m < 4; ++m) { const int row = EPI_ROW(ai, m);
#pragma unroll
                for (int bj = 0; bj < 2; ++bj) { const int cl = bj * HALF + wc * 32 + 8 * fq; f32x4 v0 = acc[ai][bj][m][0] * asc, v1 = acc[ai][bj][m][1] * asc;
                    if (pn < 8) { *(u32x4*)(QN + (size_t)row * 2048 + pn * BM + cl) = pack8(v0, v1); }
                    else if (pn < 12) { const int i0 = (cl & 63) >> 1;
                        const f32x4 cs0 = *(const f32x4*)(tab64 + ((size_t)row * 32 + i0) * 2), cs1 = *(const f32x4*)(tab64 + ((size_t)row * 32 + i0) * 2 + 4);
                        rope4(v0, v1, cs0, cs1); if constexpr (F8_LAT) { v0 = v0 * QLAT_F8SCALE; v1 = v1 * QLAT_F8SCALE; }
                        *(u32x4*)(QR + (size_t)row * 1024 + (pn - 8) * BM + cl) = pack8(v0, v1); }
                    else if (pn < 14) { float* p = CRAW + (size_t)row * 512 + (pn - 12) * BM + cl; *(f32x4*)p = v0; *(f32x4*)(p + 4) = v1; }
                    else if (pn == 14) {
                        if (cl < 64) { const int i0 = cl >> 1;
                            const f32x4 cs0 = *(const f32x4*)(tab64 + ((size_t)row * 32 + i0) * 2), cs1 = *(const f32x4*)(tab64 + ((size_t)row * 32 + i0) * 2 + 4);
                            rope4(v0, v1, cs0, cs1); *(u32x4*)(KV + (size_t)row * 576 + 512 + cl) = pack8(v0, v1); }
                        else if (cl < 128) { const int d8 = cl - 64;
                            if (d8 < 32) { const int i0 = d8 >> 1;
                                const f32x4 cs0 = *(const f32x4*)(tab32 + ((size_t)row * 16 + i0) * 2), cs1 = *(const f32x4*)(tab32 + ((size_t)row * 16 + i0) * 2 + 4);
                                rope4(v0, v1, cs0, cs1); }
                            const int b = row >> 14, s = row & (SEQ - 1), blk = s >> 5, j = s & 31, kk = d8 >> 4, hf = (d8 >> 3) & 1;
                            *(u32x4*)(KIF + ((size_t)((b * 512 + blk) * 4 + kk) * 64 + hf * 32 + j) * 8) = pack8(v0, v1); }
                        else if (cl < 144) { float* p = WI + (size_t)row * 16 + (cl - 128); *(f32x4*)p = v0; *(f32x4*)(p + 4) = v1; }
                    } else { const int cq = (pn - 15) * BM + cl, d8 = cq & 63;
                        if (d8 < 32) { const int i0 = d8 >> 1;
                            const f32x4 cs0 = *(const f32x4*)(tab32 + ((size_t)row * 16 + i0) * 2), cs1 = *(const f32x4*)(tab32 + ((size_t)row * 16 + i0) * 2 + 4);
                            rope4(v0, v1, cs0, cs1); }
                        *(u32x4*)(QI + (size_t)row * 1024 + cq) = pack8(v0, v1); }
                } }
    }
};
struct EpiMoeDown {
    unsigned char* ws;
    __device__ __forceinline__ void operator()(const AccT& acc, const Unit& u, int wr, int wc, int fr, int fq) const {
        bf16_t* O = (bf16_t*)(ws + WS_SOUT); const float* gate = (const float*)(ws + WS_SGATE);
#pragma unroll
        for (int ai = 0; ai < 2; ++ai)
#pragma unroll
            for (int m = 0; m < 4; ++m) { const int row = EPI_ROW(ai, m); const float gt = gate[row] * (1.0f / (ACT_F8SCALE * W2_F8SCALE)); bf16_t* rowp = O + (size_t)row * DM;
#pragma unroll
                for (int bj = 0; bj < 2; ++bj) *(u32x4*)(rowp + EPI_COL(bj)) = pack8(acc[ai][bj][m][0] * gt, acc[ai][bj][m][1] * gt); }
    }
};
}

#define XB_TMO      128
#define XB_XCNT(j)  (256  + 64 * (j))
#define XB_XSUB(j)  (1280 + 64 * (j))
#define XB_XGEN(j)  (2304 + 64 * (j))
#define XB_TOP      3328
#define XB_TOPGEN   3392
#define XCD_BAR_WORDS 3456
#define XB_SPIN_CAP (1u << 22)

__device__ __forceinline__ unsigned xb_ld(unsigned* p)              { return __hip_atomic_load(p, __ATOMIC_RELAXED, __HIP_MEMORY_SCOPE_AGENT); }
__device__ __forceinline__ unsigned xb_add(unsigned* p, unsigned v) { return __hip_atomic_fetch_add(p, v, __ATOMIC_RELAXED, __HIP_MEMORY_SCOPE_AGENT); }
__device__ __forceinline__ unsigned xb_xcc_id() { return (unsigned)__builtin_amdgcn_s_getreg((3 << 11) | 20) & 0xFu; }
#define XB_SPIN(cond, bar) do { unsigned _sp = 0; while (cond) { __builtin_amdgcn_s_sleep(1); \
    if ((++_sp & 255u) == 0u) { if (xb_ld(&(bar)[XB_TMO])) break; if (_sp > XB_SPIN_CAP) { atomicAdd(&(bar)[XB_TMO], 1u); break; } } } } while (0)

struct XcdBarrier { unsigned* bar; unsigned x; volatile LAS unsigned* st; };

__device__ __forceinline__ XcdBarrier xcd_barrier_post(unsigned* bar, volatile LAS unsigned* st) {
    XcdBarrier b; b.bar = bar; b.x = xb_xcc_id(); b.st = st;
    if (threadIdx.x == 0) (void)xb_add(&bar[XB_XCNT(b.x)], 1u);
    return b;
}
__device__ __forceinline__ void xcd_barrier_complete(unsigned* bar, unsigned x, unsigned& nloc, unsigned& nx) {
    const unsigned G = gridDim.x * gridDim.y * gridDim.z;
    unsigned sum, cnt, mine, sp = 0u;
    for (;;) {
        sum = 0u; cnt = 0u; mine = 0u;
#pragma unroll
        for (unsigned j = 0; j < 16; ++j) { const unsigned c = xb_ld(&bar[XB_XCNT(j)]); sum += c; cnt += (c > 0u) ? 1u : 0u; mine = (j == x) ? c : mine; }
        if (sum == G) break;
        __builtin_amdgcn_s_sleep(1);
        if ((++sp & 255u) == 0u) { if (xb_ld(&bar[XB_TMO])) break; if (sp > XB_SPIN_CAP) { atomicAdd(&bar[XB_TMO], 1u); break; } }
    }
    nloc = mine > 0u ? mine : 1u; nx = cnt > 0u ? cnt : 1u;
}
__device__ __forceinline__ void xcd_barrier(const XcdBarrier& b, int wave_) {
    asm volatile("s_waitcnt vmcnt(0)" ::: "memory");
    __syncthreads();
    int tl_ = wave_ * 64 + fresh_lane();
    if (tl_ == 0) {
        unsigned* bar = b.bar;
        __builtin_amdgcn_s_waitcnt(0);
        unsigned nloc = b.st[0], nx = b.st[1];
        if (nloc == 0u) { xcd_barrier_complete(bar, b.x, nloc, nx); b.st[0] = nloc; b.st[1] = nx; }
        const unsigned old = xb_add(&bar[XB_XSUB(b.x)], 1u);
        const unsigned gen = old / nloc;
        if (old + 1u == (gen + 1u) * nloc) {
            __builtin_amdgcn_fence(__ATOMIC_RELEASE, "agent");
            asm volatile("s_waitcnt vmcnt(0)" ::: "memory");
            const unsigned og = xb_add(&bar[XB_TOP], 1u);
            const unsigned tg = og / nx;
            if (og + 1u == (tg + 1u) * nx) xb_add(&bar[XB_TOPGEN], 1u);
            else XB_SPIN(xb_ld(&bar[XB_TOPGEN]) == tg, bar);
            __builtin_amdgcn_fence(__ATOMIC_ACQUIRE, "agent");
            xb_add(&bar[XB_XGEN(b.x)], 1u);
            asm volatile("s_waitcnt vmcnt(0)" ::: "memory");
        } else {
            XB_SPIN(xb_ld(&bar[XB_XGEN(b.x)]) == gen, bar);
            __builtin_amdgcn_fence(__ATOMIC_ACQUIRE, "agent");
            asm volatile("s_waitcnt vmcnt(0)" ::: "memory");
        }
    }
    __syncthreads();
}

struct Args { const void* in[22]; float* out; unsigned char* ws; };
struct Frame {
    LAS unsigned char* lds; volatile LAS unsigned* MISC; unsigned* ctl;
    int tid, lane, wave, gw; static constexpr int G = 256;
};
__device__ __forceinline__ void glds16(const void* g, LAS void* l) { __builtin_amdgcn_global_load_lds((const unsigned*)g, (LAS unsigned*)l, 16, 0, 0); }
__device__ __forceinline__ int mbcnt64(u64 m) { return (int)__builtin_amdgcn_mbcnt_hi((unsigned)(m >> 32), __builtin_amdgcn_mbcnt_lo((unsigned)m, 0u)); }

__device__ __forceinline__ int il64(int d) { return d < 32 ? 2 * d : 2 * (d - 32) + 1; }
__device__ __forceinline__ int il32(int d) { return d < 16 ? 2 * d : (d < 32 ? 2 * (d - 16) + 1 : d); }
__device__ __forceinline__ int map_row(int mode, int n) {
    if (mode == 1) return n < 2304 ? (n & ~63) + il64(n & 63) : n;
    if (mode == 2) return ((n >> 7) << 8) + (n & 127);
    if (mode == 3) return ((n >> 7) << 8) + 128 + (n & 127);
    if (mode == 4) {
        if (n < 3072) { const int h = n / 192, r = n - h * 192; return r < 128 ? h * 128 + r : 2048 + h * 64 + il64(r - 128); }
        if (n < 3584) return n;
        if (n < 3648) return 3584 + il64(n - 3584);
        if (n < 4672) { const int j = n - 3648; return 3840 + (j & ~63) + il32(j & 63); }
        if (n < 4736) return 3648 + il32(n - 4672);
        return 3712 + (n - 4736);
    }
    return n;
}
__device__ __forceinline__ void tr_item(const float* __restrict__ W, int N, bf16_t* WT, int ldo, int kofs, int mode, LAS float* scr, int item, int lane, float f8scale = 0.f, int rlo = 0, int rhi = 1 << 30) {
    const int nblk = (N + 63) >> 6, kb = item / nblk, nb = item - kb * nblk, k0 = 64 * kb, n0 = 64 * nb;
    const int nc = n0 + 4 * (lane & 15); const bool okr = nc < N; const float* wp = W + (size_t)(k0 + (lane >> 4)) * N + nc;
    f32x4 v[16];
#pragma unroll
    for (int i = 0; i < 16; ++i) v[i] = okr ? *(const f32x4*)(wp + (size_t)(4 * i) * N) : (f32x4){0.f, 0.f, 0.f, 0.f};
#pragma unroll
    for (int i = 0; i < 16; ++i) { const int k = 4 * i + (lane >> 4); *(LAS f32x4*)(scr + k * 64 + ((4 * (lane & 15) + 4 * (i >> 1)) & 63)) = v[i]; }
    LDS_WAIT();
    const int c = lane & 7;
#pragma unroll
    for (int j = 0; j < 8; ++j) { const int nl = (lane >> 3) + 8 * j, n = n0 + nl; const LAS float* s = scr + (8 * c) * 64 + ((nl + 4 * c) & 63);
        const int orow = map_row(mode, n); const bool okw = n < N && orow >= rlo && orow < rhi;
        if (f8scale > 0.f) { u32x2 o8; o8.x = pk4_fp8(s[0 * 64] * f8scale, s[1 * 64] * f8scale, s[2 * 64] * f8scale, s[3 * 64] * f8scale); o8.y = pk4_fp8(s[4 * 64] * f8scale, s[5 * 64] * f8scale, s[6 * 64] * f8scale, s[7 * 64] * f8scale);
            if (okw) *(u32x2*)((unsigned char*)WT + (size_t)orow * ldo + kofs + k0 + 8 * c) = o8; }
        else {
        u32x4 o; o.x = cvt_pk_bf16(s[0 * 64], s[1 * 64]); o.y = cvt_pk_bf16(s[2 * 64], s[3 * 64]); o.z = cvt_pk_bf16(s[4 * 64], s[5 * 64]); o.w = cvt_pk_bf16(s[6 * 64], s[7 * 64]);
        if (okw) *(u32x4*)(WT + (size_t)orow * ldo + kofs + k0 + 8 * c) = o; } }
    LDS_WAIT();
}
__device__ __forceinline__ void tr_matrix(const Frame& F, const float* W, int K, int N, bf16_t* WT, int ldo, int kofs, int mode, float f8scale = 0.f, int rlo = 0, int rhi = 1 << 30) {
    LAS float* scr = (LAS float*)(F.lds + F.wave * 16384);
    const int nitems = (K >> 6) * ((N + 63) >> 6), NGW = F.G * NWAVES;
    for (int it = F.gw; it < nitems; it += NGW) tr_item(W, N, WT, ldo, kofs, mode, scr, it, F.lane, f8scale, rlo, rhi);
}
__device__ __forceinline__ void cvt_linear(const Frame& F, const float* src, bf16_t* dst, size_t n8) {
    const size_t NT = (size_t)F.G * NTHREADS;
    for (size_t i = (size_t)blockIdx.x * NTHREADS + F.tid; i < n8; i += NT) { const f32x4 a = *(const f32x4*)(src + i * 8), b = *(const f32x4*)(src + i * 8 + 4); *(u32x4*)(dst + i * 8) = pg8::pack8(a, b); }
}
__device__ __forceinline__ void cvt_linear8(const Frame& F, const float* src, unsigned char* dst, size_t n8) {
    const size_t NT = (size_t)F.G * NTHREADS;
    for (size_t i = (size_t)blockIdx.x * NTHREADS + F.tid; i < n8; i += NT) { const f32x4 a = *(const f32x4*)(src + i * 8), b = *(const f32x4*)(src + i * 8 + 4); *(u32x2*)(dst + i * 8) = pg8::pack8_fp8(a, b, 1.0f); }
}
__device__ __forceinline__ void sincos_d(double ang, float& c, float& s) {
    const double n = __builtin_rint(ang * 0.6366197723675814);
    double r = __builtin_fma(-n, 1.5707963267948966, ang); r = __builtin_fma(-n, 6.123233995736766e-17, r);
    const double r2 = r * r;
    const double sp = r * (1.0 + r2 * (-1.0 / 6.0 + r2 * (1.0 / 120.0 + r2 * (-1.0 / 5040.0 + r2 * (1.0 / 362880.0 + r2 * (-1.0 / 39916800.0 + r2 * (1.0 / 6227020800.0)))))));
    const double cp = 1.0 + r2 * (-0.5 + r2 * (1.0 / 24.0 + r2 * (-1.0 / 720.0 + r2 * (1.0 / 40320.0 + r2 * (-1.0 / 3628800.0 + r2 * (1.0 / 479001600.0 + r2 * (-1.0 / 87178291200.0)))))));
    const int q = (int)((long long)n & 3);
    const float sf = (float)sp, cf = (float)cp;
    c = q == 0 ? cf : (q == 1 ? -sf : (q == 2 ? -cf : sf));
    s = q == 0 ? sf : (q == 1 ? cf : (q == 2 ? -sf : -cf));
}
__device__ __forceinline__ void rope_tables(const Frame& F, const int* pos, float* tab64, float* tab32) {
    const int NT = F.G * NTHREADS;
    for (int i = blockIdx.x * NTHREADS + F.tid; i < T * 48; i += NT) {
        const int t = i / 48, f = i - t * 48; const bool is64 = f < 32; const int fi = is64 ? f : f - 32;
        const double base = is64 ? 0.7498942093324559 : 0.5623413251903491;
        double inv = 1.0; for (int k = 0; k < fi; ++k) inv *= base;
        float c, s; sincos_d((double)pos[t] * inv, c, s);
        float* o = is64 ? tab64 + ((size_t)t * 32 + fi) * 2 : tab32 + ((size_t)t * 16 + fi) * 2; o[0] = c; o[1] = s;
    }
}

constexpr int MOE_CONV_ITEMS = 8 * 3 * 3584;
__device__ __forceinline__ void moe_conv_item(const float* w1, const float* w3, const float* w2, unsigned char* ws, LAS float* scr, int it, int lane) {
    const int e = it / (3 * 3584), r = it - e * (3 * 3584), mtx = r / 3584, sub = r - mtx * 3584;
    if (mtx < 2) tr_item((mtx == 0 ? w1 : w3) + (size_t)e * DM * MFFN, MFFN, (bf16_t*)(ws + WS_MW13 + (size_t)e * 2 * MFFN * DM), DM, 0, 2 + mtx, scr, sub, lane, W13_F8SCALE);
    else tr_item(w2 + (size_t)e * MFFN * DM, DM, (bf16_t*)(ws + WS_MW2 + (size_t)e * DM * MFFN), MFFN, 0, 0, scr, sub, lane, W2_F8SCALE);
}

__device__ __forceinline__ unsigned ln_col(int lane, int q) { return 8u * (unsigned)(lane & 63) + 512u * (unsigned)(q >> 1) + 4u * (unsigned)(q & 1); }
__device__ __forceinline__ void ln_load16(f32x4 (&v)[8], const bf16_t* row, int lane) {
#pragma unroll
    for (int j = 0; j < 4; ++j) pg8::unpack8(*(const u32x4*)(row + ln_col(lane, 2 * j)), v[2 * j], v[2 * j + 1]);
}
__device__ __forceinline__ void ln_store16(const f32x4 (&v)[8], bf16_t* row, int lane) {
#pragma unroll
    for (int j = 0; j < 4; ++j) *(u32x4*)(row + ln_col(lane, 2 * j)) = pg8::pack8(v[2 * j], v[2 * j + 1]);
}
__device__ __forceinline__ void ln_store8(const f32x4 (&v)[8], unsigned char* row, int lane) {
#pragma unroll
    for (int j = 0; j < 4; ++j) *(u32x2*)(row + ln_col(lane, 2 * j)) = pg8::pack8_fp8(v[2 * j], v[2 * j + 1], 1.0f);
}
__device__ __forceinline__ void ln_core(f32x4 (&v)[8], const float* g, const float* bb, int lane, float* st_out = nullptr) {
    float s = 0.f;
#pragma unroll
    for (int j = 0; j < 8; ++j) s += (v[j][0] + v[j][1]) + (v[j][2] + v[j][3]);
    const float mean = wave_sum(s) * (1.0f / DM); float s2 = 0.f;
#pragma unroll
    for (int j = 0; j < 8; ++j) { v[j] = v[j] - mean; s2 += (v[j][0] * v[j][0] + v[j][1] * v[j][1]) + (v[j][2] * v[j][2] + v[j][3] * v[j][3]); }
    const float rstd = 1.0f / sqrtf(wave_sum(s2) * (1.0f / DM) + LN_EPS);
    if (st_out && lane == 0) { st_out[0] = mean; st_out[1] = rstd; }
    int l2 = lane; asm volatile("" : "+v"(l2) :: "memory");
#pragma unroll
    for (int j = 0; j < 8; ++j) { const f32x4 gv = *(const f32x4*)(g + ln_col(l2, j)), bv = *(const f32x4*)(bb + ln_col(l2, j)); v[j] = v[j] * rstd * gv + bv; }
}
template <bool OUT8> __device__ __forceinline__ void ln_phase(const Frame& F, const bf16_t* YH, bf16_t* X16, unsigned char* X8, const float* g, const float* bb, float* stats = nullptr) {
    const int NGW = F.G * NWAVES;
    for (int m = F.gw; m < T; m += NGW) { f32x4 v[8];
        ln_load16(v, YH + (size_t)m * DM, F.lane); ln_core(v, g, bb, F.lane, (OUT8 && stats) ? stats + 2 * (size_t)m : nullptr);
        if (!(OUT8 && stats)) ln_store16(v, X16 + (size_t)m * DM, F.lane);
        if constexpr (OUT8) ln_store8(v, X8 + (size_t)m * DM, F.lane); }
}

__device__ __forceinline__ int crow(int r, int hi) { return (r & 3) + 8 * (r >> 2) + 4 * hi; }
template <bool OUT8> __device__ __forceinline__ void swa_phase(const Frame& F, bf16_t* Q, const bf16_t* Kb, const bf16_t* VT, const float* sinks, unsigned char* O8) {
    const int lane = F.lane, l31 = lane & 31, hf = lane >> 5;
    for (int wi = blockIdx.x; wi < 4096; wi += F.G) {
        const int kvh = wi & 3, qsi = (wi >> 2) & 511, b = wi >> 11, h = kvh * 8 + F.wave, q0 = qsi * 32;
        const size_t row0 = (size_t)b * SEQ + q0;
        bf16x8 qf[4];
#pragma unroll
        for (int kk = 0; kk < 4; ++kk) { if constexpr (SWA_FRAG) qf[kk] = *(const bf16x8*)(Q + ((((size_t)(b * 32 + h) * 512 + qsi) * 4 + kk) * 64 + lane) * 8);
            else qf[kk] = *(const bf16x8*)(Q + (row0 + l31) * 2048 + h * 64 + 16 * kk + 8 * hf); }
        f32x16 sc[5];
#pragma unroll
        for (int kt = 0; kt < 5; ++kt) {
            int kpos = q0 - 128 + 32 * kt + l31; kpos = kpos < 0 ? 0 : kpos;
            const bf16_t* kp = Kb + ((size_t)b * SEQ + kpos) * 256 + kvh * 64 + 8 * hf;
            f32x16 a;
#pragma unroll
            for (int r = 0; r < 16; ++r) a[r] = 0.f;
            const int kblk = qsi - 4 + kt < 0 ? 0 : qsi - 4 + kt;
#pragma unroll
            for (int kk = 0; kk < 4; ++kk) { bf16x8 kf; if constexpr (SWA_FRAG) kf = *(const bf16x8*)(Kb + ((((size_t)(b * 4 + kvh) * 512 + kblk) * 4 + kk) * 64 + lane) * 8); else kf = *(const bf16x8*)(kp + 16 * kk);
                a = __builtin_amdgcn_mfma_f32_32x32x16_bf16(kf, qf[kk], a, 0, 0, 0); }
            sc[kt] = a;
        }
        const float sink2 = sinks[h] * LOG2E; const int qpos = q0 + l31;
        float mx = sink2;
#pragma unroll
        for (int kt = 0; kt < 5; ++kt)
#pragma unroll
            for (int r = 0; r < 16; ++r) { const int kpos = q0 - 128 + 32 * kt + crow(r, hf); const bool ok = kpos >= 0 && kpos <= qpos && (qpos - kpos) < 128;
                const float v = ok ? sc[kt][r] : -INFINITY; sc[kt][r] = v; mx = fmaxf(mx, v); }
        mx = fmaxf(mx, shx(mx, 32, lane));
        float sum = 0.f;
#pragma unroll
        for (int kt = 0; kt < 5; ++kt)
#pragma unroll
            for (int r = 0; r < 16; ++r) { const float p = __builtin_amdgcn_exp2f(sc[kt][r] - mx); sc[kt][r] = p; sum += p; }
        sum += shx(sum, 32, lane);
        const float inv = 1.0f / (sum + __builtin_amdgcn_exp2f(sink2 - mx));
        f32x16 o[2];
#pragma unroll
        for (int r = 0; r < 16; ++r) { o[0][r] = 0.f; o[1][r] = 0.f; }
#pragma unroll
        for (int kt = 0; kt < 5; ++kt)
#pragma unroll
            for (int c = 0; c < 2; ++c) {
                bf16x8 pb; { u32x4 w; w.x = cvt_pk_bf16(sc[kt][8 * c + 0], sc[kt][8 * c + 1]); w.y = cvt_pk_bf16(sc[kt][8 * c + 2], sc[kt][8 * c + 3]); w.z = cvt_pk_bf16(sc[kt][8 * c + 4], sc[kt][8 * c + 5]); w.w = cvt_pk_bf16(sc[kt][8 * c + 6], sc[kt][8 * c + 7]); pb = __builtin_bit_cast(bf16x8, w); }
                int kb = q0 - 128 + 32 * kt + 16 * c + 4 * hf; int kb0 = kb < 0 ? 0 : kb, kb1 = kb + 8 < 0 ? 0 : kb + 8;
#pragma unroll
                for (int mt = 0; mt < 2; ++mt) { bf16x8 va;
                    if constexpr (SWA_FRAG) { const int vblk = qsi - 4 + kt < 0 ? 0 : qsi - 4 + kt; va = *(const bf16x8*)(VT + (((((size_t)(b * 4 + kvh) * 512 + vblk) * 2 + c) * 2 + mt) * 64 + lane) * 8); }
                    else { const bf16_t* vp = VT + ((size_t)(b * 4 + kvh) * 64 + 32 * mt + l31) * SEQ;
                    const u32x2 v0 = *(const u32x2*)(vp + kb0), v1 = *(const u32x2*)(vp + kb1); u32x4 w; w.x = v0.x; w.y = v0.y; w.z = v1.x; w.w = v1.y; va = __builtin_bit_cast(bf16x8, w); }
                    o[mt] = __builtin_amdgcn_mfma_f32_32x32x16_bf16(va, pb, o[mt], 0, 0, 0); }
            }
        bf16_t* op = Q + (row0 + l31) * 2048 + h * 64; unsigned char* op8 = O8 + (row0 + l31) * 2048 + h * 64; const float inv8 = inv * O0_F8SCALE;
#pragma unroll
        for (int mt = 0; mt < 2; ++mt)
#pragma unroll
            for (int r4 = 0; r4 < 4; ++r4) {
                if constexpr (OUT8) *(unsigned*)(op8 + 32 * mt + 8 * r4 + 4 * hf) = pk4_fp8(o[mt][4 * r4] * inv8, o[mt][4 * r4 + 1] * inv8, o[mt][4 * r4 + 2] * inv8, o[mt][4 * r4 + 3] * inv8);
                else { u32x2 w; w.x = cvt_pk_bf16(o[mt][4 * r4] * inv, o[mt][4 * r4 + 1] * inv); w.y = cvt_pk_bf16(o[mt][4 * r4 + 2] * inv, o[mt][4 * r4 + 3] * inv);
                *(u32x2*)(op + 32 * mt + 8 * r4 + 4 * hf) = w; } }
    }
}

__device__ __forceinline__ void kvnorm_phase(const Frame& F, const float* CRAW, const float* gk, bf16_t* KV) {
    const int NGW = F.G * NWAVES;
    for (int m = F.gw; m < T; m += NGW) { const float* cr = CRAW + (size_t)m * 512;
        const f32x4 a = *(const f32x4*)(cr + 4 * F.lane), b = *(const f32x4*)(cr + 256 + 4 * F.lane);
        float s = (a[0] * a[0] + a[1] * a[1]) + (a[2] * a[2] + a[3] * a[3]) + (b[0] * b[0] + b[1] * b[1]) + (b[2] * b[2] + b[3] * b[3]);
        const float r = 1.0f / sqrtf(wave_sum(s) * (1.0f / 512.0f) + RMS_EPS);
        const f32x4 ga = *(const f32x4*)(gk + 4 * F.lane), gb = *(const f32x4*)(gk + 256 + 4 * F.lane);
        u32x2 w0, w1; w0.x = cvt_pk_bf16(a[0] * r * ga[0], a[1] * r * ga[1]); w0.y = cvt_pk_bf16(a[2] * r * ga[2], a[3] * r * ga[3]);
        w1.x = cvt_pk_bf16(b[0] * r * gb[0], b[1] * r * gb[1]); w1.y = cvt_pk_bf16(b[2] * r * gb[2], b[3] * r * gb[3]);
        *(u32x2*)(KV + (size_t)m * 576 + 4 * F.lane) = w0; *(u32x2*)(KV + (size_t)m * 576 + 256 + 4 * F.lane) = w1; }
}

__device__ __forceinline__ float relu1(float a) { return __builtin_amdgcn_fmed3f(a, 0.f, 3.0e38f); }
__device__ __forceinline__ unsigned f2key(float f) { const unsigned u = __float_as_uint(f); return u ^ ((unsigned)((int)u >> 31) | 0x80000000u); }
__device__ __forceinline__ float key2f(unsigned k) { const unsigned u = (k & 0x80000000u) ? (k ^ 0x80000000u) : ~k; return __uint_as_float(u); }
__device__ __forceinline__ unsigned compact256(LAS u64* buf, int n, int lane) {
    u64 e[8];
#pragma unroll
    for (int i = 0; i < 8; ++i) e[i] = (lane + 64 * i < n) ? buf[lane + 64 * i] : 0ull;
    unsigned thr = 0u;
    for (int bit = 31; bit >= 0; --bit) {
        const unsigned cand = thr | (1u << bit); int c = 0;
#pragma unroll
        for (int i = 0; i < 8; ++i) c += __popcll(__ballot((unsigned)(e[i] >> 32) >= cand));
        if (c >= 256) thr = cand;
    }
    int ngt = 0;
#pragma unroll
    for (int i = 0; i < 8; ++i) ngt += __popcll(__ballot((unsigned)(e[i] >> 32) > thr));
    int pos_gt = 0, pos_eq = ngt;
#pragma unroll
    for (int i = 0; i < 8; ++i) { const unsigned k = (unsigned)(e[i] >> 32); const bool gt = k > thr, eq = k == thr; const u64 mg = __ballot(gt), me = __ballot(eq);
        if (gt) buf[pos_gt + mbcnt64(mg)] = e[i];
        const int re = pos_eq + mbcnt64(me); if (eq && re < 256) buf[re] = e[i];
        pos_gt += __popcll(mg); pos_eq += __popcll(me); }
    return thr;
}
__device__ __forceinline__ unsigned compact_bound(LAS u64* buf, int n, int lane, unsigned lo, int& n_out) {
    u64 e[8]; unsigned mx = 0u;
#pragma unroll
    for (int i = 0; i < 8; ++i) { e[i] = (lane + 64 * i < n) ? buf[lane + 64 * i] : 0ull; const unsigned k = (unsigned)(e[i] >> 32); mx = k > mx ? k : mx; }
#pragma unroll
    for (int o = 1; o < 64; o <<= 1) { const unsigned t = (unsigned)__builtin_amdgcn_ds_bpermute((lane ^ o) << 2, (int)mx); mx = t > mx ? t : mx; }
    mx = (unsigned)__builtin_amdgcn_readfirstlane((int)mx);
    const unsigned diff = mx ^ lo; const int hb = diff ? 31 - __builtin_clz(diff) : 0;
    unsigned thr = hb >= 31 ? 0u : (lo & ~((2u << hb) - 1u)); int cge = n;
    for (int bit = hb; bit >= 0; --bit) {
        const unsigned cand = thr | (1u << bit); int c = 0;
#pragma unroll
        for (int i = 0; i < 8; ++i) c += __popcll(__ballot((unsigned)(e[i] >> 32) >= cand));
        if (c >= 256) { thr = cand; cge = c; if (c <= 288) break; }
    }
    int pos = 0;
#pragma unroll
    for (int i = 0; i < 8; ++i) { const bool ge = (unsigned)(e[i] >> 32) >= thr && (lane + 64 * i < n); const u64 mg = __ballot(ge);
        if (ge) buf[pos + mbcnt64(mg)] = e[i];
        pos += __popcll(mg); }
    n_out = pos;
    return thr;
}
__device__ __forceinline__ void topk_phase(const Frame& F, const bf16_t* QI, const bf16_t* KIF, const float* WI, unsigned short* SEL) {
    const int lane = F.lane, l31 = lane & 31, hf = lane >> 5, wave = F.wave;
    LAS u64* mybuf = (LAS u64*)F.lds + (size_t)(wave * 4) * 512;
    const unsigned lmask_lt = (1u << l31) - 1u; const int hfm = -hf;
    for (int pu = blockIdx.x; pu < 512; pu += F.G) {
        const int b = pu >> 8, pi = pu & 255;
        for (int half = 0; half < 2; ++half) {
            const int tq = half == 0 ? pi : 511 - pi, q0 = tq * 32, nsteps = tq + 1;
            const size_t trow0 = (size_t)b * SEQ + q0 + 4 * wave;
            bf16x8 aq[2][4]; float wq[2][16];
#pragma unroll
            for (int s = 0; s < 2; ++s) {
                const int qq = 2 * s + ((l31 >> 2) & 1), hd = 4 * (l31 >> 3) + (l31 & 3);
#pragma unroll
                for (int kk = 0; kk < 4; ++kk) aq[s][kk] = *(const bf16x8*)(QI + ((trow0 + qq) * 16 + hd) * 64 + 16 * kk + 8 * hf);
                const float* wp = WI + (trow0 + 2 * s + hf) * 16;
#pragma unroll
                for (int r4 = 0; r4 < 4; ++r4) { const f32x4 w = *(const f32x4*)(wp + 4 * r4); wq[s][4 * r4] = w[0]; wq[s][4 * r4 + 1] = w[1]; wq[s][4 * r4 + 2] = w[2]; wq[s][4 * r4 + 3] = w[3]; }
            }
            float psc0 = 0.f, psc1 = 0.f; int pix0 = 0, pix1 = 0; bool pv0 = false, pv1 = false;
            float thr0 = -INFINITY, thr1 = -INFINITY; int c0 = 0, c1 = 0, c2 = 0, c3 = 0; unsigned b0 = 0x007fffffu, b1 = 0x007fffffu, b2 = 0x007fffffu, b3 = 0x007fffffu;
            const bf16_t* kbase = KIF + (size_t)b * 512 * 4 * 64 * 8 + (size_t)lane * 8;
            bf16x8 k0[4], k1[4], k2[4], k3[4];
#pragma unroll
            for (int kk = 0; kk < 4; ++kk) { k0[kk] = *(const bf16x8*)(kbase + (size_t)(0 * 4 + kk) * 512); k1[kk] = *(const bf16x8*)(kbase + (size_t)((nsteps > 1 ? 1 : 0) * 4 + kk) * 512);
                k2[kk] = *(const bf16x8*)(kbase + (size_t)((nsteps > 2 ? 2 : nsteps - 1) * 4 + kk) * 512); k3[kk] = *(const bf16x8*)(kbase + (size_t)((nsteps > 3 ? 3 : nsteps - 1) * 4 + kk) * 512); }
#define TOPK_STEP(KB, STEP) { const int kidx = 32 * (STEP) + l31; \
    f32x16 a0_, a1_; _Pragma("unroll") for (int r = 0; r < 16; ++r) { a0_[r] = 0.f; a1_[r] = 0.f; } \
    _Pragma("unroll") for (int kk = 0; kk < 4; ++kk) a0_ = __builtin_amdgcn_mfma_f32_32x32x16_bf16(aq[0][kk], KB[kk], a0_, 0, 0, 0); \
    _Pragma("unroll") for (int kk = 0; kk < 4; ++kk) a1_ = __builtin_amdgcn_mfma_f32_32x32x16_bf16(aq[1][kk], KB[kk], a1_, 0, 0, 0); \
    { const int sn_ = (STEP) + 4 < nsteps ? (STEP) + 4 : nsteps - 1; _Pragma("unroll") for (int kk = 0; kk < 4; ++kk) KB[kk] = *(const bf16x8*)(kbase + (size_t)(sn_ * 4 + kk) * 512); }     \
    float sc0_ = 0.f, sc1_ = 0.f; \
    _Pragma("unroll") for (int r = 0; r < 16; ++r) sc0_ = fmaf(wq[0][r], relu1(a0_[r]), sc0_); \
    _Pragma("unroll") for (int r = 0; r < 16; ++r) sc1_ = fmaf(wq[1][r], relu1(a1_[r]), sc1_); \
    const int tql0_ = q0 + 4 * wave + hf; \
    const bool pass0_ = (sc0_ > thr0) && (kidx <= tql0_), pass1_ = (sc1_ > thr1) && (kidx <= tql0_ + 2); \
      \
    if (__ballot((pass0_ && pv0) || (pass1_ && pv1))) { TOPK_FLUSH(); } \
    psc0 = pass0_ ? sc0_ : psc0; pix0 = pass0_ ? kidx : pix0; pv0 = pv0 || pass0_; \
    psc1 = pass1_ ? sc1_ : psc1; pix1 = pass1_ ? kidx : pix1; pv1 = pv1 || pass1_; }
#define TOPK_FLUSH() { const u64 mask0_ = __ballot(pv0), mask1_ = __ballot(pv1); \
        if (mask0_) { const unsigned lo = (unsigned)mask0_, hi = (unsigned)(mask0_ >> 32); const int plo = __popc(lo), phi = __popc(hi); \
          const int rank = mbcnt64(mask0_) - (plo & hfm); const int cm = c0 + ((c1 - c0) & hfm); \
          if (pv0) mybuf[hf * 512 + cm + rank] = ((u64)f2key(psc0) << 32) | (unsigned)pix0; c0 += plo; c1 += phi; } \
        if (mask1_) { const unsigned lo = (unsigned)mask1_, hi = (unsigned)(mask1_ >> 32); const int plo = __popc(lo), phi = __popc(hi); \
          const int rank = mbcnt64(mask1_) - (plo & hfm); const int cm = c2 + ((c3 - c2) & hfm); \
          if (pv1) mybuf[(2 + hf) * 512 + cm + rank] = ((u64)f2key(psc1) << 32) | (unsigned)pix1; c2 += plo; c3 += phi; } \
        pv0 = false; pv1 = false; \
        const int cmx_ = max(max(c0, c1), max(c2, c3)); \
        if (cmx_ > 480) { \
        if (c0 > 480) { b0 = compact_bound(mybuf, c0, lane, b0, c0); const float nt = key2f(b0); thr0 = hf == 0 ? nt : thr0; } \
        if (c1 > 480) { b1 = compact_bound(mybuf + 512, c1, lane, b1, c1); const float nt = key2f(b1); thr0 = hf == 1 ? nt : thr0; } \
        if (c2 > 480) { b2 = compact_bound(mybuf + 1024, c2, lane, b2, c2); const float nt = key2f(b2); thr1 = hf == 0 ? nt : thr1; } \
        if (c3 > 480) { b3 = compact_bound(mybuf + 1536, c3, lane, b3, c3); const float nt = key2f(b3); thr1 = hf == 1 ? nt : thr1; } } }
            for (int st = 0; st < nsteps; st += 4) {
                TOPK_STEP(k0, st);
                if (st + 1 < nsteps) TOPK_STEP(k1, st + 1);
                if (st + 2 < nsteps) TOPK_STEP(k2, st + 2);
                if (st + 3 < nsteps) TOPK_STEP(k3, st + 3);
            }
            TOPK_FLUSH();
#undef TOPK_STEP
#undef TOPK_FLUSH
#pragma unroll
            for (int qi = 0; qi < 4; ++qi) {
                int c = qi == 0 ? c0 : (qi == 1 ? c1 : (qi == 2 ? c2 : c3)); LAS u64* bq = mybuf + qi * 512;
                if (c > 256) { (void)compact256(bq, c, lane); c = 256; }
                LDS_WAIT();
                unsigned short v[4];
#pragma unroll
                for (int j = 0; j < 4; ++j) { const int e = 4 * lane + j; v[j] = e < c ? (unsigned short)(bq[e] & 0xffffull) : (unsigned short)0xffff; }
                u32x2 w; w.x = (unsigned)v[0] | ((unsigned)v[1] << 16); w.y = (unsigned)v[2] | ((unsigned)v[3] << 16);
                *(u32x2*)(SEL + (trow0 + qi) * 256 + 4 * lane) = w;
            }
            LDS_WAIT();
        }
    }
}

__device__ __forceinline__ bf16x4 tr_read16(const LAS unsigned char* p) { return __builtin_bit_cast(bf16x4, __builtin_amdgcn_ds_read_tr16_b64_v4i16((LAS bf16x4*)p)); }
__device__ __forceinline__ void dsa_attn_phase(const Frame& F, const bf16_t* QLAT, bf16_t* OUT, const bf16_t* QR, const bf16_t* KV, const unsigned short* SEL, const float* w1, const float* w3, const float* w2, unsigned char* ws) {
    LAS unsigned char* wb = F.lds + F.wave * DSA_WBUF; LAS unsigned char* tails = wb + 16640;
    const unsigned char* KVb = (const unsigned char*)KV;
    const int NGW = F.G * NWAVES;
    for (int tg = F.gw; tg < T; tg += NGW) {
        int lane = F.lane; asm volatile("" : "+v"(lane));
        const int l15 = lane & 15, g = lane >> 4;
        const int b = tg >> 14, t = tg & (SEQ - 1); const int nvalid = t + 1 < 256 ? t + 1 : 256, nsteps = (nvalid + 15) >> 4;
        bf16x8 qf[18];
#pragma unroll
        for (int kk = 0; kk < 16; ++kk) {
            if constexpr (F8_LAT) { const u32x2 w8 = *(const u32x2*)((const unsigned char*)QLAT + ((size_t)tg * 16 + l15) * 512 + 32 * kk + 8 * g);
                const f32x2 f0 = __builtin_amdgcn_cvt_pk_f32_fp8((int)w8.x, false), f1 = __builtin_amdgcn_cvt_pk_f32_fp8((int)w8.x, true), f2 = __builtin_amdgcn_cvt_pk_f32_fp8((int)w8.y, false), f3 = __builtin_amdgcn_cvt_pk_f32_fp8((int)w8.y, true);
                u32x4 wb16; wb16.x = cvt_pk_bf16(f0[0], f0[1]); wb16.y = cvt_pk_bf16(f1[0], f1[1]); wb16.z = cvt_pk_bf16(f2[0], f2[1]); wb16.w = cvt_pk_bf16(f3[0], f3[1]); qf[kk] = __builtin_bit_cast(bf16x8, wb16); }
            else qf[kk] = *(const bf16x8*)(QLAT + ((size_t)tg * 16 + l15) * 512 + 32 * kk + 8 * g); }
#pragma unroll
        for (int kk = 0; kk < 2; ++kk) qf[16 + kk] = *(const bf16x8*)(QR + ((size_t)tg * 16 + l15) * 64 + 32 * kk + 8 * g);
        float m = -INFINITY, lsum = 0.f; f32x4 O[32];
#pragma unroll
        for (int mt = 0; mt < 32; ++mt) O[mt] = (f32x4){0.f, 0.f, 0.f, 0.f};
        for (int st = 0; st < nsteps; ++st) {
            const int slot = 16 * st + l15;
            int idx = slot < nvalid ? (int)SEL[(size_t)tg * 256 + slot] : 0; idx = idx > t ? 0 : idx;
            const int row = b * SEQ + idx;
            LDS_WAIT();
#pragma unroll
            for (int r = 0; r < 16; ++r) { const int rr = __builtin_amdgcn_readlane(row, r); glds16(KVb + (size_t)rr * 1152 + 16 * lane, wb + r * 1040); }
#pragma unroll
            for (int p = 0; p < 2; ++p) glds16(KVb + (size_t)row * 1152 + 1024 + 16 * (4 * p + g), tails + 1024 * p);
            VM_WAIT();
            f32x4 sacc = (f32x4){0.f, 0.f, 0.f, 0.f};
#pragma unroll
            for (int kk = 0; kk < 16; ++kk) { const bf16x8 a = *(const LAS bf16x8*)(wb + l15 * 1040 + (4 * kk + g) * 16); sacc = __builtin_amdgcn_mfma_f32_16x16x32_bf16(a, qf[kk], sacc, 0, 0, 0); }
#pragma unroll
            for (int kk = 0; kk < 2; ++kk) { const bf16x8 a = *(const LAS bf16x8*)(tails + (4 * kk + g) * 256 + l15 * 16); sacc = __builtin_amdgcn_mfma_f32_16x16x32_bf16(a, qf[16 + kk], sacc, 0, 0, 0); }
            float s[4]; float tmax = -INFINITY;
#pragma unroll
            for (int i = 0; i < 4; ++i) { s[i] = (16 * st + 4 * g + i) < nvalid ? sacc[i] * (F8_LAT ? SCALE2_MLA / QLAT_F8SCALE : SCALE2_MLA) : -INFINITY; tmax = fmaxf(tmax, s[i]); }
            tmax = fmaxf(tmax, shx(tmax, 16, lane)); tmax = fmaxf(tmax, shx(tmax, 32, lane));
            const float mnew = fmaxf(m, tmax); const float alpha = __builtin_amdgcn_exp2f(m - mnew); m = mnew;
            float p[4];
#pragma unroll
            for (int i = 0; i < 4; ++i) p[i] = __builtin_amdgcn_exp2f(s[i] - mnew);
            lsum = lsum * alpha + ((p[0] + p[1]) + (p[2] + p[3]));
            if (__any(alpha != 1.0f)) {
#pragma unroll
                for (int mt = 0; mt < 32; ++mt) O[mt] = O[mt] * alpha;
            }
            u32x2 pw; pw.x = cvt_pk_bf16(p[0], p[1]); pw.y = cvt_pk_bf16(p[2], p[3]); const bf16x4 pb = __builtin_bit_cast(bf16x4, pw);
            const LAS unsigned char* trb = wb + (4 * g + (l15 >> 2)) * 1040 + (lane & 3) * 8;
#pragma unroll
            for (int mt = 0; mt < 32; ++mt) { const bf16x4 a = tr_read16(trb + mt * 32); O[mt] = __builtin_amdgcn_mfma_f32_16x16x16bf16_1k(a, pb, O[mt], 0, 0, 0); }
        }
        float lt = lsum + shx(lsum, 16, lane); lt += shx(lt, 32, lane); const float inv = 1.0f / lt;
        if constexpr (F8_LAT) { unsigned char* op8 = (unsigned char*)OUT + ((size_t)tg * 16 + l15) * 512 + 4 * g; const float inv8 = inv * OLAT_F8SCALE;
#pragma unroll
            for (int mt = 0; mt < 32; ++mt) *(unsigned*)(op8 + 16 * mt) = pk4_fp8(O[mt][0] * inv8, O[mt][1] * inv8, O[mt][2] * inv8, O[mt][3] * inv8); }
        else { bf16_t* op = OUT + ((size_t)tg * 16 + l15) * 512 + 4 * g;
#pragma unroll
        for (int mt = 0; mt < 32; ++mt) { u32x2 w; w.x = cvt_pk_bf16(O[mt][0] * inv, O[mt][1] * inv); w.y = cvt_pk_bf16(O[mt][2] * inv, O[mt][3] * inv); *(u32x2*)(op + 16 * mt) = w; } }
        if (w1) { LDS_WAIT(); int lane2 = F.lane; asm volatile("" : "+v"(lane2));
            for (int k = 0; k < 3; ++k) { const int it = F.gw + NGW * (3 * ((tg - F.gw) / NGW) + k); if (it < MOE_CONV_ITEMS) moe_conv_item(w1, w3, w2, ws, (LAS float*)wb, it, lane2); } }
    }
    LDS_WAIT();
}

__device__ __forceinline__ void ln_router_phase(const Frame& F, const bf16_t* YH, bf16_t* XB, const float* g, const float* bb, const float* wr, int* TOKE, float* TOKG, int* TOKL) {
    LAS float* wl = (LAS float*)F.lds;
    for (int i = F.tid; i < DM * NEXP; i += NTHREADS) { const int d = i >> 3, e = i & 7; wl[e * DM + d] = wr[i]; }
    __syncthreads();
    const int NGW = F.G * NWAVES, lane = F.lane;
    u64 cnt64 = 0ull; int mine = 0;
    int j = 0;
    for (int m = F.gw; m < T; m += NGW, ++j) { f32x4 v[8];
        ln_load16(v, YH + (size_t)m * DM, lane); ln_core(v, g, bb, lane); ln_store8(v, (unsigned char*)XB + (size_t)m * DM, lane);
        float lg[8];
#pragma unroll
        for (int e = 0; e < 8; ++e) { float s = 0.f;
#pragma unroll
            for (int q = 0; q < 8; ++q) { const f32x4 w = *(const LAS f32x4*)(wl + e * DM + ln_col(lane, q)); s += (v[q][0] * w[0] + v[q][1] * w[1]) + (v[q][2] * w[2] + v[q][3] * w[3]); }
            lg[e] = wave_sum(s); }
        int e1 = 0; float v1 = lg[0];
#pragma unroll
        for (int e = 1; e < 8; ++e) if (lg[e] > v1) { v1 = lg[e]; e1 = e; }
        int e2 = -1; float v2 = -INFINITY;
#pragma unroll
        for (int e = 0; e < 8; ++e) if (e != e1 && lg[e] > v2) { v2 = lg[e]; e2 = e; }
        const float g1 = 1.0f / (1.0f + __expf(v2 - v1)), g2 = 1.0f - g1;
        const int r1 = (int)((cnt64 >> (8 * e1)) & 0xffull); cnt64 += 1ull << (8 * e1);
        const int r2 = (int)((cnt64 >> (8 * e2)) & 0xffull); cnt64 += 1ull << (8 * e2);
        if (lane == 0) { TOKE[2 * m] = e1; TOKE[2 * m + 1] = e2; TOKG[2 * m] = g1; TOKG[2 * m + 1] = g2; }
        if (lane == j) mine = e1 | (e2 << 4) | (r1 << 8) | (r2 << 16);
    }
    int basev = 0;
    if (lane < 8) { const unsigned c = (unsigned)((cnt64 >> (8 * lane)) & 0xffull); basev = (int)__hip_atomic_fetch_add(F.ctl + CW_CNT + lane, c, __ATOMIC_RELAXED, __HIP_MEMORY_SCOPE_AGENT); }
    const int e1 = mine & 15, e2 = (mine >> 4) & 15, r1 = (mine >> 8) & 255, r2 = (mine >> 16) & 255;
    const int b1 = __builtin_amdgcn_ds_bpermute(e1 << 2, basev), b2 = __builtin_amdgcn_ds_bpermute(e2 << 2, basev);
    if (lane < j) { const int m = F.gw + NGW * lane; TOKL[2 * m] = b1 + r1; TOKL[2 * m + 1] = b2 + r2; }
    __syncthreads();
}
__device__ __forceinline__ void moe_tiles(const Frame& F) {
    if (F.tid == 0) { int acc = 0;
        for (int e = 0; e < 8; ++e) { const unsigned c = __hip_atomic_load(F.ctl + CW_CNT + e, __ATOMIC_RELAXED, __HIP_MEMORY_SCOPE_AGENT); F.MISC[32 + e] = c; F.MISC[40 + e] = (unsigned)acc; acc += (int)((c + 255u) >> 8); F.MISC[20 + e] = (unsigned)acc; }
        F.MISC[28] = (unsigned)acc; }
    __syncthreads();
}
__device__ __forceinline__ void moe_gather_phase(const Frame& F, const bf16_t* XB, const int* TOKE, const float* TOKG, const int* TOKL, int* TOKS, float* SGATE, bf16_t* XG) {
    const int NGW = F.G * NWAVES, lane = F.lane;
    for (int m = F.gw; m < T; m += NGW) {
        const u32x4* src = (const u32x4*)((const unsigned char*)XB + (size_t)m * DM);
        const u32x4 a0 = src[lane], a1 = src[64 + lane];
#pragma unroll
        for (int k = 0; k < 2; ++k) { const int e = TOKE[2 * m + k], li = TOKL[2 * m + k]; const int slot = (int)F.MISC[40 + e] * 256 + li;
            u32x4* dst = (u32x4*)((unsigned char*)XG + (size_t)slot * DM); dst[lane] = a0; dst[64 + lane] = a1;
            if (lane == 0) { TOKS[2 * m + k] = slot; SGATE[slot] = TOKG[2 * m + k]; } }
    }
    for (int it = F.gw; it < 8 * 256; it += NGW) { const int e = it >> 8, r = it & 255; const int c = (int)F.MISC[32 + e]; const int ntile = (c + 255) >> 8; const int row = c + r;
        if (row < ntile * 256) { const int slot = (int)F.MISC[40 + e] * 256 + row; u32x4* dst = (u32x4*)((unsigned char*)XG + (size_t)slot * DM); const u32x4 z = {0u, 0u, 0u, 0u};
            dst[lane] = z; dst[64 + lane] = z; if (lane == 0) SGATE[slot] = 0.f; } }
}
__device__ __forceinline__ void moe_combine_ln_phase(const Frame& F, const bf16_t* YH, bf16_t* XB, const bf16_t* SOUT, const int* TOKS, const float* g1, const float* bb1, const float* g, const float* bb) {
    const int NGW = F.G * NWAVES, lane = F.lane;
    for (int m = F.gw; m < T; m += NGW) { f32x4 v[8];
        const bf16_t* s0 = SOUT + (size_t)TOKS[2 * m] * DM; const bf16_t* s1 = SOUT + (size_t)TOKS[2 * m + 1] * DM;
        ln_load16(v, YH + (size_t)m * DM, lane);
        ln_core(v, g1, bb1, lane);
#pragma unroll
        for (int j = 0; j < 4; ++j) { f32x4 a0, a1, c0, c1; pg8::unpack8(*(const u32x4*)(s0 + ln_col(lane, 2 * j)), a0, a1); pg8::unpack8(*(const u32x4*)(s1 + ln_col(lane, 2 * j)), c0, c1);
            v[2 * j] = v[2 * j] * ALPHA + (a0 + c0); v[2 * j + 1] = v[2 * j + 1] * ALPHA + (a1 + c1); }
        ln_core(v, g, bb, lane); ln_store16(v, XB + (size_t)m * DM, lane); }
}

#ifndef PHASES
#define PHASES 0xFFFFFFFFu
#endif
#define PH(k) if constexpr ((PHASES >> (k)) & 1u)
#ifndef DBL
#define DBL 0u
#endif
#define DB(k) if constexpr ((DBL >> (k)) & 1u)
__global__ void __launch_bounds__(NTHREADS, 2) mega_fwd(Args args) {
    extern __shared__ __attribute__((aligned(16))) unsigned char lds_raw[];
    Frame F;
    F.lds = (LAS unsigned char*)lds_raw; F.MISC = (volatile LAS unsigned*)(F.lds + MISC_OFF);
    F.tid = threadIdx.x; F.lane = F.tid & 63; F.wave = __builtin_amdgcn_readfirstlane(F.tid >> 6); F.gw = blockIdx.x * NWAVES + F.wave;
    unsigned char* ws = args.ws;
    F.ctl = (unsigned*)(ws + WS_CTL);
    if (F.tid < 64) F.MISC[F.tid] = 0u;
    __syncthreads();
    XcdBarrier bar = xcd_barrier_post(F.ctl + CW_BAR, F.MISC + 8);
#define REFRESH() do { F.lane = fresh_lane(); F.tid = F.wave * 64 + F.lane; } while (0)
#define GRID_BAR() do { xcd_barrier(bar, F.wave); REFRESH(); } while (0)
#define YH ((bf16_t*)args.out)
#define bx ((int)blockIdx.x)
#define WSP(T_, off) ((T_*)(ws + (off)))

    PH(0) {
        { LAS float* scr = (LAS float*)(F.lds + F.wave * 16384);
          constexpr int I_QKV = 32 * 40, I_SQ = 32 * 32, I_W13 = 32 * 88, I_W2 = 88 * 32, I_WP = 4 * 32, I_WIN = 32 * 75, I_WUV = 256;
          constexpr int I_TOTAL = I_QKV + I_SQ + 2 * I_W13 + I_W2 + 2 * I_SQ + 2 * I_WP + (F8_WIN_SPLIT ? 2 : 1) * I_WIN + I_SQ + I_WUV;
          for (int it = F.gw; it < I_TOTAL; it += F.G * NWAVES) {
              int r = it; bool hit = false; const float* W = nullptr; int N = 0, ldo = 0, kofs = 0, mode = 0, rlo = 0, rhi = 1 << 30; unsigned char* WT = nullptr; float f8 = 0.f;
#define PSEG(cnt, Wp, Nn, WTp, ld, md, f8v, lo, hi) if (!hit) { if (r < (cnt)) { W = (Wp); N = (Nn); WT = (unsigned char*)(WTp); ldo = (ld); mode = (md); f8 = (f8v); rlo = (lo); rhi = (hi); hit = true; } else r -= (cnt); }
              PSEG(I_QKV, (const float*)args.in[3], NQKV, ws + WS_WQKV, DM, 1, F8_QKV ? WQKV_F8SCALE : 0.f, 0, 1 << 30)
              PSEG(I_SQ, (const float*)args.in[5], DM, ws + WS_WO0, DM, 0, F8_WO0 ? WO_F8SCALE : 0.f, 0, 1 << 30)
              PSEG(I_W13, (const float*)args.in[6], FFN, ws + WS_W13, DM, 2, F8_FFN1 ? W13_F8SCALE : 0.f, 0, 1 << 30)
              PSEG(I_W13, (const float*)args.in[7], FFN, ws + WS_W13, DM, 3, F8_FFN1 ? W13_F8SCALE : 0.f, 0, 1 << 30)
              PSEG(I_W2, (const float*)args.in[8], DM, ws + WS_W2, FFN, 0, F8_FFN2 ? W2_F8SCALE : 0.f, 0, 1 << 30)
              PSEG(I_SQ, (const float*)args.in[21], DM, ws + WS_WG0, DM, 0, 0.f, 0, 1 << 30)
              PSEG(I_SQ, (const float*)args.in[21] + (size_t)DM * DM, DM, ws + WS_WG1, DM, 0, 0.f, 0, 1 << 30)
              PSEG(I_WP, (const float*)args.in[20], DM, ws + WS_WP0, 256, 0, 0.f, 0, 1 << 30)
              PSEG(I_WP, (const float*)args.in[20] + (size_t)256 * DM, DM, ws + WS_WP1, 256, 0, 0.f, 0, 1 << 30)
              if constexpr (F8_WIN_SPLIT) { PSEG(I_WIN, (const float*)args.in[9], 4752, ws + WS_WIN8, DM, 4, WIN_F8SCALE, 0, WIN_F8_TILES * 256)
                                            PSEG(I_WIN, (const float*)args.in[9], 4752, ws + WS_WIN, DM, 4, 0.f, WIN_F8_TILES * 256, NWIN) }
              else { PSEG(I_WIN, (const float*)args.in[9], 4752, ws + WS_WIN, DM, 4, F8_WIN ? WIN_F8SCALE : 0.f, 0, 1 << 30) }
              PSEG(I_SQ, (const float*)args.in[13], DM, ws + WS_WO1, DM, 0, F8_WO1 ? WO_F8SCALE : 0.f, 0, 1 << 30)
              if (!hit) { const int h = r >> 4; r &= 15;
                  W = (const float*)args.in[12] + (size_t)h * 512 * 128; N = 128; WT = ws + WS_WUV + (size_t)h * 128 * 1024 * (F8_LAT ? 1 : 2); ldo = 1024; kofs = 512 * (h & 1); f8 = F8_LAT ? WUV_F8SCALE : 0.f; }
#undef PSEG
              tr_item(W, N, (bf16_t*)WT, ldo, kofs, mode, scr, r, F.lane, f8, rlo, rhi); } }
        { bf16_t* wuv = WSP(bf16_t, WS_WUV); const u32x4 z = {0u, 0u, 0u, 0u};
          for (int i = bx * NTHREADS + F.tid; i < 2048 * 64; i += F.G * NTHREADS) { const int n = i >> 6, c8 = i & 63; const int h = n >> 7;
              if constexpr (F8_LAT) { if (c8 < 32) *(u32x4*)((unsigned char*)wuv + (size_t)n * 1024 + 512 * ((h & 1) ^ 1) + 16 * c8) = z; }
              else *(u32x4*)(wuv + (size_t)n * 1024 + 512 * ((h & 1) ^ 1) + 8 * c8) = z; } }
        cvt_linear(F, (const float*)args.in[11], WSP(bf16_t, WS_WUK), (size_t)16 * 512 * 128 / 8);
        if constexpr (F8_QKV) cvt_linear8(F, (const float*)args.in[0], WSP(unsigned char, WS_XBA), (size_t)T * DM / 8); else cvt_linear(F, (const float*)args.in[0], WSP(bf16_t, WS_XBA), (size_t)T * DM / 8);
        cvt_linear(F, (const float*)args.in[1], WSP(bf16_t, WS_PB), (size_t)2 * T * 256 / 8);
        rope_tables(F, (const int*)args.in[2], WSP(float, WS_TAB64), WSP(float, WS_TAB32));
    }
    GRID_BAR();
    PH(1) {
        constexpr int KD = F8_QKV ? DM / 2 : DM;
        pg8::Gemm g{WSP(bf16_t, WS_XBA), WSP(bf16_t, WS_WQKV), KD, KD, KD}; pg8::GridOrder<0, T / 256, NQKV / 256> S;
        pg8::EpiQKV E{ws, F8_QKV ? 1.0f / WQKV_F8SCALE : 1.0f}; pg8::gemm_phase<pg8::EpiQKV, pg8::GridOrder<0, T / 256, NQKV / 256>, F8_QKV>(F.lds, g, S, E, F.wave);
    }
    GRID_BAR();
    PH(2) swa_phase<F8_WO0>(F, WSP(bf16_t, WS_Q), WSP(bf16_t, WS_K), WSP(bf16_t, WS_VT), (const float*)args.in[4], WSP(unsigned char, WS_O8));
    GRID_BAR();
    PH(3) {
        constexpr int KD = F8_WO0 ? DM / 2 : DM;
        pg8::Gemm g{F8_WO0 ? WSP(bf16_t, WS_O8) : WSP(bf16_t, WS_Q), WSP(bf16_t, WS_WO0), KD, KD, KD}; pg8::GridOrder<0, T / 256, DM / 256> S;
        pg8::EpiRes<0> E{args.in[0], YH, F8_WO0 ? 1.0f / (O0_F8SCALE * WO_F8SCALE) : 1.0f, nullptr, nullptr, nullptr}; pg8::gemm_phase<pg8::EpiRes<0>, pg8::GridOrder<0, T / 256, DM / 256>, F8_WO0, EPI_ALIGN_RES>(F.lds, g, S, E, F.wave);
    }
    GRID_BAR();
    PH(4) ln_phase<F8_FFN1>(F, YH, WSP(bf16_t, WS_XBB), WSP(unsigned char, WS_XBA), (const float*)args.in[18], (const float*)args.in[19], F8_FFN1 ? WSP(float, WS_SEL) : nullptr);
    GRID_BAR();
    PH(5) {
        constexpr int KD = F8_FFN1 ? DM / 2 : DM;
        pg8::Gemm g{F8_FFN1 ? WSP(bf16_t, WS_XBA) : WSP(bf16_t, WS_XBB), WSP(bf16_t, WS_W13), KD, KD, KD}; pg8::GridOrder<0, T / 256, 2 * FFN / 256> S;
        pg8::EpiSwiglu<F8_FFN2> E{WSP(bf16_t, WS_ACT), FFN, F8_FFN1 ? 1.0f / W13_F8SCALE : 1.0f, ACT_F8SCALE}; pg8::gemm_phase<pg8::EpiSwiglu<F8_FFN2>, pg8::GridOrder<0, T / 256, 2 * FFN / 256>, F8_FFN1>(F.lds, g, S, E, F.wave);
    }
    GRID_BAR();
    PH(6) {
        constexpr int KD = F8_FFN2 ? FFN / 2 : FFN;
        pg8::Gemm g{WSP(bf16_t, WS_ACT), WSP(bf16_t, WS_W2), KD, KD, KD}; pg8::GridOrder<0, T / 256, DM / 256> S;
        constexpr int RM = F8_FFN1 ? 2 : 1;
        pg8::EpiRes<RM> E{F8_FFN1 ? (const void*)YH : (const void*)WSP(bf16_t, WS_XBB), YH, F8_FFN2 ? 1.0f / (ACT_F8SCALE * W2_F8SCALE) : 1.0f, WSP(float, WS_SEL), (const float*)args.in[18], (const float*)args.in[19]};
        pg8::gemm_phase<pg8::EpiRes<RM>, pg8::GridOrder<0, T / 256, DM / 256>, F8_FFN2, EPI_ALIGN_RES>(F.lds, g, S, E, F.wave);
    }
    GRID_BAR();
    PH(7) ln_phase<false>(F, YH, WSP(bf16_t, WS_XBA), nullptr, (const float*)args.in[18] + DM, (const float*)args.in[19] + DM);
    REFRESH();
    PH(7) {
        pg8::Gemm g{WSP(bf16_t, WS_PB), WSP(bf16_t, WS_WP0), 256, 256, 256}; pg8::GridOrder<0, T / 256, DM / 256> S;
        pg8::EpiBf16<false> E{WSP(bf16_t, WS_PP0), DM, 1.0f}; pg8::gemm_phase(F.lds, g, S, E, F.wave);
    }
    GRID_BAR();
    PH(8) {
        pg8::Gemm g{WSP(bf16_t, WS_XBA), WSP(bf16_t, WS_WG0), DM, DM, DM}; pg8::GridOrder<0, T / 256, DM / 256> S;
        pg8::EpiPle E{nullptr, ws, 0}; pg8::gemm_phase<pg8::EpiPle, pg8::GridOrder<0, T / 256, DM / 256>, false, EPI_ALIGN_RES>(F.lds, g, S, E, F.wave);
    }
    GRID_BAR();
    PH(9) {
        if constexpr (F8_WIN_SPLIT) {
            { static_assert((T / 256) * WIN_F8_TILES == 7 * pg8::GRID && (T / 256) * (NWIN / 256 - WIN_F8_TILES) == 5 * pg8::GRID / 2, "uneven deal: 7 rounds of e4m3 units, 2.5 rounds of bf16 units");
              pg8::Gemm g{WSP(bf16_t, WS_XB8), WSP(bf16_t, WS_WIN8), DM / 2, DM / 2, DM / 2}; pg8::GridOrder<4, T / 256, WIN_F8_TILES> S;
              pg8::EpiWin E{ws, 1.0f / WIN_F8SCALE, 0}; pg8::gemm_phase<pg8::EpiWin, pg8::GridOrder<4, T / 256, WIN_F8_TILES>, true>(F.lds, g, S, E, F.wave); }
            REFRESH();
            { pg8::Gemm g{WSP(bf16_t, WS_XBB), WSP(bf16_t, WS_WIN) + (size_t)WIN_F8_TILES * 256 * DM, DM, DM, DM}; pg8::GridOrder<0, T / 256, NWIN / 256 - WIN_F8_TILES> S;
              pg8::EpiWin E{ws, 1.0f, WIN_F8_TILES}; pg8::gemm_phase<pg8::EpiWin, pg8::GridOrder<0, T / 256, NWIN / 256 - WIN_F8_TILES>, false>(F.lds, g, S, E, F.wave); }
        } else {
        constexpr int KD = F8_WIN ? DM / 2 : DM;
        pg8::Gemm g{WSP(bf16_t, WS_XBB), WSP(bf16_t, WS_WIN), KD, KD, KD}; pg8::GridOrder<0, T / 256, NWIN / 256> S;
        pg8::EpiWin E{ws, F8_WIN ? 1.0f / WIN_F8SCALE : 1.0f, 0}; pg8::gemm_phase<pg8::EpiWin, pg8::GridOrder<0, T / 256, NWIN / 256>, F8_WIN>(F.lds, g, S, E, F.wave);
        }
    }
    GRID_BAR();
    PH(10) kvnorm_phase(F, WSP(float, WS_CRAW), (const float*)args.in[10], WSP(bf16_t, WS_KV));
    REFRESH();
    PH(11) {
        pg8::Gemm g{WSP(bf16_t, WS_QN), WSP(bf16_t, WS_WUK), DM, 128, 128}; pg8::GridOrder<1, T / 256, 8192 / 256> S;
        pg8::EpiBf16<F8_LAT> E{WSP(bf16_t, WS_QLAT), 8192, F8_LAT ? QLAT_F8SCALE : 1.0f}; pg8::gemm_phase(F.lds, g, S, E, F.wave);
    }
    REFRESH();
    DB(12) { topk_phase(F, WSP(bf16_t, WS_QI), WSP(bf16_t, WS_KIF), WSP(float, WS_WI), WSP(unsigned short, WS_SEL)); REFRESH(); }
    PH(12) topk_phase(F, WSP(bf16_t, WS_QI), WSP(bf16_t, WS_KIF), WSP(float, WS_WI), WSP(unsigned short, WS_SEL));
    GRID_BAR();
    PH(13) dsa_attn_phase(F, WSP(bf16_t, WS_QLAT), WSP(bf16_t, WS_QLAT), WSP(bf16_t, WS_QR), WSP(bf16_t, WS_KV), WSP(unsigned short, WS_SEL), (const float*)args.in[15], (const float*)args.in[16], (const float*)args.in[17], ws);
    GRID_BAR();
    PH(14) {
        constexpr float dsc = F8_LAT ? 1.0f / (OLAT_F8SCALE * WUV_F8SCALE) : 1.0f;
        pg8::Gemm g{WSP(bf16_t, WS_QLAT), WSP(bf16_t, WS_WUV), F8_LAT ? 4096 : 8192, F8_LAT ? 512 : 1024, F8_LAT ? 512 : 1024}; pg8::GridOrder<F8_LAT ? 3 : 2, T / 256, DM / 256> S;
        pg8::EpiBf16<F8_WO1> E{WSP(bf16_t, WS_O2), DM, (F8_WO1 ? O2_F8SCALE : 1.0f) * dsc}; pg8::gemm_phase<pg8::EpiBf16<F8_WO1>, pg8::GridOrder<F8_LAT ? 3 : 2, T / 256, DM / 256>, F8_LAT>(F.lds, g, S, E, F.wave);
    }
    GRID_BAR();
    PH(15) {
        constexpr int KD = F8_WO1 ? DM / 2 : DM;
        pg8::Gemm g{WSP(bf16_t, WS_O2), WSP(bf16_t, WS_WO1), KD, KD, KD}; pg8::GridOrder<0, T / 256, DM / 256> S;
        pg8::EpiRes<1> E{WSP(bf16_t, WS_XBB), YH, F8_WO1 ? 1.0f / (O2_F8SCALE * WO_F8SCALE) : 1.0f, nullptr, nullptr, nullptr}; pg8::gemm_phase<pg8::EpiRes<1>, pg8::GridOrder<0, T / 256, DM / 256>, F8_WO1, EPI_ALIGN_RES>(F.lds, g, S, E, F.wave);
    }
    GRID_BAR();
    PH(16) ln_router_phase(F, YH, WSP(bf16_t, WS_XBA), (const float*)args.in[18] + 2 * DM, (const float*)args.in[19] + 2 * DM, (const float*)args.in[14], WSP(int, WS_TOKE), WSP(float, WS_TOKG), WSP(int, WS_TOKL));
    REFRESH();
    GRID_BAR();
    PH(18) moe_tiles(F);
    REFRESH();
    PH(18) moe_gather_phase(F, WSP(bf16_t, WS_XBA), WSP(int, WS_TOKE), WSP(float, WS_TOKG), WSP(int, WS_TOKL), WSP(int, WS_TOKS), WSP(float, WS_SGATE), WSP(bf16_t, WS_XG));
    GRID_BAR();
    PH(19) {
        const int NTL = __builtin_amdgcn_readfirstlane((int)F.MISC[28]);
        {
            pg8::MoeOrder<false, 2 * MFFN / 256> S; S.tile0 = 0; S.ntl = NTL;
            pg8::Gemm g{WSP(bf16_t, WS_XG), WSP(bf16_t, WS_MW13), DM / 2, DM / 2, DM / 2};
            pg8::EpiSwiglu<true> E{WSP(bf16_t, WS_ACT2), MFFN, 1.0f / W13_F8SCALE, ACT_F8SCALE}; pg8::gemm_phase<pg8::EpiSwiglu<true>, pg8::MoeOrder<false, 2 * MFFN / 256>, true>(F.lds, g, S, E, F.wave);
        }
        GRID_BAR();
        {
            pg8::MoeOrder<true, DM / 256> S; S.tile0 = 0; S.ntl = NTL;
            pg8::Gemm g{WSP(bf16_t, WS_ACT2), WSP(bf16_t, WS_MW2), MFFN / 2, MFFN / 2, MFFN / 2};
            pg8::EpiMoeDown E{ws}; pg8::gemm_phase<pg8::EpiMoeDown, pg8::MoeOrder<true, DM / 256>, true>(F.lds, g, S, E, F.wave);
        }
        REFRESH();
        {
            pg8::GridOrderSkip<T / 256, DM / 256> S; S.skip = (NTL * (DM / 256)) % pg8::GRID;
            pg8::Gemm g{WSP(bf16_t, WS_PB) + (size_t)T * 256, WSP(bf16_t, WS_WP1), 256, 256, 256};
            pg8::EpiBf16<false> E{WSP(bf16_t, WS_PP1), DM, 1.0f}; pg8::gemm_phase(F.lds, g, S, E, F.wave);
        }
        GRID_BAR();
    }
    PH(20) moe_combine_ln_phase(F, YH, WSP(bf16_t, WS_XBB), WSP(bf16_t, WS_SOUT), WSP(int, WS_TOKS), (const float*)args.in[18] + 2 * DM, (const float*)args.in[19] + 2 * DM, (const float*)args.in[18] + 3 * DM, (const float*)args.in[19] + 3 * DM);
    GRID_BAR();
    PH(21) {
        pg8::Gemm g{WSP(bf16_t, WS_XBB), WSP(bf16_t, WS_WG1), DM, DM, DM}; pg8::GridOrder<0, T / 256, DM / 256> S;
        pg8::EpiPle E{args.out, ws, 1}; pg8::gemm_phase<pg8::EpiPle, pg8::GridOrder<0, T / 256, DM / 256>, false, EPI_ALIGN_RES>(F.lds, g, S, E, F.wave);
    }
}

#undef YH
#undef bx
extern "C" void kernel_launch(void* const* d_in, const int* in_sizes, int n_in, void* d_out, int out_size, void* d_ws, size_t ws_size, hipStream_t stream) {
    static int grid = 0;
    if (grid == 0) {
        if (n_in != 22 || out_size != T * DM || ws_size < WS_END) { fprintf(stderr, "kernel_launch: unexpected problem (n_in %d, out %d, ws %zu < %zu)\n", n_in, out_size, ws_size, (size_t)WS_END); grid = -1; return; }
        int dev = 0, cus = 0;
        if (hipGetDevice(&dev) != hipSuccess || hipDeviceGetAttribute(&cus, hipDeviceAttributeMultiprocessorCount, dev) != hipSuccess) { grid = -1; return; }
        if (hipFuncSetAttribute((const void*)mega_fwd, hipFuncAttributeMaxDynamicSharedMemorySize, LDS_BYTES) != hipSuccess) { fprintf(stderr, "kernel_launch: hipFuncSetAttribute failed\n"); grid = -1; return; }
        int per_cu = 0;
        if (hipOccupancyMaxActiveBlocksPerMultiprocessor(&per_cu, (const void*)mega_fwd, NTHREADS, LDS_BYTES) != hipSuccess || per_cu < 1) { fprintf(stderr, "kernel_launch: occupancy query says %d\n", per_cu); }
        (void)hipGetLastError();
        if (cus != pg8::GRID) { fprintf(stderr, "kernel_launch: built for %d CUs, device has %d\n", pg8::GRID, cus); grid = -1; return; }
        grid = cus;
    }
    if (grid < 0) return;
    (void)hipMemsetAsync((char*)d_ws + WS_CTL, 0, CTL_ZERO_BYTES, stream);
    Args a{};
    for (int i = 0; i < 22; ++i) a.in[i] = d_in[i];
    a.out = (float*)d_out; a.ws = (unsigned char*)d_ws;
    hipLaunchKernelGGL(mega_fwd, dim3(grid), dim3(NTHREADS), LDS_BYTES, stream, a);
}
```

```cpp
#include <hip/hip_runtime.h>
#include <cstdio>
#include <cstdint>

#define LAS __attribute__((address_space(3)))
#define GAS __attribute__((address_space(1)))
typedef unsigned short bf16_t;
typedef short bf16x8 __attribute__((ext_vector_type(8)));
typedef short bf16x4 __attribute__((ext_vector_type(4)));
typedef float f32x2 __attribute__((ext_vector_type(2)));
typedef float f32x4 __attribute__((ext_vector_type(4)));
typedef float f32x16 __attribute__((ext_vector_type(16)));
typedef unsigned u32x2 __attribute__((ext_vector_type(2)));
typedef unsigned u32x4 __attribute__((ext_vector_type(4)));
typedef unsigned long long u64;
typedef int i32x4 __attribute__((ext_vector_type(4)));
typedef int i32x8 __attribute__((ext_vector_type(8)));

constexpr int T = 32768, SEQ = 16384, DM = 2048;
constexpr int FFN = 5632, MFFN = 7168, NEXP = 8;
constexpr int NQKV = 2560, NWIN = 4864;
constexpr float ALPHA = 1.41421356237309515f;
constexpr float LN_EPS = 1e-5f, RMS_EPS = 1e-6f;
constexpr float QSCALE_SWA = 0.18033688011112042f;
constexpr float SCALE2_MLA = 0.10411754627697264f;
constexpr float LOG2E = 1.4426950408889634f;
constexpr int NWAVES = 8, NTHREADS = 512;
constexpr float W13_F8SCALE = 32.0f;
constexpr bool F8_FFN1 = true, F8_FFN2 = true, F8_QKV = true, F8_WO0 = true, F8_WIN = false, F8_WO1 = true;
constexpr bool EPI_ALIGN_RES = true;
constexpr bool SWA_FRAG = true;
constexpr bool F8_LAT = true;
constexpr float QLAT_F8SCALE = 8.0f, OLAT_F8SCALE = 32.0f, WUV_F8SCALE = 16.0f;
constexpr bool F8_WIN_SPLIT = true;
constexpr int WIN_F8_TILES = 14;
constexpr float WQKV_F8SCALE = 32.0f, WIN_F8SCALE = 32.0f, WO_F8SCALE = 64.0f, O0_F8SCALE = 16.0f, O2_F8SCALE = 32.0f;
constexpr float ACT_F8SCALE = 16.0f, W2_F8SCALE = 128.0f;

constexpr size_t MiB = 1u << 20;
constexpr size_t WS_CTL = 0, CTL_ZERO_BYTES = 1 * MiB;
constexpr size_t WS_WQKV = 2 * MiB, WS_WO0 = 12 * MiB, WS_W13 = 20 * MiB, WS_W2 = 64 * MiB, WS_WG0 = 86 * MiB, WS_WG1 = 94 * MiB, WS_WP0 = 102 * MiB, WS_WP1 = 103 * MiB,
                 WS_WIN = 104 * MiB, WS_WUK = 123 * MiB, WS_WUV = 125 * MiB, WS_WO1 = 129 * MiB;
constexpr size_t WS_TAB64 = 137 * MiB, WS_TAB32 = 145 * MiB, WS_PB = 149 * MiB, WS_XBA = 181 * MiB, WS_XBB = 309 * MiB;
constexpr size_t WS_TOKE = 437 * MiB;
constexpr size_t WS_TOKG = WS_TOKE + 256 * 1024;
constexpr size_t WS_TOKL = WS_TOKG + 256 * 1024;
constexpr size_t WS_TOKS = WS_TOKL + 256 * 1024;
constexpr size_t WS_SGATE = WS_TOKS + 256 * 1024;
constexpr size_t WS_WI = 439 * MiB, WS_SEL = 441 * MiB, WS_R = 458 * MiB;
constexpr size_t WS_Q = WS_R, WS_K = WS_R + 128 * MiB, WS_VT = WS_R + 144 * MiB, WS_ACT = WS_R + 160 * MiB, WS_PP0 = WS_R + 512 * MiB, WS_O8 = WS_R + 640 * MiB, WS_XB8 = WS_R + 704 * MiB  , WS_WIN8 = WS_R + 768 * MiB  ;
constexpr size_t WS_QN = WS_R, WS_QR = WS_R + 128 * MiB, WS_CRAW = WS_R + 192 * MiB, WS_KV = WS_R + 256 * MiB, WS_QI = WS_R + 292 * MiB, WS_KIF = WS_R + 356 * MiB,
                 WS_QLAT = WS_R + 360 * MiB, WS_O2 = WS_R + 872 * MiB;
constexpr size_t WS_MW13 = WS_R + 1128 * MiB, WS_MW2 = WS_R + 1352 * MiB, WS_XG = WS_R, WS_SOUT = WS_R + 136 * MiB, WS_ACT2 = WS_R + 404 * MiB  , WS_PP1 = WS_R + 884 * MiB;
constexpr size_t WS_END = WS_R + 1464 * MiB;
constexpr int MAXSLOTS = 67840;
constexpr int CHUNK_TILES = 272;
constexpr int CW_TMO = 0, CW_CNT = 64  , CW_BAR = 4096;

constexpr int LDS_BYTES = 155648;
constexpr int MISC_OFF = 150016;
constexpr int DSA_WBUF = 18688;

typedef __bf16 bf16x2_t __attribute__((ext_vector_type(2)));
__device__ __forceinline__ unsigned cvt_pk_bf16(float lo, float hi) { const f32x2 v = {lo, hi}; return __builtin_bit_cast(unsigned, __builtin_convertvector(v, bf16x2_t)); }
__device__ __forceinline__ float bf2f(unsigned short h) { return __uint_as_float(((unsigned)h) << 16); }
__device__ __forceinline__ float bflo(unsigned w) { return __uint_as_float(w << 16); }
__device__ __forceinline__ float bfhi(unsigned w) { return __uint_as_float(w & 0xffff0000u); }
__device__ __forceinline__ int fresh_lane() { unsigned m = ~0u; asm volatile("" : "+v"(m)); return (int)__builtin_amdgcn_mbcnt_hi(m, __builtin_amdgcn_mbcnt_lo(m, 0u)); }
__device__ __forceinline__ float shx(float v, int o, int lane) { return __int_as_float(__builtin_amdgcn_ds_bpermute((lane ^ o) << 2, __float_as_int(v))); }
__device__ __forceinline__ float wave_sum(float v) {
    const int l = fresh_lane();
#pragma unroll
    for (int o = 1; o < 64; o <<= 1) v += shx(v, o, l);
    return v;
}
__device__ __forceinline__ unsigned pk4_fp8(float a, float b, float c, float d) { unsigned w = 0u; w = (unsigned)__builtin_amdgcn_cvt_pk_fp8_f32(a, b, (int)w, false); w = (unsigned)__builtin_amdgcn_cvt_pk_fp8_f32(c, d, (int)w, true); return w; }
#define LDS_WAIT() asm volatile("s_waitcnt lgkmcnt(0)" ::: "memory")
#define VM_WAIT() asm volatile("s_waitcnt vmcnt(0)" ::: "memory")

namespace pg8 {
constexpr int BM = 256, BK = 64, HALF = 128, HTB = HALF * BK * 2, STAGE_BYTES = 8 * HTB, NXCD = 8, WGM = 8;
__host__ __device__ __forceinline__ int lds_byte(int r, int c) { const int st = (r >> 4) * 2 + (c >> 5), rr = r & 15, cc = c & 31, ob = rr * 64 + cc * 2; return st * 1024 + (ob ^ (((ob >> 9) & 1) << 5)); }
__host__ __device__ __forceinline__ void stage_rc(int b, int& R, int& C) { const int st = b / 1024, sb = b % 1024, swz = sb ^ (((sb >> 9) & 1) << 5); R = (st >> 1) * 16 + swz / 64; C = (st & 1) * 32 + (swz % 64) / 2; }
__host__ __device__ __forceinline__ int perm32(int rho) { const int n = rho >> 4, i = rho & 15; return 8 * (i >> 2) + 4 * n + (i & 3); }

struct Unit { int pm, pn, am, acol, bn; };
struct Gemm { const bf16_t* A; const bf16_t* Bt; int lda, ldb, K; };

constexpr int GRID = 256;
template <int MODE, int NM, int NN> struct GridOrder {
    __device__ __forceinline__ bool next(int i, Unit& u) const {
        constexpr int nwg = NM * NN;
        int L = i * GRID + (int)blockIdx.x;
        if constexpr (MODE == 4) {
            if (i >= 6) { if ((int)blockIdx.x < GRID / 2 || i >= 8) return false; L = 6 * GRID + ((int)blockIdx.x - GRID / 2) * 2 + (i - 6); } }
        if (L >= nwg) return false;
        int wgid = L; { constexpr int q = nwg / NXCD, r = nwg % NXCD; const int xcd = wgid % NXCD, off = wgid / NXCD; wgid = (xcd < r ? xcd * (q + 1) : r * (q + 1) + (xcd - r) * q) + off; }
        constexpr int nig = WGM * NN; const int gid = wgid / nig, fm = gid * WGM, gsz = (NM - fm) < WGM ? (NM - fm) : WGM;
        u.pm = fm + ((wgid % nig) % gsz); u.pn = (wgid % nig) / gsz; u.am = u.pm; u.bn = u.pn;
        u.acol = MODE == 1 ? (u.pn >> 1) * 128 : (MODE == 2 ? u.pn * 1024 : (MODE == 3 ? u.pn * 512 : 0));
        return true;
    }
};
template <int NM, int NN> struct GridOrderSkip {
    int skip;
    __device__ __forceinline__ bool next(int i, Unit& u) const {
        constexpr int nwg = NM * NN; const int nW = GRID - skip, br = (int)blockIdx.x - skip; if (br < 0) return false;
        const int L = i * nW + br; if (L >= nwg) return false;
        int wgid = L; { constexpr int q = nwg / NXCD, r = nwg % NXCD; const int xcd = wgid % NXCD, off = wgid / NXCD; wgid = (xcd < r ? xcd * (q + 1) : r * (q + 1) + (xcd - r) * q) + off; }
        constexpr int nig = WGM * NN; const int gid = wgid / nig, fm = gid * WGM, gsz = (NM - fm) < WGM ? (NM - fm) : WGM;
        u.pm = fm + ((wgid % nig) % gsz); u.pn = (wgid % nig) / gsz; u.am = u.pm; u.bn = u.pn; u.acol = 0;
        return true;
    }
};
template <bool DOWN, int NN> struct MoeOrder {
    int tile0, ntl;
    __device__ __forceinline__ bool next(int i, Unit& u) const {
        int pml, pn;
        if constexpr (!DOWN && NN % 8 == 0) {
            constexpr int NJ = NN / 8; const int x = (int)blockIdx.x & 7, q = i * (GRID / 8) + ((int)blockIdx.x >> 3); if (q >= ntl * NJ) return false;
            const int nfull = ntl >> 3; int m, j;
            if (q < nfull * 8 * NJ) { const int b = q / (8 * NJ), w = q - b * (8 * NJ); m = b * 8 + (w & 7); j = w >> 3; }
            else { const int g = ntl - nfull * 8, w = q - nfull * 8 * NJ; j = w / g; m = nfull * 8 + (w - j * g); }
            pml = m; pn = 8 * j + x;
        } else {
        const int L = i * GRID + (int)blockIdx.x; if (L >= ntl * NN) return false;
        constexpr int nig = WGM * NN; const int wgid = L, gid = wgid / nig, fm = gid * WGM, gsz = (ntl - fm) < WGM ? (ntl - fm) : WGM;
        pml = fm + ((wgid % nig) % gsz); pn = (wgid % nig) / gsz; }
        const int pmg = tile0 + pml;
        const u32x4 t0 = *(const LAS u32x4*)(MISC_OFF + 20 * 4), t1 = *(const LAS u32x4*)(MISC_OFF + 24 * 4);
        int e = (pmg >= (int)t0.x) + (pmg >= (int)t0.y) + (pmg >= (int)t0.z) + (pmg >= (int)t0.w) + (pmg >= (int)t1.x) + (pmg >= (int)t1.y) + (pmg >= (int)t1.z);
        e = __builtin_amdgcn_readfirstlane(e);
        u.pn = pn; u.bn = e * NN + pn; u.acol = 0;
        if (DOWN) { u.pm = pmg; u.am = pml; } else { u.pm = pml; u.am = pmg; }
        return true;
    }
};

__device__ __forceinline__ void stage16_s(const char* gbase, unsigned voff, unsigned lds_dst) { unsigned keep;
    asm volatile("s_mov_b32 %0, m0\n\ts_mov_b32 m0, %3\n\ts_nop 0\n\tglobal_load_lds_dwordx4 %1, %2\n\ts_mov_b32 m0, %0" : "=&s"(keep) : "v"(voff), "s"(gbase), "s"(lds_dst) : "memory"); }
template <class Epi, class Sched, bool FP8 = false, bool ALIGN = true>
__device__ __forceinline__ void gemm_phase(LAS unsigned char* lds, const Gemm g, const Sched& S, const Epi& E, int wave_) {
    int tid_ = wave_ * 64 + fresh_lane(); asm volatile("" : "+v"(tid_));
    const int tid = tid_, wid = __builtin_amdgcn_readfirstlane(tid >> 6), lane = tid & 63, wr = wid >> 2, wc = wid & 3, fr = lane & 15, fq = lane >> 4;
    int K_ = g.K; asm volatile("" : "+s"(K_));
    const int K = K_, nt = K / BK;
    unsigned voffA[2], voffB[2];
#pragma unroll
    for (int i = 0; i < 2; ++i) { int R, C; stage_rc(tid * 16 + i * 8192, R, C); const int Rb = (R & ~31) + perm32(R & 31);
        voffA[i] = (unsigned)(R * g.lda + C) * 2u; voffB[i] = (unsigned)(Rb * g.ldb + C) * 2u; }
    const size_t kstep = (size_t)(BK * 2);
    const size_t hstepA = (size_t)HALF * g.lda * 2, hstepB = (size_t)HALF * g.ldb * 2;
    const unsigned ldsw = (unsigned)wid * 1024u;
    const int aoff = lds_byte(wr * 64 + fr, fq * 8), boff = lds_byte(wc * 32 + fr, fq * 8);
#define PG8_SA(b, h) (((b) * 2 + (h)) * HTB)
#define PG8_SB(b, h) ((4 + (b) * 2 + (h)) * HTB)
#define PG8_STAGE(bufoff, gbase, voff) do { _Pragma("unroll") for (int _i = 0; _i < 2; ++_i) { \
        if constexpr (FP8) stage16_s((const char*)(gbase), (voff)[_i], (unsigned)(size_t)(lds + (bufoff) + ldsw + _i * 8192)); \
        else __builtin_amdgcn_global_load_lds((const unsigned*)((const char*)(gbase) + (voff)[_i]), (LAS unsigned*)(lds + (bufoff) + ldsw + _i * 8192), 16, 0, 0); } } while (0)
#define PG8_LDA(dst, b, h) do { _Pragma("unroll") for (int m = 0; m < 4; ++m) _Pragma("unroll") for (int k = 0; k < 2; ++k) dst[m][k] = *(const LAS bf16x8*)(lds + PG8_SA(b, h) + aoff + m * 2048 + k * 1024); } while (0)
#define PG8_LDB(dst, b, h) do { _Pragma("unroll") for (int n = 0; n < 2; ++n) _Pragma("unroll") for (int k = 0; k < 2; ++k) dst[n][k] = *(const LAS bf16x8*)(lds + PG8_SB(b, h) + boff + n * 2048 + k * 1024); } while (0)
#define PG8_MMA(ai, bj, At, Bt) do { __builtin_amdgcn_s_setprio(1); _Pragma("unroll") for (int m = 0; m < 4; ++m) _Pragma("unroll") for (int n = 0; n < 2; ++n) _Pragma("unroll") for (int k = 0; k < 2; ++k) \
        acc[ai][bj][m][n] = __builtin_amdgcn_mfma_f32_16x16x32_bf16(Bt[n][k], At[m][k], acc[ai][bj][m][n], 0, 0, 0); __builtin_amdgcn_s_setprio(0); } while (0)
#define PG8_LDA8(dst, b, h) do { _Pragma("unroll") for (int m = 0; m < 4; ++m) { const i32x4 lo_ = *(const LAS i32x4*)(lds + PG8_SA(b, h) + aoff + m * 2048), hi_ = *(const LAS i32x4*)(lds + PG8_SA(b, h) + aoff + m * 2048 + 1024); \
        dst[m] = __builtin_shufflevector(lo_, hi_, 0, 1, 2, 3, 4, 5, 6, 7); } } while (0)
#define PG8_LDB8(dst, b, h) do { _Pragma("unroll") for (int n = 0; n < 2; ++n) { const i32x4 lo_ = *(const LAS i32x4*)(lds + PG8_SB(b, h) + boff + n * 2048), hi_ = *(const LAS i32x4*)(lds + PG8_SB(b, h) + boff + n * 2048 + 1024); \
        dst[n] = __builtin_shufflevector(lo_, hi_, 0, 1, 2, 3, 4, 5, 6, 7); } } while (0)
#define PG8_MMA8(ai, bj, At, Bt) do { __builtin_amdgcn_s_setprio(1); _Pragma("unroll") for (int m = 0; m < 4; ++m) _Pragma("unroll") for (int n = 0; n < 2; ++n) \
        acc[ai][bj][m][n] = __builtin_amdgcn_mfma_scale_f32_16x16x128_f8f6f4(Bt[n], At[m], acc[ai][bj][m][n], 0, 0, 0, 0, 0, 0); __builtin_amdgcn_s_setprio(0); } while (0)
#define PG8_WAIT_V(n) asm volatile("s_waitcnt vmcnt(" #n ")" ::: "memory")
#define PG8_WAIT_L(n) asm volatile("s_waitcnt lgkmcnt(" #n ")" ::: "memory")
#define PG8_BAR __builtin_amdgcn_s_barrier()
#define PG8_SCHED __builtin_amdgcn_sched_barrier(0)
#define PG8_ABASE(u) ((const char*)g.A + ((size_t)(u).am * BM * g.lda + (size_t)(u).acol) * 2)
#define PG8_BBASE(u) ((const char*)g.Bt + (size_t)(u).bn * BM * g.ldb * 2)
    Unit cur, nxt; int ui = 0;
    if (!S.next(0, cur)) return;
    f32x4 acc[2][2][4][2];
#pragma unroll
    for (int a = 0; a < 2; ++a)
#pragma unroll
        for (int b = 0; b < 2; ++b)
#pragma unroll
            for (int m = 0; m < 4; ++m)
#pragma unroll
                for (int n = 0; n < 2; ++n) acc[a][b][m][n] = (f32x4){0.f, 0.f, 0.f, 0.f};
    bf16x8 At[4][2], B0[2][2], B1[2][2]; i32x8 At8[4], B08[2], B18[2];
    const char* cA = PG8_ABASE(cur); const char* cB = PG8_BBASE(cur);
    {
        PG8_STAGE(PG8_SB(0, 0), cB, voffB); PG8_STAGE(PG8_SB(0, 1), cB + hstepB, voffB); PG8_STAGE(PG8_SA(0, 0), cA, voffA); PG8_STAGE(PG8_SA(0, 1), cA + hstepA, voffA);
        if (wr == 1) PG8_BAR;
        PG8_WAIT_V(2); PG8_BAR;
        PG8_STAGE(PG8_SB(1, 0), cB + kstep, voffB); PG8_STAGE(PG8_SA(1, 0), cA + kstep, voffA); PG8_STAGE(PG8_SB(1, 1), cB + hstepB + kstep, voffB);
        PG8_WAIT_V(6); PG8_BAR;
    }
    for (;;) {
        const bool has_next = S.next(ui + 1, nxt);
        const char* nA = has_next ? PG8_ABASE(nxt) : cA; const char* nB = has_next ? PG8_BBASE(nxt) : cB;
        for (int t = 0; t < nt; t += 2) {
            const bool last = (t == nt - 2);
            const char* a1 = cA + (size_t)(t + 1) * kstep;
            const char* a2 = last ? nA : cA + (size_t)(t + 2) * kstep; const char* b2 = last ? nB : cB + (size_t)(t + 2) * kstep;
            const char* a3 = a2 + kstep; const char* b3 = b2 + kstep;
            if constexpr (FP8) {
            PG8_LDB8(B08, 0, 0); PG8_LDB8(B18, 0, 1); PG8_SCHED; PG8_LDA8(At8, 0, 0); PG8_STAGE(PG8_SA(1, 1), a1 + hstepA, voffA);
            PG8_WAIT_V(8); PG8_WAIT_L(0); PG8_BAR; PG8_MMA8(0, 0, At8, B08); PG8_MMA8(0, 1, At8, B18); PG8_BAR; PG8_SCHED;
            PG8_LDA8(At8, 0, 1); PG8_STAGE(PG8_SB(0, 0), b2, voffB); PG8_STAGE(PG8_SB(0, 1), b2 + hstepB, voffB); PG8_STAGE(PG8_SA(0, 0), a2, voffA);
            PG8_WAIT_V(8); PG8_WAIT_L(0); PG8_BAR; PG8_MMA8(1, 0, At8, B08); PG8_MMA8(1, 1, At8, B18); PG8_BAR; PG8_SCHED;
            PG8_LDB8(B08, 1, 0); PG8_LDB8(B18, 1, 1); PG8_SCHED; PG8_LDA8(At8, 1, 0); PG8_STAGE(PG8_SA(0, 1), a2 + hstepA, voffA);
            PG8_WAIT_V(8); PG8_WAIT_L(0); PG8_BAR; PG8_MMA8(0, 0, At8, B08); PG8_MMA8(0, 1, At8, B18); PG8_BAR; PG8_SCHED;
            PG8_LDA8(At8, 1, 1); PG8_STAGE(PG8_SB(1, 0), b3, voffB); PG8_STAGE(PG8_SB(1, 1), b3 + hstepB, voffB); PG8_STAGE(PG8_SA(1, 0), a3, voffA);
            PG8_WAIT_V(8); PG8_WAIT_L(0); PG8_BAR; PG8_MMA8(1, 0, At8, B08); PG8_MMA8(1, 1, At8, B18); PG8_BAR; PG8_SCHED;
            } else {
            PG8_LDB(B0, 0, 0); PG8_LDB(B1, 0, 1); PG8_SCHED; PG8_LDA(At, 0, 0); PG8_STAGE(PG8_SA(1, 1), a1 + hstepA, voffA);
            PG8_WAIT_V(8); PG8_WAIT_L(0); PG8_BAR; PG8_MMA(0, 0, At, B0); PG8_MMA(0, 1, At, B1); PG8_BAR; PG8_SCHED;
            PG8_LDA(At, 0, 1); PG8_STAGE(PG8_SB(0, 0), b2, voffB); PG8_STAGE(PG8_SB(0, 1), b2 + hstepB, voffB); PG8_STAGE(PG8_SA(0, 0), a2, voffA);
            PG8_WAIT_V(8); PG8_WAIT_L(0); PG8_BAR; PG8_MMA(1, 0, At, B0); PG8_MMA(1, 1, At, B1); PG8_BAR; PG8_SCHED;
            PG8_LDB(B0, 1, 0); PG8_LDB(B1, 1, 1); PG8_SCHED; PG8_LDA(At, 1, 0); PG8_STAGE(PG8_SA(0, 1), a2 + hstepA, voffA);
            PG8_WAIT_V(8); PG8_WAIT_L(0); PG8_BAR; PG8_MMA(0, 0, At, B0); PG8_MMA(0, 1, At, B1); PG8_BAR; PG8_SCHED;
            PG8_LDA(At, 1, 1); PG8_STAGE(PG8_SB(1, 0), b3, voffB); PG8_STAGE(PG8_SB(1, 1), b3 + hstepB, voffB); PG8_STAGE(PG8_SA(1, 0), a3, voffA);
            PG8_WAIT_V(8); PG8_WAIT_L(0); PG8_BAR; PG8_MMA(1, 0, At, B0); PG8_MMA(1, 1, At, B1); PG8_BAR; PG8_SCHED;
            }
        }
        if constexpr (ALIGN) { if (wr == 0) PG8_BAR; }
        { int fr_ = fr, fq_ = fq; asm volatile("" : "+v"(fr_), "+v"(fq_));
          E(acc, cur, wr, wc, fr_, fq_); }
        if (!has_next) break;
#pragma unroll
        for (int a = 0; a < 2; ++a)
#pragma unroll
            for (int b = 0; b < 2; ++b)
#pragma unroll
                for (int m = 0; m < 4; ++m)
#pragma unroll
                    for (int n = 0; n < 2; ++n) acc[a][b][m][n] = (f32x4){0.f, 0.f, 0.f, 0.f};
        cur = nxt; cA = nA; cB = nB; ++ui;
        if constexpr (ALIGN) { if (wr == 1) PG8_BAR; }
    }
    PG8_WAIT_V(0);
    if constexpr (!ALIGN) { if (wr == 0) PG8_BAR; }
    PG8_BAR;
#undef PG8_SA
#undef PG8_SB
#undef PG8_STAGE
#undef PG8_LDA
#undef PG8_LDB
#undef PG8_MMA
#undef PG8_LDA8
#undef PG8_LDB8
#undef PG8_MMA8
#undef PG8_WAIT_V
#undef PG8_WAIT_L
#undef PG8_BAR
#undef PG8_SCHED
#undef PG8_ABASE
#undef PG8_BBASE
}

#define EPI_ROW(ai, m) (u.pm * BM + (ai) * HALF + wr * 64 + (m) * 16 + fr)
#define EPI_COL(bj) (u.pn * BM + (bj) * HALF + wc * 32 + 8 * fq)
typedef f32x4 AccT[2][2][4][2];

__device__ __forceinline__ void rope4(f32x4& v0, f32x4& v1, const f32x4 cs0, const f32x4 cs1) {
    f32x4 o0, o1;
    o0[0] = v0[0] * cs0[0] - v0[1] * cs0[1]; o0[1] = v0[1] * cs0[0] + v0[0] * cs0[1];
    o0[2] = v0[2] * cs0[2] - v0[3] * cs0[3]; o0[3] = v0[3] * cs0[2] + v0[2] * cs0[3];
    o1[0] = v1[0] * cs1[0] - v1[1] * cs1[1]; o1[1] = v1[1] * cs1[0] + v1[0] * cs1[1];
    o1[2] = v1[2] * cs1[2] - v1[3] * cs1[3]; o1[3] = v1[3] * cs1[2] + v1[2] * cs1[3];
    v0 = o0; v1 = o1;
}
__device__ __forceinline__ u32x4 pack8(const f32x4 v0, const f32x4 v1) { u32x4 w; w.x = cvt_pk_bf16(v0[0], v0[1]); w.y = cvt_pk_bf16(v0[2], v0[3]); w.z = cvt_pk_bf16(v1[0], v1[1]); w.w = cvt_pk_bf16(v1[2], v1[3]); return w; }

__device__ __forceinline__ void unpack8(const u32x4 w, f32x4& a, f32x4& b) { a[0] = bflo(w.x); a[1] = bfhi(w.x); a[2] = bflo(w.y); a[3] = bfhi(w.y); b[0] = bflo(w.z); b[1] = bfhi(w.z); b[2] = bflo(w.w); b[3] = bfhi(w.w); }
__device__ __forceinline__ u32x2 pack8_fp8(const f32x4 v0, const f32x4 v1, float s) { u32x2 w; w.x = pk4_fp8(v0[0] * s, v0[1] * s, v0[2] * s, v0[3] * s); w.y = pk4_fp8(v1[0] * s, v1[1] * s, v1[2] * s, v1[3] * s); return w; }
template <bool OUT8> struct EpiBf16 {
    bf16_t* O; int ldc; float osc;
    __device__ __forceinline__ void operator()(const AccT& acc, const Unit& u, int wr, int wc, int fr, int fq) const {
#pragma unroll
        for (int ai = 0; ai < 2; ++ai)
#pragma unroll
            for (int m = 0; m < 4; ++m) {
#pragma unroll
                for (int bj = 0; bj < 2; ++bj) {
                    if constexpr (OUT8) *(u32x2*)((unsigned char*)O + (size_t)EPI_ROW(ai, m) * ldc + EPI_COL(bj)) = pack8_fp8(acc[ai][bj][m][0], acc[ai][bj][m][1], osc);
                    else *(u32x4*)(O + (size_t)EPI_ROW(ai, m) * ldc + EPI_COL(bj)) = pack8(acc[ai][bj][m][0] * osc, acc[ai][bj][m][1] * osc); } }
    }
};
struct EpiQKV {
    unsigned char* ws; float asc;
    __device__ __forceinline__ void operator()(const AccT& acc, const Unit& u, int wr, int wc, int fr, int fq) const {
        bf16_t* Q = (bf16_t*)(ws + WS_Q); bf16_t* Kb = (bf16_t*)(ws + WS_K); bf16_t* VT = (bf16_t*)(ws + WS_VT); const float* tab64 = (const float*)(ws + WS_TAB64);
        if (u.pn < 9) {
            bf16_t* base = u.pn < 8 ? Q : Kb; const int ldc = u.pn < 8 ? 2048 : 256; const int colt = u.pn < 8 ? u.pn * BM : 0; const float sc = (u.pn < 8 ? QSCALE_SWA : 1.0f) * asc;
#pragma unroll
            for (int ai = 0; ai < 2; ++ai)
#pragma unroll
                for (int m = 0; m < 4; ++m) { const int row = EPI_ROW(ai, m);
#pragma unroll
                    for (int bj = 0; bj < 2; ++bj) { const int cl = bj * HALF + wc * 32 + 8 * fq; const int i0 = (cl & 63) >> 1;
                        const f32x4 cs0 = *(const f32x4*)(tab64 + ((size_t)row * 32 + i0) * 2), cs1 = *(const f32x4*)(tab64 + ((size_t)row * 32 + i0) * 2 + 4);
                        f32x4 v0 = acc[ai][bj][m][0], v1 = acc[ai][bj][m][1]; rope4(v0, v1, cs0, cs1); v0 = v0 * sc; v1 = v1 * sc;
                        if constexpr (SWA_FRAG) {
                            const int b = row >> 14, s = row & (SEQ - 1), hh = (colt + cl) >> 6, c64 = cl & 63, kk = c64 >> 4, hf2 = (c64 >> 3) & 1, nh = u.pn < 8 ? 32 : 4;
                            *(u32x4*)(base + ((((size_t)(b * nh + hh) * 512 + (s >> 5)) * 4 + kk) * 64 + hf2 * 32 + (s & 31)) * 8) = pack8(v0, v1); }
                        else *(u32x4*)(base + (size_t)row * ldc + colt + cl) = pack8(v0, v1); } }
        } else {
#pragma unroll
            for (int ai = 0; ai < 2; ++ai)
#pragma unroll
                for (int m = 0; m < 4; ++m) { const int row = EPI_ROW(ai, m), b = row >> 14, s = row & (SEQ - 1);
#pragma unroll
                    for (int bj = 0; bj < 2; ++bj) { const int cl = bj * HALF + wc * 32 + 8 * fq, kvh = cl >> 6, d0 = cl & 63;
                        const u32x4 w = pack8(acc[ai][bj][m][0] * asc, acc[ai][bj][m][1] * asc);
                        if constexpr (SWA_FRAG) {
                            const int j = s & 31, c = j >> 4, jj = j & 15, hfv = (jj & 7) >> 2, e = (jj & 3) + ((jj >> 3) << 2), mt = d0 >> 5;
                            bf16_t* pf = VT + (((((size_t)(b * 4 + kvh) * 512 + (s >> 5)) * 2 + c) * 2 + mt) * 64 + hfv * 32 + (d0 & 31)) * 8 + e;
                            pf[0] = (bf16_t)(w.x & 0xffff); pf[8] = (bf16_t)(w.x >> 16); pf[16] = (bf16_t)(w.y & 0xffff); pf[24] = (bf16_t)(w.y >> 16);
                            pf[32] = (bf16_t)(w.z & 0xffff); pf[40] = (bf16_t)(w.z >> 16); pf[48] = (bf16_t)(w.w & 0xffff); pf[56] = (bf16_t)(w.w >> 16); }
                        else {
                        bf16_t* p = VT + ((size_t)(b * 4 + kvh) * 64 + d0) * SEQ + s;
                        p[0 * SEQ] = (bf16_t)(w.x & 0xffff); p[1 * SEQ] = (bf16_t)(w.x >> 16); p[2 * SEQ] = (bf16_t)(w.y & 0xffff); p[3 * SEQ] = (bf16_t)(w.y >> 16);
                        p[4 * SEQ] = (bf16_t)(w.z & 0xffff); p[5 * SEQ] = (bf16_t)(w.z >> 16); p[6 * SEQ] = (bf16_t)(w.w & 0xffff); p[7 * SEQ] = (bf16_t)(w.w >> 16); } } }
        }
    }
};
template <bool RES16> struct EpiRes {
    const void* res; bf16_t* out; float sc;
    __device__ __forceinline__ void operator()(const AccT& acc, const Unit& u, int wr, int wc, int fr, int fq) const {
#pragma unroll
        for (int ai = 0; ai < 2; ++ai)
#pragma unroll
            for (int m = 0; m < 4; ++m) { const size_t ro = (size_t)EPI_ROW(ai, m) * DM;
#pragma unroll
                for (int bj = 0; bj < 2; ++bj) { const size_t o = ro + EPI_COL(bj); f32x4 r0, r1;
                    if constexpr (RES16) unpack8(*(const u32x4*)((const bf16_t*)res + o), r0, r1);
                    else { r0 = *(const f32x4*)((const float*)res + o); r1 = *(const f32x4*)((const float*)res + o + 4); }
                    *(u32x4*)(out + o) = pack8(r0 * ALPHA + acc[ai][bj][m][0] * sc, r1 * ALPHA + acc[ai][bj][m][1] * sc); }
                asm volatile("" ::: "memory"); }
    }
};
__device__ __forceinline__ float silu_mul(float g, float uu) { return g * __builtin_amdgcn_rcpf(1.0f + __builtin_amdgcn_exp2f(-g * LOG2E)) * uu; }
template <bool OUT8> struct EpiSwiglu {
    bf16_t* O; int ldc; float sc; float osc;
    __device__ __forceinline__ void operator()(const AccT& acc, const Unit& u, int wr, int wc, int fr, int fq) const {
#pragma unroll
        for (int ai = 0; ai < 2; ++ai)
#pragma unroll
            for (int m = 0; m < 4; ++m) { f32x4 a0, a1;
#pragma unroll
                for (int j = 0; j < 4; ++j) { a0[j] = silu_mul(acc[ai][0][m][0][j] * sc, acc[ai][1][m][0][j] * sc); a1[j] = silu_mul(acc[ai][0][m][1][j] * sc, acc[ai][1][m][1][j] * sc); }
                if constexpr (OUT8) { u32x2 w8; w8.x = pk4_fp8(a0[0] * osc, a0[1] * osc, a0[2] * osc, a0[3] * osc); w8.y = pk4_fp8(a1[0] * osc, a1[1] * osc, a1[2] * osc, a1[3] * osc);
                    *(u32x2*)((unsigned char*)O + (size_t)EPI_ROW(ai, m) * ldc + u.pn * HALF + wc * 32 + 8 * fq) = w8; }
                else *(u32x4*)(O + (size_t)EPI_ROW(ai, m) * ldc + u.pn * HALF + wc * 32 + 8 * fq) = pack8(a0, a1); }
    }
};
struct EpiPle {
    float* outf; unsigned char* ws; int layer;
    __device__ __forceinline__ void operator()(const AccT& acc, const Unit& u, int wr, int wc, int fr, int fq) const {
        const bf16_t* pp = (const bf16_t*)(ws + (layer == 0 ? WS_PP0 : WS_PP1));
        const bf16_t* xres = (const bf16_t*)(ws + (layer == 0 ? WS_XBA : WS_XBB));
#pragma unroll
        for (int ai = 0; ai < 2; ++ai)
#pragma unroll
            for (int m = 0; m < 4; ++m) { const size_t ro = (size_t)EPI_ROW(ai, m) * DM;
#pragma unroll
                for (int bj = 0; bj < 2; ++bj) { const size_t o = ro + EPI_COL(bj);
                    f32x4 r0, r1, p0, p1; unpack8(*(const u32x4*)(xres + o), r0, r1); unpack8(*(const u32x4*)(pp + o), p0, p1);
                    f32x4 s0, s1;
#pragma unroll
                    for (int j = 0; j < 4; ++j) { s0[j] = __builtin_amdgcn_rcpf(1.0f + __builtin_amdgcn_exp2f(-acc[ai][bj][m][0][j] * LOG2E)); s1[j] = __builtin_amdgcn_rcpf(1.0f + __builtin_amdgcn_exp2f(-acc[ai][bj][m][1][j] * LOG2E)); }
                    const f32x4 o0 = r0 + s0 * p0, o1 = r1 + s1 * p1;
                    if (layer == 0) { *(u32x4*)((bf16_t*)(ws + WS_XBB) + o) = pack8(o0, o1);
                                      if constexpr (F8_WIN_SPLIT || F8_WIN) *(u32x2*)(ws + WS_XB8 + o) = pack8_fp8(o0, o1, 1.0f); }
                    else { *(f32x4*)(outf + o) = o0; *(f32x4*)(outf + o + 4) = o1; } }
                asm volatile("" ::: "memory"); }
    }
};
struct EpiWin {
    unsigned char* ws; float asc; int pn0;
    __device__ __forceinline__ void operator()(const AccT& acc, const Unit& u, int wr, int wc, int fr, int fq) const {
        bf16_t* QN = (bf16_t*)(ws + WS_QN); bf16_t* QR = (bf16_t*)(ws + WS_QR); float* CRAW = (float*)(ws + WS_CRAW); bf16_t* KV = (bf16_t*)(ws + WS_KV); bf16_t* QI = (bf16_t*)(ws + WS_QI);
        bf16_t* KIF = (bf16_t*)(ws + WS_KIF); float* WI = (float*)(ws + WS_WI); const float* tab64 = (const float*)(ws + WS_TAB64); const float* tab32 = (const float*)(ws + WS_TAB32);
        const int pn = u.pn + pn0;
#pragma unroll
        for (int ai = 0; ai < 2; ++ai)
#pragma unroll
            for (int m = 0; m < 4; ++m) { const int row = EPI_ROW(ai, m);
#pragma unroll
                for (int bj = 0; bj < 2; ++bj) { const int cl = bj * HALF + wc * 32 + 8 * fq; f32x4 v0 = acc[ai][bj][m][0] * asc, v1 = acc[ai][bj][m][1] * asc;
                    if (pn < 8) { *(u32x4*)(QN + (size_t)row * 2048 + pn * BM + cl) = pack8(v0, v1); }
                    else if (pn < 12) { const int i0 = (cl & 63) >> 1;
                        const f32x4 cs0 = *(const f32x4*)(tab64 + ((size_t)row * 32 + i0) * 2), cs1 = *(const f32x4*)(tab64 + ((size_t)row * 32 + i0) * 2 + 4);
                        rope4(v0, v1, cs0, cs1); if constexpr (F8_LAT) { v0 = v0 * QLAT_F8SCALE; v1 = v1 * QLAT_F8SCALE; }
                        *(u32x4*)(QR + (size_t)row * 1024 + (pn - 8) * BM + cl) = pack8(v0, v1); }
                    else if (pn < 14) { float* p = CRAW + (size_t)row * 512 + (pn - 12) * BM + cl; *(f32x4*)p = v0; *(f32x4*)(p + 4) = v1; }
                    else if (pn == 14) {
                        if (cl < 64) { const int i0 = cl >> 1;
                            const f32x4 cs0 = *(const f32x4*)(tab64 + ((size_t)row * 32 + i0) * 2), cs1 = *(const f32x4*)(tab64 + ((size_t)row * 32 + i0) * 2 + 4);
                            rope4(v0, v1, cs0, cs1); *(u32x4*)(KV + (size_t)row * 576 + 512 + cl) = pack8(v0, v1); }
                        else if (cl < 128) { const int d8 = cl - 64;
                            if (d8 < 32) { const int i0 = d8 >> 1;
                                const f32x4 cs0 = *(const f32x4*)(tab32 + ((size_t)row * 16 + i0) * 2), cs1 = *(const f32x4*)(tab32 + ((size_t)row * 16 + i0) * 2 + 4);
                                rope4(v0, v1, cs0, cs1); }
                            const int b = row >> 14, s = row & (SEQ - 1), blk = s >> 5, j = s & 31, kk = d8 >> 4, hf = (d8 >> 3) & 1;
                            *(u32x4*)(KIF + ((size_t)((b * 512 + blk) * 4 + kk) * 64 + hf * 32 + j) * 8) = pack8(v0, v1); }
                        else if (cl < 144) { float* p = WI + (size_t)row * 16 + (cl - 128); *(f32x4*)p = v0; *(f32x4*)(p + 4) = v1; }
                    } else { const int cq = (pn - 15) * BM + cl, d8 = cq & 63;
                        if (d8 < 32) { const int i0 = d8 >> 1;
                            const f32x4 cs0 = *(const f32x4*)(tab32 + ((size_t)row * 16 + i0) * 2), cs1 = *(const f32x4*)(tab32 + ((size_t)row * 16 + i0) * 2 + 4);
                            rope4(v0, v1, cs0, cs1); }
                        *(u32x4*)(QI + (size_t)row * 1024 + cq) = pack8(v0, v1); }
                } }
    }
};
struct EpiMoeDown {
    unsigned char* ws;
    __device__ __forceinline__ void operator()(const AccT& acc, const Unit& u, int wr, int wc, int fr, int fq) const {
        bf16_t* O = (bf16_t*)(ws + WS_SOUT); const float* gate = (const float*)(ws + WS_SGATE);
#pragma unroll
        for (int ai = 0; ai < 2; ++ai)
#pragma unroll
            for (int m = 0; m < 4; ++m) { const int row = EPI_ROW(ai, m); const float gt = gate[row] * (1.0f / (ACT_F8SCALE * W2_F8SCALE)); bf16_t* rowp = O + (size_t)row * DM;
#pragma unroll
                for (int bj = 0; bj < 2; ++bj) *(u32x4*)(rowp + EPI_COL(bj)) = pack8(acc[ai][bj][m][0] * gt, acc[ai][bj][m][1] * gt); }
    }
};
}

#define XB_TMO      128
#define XB_XCNT(j)  (256  + 64 * (j))
#define XB_XSUB(j)  (1280 + 64 * (j))
#define XB_XGEN(j)  (2304 + 64 * (j))
#define XB_TOP      3328
#define XB_TOPGEN   3392
#define XCD_BAR_WORDS 3456
#define XB_SPIN_CAP (1u << 22)

__device__ __forceinline__ unsigned xb_ld(unsigned* p)              { return __hip_atomic_load(p, __ATOMIC_RELAXED, __HIP_MEMORY_SCOPE_AGENT); }
__device__ __forceinline__ unsigned xb_add(unsigned* p, unsigned v) { return __hip_atomic_fetch_add(p, v, __ATOMIC_RELAXED, __HIP_MEMORY_SCOPE_AGENT); }
__device__ __forceinline__ unsigned xb_xcc_id() { return (unsigned)__builtin_amdgcn_s_getreg((3 << 11) | 20) & 0xFu; }
#define XB_SPIN(cond, bar) do { unsigned _sp = 0; while (cond) { __builtin_amdgcn_s_sleep(1); \
    if ((++_sp & 255u) == 0u) { if (xb_ld(&(bar)[XB_TMO])) break; if (_sp > XB_SPIN_CAP) { atomicAdd(&(bar)[XB_TMO], 1u); break; } } } } while (0)

struct XcdBarrier { unsigned* bar; unsigned x; volatile LAS unsigned* st; };

__device__ __forceinline__ XcdBarrier xcd_barrier_post(unsigned* bar, volatile LAS unsigned* st) {
    XcdBarrier b; b.bar = bar; b.x = xb_xcc_id(); b.st = st;
    if (threadIdx.x == 0) (void)xb_add(&bar[XB_XCNT(b.x)], 1u);
    return b;
}
__device__ __forceinline__ void xcd_barrier_complete(unsigned* bar, unsigned x, unsigned& nloc, unsigned& nx) {
    const unsigned G = gridDim.x * gridDim.y * gridDim.z;
    unsigned sum, cnt, mine, sp = 0u;
    for (;;) {
        sum = 0u; cnt = 0u; mine = 0u;
#pragma unroll
        for (unsigned j = 0; j < 16; ++j) { const unsigned c = xb_ld(&bar[XB_XCNT(j)]); sum += c; cnt += (c > 0u) ? 1u : 0u; mine = (j == x) ? c : mine; }
        if (sum == G) break;
        __builtin_amdgcn_s_sleep(1);
        if ((++sp & 255u) == 0u) { if (xb_ld(&bar[XB_TMO])) break; if (sp > XB_SPIN_CAP) { atomicAdd(&bar[XB_TMO], 1u); break; } }
    }
    nloc = mine > 0u ? mine : 1u; nx = cnt > 0u ? cnt : 1u;
}
__device__ __forceinline__ void xcd_barrier(const XcdBarrier& b, int wave_) {
    asm volatile("s_waitcnt vmcnt(0)" ::: "memory");
    __syncthreads();
    int tl_ = wave_ * 64 + fresh_lane();
    if (tl_ == 0) {
        unsigned* bar = b.bar;
        __builtin_amdgcn_s_waitcnt(0);
        unsigned nloc = b.st[0], nx = b.st[1];
        if (nloc == 0u) { xcd_barrier_complete(bar, b.x, nloc, nx); b.st[0] = nloc; b.st[1] = nx; }
        const unsigned old = xb_add(&bar[XB_XSUB(b.x)], 1u);
        const unsigned gen = old / nloc;
        if (old + 1u == (gen + 1u) * nloc) {
            __builtin_amdgcn_fence(__ATOMIC_RELEASE, "agent");
            asm volatile("s_waitcnt vmcnt(0)" ::: "memory");
            const unsigned og = xb_add(&bar[XB_TOP], 1u);
            const unsigned tg = og / nx;
            if (og + 1u == (tg + 1u) * nx) xb_add(&bar[XB_TOPGEN], 1u);
            else XB_SPIN(xb_ld(&bar[XB_TOPGEN]) == tg, bar);
            __builtin_amdgcn_fence(__ATOMIC_ACQUIRE, "agent");
            xb_add(&bar[XB_XGEN(b.x)], 1u);
            asm volatile("s_waitcnt vmcnt(0)" ::: "memory");
        } else {
            XB_SPIN(xb_ld(&bar[XB_XGEN(b.x)]) == gen, bar);
            __builtin_amdgcn_fence(__ATOMIC_ACQUIRE, "agent");
            asm volatile("s_waitcnt vmcnt(0)" ::: "memory");
        }
    }
    __syncthreads();
}

struct Args { const void* in[22]; float* out; unsigned char* ws; };
struct Frame {
    LAS unsigned char* lds; volatile LAS unsigned* MISC; unsigned* ctl;
    int tid, lane, wave, gw; static constexpr int G = 256;
};
__device__ __forceinline__ void glds16(const void* g, LAS void* l) { __builtin_amdgcn_global_load_lds((const unsigned*)g, (LAS unsigned*)l, 16, 0, 0); }
__device__ __forceinline__ int mbcnt64(u64 m) { return (int)__builtin_amdgcn_mbcnt_hi((unsigned)(m >> 32), __builtin_amdgcn_mbcnt_lo((unsigned)m, 0u)); }

__device__ __forceinline__ int il64(int d) { return d < 32 ? 2 * d : 2 * (d - 32) + 1; }
__device__ __forceinline__ int il32(int d) { return d < 16 ? 2 * d : (d < 32 ? 2 * (d - 16) + 1 : d); }
__device__ __forceinline__ int map_row(int mode, int n) {
    if (mode == 1) return n < 2304 ? (n & ~63) + il64(n & 63) : n;
    if (mode == 2) return ((n >> 7) << 8) + (n & 127);
    if (mode == 3) return ((n >> 7) << 8) + 128 + (n & 127);
    if (mode == 4) {
        if (n < 3072) { const int h = n / 192, r = n - h * 192; return r < 128 ? h * 128 + r : 2048 + h * 64 + il64(r - 128); }
        if (n < 3584) return n;
        if (n < 3648) return 3584 + il64(n - 3584);
        if (n < 4672) { const int j = n - 3648; return 3840 + (j & ~63) + il32(j & 63); }
        if (n < 4736) return 3648 + il32(n - 4672);
        return 3712 + (n - 4736);
    }
    return n;
}
__device__ __forceinline__ void tr_item(const float* __restrict__ W, int N, bf16_t* WT, int ldo, int kofs, int mode, LAS float* scr, int item, int lane, float f8scale = 0.f, int rlo = 0, int rhi = 1 << 30) {
    const int nblk = (N + 63) >> 6, kb = item / nblk, nb = item - kb * nblk, k0 = 64 * kb, n0 = 64 * nb;
    const int nc = n0 + 4 * (lane & 15); const bool okr = nc < N; const float* wp = W + (size_t)(k0 + (lane >> 4)) * N + nc;
    f32x4 v[16];
#pragma unroll
    for (int i = 0; i < 16; ++i) v[i] = okr ? *(const f32x4*)(wp + (size_t)(4 * i) * N) : (f32x4){0.f, 0.f, 0.f, 0.f};
#pragma unroll
    for (int i = 0; i < 16; ++i) { const int k = 4 * i + (lane >> 4); *(LAS f32x4*)(scr + k * 64 + ((4 * (lane & 15) + 4 * (i >> 1)) & 63)) = v[i]; }
    LDS_WAIT();
    const int c = lane & 7;
#pragma unroll
    for (int j = 0; j < 8; ++j) { const int nl = (lane >> 3) + 8 * j, n = n0 + nl; const LAS float* s = scr + (8 * c) * 64 + ((nl + 4 * c) & 63);
        const int orow = map_row(mode, n); const bool okw = n < N && orow >= rlo && orow < rhi;
        if (f8scale > 0.f) { u32x2 o8; o8.x = pk4_fp8(s[0 * 64] * f8scale, s[1 * 64] * f8scale, s[2 * 64] * f8scale, s[3 * 64] * f8scale); o8.y = pk4_fp8(s[4 * 64] * f8scale, s[5 * 64] * f8scale, s[6 * 64] * f8scale, s[7 * 64] * f8scale);
            if (okw) *(u32x2*)((unsigned char*)WT + (size_t)orow * ldo + kofs + k0 + 8 * c) = o8; }
        else {
        u32x4 o; o.x = cvt_pk_bf16(s[0 * 64], s[1 * 64]); o.y = cvt_pk_bf16(s[2 * 64], s[3 * 64]); o.z = cvt_pk_bf16(s[4 * 64], s[5 * 64]); o.w = cvt_pk_bf16(s[6 * 64], s[7 * 64]);
        if (okw) *(u32x4*)(WT + (size_t)orow * ldo + kofs + k0 + 8 * c) = o; } }
    LDS_WAIT();
}
__device__ __forceinline__ void tr_matrix(const Frame& F, const float* W, int K, int N, bf16_t* WT, int ldo, int kofs, int mode, float f8scale = 0.f, int rlo = 0, int rhi = 1 << 30) {
    LAS float* scr = (LAS float*)(F.lds + F.wave * 16384);
    const int nitems = (K >> 6) * ((N + 63) >> 6), NGW = F.G * NWAVES;
    for (int it = F.gw; it < nitems; it += NGW) tr_item(W, N, WT, ldo, kofs, mode, scr, it, F.lane, f8scale, rlo, rhi);
}
__device__ __forceinline__ void cvt_linear(const Frame& F, const float* src, bf16_t* dst, size_t n8) {
    const size_t NT = (size_t)F.G * NTHREADS;
    for (size_t i = (size_t)blockIdx.x * NTHREADS + F.tid; i < n8; i += NT) { const f32x4 a = *(const f32x4*)(src + i * 8), b = *(const f32x4*)(src + i * 8 + 4); *(u32x4*)(dst + i * 8) = pg8::pack8(a, b); }
}
__device__ __forceinline__ void cvt_linear8(const Frame& F, const float* src, unsigned char* dst, size_t n8) {
    const size_t NT = (size_t)F.G * NTHREADS;
    for (size_t i = (size_t)blockIdx.x * NTHREADS + F.tid; i < n8; i += NT) { const f32x4 a = *(const f32x4*)(src + i * 8), b = *(const f32x4*)(src + i * 8 + 4); *(u32x2*)(dst + i * 8) = pg8::pack8_fp8(a, b, 1.0f); }
}
__device__ __forceinline__ void sincos_d(double ang, float& c, float& s) {
    const double n = __builtin_rint(ang * 0.6366197723675814);
    double r = __builtin_fma(-n, 1.5707963267948966, ang); r = __builtin_fma(-n, 6.123233995736766e-17, r);
    const double r2 = r * r;
    const double sp = r * (1.0 + r2 * (-1.0 / 6.0 + r2 * (1.0 / 120.0 + r2 * (-1.0 / 5040.0 + r2 * (1.0 / 362880.0 + r2 * (-1.0 / 39916800.0 + r2 * (1.0 / 6227020800.0)))))));
    const double cp = 1.0 + r2 * (-0.5 + r2 * (1.0 / 24.0 + r2 * (-1.0 / 720.0 + r2 * (1.0 / 40320.0 + r2 * (-1.0 / 3628800.0 + r2 * (1.0 / 479001600.0 + r2 * (-1.0 / 87178291200.0)))))));
    const int q = (int)((long long)n & 3);
    const float sf = (float)sp, cf = (float)cp;
    c = q == 0 ? cf : (q == 1 ? -sf : (q == 2 ? -cf : sf));
    s = q == 0 ? sf : (q == 1 ? cf : (q == 2 ? -sf : -cf));
}
__device__ __forceinline__ void rope_tables(const Frame& F, const int* pos, float* tab64, float* tab32) {
    const int NT = F.G * NTHREADS;
    for (int i = blockIdx.x * NTHREADS + F.tid; i < T * 48; i += NT) {
        const int t = i / 48, f = i - t * 48; const bool is64 = f < 32; const int fi = is64 ? f : f - 32;
        const double base = is64 ? 0.7498942093324559 : 0.5623413251903491;
        double inv = 1.0; for (int k = 0; k < fi; ++k) inv *= base;
        float c, s; sincos_d((double)pos[t] * inv, c, s);
        float* o = is64 ? tab64 + ((size_t)t * 32 + fi) * 2 : tab32 + ((size_t)t * 16 + fi) * 2; o[0] = c; o[1] = s;
    }
}

constexpr int MOE_CONV_ITEMS = 8 * 3 * 3584;
__device__ __forceinline__ void moe_conv_item(const float* w1, const float* w3, const float* w2, unsigned char* ws, LAS float* scr, int it, int lane) {
    const int e = it / (3 * 3584), r = it - e * (3 * 3584), mtx = r / 3584, sub = r - mtx * 3584;
    if (mtx < 2) tr_item((mtx == 0 ? w1 : w3) + (size_t)e * DM * MFFN, MFFN, (bf16_t*)(ws + WS_MW13 + (size_t)e * 2 * MFFN * DM), DM, 0, 2 + mtx, scr, sub, lane, W13_F8SCALE);
    else tr_item(w2 + (size_t)e * MFFN * DM, DM, (bf16_t*)(ws + WS_MW2 + (size_t)e * DM * MFFN), MFFN, 0, 0, scr, sub, lane, W2_F8SCALE);
}

__device__ __forceinline__ unsigned ln_col(int lane, int q) { return 8u * (unsigned)(lane & 63) + 512u * (unsigned)(q >> 1) + 4u * (unsigned)(q & 1); }
__device__ __forceinline__ void ln_load16(f32x4 (&v)[8], const bf16_t* row, int lane) {
#pragma unroll
    for (int j = 0; j < 4; ++j) pg8::unpack8(*(const u32x4*)(row + ln_col(lane, 2 * j)), v[2 * j], v[2 * j + 1]);
}
__device__ __forceinline__ void ln_store16(const f32x4 (&v)[8], bf16_t* row, int lane) {
#pragma unroll
    for (int j = 0; j < 4; ++j) *(u32x4*)(row + ln_col(lane, 2 * j)) = pg8::pack8(v[2 * j], v[2 * j + 1]);
}
__device__ __forceinline__ void ln_store8(const f32x4 (&v)[8], unsigned char* row, int lane) {
#pragma unroll
    for (int j = 0; j < 4; ++j) *(u32x2*)(row + ln_col(lane, 2 * j)) = pg8::pack8_fp8(v[2 * j], v[2 * j + 1], 1.0f);
}
__device__ __forceinline__ void ln_core(f32x4 (&v)[8], const float* g, const float* bb, int lane) {
    float s = 0.f;
#pragma unroll
    for (int j = 0; j < 8; ++j) s += (v[j][0] + v[j][1]) + (v[j][2] + v[j][3]);
    const float mean = wave_sum(s) * (1.0f / DM); float s2 = 0.f;
#pragma unroll
    for (int j = 0; j < 8; ++j) { v[j] = v[j] - mean; s2 += (v[j][0] * v[j][0] + v[j][1] * v[j][1]) + (v[j][2] * v[j][2] + v[j][3] * v[j][3]); }
    const float rstd = 1.0f / sqrtf(wave_sum(s2) * (1.0f / DM) + LN_EPS);
    int l2 = lane; asm volatile("" : "+v"(l2) :: "memory");
#pragma unroll
    for (int j = 0; j < 8; ++j) { const f32x4 gv = *(const f32x4*)(g + ln_col(l2, j)), bv = *(const f32x4*)(bb + ln_col(l2, j)); v[j] = v[j] * rstd * gv + bv; }
}
template <bool OUT8> __device__ __forceinline__ void ln_phase(const Frame& F, const bf16_t* YH, bf16_t* X16, unsigned char* X8, const float* g, const float* bb) {
    const int NGW = F.G * NWAVES;
    for (int m = F.gw; m < T; m += NGW) { f32x4 v[8];
        ln_load16(v, YH + (size_t)m * DM, F.lane); ln_core(v, g, bb, F.lane); ln_store16(v, X16 + (size_t)m * DM, F.lane);
        if constexpr (OUT8) ln_store8(v, X8 + (size_t)m * DM, F.lane); }
}

__device__ __forceinline__ int crow(int r, int hi) { return (r & 3) + 8 * (r >> 2) + 4 * hi; }
template <bool OUT8> __device__ __forceinline__ void swa_phase(const Frame& F, bf16_t* Q, const bf16_t* Kb, const bf16_t* VT, const float* sinks, unsigned char* O8) {
    const int lane = F.lane, l31 = lane & 31, hf = lane >> 5;
    for (int wi = blockIdx.x; wi < 4096; wi += F.G) {
        const int kvh = wi & 3, qsi = (wi >> 2) & 511, b = wi >> 11, h = kvh * 8 + F.wave, q0 = qsi * 32;
        const size_t row0 = (size_t)b * SEQ + q0;
        bf16x8 qf[4];
#pragma unroll
        for (int kk = 0; kk < 4; ++kk) { if constexpr (SWA_FRAG) qf[kk] = *(const bf16x8*)(Q + ((((size_t)(b * 32 + h) * 512 + qsi) * 4 + kk) * 64 + lane) * 8);
            else qf[kk] = *(const bf16x8*)(Q + (row0 + l31) * 2048 + h * 64 + 16 * kk + 8 * hf); }
        f32x16 sc[5];
#pragma unroll
        for (int kt = 0; kt < 5; ++kt) {
            int kpos = q0 - 128 + 32 * kt + l31; kpos = kpos < 0 ? 0 : kpos;
            const bf16_t* kp = Kb + ((size_t)b * SEQ + kpos) * 256 + kvh * 64 + 8 * hf;
            f32x16 a;
#pragma unroll
            for (int r = 0; r < 16; ++r) a[r] = 0.f;
            const int kblk = qsi - 4 + kt < 0 ? 0 : qsi - 4 + kt;
#pragma unroll
            for (int kk = 0; kk < 4; ++kk) { bf16x8 kf; if constexpr (SWA_FRAG) kf = *(const bf16x8*)(Kb + ((((size_t)(b * 4 + kvh) * 512 + kblk) * 4 + kk) * 64 + lane) * 8); else kf = *(const bf16x8*)(kp + 16 * kk);
                a = __builtin_amdgcn_mfma_f32_32x32x16_bf16(kf, qf[kk], a, 0, 0, 0); }
            sc[kt] = a;
        }
        const float sink2 = sinks[h] * LOG2E; const int qpos = q0 + l31;
        float mx = sink2;
#pragma unroll
        for (int kt = 0; kt < 5; ++kt)
#pragma unroll
            for (int r = 0; r < 16; ++r) { const int kpos = q0 - 128 + 32 * kt + crow(r, hf); const bool ok = kpos >= 0 && kpos <= qpos && (qpos - kpos) < 128;
                const float v = ok ? sc[kt][r] : -INFINITY; sc[kt][r] = v; mx = fmaxf(mx, v); }
        mx = fmaxf(mx, shx(mx, 32, lane));
        float sum = 0.f;
#pragma unroll
        for (int kt = 0; kt < 5; ++kt)
#pragma unroll
            for (int r = 0; r < 16; ++r) { const float p = __builtin_amdgcn_exp2f(sc[kt][r] - mx); sc[kt][r] = p; sum += p; }
        sum += shx(sum, 32, lane);
        const float inv = 1.0f / (sum + __builtin_amdgcn_exp2f(sink2 - mx));
        f32x16 o[2];
#pragma unroll
        for (int r = 0; r < 16; ++r) { o[0][r] = 0.f; o[1][r] = 0.f; }
#pragma unroll
        for (int kt = 0; kt < 5; ++kt)
#pragma unroll
            for (int c = 0; c < 2; ++c) {
                bf16x8 pb; { u32x4 w; w.x = cvt_pk_bf16(sc[kt][8 * c + 0], sc[kt][8 * c + 1]); w.y = cvt_pk_bf16(sc[kt][8 * c + 2], sc[kt][8 * c + 3]); w.z = cvt_pk_bf16(sc[kt][8 * c + 4], sc[kt][8 * c + 5]); w.w = cvt_pk_bf16(sc[kt][8 * c + 6], sc[kt][8 * c + 7]); pb = __builtin_bit_cast(bf16x8, w); }
                int kb = q0 - 128 + 32 * kt + 16 * c + 4 * hf; int kb0 = kb < 0 ? 0 : kb, kb1 = kb + 8 < 0 ? 0 : kb + 8;
#pragma unroll
                for (int mt = 0; mt < 2; ++mt) { bf16x8 va;
                    if constexpr (SWA_FRAG) { const int vblk = qsi - 4 + kt < 0 ? 0 : qsi - 4 + kt; va = *(const bf16x8*)(VT + (((((size_t)(b * 4 + kvh) * 512 + vblk) * 2 + c) * 2 + mt) * 64 + lane) * 8); }
                    else { const bf16_t* vp = VT + ((size_t)(b * 4 + kvh) * 64 + 32 * mt + l31) * SEQ;
                    const u32x2 v0 = *(const u32x2*)(vp + kb0), v1 = *(const u32x2*)(vp + kb1); u32x4 w; w.x = v0.x; w.y = v0.y; w.z = v1.x; w.w = v1.y; va = __builtin_bit_cast(bf16x8, w); }
                    o[mt] = __builtin_amdgcn_mfma_f32_32x32x16_bf16(va, pb, o[mt], 0, 0, 0); }
            }
        bf16_t* op = Q + (row0 + l31) * 2048 + h * 64; unsigned char* op8 = O8 + (row0 + l31) * 2048 + h * 64; const float inv8 = inv * O0_F8SCALE;
#pragma unroll
        for (int mt = 0; mt < 2; ++mt)
#pragma unroll
            for (int r4 = 0; r4 < 4; ++r4) {
                if constexpr (OUT8) *(unsigned*)(op8 + 32 * mt + 8 * r4 + 4 * hf) = pk4_fp8(o[mt][4 * r4] * inv8, o[mt][4 * r4 + 1] * inv8, o[mt][4 * r4 + 2] * inv8, o[mt][4 * r4 + 3] * inv8);
                else { u32x2 w; w.x = cvt_pk_bf16(o[mt][4 * r4] * inv, o[mt][4 * r4 + 1] * inv); w.y = cvt_pk_bf16(o[mt][4 * r4 + 2] * inv, o[mt][4 * r4 + 3] * inv);
                *(u32x2*)(op + 32 * mt + 8 * r4 + 4 * hf) = w; } }
    }
}

__device__ __forceinline__ void kvnorm_phase(const Frame& F, const float* CRAW, const float* gk, bf16_t* KV) {
    const int NGW = F.G * NWAVES;
    for (int m = F.gw; m < T; m += NGW) { const float* cr = CRAW + (size_t)m * 512;
        const f32x4 a = *(const f32x4*)(cr + 4 * F.lane), b = *(const f32x4*)(cr + 256 + 4 * F.lane);
        float s = (a[0] * a[0] + a[1] * a[1]) + (a[2] * a[2] + a[3] * a[3]) + (b[0] * b[0] + b[1] * b[1]) + (b[2] * b[2] + b[3] * b[3]);
        const float r = 1.0f / sqrtf(wave_sum(s) * (1.0f / 512.0f) + RMS_EPS);
        const f32x4 ga = *(const f32x4*)(gk + 4 * F.lane), gb = *(const f32x4*)(gk + 256 + 4 * F.lane);
        u32x2 w0, w1; w0.x = cvt_pk_bf16(a[0] * r * ga[0], a[1] * r * ga[1]); w0.y = cvt_pk_bf16(a[2] * r * ga[2], a[3] * r * ga[3]);
        w1.x = cvt_pk_bf16(b[0] * r * gb[0], b[1] * r * gb[1]); w1.y = cvt_pk_bf16(b[2] * r * gb[2], b[3] * r * gb[3]);
        *(u32x2*)(KV + (size_t)m * 576 + 4 * F.lane) = w0; *(u32x2*)(KV + (size_t)m * 576 + 256 + 4 * F.lane) = w1; }
}

__device__ __forceinline__ float relu1(float a) { return __builtin_amdgcn_fmed3f(a, 0.f, 3.0e38f); }
__device__ __forceinline__ unsigned f2key(float f) { const unsigned u = __float_as_uint(f); return u ^ ((unsigned)((int)u >> 31) | 0x80000000u); }
__device__ __forceinline__ float key2f(unsigned k) { const unsigned u = (k & 0x80000000u) ? (k ^ 0x80000000u) : ~k; return __uint_as_float(u); }
__device__ __forceinline__ unsigned compact256(LAS u64* buf, int n, int lane) {
    u64 e[8];
#pragma unroll
    for (int i = 0; i < 8; ++i) e[i] = (lane + 64 * i < n) ? buf[lane + 64 * i] : 0ull;
    unsigned thr = 0u;
    for (int bit = 31; bit >= 0; --bit) {
        const unsigned cand = thr | (1u << bit); int c = 0;
#pragma unroll
        for (int i = 0; i < 8; ++i) c += __popcll(__ballot((unsigned)(e[i] >> 32) >= cand));
        if (c >= 256) thr = cand;
    }
    int ngt = 0;
#pragma unroll
    for (int i = 0; i < 8; ++i) ngt += __popcll(__ballot((unsigned)(e[i] >> 32) > thr));
    int pos_gt = 0, pos_eq = ngt;
#pragma unroll
    for (int i = 0; i < 8; ++i) { const unsigned k = (unsigned)(e[i] >> 32); const bool gt = k > thr, eq = k == thr; const u64 mg = __ballot(gt), me = __ballot(eq);
        if (gt) buf[pos_gt + mbcnt64(mg)] = e[i];
        const int re = pos_eq + mbcnt64(me); if (eq && re < 256) buf[re] = e[i];
        pos_gt += __popcll(mg); pos_eq += __popcll(me); }
    return thr;
}
__device__ __forceinline__ unsigned compact_bound(LAS u64* buf, int n, int lane, unsigned lo, int& n_out) {
    u64 e[8]; unsigned mx = 0u;
#pragma unroll
    for (int i = 0; i < 8; ++i) { e[i] = (lane + 64 * i < n) ? buf[lane + 64 * i] : 0ull; const unsigned k = (unsigned)(e[i] >> 32); mx = k > mx ? k : mx; }
#pragma unroll
    for (int o = 1; o < 64; o <<= 1) { const unsigned t = (unsigned)__builtin_amdgcn_ds_bpermute((lane ^ o) << 2, (int)mx); mx = t > mx ? t : mx; }
    mx = (unsigned)__builtin_amdgcn_readfirstlane((int)mx);
    const unsigned diff = mx ^ lo; const int hb = diff ? 31 - __builtin_clz(diff) : 0;
    unsigned thr = hb >= 31 ? 0u : (lo & ~((2u << hb) - 1u)); int cge = n;
    for (int bit = hb; bit >= 0; --bit) {
        const unsigned cand = thr | (1u << bit); int c = 0;
#pragma unroll
        for (int i = 0; i < 8; ++i) c += __popcll(__ballot((unsigned)(e[i] >> 32) >= cand));
        if (c >= 256) { thr = cand; cge = c; if (c <= 288) break; }
    }
    int pos = 0;
#pragma unroll
    for (int i = 0; i < 8; ++i) { const bool ge = (unsigned)(e[i] >> 32) >= thr && (lane + 64 * i < n); const u64 mg = __ballot(ge);
        if (ge) buf[pos + mbcnt64(mg)] = e[i];
        pos += __popcll(mg); }
    n_out = pos;
    return thr;
}
__device__ __forceinline__ void topk_phase(const Frame& F, const bf16_t* QI, const bf16_t* KIF, const float* WI, unsigned short* SEL) {
    const int lane = F.lane, l31 = lane & 31, hf = lane >> 5, wave = F.wave;
    LAS u64* mybuf = (LAS u64*)F.lds + (size_t)(wave * 4) * 512;
    const unsigned lmask_lt = (1u << l31) - 1u; const int hfm = -hf;
    for (int pu = blockIdx.x; pu < 512; pu += F.G) {
        const int b = pu >> 8, pi = pu & 255;
        for (int half = 0; half < 2; ++half) {
            const int tq = half == 0 ? pi : 511 - pi, q0 = tq * 32, nsteps = tq + 1;
            const size_t trow0 = (size_t)b * SEQ + q0 + 4 * wave;
            bf16x8 aq[2][4]; float wq[2][16];
#pragma unroll
            for (int s = 0; s < 2; ++s) {
                const int qq = 2 * s + ((l31 >> 2) & 1), hd = 4 * (l31 >> 3) + (l31 & 3);
#pragma unroll
                for (int kk = 0; kk < 4; ++kk) aq[s][kk] = *(const bf16x8*)(QI + ((trow0 + qq) * 16 + hd) * 64 + 16 * kk + 8 * hf);
                const float* wp = WI + (trow0 + 2 * s + hf) * 16;
#pragma unroll
                for (int r4 = 0; r4 < 4; ++r4) { const f32x4 w = *(const f32x4*)(wp + 4 * r4); wq[s][4 * r4] = w[0]; wq[s][4 * r4 + 1] = w[1]; wq[s][4 * r4 + 2] = w[2]; wq[s][4 * r4 + 3] = w[3]; }
            }
            float psc0 = 0.f, psc1 = 0.f; int pix0 = 0, pix1 = 0; bool pv0 = false, pv1 = false;
            float thr0 = -INFINITY, thr1 = -INFINITY; int c0 = 0, c1 = 0, c2 = 0, c3 = 0; unsigned b0 = 0x007fffffu, b1 = 0x007fffffu, b2 = 0x007fffffu, b3 = 0x007fffffu;
            const bf16_t* kbase = KIF + (size_t)b * 512 * 4 * 64 * 8 + (size_t)lane * 8;
            bf16x8 k0[4], k1[4], k2[4], k3[4];
#pragma unroll
            for (int kk = 0; kk < 4; ++kk) { k0[kk] = *(const bf16x8*)(kbase + (size_t)(0 * 4 + kk) * 512); k1[kk] = *(const bf16x8*)(kbase + (size_t)((nsteps > 1 ? 1 : 0) * 4 + kk) * 512);
                k2[kk] = *(const bf16x8*)(kbase + (size_t)((nsteps > 2 ? 2 : nsteps - 1) * 4 + kk) * 512); k3[kk] = *(const bf16x8*)(kbase + (size_t)((nsteps > 3 ? 3 : nsteps - 1) * 4 + kk) * 512); }
#define TOPK_STEP(KB, STEP) { const int kidx = 32 * (STEP) + l31; \
    f32x16 a0_, a1_; _Pragma("unroll") for (int r = 0; r < 16; ++r) { a0_[r] = 0.f; a1_[r] = 0.f; } \
    _Pragma("unroll") for (int kk = 0; kk < 4; ++kk) a0_ = __builtin_amdgcn_mfma_f32_32x32x16_bf16(aq[0][kk], KB[kk], a0_, 0, 0, 0); \
    _Pragma("unroll") for (int kk = 0; kk < 4; ++kk) a1_ = __builtin_amdgcn_mfma_f32_32x32x16_bf16(aq[1][kk], KB[kk], a1_, 0, 0, 0); \
    { const int sn_ = (STEP) + 4 < nsteps ? (STEP) + 4 : nsteps - 1; _Pragma("unroll") for (int kk = 0; kk < 4; ++kk) KB[kk] = *(const bf16x8*)(kbase + (size_t)(sn_ * 4 + kk) * 512); }     \
    float sc0_ = 0.f, sc1_ = 0.f; \
    _Pragma("unroll") for (int r = 0; r < 16; ++r) sc0_ = fmaf(wq[0][r], relu1(a0_[r]), sc0_); \
    _Pragma("unroll") for (int r = 0; r < 16; ++r) sc1_ = fmaf(wq[1][r], relu1(a1_[r]), sc1_); \
    const int tql0_ = q0 + 4 * wave + hf; \
    const bool pass0_ = (sc0_ > thr0) && (kidx <= tql0_), pass1_ = (sc1_ > thr1) && (kidx <= tql0_ + 2); \
      \
    if (__ballot((pass0_ && pv0) || (pass1_ && pv1))) { TOPK_FLUSH(); } \
    psc0 = pass0_ ? sc0_ : psc0; pix0 = pass0_ ? kidx : pix0; pv0 = pv0 || pass0_; \
    psc1 = pass1_ ? sc1_ : psc1; pix1 = pass1_ ? kidx : pix1; pv1 = pv1 || pass1_; }
#define TOPK_FLUSH() { const u64 mask0_ = __ballot(pv0), mask1_ = __ballot(pv1); \
        if (mask0_) { const unsigned lo = (unsigned)mask0_, hi = (unsigned)(mask0_ >> 32); const int plo = __popc(lo), phi = __popc(hi); \
          const int rank = mbcnt64(mask0_) - (plo & hfm); const int cm = c0 + ((c1 - c0) & hfm); \
          if (pv0) mybuf[hf * 512 + cm + rank] = ((u64)f2key(psc0) << 32) | (unsigned)pix0; c0 += plo; c1 += phi; } \
        if (mask1_) { const unsigned lo = (unsigned)mask1_, hi = (unsigned)(mask1_ >> 32); const int plo = __popc(lo), phi = __popc(hi); \
          const int rank = mbcnt64(mask1_) - (plo & hfm); const int cm = c2 + ((c3 - c2) & hfm); \
          if (pv1) mybuf[(2 + hf) * 512 + cm + rank] = ((u64)f2key(psc1) << 32) | (unsigned)pix1; c2 += plo; c3 += phi; } \
        pv0 = false; pv1 = false; \
        const int cmx_ = max(max(c0, c1), max(c2, c3)); \
        if (cmx_ > 480) { \
        if (c0 > 480) { b0 = compact_bound(mybuf, c0, lane, b0, c0); const float nt = key2f(b0); thr0 = hf == 0 ? nt : thr0; } \
        if (c1 > 480) { b1 = compact_bound(mybuf + 512, c1, lane, b1, c1); const float nt = key2f(b1); thr0 = hf == 1 ? nt : thr0; } \
        if (c2 > 480) { b2 = compact_bound(mybuf + 1024, c2, lane, b2, c2); const float nt = key2f(b2); thr1 = hf == 0 ? nt : thr1; } \
        if (c3 > 480) { b3 = compact_bound(mybuf + 1536, c3, lane, b3, c3); const float nt = key2f(b3); thr1 = hf == 1 ? nt : thr1; } } }
            for (int st = 0; st < nsteps; st += 4) {
                TOPK_STEP(k0, st);
                if (st + 1 < nsteps) TOPK_STEP(k1, st + 1);
                if (st + 2 < nsteps) TOPK_STEP(k2, st + 2);
                if (st + 3 < nsteps) TOPK_STEP(k3, st + 3);
            }
            TOPK_FLUSH();
#undef TOPK_STEP
#undef TOPK_FLUSH
#pragma unroll
            for (int qi = 0; qi < 4; ++qi) {
                int c = qi == 0 ? c0 : (qi == 1 ? c1 : (qi == 2 ? c2 : c3)); LAS u64* bq = mybuf + qi * 512;
                if (c > 256) { (void)compact256(bq, c, lane); c = 256; }
                LDS_WAIT();
                unsigned short v[4];
#pragma unroll
                for (int j = 0; j < 4; ++j) { const int e = 4 * lane + j; v[j] = e < c ? (unsigned short)(bq[e] & 0xffffull) : (unsigned short)0xffff; }
                u32x2 w; w.x = (unsigned)v[0] | ((unsigned)v[1] << 16); w.y = (unsigned)v[2] | ((unsigned)v[3] << 16);
                *(u32x2*)(SEL + (trow0 + qi) * 256 + 4 * lane) = w;
            }
            LDS_WAIT();
        }
    }
}

__device__ __forceinline__ bf16x4 tr_read16(const LAS unsigned char* p) { return __builtin_bit_cast(bf16x4, __builtin_amdgcn_ds_read_tr16_b64_v4i16((LAS bf16x4*)p)); }
__device__ __forceinline__ void dsa_attn_phase(const Frame& F, const bf16_t* QLAT, bf16_t* OUT, const bf16_t* QR, const bf16_t* KV, const unsigned short* SEL, const float* w1, const float* w3, const float* w2, unsigned char* ws) {
    LAS unsigned char* wb = F.lds + F.wave * DSA_WBUF; LAS unsigned char* tails = wb + 16640;
    const unsigned char* KVb = (const unsigned char*)KV;
    const int NGW = F.G * NWAVES;
    for (int tg = F.gw; tg < T; tg += NGW) {
        int lane = F.lane; asm volatile("" : "+v"(lane));
        const int l15 = lane & 15, g = lane >> 4;
        const int b = tg >> 14, t = tg & (SEQ - 1); const int nvalid = t + 1 < 256 ? t + 1 : 256, nsteps = (nvalid + 15) >> 4;
        bf16x8 qf[18];
#pragma unroll
        for (int kk = 0; kk < 16; ++kk) {
            if constexpr (F8_LAT) { const u32x2 w8 = *(const u32x2*)((const unsigned char*)QLAT + ((size_t)tg * 16 + l15) * 512 + 32 * kk + 8 * g);
                const f32x2 f0 = __builtin_amdgcn_cvt_pk_f32_fp8((int)w8.x, false), f1 = __builtin_amdgcn_cvt_pk_f32_fp8((int)w8.x, true), f2 = __builtin_amdgcn_cvt_pk_f32_fp8((int)w8.y, false), f3 = __builtin_amdgcn_cvt_pk_f32_fp8((int)w8.y, true);
                u32x4 wb16; wb16.x = cvt_pk_bf16(f0[0], f0[1]); wb16.y = cvt_pk_bf16(f1[0], f1[1]); wb16.z = cvt_pk_bf16(f2[0], f2[1]); wb16.w = cvt_pk_bf16(f3[0], f3[1]); qf[kk] = __builtin_bit_cast(bf16x8, wb16); }
            else qf[kk] = *(const bf16x8*)(QLAT + ((size_t)tg * 16 + l15) * 512 + 32 * kk + 8 * g); }
#pragma unroll
        for (int kk = 0; kk < 2; ++kk) qf[16 + kk] = *(const bf16x8*)(QR + ((size_t)tg * 16 + l15) * 64 + 32 * kk + 8 * g);
        float m = -INFINITY, lsum = 0.f; f32x4 O[32];
#pragma unroll
        for (int mt = 0; mt < 32; ++mt) O[mt] = (f32x4){0.f, 0.f, 0.f, 0.f};
        for (int st = 0; st < nsteps; ++st) {
            const int slot = 16 * st + l15;
            int idx = slot < nvalid ? (int)SEL[(size_t)tg * 256 + slot] : 0; idx = idx > t ? 0 : idx;
            const int row = b * SEQ + idx;
            LDS_WAIT();
#pragma unroll
            for (int r = 0; r < 16; ++r) { const int rr = __builtin_amdgcn_readlane(row, r); glds16(KVb + (size_t)rr * 1152 + 16 * lane, wb + r * 1040); }
#pragma unroll
            for (int p = 0; p < 2; ++p) glds16(KVb + (size_t)row * 1152 + 1024 + 16 * (4 * p + g), tails + 1024 * p);
            VM_WAIT();
            f32x4 sacc = (f32x4){0.f, 0.f, 0.f, 0.f};
#pragma unroll
            for (int kk = 0; kk < 16; ++kk) { const bf16x8 a = *(const LAS bf16x8*)(wb + l15 * 1040 + (4 * kk + g) * 16); sacc = __builtin_amdgcn_mfma_f32_16x16x32_bf16(a, qf[kk], sacc, 0, 0, 0); }
#pragma unroll
            for (int kk = 0; kk < 2; ++kk) { const bf16x8 a = *(const LAS bf16x8*)(tails + (4 * kk + g) * 256 + l15 * 16); sacc = __builtin_amdgcn_mfma_f32_16x16x32_bf16(a, qf[16 + kk], sacc, 0, 0, 0); }
            float s[4]; float tmax = -INFINITY;
#pragma unroll
            for (int i = 0; i < 4; ++i) { s[i] = (16 * st + 4 * g + i) < nvalid ? sacc[i] * (F8_LAT ? SCALE2_MLA / QLAT_F8SCALE : SCALE2_MLA) : -INFINITY; tmax = fmaxf(tmax, s[i]); }
            tmax = fmaxf(tmax, shx(tmax, 16, lane)); tmax = fmaxf(tmax, shx(tmax, 32, lane));
            const bool reb = tmax > m + 8.0f; const float mnew = reb ? tmax : m; const float alpha = reb ? __builtin_amdgcn_exp2f(m - mnew) : 1.0f; m = mnew;
            float p[4];
#pragma unroll
            for (int i = 0; i < 4; ++i) p[i] = __builtin_amdgcn_exp2f(s[i] - mnew);
            lsum = lsum * alpha + ((p[0] + p[1]) + (p[2] + p[3]));
            if (__any(reb)) {
#pragma unroll
                for (int mt = 0; mt < 32; ++mt) O[mt] = O[mt] * alpha;
            }
            u32x2 pw; pw.x = cvt_pk_bf16(p[0], p[1]); pw.y = cvt_pk_bf16(p[2], p[3]); const bf16x4 pb = __builtin_bit_cast(bf16x4, pw);
            const LAS unsigned char* trb = wb + (4 * g + (l15 >> 2)) * 1040 + (lane & 3) * 8;
#pragma unroll
            for (int mt = 0; mt < 32; ++mt) { const bf16x4 a = tr_read16(trb + mt * 32); O[mt] = __builtin_amdgcn_mfma_f32_16x16x16bf16_1k(a, pb, O[mt], 0, 0, 0); }
        }
        float lt = lsum + shx(lsum, 16, lane); lt += shx(lt, 32, lane); const float inv = 1.0f / lt;
        if constexpr (F8_LAT) { unsigned char* op8 = (unsigned char*)OUT + ((size_t)tg * 16 + l15) * 512 + 4 * g; const float inv8 = inv * OLAT_F8SCALE;
#pragma unroll
            for (int mt = 0; mt < 32; ++mt) *(unsigned*)(op8 + 16 * mt) = pk4_fp8(O[mt][0] * inv8, O[mt][1] * inv8, O[mt][2] * inv8, O[mt][3] * inv8); }
        else { bf16_t* op = OUT + ((size_t)tg * 16 + l15) * 512 + 4 * g;
#pragma unroll
        for (int mt = 0; mt < 32; ++mt) { u32x2 w; w.x = cvt_pk_bf16(O[mt][0] * inv, O[mt][1] * inv); w.y = cvt_pk_bf16(O[mt][2] * inv, O[mt][3] * inv); *(u32x2*)(op + 16 * mt) = w; } }
        if (w1) { LDS_WAIT(); int lane2 = F.lane; asm volatile("" : "+v"(lane2));
            for (int k = 0; k < 3; ++k) { const int it = F.gw + NGW * (3 * ((tg - F.gw) / NGW) + k); if (it < MOE_CONV_ITEMS) moe_conv_item(w1, w3, w2, ws, (LAS float*)wb, it, lane2); } }
    }
    LDS_WAIT();
}

__device__ __forceinline__ void ln_router_phase(const Frame& F, const bf16_t* YH, bf16_t* XB, const float* g, const float* bb, const float* wr, int* TOKE, float* TOKG, int* TOKL) {
    LAS float* wl = (LAS float*)F.lds;
    for (int i = F.tid; i < DM * NEXP; i += NTHREADS) { const int d = i >> 3, e = i & 7; wl[e * DM + d] = wr[i]; }
    __syncthreads();
    const int NGW = F.G * NWAVES, lane = F.lane;
    u64 cnt64 = 0ull; int mine = 0;
    int j = 0;
    for (int m = F.gw; m < T; m += NGW, ++j) { f32x4 v[8];
        ln_load16(v, YH + (size_t)m * DM, lane); ln_core(v, g, bb, lane); ln_store8(v, (unsigned char*)XB + (size_t)m * DM, lane);
        float lg[8];
#pragma unroll
        for (int e = 0; e < 8; ++e) { float s = 0.f;
#pragma unroll
            for (int q = 0; q < 8; ++q) { const f32x4 w = *(const LAS f32x4*)(wl + e * DM + ln_col(lane, q)); s += (v[q][0] * w[0] + v[q][1] * w[1]) + (v[q][2] * w[2] + v[q][3] * w[3]); }
            lg[e] = wave_sum(s); }
        int e1 = 0; float v1 = lg[0];
#pragma unroll
        for (int e = 1; e < 8; ++e) if (lg[e] > v1) { v1 = lg[e]; e1 = e; }
        int e2 = -1; float v2 = -INFINITY;
#pragma unroll
        for (int e = 0; e < 8; ++e) if (e != e1 && lg[e] > v2) { v2 = lg[e]; e2 = e; }
        const float g1 = 1.0f / (1.0f + __expf(v2 - v1)), g2 = 1.0f - g1;
        const int r1 = (int)((cnt64 >> (8 * e1)) & 0xffull); cnt64 += 1ull << (8 * e1);
        const int r2 = (int)((cnt64 >> (8 * e2)) & 0xffull); cnt64 += 1ull << (8 * e2);
        if (lane == 0) { TOKE[2 * m] = e1; TOKE[2 * m + 1] = e2; TOKG[2 * m] = g1; TOKG[2 * m + 1] = g2; }
        if (lane == j) mine = e1 | (e2 << 4) | (r1 << 8) | (r2 << 16);
    }
    int basev = 0;
    if (lane < 8) { const unsigned c = (unsigned)((cnt64 >> (8 * lane)) & 0xffull); basev = (int)__hip_atomic_fetch_add(F.ctl + CW_CNT + lane, c, __ATOMIC_RELAXED, __HIP_MEMORY_SCOPE_AGENT); }
    const int e1 = mine & 15, e2 = (mine >> 4) & 15, r1 = (mine >> 8) & 255, r2 = (mine >> 16) & 255;
    const int b1 = __builtin_amdgcn_ds_bpermute(e1 << 2, basev), b2 = __builtin_amdgcn_ds_bpermute(e2 << 2, basev);
    if (lane < j) { const int m = F.gw + NGW * lane; TOKL[2 * m] = b1 + r1; TOKL[2 * m + 1] = b2 + r2; }
    __syncthreads();
}
__device__ __forceinline__ void moe_tiles(const Frame& F) {
    if (F.tid == 0) { int acc = 0;
        for (int e = 0; e < 8; ++e) { const unsigned c = __hip_atomic_load(F.ctl + CW_CNT + e, __ATOMIC_RELAXED, __HIP_MEMORY_SCOPE_AGENT); F.MISC[32 + e] = c; F.MISC[40 + e] = (unsigned)acc; acc += (int)((c + 255u) >> 8); F.MISC[20 + e] = (unsigned)acc; }
        F.MISC[28] = (unsigned)acc; }
    __syncthreads();
}
__device__ __forceinline__ void moe_gather_phase(const Frame& F, const bf16_t* XB, const int* TOKE, const float* TOKG, const int* TOKL, int* TOKS, float* SGATE, bf16_t* XG) {
    const int NGW = F.G * NWAVES, lane = F.lane;
    for (int m = F.gw; m < T; m += NGW) {
        const u32x4* src = (const u32x4*)((const unsigned char*)XB + (size_t)m * DM);
        const u32x4 a0 = src[lane], a1 = src[64 + lane];
#pragma unroll
        for (int k = 0; k < 2; ++k) { const int e = TOKE[2 * m + k], li = TOKL[2 * m + k]; const int slot = (int)F.MISC[40 + e] * 256 + li;
            u32x4* dst = (u32x4*)((unsigned char*)XG + (size_t)slot * DM); dst[lane] = a0; dst[64 + lane] = a1;
            if (lane == 0) { TOKS[2 * m + k] = slot; SGATE[slot] = TOKG[2 * m + k]; } }
    }
    for (int it = F.gw; it < 8 * 256; it += NGW) { const int e = it >> 8, r = it & 255; const int c = (int)F.MISC[32 + e]; const int ntile = (c + 255) >> 8; const int row = c + r;
        if (row < ntile * 256) { const int slot = (int)F.MISC[40 + e] * 256 + row; u32x4* dst = (u32x4*)((unsigned char*)XG + (size_t)slot * DM); const u32x4 z = {0u, 0u, 0u, 0u};
            dst[lane] = z; dst[64 + lane] = z; if (lane == 0) SGATE[slot] = 0.f; } }
}
__device__ __forceinline__ void moe_combine_ln_phase(const Frame& F, const bf16_t* YH, bf16_t* XB, const bf16_t* SOUT, const int* TOKS, const float* g1, const float* bb1, const float* g, const float* bb) {
    const int NGW = F.G * NWAVES, lane = F.lane;
    for (int m = F.gw; m < T; m += NGW) { f32x4 v[8];
        const bf16_t* s0 = SOUT + (size_t)TOKS[2 * m] * DM; const bf16_t* s1 = SOUT + (size_t)TOKS[2 * m + 1] * DM;
        ln_load16(v, YH + (size_t)m * DM, lane);
        ln_core(v, g1, bb1, lane);
#pragma unroll
        for (int j = 0; j < 4; ++j) { f32x4 a0, a1, c0, c1; pg8::unpack8(*(const u32x4*)(s0 + ln_col(lane, 2 * j)), a0, a1); pg8::unpack8(*(const u32x4*)(s1 + ln_col(lane, 2 * j)), c0, c1);
            v[2 * j] = v[2 * j] * ALPHA + (a0 + c0); v[2 * j + 1] = v[2 * j + 1] * ALPHA + (a1 + c1); }
        ln_core(v, g, bb, lane); ln_store16(v, XB + (size_t)m * DM, lane); }
}

#ifndef PHASES
#define PHASES 0xFFFFFFFFu
#endif
#define PH(k) if constexpr ((PHASES >> (k)) & 1u)
#ifndef DBL
#define DBL 0u
#endif
#define DB(k) if constexpr ((DBL >> (k)) & 1u)
__global__ void __launch_bounds__(NTHREADS, 2) mega_fwd(Args args) {
    extern __shared__ __attribute__((aligned(16))) unsigned char lds_raw[];
    Frame F;
    F.lds = (LAS unsigned char*)lds_raw; F.MISC = (volatile LAS unsigned*)(F.lds + MISC_OFF);
    F.tid = threadIdx.x; F.lane = F.tid & 63; F.wave = __builtin_amdgcn_readfirstlane(F.tid >> 6); F.gw = blockIdx.x * NWAVES + F.wave;
    unsigned char* ws = args.ws;
    F.ctl = (unsigned*)(ws + WS_CTL);
    if (F.tid < 64) F.MISC[F.tid] = 0u;
    __syncthreads();
    XcdBarrier bar = xcd_barrier_post(F.ctl + CW_BAR, F.MISC + 8);
#define REFRESH() do { F.lane = fresh_lane(); F.tid = F.wave * 64 + F.lane; } while (0)
#define GRID_BAR() do { xcd_barrier(bar, F.wave); REFRESH(); } while (0)
#define YH ((bf16_t*)args.out)
#define bx ((int)blockIdx.x)
#define WSP(T_, off) ((T_*)(ws + (off)))

    PH(0) {
        { LAS float* scr = (LAS float*)(F.lds + F.wave * 16384);
          constexpr int I_QKV = 32 * 40, I_SQ = 32 * 32, I_W13 = 32 * 88, I_W2 = 88 * 32, I_WP = 4 * 32, I_WIN = 32 * 75, I_WUV = 256;
          constexpr int I_TOTAL = I_QKV + I_SQ + 2 * I_W13 + I_W2 + 2 * I_SQ + 2 * I_WP + (F8_WIN_SPLIT ? 2 : 1) * I_WIN + I_SQ + I_WUV;
          for (int it = F.gw; it < I_TOTAL; it += F.G * NWAVES) {
              int r = it; bool hit = false; const float* W = nullptr; int N = 0, ldo = 0, kofs = 0, mode = 0, rlo = 0, rhi = 1 << 30; unsigned char* WT = nullptr; float f8 = 0.f;
#define PSEG(cnt, Wp, Nn, WTp, ld, md, f8v, lo, hi) if (!hit) { if (r < (cnt)) { W = (Wp); N = (Nn); WT = (unsigned char*)(WTp); ldo = (ld); mode = (md); f8 = (f8v); rlo = (lo); rhi = (hi); hit = true; } else r -= (cnt); }
              PSEG(I_QKV, (const float*)args.in[3], NQKV, ws + WS_WQKV, DM, 1, F8_QKV ? WQKV_F8SCALE : 0.f, 0, 1 << 30)
              PSEG(I_SQ, (const float*)args.in[5], DM, ws + WS_WO0, DM, 0, F8_WO0 ? WO_F8SCALE : 0.f, 0, 1 << 30)
              PSEG(I_W13, (const float*)args.in[6], FFN, ws + WS_W13, DM, 2, F8_FFN1 ? W13_F8SCALE : 0.f, 0, 1 << 30)
              PSEG(I_W13, (const float*)args.in[7], FFN, ws + WS_W13, DM, 3, F8_FFN1 ? W13_F8SCALE : 0.f, 0, 1 << 30)
              PSEG(I_W2, (const float*)args.in[8], DM, ws + WS_W2, FFN, 0, F8_FFN2 ? W2_F8SCALE : 0.f, 0, 1 << 30)
              PSEG(I_SQ, (const float*)args.in[21], DM, ws + WS_WG0, DM, 0, 0.f, 0, 1 << 30)
              PSEG(I_SQ, (const float*)args.in[21] + (size_t)DM * DM, DM, ws + WS_WG1, DM, 0, 0.f, 0, 1 << 30)
              PSEG(I_WP, (const float*)args.in[20], DM, ws + WS_WP0, 256, 0, 0.f, 0, 1 << 30)
              PSEG(I_WP, (const float*)args.in[20] + (size_t)256 * DM, DM, ws + WS_WP1, 256, 0, 0.f, 0, 1 << 30)
              if constexpr (F8_WIN_SPLIT) { PSEG(I_WIN, (const float*)args.in[9], 4752, ws + WS_WIN8, DM, 4, WIN_F8SCALE, 0, WIN_F8_TILES * 256)
                                            PSEG(I_WIN, (const float*)args.in[9], 4752, ws + WS_WIN, DM, 4, 0.f, WIN_F8_TILES * 256, NWIN) }
              else { PSEG(I_WIN, (const float*)args.in[9], 4752, ws + WS_WIN, DM, 4, F8_WIN ? WIN_F8SCALE : 0.f, 0, 1 << 30) }
              PSEG(I_SQ, (const float*)args.in[13], DM, ws + WS_WO1, DM, 0, F8_WO1 ? WO_F8SCALE : 0.f, 0, 1 << 30)
              if (!hit) { const int h = r >> 4; r &= 15;
                  W = (const float*)args.in[12] + (size_t)h * 512 * 128; N = 128; WT = ws + WS_WUV + (size_t)h * 128 * 1024 * (F8_LAT ? 1 : 2); ldo = 1024; kofs = 512 * (h & 1); f8 = F8_LAT ? WUV_F8SCALE : 0.f; }
#undef PSEG
              tr_item(W, N, (bf16_t*)WT, ldo, kofs, mode, scr, r, F.lane, f8, rlo, rhi); } }
        { bf16_t* wuv = WSP(bf16_t, WS_WUV); const u32x4 z = {0u, 0u, 0u, 0u};
          for (int i = bx * NTHREADS + F.tid; i < 2048 * 64; i += F.G * NTHREADS) { const int n = i >> 6, c8 = i & 63; const int h = n >> 7;
              if constexpr (F8_LAT) { if (c8 < 32) *(u32x4*)((unsigned char*)wuv + (size_t)n * 1024 + 512 * ((h & 1) ^ 1) + 16 * c8) = z; }
              else *(u32x4*)(wuv + (size_t)n * 1024 + 512 * ((h & 1) ^ 1) + 8 * c8) = z; } }
        cvt_linear(F, (const float*)args.in[11], WSP(bf16_t, WS_WUK), (size_t)16 * 512 * 128 / 8);
        if constexpr (F8_QKV) cvt_linear8(F, (const float*)args.in[0], WSP(unsigned char, WS_XBA), (size_t)T * DM / 8); else cvt_linear(F, (const float*)args.in[0], WSP(bf16_t, WS_XBA), (size_t)T * DM / 8);
        cvt_linear(F, (const float*)args.in[1], WSP(bf16_t, WS_PB), (size_t)2 * T * 256 / 8);
        rope_tables(F, (const int*)args.in[2], WSP(float, WS_TAB64), WSP(float, WS_TAB32));
    }
    GRID_BAR();
    PH(1) {
        constexpr int KD = F8_QKV ? DM / 2 : DM;
        pg8::Gemm g{WSP(bf16_t, WS_XBA), WSP(bf16_t, WS_WQKV), KD, KD, KD}; pg8::GridOrder<0, T / 256, NQKV / 256> S;
        pg8::EpiQKV E{ws, F8_QKV ? 1.0f / WQKV_F8SCALE : 1.0f}; pg8::gemm_phase<pg8::EpiQKV, pg8::GridOrder<0, T / 256, NQKV / 256>, F8_QKV>(F.lds, g, S, E, F.wave);
    }
    GRID_BAR();
    PH(2) swa_phase<F8_WO0>(F, WSP(bf16_t, WS_Q), WSP(bf16_t, WS_K), WSP(bf16_t, WS_VT), (const float*)args.in[4], WSP(unsigned char, WS_O8));
    GRID_BAR();
    PH(3) {
        constexpr int KD = F8_WO0 ? DM / 2 : DM;
        pg8::Gemm g{F8_WO0 ? WSP(bf16_t, WS_O8) : WSP(bf16_t, WS_Q), WSP(bf16_t, WS_WO0), KD, KD, KD}; pg8::GridOrder<0, T / 256, DM / 256> S;
        pg8::EpiRes<false> E{args.in[0], YH, F8_WO0 ? 1.0f / (O0_F8SCALE * WO_F8SCALE) : 1.0f}; pg8::gemm_phase<pg8::EpiRes<false>, pg8::GridOrder<0, T / 256, DM / 256>, F8_WO0, EPI_ALIGN_RES>(F.lds, g, S, E, F.wave);
    }
    GRID_BAR();
    PH(4) ln_phase<F8_FFN1>(F, YH, WSP(bf16_t, WS_XBB), WSP(unsigned char, WS_XBA), (const float*)args.in[18], (const float*)args.in[19]);
    GRID_BAR();
    PH(5) {
        constexpr int KD = F8_FFN1 ? DM / 2 : DM;
        pg8::Gemm g{F8_FFN1 ? WSP(bf16_t, WS_XBA) : WSP(bf16_t, WS_XBB), WSP(bf16_t, WS_W13), KD, KD, KD}; pg8::GridOrder<0, T / 256, 2 * FFN / 256> S;
        pg8::EpiSwiglu<F8_FFN2> E{WSP(bf16_t, WS_ACT), FFN, F8_FFN1 ? 1.0f / W13_F8SCALE : 1.0f, ACT_F8SCALE}; pg8::gemm_phase<pg8::EpiSwiglu<F8_FFN2>, pg8::GridOrder<0, T / 256, 2 * FFN / 256>, F8_FFN1>(F.lds, g, S, E, F.wave);
    }
    GRID_BAR();
    PH(6) {
        constexpr int KD = F8_FFN2 ? FFN / 2 : FFN;
        pg8::Gemm g{WSP(bf16_t, WS_ACT), WSP(bf16_t, WS_W2), KD, KD, KD}; pg8::GridOrder<0, T / 256, DM / 256> S;
        pg8::EpiRes<true> E{WSP(bf16_t, WS_XBB), YH, F8_FFN2 ? 1.0f / (ACT_F8SCALE * W2_F8SCALE) : 1.0f}; pg8::gemm_phase<pg8::EpiRes<true>, pg8::GridOrder<0, T / 256, DM / 256>, F8_FFN2, EPI_ALIGN_RES>(F.lds, g, S, E, F.wave);
    }
    GRID_BAR();
    PH(7) ln_phase<false>(F, YH, WSP(bf16_t, WS_XBA), nullptr, (const float*)args.in[18] + DM, (const float*)args.in[19] + DM);
    REFRESH();
    PH(7) {
        pg8::Gemm g{WSP(bf16_t, WS_PB), WSP(bf16_t, WS_WP0), 256, 256, 256}; pg8::GridOrder<0, T / 256, DM / 256> S;
        pg8::EpiBf16<false> E{WSP(bf16_t, WS_PP0), DM, 1.0f}; pg8::gemm_phase(F.lds, g, S, E, F.wave);
    }
    GRID_BAR();
    PH(8) {
        pg8::Gemm g{WSP(bf16_t, WS_XBA), WSP(bf16_t, WS_WG0), DM, DM, DM}; pg8::GridOrder<0, T / 256, DM / 256> S;
        pg8::EpiPle E{nullptr, ws, 0}; pg8::gemm_phase<pg8::EpiPle, pg8::GridOrder<0, T / 256, DM / 256>, false, EPI_ALIGN_RES>(F.lds, g, S, E, F.wave);
    }
    GRID_BAR();
    PH(9) {
        if constexpr (F8_WIN_SPLIT) {
            { static_assert((T / 256) * WIN_F8_TILES == 7 * pg8::GRID && (T / 256) * (NWIN / 256 - WIN_F8_TILES) == 5 * pg8::GRID / 2, "uneven deal: 7 rounds of e4m3 units, 2.5 rounds of bf16 units");
              pg8::Gemm g{WSP(bf16_t, WS_XB8), WSP(bf16_t, WS_WIN8), DM / 2, DM / 2, DM / 2}; pg8::GridOrder<4, T / 256, WIN_F8_TILES> S;
              pg8::EpiWin E{ws, 1.0f / WIN_F8SCALE, 0}; pg8::gemm_phase<pg8::EpiWin, pg8::GridOrder<4, T / 256, WIN_F8_TILES>, true>(F.lds, g, S, E, F.wave); }
            REFRESH();
            { pg8::Gemm g{WSP(bf16_t, WS_XBB), WSP(bf16_t, WS_WIN) + (size_t)WIN_F8_TILES * 256 * DM, DM, DM, DM}; pg8::GridOrder<0, T / 256, NWIN / 256 - WIN_F8_TILES> S;
              pg8::EpiWin E{ws, 1.0f, WIN_F8_TILES}; pg8::gemm_phase<pg8::EpiWin, pg8::GridOrder<0, T / 256, NWIN / 256 - WIN_F8_TILES>, false>(F.lds, g, S, E, F.wave); }
        } else {
        constexpr int KD = F8_WIN ? DM / 2 : DM;
        pg8::Gemm g{WSP(bf16_t, WS_XBB), WSP(bf16_t, WS_WIN), KD, KD, KD}; pg8::GridOrder<0, T / 256, NWIN / 256> S;
        pg8::EpiWin E{ws, F8_WIN ? 1.0f / WIN_F8SCALE : 1.0f, 0}; pg8::gemm_phase<pg8::EpiWin, pg8::GridOrder<0, T / 256, NWIN / 256>, F8_WIN>(F.lds, g, S, E, F.wave);
        }
    }
    GRID_BAR();
    PH(10) kvnorm_phase(F, WSP(float, WS_CRAW), (const float*)args.in[10], WSP(bf16_t, WS_KV));
    REFRESH();
    PH(11) {
        pg8::Gemm g{WSP(bf16_t, WS_QN), WSP(bf16_t, WS_WUK), DM, 128, 128}; pg8::GridOrder<1, T / 256, 8192 / 256> S;
        pg8::EpiBf16<F8_LAT> E{WSP(bf16_t, WS_QLAT), 8192, F8_LAT ? QLAT_F8SCALE : 1.0f}; pg8::gemm_phase(F.lds, g, S, E, F.wave);
    }
    REFRESH();
    DB(12) { topk_phase(F, WSP(bf16_t, WS_QI), WSP(bf16_t, WS_KIF), WSP(float, WS_WI), WSP(unsigned short, WS_SEL)); REFRESH(); }
    PH(12) topk_phase(F, WSP(bf16_t, WS_QI), WSP(bf16_t, WS_KIF), WSP(float, WS_WI), WSP(unsigned short, WS_SEL));
    GRID_BAR();
    PH(13) dsa_attn_phase(F, WSP(bf16_t, WS_QLAT), WSP(bf16_t, WS_QLAT), WSP(bf16_t, WS_QR), WSP(bf16_t, WS_KV), WSP(unsigned short, WS_SEL), (const float*)args.in[15], (const float*)args.in[16], (const float*)args.in[17], ws);
    GRID_BAR();
    PH(14) {
        constexpr float dsc = F8_LAT ? 1.0f / (OLAT_F8SCALE * WUV_F8SCALE) : 1.0f;
        pg8::Gemm g{WSP(bf16_t, WS_QLAT), WSP(bf16_t, WS_WUV), F8_LAT ? 4096 : 8192, F8_LAT ? 512 : 1024, F8_LAT ? 512 : 1024}; pg8::GridOrder<F8_LAT ? 3 : 2, T / 256, DM / 256> S;
        pg8::EpiBf16<F8_WO1> E{WSP(bf16_t, WS_O2), DM, (F8_WO1 ? O2_F8SCALE : 1.0f) * dsc}; pg8::gemm_phase<pg8::EpiBf16<F8_WO1>, pg8::GridOrder<F8_LAT ? 3 : 2, T / 256, DM / 256>, F8_LAT>(F.lds, g, S, E, F.wave);
    }
    GRID_BAR();
    PH(15) {
        constexpr int KD = F8_WO1 ? DM / 2 : DM;
        pg8::Gemm g{WSP(bf16_t, WS_O2), WSP(bf16_t, WS_WO1), KD, KD, KD}; pg8::GridOrder<0, T / 256, DM / 256> S;
        pg8::EpiRes<true> E{WSP(bf16_t, WS_XBB), YH, F8_WO1 ? 1.0f / (O2_F8SCALE * WO_F8SCALE) : 1.0f}; pg8::gemm_phase<pg8::EpiRes<true>, pg8::GridOrder<0, T / 256, DM / 256>, F8_WO1, EPI_ALIGN_RES>(F.lds, g, S, E, F.wave);
    }
    GRID_BAR();
    PH(16) ln_router_phase(F, YH, WSP(bf16_t, WS_XBA), (const float*)args.in[18] + 2 * DM, (const float*)args.in[19] + 2 * DM, (const float*)args.in[14], WSP(int, WS_TOKE), WSP(float, WS_TOKG), WSP(int, WS_TOKL));
    REFRESH();
    GRID_BAR();
    PH(18) moe_tiles(F);
    REFRESH();
    PH(18) moe_gather_phase(F, WSP(bf16_t, WS_XBA), WSP(int, WS_TOKE), WSP(float, WS_TOKG), WSP(int, WS_TOKL), WSP(int, WS_TOKS), WSP(float, WS_SGATE), WSP(bf16_t, WS_XG));
    GRID_BAR();
    PH(19) {
        const int NTL = __builtin_amdgcn_readfirstlane((int)F.MISC[28]);
        {
            pg8::MoeOrder<false, 2 * MFFN / 256> S; S.tile0 = 0; S.ntl = NTL;
            pg8::Gemm g{WSP(bf16_t, WS_XG), WSP(bf16_t, WS_MW13), DM / 2, DM / 2, DM / 2};
            pg8::EpiSwiglu<true> E{WSP(bf16_t, WS_ACT2), MFFN, 1.0f / W13_F8SCALE, ACT_F8SCALE}; pg8::gemm_phase<pg8::EpiSwiglu<true>, pg8::MoeOrder<false, 2 * MFFN / 256>, true>(F.lds, g, S, E, F.wave);
        }
        GRID_BAR();
        {
            pg8::MoeOrder<true, DM / 256> S; S.tile0 = 0; S.ntl = NTL;
            pg8::Gemm g{WSP(bf16_t, WS_ACT2), WSP(bf16_t, WS_MW2), MFFN / 2, MFFN / 2, MFFN / 2};
            pg8::EpiMoeDown E{ws}; pg8::gemm_phase<pg8::EpiMoeDown, pg8::MoeOrder<true, DM / 256>, true>(F.lds, g, S, E, F.wave);
        }
        REFRESH();
        {
            pg8::GridOrderSkip<T / 256, DM / 256> S; S.skip = (NTL * (DM / 256)) % pg8::GRID;
            pg8::Gemm g{WSP(bf16_t, WS_PB) + (size_t)T * 256, WSP(bf16_t, WS_WP1), 256, 256, 256};
            pg8::EpiBf16<false> E{WSP(bf16_t, WS_PP1), DM, 1.0f}; pg8::gemm_phase(F.lds, g, S, E, F.wave);
        }
        GRID_BAR();
    }
    PH(20) moe_combine_ln_phase(F, YH, WSP(bf16_t, WS_XBB), WSP(bf16_t, WS_SOUT), WSP(int, WS_TOKS), (const float*)args.in[18] + 2 * DM, (const float*)args.in[19] + 2 * DM, (const float*)args.in[18] + 3 * DM, (const float*)args.in[19] + 3 * DM);
    GRID_BAR();
    PH(21) {
        pg8::Gemm g{WSP(bf16_t, WS_XBB), WSP(bf16_t, WS_WG1), DM, DM, DM}; pg8::GridOrder<0, T / 256, DM / 256> S;
        pg8::EpiPle E{args.out, ws, 1}; pg8::gemm_phase<pg8::EpiPle, pg8::GridOrder<0, T / 256, DM / 256>, false, EPI_ALIGN_RES>(F.lds, g, S, E, F.wave);
    }
}

#undef YH
#undef bx
extern "C" void kernel_launch(void* const* d_in, const int* in_sizes, int n_in, void* d_out, int out_size, void* d_ws, size_t ws_size, hipStream_t stream) {
    static int grid = 0;
    if (grid == 0) {
        if (n_in != 22 || out_size != T * DM || ws_size < WS_END) { fprintf(stderr, "kernel_launch: unexpected problem (n_in %d, out %d, ws %zu < %zu)\n", n_in, out_size, ws_size, (size_t)WS_END); grid = -1; return; }
        int dev = 0, cus = 0;
        if (hipGetDevice(&dev) != hipSuccess || hipDeviceGetAttribute(&cus, hipDeviceAttributeMultiprocessorCount, dev) != hipSuccess) { grid = -1; return; }
        if (hipFuncSetAttribute((const void*)mega_fwd, hipFuncAttributeMaxDynamicSharedMemorySize, LDS_BYTES) != hipSuccess) { fprintf(stderr, "kernel_launch: hipFuncSetAttribute failed\n"); grid = -1; return; }
        int per_cu = 0;
        if (hipOccupancyMaxActiveBlocksPerMultiprocessor(&per_cu, (const void*)mega_fwd, NTHREADS, LDS_BYTES) != hipSuccess || per_cu < 1) { fprintf(stderr, "kernel_launch: occupancy query says %d\n", per_cu); }
        (void)hipGetLastError();
        if (cus != pg8::GRID) { fprintf(stderr, "kernel_launch: built for %d CUs, device has %d\n", pg8::GRID, cus); grid = -1; return; }
        grid = cus;
    }
    if (grid < 0) return;
    (void)hipMemsetAsync((char*)d_ws + WS_CTL, 0, CTL_ZERO_BYTES, stream);
    Args a{};
    for (int i = 0; i < 22; ++i) a.in[i] = d_in[i];
    a.out = (float*)d_out; a.ws = (unsigned char*)d_ws;
    hipLaunchKernelGGL(mega_fwd, dim3(grid), dim3(NTHREADS), LDS_BYTES, stream, a);
}
```

```cpp
#include <hip/hip_runtime.h>
#include <cstdio>
#include <cstdint>

#define LAS __attribute__((address_space(3)))
#define GAS __attribute__((address_space(1)))
typedef unsigned short bf16_t;
typedef short bf16x8 __attribute__((ext_vector_type(8)));
typedef short bf16x4 __attribute__((ext_vector_type(4)));
typedef float f32x2 __attribute__((ext_vector_type(2)));
typedef float f32x4 __attribute__((ext_vector_type(4)));
typedef float f32x16 __attribute__((ext_vector_type(16)));
typedef unsigned u32x2 __attribute__((ext_vector_type(2)));
typedef unsigned u32x4 __attribute__((ext_vector_type(4)));
typedef unsigned long long u64;
typedef int i32x2 __attribute__((ext_vector_type(2)));
typedef int i32x4 __attribute__((ext_vector_type(4)));
typedef int i32x8 __attribute__((ext_vector_type(8)));

constexpr int T = 32768, SEQ = 16384, DM = 2048;
constexpr int FFN = 5632, MFFN = 7168, NEXP = 8;
constexpr int NQKV = 2560, NWIN = 4864;
constexpr float ALPHA = 1.41421356237309515f;
constexpr float LN_EPS = 1e-5f, RMS_EPS = 1e-6f;
constexpr float QSCALE_SWA = 0.18033688011112042f;
constexpr float SCALE2_MLA = 0.10411754627697264f;
constexpr float LOG2E = 1.4426950408889634f;
constexpr int NWAVES = 8, NTHREADS = 512;
constexpr float W13_F8SCALE = 32.0f;
constexpr bool F8_FFN1 = true, F8_FFN2 = true, F8_QKV = true, F8_WO0 = true, F8_WIN = false, F8_WO1 = true;
constexpr bool EPI_ALIGN_RES = true;
constexpr bool SWA_FRAG = true;
constexpr bool F8_LAT = true;
constexpr float QLAT_F8SCALE = 8.0f, OLAT_F8SCALE = 32.0f, WUV_F8SCALE = 16.0f;
constexpr bool F8_KV = true;
constexpr float KV_F8SCALE = 16.0f;
constexpr bool F8_WIN_SPLIT = true;
constexpr int WIN_F8_TILES = 14;
constexpr float WQKV_F8SCALE = 32.0f, WIN_F8SCALE = 32.0f, WO_F8SCALE = 64.0f, O0_F8SCALE = 16.0f, O2_F8SCALE = 32.0f;
constexpr float ACT_F8SCALE = 16.0f, W2_F8SCALE = 128.0f;

constexpr size_t MiB = 1u << 20;
constexpr size_t WS_CTL = 0, CTL_ZERO_BYTES = 1 * MiB;
constexpr size_t WS_WQKV = 2 * MiB, WS_WO0 = 12 * MiB, WS_W13 = 20 * MiB, WS_W2 = 64 * MiB, WS_WG0 = 86 * MiB, WS_WG1 = 94 * MiB, WS_WP0 = 102 * MiB, WS_WP1 = 103 * MiB,
                 WS_WIN = 104 * MiB, WS_WUK = 123 * MiB, WS_WUV = 125 * MiB, WS_WO1 = 129 * MiB;
constexpr size_t WS_TAB64 = 137 * MiB, WS_TAB32 = 145 * MiB, WS_PB = 149 * MiB, WS_XBA = 181 * MiB, WS_XBB = 309 * MiB;
constexpr size_t WS_TOKE = 437 * MiB;
constexpr size_t WS_TOKG = WS_TOKE + 256 * 1024;
constexpr size_t WS_TOKL = WS_TOKG + 256 * 1024;
constexpr size_t WS_TOKS = WS_TOKL + 256 * 1024;
constexpr size_t WS_SGATE = WS_TOKS + 256 * 1024;
constexpr size_t WS_WI = 439 * MiB, WS_SEL = 441 * MiB, WS_R = 458 * MiB;
constexpr size_t WS_Q = WS_R, WS_K = WS_R + 128 * MiB, WS_VT = WS_R + 144 * MiB, WS_ACT = WS_R + 160 * MiB, WS_PP0 = WS_R + 512 * MiB, WS_O8 = WS_R + 640 * MiB, WS_XB8 = WS_R + 704 * MiB  , WS_WIN8 = WS_R + 768 * MiB  ;
constexpr size_t WS_QN = WS_R, WS_QR = WS_R + 128 * MiB, WS_CRAW = WS_R + 192 * MiB, WS_KV = WS_R + 256 * MiB, WS_QI = WS_R + 292 * MiB, WS_KIF = WS_R + 356 * MiB,
                 WS_QLAT = WS_R + 360 * MiB, WS_O2 = WS_R + 872 * MiB;
constexpr size_t WS_MW13 = WS_R + 1128 * MiB, WS_MW2 = WS_R + 1352 * MiB, WS_XG = WS_R, WS_SOUT = WS_R + 136 * MiB, WS_ACT2 = WS_R + 404 * MiB  , WS_PP1 = WS_R + 884 * MiB;
constexpr size_t WS_END = WS_R + 1464 * MiB;
constexpr int MAXSLOTS = 67840;
constexpr int CHUNK_TILES = 272;
constexpr int CW_TMO = 0, CW_CNT = 64  , CW_BAR = 4096;

constexpr int LDS_BYTES = 155648;
constexpr int MISC_OFF = 150016;
constexpr int DSA_WBUF = 18688;

typedef __bf16 bf16x2_t __attribute__((ext_vector_type(2)));
__device__ __forceinline__ unsigned cvt_pk_bf16(float lo, float hi) { const f32x2 v = {lo, hi}; return __builtin_bit_cast(unsigned, __builtin_convertvector(v, bf16x2_t)); }
__device__ __forceinline__ float bf2f(unsigned short h) { return __uint_as_float(((unsigned)h) << 16); }
__device__ __forceinline__ float bflo(unsigned w) { return __uint_as_float(w << 16); }
__device__ __forceinline__ float bfhi(unsigned w) { return __uint_as_float(w & 0xffff0000u); }
__device__ __forceinline__ int fresh_lane() { unsigned m = ~0u; asm volatile("" : "+v"(m)); return (int)__builtin_amdgcn_mbcnt_hi(m, __builtin_amdgcn_mbcnt_lo(m, 0u)); }
__device__ __forceinline__ float shx(float v, int o, int lane) { return __int_as_float(__builtin_amdgcn_ds_bpermute((lane ^ o) << 2, __float_as_int(v))); }
__device__ __forceinline__ float wave_sum(float v) {
    const int l = fresh_lane();
#pragma unroll
    for (int o = 1; o < 64; o <<= 1) v += shx(v, o, l);
    return v;
}
__device__ __forceinline__ unsigned pk4_fp8(float a, float b, float c, float d) { unsigned w = 0u; w = (unsigned)__builtin_amdgcn_cvt_pk_fp8_f32(a, b, (int)w, false); w = (unsigned)__builtin_amdgcn_cvt_pk_fp8_f32(c, d, (int)w, true); return w; }
#define LDS_WAIT() asm volatile("s_waitcnt lgkmcnt(0)" ::: "memory")
#define VM_WAIT() asm volatile("s_waitcnt vmcnt(0)" ::: "memory")

namespace pg8 {
constexpr int BM = 256, BK = 64, HALF = 128, HTB = HALF * BK * 2, STAGE_BYTES = 8 * HTB, NXCD = 8, WGM = 8;
__host__ __device__ __forceinline__ int lds_byte(int r, int c) { const int st = (r >> 4) * 2 + (c >> 5), rr = r & 15, cc = c & 31, ob = rr * 64 + cc * 2; return st * 1024 + (ob ^ (((ob >> 9) & 1) << 5)); }
__host__ __device__ __forceinline__ void stage_rc(int b, int& R, int& C) { const int st = b / 1024, sb = b % 1024, swz = sb ^ (((sb >> 9) & 1) << 5); R = (st >> 1) * 16 + swz / 64; C = (st & 1) * 32 + (swz % 64) / 2; }
__host__ __device__ __forceinline__ int perm32(int rho) { const int n = rho >> 4, i = rho & 15; return 8 * (i >> 2) + 4 * n + (i & 3); }

struct Unit { int pm, pn, am, acol, bn; };
struct Gemm { const bf16_t* A; const bf16_t* Bt; int lda, ldb, K; };

constexpr int GRID = 256;
template <int MODE, int NM, int NN> struct GridOrder {
    __device__ __forceinline__ bool next(int i, Unit& u) const {
        constexpr int nwg = NM * NN;
        int L = i * GRID + (int)blockIdx.x;
        if constexpr (MODE == 4) {
            if (i >= 6) { if ((int)blockIdx.x < GRID / 2 || i >= 8) return false; L = 6 * GRID + ((int)blockIdx.x - GRID / 2) * 2 + (i - 6); } }
        if (L >= nwg) return false;
        int wgid = L; { constexpr int q = nwg / NXCD, r = nwg % NXCD; const int xcd = wgid % NXCD, off = wgid / NXCD; wgid = (xcd < r ? xcd * (q + 1) : r * (q + 1) + (xcd - r) * q) + off; }
        constexpr int nig = WGM * NN; const int gid = wgid / nig, fm = gid * WGM, gsz = (NM - fm) < WGM ? (NM - fm) : WGM;
        u.pm = fm + ((wgid % nig) % gsz); u.pn = (wgid % nig) / gsz; u.am = u.pm; u.bn = u.pn;
        u.acol = MODE == 1 ? (u.pn >> 1) * 128 : (MODE == 2 ? u.pn * 1024 : (MODE == 3 ? u.pn * 512 : 0));
        return true;
    }
};
template <int NM, int NN> struct GridOrderSkip {
    int skip;
    __device__ __forceinline__ bool next(int i, Unit& u) const {
        constexpr int nwg = NM * NN; const int nW = GRID - skip, br = (int)blockIdx.x - skip; if (br < 0) return false;
        const int L = i * nW + br; if (L >= nwg) return false;
        int wgid = L; { constexpr int q = nwg / NXCD, r = nwg % NXCD; const int xcd = wgid % NXCD, off = wgid / NXCD; wgid = (xcd < r ? xcd * (q + 1) : r * (q + 1) + (xcd - r) * q) + off; }
        constexpr int nig = WGM * NN; const int gid = wgid / nig, fm = gid * WGM, gsz = (NM - fm) < WGM ? (NM - fm) : WGM;
        u.pm = fm + ((wgid % nig) % gsz); u.pn = (wgid % nig) / gsz; u.am = u.pm; u.bn = u.pn; u.acol = 0;
        return true;
    }
};
template <bool DOWN, int NN> struct MoeOrder {
    int tile0, ntl;
    __device__ __forceinline__ bool next(int i, Unit& u) const {
        int pml, pn;
        if constexpr (!DOWN && NN % 8 == 0) {
            constexpr int NJ = NN / 8; const int x = (int)blockIdx.x & 7, q = i * (GRID / 8) + ((int)blockIdx.x >> 3); if (q >= ntl * NJ) return false;
            const int nfull = ntl >> 3; int m, j;
            if (q < nfull * 8 * NJ) { const int b = q / (8 * NJ), w = q - b * (8 * NJ); m = b * 8 + (w & 7); j = w >> 3; }
            else { const int g = ntl - nfull * 8, w = q - nfull * 8 * NJ; j = w / g; m = nfull * 8 + (w - j * g); }
            pml = m; pn = 8 * j + x;
        } else {
        const int L = i * GRID + (int)blockIdx.x; if (L >= ntl * NN) return false;
        constexpr int nig = WGM * NN; const int wgid = L, gid = wgid / nig, fm = gid * WGM, gsz = (ntl - fm) < WGM ? (ntl - fm) : WGM;
        pml = fm + ((wgid % nig) % gsz); pn = (wgid % nig) / gsz; }
        const int pmg = tile0 + pml;
        const u32x4 t0 = *(const LAS u32x4*)(MISC_OFF + 20 * 4), t1 = *(const LAS u32x4*)(MISC_OFF + 24 * 4);
        int e = (pmg >= (int)t0.x) + (pmg >= (int)t0.y) + (pmg >= (int)t0.z) + (pmg >= (int)t0.w) + (pmg >= (int)t1.x) + (pmg >= (int)t1.y) + (pmg >= (int)t1.z);
        e = __builtin_amdgcn_readfirstlane(e);
        u.pn = pn; u.bn = e * NN + pn; u.acol = 0;
        if (DOWN) { u.pm = pmg; u.am = pml; } else { u.pm = pml; u.am = pmg; }
        return true;
    }
};

__device__ __forceinline__ void stage16_s(const char* gbase, unsigned voff, unsigned lds_dst) { unsigned keep;
    asm volatile("s_mov_b32 %0, m0\n\ts_mov_b32 m0, %3\n\ts_nop 0\n\tglobal_load_lds_dwordx4 %1, %2\n\ts_mov_b32 m0, %0" : "=&s"(keep) : "v"(voff), "s"(gbase), "s"(lds_dst) : "memory"); }
template <class Epi, class Sched, bool FP8 = false, bool ALIGN = true>
__device__ __forceinline__ void gemm_phase(LAS unsigned char* lds, const Gemm g, const Sched& S, const Epi& E, int wave_) {
    int tid_ = wave_ * 64 + fresh_lane(); asm volatile("" : "+v"(tid_));
    const int tid = tid_, wid = __builtin_amdgcn_readfirstlane(tid >> 6), lane = tid & 63, wr = wid >> 2, wc = wid & 3, fr = lane & 15, fq = lane >> 4;
    int K_ = g.K; asm volatile("" : "+s"(K_));
    const int K = K_, nt = K / BK;
    unsigned voffA[2], voffB[2];
#pragma unroll
    for (int i = 0; i < 2; ++i) { int R, C; stage_rc(tid * 16 + i * 8192, R, C); const int Rb = (R & ~31) + perm32(R & 31);
        voffA[i] = (unsigned)(R * g.lda + C) * 2u; voffB[i] = (unsigned)(Rb * g.ldb + C) * 2u; }
    const size_t kstep = (size_t)(BK * 2);
    const size_t hstepA = (size_t)HALF * g.lda * 2, hstepB = (size_t)HALF * g.ldb * 2;
    const unsigned ldsw = (unsigned)wid * 1024u;
    const int aoff = lds_byte(wr * 64 + fr, fq * 8), boff = lds_byte(wc * 32 + fr, fq * 8);
#define PG8_SA(b, h) (((b) * 2 + (h)) * HTB)
#define PG8_SB(b, h) ((4 + (b) * 2 + (h)) * HTB)
#define PG8_STAGE(bufoff, gbase, voff) do { _Pragma("unroll") for (int _i = 0; _i < 2; ++_i) { \
        if constexpr (FP8) stage16_s((const char*)(gbase), (voff)[_i], (unsigned)(size_t)(lds + (bufoff) + ldsw + _i * 8192)); \
        else __builtin_amdgcn_global_load_lds((const unsigned*)((const char*)(gbase) + (voff)[_i]), (LAS unsigned*)(lds + (bufoff) + ldsw + _i * 8192), 16, 0, 0); } } while (0)
#define PG8_LDA(dst, b, h) do { _Pragma("unroll") for (int m = 0; m < 4; ++m) _Pragma("unroll") for (int k = 0; k < 2; ++k) dst[m][k] = *(const LAS bf16x8*)(lds + PG8_SA(b, h) + aoff + m * 2048 + k * 1024); } while (0)
#define PG8_LDB(dst, b, h) do { _Pragma("unroll") for (int n = 0; n < 2; ++n) _Pragma("unroll") for (int k = 0; k < 2; ++k) dst[n][k] = *(const LAS bf16x8*)(lds + PG8_SB(b, h) + boff + n * 2048 + k * 1024); } while (0)
#define PG8_MMA(ai, bj, At, Bt) do { __builtin_amdgcn_s_setprio(1); _Pragma("unroll") for (int m = 0; m < 4; ++m) _Pragma("unroll") for (int n = 0; n < 2; ++n) _Pragma("unroll") for (int k = 0; k < 2; ++k) \
        acc[ai][bj][m][n] = __builtin_amdgcn_mfma_f32_16x16x32_bf16(Bt[n][k], At[m][k], acc[ai][bj][m][n], 0, 0, 0); __builtin_amdgcn_s_setprio(0); } while (0)
#define PG8_LDA8(dst, b, h) do { _Pragma("unroll") for (int m = 0; m < 4; ++m) { const i32x4 lo_ = *(const LAS i32x4*)(lds + PG8_SA(b, h) + aoff + m * 2048), hi_ = *(const LAS i32x4*)(lds + PG8_SA(b, h) + aoff + m * 2048 + 1024); \
        dst[m] = __builtin_shufflevector(lo_, hi_, 0, 1, 2, 3, 4, 5, 6, 7); } } while (0)
#define PG8_LDB8(dst, b, h) do { _Pragma("unroll") for (int n = 0; n < 2; ++n) { const i32x4 lo_ = *(const LAS i32x4*)(lds + PG8_SB(b, h) + boff + n * 2048), hi_ = *(const LAS i32x4*)(lds + PG8_SB(b, h) + boff + n * 2048 + 1024); \
        dst[n] = __builtin_shufflevector(lo_, hi_, 0, 1, 2, 3, 4, 5, 6, 7); } } while (0)
#define PG8_MMA8(ai, bj, At, Bt) do { __builtin_amdgcn_s_setprio(1); _Pragma("unroll") for (int m = 0; m < 4; ++m) _Pragma("unroll") for (int n = 0; n < 2; ++n) \
        acc[ai][bj][m][n] = __builtin_amdgcn_mfma_scale_f32_16x16x128_f8f6f4(Bt[n], At[m], acc[ai][bj][m][n], 0, 0, 0, 0, 0, 0); __builtin_amdgcn_s_setprio(0); } while (0)
#define PG8_WAIT_V(n) asm volatile("s_waitcnt vmcnt(" #n ")" ::: "memory")
#define PG8_WAIT_L(n) asm volatile("s_waitcnt lgkmcnt(" #n ")" ::: "memory")
#define PG8_BAR __builtin_amdgcn_s_barrier()
#define PG8_SCHED __builtin_amdgcn_sched_barrier(0)
#define PG8_ABASE(u) ((const char*)g.A + ((size_t)(u).am * BM * g.lda + (size_t)(u).acol) * 2)
#define PG8_BBASE(u) ((const char*)g.Bt + (size_t)(u).bn * BM * g.ldb * 2)
    Unit cur, nxt; int ui = 0;
    if (!S.next(0, cur)) return;
    f32x4 acc[2][2][4][2];
#pragma unroll
    for (int a = 0; a < 2; ++a)
#pragma unroll
        for (int b = 0; b < 2; ++b)
#pragma unroll
            for (int m = 0; m < 4; ++m)
#pragma unroll
                for (int n = 0; n < 2; ++n) acc[a][b][m][n] = (f32x4){0.f, 0.f, 0.f, 0.f};
    bf16x8 At[4][2], B0[2][2], B1[2][2]; i32x8 At8[4], B08[2], B18[2];
    const char* cA = PG8_ABASE(cur); const char* cB = PG8_BBASE(cur);
    {
        PG8_STAGE(PG8_SB(0, 0), cB, voffB); PG8_STAGE(PG8_SB(0, 1), cB + hstepB, voffB); PG8_STAGE(PG8_SA(0, 0), cA, voffA); PG8_STAGE(PG8_SA(0, 1), cA + hstepA, voffA);
        if (wr == 1) PG8_BAR;
        PG8_WAIT_V(2); PG8_BAR;
        PG8_STAGE(PG8_SB(1, 0), cB + kstep, voffB); PG8_STAGE(PG8_SA(1, 0), cA + kstep, voffA); PG8_STAGE(PG8_SB(1, 1), cB + hstepB + kstep, voffB);
        PG8_WAIT_V(6); PG8_BAR;
    }
    for (;;) {
        const bool has_next = S.next(ui + 1, nxt);
        const char* nA = has_next ? PG8_ABASE(nxt) : cA; const char* nB = has_next ? PG8_BBASE(nxt) : cB;
        for (int t = 0; t < nt; t += 2) {
            const bool last = (t == nt - 2);
            const char* a1 = cA + (size_t)(t + 1) * kstep;
            const char* a2 = last ? nA : cA + (size_t)(t + 2) * kstep; const char* b2 = last ? nB : cB + (size_t)(t + 2) * kstep;
            const char* a3 = a2 + kstep; const char* b3 = b2 + kstep;
            if constexpr (FP8) {
            PG8_LDB8(B08, 0, 0); PG8_LDB8(B18, 0, 1); PG8_SCHED; PG8_LDA8(At8, 0, 0); PG8_STAGE(PG8_SA(1, 1), a1 + hstepA, voffA);
            PG8_WAIT_V(8); PG8_WAIT_L(0); PG8_BAR; PG8_MMA8(0, 0, At8, B08); PG8_MMA8(0, 1, At8, B18); PG8_BAR; PG8_SCHED;
            PG8_LDA8(At8, 0, 1); PG8_STAGE(PG8_SB(0, 0), b2, voffB); PG8_STAGE(PG8_SB(0, 1), b2 + hstepB, voffB); PG8_STAGE(PG8_SA(0, 0), a2, voffA);
            PG8_WAIT_V(8); PG8_WAIT_L(0); PG8_BAR; PG8_MMA8(1, 0, At8, B08); PG8_MMA8(1, 1, At8, B18); PG8_BAR; PG8_SCHED;
            PG8_LDB8(B08, 1, 0); PG8_LDB8(B18, 1, 1); PG8_SCHED; PG8_LDA8(At8, 1, 0); PG8_STAGE(PG8_SA(0, 1), a2 + hstepA, voffA);
            PG8_WAIT_V(8); PG8_WAIT_L(0); PG8_BAR; PG8_MMA8(0, 0, At8, B08); PG8_MMA8(0, 1, At8, B18); PG8_BAR; PG8_SCHED;
            PG8_LDA8(At8, 1, 1); PG8_STAGE(PG8_SB(1, 0), b3, voffB); PG8_STAGE(PG8_SB(1, 1), b3 + hstepB, voffB); PG8_STAGE(PG8_SA(1, 0), a3, voffA);
            PG8_WAIT_V(8); PG8_WAIT_L(0); PG8_BAR; PG8_MMA8(1, 0, At8, B08); PG8_MMA8(1, 1, At8, B18); PG8_BAR; PG8_SCHED;
            } else {
            PG8_LDB(B0, 0, 0); PG8_LDB(B1, 0, 1); PG8_SCHED; PG8_LDA(At, 0, 0); PG8_STAGE(PG8_SA(1, 1), a1 + hstepA, voffA);
            PG8_WAIT_V(8); PG8_WAIT_L(0); PG8_BAR; PG8_MMA(0, 0, At, B0); PG8_MMA(0, 1, At, B1); PG8_BAR; PG8_SCHED;
            PG8_LDA(At, 0, 1); PG8_STAGE(PG8_SB(0, 0), b2, voffB); PG8_STAGE(PG8_SB(0, 1), b2 + hstepB, voffB); PG8_STAGE(PG8_SA(0, 0), a2, voffA);
            PG8_WAIT_V(8); PG8_WAIT_L(0); PG8_BAR; PG8_MMA(1, 0, At, B0); PG8_MMA(1, 1, At, B1); PG8_BAR; PG8_SCHED;
            PG8_LDB(B0, 1, 0); PG8_LDB(B1, 1, 1); PG8_SCHED; PG8_LDA(At, 1, 0); PG8_STAGE(PG8_SA(0, 1), a2 + hstepA, voffA);
            PG8_WAIT_V(8); PG8_WAIT_L(0); PG8_BAR; PG8_MMA(0, 0, At, B0); PG8_MMA(0, 1, At, B1); PG8_BAR; PG8_SCHED;
            PG8_LDA(At, 1, 1); PG8_STAGE(PG8_SB(1, 0), b3, voffB); PG8_STAGE(PG8_SB(1, 1), b3 + hstepB, voffB); PG8_STAGE(PG8_SA(1, 0), a3, voffA);
            PG8_WAIT_V(8); PG8_WAIT_L(0); PG8_BAR; PG8_MMA(1, 0, At, B0); PG8_MMA(1, 1, At, B1); PG8_BAR; PG8_SCHED;
            }
        }
        if constexpr (ALIGN) { if (wr == 0) PG8_BAR; }
        { int fr_ = fr, fq_ = fq; asm volatile("" : "+v"(fr_), "+v"(fq_));
          E(acc, cur, wr, wc, fr_, fq_); }
        if (!has_next) break;
#pragma unroll
        for (int a = 0; a < 2; ++a)
#pragma unroll
            for (int b = 0; b < 2; ++b)
#pragma unroll
                for (int m = 0; m < 4; ++m)
#pragma unroll
                    for (int n = 0; n < 2; ++n) acc[a][b][m][n] = (f32x4){0.f, 0.f, 0.f, 0.f};
        cur = nxt; cA = nA; cB = nB; ++ui;
        if constexpr (ALIGN) { if (wr == 1) PG8_BAR; }
    }
    PG8_WAIT_V(0);
    if constexpr (!ALIGN) { if (wr == 0) PG8_BAR; }
    PG8_BAR;
#undef PG8_SA
#undef PG8_SB
#undef PG8_STAGE
#undef PG8_LDA
#undef PG8_LDB
#undef PG8_MMA
#undef PG8_LDA8
#undef PG8_LDB8
#undef PG8_MMA8
#undef PG8_WAIT_V
#undef PG8_WAIT_L
#undef PG8_BAR
#undef PG8_SCHED
#undef PG8_ABASE
#undef PG8_BBASE
}

#define EPI_ROW(ai, m) (u.pm * BM + (ai) * HALF + wr * 64 + (m) * 16 + fr)
#define EPI_COL(bj) (u.pn * BM + (bj) * HALF + wc * 32 + 8 * fq)
typedef f32x4 AccT[2][2][4][2];

__device__ __forceinline__ void rope4(f32x4& v0, f32x4& v1, const f32x4 cs0, const f32x4 cs1) {
    f32x4 o0, o1;
    o0[0] = v0[0] * cs0[0] - v0[1] * cs0[1]; o0[1] = v0[1] * cs0[0] + v0[0] * cs0[1];
    o0[2] = v0[2] * cs0[2] - v0[3] * cs0[3]; o0[3] = v0[3] * cs0[2] + v0[2] * cs0[3];
    o1[0] = v1[0] * cs1[0] - v1[1] * cs1[1]; o1[1] = v1[1] * cs1[0] + v1[0] * cs1[1];
    o1[2] = v1[2] * cs1[2] - v1[3] * cs1[3]; o1[3] = v1[3] * cs1[2] + v1[2] * cs1[3];
    v0 = o0; v1 = o1;
}
__device__ __forceinline__ u32x4 pack8(const f32x4 v0, const f32x4 v1) { u32x4 w; w.x = cvt_pk_bf16(v0[0], v0[1]); w.y = cvt_pk_bf16(v0[2], v0[3]); w.z = cvt_pk_bf16(v1[0], v1[1]); w.w = cvt_pk_bf16(v1[2], v1[3]); return w; }

__device__ __forceinline__ void unpack8(const u32x4 w, f32x4& a, f32x4& b) { a[0] = bflo(w.x); a[1] = bfhi(w.x); a[2] = bflo(w.y); a[3] = bfhi(w.y); b[0] = bflo(w.z); b[1] = bfhi(w.z); b[2] = bflo(w.w); b[3] = bfhi(w.w); }
__device__ __forceinline__ u32x2 pack8_fp8(const f32x4 v0, const f32x4 v1, float s) { u32x2 w; w.x = pk4_fp8(v0[0] * s, v0[1] * s, v0[2] * s, v0[3] * s); w.y = pk4_fp8(v1[0] * s, v1[1] * s, v1[2] * s, v1[3] * s); return w; }
template <bool OUT8> struct EpiBf16 {
    bf16_t* O; int ldc; float osc;
    __device__ __forceinline__ void operator()(const AccT& acc, const Unit& u, int wr, int wc, int fr, int fq) const {
#pragma unroll
        for (int ai = 0; ai < 2; ++ai)
#pragma unroll
            for (int m = 0; m < 4; ++m) {
#pragma unroll
                for (int bj = 0; bj < 2; ++bj) {
                    if constexpr (OUT8) *(u32x2*)((unsigned char*)O + (size_t)EPI_ROW(ai, m) * ldc + EPI_COL(bj)) = pack8_fp8(acc[ai][bj][m][0], acc[ai][bj][m][1], osc);
                    else *(u32x4*)(O + (size_t)EPI_ROW(ai, m) * ldc + EPI_COL(bj)) = pack8(acc[ai][bj][m][0] * osc, acc[ai][bj][m][1] * osc); } }
    }
};
struct EpiQKV {
    unsigned char* ws; float asc;
    __device__ __forceinline__ void operator()(const AccT& acc, const Unit& u, int wr, int wc, int fr, int fq) const {
        bf16_t* Q = (bf16_t*)(ws + WS_Q); bf16_t* Kb = (bf16_t*)(ws + WS_K); bf16_t* VT = (bf16_t*)(ws + WS_VT); const float* tab64 = (const float*)(ws + WS_TAB64);
        if (u.pn < 9) {
            bf16_t* base = u.pn < 8 ? Q : Kb; const int ldc = u.pn < 8 ? 2048 : 256; const int colt = u.pn < 8 ? u.pn * BM : 0; const float sc = (u.pn < 8 ? QSCALE_SWA : 1.0f) * asc;
#pragma unroll
            for (int ai = 0; ai < 2; ++ai)
#pragma unroll
                for (int m = 0; m < 4; ++m) { const int row = EPI_ROW(ai, m);
#pragma unroll
                    for (int bj = 0; bj < 2; ++bj) { const int cl = bj * HALF + wc * 32 + 8 * fq; const int i0 = (cl & 63) >> 1;
                        const f32x4 cs0 = *(const f32x4*)(tab64 + ((size_t)row * 32 + i0) * 2), cs1 = *(const f32x4*)(tab64 + ((size_t)row * 32 + i0) * 2 + 4);
                        f32x4 v0 = acc[ai][bj][m][0], v1 = acc[ai][bj][m][1]; rope4(v0, v1, cs0, cs1); v0 = v0 * sc; v1 = v1 * sc;
                        if constexpr (SWA_FRAG) {
                            const int b = row >> 14, s = row & (SEQ - 1), hh = (colt + cl) >> 6, c64 = cl & 63, kk = c64 >> 4, hf2 = (c64 >> 3) & 1, nh = u.pn < 8 ? 32 : 4;
                            *(u32x4*)(base + ((((size_t)(b * nh + hh) * 512 + (s >> 5)) * 4 + kk) * 64 + hf2 * 32 + (s & 31)) * 8) = pack8(v0, v1); }
                        else *(u32x4*)(base + (size_t)row * ldc + colt + cl) = pack8(v0, v1); } }
        } else {
#pragma unroll
            for (int ai = 0; ai < 2; ++ai)
#pragma unroll
                for (int m = 0; m < 4; ++m) { const int row = EPI_ROW(ai, m), b = row >> 14, s = row & (SEQ - 1);
#pragma unroll
                    for (int bj = 0; bj < 2; ++bj) { const int cl = bj * HALF + wc * 32 + 8 * fq, kvh = cl >> 6, d0 = cl & 63;
                        const u32x4 w = pack8(acc[ai][bj][m][0] * asc, acc[ai][bj][m][1] * asc);
                        if constexpr (SWA_FRAG) {
                            const int j = s & 31, c = j >> 4, jj = j & 15, hfv = (jj & 7) >> 2, e = (jj & 3) + ((jj >> 3) << 2), mt = d0 >> 5;
                            bf16_t* pf = VT + (((((size_t)(b * 4 + kvh) * 512 + (s >> 5)) * 2 + c) * 2 + mt) * 64 + hfv * 32 + (d0 & 31)) * 8 + e;
                            pf[0] = (bf16_t)(w.x & 0xffff); pf[8] = (bf16_t)(w.x >> 16); pf[16] = (bf16_t)(w.y & 0xffff); pf[24] = (bf16_t)(w.y >> 16);
                            pf[32] = (bf16_t)(w.z & 0xffff); pf[40] = (bf16_t)(w.z >> 16); pf[48] = (bf16_t)(w.w & 0xffff); pf[56] = (bf16_t)(w.w >> 16); }
                        else {
                        bf16_t* p = VT + ((size_t)(b * 4 + kvh) * 64 + d0) * SEQ + s;
                        p[0 * SEQ] = (bf16_t)(w.x & 0xffff); p[1 * SEQ] = (bf16_t)(w.x >> 16); p[2 * SEQ] = (bf16_t)(w.y & 0xffff); p[3 * SEQ] = (bf16_t)(w.y >> 16);
                        p[4 * SEQ] = (bf16_t)(w.z & 0xffff); p[5 * SEQ] = (bf16_t)(w.z >> 16); p[6 * SEQ] = (bf16_t)(w.w & 0xffff); p[7 * SEQ] = (bf16_t)(w.w >> 16); } } }
        }
    }
};
template <bool RES16> struct EpiRes {
    const void* res; bf16_t* out; float sc;
    __device__ __forceinline__ void operator()(const AccT& acc, const Unit& u, int wr, int wc, int fr, int fq) const {
#pragma unroll
        for (int ai = 0; ai < 2; ++ai)
#pragma unroll
            for (int m = 0; m < 4; ++m) { const size_t ro = (size_t)EPI_ROW(ai, m) * DM;
#pragma unroll
                for (int bj = 0; bj < 2; ++bj) { const size_t o = ro + EPI_COL(bj); f32x4 r0, r1;
                    if constexpr (RES16) unpack8(*(const u32x4*)((const bf16_t*)res + o), r0, r1);
                    else { r0 = *(const f32x4*)((const float*)res + o); r1 = *(const f32x4*)((const float*)res + o + 4); }
                    *(u32x4*)(out + o) = pack8(r0 * ALPHA + acc[ai][bj][m][0] * sc, r1 * ALPHA + acc[ai][bj][m][1] * sc); }
                asm volatile("" ::: "memory"); }
    }
};
__device__ __forceinline__ float silu_mul(float g, float uu) { return g * __builtin_amdgcn_rcpf(1.0f + __builtin_amdgcn_exp2f(-g * LOG2E)) * uu; }
template <bool OUT8> struct EpiSwiglu {
    bf16_t* O; int ldc; float sc; float osc;
    __device__ __forceinline__ void operator()(const AccT& acc, const Unit& u, int wr, int wc, int fr, int fq) const {
#pragma unroll
        for (int ai = 0; ai < 2; ++ai)
#pragma unroll
            for (int m = 0; m < 4; ++m) { f32x4 a0, a1;
#pragma unroll
                for (int j = 0; j < 4; ++j) { a0[j] = silu_mul(acc[ai][0][m][0][j] * sc, acc[ai][1][m][0][j] * sc); a1[j] = silu_mul(acc[ai][0][m][1][j] * sc, acc[ai][1][m][1][j] * sc); }
                if constexpr (OUT8) { u32x2 w8; w8.x = pk4_fp8(a0[0] * osc, a0[1] * osc, a0[2] * osc, a0[3] * osc); w8.y = pk4_fp8(a1[0] * osc, a1[1] * osc, a1[2] * osc, a1[3] * osc);
                    *(u32x2*)((unsigned char*)O + (size_t)EPI_ROW(ai, m) * ldc + u.pn * HALF + wc * 32 + 8 * fq) = w8; }
                else *(u32x4*)(O + (size_t)EPI_ROW(ai, m) * ldc + u.pn * HALF + wc * 32 + 8 * fq) = pack8(a0, a1); }
    }
};
struct EpiPle {
    float* outf; unsigned char* ws; int layer;
    __device__ __forceinline__ void operator()(const AccT& acc, const Unit& u, int wr, int wc, int fr, int fq) const {
        const bf16_t* pp = (const bf16_t*)(ws + (layer == 0 ? WS_PP0 : WS_PP1));
        const bf16_t* xres = (const bf16_t*)(ws + (layer == 0 ? WS_XBA : WS_XBB));
#pragma unroll
        for (int ai = 0; ai < 2; ++ai)
#pragma unroll
            for (int m = 0; m < 4; ++m) { const size_t ro = (size_t)EPI_ROW(ai, m) * DM;
#pragma unroll
                for (int bj = 0; bj < 2; ++bj) { const size_t o = ro + EPI_COL(bj);
                    f32x4 r0, r1, p0, p1; unpack8(*(const u32x4*)(xres + o), r0, r1); unpack8(*(const u32x4*)(pp + o), p0, p1);
                    f32x4 s0, s1;
#pragma unroll
                    for (int j = 0; j < 4; ++j) { s0[j] = __builtin_amdgcn_rcpf(1.0f + __builtin_amdgcn_exp2f(-acc[ai][bj][m][0][j] * LOG2E)); s1[j] = __builtin_amdgcn_rcpf(1.0f + __builtin_amdgcn_exp2f(-acc[ai][bj][m][1][j] * LOG2E)); }
                    const f32x4 o0 = r0 + s0 * p0, o1 = r1 + s1 * p1;
                    if (layer == 0) { *(u32x4*)((bf16_t*)(ws + WS_XBB) + o) = pack8(o0, o1);
                                      if constexpr (F8_WIN_SPLIT || F8_WIN) *(u32x2*)(ws + WS_XB8 + o) = pack8_fp8(o0, o1, 1.0f); }
                    else { *(f32x4*)(outf + o) = o0; *(f32x4*)(outf + o + 4) = o1; } }
                asm volatile("" ::: "memory"); }
    }
};
struct EpiWin {
    unsigned char* ws; float asc; int pn0;
    __device__ __forceinline__ void operator()(const AccT& acc, const Unit& u, int wr, int wc, int fr, int fq) const {
        bf16_t* QN = (bf16_t*)(ws + WS_QN); bf16_t* QR = (bf16_t*)(ws + WS_QR); float* CRAW = (float*)(ws + WS_CRAW); bf16_t* KV = (bf16_t*)(ws + WS_KV); bf16_t* QI = (bf16_t*)(ws + WS_QI);
        bf16_t* KIF = (bf16_t*)(ws + WS_KIF); float* WI = (float*)(ws + WS_WI); const float* tab64 = (const float*)(ws + WS_TAB64); const float* tab32 = (const float*)(ws + WS_TAB32);
        const int pn = u.pn + pn0;
#pragma unroll
        for (int ai = 0; ai < 2; ++ai)
#pragma unroll
            for (int m = 0; m < 4; ++m) { const int row = EPI_ROW(ai, m);
#pragma unroll
                for (int bj = 0; bj < 2; ++bj) { const int cl = bj * HALF + wc * 32 + 8 * fq; f32x4 v0 = acc[ai][bj][m][0] * asc, v1 = acc[ai][bj][m][1] * asc;
                    if (pn < 8) { *(u32x4*)(QN + (size_t)row * 2048 + pn * BM + cl) = pack8(v0, v1); }
                    else if (pn < 12) { const int i0 = (cl & 63) >> 1;
                        const f32x4 cs0 = *(const f32x4*)(tab64 + ((size_t)row * 32 + i0) * 2), cs1 = *(const f32x4*)(tab64 + ((size_t)row * 32 + i0) * 2 + 4);
                        rope4(v0, v1, cs0, cs1); if constexpr (F8_LAT) { v0 = v0 * QLAT_F8SCALE; v1 = v1 * QLAT_F8SCALE; }
                        if constexpr (F8_KV) *(u32x2*)((unsigned char*)QR + (size_t)row * 1024 + (pn - 8) * BM + cl) = pack8_fp8(v0, v1, 1.0f);
                        else *(u32x4*)(QR + (size_t)row * 1024 + (pn - 8) * BM + cl) = pack8(v0, v1); }
                    else if (pn < 14) { float* p = CRAW + (size_t)row * 512 + (pn - 12) * BM + cl; *(f32x4*)p = v0; *(f32x4*)(p + 4) = v1; }
                    else if (pn == 14) {
                        if (cl < 64) { const int i0 = cl >> 1;
                            const f32x4 cs0 = *(const f32x4*)(tab64 + ((size_t)row * 32 + i0) * 2), cs1 = *(const f32x4*)(tab64 + ((size_t)row * 32 + i0) * 2 + 4);
                            rope4(v0, v1, cs0, cs1);
                            if constexpr (F8_KV) *(u32x2*)((unsigned char*)KV + (size_t)row * 576 + 512 + cl) = pack8_fp8(v0, v1, KV_F8SCALE);
                            else *(u32x4*)(KV + (size_t)row * 576 + 512 + cl) = pack8(v0, v1); }
                        else if (cl < 128) { const int d8 = cl - 64;
                            if (d8 < 32) { const int i0 = d8 >> 1;
                                const f32x4 cs0 = *(const f32x4*)(tab32 + ((size_t)row * 16 + i0) * 2), cs1 = *(const f32x4*)(tab32 + ((size_t)row * 16 + i0) * 2 + 4);
                                rope4(v0, v1, cs0, cs1); }
                            const int b = row >> 14, s = row & (SEQ - 1), blk = s >> 5, j = s & 31, kk = d8 >> 4, hf = (d8 >> 3) & 1;
                            *(u32x4*)(KIF + ((size_t)((b * 512 + blk) * 4 + kk) * 64 + hf * 32 + j) * 8) = pack8(v0, v1); }
                        else if (cl < 144) { float* p = WI + (size_t)row * 16 + (cl - 128); *(f32x4*)p = v0; *(f32x4*)(p + 4) = v1; }
                    } else { const int cq = (pn - 15) * BM + cl, d8 = cq & 63;
                        if (d8 < 32) { const int i0 = d8 >> 1;
                            const f32x4 cs0 = *(const f32x4*)(tab32 + ((size_t)row * 16 + i0) * 2), cs1 = *(const f32x4*)(tab32 + ((size_t)row * 16 + i0) * 2 + 4);
                            rope4(v0, v1, cs0, cs1); }
                        *(u32x4*)(QI + (size_t)row * 1024 + cq) = pack8(v0, v1); }
                } }
    }
};
struct EpiMoeDown {
    unsigned char* ws;
    __device__ __forceinline__ void operator()(const AccT& acc, const Unit& u, int wr, int wc, int fr, int fq) const {
        bf16_t* O = (bf16_t*)(ws + WS_SOUT); const float* gate = (const float*)(ws + WS_SGATE);
#pragma unroll
        for (int ai = 0; ai < 2; ++ai)
#pragma unroll
            for (int m = 0; m < 4; ++m) { const int row = EPI_ROW(ai, m); const float gt = gate[row] * (1.0f / (ACT_F8SCALE * W2_F8SCALE)); bf16_t* rowp = O + (size_t)row * DM;
#pragma unroll
                for (int bj = 0; bj < 2; ++bj) *(u32x4*)(rowp + EPI_COL(bj)) = pack8(acc[ai][bj][m][0] * gt, acc[ai][bj][m][1] * gt); }
    }
};
}

#define XB_TMO      128
#define XB_XCNT(j)  (256  + 64 * (j))
#define XB_XSUB(j)  (1280 + 64 * (j))
#define XB_XGEN(j)  (2304 + 64 * (j))
#define XB_TOP      3328
#define XB_TOPGEN   3392
#define XCD_BAR_WORDS 3456
#define XB_SPIN_CAP (1u << 22)

__device__ __forceinline__ unsigned xb_ld(unsigned* p)              { return __hip_atomic_load(p, __ATOMIC_RELAXED, __HIP_MEMORY_SCOPE_AGENT); }
__device__ __forceinline__ unsigned xb_add(unsigned* p, unsigned v) { return __hip_atomic_fetch_add(p, v, __ATOMIC_RELAXED, __HIP_MEMORY_SCOPE_AGENT); }
__device__ __forceinline__ unsigned xb_xcc_id() { return (unsigned)__builtin_amdgcn_s_getreg((3 << 11) | 20) & 0xFu; }
#define XB_SPIN(cond, bar) do { unsigned _sp = 0; while (cond) { __builtin_amdgcn_s_sleep(1); \
    if ((++_sp & 255u) == 0u) { if (xb_ld(&(bar)[XB_TMO])) break; if (_sp > XB_SPIN_CAP) { atomicAdd(&(bar)[XB_TMO], 1u); break; } } } } while (0)

struct XcdBarrier { unsigned* bar; unsigned x; volatile LAS unsigned* st; };

__device__ __forceinline__ XcdBarrier xcd_barrier_post(unsigned* bar, volatile LAS unsigned* st) {
    XcdBarrier b; b.bar = bar; b.x = xb_xcc_id(); b.st = st;
    if (threadIdx.x == 0) (void)xb_add(&bar[XB_XCNT(b.x)], 1u);
    return b;
}
__device__ __forceinline__ void xcd_barrier_complete(unsigned* bar, unsigned x, unsigned& nloc, unsigned& nx) {
    const unsigned G = gridDim.x * gridDim.y * gridDim.z;
    unsigned sum, cnt, mine, sp = 0u;
    for (;;) {
        sum = 0u; cnt = 0u; mine = 0u;
#pragma unroll
        for (unsigned j = 0; j < 16; ++j) { const unsigned c = xb_ld(&bar[XB_XCNT(j)]); sum += c; cnt += (c > 0u) ? 1u : 0u; mine = (j == x) ? c : mine; }
        if (sum == G) break;
        __builtin_amdgcn_s_sleep(1);
        if ((++sp & 255u) == 0u) { if (xb_ld(&bar[XB_TMO])) break; if (sp > XB_SPIN_CAP) { atomicAdd(&bar[XB_TMO], 1u); break; } }
    }
    nloc = mine > 0u ? mine : 1u; nx = cnt > 0u ? cnt : 1u;
}
__device__ __forceinline__ void xcd_barrier(const XcdBarrier& b, int wave_) {
    asm volatile("s_waitcnt vmcnt(0)" ::: "memory");
    __syncthreads();
    int tl_ = wave_ * 64 + fresh_lane();
    if (tl_ == 0) {
        unsigned* bar = b.bar;
        __builtin_amdgcn_s_waitcnt(0);
        unsigned nloc = b.st[0], nx = b.st[1];
        if (nloc == 0u) { xcd_barrier_complete(bar, b.x, nloc, nx); b.st[0] = nloc; b.st[1] = nx; }
        const unsigned old = xb_add(&bar[XB_XSUB(b.x)], 1u);
        const unsigned gen = old / nloc;
        if (old + 1u == (gen + 1u) * nloc) {
            __builtin_amdgcn_fence(__ATOMIC_RELEASE, "agent");
            asm volatile("s_waitcnt vmcnt(0)" ::: "memory");
            const unsigned og = xb_add(&bar[XB_TOP], 1u);
            const unsigned tg = og / nx;
            if (og + 1u == (tg + 1u) * nx) xb_add(&bar[XB_TOPGEN], 1u);
            else XB_SPIN(xb_ld(&bar[XB_TOPGEN]) == tg, bar);
            __builtin_amdgcn_fence(__ATOMIC_ACQUIRE, "agent");
            xb_add(&bar[XB_XGEN(b.x)], 1u);
            asm volatile("s_waitcnt vmcnt(0)" ::: "memory");
        } else {
            XB_SPIN(xb_ld(&bar[XB_XGEN(b.x)]) == gen, bar);
            __builtin_amdgcn_fence(__ATOMIC_ACQUIRE, "agent");
            asm volatile("s_waitcnt vmcnt(0)" ::: "memory");
        }
    }
    __syncthreads();
}

struct Args { const void* in[22]; float* out; unsigned char* ws; };
struct Frame {
    LAS unsigned char* lds; volatile LAS unsigned* MISC; unsigned* ctl;
    int tid, lane, wave, gw; static constexpr int G = 256;
};
__device__ __forceinline__ void glds16(const void* g, LAS void* l) { __builtin_amdgcn_global_load_lds((const unsigned*)g, (LAS unsigned*)l, 16, 0, 0); }
__device__ __forceinline__ int mbcnt64(u64 m) { return (int)__builtin_amdgcn_mbcnt_hi((unsigned)(m >> 32), __builtin_amdgcn_mbcnt_lo((unsigned)m, 0u)); }

__device__ __forceinline__ int il64(int d) { return d < 32 ? 2 * d : 2 * (d - 32) + 1; }
__device__ __forceinline__ int il32(int d) { return d < 16 ? 2 * d : (d < 32 ? 2 * (d - 16) + 1 : d); }
__device__ __forceinline__ int map_row(int mode, int n) {
    if (mode == 1) return n < 2304 ? (n & ~63) + il64(n & 63) : n;
    if (mode == 2) return ((n >> 7) << 8) + (n & 127);
    if (mode == 3) return ((n >> 7) << 8) + 128 + (n & 127);
    if (mode == 4) {
        if (n < 3072) { const int h = n / 192, r = n - h * 192; return r < 128 ? h * 128 + r : 2048 + h * 64 + il64(r - 128); }
        if (n < 3584) return n;
        if (n < 3648) return 3584 + il64(n - 3584);
        if (n < 4672) { const int j = n - 3648; return 3840 + (j & ~63) + il32(j & 63); }
        if (n < 4736) return 3648 + il32(n - 4672);
        return 3712 + (n - 4736);
    }
    return n;
}
__device__ __forceinline__ void tr_item(const float* __restrict__ W, int N, bf16_t* WT, int ldo, int kofs, int mode, LAS float* scr, int item, int lane, float f8scale = 0.f, int rlo = 0, int rhi = 1 << 30) {
    const int nblk = (N + 63) >> 6, kb = item / nblk, nb = item - kb * nblk, k0 = 64 * kb, n0 = 64 * nb;
    const int nc = n0 + 4 * (lane & 15); const bool okr = nc < N; const float* wp = W + (size_t)(k0 + (lane >> 4)) * N + nc;
    f32x4 v[16];
#pragma unroll
    for (int i = 0; i < 16; ++i) v[i] = okr ? *(const f32x4*)(wp + (size_t)(4 * i) * N) : (f32x4){0.f, 0.f, 0.f, 0.f};
#pragma unroll
    for (int i = 0; i < 16; ++i) { const int k = 4 * i + (lane >> 4); *(LAS f32x4*)(scr + k * 64 + ((4 * (lane & 15) + 4 * (i >> 1)) & 63)) = v[i]; }
    LDS_WAIT();
    const int c = lane & 7;
#pragma unroll
    for (int j = 0; j < 8; ++j) { const int nl = (lane >> 3) + 8 * j, n = n0 + nl; const LAS float* s = scr + (8 * c) * 64 + ((nl + 4 * c) & 63);
        const int orow = map_row(mode, n); const bool okw = n < N && orow >= rlo && orow < rhi;
        if (f8scale > 0.f) { u32x2 o8; o8.x = pk4_fp8(s[0 * 64] * f8scale, s[1 * 64] * f8scale, s[2 * 64] * f8scale, s[3 * 64] * f8scale); o8.y = pk4_fp8(s[4 * 64] * f8scale, s[5 * 64] * f8scale, s[6 * 64] * f8scale, s[7 * 64] * f8scale);
            if (okw) *(u32x2*)((unsigned char*)WT + (size_t)orow * ldo + kofs + k0 + 8 * c) = o8; }
        else {
        u32x4 o; o.x = cvt_pk_bf16(s[0 * 64], s[1 * 64]); o.y = cvt_pk_bf16(s[2 * 64], s[3 * 64]); o.z = cvt_pk_bf16(s[4 * 64], s[5 * 64]); o.w = cvt_pk_bf16(s[6 * 64], s[7 * 64]);
        if (okw) *(u32x4*)(WT + (size_t)orow * ldo + kofs + k0 + 8 * c) = o; } }
    LDS_WAIT();
}
__device__ __forceinline__ void tr_matrix(const Frame& F, const float* W, int K, int N, bf16_t* WT, int ldo, int kofs, int mode, float f8scale = 0.f, int rlo = 0, int rhi = 1 << 30) {
    LAS float* scr = (LAS float*)(F.lds + F.wave * 16384);
    const int nitems = (K >> 6) * ((N + 63) >> 6), NGW = F.G * NWAVES;
    for (int it = F.gw; it < nitems; it += NGW) tr_item(W, N, WT, ldo, kofs, mode, scr, it, F.lane, f8scale, rlo, rhi);
}
__device__ __forceinline__ void cvt_linear(const Frame& F, const float* src, bf16_t* dst, size_t n8) {
    const size_t NT = (size_t)F.G * NTHREADS;
    for (size_t i = (size_t)blockIdx.x * NTHREADS + F.tid; i < n8; i += NT) { const f32x4 a = *(const f32x4*)(src + i * 8), b = *(const f32x4*)(src + i * 8 + 4); *(u32x4*)(dst + i * 8) = pg8::pack8(a, b); }
}
__device__ __forceinline__ void cvt_linear8(const Frame& F, const float* src, unsigned char* dst, size_t n8) {
    const size_t NT = (size_t)F.G * NTHREADS;
    for (size_t i = (size_t)blockIdx.x * NTHREADS + F.tid; i < n8; i += NT) { const f32x4 a = *(const f32x4*)(src + i * 8), b = *(const f32x4*)(src + i * 8 + 4); *(u32x2*)(dst + i * 8) = pg8::pack8_fp8(a, b, 1.0f); }
}
__device__ __forceinline__ void sincos_d(double ang, float& c, float& s) {
    const double n = __builtin_rint(ang * 0.6366197723675814);
    double r = __builtin_fma(-n, 1.5707963267948966, ang); r = __builtin_fma(-n, 6.123233995736766e-17, r);
    const double r2 = r * r;
    const double sp = r * (1.0 + r2 * (-1.0 / 6.0 + r2 * (1.0 / 120.0 + r2 * (-1.0 / 5040.0 + r2 * (1.0 / 362880.0 + r2 * (-1.0 / 39916800.0 + r2 * (1.0 / 6227020800.0)))))));
    const double cp = 1.0 + r2 * (-0.5 + r2 * (1.0 / 24.0 + r2 * (-1.0 / 720.0 + r2 * (1.0 / 40320.0 + r2 * (-1.0 / 3628800.0 + r2 * (1.0 / 479001600.0 + r2 * (-1.0 / 87178291200.0)))))));
    const int q = (int)((long long)n & 3);
    const float sf = (float)sp, cf = (float)cp;
    c = q == 0 ? cf : (q == 1 ? -sf : (q == 2 ? -cf : sf));
    s = q == 0 ? sf : (q == 1 ? cf : (q == 2 ? -sf : -cf));
}
__device__ __forceinline__ void rope_tables(const Frame& F, const int* pos, float* tab64, float* tab32) {
    const int NT = F.G * NTHREADS;
    for (int i = blockIdx.x * NTHREADS + F.tid; i < T * 48; i += NT) {
        const int t = i / 48, f = i - t * 48; const bool is64 = f < 32; const int fi = is64 ? f : f - 32;
        const double base = is64 ? 0.7498942093324559 : 0.5623413251903491;
        double inv = 1.0; for (int k = 0; k < fi; ++k) inv *= base;
        float c, s; sincos_d((double)pos[t] * inv, c, s);
        float* o = is64 ? tab64 + ((size_t)t * 32 + fi) * 2 : tab32 + ((size_t)t * 16 + fi) * 2; o[0] = c; o[1] = s;
    }
}

constexpr int MOE_CONV_ITEMS = 8 * 3 * 3584;
__device__ __forceinline__ void moe_conv_item(const float* w1, const float* w3, const float* w2, unsigned char* ws, LAS float* scr, int it, int lane) {
    const int e = it / (3 * 3584), r = it - e * (3 * 3584), mtx = r / 3584, sub = r - mtx * 3584;
    if (mtx < 2) tr_item((mtx == 0 ? w1 : w3) + (size_t)e * DM * MFFN, MFFN, (bf16_t*)(ws + WS_MW13 + (size_t)e * 2 * MFFN * DM), DM, 0, 2 + mtx, scr, sub, lane, W13_F8SCALE);
    else tr_item(w2 + (size_t)e * MFFN * DM, DM, (bf16_t*)(ws + WS_MW2 + (size_t)e * DM * MFFN), MFFN, 0, 0, scr, sub, lane, W2_F8SCALE);
}

__device__ __forceinline__ unsigned ln_col(int lane, int q) { return 8u * (unsigned)(lane & 63) + 512u * (unsigned)(q >> 1) + 4u * (unsigned)(q & 1); }
__device__ __forceinline__ void ln_load16(f32x4 (&v)[8], const bf16_t* row, int lane) {
#pragma unroll
    for (int j = 0; j < 4; ++j) pg8::unpack8(*(const u32x4*)(row + ln_col(lane, 2 * j)), v[2 * j], v[2 * j + 1]);
}
__device__ __forceinline__ void ln_store16(const f32x4 (&v)[8], bf16_t* row, int lane) {
#pragma unroll
    for (int j = 0; j < 4; ++j) *(u32x4*)(row + ln_col(lane, 2 * j)) = pg8::pack8(v[2 * j], v[2 * j + 1]);
}
__device__ __forceinline__ void ln_store8(const f32x4 (&v)[8], unsigned char* row, int lane) {
#pragma unroll
    for (int j = 0; j < 4; ++j) *(u32x2*)(row + ln_col(lane, 2 * j)) = pg8::pack8_fp8(v[2 * j], v[2 * j + 1], 1.0f);
}
__device__ __forceinline__ void ln_core(f32x4 (&v)[8], const float* g, const float* bb, int lane) {
    float s = 0.f;
#pragma unroll
    for (int j = 0; j < 8; ++j) s += (v[j][0] + v[j][1]) + (v[j][2] + v[j][3]);
    const float mean = wave_sum(s) * (1.0f / DM); float s2 = 0.f;
#pragma unroll
    for (int j = 0; j < 8; ++j) { v[j] = v[j] - mean; s2 += (v[j][0] * v[j][0] + v[j][1] * v[j][1]) + (v[j][2] * v[j][2] + v[j][3] * v[j][3]); }
    const float rstd = 1.0f / sqrtf(wave_sum(s2) * (1.0f / DM) + LN_EPS);
    int l2 = lane; asm volatile("" : "+v"(l2) :: "memory");
#pragma unroll
    for (int j = 0; j < 8; ++j) { const f32x4 gv = *(const f32x4*)(g + ln_col(l2, j)), bv = *(const f32x4*)(bb + ln_col(l2, j)); v[j] = v[j] * rstd * gv + bv; }
}
template <bool OUT8> __device__ __forceinline__ void ln_phase(const Frame& F, const bf16_t* YH, bf16_t* X16, unsigned char* X8, const float* g, const float* bb) {
    const int NGW = F.G * NWAVES;
    for (int m = F.gw; m < T; m += NGW) { f32x4 v[8];
        ln_load16(v, YH + (size_t)m * DM, F.lane); ln_core(v, g, bb, F.lane); ln_store16(v, X16 + (size_t)m * DM, F.lane);
        if constexpr (OUT8) ln_store8(v, X8 + (size_t)m * DM, F.lane); }
}

__device__ __forceinline__ int crow(int r, int hi) { return (r & 3) + 8 * (r >> 2) + 4 * hi; }
template <bool OUT8> __device__ __forceinline__ void swa_phase(const Frame& F, bf16_t* Q, const bf16_t* Kb, const bf16_t* VT, const float* sinks, unsigned char* O8) {
    const int lane = F.lane, l31 = lane & 31, hf = lane >> 5;
    for (int wi = blockIdx.x; wi < 4096; wi += F.G) {
        const int kvh = wi & 3, qsi = (wi >> 2) & 511, b = wi >> 11, h = kvh * 8 + F.wave, q0 = qsi * 32;
        const size_t row0 = (size_t)b * SEQ + q0;
        bf16x8 qf[4];
#pragma unroll
        for (int kk = 0; kk < 4; ++kk) { if constexpr (SWA_FRAG) qf[kk] = *(const bf16x8*)(Q + ((((size_t)(b * 32 + h) * 512 + qsi) * 4 + kk) * 64 + lane) * 8);
            else qf[kk] = *(const bf16x8*)(Q + (row0 + l31) * 2048 + h * 64 + 16 * kk + 8 * hf); }
        f32x16 sc[5];
#pragma unroll
        for (int kt = 0; kt < 5; ++kt) {
            int kpos = q0 - 128 + 32 * kt + l31; kpos = kpos < 0 ? 0 : kpos;
            const bf16_t* kp = Kb + ((size_t)b * SEQ + kpos) * 256 + kvh * 64 + 8 * hf;
            f32x16 a;
#pragma unroll
            for (int r = 0; r < 16; ++r) a[r] = 0.f;
            const int kblk = qsi - 4 + kt < 0 ? 0 : qsi - 4 + kt;
#pragma unroll
            for (int kk = 0; kk < 4; ++kk) { bf16x8 kf; if constexpr (SWA_FRAG) kf = *(const bf16x8*)(Kb + ((((size_t)(b * 4 + kvh) * 512 + kblk) * 4 + kk) * 64 + lane) * 8); else kf = *(const bf16x8*)(kp + 16 * kk);
                a = __builtin_amdgcn_mfma_f32_32x32x16_bf16(kf, qf[kk], a, 0, 0, 0); }
            sc[kt] = a;
        }
        const float sink2 = sinks[h] * LOG2E; const int qpos = q0 + l31;
        float mx = sink2;
#pragma unroll
        for (int kt = 0; kt < 5; ++kt)
#pragma unroll
            for (int r = 0; r < 16; ++r) { const int kpos = q0 - 128 + 32 * kt + crow(r, hf); const bool ok = kpos >= 0 && kpos <= qpos && (qpos - kpos) < 128;
                const float v = ok ? sc[kt][r] : -INFINITY; sc[kt][r] = v; mx = fmaxf(mx, v); }
        mx = fmaxf(mx, shx(mx, 32, lane));
        float sum = 0.f;
#pragma unroll
        for (int kt = 0; kt < 5; ++kt)
#pragma unroll
            for (int r = 0; r < 16; ++r) { const float p = __builtin_amdgcn_exp2f(sc[kt][r] - mx); sc[kt][r] = p; sum += p; }
        sum += shx(sum, 32, lane);
        const float inv = 1.0f / (sum + __builtin_amdgcn_exp2f(sink2 - mx));
        f32x16 o[2];
#pragma unroll
        for (int r = 0; r < 16; ++r) { o[0][r] = 0.f; o[1][r] = 0.f; }
#pragma unroll
        for (int kt = 0; kt < 5; ++kt)
#pragma unroll
            for (int c = 0; c < 2; ++c) {
                bf16x8 pb; { u32x4 w; w.x = cvt_pk_bf16(sc[kt][8 * c + 0], sc[kt][8 * c + 1]); w.y = cvt_pk_bf16(sc[kt][8 * c + 2], sc[kt][8 * c + 3]); w.z = cvt_pk_bf16(sc[kt][8 * c + 4], sc[kt][8 * c + 5]); w.w = cvt_pk_bf16(sc[kt][8 * c + 6], sc[kt][8 * c + 7]); pb = __builtin_bit_cast(bf16x8, w); }
                int kb = q0 - 128 + 32 * kt + 16 * c + 4 * hf; int kb0 = kb < 0 ? 0 : kb, kb1 = kb + 8 < 0 ? 0 : kb + 8;
#pragma unroll
                for (int mt = 0; mt < 2; ++mt) { bf16x8 va;
                    if constexpr (SWA_FRAG) { const int vblk = qsi - 4 + kt < 0 ? 0 : qsi - 4 + kt; va = *(const bf16x8*)(VT + (((((size_t)(b * 4 + kvh) * 512 + vblk) * 2 + c) * 2 + mt) * 64 + lane) * 8); }
                    else { const bf16_t* vp = VT + ((size_t)(b * 4 + kvh) * 64 + 32 * mt + l31) * SEQ;
                    const u32x2 v0 = *(const u32x2*)(vp + kb0), v1 = *(const u32x2*)(vp + kb1); u32x4 w; w.x = v0.x; w.y = v0.y; w.z = v1.x; w.w = v1.y; va = __builtin_bit_cast(bf16x8, w); }
                    o[mt] = __builtin_amdgcn_mfma_f32_32x32x16_bf16(va, pb, o[mt], 0, 0, 0); }
            }
        bf16_t* op = Q + (row0 + l31) * 2048 + h * 64; unsigned char* op8 = O8 + (row0 + l31) * 2048 + h * 64; const float inv8 = inv * O0_F8SCALE;
#pragma unroll
        for (int mt = 0; mt < 2; ++mt)
#pragma unroll
            for (int r4 = 0; r4 < 4; ++r4) {
                if constexpr (OUT8) *(unsigned*)(op8 + 32 * mt + 8 * r4 + 4 * hf) = pk4_fp8(o[mt][4 * r4] * inv8, o[mt][4 * r4 + 1] * inv8, o[mt][4 * r4 + 2] * inv8, o[mt][4 * r4 + 3] * inv8);
                else { u32x2 w; w.x = cvt_pk_bf16(o[mt][4 * r4] * inv, o[mt][4 * r4 + 1] * inv); w.y = cvt_pk_bf16(o[mt][4 * r4 + 2] * inv, o[mt][4 * r4 + 3] * inv);
                *(u32x2*)(op + 32 * mt + 8 * r4 + 4 * hf) = w; } }
    }
}

__device__ __forceinline__ void kvnorm_phase(const Frame& F, const float* CRAW, const float* gk, bf16_t* KV) {
    const int NGW = F.G * NWAVES;
    for (int m = F.gw; m < T; m += NGW) { const float* cr = CRAW + (size_t)m * 512;
        const f32x4 a = *(const f32x4*)(cr + 4 * F.lane), b = *(const f32x4*)(cr + 256 + 4 * F.lane);
        float s = (a[0] * a[0] + a[1] * a[1]) + (a[2] * a[2] + a[3] * a[3]) + (b[0] * b[0] + b[1] * b[1]) + (b[2] * b[2] + b[3] * b[3]);
        const float r = 1.0f / sqrtf(wave_sum(s) * (1.0f / 512.0f) + RMS_EPS);
        const f32x4 ga = *(const f32x4*)(gk + 4 * F.lane), gb = *(const f32x4*)(gk + 256 + 4 * F.lane);
        if constexpr (F8_KV) { const float r8 = r * KV_F8SCALE; unsigned char* kp = (unsigned char*)KV + (size_t)m * 576 + 4 * F.lane;
            *(unsigned*)kp = pk4_fp8(a[0] * r8 * ga[0], a[1] * r8 * ga[1], a[2] * r8 * ga[2], a[3] * r8 * ga[3]);
            *(unsigned*)(kp + 256) = pk4_fp8(b[0] * r8 * gb[0], b[1] * r8 * gb[1], b[2] * r8 * gb[2], b[3] * r8 * gb[3]); continue; }
        u32x2 w0, w1; w0.x = cvt_pk_bf16(a[0] * r * ga[0], a[1] * r * ga[1]); w0.y = cvt_pk_bf16(a[2] * r * ga[2], a[3] * r * ga[3]);
        w1.x = cvt_pk_bf16(b[0] * r * gb[0], b[1] * r * gb[1]); w1.y = cvt_pk_bf16(b[2] * r * gb[2], b[3] * r * gb[3]);
        *(u32x2*)(KV + (size_t)m * 576 + 4 * F.lane) = w0; *(u32x2*)(KV + (size_t)m * 576 + 256 + 4 * F.lane) = w1; }
}

__device__ __forceinline__ float relu1(float a) { return __builtin_amdgcn_fmed3f(a, 0.f, 3.0e38f); }
__device__ __forceinline__ unsigned f2key(float f) { const unsigned u = __float_as_uint(f); return u ^ ((unsigned)((int)u >> 31) | 0x80000000u); }
__device__ __forceinline__ float key2f(unsigned k) { const unsigned u = (k & 0x80000000u) ? (k ^ 0x80000000u) : ~k; return __uint_as_float(u); }
__device__ __forceinline__ unsigned compact256(LAS u64* buf, int n, int lane) {
    u64 e[8];
#pragma unroll
    for (int i = 0; i < 8; ++i) e[i] = (lane + 64 * i < n) ? buf[lane + 64 * i] : 0ull;
    unsigned thr = 0u;
    for (int bit = 31; bit >= 0; --bit) {
        const unsigned cand = thr | (1u << bit); int c = 0;
#pragma unroll
        for (int i = 0; i < 8; ++i) c += __popcll(__ballot((unsigned)(e[i] >> 32) >= cand));
        if (c >= 256) thr = cand;
    }
    int ngt = 0;
#pragma unroll
    for (int i = 0; i < 8; ++i) ngt += __popcll(__ballot((unsigned)(e[i] >> 32) > thr));
    int pos_gt = 0, pos_eq = ngt;
#pragma unroll
    for (int i = 0; i < 8; ++i) { const unsigned k = (unsigned)(e[i] >> 32); const bool gt = k > thr, eq = k == thr; const u64 mg = __ballot(gt), me = __ballot(eq);
        if (gt) buf[pos_gt + mbcnt64(mg)] = e[i];
        const int re = pos_eq + mbcnt64(me); if (eq && re < 256) buf[re] = e[i];
        pos_gt += __popcll(mg); pos_eq += __popcll(me); }
    return thr;
}
__device__ __forceinline__ unsigned compact_bound(LAS u64* buf, int n, int lane, unsigned lo, int& n_out) {
    u64 e[8]; unsigned mx = 0u;
#pragma unroll
    for (int i = 0; i < 8; ++i) { e[i] = (lane + 64 * i < n) ? buf[lane + 64 * i] : 0ull; const unsigned k = (unsigned)(e[i] >> 32); mx = k > mx ? k : mx; }
#pragma unroll
    for (int o = 1; o < 64; o <<= 1) { const unsigned t = (unsigned)__builtin_amdgcn_ds_bpermute((lane ^ o) << 2, (int)mx); mx = t > mx ? t : mx; }
    mx = (unsigned)__builtin_amdgcn_readfirstlane((int)mx);
    const unsigned diff = mx ^ lo; const int hb = diff ? 31 - __builtin_clz(diff) : 0;
    unsigned thr = hb >= 31 ? 0u : (lo & ~((2u << hb) - 1u)); int cge = n;
    for (int bit = hb; bit >= 0; --bit) {
        const unsigned cand = thr | (1u << bit); int c = 0;
#pragma unroll
        for (int i = 0; i < 8; ++i) c += __popcll(__ballot((unsigned)(e[i] >> 32) >= cand));
        if (c >= 256) { thr = cand; cge = c; if (c <= 288) break; }
    }
    int pos = 0;
#pragma unroll
    for (int i = 0; i < 8; ++i) { const bool ge = (unsigned)(e[i] >> 32) >= thr && (lane + 64 * i < n); const u64 mg = __ballot(ge);
        if (ge) buf[pos + mbcnt64(mg)] = e[i];
        pos += __popcll(mg); }
    n_out = pos;
    return thr;
}
__device__ __forceinline__ void topk_phase(const Frame& F, const bf16_t* QI, const bf16_t* KIF, const float* WI, unsigned short* SEL) {
    const int lane = F.lane, l31 = lane & 31, hf = lane >> 5, wave = F.wave;
    LAS u64* mybuf = (LAS u64*)F.lds + (size_t)(wave * 4) * 512;
    const unsigned lmask_lt = (1u << l31) - 1u; const int hfm = -hf;
    for (int pu = blockIdx.x; pu < 512; pu += F.G) {
        const int b = pu >> 8, pi = pu & 255;
        for (int half = 0; half < 2; ++half) {
            const int tq = half == 0 ? pi : 511 - pi, q0 = tq * 32, nsteps = tq + 1;
            const size_t trow0 = (size_t)b * SEQ + q0 + 4 * wave;
            bf16x8 aq[2][4]; float wq[2][16];
#pragma unroll
            for (int s = 0; s < 2; ++s) {
                const int qq = 2 * s + ((l31 >> 2) & 1), hd = 4 * (l31 >> 3) + (l31 & 3);
#pragma unroll
                for (int kk = 0; kk < 4; ++kk) aq[s][kk] = *(const bf16x8*)(QI + ((trow0 + qq) * 16 + hd) * 64 + 16 * kk + 8 * hf);
                const float* wp = WI + (trow0 + 2 * s + hf) * 16;
#pragma unroll
                for (int r4 = 0; r4 < 4; ++r4) { const f32x4 w = *(const f32x4*)(wp + 4 * r4); wq[s][4 * r4] = w[0]; wq[s][4 * r4 + 1] = w[1]; wq[s][4 * r4 + 2] = w[2]; wq[s][4 * r4 + 3] = w[3]; }
            }
            float psc0 = 0.f, psc1 = 0.f; int pix0 = 0, pix1 = 0; bool pv0 = false, pv1 = false;
            float thr0 = -INFINITY, thr1 = -INFINITY; int c0 = 0, c1 = 0, c2 = 0, c3 = 0; unsigned b0 = 0x007fffffu, b1 = 0x007fffffu, b2 = 0x007fffffu, b3 = 0x007fffffu;
            const bf16_t* kbase = KIF + (size_t)b * 512 * 4 * 64 * 8 + (size_t)lane * 8;
            bf16x8 k0[4], k1[4], k2[4], k3[4];
#pragma unroll
            for (int kk = 0; kk < 4; ++kk) { k0[kk] = *(const bf16x8*)(kbase + (size_t)(0 * 4 + kk) * 512); k1[kk] = *(const bf16x8*)(kbase + (size_t)((nsteps > 1 ? 1 : 0) * 4 + kk) * 512);
                k2[kk] = *(const bf16x8*)(kbase + (size_t)((nsteps > 2 ? 2 : nsteps - 1) * 4 + kk) * 512); k3[kk] = *(const bf16x8*)(kbase + (size_t)((nsteps > 3 ? 3 : nsteps - 1) * 4 + kk) * 512); }
#define TOPK_STEP(KB, STEP) { const int kidx = 32 * (STEP) + l31; \
    f32x16 a0_, a1_; _Pragma("unroll") for (int r = 0; r < 16; ++r) { a0_[r] = 0.f; a1_[r] = 0.f; } \
    _Pragma("unroll") for (int kk = 0; kk < 4; ++kk) a0_ = __builtin_amdgcn_mfma_f32_32x32x16_bf16(aq[0][kk], KB[kk], a0_, 0, 0, 0); \
    _Pragma("unroll") for (int kk = 0; kk < 4; ++kk) a1_ = __builtin_amdgcn_mfma_f32_32x32x16_bf16(aq[1][kk], KB[kk], a1_, 0, 0, 0); \
    { const int sn_ = (STEP) + 4 < nsteps ? (STEP) + 4 : nsteps - 1; _Pragma("unroll") for (int kk = 0; kk < 4; ++kk) KB[kk] = *(const bf16x8*)(kbase + (size_t)(sn_ * 4 + kk) * 512); }     \
    float sc0_ = 0.f, sc1_ = 0.f; \
    _Pragma("unroll") for (int r = 0; r < 16; ++r) sc0_ = fmaf(wq[0][r], relu1(a0_[r]), sc0_); \
    _Pragma("unroll") for (int r = 0; r < 16; ++r) sc1_ = fmaf(wq[1][r], relu1(a1_[r]), sc1_); \
    const int tql0_ = q0 + 4 * wave + hf; \
    const bool pass0_ = (sc0_ > thr0) && (kidx <= tql0_), pass1_ = (sc1_ > thr1) && (kidx <= tql0_ + 2); \
      \
    if (__ballot((pass0_ && pv0) || (pass1_ && pv1))) { TOPK_FLUSH(); } \
    psc0 = pass0_ ? sc0_ : psc0; pix0 = pass0_ ? kidx : pix0; pv0 = pv0 || pass0_; \
    psc1 = pass1_ ? sc1_ : psc1; pix1 = pass1_ ? kidx : pix1; pv1 = pv1 || pass1_; }
#define TOPK_FLUSH() { const u64 mask0_ = __ballot(pv0), mask1_ = __ballot(pv1); \
        if (mask0_) { const unsigned lo = (unsigned)mask0_, hi = (unsigned)(mask0_ >> 32); const int plo = __popc(lo), phi = __popc(hi); \
          const int rank = mbcnt64(mask0_) - (plo & hfm); const int cm = c0 + ((c1 - c0) & hfm); \
          if (pv0) mybuf[hf * 512 + cm + rank] = ((u64)f2key(psc0) << 32) | (unsigned)pix0; c0 += plo; c1 += phi; } \
        if (mask1_) { const unsigned lo = (unsigned)mask1_, hi = (unsigned)(mask1_ >> 32); const int plo = __popc(lo), phi = __popc(hi); \
          const int rank = mbcnt64(mask1_) - (plo & hfm); const int cm = c2 + ((c3 - c2) & hfm); \
          if (pv1) mybuf[(2 + hf) * 512 + cm + rank] = ((u64)f2key(psc1) << 32) | (unsigned)pix1; c2 += plo; c3 += phi; } \
        pv0 = false; pv1 = false; \
        const int cmx_ = max(max(c0, c1), max(c2, c3)); \
        if (cmx_ > 480) { \
        if (c0 > 480) { b0 = compact_bound(mybuf, c0, lane, b0, c0); const float nt = key2f(b0); thr0 = hf == 0 ? nt : thr0; } \
        if (c1 > 480) { b1 = compact_bound(mybuf + 512, c1, lane, b1, c1); const float nt = key2f(b1); thr0 = hf == 1 ? nt : thr0; } \
        if (c2 > 480) { b2 = compact_bound(mybuf + 1024, c2, lane, b2, c2); const float nt = key2f(b2); thr1 = hf == 0 ? nt : thr1; } \
        if (c3 > 480) { b3 = compact_bound(mybuf + 1536, c3, lane, b3, c3); const float nt = key2f(b3); thr1 = hf == 1 ? nt : thr1; } } }
            for (int st = 0; st < nsteps; st += 4) {
                TOPK_STEP(k0, st);
                if (st + 1 < nsteps) TOPK_STEP(k1, st + 1);
                if (st + 2 < nsteps) TOPK_STEP(k2, st + 2);
                if (st + 3 < nsteps) TOPK_STEP(k3, st + 3);
            }
            TOPK_FLUSH();
#undef TOPK_STEP
#undef TOPK_FLUSH
#pragma unroll
            for (int qi = 0; qi < 4; ++qi) {
                int c = qi == 0 ? c0 : (qi == 1 ? c1 : (qi == 2 ? c2 : c3)); LAS u64* bq = mybuf + qi * 512;
                if (c > 256) { (void)compact256(bq, c, lane); c = 256; }
                LDS_WAIT();
                unsigned short v[4];
#pragma unroll
                for (int j = 0; j < 4; ++j) { const int e = 4 * lane + j; v[j] = e < c ? (unsigned short)(bq[e] & 0xffffull) : (unsigned short)0xffff; }
                u32x2 w; w.x = (unsigned)v[0] | ((unsigned)v[1] << 16); w.y = (unsigned)v[2] | ((unsigned)v[3] << 16);
                *(u32x2*)(SEL + (trow0 + qi) * 256 + 4 * lane) = w;
            }
            LDS_WAIT();
        }
    }
}

__device__ __forceinline__ bf16x4 tr_read16(const LAS unsigned char* p) { return __builtin_bit_cast(bf16x4, __builtin_amdgcn_ds_read_tr16_b64_v4i16((LAS bf16x4*)p)); }
__device__ __forceinline__ void dsa_attn_phase(const Frame& F, const bf16_t* QLAT, bf16_t* OUT, const bf16_t* QR, const bf16_t* KV, const unsigned short* SEL, const float* w1, const float* w3, const float* w2, unsigned char* ws) {
    LAS unsigned char* wb = F.lds + F.wave * DSA_WBUF; LAS unsigned char* tails = wb + 16640;
    const unsigned char* KVb = (const unsigned char*)KV;
    const int NGW = F.G * NWAVES;
    for (int tg = F.gw; tg < T; tg += NGW) {
        int lane = F.lane; asm volatile("" : "+v"(lane));
        const int l15 = lane & 15, g = lane >> 4;
        const int b = tg >> 14, t = tg & (SEQ - 1); const int nvalid = t + 1 < 256 ? t + 1 : 256, nsteps = (nvalid + 15) >> 4;
        bf16x8 qf[18];
#pragma unroll
        for (int kk = 0; kk < 16; ++kk) {
            if constexpr (F8_LAT) { const u32x2 w8 = *(const u32x2*)((const unsigned char*)QLAT + ((size_t)tg * 16 + l15) * 512 + 32 * kk + 8 * g);
                const f32x2 f0 = __builtin_amdgcn_cvt_pk_f32_fp8((int)w8.x, false), f1 = __builtin_amdgcn_cvt_pk_f32_fp8((int)w8.x, true), f2 = __builtin_amdgcn_cvt_pk_f32_fp8((int)w8.y, false), f3 = __builtin_amdgcn_cvt_pk_f32_fp8((int)w8.y, true);
                u32x4 wb16; wb16.x = cvt_pk_bf16(f0[0], f0[1]); wb16.y = cvt_pk_bf16(f1[0], f1[1]); wb16.z = cvt_pk_bf16(f2[0], f2[1]); wb16.w = cvt_pk_bf16(f3[0], f3[1]); qf[kk] = __builtin_bit_cast(bf16x8, wb16); }
            else qf[kk] = *(const bf16x8*)(QLAT + ((size_t)tg * 16 + l15) * 512 + 32 * kk + 8 * g); }
#pragma unroll
        for (int kk = 0; kk < 2; ++kk) qf[16 + kk] = *(const bf16x8*)(QR + ((size_t)tg * 16 + l15) * 64 + 32 * kk + 8 * g);
        float m = -INFINITY, lsum = 0.f; f32x4 O[32];
#pragma unroll
        for (int mt = 0; mt < 32; ++mt) O[mt] = (f32x4){0.f, 0.f, 0.f, 0.f};
        for (int st = 0; st < nsteps; ++st) {
            const int slot = 16 * st + l15;
            int idx = slot < nvalid ? (int)SEL[(size_t)tg * 256 + slot] : 0; idx = idx > t ? 0 : idx;
            const int row = b * SEQ + idx;
            LDS_WAIT();
#pragma unroll
            for (int r = 0; r < 16; ++r) { const int rr = __builtin_amdgcn_readlane(row, r); glds16(KVb + (size_t)rr * 1152 + 16 * lane, wb + r * 1040); }
#pragma unroll
            for (int p = 0; p < 2; ++p) glds16(KVb + (size_t)row * 1152 + 1024 + 16 * (4 * p + g), tails + 1024 * p);
            VM_WAIT();
            f32x4 sacc = (f32x4){0.f, 0.f, 0.f, 0.f};
#pragma unroll
            for (int kk = 0; kk < 16; ++kk) { const bf16x8 a = *(const LAS bf16x8*)(wb + l15 * 1040 + (4 * kk + g) * 16); sacc = __builtin_amdgcn_mfma_f32_16x16x32_bf16(a, qf[kk], sacc, 0, 0, 0); }
#pragma unroll
            for (int kk = 0; kk < 2; ++kk) { const bf16x8 a = *(const LAS bf16x8*)(tails + (4 * kk + g) * 256 + l15 * 16); sacc = __builtin_amdgcn_mfma_f32_16x16x32_bf16(a, qf[16 + kk], sacc, 0, 0, 0); }
            float s[4]; float tmax = -INFINITY;
#pragma unroll
            for (int i = 0; i < 4; ++i) { s[i] = (16 * st + 4 * g + i) < nvalid ? sacc[i] * (F8_LAT ? SCALE2_MLA / QLAT_F8SCALE : SCALE2_MLA) : -INFINITY; tmax = fmaxf(tmax, s[i]); }
            tmax = fmaxf(tmax, shx(tmax, 16, lane)); tmax = fmaxf(tmax, shx(tmax, 32, lane));
            const float mnew = fmaxf(m, tmax); const float alpha = __builtin_amdgcn_exp2f(m - mnew); m = mnew;
            float p[4];
#pragma unroll
            for (int i = 0; i < 4; ++i) p[i] = __builtin_amdgcn_exp2f(s[i] - mnew);
            lsum = lsum * alpha + ((p[0] + p[1]) + (p[2] + p[3]));
            if (__any(alpha != 1.0f)) {
#pragma unroll
                for (int mt = 0; mt < 32; ++mt) O[mt] = O[mt] * alpha;
            }
            u32x2 pw; pw.x = cvt_pk_bf16(p[0], p[1]); pw.y = cvt_pk_bf16(p[2], p[3]); const bf16x4 pb = __builtin_bit_cast(bf16x4, pw);
            const LAS unsigned char* trb = wb + (4 * g + (l15 >> 2)) * 1040 + (lane & 3) * 8;
#pragma unroll
            for (int mt = 0; mt < 32; ++mt) { const bf16x4 a = tr_read16(trb + mt * 32); O[mt] = __builtin_amdgcn_mfma_f32_16x16x16bf16_1k(a, pb, O[mt], 0, 0, 0); }
        }
        float lt = lsum + shx(lsum, 16, lane); lt += shx(lt, 32, lane); const float inv = 1.0f / lt;
        if constexpr (F8_LAT) { unsigned char* op8 = (unsigned char*)OUT + ((size_t)tg * 16 + l15) * 512 + 4 * g; const float inv8 = inv * OLAT_F8SCALE;
#pragma unroll
            for (int mt = 0; mt < 32; ++mt) *(unsigned*)(op8 + 16 * mt) = pk4_fp8(O[mt][0] * inv8, O[mt][1] * inv8, O[mt][2] * inv8, O[mt][3] * inv8); }
        else { bf16_t* op = OUT + ((size_t)tg * 16 + l15) * 512 + 4 * g;
#pragma unroll
        for (int mt = 0; mt < 32; ++mt) { u32x2 w; w.x = cvt_pk_bf16(O[mt][0] * inv, O[mt][1] * inv); w.y = cvt_pk_bf16(O[mt][2] * inv, O[mt][3] * inv); *(u32x2*)(op + 16 * mt) = w; } }
        if (w1) { LDS_WAIT(); int lane2 = F.lane; asm volatile("" : "+v"(lane2));
            for (int k = 0; k < 3; ++k) { const int it = F.gw + NGW * (3 * ((tg - F.gw) / NGW) + k); if (it < MOE_CONV_ITEMS) moe_conv_item(w1, w3, w2, ws, (LAS float*)wb, it, lane2); } }
    }
    LDS_WAIT();
}

__device__ __forceinline__ long tr_read8(const LAS unsigned char* p) { return __builtin_bit_cast(long, __builtin_amdgcn_ds_read_tr8_b64_v2i32((LAS i32x2*)p)); }
__device__ __forceinline__ void dsa_attn8_phase(const Frame& F, const unsigned char* QLAT, unsigned char* OUT, const unsigned char* QR, const unsigned char* KVb, const unsigned short* SEL, const float* w1, const float* w3, const float* w2, unsigned char* ws) {
    LAS unsigned char* wb = F.lds + F.wave * DSA_WBUF; LAS unsigned char* tails = wb + 16640;
    const int NGW = F.G * NWAVES;
    for (int tg = F.gw; tg < T; tg += NGW) {
        int lane = F.lane; asm volatile("" : "+v"(lane));
        const int l15 = lane & 15, g = lane >> 4;
        const int b = tg >> 14, t = tg & (SEQ - 1); const int nvalid = t + 1 < 256 ? t + 1 : 256, nsteps = (nvalid + 31) >> 5;
        i32x8 qf[5];
        { const unsigned char* qp = QLAT + ((size_t)tg * 16 + l15) * 512 + 32 * g;
#pragma unroll
          for (int kk = 0; kk < 4; ++kk) { const i32x4 lo = *(const i32x4*)(qp + 128 * kk), hi = *(const i32x4*)(qp + 128 * kk + 16); qf[kk] = (i32x8){lo[0], lo[1], lo[2], lo[3], hi[0], hi[1], hi[2], hi[3]}; }
          const i32x4 r = *(const i32x4*)(QR + ((size_t)tg * 16 + l15) * 64 + 16 * g); qf[4] = (i32x8){r[0], r[1], r[2], r[3], 0, 0, 0, 0}; }
        float m = -INFINITY, lsum = 0.f; f32x4 O[32];
#pragma unroll
        for (int mt = 0; mt < 32; ++mt) O[mt] = (f32x4){0.f, 0.f, 0.f, 0.f};
        const int dtau = (lane >> 2) & 1, dch = 16 * (4 * (lane >> 3) + (lane & 3));
        for (int st = 0; st < nsteps; ++st) {
            const int slot = 32 * st + (lane & 31);
            int idx = slot < nvalid ? (int)SEL[(size_t)tg * 256 + slot] : 0; idx = idx > t ? 0 : idx;
            const int row = b * SEQ + idx;
            LDS_WAIT();
#pragma unroll
            for (int p = 0; p < 16; ++p) { const int r0 = __builtin_amdgcn_readlane(row, p), r1 = __builtin_amdgcn_readlane(row, 16 + p); const int rr = dtau ? r1 : r0;
                glds16(KVb + (size_t)rr * 576 + dch, wb + p * 1040); }
#pragma unroll
            for (int p = 0; p < 2; ++p) glds16(KVb + (size_t)row * 576 + 512 + 16 * (2 * p + (lane >> 5)), tails + 1024 * p);
            VM_WAIT();
            f32x4 sacc[2] = {(f32x4){0.f, 0.f, 0.f, 0.f}, (f32x4){0.f, 0.f, 0.f, 0.f}};
            const LAS unsigned char* sb = wb + l15 * 1040 + 16 * (8 * (g >> 1) + 2 * (g & 1));
#pragma unroll
            for (int kk = 0; kk < 4; ++kk)
#pragma unroll
                for (int tu = 0; tu < 2; ++tu) { const i32x4 lo = *(const LAS i32x4*)(sb + 256 * kk + 64 * tu), hi = *(const LAS i32x4*)(sb + 256 * kk + 64 * tu + 16);
                    const i32x8 a = (i32x8){lo[0], lo[1], lo[2], lo[3], hi[0], hi[1], hi[2], hi[3]};
                    sacc[tu] = __builtin_amdgcn_mfma_scale_f32_16x16x128_f8f6f4(a, qf[kk], sacc[tu], 0, 0, 0, 0, 0, 0); }
#pragma unroll
            for (int tu = 0; tu < 2; ++tu) { const i32x4 lo = *(const LAS i32x4*)(tails + (g * 32 + 16 * tu + l15) * 16);
                const i32x8 a = (i32x8){lo[0], lo[1], lo[2], lo[3], 0, 0, 0, 0};
                sacc[tu] = __builtin_amdgcn_mfma_scale_f32_16x16x128_f8f6f4(a, qf[4], sacc[tu], 0, 0, 0, 0, 0, 0); }
            float s[8]; float tmax = -INFINITY;
#pragma unroll
            for (int tu = 0; tu < 2; ++tu)
#pragma unroll
                for (int i = 0; i < 4; ++i) { s[4 * tu + i] = (32 * st + 16 * tu + 4 * g + i) < nvalid ? sacc[tu][i] * (SCALE2_MLA / (QLAT_F8SCALE * KV_F8SCALE)) : -INFINITY; tmax = fmaxf(tmax, s[4 * tu + i]); }
            tmax = fmaxf(tmax, shx(tmax, 16, lane)); tmax = fmaxf(tmax, shx(tmax, 32, lane));
            const float mnew = fmaxf(m, tmax); const float alpha = __builtin_amdgcn_exp2f(m - mnew); m = mnew;
            const float mo = mnew - 8.0f;
            float p[8];
#pragma unroll
            for (int i = 0; i < 8; ++i) p[i] = __builtin_amdgcn_exp2f(s[i] - mo);
            lsum = lsum * alpha + (((p[0] + p[1]) + (p[2] + p[3])) + ((p[4] + p[5]) + (p[6] + p[7])));
            if (__any(alpha != 1.0f)) {
#pragma unroll
                for (int mt = 0; mt < 32; ++mt) O[mt] = O[mt] * alpha;
            }
            u32x2 pw; pw.x = pk4_fp8(p[0], p[1], p[2], p[3]); pw.y = pk4_fp8(p[4], p[5], p[6], p[7]); const long pb = __builtin_bit_cast(long, pw);
            const LAS unsigned char* trb = wb + (4 * g + ((l15 >> 1) & 3)) * 1040 + 64 * (l15 >> 3) + 8 * (l15 & 1);
#pragma unroll
            for (int mt = 0; mt < 32; ++mt) { const long a = tr_read8(trb + 128 * (mt >> 2) + 16 * (mt & 3)); O[mt] = __builtin_amdgcn_mfma_f32_16x16x32_fp8_fp8(a, pb, O[mt], 0, 0, 0); }
        }
        float lt = lsum + shx(lsum, 16, lane); lt += shx(lt, 32, lane); const float inv8 = (OLAT_F8SCALE / KV_F8SCALE) / lt;
        unsigned char* op8 = OUT + ((size_t)tg * 16 + l15) * 512 + 4 * g;
#pragma unroll
        for (int mt = 0; mt < 32; ++mt) *(unsigned*)(op8 + 16 * mt) = pk4_fp8(O[mt][0] * inv8, O[mt][1] * inv8, O[mt][2] * inv8, O[mt][3] * inv8);
        if (w1) { LDS_WAIT(); int lane2 = F.lane; asm volatile("" : "+v"(lane2));
            for (int k = 0; k < 3; ++k) { const int it = F.gw + NGW * (3 * ((tg - F.gw) / NGW) + k); if (it < MOE_CONV_ITEMS) moe_conv_item(w1, w3, w2, ws, (LAS float*)wb, it, lane2); } }
    }
    LDS_WAIT();
}

__device__ __forceinline__ void ln_router_phase(const Frame& F, const bf16_t* YH, bf16_t* XB, const float* g, const float* bb, const float* wr, int* TOKE, float* TOKG, int* TOKL) {
    LAS float* wl = (LAS float*)F.lds;
    for (int i = F.tid; i < DM * NEXP; i += NTHREADS) { const int d = i >> 3, e = i & 7; wl[e * DM + d] = wr[i]; }
    __syncthreads();
    const int NGW = F.G * NWAVES, lane = F.lane;
    u64 cnt64 = 0ull; int mine = 0;
    int j = 0;
    for (int m = F.gw; m < T; m += NGW, ++j) { f32x4 v[8];
        ln_load16(v, YH + (size_t)m * DM, lane); ln_core(v, g, bb, lane); ln_store8(v, (unsigned char*)XB + (size_t)m * DM, lane);
        float lg[8];
#pragma unroll
        for (int e = 0; e < 8; ++e) { float s = 0.f;
#pragma unroll
            for (int q = 0; q < 8; ++q) { const f32x4 w = *(const LAS f32x4*)(wl + e * DM + ln_col(lane, q)); s += (v[q][0] * w[0] + v[q][1] * w[1]) + (v[q][2] * w[2] + v[q][3] * w[3]); }
            lg[e] = wave_sum(s); }
        int e1 = 0; float v1 = lg[0];
#pragma unroll
        for (int e = 1; e < 8; ++e) if (lg[e] > v1) { v1 = lg[e]; e1 = e; }
        int e2 = -1; float v2 = -INFINITY;
#pragma unroll
        for (int e = 0; e < 8; ++e) if (e != e1 && lg[e] > v2) { v2 = lg[e]; e2 = e; }
        const float g1 = 1.0f / (1.0f + __expf(v2 - v1)), g2 = 1.0f - g1;
        const int r1 = (int)((cnt64 >> (8 * e1)) & 0xffull); cnt64 += 1ull << (8 * e1);
        const int r2 = (int)((cnt64 >> (8 * e2)) & 0xffull); cnt64 += 1ull << (8 * e2);
        if (lane == 0) { TOKE[2 * m] = e1; TOKE[2 * m + 1] = e2; TOKG[2 * m] = g1; TOKG[2 * m + 1] = g2; }
        if (lane == j) mine = e1 | (e2 << 4) | (r1 << 8) | (r2 << 16);
    }
    int basev = 0;
    if (lane < 8) { const unsigned c = (unsigned)((cnt64 >> (8 * lane)) & 0xffull); basev = (int)__hip_atomic_fetch_add(F.ctl + CW_CNT + lane, c, __ATOMIC_RELAXED, __HIP_MEMORY_SCOPE_AGENT); }
    const int e1 = mine & 15, e2 = (mine >> 4) & 15, r1 = (mine >> 8) & 255, r2 = (mine >> 16) & 255;
    const int b1 = __builtin_amdgcn_ds_bpermute(e1 << 2, basev), b2 = __builtin_amdgcn_ds_bpermute(e2 << 2, basev);
    if (lane < j) { const int m = F.gw + NGW * lane; TOKL[2 * m] = b1 + r1; TOKL[2 * m + 1] = b2 + r2; }
    __syncthreads();
}
__device__ __forceinline__ void moe_tiles(const Frame& F) {
    if (F.tid == 0) { int acc = 0;
        for (int e = 0; e < 8; ++e) { const unsigned c = __hip_atomic_load(F.ctl + CW_CNT + e, __ATOMIC_RELAXED, __HIP_MEMORY_SCOPE_AGENT); F.MISC[32 + e] = c; F.MISC[40 + e] = (unsigned)acc; acc += (int)((c + 255u) >> 8); F.MISC[20 + e] = (unsigned)acc; }
        F.MISC[28] = (unsigned)acc; }
    __syncthreads();
}
__device__ __forceinline__ void moe_gather_phase(const Frame& F, const bf16_t* XB, const int* TOKE, const float* TOKG, const int* TOKL, int* TOKS, float* SGATE, bf16_t* XG) {
    const int NGW = F.G * NWAVES, lane = F.lane;
    for (int m = F.gw; m < T; m += NGW) {
        const u32x4* src = (const u32x4*)((const unsigned char*)XB + (size_t)m * DM);
        const u32x4 a0 = src[lane], a1 = src[64 + lane];
#pragma unroll
        for (int k = 0; k < 2; ++k) { const int e = TOKE[2 * m + k], li = TOKL[2 * m + k]; const int slot = (int)F.MISC[40 + e] * 256 + li;
            u32x4* dst = (u32x4*)((unsigned char*)XG + (size_t)slot * DM); dst[lane] = a0; dst[64 + lane] = a1;
            if (lane == 0) { TOKS[2 * m + k] = slot; SGATE[slot] = TOKG[2 * m + k]; } }
    }
    for (int it = F.gw; it < 8 * 256; it += NGW) { const int e = it >> 8, r = it & 255; const int c = (int)F.MISC[32 + e]; const int ntile = (c + 255) >> 8; const int row = c + r;
        if (row < ntile * 256) { const int slot = (int)F.MISC[40 + e] * 256 + row; u32x4* dst = (u32x4*)((unsigned char*)XG + (size_t)slot * DM); const u32x4 z = {0u, 0u, 0u, 0u};
            dst[lane] = z; dst[64 + lane] = z; if (lane == 0) SGATE[slot] = 0.f; } }
}
__device__ __forceinline__ void moe_combine_ln_phase(const Frame& F, const bf16_t* YH, bf16_t* XB, const bf16_t* SOUT, const int* TOKS, const float* g1, const float* bb1, const float* g, const float* bb) {
    const int NGW = F.G * NWAVES, lane = F.lane;
    for (int m = F.gw; m < T; m += NGW) { f32x4 v[8];
        const bf16_t* s0 = SOUT + (size_t)TOKS[2 * m] * DM; const bf16_t* s1 = SOUT + (size_t)TOKS[2 * m + 1] * DM;
        ln_load16(v, YH + (size_t)m * DM, lane);
        ln_core(v, g1, bb1, lane);
#pragma unroll
        for (int j = 0; j < 4; ++j) { f32x4 a0, a1, c0, c1; pg8::unpack8(*(const u32x4*)(s0 + ln_col(lane, 2 * j)), a0, a1); pg8::unpack8(*(const u32x4*)(s1 + ln_col(lane, 2 * j)), c0, c1);
            v[2 * j] = v[2 * j] * ALPHA + (a0 + c0); v[2 * j + 1] = v[2 * j + 1] * ALPHA + (a1 + c1); }
        ln_core(v, g, bb, lane); ln_store16(v, XB + (size_t)m * DM, lane); }
}

#ifndef PHASES
#define PHASES 0xFFFFFFFFu
#endif
#define PH(k) if constexpr ((PHASES >> (k)) & 1u)
#ifndef DBL
#define DBL 0u
#endif
#define DB(k) if constexpr ((DBL >> (k)) & 1u)
__global__ void __launch_bounds__(NTHREADS, 2) mega_fwd(Args args) {
    extern __shared__ __attribute__((aligned(16))) unsigned char lds_raw[];
    Frame F;
    F.lds = (LAS unsigned char*)lds_raw; F.MISC = (volatile LAS unsigned*)(F.lds + MISC_OFF);
    F.tid = threadIdx.x; F.lane = F.tid & 63; F.wave = __builtin_amdgcn_readfirstlane(F.tid >> 6); F.gw = blockIdx.x * NWAVES + F.wave;
    unsigned char* ws = args.ws;
    F.ctl = (unsigned*)(ws + WS_CTL);
    if (F.tid < 64) F.MISC[F.tid] = 0u;
    __syncthreads();
    XcdBarrier bar = xcd_barrier_post(F.ctl + CW_BAR, F.MISC + 8);
#define REFRESH() do { F.lane = fresh_lane(); F.tid = F.wave * 64 + F.lane; } while (0)
#define GRID_BAR() do { xcd_barrier(bar, F.wave); REFRESH(); } while (0)
#define YH ((bf16_t*)args.out)
#define bx ((int)blockIdx.x)
#define WSP(T_, off) ((T_*)(ws + (off)))

    PH(0) {
        { LAS float* scr = (LAS float*)(F.lds + F.wave * 16384);
          constexpr int I_QKV = 32 * 40, I_SQ = 32 * 32, I_W13 = 32 * 88, I_W2 = 88 * 32, I_WP = 4 * 32, I_WIN = 32 * 75, I_WUV = 256;
          constexpr int I_TOTAL = I_QKV + I_SQ + 2 * I_W13 + I_W2 + 2 * I_SQ + 2 * I_WP + (F8_WIN_SPLIT ? 2 : 1) * I_WIN + I_SQ + I_WUV;
          for (int it = F.gw; it < I_TOTAL; it += F.G * NWAVES) {
              int r = it; bool hit = false; const float* W = nullptr; int N = 0, ldo = 0, kofs = 0, mode = 0, rlo = 0, rhi = 1 << 30; unsigned char* WT = nullptr; float f8 = 0.f;
#define PSEG(cnt, Wp, Nn, WTp, ld, md, f8v, lo, hi) if (!hit) { if (r < (cnt)) { W = (Wp); N = (Nn); WT = (unsigned char*)(WTp); ldo = (ld); mode = (md); f8 = (f8v); rlo = (lo); rhi = (hi); hit = true; } else r -= (cnt); }
              PSEG(I_QKV, (const float*)args.in[3], NQKV, ws + WS_WQKV, DM, 1, F8_QKV ? WQKV_F8SCALE : 0.f, 0, 1 << 30)
              PSEG(I_SQ, (const float*)args.in[5], DM, ws + WS_WO0, DM, 0, F8_WO0 ? WO_F8SCALE : 0.f, 0, 1 << 30)
              PSEG(I_W13, (const float*)args.in[6], FFN, ws + WS_W13, DM, 2, F8_FFN1 ? W13_F8SCALE : 0.f, 0, 1 << 30)
              PSEG(I_W13, (const float*)args.in[7], FFN, ws + WS_W13, DM, 3, F8_FFN1 ? W13_F8SCALE : 0.f, 0, 1 << 30)
              PSEG(I_W2, (const float*)args.in[8], DM, ws + WS_W2, FFN, 0, F8_FFN2 ? W2_F8SCALE : 0.f, 0, 1 << 30)
              PSEG(I_SQ, (const float*)args.in[21], DM, ws + WS_WG0, DM, 0, 0.f, 0, 1 << 30)
              PSEG(I_SQ, (const float*)args.in[21] + (size_t)DM * DM, DM, ws + WS_WG1, DM, 0, 0.f, 0, 1 << 30)
              PSEG(I_WP, (const float*)args.in[20], DM, ws + WS_WP0, 256, 0, 0.f, 0, 1 << 30)
              PSEG(I_WP, (const float*)args.in[20] + (size_t)256 * DM, DM, ws + WS_WP1, 256, 0, 0.f, 0, 1 << 30)
              if constexpr (F8_WIN_SPLIT) { PSEG(I_WIN, (const float*)args.in[9], 4752, ws + WS_WIN8, DM, 4, WIN_F8SCALE, 0, WIN_F8_TILES * 256)
                                            PSEG(I_WIN, (const float*)args.in[9], 4752, ws + WS_WIN, DM, 4, 0.f, WIN_F8_TILES * 256, NWIN) }
              else { PSEG(I_WIN, (const float*)args.in[9], 4752, ws + WS_WIN, DM, 4, F8_WIN ? WIN_F8SCALE : 0.f, 0, 1 << 30) }
              PSEG(I_SQ, (const float*)args.in[13], DM, ws + WS_WO1, DM, 0, F8_WO1 ? WO_F8SCALE : 0.f, 0, 1 << 30)
              if (!hit) { const int h = r >> 4; r &= 15;
                  W = (const float*)args.in[12] + (size_t)h * 512 * 128; N = 128; WT = ws + WS_WUV + (size_t)h * 128 * 1024 * (F8_LAT ? 1 : 2); ldo = 1024; kofs = 512 * (h & 1); f8 = F8_LAT ? WUV_F8SCALE : 0.f; }
#undef PSEG
              tr_item(W, N, (bf16_t*)WT, ldo, kofs, mode, scr, r, F.lane, f8, rlo, rhi); } }
        { bf16_t* wuv = WSP(bf16_t, WS_WUV); const u32x4 z = {0u, 0u, 0u, 0u};
          for (int i = bx * NTHREADS + F.tid; i < 2048 * 64; i += F.G * NTHREADS) { const int n = i >> 6, c8 = i & 63; const int h = n >> 7;
              if constexpr (F8_LAT) { if (c8 < 32) *(u32x4*)((unsigned char*)wuv + (size_t)n * 1024 + 512 * ((h & 1) ^ 1) + 16 * c8) = z; }
              else *(u32x4*)(wuv + (size_t)n * 1024 + 512 * ((h & 1) ^ 1) + 8 * c8) = z; } }
        cvt_linear(F, (const float*)args.in[11], WSP(bf16_t, WS_WUK), (size_t)16 * 512 * 128 / 8);
        if constexpr (F8_QKV) cvt_linear8(F, (const float*)args.in[0], WSP(unsigned char, WS_XBA), (size_t)T * DM / 8); else cvt_linear(F, (const float*)args.in[0], WSP(bf16_t, WS_XBA), (size_t)T * DM / 8);
        cvt_linear(F, (const float*)args.in[1], WSP(bf16_t, WS_PB), (size_t)2 * T * 256 / 8);
        rope_tables(F, (const int*)args.in[2], WSP(float, WS_TAB64), WSP(float, WS_TAB32));
    }
    GRID_BAR();
    PH(1) {
        constexpr int KD = F8_QKV ? DM / 2 : DM;
        pg8::Gemm g{WSP(bf16_t, WS_XBA), WSP(bf16_t, WS_WQKV), KD, KD, KD}; pg8::GridOrder<0, T / 256, NQKV / 256> S;
        pg8::EpiQKV E{ws, F8_QKV ? 1.0f / WQKV_F8SCALE : 1.0f}; pg8::gemm_phase<pg8::EpiQKV, pg8::GridOrder<0, T / 256, NQKV / 256>, F8_QKV>(F.lds, g, S, E, F.wave);
    }
    GRID_BAR();
    PH(2) swa_phase<F8_WO0>(F, WSP(bf16_t, WS_Q), WSP(bf16_t, WS_K), WSP(bf16_t, WS_VT), (const float*)args.in[4], WSP(unsigned char, WS_O8));
    GRID_BAR();
    PH(3) {
        constexpr int KD = F8_WO0 ? DM / 2 : DM;
        pg8::Gemm g{F8_WO0 ? WSP(bf16_t, WS_O8) : WSP(bf16_t, WS_Q), WSP(bf16_t, WS_WO0), KD, KD, KD}; pg8::GridOrder<0, T / 256, DM / 256> S;
        pg8::EpiRes<false> E{args.in[0], YH, F8_WO0 ? 1.0f / (O0_F8SCALE * WO_F8SCALE) : 1.0f}; pg8::gemm_phase<pg8::EpiRes<false>, pg8::GridOrder<0, T / 256, DM / 256>, F8_WO0, EPI_ALIGN_RES>(F.lds, g, S, E, F.wave);
    }
    GRID_BAR();
    PH(4) ln_phase<F8_FFN1>(F, YH, WSP(bf16_t, WS_XBB), WSP(unsigned char, WS_XBA), (const float*)args.in[18], (const float*)args.in[19]);
    GRID_BAR();
    PH(5) {
        constexpr int KD = F8_FFN1 ? DM / 2 : DM;
        pg8::Gemm g{F8_FFN1 ? WSP(bf16_t, WS_XBA) : WSP(bf16_t, WS_XBB), WSP(bf16_t, WS_W13), KD, KD, KD}; pg8::GridOrder<0, T / 256, 2 * FFN / 256> S;
        pg8::EpiSwiglu<F8_FFN2> E{WSP(bf16_t, WS_ACT), FFN, F8_FFN1 ? 1.0f / W13_F8SCALE : 1.0f, ACT_F8SCALE}; pg8::gemm_phase<pg8::EpiSwiglu<F8_FFN2>, pg8::GridOrder<0, T / 256, 2 * FFN / 256>, F8_FFN1>(F.lds, g, S, E, F.wave);
    }
    GRID_BAR();
    PH(6) {
        constexpr int KD = F8_FFN2 ? FFN / 2 : FFN;
        pg8::Gemm g{WSP(bf16_t, WS_ACT), WSP(bf16_t, WS_W2), KD, KD, KD}; pg8::GridOrder<0, T / 256, DM / 256> S;
        pg8::EpiRes<true> E{WSP(bf16_t, WS_XBB), YH, F8_FFN2 ? 1.0f / (ACT_F8SCALE * W2_F8SCALE) : 1.0f}; pg8::gemm_phase<pg8::EpiRes<true>, pg8::GridOrder<0, T / 256, DM / 256>, F8_FFN2, EPI_ALIGN_RES>(F.lds, g, S, E, F.wave);
    }
    GRID_BAR();
    PH(7) ln_phase<false>(F, YH, WSP(bf16_t, WS_XBA), nullptr, (const float*)args.in[18] + DM, (const float*)args.in[19] + DM);
    REFRESH();
    PH(7) {
        pg8::Gemm g{WSP(bf16_t, WS_PB), WSP(bf16_t, WS_WP0), 256, 256, 256}; pg8::GridOrder<0, T / 256, DM / 256> S;
        pg8::EpiBf16<false> E{WSP(bf16_t, WS_PP0), DM, 1.0f}; pg8::gemm_phase(F.lds, g, S, E, F.wave);
    }
    GRID_BAR();
    PH(8) {
        pg8::Gemm g{WSP(bf16_t, WS_XBA), WSP(bf16_t, WS_WG0), DM, DM, DM}; pg8::GridOrder<0, T / 256, DM / 256> S;
        pg8::EpiPle E{nullptr, ws, 0}; pg8::gemm_phase<pg8::EpiPle, pg8::GridOrder<0, T / 256, DM / 256>, false, EPI_ALIGN_RES>(F.lds, g, S, E, F.wave);
    }
    GRID_BAR();
    PH(9) {
        if constexpr (F8_WIN_SPLIT) {
            { static_assert((T / 256) * WIN_F8_TILES == 7 * pg8::GRID && (T / 256) * (NWIN / 256 - WIN_F8_TILES) == 5 * pg8::GRID / 2, "uneven deal: 7 rounds of e4m3 units, 2.5 rounds of bf16 units");
              pg8::Gemm g{WSP(bf16_t, WS_XB8), WSP(bf16_t, WS_WIN8), DM / 2, DM / 2, DM / 2}; pg8::GridOrder<4, T / 256, WIN_F8_TILES> S;
              pg8::EpiWin E{ws, 1.0f / WIN_F8SCALE, 0}; pg8::gemm_phase<pg8::EpiWin, pg8::GridOrder<4, T / 256, WIN_F8_TILES>, true>(F.lds, g, S, E, F.wave); }
            REFRESH();
            { pg8::Gemm g{WSP(bf16_t, WS_XBB), WSP(bf16_t, WS_WIN) + (size_t)WIN_F8_TILES * 256 * DM, DM, DM, DM}; pg8::GridOrder<0, T / 256, NWIN / 256 - WIN_F8_TILES> S;
              pg8::EpiWin E{ws, 1.0f, WIN_F8_TILES}; pg8::gemm_phase<pg8::EpiWin, pg8::GridOrder<0, T / 256, NWIN / 256 - WIN_F8_TILES>, false>(F.lds, g, S, E, F.wave); }
        } else {
        constexpr int KD = F8_WIN ? DM / 2 : DM;
        pg8::Gemm g{WSP(bf16_t, WS_XBB), WSP(bf16_t, WS_WIN), KD, KD, KD}; pg8::GridOrder<0, T / 256, NWIN / 256> S;
        pg8::EpiWin E{ws, F8_WIN ? 1.0f / WIN_F8SCALE : 1.0f, 0}; pg8::gemm_phase<pg8::EpiWin, pg8::GridOrder<0, T / 256, NWIN / 256>, F8_WIN>(F.lds, g, S, E, F.wave);
        }
    }
    GRID_BAR();
    PH(10) kvnorm_phase(F, WSP(float, WS_CRAW), (const float*)args.in[10], WSP(bf16_t, WS_KV));
    REFRESH();
    PH(11) {
        pg8::Gemm g{WSP(bf16_t, WS_QN), WSP(bf16_t, WS_WUK), DM, 128, 128}; pg8::GridOrder<1, T / 256, 8192 / 256> S;
        pg8::EpiBf16<F8_LAT> E{WSP(bf16_t, WS_QLAT), 8192, F8_LAT ? QLAT_F8SCALE : 1.0f}; pg8::gemm_phase(F.lds, g, S, E, F.wave);
    }
    REFRESH();
    DB(12) { topk_phase(F, WSP(bf16_t, WS_QI), WSP(bf16_t, WS_KIF), WSP(float, WS_WI), WSP(unsigned short, WS_SEL)); REFRESH(); }
    PH(12) topk_phase(F, WSP(bf16_t, WS_QI), WSP(bf16_t, WS_KIF), WSP(float, WS_WI), WSP(unsigned short, WS_SEL));
    GRID_BAR();
    PH(13) { if constexpr (F8_KV && F8_LAT) dsa_attn8_phase(F, WSP(unsigned char, WS_QLAT), WSP(unsigned char, WS_QLAT), WSP(unsigned char, WS_QR), WSP(unsigned char, WS_KV), WSP(unsigned short, WS_SEL), (const float*)args.in[15], (const float*)args.in[16], (const float*)args.in[17], ws);
             else dsa_attn_phase(F, WSP(bf16_t, WS_QLAT), WSP(bf16_t, WS_QLAT), WSP(bf16_t, WS_QR), WSP(bf16_t, WS_KV), WSP(unsigned short, WS_SEL), (const float*)args.in[15], (const float*)args.in[16], (const float*)args.in[17], ws); }
    GRID_BAR();
    PH(14) {
        constexpr float dsc = F8_LAT ? 1.0f / (OLAT_F8SCALE * WUV_F8SCALE) : 1.0f;
        pg8::Gemm g{WSP(bf16_t, WS_QLAT), WSP(bf16_t, WS_WUV), F8_LAT ? 4096 : 8192, F8_LAT ? 512 : 1024, F8_LAT ? 512 : 1024}; pg8::GridOrder<F8_LAT ? 3 : 2, T / 256, DM / 256> S;
        pg8::EpiBf16<F8_WO1> E{WSP(bf16_t, WS_O2), DM, (F8_WO1 ? O2_F8SCALE : 1.0f) * dsc}; pg8::gemm_phase<pg8::EpiBf16<F8_WO1>, pg8::GridOrder<F8_LAT ? 3 : 2, T / 256, DM / 256>, F8_LAT>(F.lds, g, S, E, F.wave);
    }
    GRID_BAR();
    PH(15) {
        constexpr int KD = F8_WO1 ? DM / 2 : DM;
        pg8::Gemm g{WSP(bf16_t, WS_O2), WSP(bf16_t, WS_WO1), KD, KD, KD}; pg8::GridOrder<0, T / 256, DM / 256> S;
        pg8::EpiRes<true> E{WSP(bf16_t, WS_XBB), YH, F8_WO1 ? 1.0f / (O2_F8SCALE * WO_F8SCALE) : 1.0f}; pg8::gemm_phase<pg8::EpiRes<true>, pg8::GridOrder<0, T / 256, DM / 256>, F8_WO1, EPI_ALIGN_RES>(F.lds, g, S, E, F.wave);
    }
    GRID_BAR();
    PH(16) ln_router_phase(F, YH, WSP(bf16_t, WS_XBA), (const float*)args.in[18] + 2 * DM, (const float*)args.in[19] + 2 * DM, (const float*)args.in[14], WSP(int, WS_TOKE), WSP(float, WS_TOKG), WSP(int, WS_TOKL));
    REFRESH();
    GRID_BAR();
    PH(18) moe_tiles(F);
    REFRESH();
    PH(18) moe_gather_phase(F, WSP(bf16_t, WS_XBA), WSP(int, WS_TOKE), WSP(float, WS_TOKG), WSP(int, WS_TOKL), WSP(int, WS_TOKS), WSP(float, WS_SGATE), WSP(bf16_t, WS_XG));
    GRID_BAR();
    PH(19) {
        const int NTL = __builtin_amdgcn_readfirstlane((int)F.MISC[28]);
        {
            pg8::MoeOrder<false, 2 * MFFN / 256> S; S.tile0 = 0; S.ntl = NTL;
            pg8::Gemm g{WSP(bf16_t, WS_XG), WSP(bf16_t, WS_MW13), DM / 2, DM / 2, DM / 2};
            pg8::EpiSwiglu<true> E{WSP(bf16_t, WS_ACT2), MFFN, 1.0f / W13_F8SCALE, ACT_F8SCALE}; pg8::gemm_phase<pg8::EpiSwiglu<true>, pg8::MoeOrder<false, 2 * MFFN / 256>, true>(F.lds, g, S, E, F.wave);
        }
        GRID_BAR();
        {
            pg8::MoeOrder<true, DM / 256> S; S.tile0 = 0; S.ntl = NTL;
            pg8::Gemm g{WSP(bf16_t, WS_ACT2), WSP(bf16_t, WS_MW2), MFFN / 2, MFFN / 2, MFFN / 2};
            pg8::EpiMoeDown E{ws}; pg8::gemm_phase<pg8::EpiMoeDown, pg8::MoeOrder<true, DM / 256>, true>(F.lds, g, S, E, F.wave);
        }
        REFRESH();
        {
            pg8::GridOrderSkip<T / 256, DM / 256> S; S.skip = (NTL * (DM / 256)) % pg8::GRID;
            pg8::Gemm g{WSP(bf16_t, WS_PB) + (size_t)T * 256, WSP(bf16_t, WS_WP1), 256, 256, 256};
            pg8::EpiBf16<false> E{WSP(bf16_t, WS_PP1), DM, 1.0f}; pg8::gemm_phase(F.lds, g, S, E, F.wave);
        }
        GRID_BAR();
    }
    PH(20) moe_combine_ln_phase(F, YH, WSP(bf16_t, WS_XBB), WSP(bf16_t, WS_SOUT), WSP(int, WS_TOKS), (const float*)args.in[18] + 2 * DM, (const float*)args.in[19] + 2 * DM, (const float*)args.in[18] + 3 * DM, (const float*)args.in[19] + 3 * DM);
    GRID_BAR();
    PH(21) {
        pg8::Gemm g{WSP(bf16_t, WS_XBB), WSP(bf16_t, WS_WG1), DM, DM, DM}; pg8::GridOrder<0, T / 256, DM / 256> S;
        pg8::EpiPle E{args.out, ws, 1}; pg8::gemm_phase<pg8::EpiPle, pg8::GridOrder<0, T / 256, DM / 256>, false, EPI_ALIGN_RES>(F.lds, g, S, E, F.wave);
    }
}

#undef YH
#undef bx
extern "C" void kernel_launch(void* const* d_in, const int* in_sizes, int n_in, void* d_out, int out_size, void* d_ws, size_t ws_size, hipStream_t stream) {
    static int grid = 0;
    if (grid == 0) {
        if (n_in != 22 || out_size != T * DM || ws_size < WS_END) { fprintf(stderr, "kernel_launch: unexpected problem (n_in %d, out %d, ws %zu < %zu)\n", n_in, out_size, ws_size, (size_t)WS_END); grid = -1; return; }
        int dev = 0, cus = 0;
        if (hipGetDevice(&dev) != hipSuccess || hipDeviceGetAttribute(&cus, hipDeviceAttributeMultiprocessorCount, dev) != hipSuccess) { grid = -1; return; }
        if (hipFuncSetAttribute((const void*)mega_fwd, hipFuncAttributeMaxDynamicSharedMemorySize, LDS_BYTES) != hipSuccess) { fprintf(stderr, "kernel_launch: hipFuncSetAttribute failed\n"); grid = -1; return; }
        int per_cu = 0;
        if (hipOccupancyMaxActiveBlocksPerMultiprocessor(&per_cu, (const void*)mega_fwd, NTHREADS, LDS_BYTES) != hipSuccess || per_cu < 1) { fprintf(stderr, "kernel_launch: occupancy query says %d\n", per_cu); }
        (void)hipGetLastError();
        if (cus != pg8::GRID) { fprintf(stderr, "kernel_launch: built for %d CUs, device has %d\n", pg8::GRID, cus); grid = -1; return; }
        grid = cus;
    }
    if (grid < 0) return;
    (void)hipMemsetAsync((char*)d_ws + WS_CTL, 0, CTL_ZERO_BYTES, stream);
    Args a{};
    for (int i = 0; i < 22; ++i) a.in[i] = d_in[i];
    a.out = (float*)d_out; a.ws = (unsigned char*)d_ws;
    hipLaunchKernelGGL(mega_fwd, dim3(grid), dim3(NTHREADS), LDS_BYTES, stream, a);
}
```

```cpp
#include <hip/hip_runtime.h>
#include <cstdio>
#include <cstdint>

#define LAS __attribute__((address_space(3)))
#define GAS __attribute__((address_space(1)))
typedef unsigned short bf16_t;
typedef short bf16x8 __attribute__((ext_vector_type(8)));
typedef short bf16x4 __attribute__((ext_vector_type(4)));
typedef float f32x2 __attribute__((ext_vector_type(2)));
typedef float f32x4 __attribute__((ext_vector_type(4)));
typedef float f32x16 __attribute__((ext_vector_type(16)));
typedef unsigned u32x2 __attribute__((ext_vector_type(2)));
typedef unsigned u32x4 __attribute__((ext_vector_type(4)));
typedef unsigned long long u64;
typedef int i32x2 __attribute__((ext_vector_type(2)));
typedef int i32x4 __attribute__((ext_vector_type(4)));
typedef int i32x8 __attribute__((ext_vector_type(8)));

constexpr int T = 32768, SEQ = 16384, DM = 2048;
constexpr int FFN = 5632, MFFN = 7168, NEXP = 8;
constexpr int NQKV = 2560, NWIN = 4864;
constexpr float ALPHA = 1.41421356237309515f;
constexpr float LN_EPS = 1e-5f, RMS_EPS = 1e-6f;
constexpr float QSCALE_SWA = 0.18033688011112042f;
constexpr float SCALE2_MLA = 0.10411754627697264f;
constexpr float LOG2E = 1.4426950408889634f;
constexpr int NWAVES = 8, NTHREADS = 512;
constexpr float W13_F8SCALE = 32.0f;
constexpr bool F8_FFN1 = true, F8_FFN2 = true, F8_QKV = true, F8_WO0 = true, F8_WIN = false, F8_WO1 = true;
constexpr bool EPI_ALIGN_RES = true;
constexpr bool SWA_FRAG = true;
constexpr bool F8_LAT = true;
constexpr float QLAT_F8SCALE = 8.0f, OLAT_F8SCALE = 32.0f, WUV_F8SCALE = 16.0f;
constexpr bool F8_KV = true;
constexpr float KV_F8SCALE = 16.0f;
constexpr bool F8_WIN_SPLIT = true;
constexpr int WIN_F8_TILES = 14;
constexpr float WQKV_F8SCALE = 32.0f, WIN_F8SCALE = 32.0f, WO_F8SCALE = 64.0f, O0_F8SCALE = 16.0f, O2_F8SCALE = 32.0f;
constexpr float ACT_F8SCALE = 16.0f, W2_F8SCALE = 128.0f;

constexpr size_t MiB = 1u << 20;
constexpr size_t WS_CTL = 0, CTL_ZERO_BYTES = 1 * MiB;
constexpr size_t WS_WQKV = 2 * MiB, WS_WO0 = 12 * MiB, WS_W13 = 20 * MiB, WS_W2 = 64 * MiB, WS_WG0 = 86 * MiB, WS_WG1 = 94 * MiB, WS_WP0 = 102 * MiB, WS_WP1 = 103 * MiB,
                 WS_WIN = 104 * MiB, WS_WUK = 123 * MiB, WS_WUV = 125 * MiB, WS_WO1 = 129 * MiB;
constexpr size_t WS_TAB64 = 137 * MiB, WS_TAB32 = 145 * MiB, WS_PB = 149 * MiB, WS_XBA = 181 * MiB, WS_XBB = 309 * MiB;
constexpr size_t WS_TOKE = 437 * MiB;
constexpr size_t WS_TOKG = WS_TOKE + 256 * 1024;
constexpr size_t WS_TOKL = WS_TOKG + 256 * 1024;
constexpr size_t WS_TOKS = WS_TOKL + 256 * 1024;
constexpr size_t WS_SGATE = WS_TOKS + 256 * 1024;
constexpr size_t WS_WI = 439 * MiB, WS_SEL = 441 * MiB, WS_R = 458 * MiB;
constexpr size_t WS_Q = WS_R, WS_K = WS_R + 128 * MiB, WS_VT = WS_R + 144 * MiB, WS_ACT = WS_R + 160 * MiB, WS_PP0 = WS_R + 512 * MiB, WS_O8 = WS_R + 640 * MiB, WS_XB8 = WS_R + 704 * MiB  , WS_WIN8 = WS_R + 768 * MiB  ;
constexpr size_t WS_QN = WS_R, WS_QR = WS_R + 128 * MiB, WS_CRAW = WS_R + 192 * MiB, WS_KV = WS_R + 256 * MiB, WS_QI = WS_R + 292 * MiB, WS_KIF = WS_R + 356 * MiB,
                 WS_QLAT = WS_R + 360 * MiB, WS_O2 = WS_R + 872 * MiB;
constexpr size_t WS_MW13 = WS_R + 1128 * MiB, WS_MW2 = WS_R + 1352 * MiB, WS_XG = WS_R, WS_SOUT = WS_R + 136 * MiB, WS_ACT2 = WS_R + 404 * MiB  , WS_PP1 = WS_R + 884 * MiB;
constexpr size_t WS_END = WS_R + 1464 * MiB;
constexpr int MAXSLOTS = 67840;
constexpr int CHUNK_TILES = 272;
constexpr int CW_TMO = 0, CW_CNT = 64  , CW_BAR = 4096;

constexpr int LDS_BYTES = 155648;
constexpr int MISC_OFF = 150016;
constexpr int DSA_WBUF = 18688;

typedef __bf16 bf16x2_t __attribute__((ext_vector_type(2)));
__device__ __forceinline__ unsigned cvt_pk_bf16(float lo, float hi) { const f32x2 v = {lo, hi}; return __builtin_bit_cast(unsigned, __builtin_convertvector(v, bf16x2_t)); }
__device__ __forceinline__ float bf2f(unsigned short h) { return __uint_as_float(((unsigned)h) << 16); }
__device__ __forceinline__ float bflo(unsigned w) { return __uint_as_float(w << 16); }
__device__ __forceinline__ float bfhi(unsigned w) { return __uint_as_float(w & 0xffff0000u); }
__device__ __forceinline__ int fresh_lane() { unsigned m = ~0u; asm volatile("" : "+v"(m)); return (int)__builtin_amdgcn_mbcnt_hi(m, __builtin_amdgcn_mbcnt_lo(m, 0u)); }
__device__ __forceinline__ float shx(float v, int o, int lane) { return __int_as_float(__builtin_amdgcn_ds_bpermute((lane ^ o) << 2, __float_as_int(v))); }
__device__ __forceinline__ float wave_sum(float v) {
    const int l = fresh_lane();
#pragma unroll
    for (int o = 1; o < 64; o <<= 1) v += shx(v, o, l);
    return v;
}
__device__ __forceinline__ unsigned pk4_fp8(float a, float b, float c, float d) { unsigned w = 0u; w = (unsigned)__builtin_amdgcn_cvt_pk_fp8_f32(a, b, (int)w, false); w = (unsigned)__builtin_amdgcn_cvt_pk_fp8_f32(c, d, (int)w, true); return w; }
#define LDS_WAIT() asm volatile("s_waitcnt lgkmcnt(0)" ::: "memory")
#define VM_WAIT() asm volatile("s_waitcnt vmcnt(0)" ::: "memory")

namespace pg8 {
constexpr int BM = 256, BK = 64, HALF = 128, HTB = HALF * BK * 2, STAGE_BYTES = 8 * HTB, NXCD = 8, WGM = 8;
__host__ __device__ __forceinline__ int lds_byte(int r, int c) { const int st = (r >> 4) * 2 + (c >> 5), rr = r & 15, cc = c & 31, ob = rr * 64 + cc * 2; return st * 1024 + (ob ^ (((ob >> 9) & 1) << 5)); }
__host__ __device__ __forceinline__ void stage_rc(int b, int& R, int& C) { const int st = b / 1024, sb = b % 1024, swz = sb ^ (((sb >> 9) & 1) << 5); R = (st >> 1) * 16 + swz / 64; C = (st & 1) * 32 + (swz % 64) / 2; }
__host__ __device__ __forceinline__ int perm32(int rho) { const int n = rho >> 4, i = rho & 15; return 8 * (i >> 2) + 4 * n + (i & 3); }

struct Unit { int pm, pn, am, acol, bn; };
struct Gemm { const bf16_t* A; const bf16_t* Bt; int lda, ldb, K; };

constexpr int GRID = 256;
template <int MODE, int NM, int NN> struct GridOrder {
    __device__ __forceinline__ bool next(int i, Unit& u) const {
        constexpr int nwg = NM * NN;
        int L = i * GRID + (int)blockIdx.x;
        if constexpr (MODE == 4) {
            if (i >= 6) { if ((int)blockIdx.x < GRID / 2 || i >= 8) return false; L = 6 * GRID + ((int)blockIdx.x - GRID / 2) * 2 + (i - 6); } }
        if (L >= nwg) return false;
        int wgid = L; { constexpr int q = nwg / NXCD, r = nwg % NXCD; const int xcd = wgid % NXCD, off = wgid / NXCD; wgid = (xcd < r ? xcd * (q + 1) : r * (q + 1) + (xcd - r) * q) + off; }
        constexpr int nig = WGM * NN; const int gid = wgid / nig, fm = gid * WGM, gsz = (NM - fm) < WGM ? (NM - fm) : WGM;
        u.pm = fm + ((wgid % nig) % gsz); u.pn = (wgid % nig) / gsz; u.am = u.pm; u.bn = u.pn;
        u.acol = MODE == 1 ? (u.pn >> 1) * 128 : (MODE == 2 ? u.pn * 1024 : (MODE == 3 ? u.pn * 512 : 0));
        return true;
    }
};
template <int NM, int NN> struct GridOrderSkip {
    int skip;
    __device__ __forceinline__ bool next(int i, Unit& u) const {
        constexpr int nwg = NM * NN; const int nW = GRID - skip, br = (int)blockIdx.x - skip; if (br < 0) return false;
        const int L = i * nW + br; if (L >= nwg) return false;
        int wgid = L; { constexpr int q = nwg / NXCD, r = nwg % NXCD; const int xcd = wgid % NXCD, off = wgid / NXCD; wgid = (xcd < r ? xcd * (q + 1) : r * (q + 1) + (xcd - r) * q) + off; }
        constexpr int nig = WGM * NN; const int gid = wgid / nig, fm = gid * WGM, gsz = (NM - fm) < WGM ? (NM - fm) : WGM;
        u.pm = fm + ((wgid % nig) % gsz); u.pn = (wgid % nig) / gsz; u.am = u.pm; u.bn = u.pn; u.acol = 0;
        return true;
    }
};
template <bool DOWN, int NN> struct MoeOrder {
    int tile0, ntl;
    __device__ __forceinline__ bool next(int i, Unit& u) const {
        int pml, pn;
        if constexpr (!DOWN && NN % 8 == 0) {
            constexpr int NJ = NN / 8; const int x = (int)blockIdx.x & 7, q = i * (GRID / 8) + ((int)blockIdx.x >> 3); if (q >= ntl * NJ) return false;
            const int nfull = ntl >> 3; int m, j;
            if (q < nfull * 8 * NJ) { const int b = q / (8 * NJ), w = q - b * (8 * NJ); m = b * 8 + (w & 7); j = w >> 3; }
            else { const int g = ntl - nfull * 8, w = q - nfull * 8 * NJ; j = w / g; m = nfull * 8 + (w - j * g); }
            pml = m; pn = 8 * j + x;
        } else {
        const int L = i * GRID + (int)blockIdx.x; if (L >= ntl * NN) return false;
        constexpr int nig = WGM * NN; const int wgid = L, gid = wgid / nig, fm = gid * WGM, gsz = (ntl - fm) < WGM ? (ntl - fm) : WGM;
        pml = fm + ((wgid % nig) % gsz); pn = (wgid % nig) / gsz; }
        const int pmg = tile0 + pml;
        const u32x4 t0 = *(const LAS u32x4*)(MISC_OFF + 20 * 4), t1 = *(const LAS u32x4*)(MISC_OFF + 24 * 4);
        int e = (pmg >= (int)t0.x) + (pmg >= (int)t0.y) + (pmg >= (int)t0.z) + (pmg >= (int)t0.w) + (pmg >= (int)t1.x) + (pmg >= (int)t1.y) + (pmg >= (int)t1.z);
        e = __builtin_amdgcn_readfirstlane(e);
        u.pn = pn; u.bn = e * NN + pn; u.acol = 0;
        if (DOWN) { u.pm = pmg; u.am = pml; } else { u.pm = pml; u.am = pmg; }
        return true;
    }
};

__device__ __forceinline__ void stage16_s(const char* gbase, unsigned voff, unsigned lds_dst) { unsigned keep;
    asm volatile("s_mov_b32 %0, m0\n\ts_mov_b32 m0, %3\n\ts_nop 0\n\tglobal_load_lds_dwordx4 %1, %2\n\ts_mov_b32 m0, %0" : "=&s"(keep) : "v"(voff), "s"(gbase), "s"(lds_dst) : "memory"); }
template <class Epi, class Sched, bool FP8 = false, bool ALIGN = true>
__device__ __forceinline__ void gemm_phase(LAS unsigned char* lds, const Gemm g, const Sched& S, const Epi& E, int wave_) {
    int tid_ = wave_ * 64 + fresh_lane(); asm volatile("" : "+v"(tid_));
    const int tid = tid_, wid = __builtin_amdgcn_readfirstlane(tid >> 6), lane = tid & 63, wr = wid >> 2, wc = wid & 3, fr = lane & 15, fq = lane >> 4;
    int K_ = g.K; asm volatile("" : "+s"(K_));
    const int K = K_, nt = K / BK;
    unsigned voffA[2], voffB[2];
#pragma unroll
    for (int i = 0; i < 2; ++i) { int R, C; stage_rc(tid * 16 + i * 8192, R, C); const int Rb = (R & ~31) + perm32(R & 31);
        voffA[i] = (unsigned)(R * g.lda + C) * 2u; voffB[i] = (unsigned)(Rb * g.ldb + C) * 2u; }
    const size_t kstep = (size_t)(BK * 2);
    const size_t hstepA = (size_t)HALF * g.lda * 2, hstepB = (size_t)HALF * g.ldb * 2;
    const unsigned ldsw = (unsigned)wid * 1024u;
    const int aoff = lds_byte(wr * 64 + fr, fq * 8), boff = lds_byte(wc * 32 + fr, fq * 8);
#define PG8_SA(b, h) (((b) * 2 + (h)) * HTB)
#define PG8_SB(b, h) ((4 + (b) * 2 + (h)) * HTB)
#define PG8_STAGE(bufoff, gbase, voff) do { _Pragma("unroll") for (int _i = 0; _i < 2; ++_i) { \
        if constexpr (FP8) stage16_s((const char*)(gbase), (voff)[_i], (unsigned)(size_t)(lds + (bufoff) + ldsw + _i * 8192)); \
        else __builtin_amdgcn_global_load_lds((const unsigned*)((const char*)(gbase) + (voff)[_i]), (LAS unsigned*)(lds + (bufoff) + ldsw + _i * 8192), 16, 0, 0); } } while (0)
#define PG8_LDA(dst, b, h) do { _Pragma("unroll") for (int m = 0; m < 4; ++m) _Pragma("unroll") for (int k = 0; k < 2; ++k) dst[m][k] = *(const LAS bf16x8*)(lds + PG8_SA(b, h) + aoff + m * 2048 + k * 1024); } while (0)
#define PG8_LDB(dst, b, h) do { _Pragma("unroll") for (int n = 0; n < 2; ++n) _Pragma("unroll") for (int k = 0; k < 2; ++k) dst[n][k] = *(const LAS bf16x8*)(lds + PG8_SB(b, h) + boff + n * 2048 + k * 1024); } while (0)
#define PG8_MMA(ai, bj, At, Bt) do { __builtin_amdgcn_s_setprio(1); _Pragma("unroll") for (int m = 0; m < 4; ++m) _Pragma("unroll") for (int n = 0; n < 2; ++n) _Pragma("unroll") for (int k = 0; k < 2; ++k) \
        acc[ai][bj][m][n] = __builtin_amdgcn_mfma_f32_16x16x32_bf16(Bt[n][k], At[m][k], acc[ai][bj][m][n], 0, 0, 0); __builtin_amdgcn_s_setprio(0); } while (0)
#define PG8_LDA8(dst, b, h) do { _Pragma("unroll") for (int m = 0; m < 4; ++m) { const i32x4 lo_ = *(const LAS i32x4*)(lds + PG8_SA(b, h) + aoff + m * 2048), hi_ = *(const LAS i32x4*)(lds + PG8_SA(b, h) + aoff + m * 2048 + 1024); \
        dst[m] = __builtin_shufflevector(lo_, hi_, 0, 1, 2, 3, 4, 5, 6, 7); } } while (0)
#define PG8_LDB8(dst, b, h) do { _Pragma("unroll") for (int n = 0; n < 2; ++n) { const i32x4 lo_ = *(const LAS i32x4*)(lds + PG8_SB(b, h) + boff + n * 2048), hi_ = *(const LAS i32x4*)(lds + PG8_SB(b, h) + boff + n * 2048 + 1024); \
        dst[n] = __builtin_shufflevector(lo_, hi_, 0, 1, 2, 3, 4, 5, 6, 7); } } while (0)
#define PG8_MMA8(ai, bj, At, Bt) do { __builtin_amdgcn_s_setprio(1); _Pragma("unroll") for (int m = 0; m < 4; ++m) _Pragma("unroll") for (int n = 0; n < 2; ++n) \
        acc[ai][bj][m][n] = __builtin_amdgcn_mfma_scale_f32_16x16x128_f8f6f4(Bt[n], At[m], acc[ai][bj][m][n], 0, 0, 0, 0, 0, 0); __builtin_amdgcn_s_setprio(0); } while (0)
#define PG8_WAIT_V(n) asm volatile("s_waitcnt vmcnt(" #n ")" ::: "memory")
#define PG8_WAIT_L(n) asm volatile("s_waitcnt lgkmcnt(" #n ")" ::: "memory")
#define PG8_BAR __builtin_amdgcn_s_barrier()
#define PG8_SCHED __builtin_amdgcn_sched_barrier(0)
#define PG8_ABASE(u) ((const char*)g.A + ((size_t)(u).am * BM * g.lda + (size_t)(u).acol) * 2)
#define PG8_BBASE(u) ((const char*)g.Bt + (size_t)(u).bn * BM * g.ldb * 2)
    Unit cur, nxt; int ui = 0;
    if (!S.next(0, cur)) return;
    f32x4 acc[2][2][4][2];
#pragma unroll
    for (int a = 0; a < 2; ++a)
#pragma unroll
        for (int b = 0; b < 2; ++b)
#pragma unroll
            for (int m = 0; m < 4; ++m)
#pragma unroll
                for (int n = 0; n < 2; ++n) acc[a][b][m][n] = (f32x4){0.f, 0.f, 0.f, 0.f};
    bf16x8 At[4][2], B0[2][2], B1[2][2]; i32x8 At8[4], B08[2], B18[2];
    const char* cA = PG8_ABASE(cur); const char* cB = PG8_BBASE(cur);
    {
        PG8_STAGE(PG8_SB(0, 0), cB, voffB); PG8_STAGE(PG8_SB(0, 1), cB + hstepB, voffB); PG8_STAGE(PG8_SA(0, 0), cA, voffA); PG8_STAGE(PG8_SA(0, 1), cA + hstepA, voffA);
        if (wr == 1) PG8_BAR;
        PG8_WAIT_V(2); PG8_BAR;
        PG8_STAGE(PG8_SB(1, 0), cB + kstep, voffB); PG8_STAGE(PG8_SA(1, 0), cA + kstep, voffA); PG8_STAGE(PG8_SB(1, 1), cB + hstepB + kstep, voffB);
        PG8_WAIT_V(6); PG8_BAR;
    }
    for (;;) {
        const bool has_next = S.next(ui + 1, nxt);
        const char* nA = has_next ? PG8_ABASE(nxt) : cA; const char* nB = has_next ? PG8_BBASE(nxt) : cB;
        for (int t = 0; t < nt; t += 2) {
            const bool last = (t == nt - 2);
            const char* a1 = cA + (size_t)(t + 1) * kstep;
            const char* a2 = last ? nA : cA + (size_t)(t + 2) * kstep; const char* b2 = last ? nB : cB + (size_t)(t + 2) * kstep;
            const char* a3 = a2 + kstep; const char* b3 = b2 + kstep;
            if constexpr (FP8) {
            PG8_LDB8(B08, 0, 0); PG8_LDB8(B18, 0, 1); PG8_SCHED; PG8_LDA8(At8, 0, 0); PG8_STAGE(PG8_SA(1, 1), a1 + hstepA, voffA);
            PG8_WAIT_V(8); PG8_WAIT_L(0); PG8_BAR; PG8_MMA8(0, 0, At8, B08); PG8_MMA8(0, 1, At8, B18); PG8_BAR; PG8_SCHED;
            PG8_LDA8(At8, 0, 1); PG8_STAGE(PG8_SB(0, 0), b2, voffB); PG8_STAGE(PG8_SB(0, 1), b2 + hstepB, voffB); PG8_STAGE(PG8_SA(0, 0), a2, voffA);
            PG8_WAIT_V(8); PG8_WAIT_L(0); PG8_BAR; PG8_MMA8(1, 0, At8, B08); PG8_MMA8(1, 1, At8, B18); PG8_BAR; PG8_SCHED;
            PG8_LDB8(B08, 1, 0); PG8_LDB8(B18, 1, 1); PG8_SCHED; PG8_LDA8(At8, 1, 0); PG8_STAGE(PG8_SA(0, 1), a2 + hstepA, voffA);
            PG8_WAIT_V(8); PG8_WAIT_L(0); PG8_BAR; PG8_MMA8(0, 0, At8, B08); PG8_MMA8(0, 1, At8, B18); PG8_BAR; PG8_SCHED;
            PG8_LDA8(At8, 1, 1); PG8_STAGE(PG8_SB(1, 0), b3, voffB); PG8_STAGE(PG8_SB(1, 1), b3 + hstepB, voffB); PG8_STAGE(PG8_SA(1, 0), a3, voffA);
            PG8_WAIT_V(8); PG8_WAIT_L(0); PG8_BAR; PG8_MMA8(1, 0, At8, B08); PG8_MMA8(1, 1, At8, B18); PG8_BAR; PG8_SCHED;
            } else {
            PG8_LDB(B0, 0, 0); PG8_LDB(B1, 0, 1); PG8_SCHED; PG8_LDA(At, 0, 0); PG8_STAGE(PG8_SA(1, 1), a1 + hstepA, voffA);
            PG8_WAIT_V(8); PG8_WAIT_L(0); PG8_BAR; PG8_MMA(0, 0, At, B0); PG8_MMA(0, 1, At, B1); PG8_BAR; PG8_SCHED;
            PG8_LDA(At, 0, 1); PG8_STAGE(PG8_SB(0, 0), b2, voffB); PG8_STAGE(PG8_SB(0, 1), b2 + hstepB, voffB); PG8_STAGE(PG8_SA(0, 0), a2, voffA);
            PG8_WAIT_V(8); PG8_WAIT_L(0); PG8_BAR; PG8_MMA(1, 0, At, B0); PG8_MMA(1, 1, At, B1); PG8_BAR; PG8_SCHED;
            PG8_LDB(B0, 1, 0); PG8_LDB(B1, 1, 1); PG8_SCHED; PG8_LDA(At, 1, 0); PG8_STAGE(PG8_SA(0, 1), a2 + hstepA, voffA);
            PG8_WAIT_V(8); PG8_WAIT_L(0); PG8_BAR; PG8_MMA(0, 0, At, B0); PG8_MMA(0, 1, At, B1); PG8_BAR; PG8_SCHED;
            PG8_LDA(At, 1, 1); PG8_STAGE(PG8_SB(1, 0), b3, voffB); PG8_STAGE(PG8_SB(1, 1), b3 + hstepB, voffB); PG8_STAGE(PG8_SA(1, 0), a3, voffA);
            PG8_WAIT_V(8); PG8_WAIT_L(0); PG8_BAR; PG8_MMA(1, 0, At, B0); PG8_MMA(1, 1, At, B1); PG8_BAR; PG8_SCHED;
            }
        }
        if constexpr (ALIGN) { if (wr == 0) PG8_BAR; }
        { int fr_ = fr, fq_ = fq; asm volatile("" : "+v"(fr_), "+v"(fq_));
          E(acc, cur, wr, wc, fr_, fq_); }
        if (!has_next) break;
#pragma unroll
        for (int a = 0; a < 2; ++a)
#pragma unroll
            for (int b = 0; b < 2; ++b)
#pragma unroll
                for (int m = 0; m < 4; ++m)
#pragma unroll
                    for (int n = 0; n < 2; ++n) acc[a][b][m][n] = (f32x4){0.f, 0.f, 0.f, 0.f};
        cur = nxt; cA = nA; cB = nB; ++ui;
        if constexpr (ALIGN) { if (wr == 1) PG8_BAR; }
    }
    PG8_WAIT_V(0);
    if constexpr (!ALIGN) { if (wr == 0) PG8_BAR; }
    PG8_BAR;
#undef PG8_SA
#undef PG8_SB
#undef PG8_STAGE
#undef PG8_LDA
#undef PG8_LDB
#undef PG8_MMA
#undef PG8_LDA8
#undef PG8_LDB8
#undef PG8_MMA8
#undef PG8_WAIT_V
#undef PG8_WAIT_L
#undef PG8_BAR
#undef PG8_SCHED
#undef PG8_ABASE
#undef PG8_BBASE
}

#define EPI_ROW(ai, m) (u.pm * BM + (ai) * HALF + wr * 64 + (m) * 16 + fr)
#define EPI_COL(bj) (u.pn * BM + (bj) * HALF + wc * 32 + 8 * fq)
typedef f32x4 AccT[2][2][4][2];

__device__ __forceinline__ void rope4(f32x4& v0, f32x4& v1, const f32x4 cs0, const f32x4 cs1) {
    f32x4 o0, o1;
    o0[0] = v0[0] * cs0[0] - v0[1] * cs0[1]; o0[1] = v0[1] * cs0[0] + v0[0] * cs0[1];
    o0[2] = v0[2] * cs0[2] - v0[3] * cs0[3]; o0[3] = v0[3] * cs0[2] + v0[2] * cs0[3];
    o1[0] = v1[0] * cs1[0] - v1[1] * cs1[1]; o1[1] = v1[1] * cs1[0] + v1[0] * cs1[1];
    o1[2] = v1[2] * cs1[2] - v1[3] * cs1[3]; o1[3] = v1[3] * cs1[2] + v1[2] * cs1[3];
    v0 = o0; v1 = o1;
}
__device__ __forceinline__ u32x4 pack8(const f32x4 v0, const f32x4 v1) { u32x4 w; w.x = cvt_pk_bf16(v0[0], v0[1]); w.y = cvt_pk_bf16(v0[2], v0[3]); w.z = cvt_pk_bf16(v1[0], v1[1]); w.w = cvt_pk_bf16(v1[2], v1[3]); return w; }

__device__ __forceinline__ void unpack8(const u32x4 w, f32x4& a, f32x4& b) { a[0] = bflo(w.x); a[1] = bfhi(w.x); a[2] = bflo(w.y); a[3] = bfhi(w.y); b[0] = bflo(w.z); b[1] = bfhi(w.z); b[2] = bflo(w.w); b[3] = bfhi(w.w); }
__device__ __forceinline__ u32x2 pack8_fp8(const f32x4 v0, const f32x4 v1, float s) { u32x2 w; w.x = pk4_fp8(v0[0] * s, v0[1] * s, v0[2] * s, v0[3] * s); w.y = pk4_fp8(v1[0] * s, v1[1] * s, v1[2] * s, v1[3] * s); return w; }
template <bool OUT8> struct EpiBf16 {
    bf16_t* O; int ldc; float osc;
    __device__ __forceinline__ void operator()(const AccT& acc, const Unit& u, int wr, int wc, int fr, int fq) const {
#pragma unroll
        for (int ai = 0; ai < 2; ++ai)
#pragma unroll
            for (int m = 0; m < 4; ++m) {
#pragma unroll
                for (int bj = 0; bj < 2; ++bj) {
                    if constexpr (OUT8) *(u32x2*)((unsigned char*)O + (size_t)EPI_ROW(ai, m) * ldc + EPI_COL(bj)) = pack8_fp8(acc[ai][bj][m][0], acc[ai][bj][m][1], osc);
                    else *(u32x4*)(O + (size_t)EPI_ROW(ai, m) * ldc + EPI_COL(bj)) = pack8(acc[ai][bj][m][0] * osc, acc[ai][bj][m][1] * osc); } }
    }
};
struct EpiQKV {
    unsigned char* ws; float asc;
    __device__ __forceinline__ void operator()(const AccT& acc, const Unit& u, int wr, int wc, int fr, int fq) const {
        bf16_t* Q = (bf16_t*)(ws + WS_Q); bf16_t* Kb = (bf16_t*)(ws + WS_K); bf16_t* VT = (bf16_t*)(ws + WS_VT); const float* tab64 = (const float*)(ws + WS_TAB64);
        if (u.pn < 9) {
            bf16_t* base = u.pn < 8 ? Q : Kb; const int ldc = u.pn < 8 ? 2048 : 256; const int colt = u.pn < 8 ? u.pn * BM : 0; const float sc = (u.pn < 8 ? QSCALE_SWA : 1.0f) * asc;
#pragma unroll
            for (int ai = 0; ai < 2; ++ai)
#pragma unroll
                for (int m = 0; m < 4; ++m) { const int row = EPI_ROW(ai, m);
#pragma unroll
                    for (int bj = 0; bj < 2; ++bj) { const int cl = bj * HALF + wc * 32 + 8 * fq; const int i0 = (cl & 63) >> 1;
                        const f32x4 cs0 = *(const f32x4*)(tab64 + ((size_t)row * 32 + i0) * 2), cs1 = *(const f32x4*)(tab64 + ((size_t)row * 32 + i0) * 2 + 4);
                        f32x4 v0 = acc[ai][bj][m][0], v1 = acc[ai][bj][m][1]; rope4(v0, v1, cs0, cs1); v0 = v0 * sc; v1 = v1 * sc;
                        if constexpr (SWA_FRAG) {
                            const int b = row >> 14, s = row & (SEQ - 1), hh = (colt + cl) >> 6, c64 = cl & 63, kk = c64 >> 4, hf2 = (c64 >> 3) & 1, nh = u.pn < 8 ? 32 : 4;
                            *(u32x4*)(base + ((((size_t)(b * nh + hh) * 512 + (s >> 5)) * 4 + kk) * 64 + hf2 * 32 + (s & 31)) * 8) = pack8(v0, v1); }
                        else *(u32x4*)(base + (size_t)row * ldc + colt + cl) = pack8(v0, v1); } }
        } else {
#pragma unroll
            for (int ai = 0; ai < 2; ++ai)
#pragma unroll
                for (int m = 0; m < 4; ++m) { const int row = EPI_ROW(ai, m), b = row >> 14, s = row & (SEQ - 1);
#pragma unroll
                    for (int bj = 0; bj < 2; ++bj) { const int cl = bj * HALF + wc * 32 + 8 * fq, kvh = cl >> 6, d0 = cl & 63;
                        const u32x4 w = pack8(acc[ai][bj][m][0] * asc, acc[ai][bj][m][1] * asc);
                        if constexpr (SWA_FRAG) {
                            const int j = s & 31, c = j >> 4, jj = j & 15, hfv = (jj & 7) >> 2, e = (jj & 3) + ((jj >> 3) << 2), mt = d0 >> 5;
                            bf16_t* pf = VT + (((((size_t)(b * 4 + kvh) * 512 + (s >> 5)) * 2 + c) * 2 + mt) * 64 + hfv * 32 + (d0 & 31)) * 8 + e;
                            pf[0] = (bf16_t)(w.x & 0xffff); pf[8] = (bf16_t)(w.x >> 16); pf[16] = (bf16_t)(w.y & 0xffff); pf[24] = (bf16_t)(w.y >> 16);
                            pf[32] = (bf16_t)(w.z & 0xffff); pf[40] = (bf16_t)(w.z >> 16); pf[48] = (bf16_t)(w.w & 0xffff); pf[56] = (bf16_t)(w.w >> 16); }
                        else {
                        bf16_t* p = VT + ((size_t)(b * 4 + kvh) * 64 + d0) * SEQ + s;
                        p[0 * SEQ] = (bf16_t)(w.x & 0xffff); p[1 * SEQ] = (bf16_t)(w.x >> 16); p[2 * SEQ] = (bf16_t)(w.y & 0xffff); p[3 * SEQ] = (bf16_t)(w.y >> 16);
                        p[4 * SEQ] = (bf16_t)(w.z & 0xffff); p[5 * SEQ] = (bf16_t)(w.z >> 16); p[6 * SEQ] = (bf16_t)(w.w & 0xffff); p[7 * SEQ] = (bf16_t)(w.w >> 16); } } }
        }
    }
};
template <bool RES16> struct EpiRes {
    const void* res; bf16_t* out; float sc;
    __device__ __forceinline__ void operator()(const AccT& acc, const Unit& u, int wr, int wc, int fr, int fq) const {
#pragma unroll
        for (int ai = 0; ai < 2; ++ai)
#pragma unroll
            for (int m = 0; m < 4; ++m) { const size_t ro = (size_t)EPI_ROW(ai, m) * DM;
#pragma unroll
                for (int bj = 0; bj < 2; ++bj) { const size_t o = ro + EPI_COL(bj); f32x4 r0, r1;
                    if constexpr (RES16) unpack8(*(const u32x4*)((const bf16_t*)res + o), r0, r1);
                    else { r0 = *(const f32x4*)((const float*)res + o); r1 = *(const f32x4*)((const float*)res + o + 4); }
                    *(u32x4*)(out + o) = pack8(r0 * ALPHA + acc[ai][bj][m][0] * sc, r1 * ALPHA + acc[ai][bj][m][1] * sc); }
                asm volatile("" ::: "memory"); }
    }
};
__device__ __forceinline__ float silu_mul(float g, float uu) { return g * __builtin_amdgcn_rcpf(1.0f + __builtin_amdgcn_exp2f(-g * LOG2E)) * uu; }
template <bool OUT8> struct EpiSwiglu {
    bf16_t* O; int ldc; float sc; float osc;
    __device__ __forceinline__ void operator()(const AccT& acc, const Unit& u, int wr, int wc, int fr, int fq) const {
#pragma unroll
        for (int ai = 0; ai < 2; ++ai)
#pragma unroll
            for (int m = 0; m < 4; ++m) { f32x4 a0, a1;
#pragma unroll
                for (int j = 0; j < 4; ++j) { a0[j] = silu_mul(acc[ai][0][m][0][j] * sc, acc[ai][1][m][0][j] * sc); a1[j] = silu_mul(acc[ai][0][m][1][j] * sc, acc[ai][1][m][1][j] * sc); }
                if constexpr (OUT8) { u32x2 w8; w8.x = pk4_fp8(a0[0] * osc, a0[1] * osc, a0[2] * osc, a0[3] * osc); w8.y = pk4_fp8(a1[0] * osc, a1[1] * osc, a1[2] * osc, a1[3] * osc);
                    *(u32x2*)((unsigned char*)O + (size_t)EPI_ROW(ai, m) * ldc + u.pn * HALF + wc * 32 + 8 * fq) = w8; }
                else *(u32x4*)(O + (size_t)EPI_ROW(ai, m) * ldc + u.pn * HALF + wc * 32 + 8 * fq) = pack8(a0, a1); }
    }
};
struct EpiPle {
    float* outf; unsigned char* ws; int layer;
    __device__ __forceinline__ void operator()(const AccT& acc, const Unit& u, int wr, int wc, int fr, int fq) const {
        const bf16_t* pp = (const bf16_t*)(ws + (layer == 0 ? WS_PP0 : WS_PP1));
        const bf16_t* xres = (const bf16_t*)(ws + (layer == 0 ? WS_XBA : WS_XBB));
#pragma unroll
        for (int ai = 0; ai < 2; ++ai)
#pragma unroll
            for (int m = 0; m < 4; ++m) { const size_t ro = (size_t)EPI_ROW(ai, m) * DM;
#pragma unroll
                for (int bj = 0; bj < 2; ++bj) { const size_t o = ro + EPI_COL(bj);
                    f32x4 r0, r1, p0, p1; unpack8(*(const u32x4*)(xres + o), r0, r1); unpack8(*(const u32x4*)(pp + o), p0, p1);
                    f32x4 s0, s1;
#pragma unroll
                    for (int j = 0; j < 4; ++j) { s0[j] = __builtin_amdgcn_rcpf(1.0f + __builtin_amdgcn_exp2f(-acc[ai][bj][m][0][j] * LOG2E)); s1[j] = __builtin_amdgcn_rcpf(1.0f + __builtin_amdgcn_exp2f(-acc[ai][bj][m][1][j] * LOG2E)); }
                    const f32x4 o0 = r0 + s0 * p0, o1 = r1 + s1 * p1;
                    if (layer == 0) { *(u32x4*)((bf16_t*)(ws + WS_XBB) + o) = pack8(o0, o1);
                                      if constexpr (F8_WIN_SPLIT || F8_WIN) *(u32x2*)(ws + WS_XB8 + o) = pack8_fp8(o0, o1, 1.0f); }
                    else { *(f32x4*)(outf + o) = o0; *(f32x4*)(outf + o + 4) = o1; } }
                asm volatile("" ::: "memory"); }
    }
};
struct EpiWin {
    unsigned char* ws; float asc; int pn0;
    __device__ __forceinline__ void operator()(const AccT& acc, const Unit& u, int wr, int wc, int fr, int fq) const {
        bf16_t* QN = (bf16_t*)(ws + WS_QN); bf16_t* QR = (bf16_t*)(ws + WS_QR); float* CRAW = (float*)(ws + WS_CRAW); bf16_t* KV = (bf16_t*)(ws + WS_KV); bf16_t* QI = (bf16_t*)(ws + WS_QI);
        bf16_t* KIF = (bf16_t*)(ws + WS_KIF); float* WI = (float*)(ws + WS_WI); const float* tab64 = (const float*)(ws + WS_TAB64); const float* tab32 = (const float*)(ws + WS_TAB32);
        const int pn = u.pn + pn0;
#pragma unroll
        for (int ai = 0; ai < 2; ++ai)
#pragma unroll
            for (int m = 0; m < 4; ++m) { const int row = EPI_ROW(ai, m);
#pragma unroll
                for (int bj = 0; bj < 2; ++bj) { const int cl = bj * HALF + wc * 32 + 8 * fq; f32x4 v0 = acc[ai][bj][m][0] * asc, v1 = acc[ai][bj][m][1] * asc;
                    if (pn < 8) { *(u32x4*)(QN + (size_t)row * 2048 + pn * BM + cl) = pack8(v0, v1); }
                    else if (pn < 12) { const int i0 = (cl & 63) >> 1;
                        const f32x4 cs0 = *(const f32x4*)(tab64 + ((size_t)row * 32 + i0) * 2), cs1 = *(const f32x4*)(tab64 + ((size_t)row * 32 + i0) * 2 + 4);
                        rope4(v0, v1, cs0, cs1); if constexpr (F8_LAT) { v0 = v0 * QLAT_F8SCALE; v1 = v1 * QLAT_F8SCALE; }
                        if constexpr (F8_KV) *(u32x2*)((unsigned char*)QR + (size_t)row * 1024 + (pn - 8) * BM + cl) = pack8_fp8(v0, v1, 1.0f);
                        else *(u32x4*)(QR + (size_t)row * 1024 + (pn - 8) * BM + cl) = pack8(v0, v1); }
                    else if (pn < 14) { float* p = CRAW + (size_t)row * 512 + (pn - 12) * BM + cl; *(f32x4*)p = v0; *(f32x4*)(p + 4) = v1; }
                    else if (pn == 14) {
                        if (cl < 64) { const int i0 = cl >> 1;
                            const f32x4 cs0 = *(const f32x4*)(tab64 + ((size_t)row * 32 + i0) * 2), cs1 = *(const f32x4*)(tab64 + ((size_t)row * 32 + i0) * 2 + 4);
                            rope4(v0, v1, cs0, cs1);
                            if constexpr (F8_KV) *(u32x2*)((unsigned char*)KV + (size_t)row * 576 + 512 + cl) = pack8_fp8(v0, v1, KV_F8SCALE);
                            else *(u32x4*)(KV + (size_t)row * 576 + 512 + cl) = pack8(v0, v1); }
                        else if (cl < 128) { const int d8 = cl - 64;
                            if (d8 < 32) { const int i0 = d8 >> 1;
                                const f32x4 cs0 = *(const f32x4*)(tab32 + ((size_t)row * 16 + i0) * 2), cs1 = *(const f32x4*)(tab32 + ((size_t)row * 16 + i0) * 2 + 4);
                                rope4(v0, v1, cs0, cs1); }
                            const int b = row >> 14, s = row & (SEQ - 1), blk = s >> 5, j = s & 31, kk = d8 >> 4, hf = (d8 >> 3) & 1;
                            *(u32x4*)(KIF + ((size_t)((b * 512 + blk) * 4 + kk) * 64 + hf * 32 + j) * 8) = pack8(v0, v1); }
                        else if (cl < 144) { float* p = WI + (size_t)row * 16 + (cl - 128); *(f32x4*)p = v0; *(f32x4*)(p + 4) = v1; }
                    } else { const int cq = (pn - 15) * BM + cl, d8 = cq & 63;
                        if (d8 < 32) { const int i0 = d8 >> 1;
                            const f32x4 cs0 = *(const f32x4*)(tab32 + ((size_t)row * 16 + i0) * 2), cs1 = *(const f32x4*)(tab32 + ((size_t)row * 16 + i0) * 2 + 4);
                            rope4(v0, v1, cs0, cs1); }
                        *(u32x4*)(QI + (size_t)row * 1024 + cq) = pack8(v0, v1); }
                } }
    }
};
struct EpiMoeDown {
    unsigned char* ws;
    __device__ __forceinline__ void operator()(const AccT& acc, const Unit& u, int wr, int wc, int fr, int fq) const {
        bf16_t* O = (bf16_t*)(ws + WS_SOUT); const float* gate = (const float*)(ws + WS_SGATE);
#pragma unroll
        for (int ai = 0; ai < 2; ++ai)
#pragma unroll
            for (int m = 0; m < 4; ++m) { const int row = EPI_ROW(ai, m); const float gt = gate[row] * (1.0f / (ACT_F8SCALE * W2_F8SCALE)); bf16_t* rowp = O + (size_t)row * DM;
#pragma unroll
                for (int bj = 0; bj < 2; ++bj) *(u32x4*)(rowp + EPI_COL(bj)) = pack8(acc[ai][bj][m][0] * gt, acc[ai][bj][m][1] * gt); }
    }
};
}

#define XB_TMO      128
#define XB_XCNT(j)  (256  + 64 * (j))
#define XB_XSUB(j)  (1280 + 64 * (j))
#define XB_XGEN(j)  (2304 + 64 * (j))
#define XB_TOP      3328
#define XB_TOPGEN   3392
#define XCD_BAR_WORDS 3456
#define XB_SPIN_CAP (1u << 22)

__device__ __forceinline__ unsigned xb_ld(unsigned* p)              { return __hip_atomic_load(p, __ATOMIC_RELAXED, __HIP_MEMORY_SCOPE_AGENT); }
__device__ __forceinline__ unsigned xb_add(unsigned* p, unsigned v) { return __hip_atomic_fetch_add(p, v, __ATOMIC_RELAXED, __HIP_MEMORY_SCOPE_AGENT); }
__device__ __forceinline__ unsigned xb_xcc_id() { return (unsigned)__builtin_amdgcn_s_getreg((3 << 11) | 20) & 0xFu; }
#define XB_SPIN(cond, bar) do { unsigned _sp = 0; while (cond) { __builtin_amdgcn_s_sleep(1); \
    if ((++_sp & 255u) == 0u) { if (xb_ld(&(bar)[XB_TMO])) break; if (_sp > XB_SPIN_CAP) { atomicAdd(&(bar)[XB_TMO], 1u); break; } } } } while (0)

struct XcdBarrier { unsigned* bar; unsigned x; volatile LAS unsigned* st; };

__device__ __forceinline__ XcdBarrier xcd_barrier_post(unsigned* bar, volatile LAS unsigned* st) {
    XcdBarrier b; b.bar = bar; b.x = xb_xcc_id(); b.st = st;
    if (threadIdx.x == 0) (void)xb_add(&bar[XB_XCNT(b.x)], 1u);
    return b;
}
__device__ __forceinline__ void xcd_barrier_complete(unsigned* bar, unsigned x, unsigned& nloc, unsigned& nx) {
    const unsigned G = gridDim.x * gridDim.y * gridDim.z;
    unsigned sum, cnt, mine, sp = 0u;
    for (;;) {
        sum = 0u; cnt = 0u; mine = 0u;
#pragma unroll
        for (unsigned j = 0; j < 16; ++j) { const unsigned c = xb_ld(&bar[XB_XCNT(j)]); sum += c; cnt += (c > 0u) ? 1u : 0u; mine = (j == x) ? c : mine; }
        if (sum == G) break;
        __builtin_amdgcn_s_sleep(1);
        if ((++sp & 255u) == 0u) { if (xb_ld(&bar[XB_TMO])) break; if (sp > XB_SPIN_CAP) { atomicAdd(&bar[XB_TMO], 1u); break; } }
    }
    nloc = mine > 0u ? mine : 1u; nx = cnt > 0u ? cnt : 1u;
}
__device__ __forceinline__ void xcd_barrier(const XcdBarrier& b, int wave_) {
    asm volatile("s_waitcnt vmcnt(0)" ::: "memory");
    __syncthreads();
    int tl_ = wave_ * 64 + fresh_lane();
    if (tl_ == 0) {
        unsigned* bar = b.bar;
        __builtin_amdgcn_s_waitcnt(0);
        unsigned nloc = b.st[0], nx = b.st[1];
        if (nloc == 0u) { xcd_barrier_complete(bar, b.x, nloc, nx); b.st[0] = nloc; b.st[1] = nx; }
        const unsigned old = xb_add(&bar[XB_XSUB(b.x)], 1u);
        const unsigned gen = old / nloc;
        if (old + 1u == (gen + 1u) * nloc) {
            __builtin_amdgcn_fence(__ATOMIC_RELEASE, "agent");
            asm volatile("s_waitcnt vmcnt(0)" ::: "memory");
            const unsigned og = xb_add(&bar[XB_TOP], 1u);
            const unsigned tg = og / nx;
            if (og + 1u == (tg + 1u) * nx) xb_add(&bar[XB_TOPGEN], 1u);
            else XB_SPIN(xb_ld(&bar[XB_TOPGEN]) == tg, bar);
            __builtin_amdgcn_fence(__ATOMIC_ACQUIRE, "agent");
            xb_add(&bar[XB_XGEN(b.x)], 1u);
            asm volatile("s_waitcnt vmcnt(0)" ::: "memory");
        } else {
            XB_SPIN(xb_ld(&bar[XB_XGEN(b.x)]) == gen, bar);
            __builtin_amdgcn_fence(__ATOMIC_ACQUIRE, "agent");
            asm volatile("s_waitcnt vmcnt(0)" ::: "memory");
        }
    }
    __syncthreads();
}

struct Args { const void* in[22]; float* out; unsigned char* ws; };
struct Frame {
    LAS unsigned char* lds; volatile LAS unsigned* MISC; unsigned* ctl;
    int tid, lane, wave, gw; static constexpr int G = 256;
};
__device__ __forceinline__ void glds16(const void* g, LAS void* l) { __builtin_amdgcn_global_load_lds((const unsigned*)g, (LAS unsigned*)l, 16, 0, 0); }
__device__ __forceinline__ int mbcnt64(u64 m) { return (int)__builtin_amdgcn_mbcnt_hi((unsigned)(m >> 32), __builtin_amdgcn_mbcnt_lo((unsigned)m, 0u)); }

__device__ __forceinline__ int il64(int d) { return d < 32 ? 2 * d : 2 * (d - 32) + 1; }
__device__ __forceinline__ int il32(int d) { return d < 16 ? 2 * d : (d < 32 ? 2 * (d - 16) + 1 : d); }
__device__ __forceinline__ int map_row(int mode, int n) {
    if (mode == 1) return n < 2304 ? (n & ~63) + il64(n & 63) : n;
    if (mode == 2) return ((n >> 7) << 8) + (n & 127);
    if (mode == 3) return ((n >> 7) << 8) + 128 + (n & 127);
    if (mode == 4) {
        if (n < 3072) { const int h = n / 192, r = n - h * 192; return r < 128 ? h * 128 + r : 2048 + h * 64 + il64(r - 128); }
        if (n < 3584) return n;
        if (n < 3648) return 3584 + il64(n - 3584);
        if (n < 4672) { const int j = n - 3648; return 3840 + (j & ~63) + il32(j & 63); }
        if (n < 4736) return 3648 + il32(n - 4672);
        return 3712 + (n - 4736);
    }
    return n;
}
__device__ __forceinline__ void tr_item(const float* __restrict__ W, int N, bf16_t* WT, int ldo, int kofs, int mode, LAS float* scr, int item, int lane, float f8scale = 0.f, int rlo = 0, int rhi = 1 << 30) {
    const int nblk = (N + 63) >> 6, kb = item / nblk, nb = item - kb * nblk, k0 = 64 * kb, n0 = 64 * nb;
    const int nc = n0 + 4 * (lane & 15); const bool okr = nc < N; const float* wp = W + (size_t)(k0 + (lane >> 4)) * N + nc;
    f32x4 v[16];
#pragma unroll
    for (int i = 0; i < 16; ++i) v[i] = okr ? *(const f32x4*)(wp + (size_t)(4 * i) * N) : (f32x4){0.f, 0.f, 0.f, 0.f};
#pragma unroll
    for (int i = 0; i < 16; ++i) { const int k = 4 * i + (lane >> 4); *(LAS f32x4*)(scr + k * 64 + ((4 * (lane & 15) + 4 * (i >> 1)) & 63)) = v[i]; }
    LDS_WAIT();
    const int c = lane & 7;
#pragma unroll
    for (int j = 0; j < 8; ++j) { const int nl = (lane >> 3) + 8 * j, n = n0 + nl; const LAS float* s = scr + (8 * c) * 64 + ((nl + 4 * c) & 63);
        const int orow = map_row(mode, n); const bool okw = n < N && orow >= rlo && orow < rhi;
        if (f8scale > 0.f) { u32x2 o8; o8.x = pk4_fp8(s[0 * 64] * f8scale, s[1 * 64] * f8scale, s[2 * 64] * f8scale, s[3 * 64] * f8scale); o8.y = pk4_fp8(s[4 * 64] * f8scale, s[5 * 64] * f8scale, s[6 * 64] * f8scale, s[7 * 64] * f8scale);
            if (okw) *(u32x2*)((unsigned char*)WT + (size_t)orow * ldo + kofs + k0 + 8 * c) = o8; }
        else {
        u32x4 o; o.x = cvt_pk_bf16(s[0 * 64], s[1 * 64]); o.y = cvt_pk_bf16(s[2 * 64], s[3 * 64]); o.z = cvt_pk_bf16(s[4 * 64], s[5 * 64]); o.w = cvt_pk_bf16(s[6 * 64], s[7 * 64]);
        if (okw) *(u32x4*)(WT + (size_t)orow * ldo + kofs + k0 + 8 * c) = o; } }
    LDS_WAIT();
}
__device__ __forceinline__ void tr_matrix(const Frame& F, const float* W, int K, int N, bf16_t* WT, int ldo, int kofs, int mode, float f8scale = 0.f, int rlo = 0, int rhi = 1 << 30) {
    LAS float* scr = (LAS float*)(F.lds + F.wave * 16384);
    const int nitems = (K >> 6) * ((N + 63) >> 6), NGW = F.G * NWAVES;
    for (int it = F.gw; it < nitems; it += NGW) tr_item(W, N, WT, ldo, kofs, mode, scr, it, F.lane, f8scale, rlo, rhi);
}
__device__ __forceinline__ void cvt_linear(const Frame& F, const float* src, bf16_t* dst, size_t n8) {
    const size_t NT = (size_t)F.G * NTHREADS;
    for (size_t i = (size_t)blockIdx.x * NTHREADS + F.tid; i < n8; i += NT) { const f32x4 a = *(const f32x4*)(src + i * 8), b = *(const f32x4*)(src + i * 8 + 4); *(u32x4*)(dst + i * 8) = pg8::pack8(a, b); }
}
__device__ __forceinline__ void cvt_linear8(const Frame& F, const float* src, unsigned char* dst, size_t n8) {
    const size_t NT = (size_t)F.G * NTHREADS;
    for (size_t i = (size_t)blockIdx.x * NTHREADS + F.tid; i < n8; i += NT) { const f32x4 a = *(const f32x4*)(src + i * 8), b = *(const f32x4*)(src + i * 8 + 4); *(u32x2*)(dst + i * 8) = pg8::pack8_fp8(a, b, 1.0f); }
}
__device__ __forceinline__ void sincos_d(double ang, float& c, float& s) {
    const double n = __builtin_rint(ang * 0.6366197723675814);
    double r = __builtin_fma(-n, 1.5707963267948966, ang); r = __builtin_fma(-n, 6.123233995736766e-17, r);
    const double r2 = r * r;
    const double sp = r * (1.0 + r2 * (-1.0 / 6.0 + r2 * (1.0 / 120.0 + r2 * (-1.0 / 5040.0 + r2 * (1.0 / 362880.0 + r2 * (-1.0 / 39916800.0 + r2 * (1.0 / 6227020800.0)))))));
    const double cp = 1.0 + r2 * (-0.5 + r2 * (1.0 / 24.0 + r2 * (-1.0 / 720.0 + r2 * (1.0 / 40320.0 + r2 * (-1.0 / 3628800.0 + r2 * (1.0 / 479001600.0 + r2 * (-1.0 / 87178291200.0)))))));
    const int q = (int)((long long)n & 3);
    const float sf = (float)sp, cf = (float)cp;
    c = q == 0 ? cf : (q == 1 ? -sf : (q == 2 ? -cf : sf));
    s = q == 0 ? sf : (q == 1 ? cf : (q == 2 ? -sf : -cf));
}
__device__ __forceinline__ void rope_tables(const Frame& F, const int* pos, float* tab64, float* tab32) {
    const int NT = F.G * NTHREADS;
    for (int i = blockIdx.x * NTHREADS + F.tid; i < T * 48; i += NT) {
        const int t = i / 48, f = i - t * 48; const bool is64 = f < 32; const int fi = is64 ? f : f - 32;
        const double base = is64 ? 0.7498942093324559 : 0.5623413251903491;
        double inv = 1.0; for (int k = 0; k < fi; ++k) inv *= base;
        float c, s; sincos_d((double)pos[t] * inv, c, s);
        float* o = is64 ? tab64 + ((size_t)t * 32 + fi) * 2 : tab32 + ((size_t)t * 16 + fi) * 2; o[0] = c; o[1] = s;
    }
}

constexpr int MOE_CONV_ITEMS = 8 * 3 * 3584;
constexpr int TOPK_CONV = 11;
__device__ __forceinline__ void moe_conv_item(const float* w1, const float* w3, const float* w2, unsigned char* ws, LAS float* scr, int it, int lane) {
    const int e = it / (3 * 3584), r = it - e * (3 * 3584), mtx = r / 3584, sub = r - mtx * 3584;
    if (mtx < 2) tr_item((mtx == 0 ? w1 : w3) + (size_t)e * DM * MFFN, MFFN, (bf16_t*)(ws + WS_MW13 + (size_t)e * 2 * MFFN * DM), DM, 0, 2 + mtx, scr, sub, lane, W13_F8SCALE);
    else tr_item(w2 + (size_t)e * MFFN * DM, DM, (bf16_t*)(ws + WS_MW2 + (size_t)e * DM * MFFN), MFFN, 0, 0, scr, sub, lane, W2_F8SCALE);
}

__device__ __forceinline__ unsigned ln_col(int lane, int q) { return 8u * (unsigned)(lane & 63) + 512u * (unsigned)(q >> 1) + 4u * (unsigned)(q & 1); }
__device__ __forceinline__ void ln_load16(f32x4 (&v)[8], const bf16_t* row, int lane) {
#pragma unroll
    for (int j = 0; j < 4; ++j) pg8::unpack8(*(const u32x4*)(row + ln_col(lane, 2 * j)), v[2 * j], v[2 * j + 1]);
}
__device__ __forceinline__ void ln_store16(const f32x4 (&v)[8], bf16_t* row, int lane) {
#pragma unroll
    for (int j = 0; j < 4; ++j) *(u32x4*)(row + ln_col(lane, 2 * j)) = pg8::pack8(v[2 * j], v[2 * j + 1]);
}
__device__ __forceinline__ void ln_store8(const f32x4 (&v)[8], unsigned char* row, int lane) {
#pragma unroll
    for (int j = 0; j < 4; ++j) *(u32x2*)(row + ln_col(lane, 2 * j)) = pg8::pack8_fp8(v[2 * j], v[2 * j + 1], 1.0f);
}
__device__ __forceinline__ void ln_core(f32x4 (&v)[8], const float* g, const float* bb, int lane) {
    float s = 0.f;
#pragma unroll
    for (int j = 0; j < 8; ++j) s += (v[j][0] + v[j][1]) + (v[j][2] + v[j][3]);
    const float mean = wave_sum(s) * (1.0f / DM); float s2 = 0.f;
#pragma unroll
    for (int j = 0; j < 8; ++j) { v[j] = v[j] - mean; s2 += (v[j][0] * v[j][0] + v[j][1] * v[j][1]) + (v[j][2] * v[j][2] + v[j][3] * v[j][3]); }
    const float rstd = 1.0f / sqrtf(wave_sum(s2) * (1.0f / DM) + LN_EPS);
    int l2 = lane; asm volatile("" : "+v"(l2) :: "memory");
#pragma unroll
    for (int j = 0; j < 8; ++j) { const f32x4 gv = *(const f32x4*)(g + ln_col(l2, j)), bv = *(const f32x4*)(bb + ln_col(l2, j)); v[j] = v[j] * rstd * gv + bv; }
}
template <bool OUT8> __device__ __forceinline__ void ln_phase(const Frame& F, const bf16_t* YH, bf16_t* X16, unsigned char* X8, const float* g, const float* bb) {
    const int NGW = F.G * NWAVES;
    for (int m = F.gw; m < T; m += NGW) { f32x4 v[8];
        ln_load16(v, YH + (size_t)m * DM, F.lane); ln_core(v, g, bb, F.lane); ln_store16(v, X16 + (size_t)m * DM, F.lane);
        if constexpr (OUT8) ln_store8(v, X8 + (size_t)m * DM, F.lane); }
}

__device__ __forceinline__ int crow(int r, int hi) { return (r & 3) + 8 * (r >> 2) + 4 * hi; }
template <bool OUT8> __device__ __forceinline__ void swa_phase(const Frame& F, bf16_t* Q, const bf16_t* Kb, const bf16_t* VT, const float* sinks, unsigned char* O8) {
    const int lane = F.lane, l31 = lane & 31, hf = lane >> 5;
    for (int wi = blockIdx.x; wi < 4096; wi += F.G) {
        const int kvh = wi & 3, qsi = (wi >> 2) & 511, b = wi >> 11, h = kvh * 8 + F.wave, q0 = qsi * 32;
        const size_t row0 = (size_t)b * SEQ + q0;
        bf16x8 qf[4];
#pragma unroll
        for (int kk = 0; kk < 4; ++kk) { if constexpr (SWA_FRAG) qf[kk] = *(const bf16x8*)(Q + ((((size_t)(b * 32 + h) * 512 + qsi) * 4 + kk) * 64 + lane) * 8);
            else qf[kk] = *(const bf16x8*)(Q + (row0 + l31) * 2048 + h * 64 + 16 * kk + 8 * hf); }
        f32x16 sc[5];
#pragma unroll
        for (int kt = 0; kt < 5; ++kt) {
            int kpos = q0 - 128 + 32 * kt + l31; kpos = kpos < 0 ? 0 : kpos;
            const bf16_t* kp = Kb + ((size_t)b * SEQ + kpos) * 256 + kvh * 64 + 8 * hf;
            f32x16 a;
#pragma unroll
            for (int r = 0; r < 16; ++r) a[r] = 0.f;
            const int kblk = qsi - 4 + kt < 0 ? 0 : qsi - 4 + kt;
#pragma unroll
            for (int kk = 0; kk < 4; ++kk) { bf16x8 kf; if constexpr (SWA_FRAG) kf = *(const bf16x8*)(Kb + ((((size_t)(b * 4 + kvh) * 512 + kblk) * 4 + kk) * 64 + lane) * 8); else kf = *(const bf16x8*)(kp + 16 * kk);
                a = __builtin_amdgcn_mfma_f32_32x32x16_bf16(kf, qf[kk], a, 0, 0, 0); }
            sc[kt] = a;
        }
        const float sink2 = sinks[h] * LOG2E; const int qpos = q0 + l31;
        float mx = sink2;
#pragma unroll
        for (int kt = 0; kt < 5; ++kt)
#pragma unroll
            for (int r = 0; r < 16; ++r) { const int kpos = q0 - 128 + 32 * kt + crow(r, hf); const bool ok = kpos >= 0 && kpos <= qpos && (qpos - kpos) < 128;
                const float v = ok ? sc[kt][r] : -INFINITY; sc[kt][r] = v; mx = fmaxf(mx, v); }
        mx = fmaxf(mx, shx(mx, 32, lane));
        float sum = 0.f;
#pragma unroll
        for (int kt = 0; kt < 5; ++kt)
#pragma unroll
            for (int r = 0; r < 16; ++r) { const float p = __builtin_amdgcn_exp2f(sc[kt][r] - mx); sc[kt][r] = p; sum += p; }
        sum += shx(sum, 32, lane);
        const float inv = 1.0f / (sum + __builtin_amdgcn_exp2f(sink2 - mx));
        f32x16 o[2];
#pragma unroll
        for (int r = 0; r < 16; ++r) { o[0][r] = 0.f; o[1][r] = 0.f; }
#pragma unroll
        for (int kt = 0; kt < 5; ++kt)
#pragma unroll
            for (int c = 0; c < 2; ++c) {
                bf16x8 pb; { u32x4 w; w.x = cvt_pk_bf16(sc[kt][8 * c + 0], sc[kt][8 * c + 1]); w.y = cvt_pk_bf16(sc[kt][8 * c + 2], sc[kt][8 * c + 3]); w.z = cvt_pk_bf16(sc[kt][8 * c + 4], sc[kt][8 * c + 5]); w.w = cvt_pk_bf16(sc[kt][8 * c + 6], sc[kt][8 * c + 7]); pb = __builtin_bit_cast(bf16x8, w); }
                int kb = q0 - 128 + 32 * kt + 16 * c + 4 * hf; int kb0 = kb < 0 ? 0 : kb, kb1 = kb + 8 < 0 ? 0 : kb + 8;
#pragma unroll
                for (int mt = 0; mt < 2; ++mt) { bf16x8 va;
                    if constexpr (SWA_FRAG) { const int vblk = qsi - 4 + kt < 0 ? 0 : qsi - 4 + kt; va = *(const bf16x8*)(VT + (((((size_t)(b * 4 + kvh) * 512 + vblk) * 2 + c) * 2 + mt) * 64 + lane) * 8); }
                    else { const bf16_t* vp = VT + ((size_t)(b * 4 + kvh) * 64 + 32 * mt + l31) * SEQ;
                    const u32x2 v0 = *(const u32x2*)(vp + kb0), v1 = *(const u32x2*)(vp + kb1); u32x4 w; w.x = v0.x; w.y = v0.y; w.z = v1.x; w.w = v1.y; va = __builtin_bit_cast(bf16x8, w); }
                    o[mt] = __builtin_amdgcn_mfma_f32_32x32x16_bf16(va, pb, o[mt], 0, 0, 0); }
            }
        bf16_t* op = Q + (row0 + l31) * 2048 + h * 64; unsigned char* op8 = O8 + (row0 + l31) * 2048 + h * 64; const float inv8 = inv * O0_F8SCALE;
#pragma unroll
        for (int mt = 0; mt < 2; ++mt)
#pragma unroll
            for (int r4 = 0; r4 < 4; ++r4) {
                if constexpr (OUT8) *(unsigned*)(op8 + 32 * mt + 8 * r4 + 4 * hf) = pk4_fp8(o[mt][4 * r4] * inv8, o[mt][4 * r4 + 1] * inv8, o[mt][4 * r4 + 2] * inv8, o[mt][4 * r4 + 3] * inv8);
                else { u32x2 w; w.x = cvt_pk_bf16(o[mt][4 * r4] * inv, o[mt][4 * r4 + 1] * inv); w.y = cvt_pk_bf16(o[mt][4 * r4 + 2] * inv, o[mt][4 * r4 + 3] * inv);
                *(u32x2*)(op + 32 * mt + 8 * r4 + 4 * hf) = w; } }
    }
}

__device__ __forceinline__ void kvnorm_phase(const Frame& F, const float* CRAW, const float* gk, bf16_t* KV) {
    const int NGW = F.G * NWAVES;
    for (int m = F.gw; m < T; m += NGW) { const float* cr = CRAW + (size_t)m * 512;
        const f32x4 a = *(const f32x4*)(cr + 4 * F.lane), b = *(const f32x4*)(cr + 256 + 4 * F.lane);
        float s = (a[0] * a[0] + a[1] * a[1]) + (a[2] * a[2] + a[3] * a[3]) + (b[0] * b[0] + b[1] * b[1]) + (b[2] * b[2] + b[3] * b[3]);
        const float r = 1.0f / sqrtf(wave_sum(s) * (1.0f / 512.0f) + RMS_EPS);
        const f32x4 ga = *(const f32x4*)(gk + 4 * F.lane), gb = *(const f32x4*)(gk + 256 + 4 * F.lane);
        if constexpr (F8_KV) { const float r8 = r * KV_F8SCALE; unsigned char* kp = (unsigned char*)KV + (size_t)m * 576 + 4 * F.lane;
            *(unsigned*)kp = pk4_fp8(a[0] * r8 * ga[0], a[1] * r8 * ga[1], a[2] * r8 * ga[2], a[3] * r8 * ga[3]);
            *(unsigned*)(kp + 256) = pk4_fp8(b[0] * r8 * gb[0], b[1] * r8 * gb[1], b[2] * r8 * gb[2], b[3] * r8 * gb[3]); continue; }
        u32x2 w0, w1; w0.x = cvt_pk_bf16(a[0] * r * ga[0], a[1] * r * ga[1]); w0.y = cvt_pk_bf16(a[2] * r * ga[2], a[3] * r * ga[3]);
        w1.x = cvt_pk_bf16(b[0] * r * gb[0], b[1] * r * gb[1]); w1.y = cvt_pk_bf16(b[2] * r * gb[2], b[3] * r * gb[3]);
        *(u32x2*)(KV + (size_t)m * 576 + 4 * F.lane) = w0; *(u32x2*)(KV + (size_t)m * 576 + 256 + 4 * F.lane) = w1; }
}

__device__ __forceinline__ float relu1(float a) { return __builtin_amdgcn_fmed3f(a, 0.f, 3.0e38f); }
__device__ __forceinline__ unsigned f2key(float f) { const unsigned u = __float_as_uint(f); return u ^ ((unsigned)((int)u >> 31) | 0x80000000u); }
__device__ __forceinline__ float key2f(unsigned k) { const unsigned u = (k & 0x80000000u) ? (k ^ 0x80000000u) : ~k; return __uint_as_float(u); }
__device__ __forceinline__ unsigned compact256(LAS u64* buf, int n, int lane) {
    u64 e[8];
#pragma unroll
    for (int i = 0; i < 8; ++i) e[i] = (lane + 64 * i < n) ? buf[lane + 64 * i] : 0ull;
    unsigned thr = 0u;
    for (int bit = 31; bit >= 0; --bit) {
        const unsigned cand = thr | (1u << bit); int c = 0;
#pragma unroll
        for (int i = 0; i < 8; ++i) c += __popcll(__ballot((unsigned)(e[i] >> 32) >= cand));
        if (c >= 256) thr = cand;
    }
    int ngt = 0;
#pragma unroll
    for (int i = 0; i < 8; ++i) ngt += __popcll(__ballot((unsigned)(e[i] >> 32) > thr));
    int pos_gt = 0, pos_eq = ngt;
#pragma unroll
    for (int i = 0; i < 8; ++i) { const unsigned k = (unsigned)(e[i] >> 32); const bool gt = k > thr, eq = k == thr; const u64 mg = __ballot(gt), me = __ballot(eq);
        if (gt) buf[pos_gt + mbcnt64(mg)] = e[i];
        const int re = pos_eq + mbcnt64(me); if (eq && re < 256) buf[re] = e[i];
        pos_gt += __popcll(mg); pos_eq += __popcll(me); }
    return thr;
}
__device__ __forceinline__ unsigned compact_bound(LAS u64* buf, int n, int lane, unsigned lo, int& n_out) {
    u64 e[8]; unsigned mx = 0u;
#pragma unroll
    for (int i = 0; i < 8; ++i) { e[i] = (lane + 64 * i < n) ? buf[lane + 64 * i] : 0ull; const unsigned k = (unsigned)(e[i] >> 32); mx = k > mx ? k : mx; }
#pragma unroll
    for (int o = 1; o < 64; o <<= 1) { const unsigned t = (unsigned)__builtin_amdgcn_ds_bpermute((lane ^ o) << 2, (int)mx); mx = t > mx ? t : mx; }
    mx = (unsigned)__builtin_amdgcn_readfirstlane((int)mx);
    const unsigned diff = mx ^ lo; const int hb = diff ? 31 - __builtin_clz(diff) : 0;
    unsigned thr = hb >= 31 ? 0u : (lo & ~((2u << hb) - 1u)); int cge = n;
    for (int bit = hb; bit >= 0; --bit) {
        const unsigned cand = thr | (1u << bit); int c = 0;
#pragma unroll
        for (int i = 0; i < 8; ++i) c += __popcll(__ballot((unsigned)(e[i] >> 32) >= cand));
        if (c >= 256) { thr = cand; cge = c; if (c <= 288) break; }
    }
    int pos = 0;
#pragma unroll
    for (int i = 0; i < 8; ++i) { const bool ge = (unsigned)(e[i] >> 32) >= thr && (lane + 64 * i < n); const u64 mg = __ballot(ge);
        if (ge) buf[pos + mbcnt64(mg)] = e[i];
        pos += __popcll(mg); }
    n_out = pos;
    return thr;
}
template <bool CONV = false> __device__ __forceinline__ void topk_phase(const Frame& F, const bf16_t* QI, const bf16_t* KIF, const float* WI, unsigned short* SEL) {
    const int lane = F.lane, l31 = lane & 31, hf = lane >> 5, wave = F.wave;
    LAS u64* mybuf = (LAS u64*)F.lds + (size_t)(wave * 4) * 512;
    const unsigned lmask_lt = (1u << l31) - 1u; const int hfm = -hf;
    for (int pu = blockIdx.x; pu < 512; pu += F.G) {
        const int b = pu >> 8, pi = pu & 255;
        for (int half = 0; half < 2; ++half) {
            const int tq = half == 0 ? pi : 511 - pi, q0 = tq * 32, nsteps = tq + 1;
            const size_t trow0 = (size_t)b * SEQ + q0 + 4 * wave;
            bf16x8 aq[2][4]; float wq[2][16];
#pragma unroll
            for (int s = 0; s < 2; ++s) {
                const int qq = 2 * s + ((l31 >> 2) & 1), hd = 4 * (l31 >> 3) + (l31 & 3);
#pragma unroll
                for (int kk = 0; kk < 4; ++kk) aq[s][kk] = *(const bf16x8*)(QI + ((trow0 + qq) * 16 + hd) * 64 + 16 * kk + 8 * hf);
                const float* wp = WI + (trow0 + 2 * s + hf) * 16;
#pragma unroll
                for (int r4 = 0; r4 < 4; ++r4) { const f32x4 w = *(const f32x4*)(wp + 4 * r4); wq[s][4 * r4] = w[0]; wq[s][4 * r4 + 1] = w[1]; wq[s][4 * r4 + 2] = w[2]; wq[s][4 * r4 + 3] = w[3]; }
            }
            float psc0 = 0.f, psc1 = 0.f; int pix0 = 0, pix1 = 0; bool pv0 = false, pv1 = false;
            float thr0 = -INFINITY, thr1 = -INFINITY; int c0 = 0, c1 = 0, c2 = 0, c3 = 0; unsigned b0 = 0x007fffffu, b1 = 0x007fffffu, b2 = 0x007fffffu, b3 = 0x007fffffu;
            const bf16_t* kbase = KIF + (size_t)b * 512 * 4 * 64 * 8 + (size_t)lane * 8;
            bf16x8 k0[4], k1[4], k2[4], k3[4];
#pragma unroll
            for (int kk = 0; kk < 4; ++kk) { k0[kk] = *(const bf16x8*)(kbase + (size_t)(0 * 4 + kk) * 512); k1[kk] = *(const bf16x8*)(kbase + (size_t)((nsteps > 1 ? 1 : 0) * 4 + kk) * 512);
                k2[kk] = *(const bf16x8*)(kbase + (size_t)((nsteps > 2 ? 2 : nsteps - 1) * 4 + kk) * 512); k3[kk] = *(const bf16x8*)(kbase + (size_t)((nsteps > 3 ? 3 : nsteps - 1) * 4 + kk) * 512); }
#define TOPK_STEP(KB, STEP) { const int kidx = 32 * (STEP) + l31; \
    f32x16 a0_, a1_; _Pragma("unroll") for (int r = 0; r < 16; ++r) { a0_[r] = 0.f; a1_[r] = 0.f; } \
    _Pragma("unroll") for (int kk = 0; kk < 4; ++kk) a0_ = __builtin_amdgcn_mfma_f32_32x32x16_bf16(aq[0][kk], KB[kk], a0_, 0, 0, 0); \
    _Pragma("unroll") for (int kk = 0; kk < 4; ++kk) a1_ = __builtin_amdgcn_mfma_f32_32x32x16_bf16(aq[1][kk], KB[kk], a1_, 0, 0, 0); \
    { const int sn_ = (STEP) + 4 < nsteps ? (STEP) + 4 : nsteps - 1; _Pragma("unroll") for (int kk = 0; kk < 4; ++kk) KB[kk] = *(const bf16x8*)(kbase + (size_t)(sn_ * 4 + kk) * 512); }     \
    float sc0_ = 0.f, sc1_ = 0.f; \
    _Pragma("unroll") for (int r = 0; r < 16; ++r) sc0_ = fmaf(wq[0][r], relu1(a0_[r]), sc0_); \
    _Pragma("unroll") for (int r = 0; r < 16; ++r) sc1_ = fmaf(wq[1][r], relu1(a1_[r]), sc1_); \
    const int tql0_ = q0 + 4 * wave + hf; \
    const bool pass0_ = (sc0_ > thr0) && (kidx <= tql0_), pass1_ = (sc1_ > thr1) && (kidx <= tql0_ + 2); \
      \
    if (__ballot((pass0_ && pv0) || (pass1_ && pv1))) { TOPK_FLUSH(); } \
    psc0 = pass0_ ? sc0_ : psc0; pix0 = pass0_ ? kidx : pix0; pv0 = pv0 || pass0_; \
    psc1 = pass1_ ? sc1_ : psc1; pix1 = pass1_ ? kidx : pix1; pv1 = pv1 || pass1_; }
#define TOPK_FLUSH() { const u64 mask0_ = __ballot(pv0), mask1_ = __ballot(pv1); \
        if (mask0_) { const unsigned lo = (unsigned)mask0_, hi = (unsigned)(mask0_ >> 32); const int plo = __popc(lo), phi = __popc(hi); \
          const int rank = mbcnt64(mask0_) - (plo & hfm); const int cm = c0 + ((c1 - c0) & hfm); \
          if (pv0) mybuf[hf * 512 + cm + rank] = ((u64)f2key(psc0) << 32) | (unsigned)pix0; c0 += plo; c1 += phi; } \
        if (mask1_) { const unsigned lo = (unsigned)mask1_, hi = (unsigned)(mask1_ >> 32); const int plo = __popc(lo), phi = __popc(hi); \
          const int rank = mbcnt64(mask1_) - (plo & hfm); const int cm = c2 + ((c3 - c2) & hfm); \
          if (pv1) mybuf[(2 + hf) * 512 + cm + rank] = ((u64)f2key(psc1) << 32) | (unsigned)pix1; c2 += plo; c3 += phi; } \
        pv0 = false; pv1 = false; \
        const int cmx_ = max(max(c0, c1), max(c2, c3)); \
        if (cmx_ > 480) { \
        if (c0 > 480) { b0 = compact_bound(mybuf, c0, lane, b0, c0); const float nt = key2f(b0); thr0 = hf == 0 ? nt : thr0; } \
        if (c1 > 480) { b1 = compact_bound(mybuf + 512, c1, lane, b1, c1); const float nt = key2f(b1); thr0 = hf == 1 ? nt : thr0; } \
        if (c2 > 480) { b2 = compact_bound(mybuf + 1024, c2, lane, b2, c2); const float nt = key2f(b2); thr1 = hf == 0 ? nt : thr1; } \
        if (c3 > 480) { b3 = compact_bound(mybuf + 1536, c3, lane, b3, c3); const float nt = key2f(b3); thr1 = hf == 1 ? nt : thr1; } } }
            for (int st = 0; st < nsteps; st += 4) {
                TOPK_STEP(k0, st);
                if (st + 1 < nsteps) TOPK_STEP(k1, st + 1);
                if (st + 2 < nsteps) TOPK_STEP(k2, st + 2);
                if (st + 3 < nsteps) TOPK_STEP(k3, st + 3);
            }
            TOPK_FLUSH();
#undef TOPK_STEP
#undef TOPK_FLUSH
#pragma unroll
            for (int qi = 0; qi < 4; ++qi) {
                int c = qi == 0 ? c0 : (qi == 1 ? c1 : (qi == 2 ? c2 : c3)); LAS u64* bq = mybuf + qi * 512;
                if (c > 256) { (void)compact256(bq, c, lane); c = 256; }
                LDS_WAIT();
                unsigned short v[4];
#pragma unroll
                for (int j = 0; j < 4; ++j) { const int e = 4 * lane + j; v[j] = e < c ? (unsigned short)(bq[e] & 0xffffull) : (unsigned short)0xffff; }
                u32x2 w; w.x = (unsigned)v[0] | ((unsigned)v[1] << 16); w.y = (unsigned)v[2] | ((unsigned)v[3] << 16);
                *(u32x2*)(SEL + (trow0 + qi) * 256 + 4 * lane) = w;
            }
            LDS_WAIT();
            if constexpr (CONV) { int lane2 = F.lane; asm volatile("" : "+v"(lane2)); const int NGW = F.G * NWAVES, iter = 2 * ((pu - (int)blockIdx.x) / F.G) + half;
                typedef const unsigned char __attribute__((address_space(4))) kab_t;
                kab_t* ka = (kab_t*)__builtin_amdgcn_kernarg_segment_ptr();
                const float* w1 = *(const float* const __attribute__((address_space(4)))*)(ka + 15 * 8); const float* w3 = *(const float* const __attribute__((address_space(4)))*)(ka + 16 * 8);
                const float* w2 = *(const float* const __attribute__((address_space(4)))*)(ka + 17 * 8); unsigned char* ws = *(unsigned char* const __attribute__((address_space(4)))*)(ka + 23 * 8);
                for (int k = 0; k < TOPK_CONV; ++k) { const int it = F.gw + NGW * (TOPK_CONV * iter + k); if (it < MOE_CONV_ITEMS) moe_conv_item(w1, w3, w2, ws, (LAS float*)mybuf, it, lane2); } }
        }
    }
}

__device__ __forceinline__ bf16x4 tr_read16(const LAS unsigned char* p) { return __builtin_bit_cast(bf16x4, __builtin_amdgcn_ds_read_tr16_b64_v4i16((LAS bf16x4*)p)); }
__device__ __forceinline__ void dsa_attn_phase(const Frame& F, const bf16_t* QLAT, bf16_t* OUT, const bf16_t* QR, const bf16_t* KV, const unsigned short* SEL, const float* w1, const float* w3, const float* w2, unsigned char* ws) {
    LAS unsigned char* wb = F.lds + F.wave * DSA_WBUF; LAS unsigned char* tails = wb + 16640;
    const unsigned char* KVb = (const unsigned char*)KV;
    const int NGW = F.G * NWAVES;
    for (int tg = F.gw; tg < T; tg += NGW) {
        int lane = F.lane; asm volatile("" : "+v"(lane));
        const int l15 = lane & 15, g = lane >> 4;
        const int b = tg >> 14, t = tg & (SEQ - 1); const int nvalid = t + 1 < 256 ? t + 1 : 256, nsteps = (nvalid + 15) >> 4;
        bf16x8 qf[18];
#pragma unroll
        for (int kk = 0; kk < 16; ++kk) {
            if constexpr (F8_LAT) { const u32x2 w8 = *(const u32x2*)((const unsigned char*)QLAT + ((size_t)tg * 16 + l15) * 512 + 32 * kk + 8 * g);
                const f32x2 f0 = __builtin_amdgcn_cvt_pk_f32_fp8((int)w8.x, false), f1 = __builtin_amdgcn_cvt_pk_f32_fp8((int)w8.x, true), f2 = __builtin_amdgcn_cvt_pk_f32_fp8((int)w8.y, false), f3 = __builtin_amdgcn_cvt_pk_f32_fp8((int)w8.y, true);
                u32x4 wb16; wb16.x = cvt_pk_bf16(f0[0], f0[1]); wb16.y = cvt_pk_bf16(f1[0], f1[1]); wb16.z = cvt_pk_bf16(f2[0], f2[1]); wb16.w = cvt_pk_bf16(f3[0], f3[1]); qf[kk] = __builtin_bit_cast(bf16x8, wb16); }
            else qf[kk] = *(const bf16x8*)(QLAT + ((size_t)tg * 16 + l15) * 512 + 32 * kk + 8 * g); }
#pragma unroll
        for (int kk = 0; kk < 2; ++kk) qf[16 + kk] = *(const bf16x8*)(QR + ((size_t)tg * 16 + l15) * 64 + 32 * kk + 8 * g);
        float m = -INFINITY, lsum = 0.f; f32x4 O[32];
#pragma unroll
        for (int mt = 0; mt < 32; ++mt) O[mt] = (f32x4){0.f, 0.f, 0.f, 0.f};
        for (int st = 0; st < nsteps; ++st) {
            const int slot = 16 * st + l15;
            int idx = slot < nvalid ? (int)SEL[(size_t)tg * 256 + slot] : 0; idx = idx > t ? 0 : idx;
            const int row = b * SEQ + idx;
            LDS_WAIT();
#pragma unroll
            for (int r = 0; r < 16; ++r) { const int rr = __builtin_amdgcn_readlane(row, r); glds16(KVb + (size_t)rr * 1152 + 16 * lane, wb + r * 1040); }
#pragma unroll
            for (int p = 0; p < 2; ++p) glds16(KVb + (size_t)row * 1152 + 1024 + 16 * (4 * p + g), tails + 1024 * p);
            VM_WAIT();
            f32x4 sacc = (f32x4){0.f, 0.f, 0.f, 0.f};
#pragma unroll
            for (int kk = 0; kk < 16; ++kk) { const bf16x8 a = *(const LAS bf16x8*)(wb + l15 * 1040 + (4 * kk + g) * 16); sacc = __builtin_amdgcn_mfma_f32_16x16x32_bf16(a, qf[kk], sacc, 0, 0, 0); }
#pragma unroll
            for (int kk = 0; kk < 2; ++kk) { const bf16x8 a = *(const LAS bf16x8*)(tails + (4 * kk + g) * 256 + l15 * 16); sacc = __builtin_amdgcn_mfma_f32_16x16x32_bf16(a, qf[16 + kk], sacc, 0, 0, 0); }
            float s[4]; float tmax = -INFINITY;
#pragma unroll
            for (int i = 0; i < 4; ++i) { s[i] = (16 * st + 4 * g + i) < nvalid ? sacc[i] * (F8_LAT ? SCALE2_MLA / QLAT_F8SCALE : SCALE2_MLA) : -INFINITY; tmax = fmaxf(tmax, s[i]); }
            tmax = fmaxf(tmax, shx(tmax, 16, lane)); tmax = fmaxf(tmax, shx(tmax, 32, lane));
            const float mnew = fmaxf(m, tmax); const float alpha = __builtin_amdgcn_exp2f(m - mnew); m = mnew;
            float p[4];
#pragma unroll
            for (int i = 0; i < 4; ++i) p[i] = __builtin_amdgcn_exp2f(s[i] - mnew);
            lsum = lsum * alpha + ((p[0] + p[1]) + (p[2] + p[3]));
            if (__any(alpha != 1.0f)) {
#pragma unroll
                for (int mt = 0; mt < 32; ++mt) O[mt] = O[mt] * alpha;
            }
            u32x2 pw; pw.x = cvt_pk_bf16(p[0], p[1]); pw.y = cvt_pk_bf16(p[2], p[3]); const bf16x4 pb = __builtin_bit_cast(bf16x4, pw);
            const LAS unsigned char* trb = wb + (4 * g + (l15 >> 2)) * 1040 + (lane & 3) * 8;
#pragma unroll
            for (int mt = 0; mt < 32; ++mt) { const bf16x4 a = tr_read16(trb + mt * 32); O[mt] = __builtin_amdgcn_mfma_f32_16x16x16bf16_1k(a, pb, O[mt], 0, 0, 0); }
        }
        float lt = lsum + shx(lsum, 16, lane); lt += shx(lt, 32, lane); const float inv = 1.0f / lt;
        if constexpr (F8_LAT) { unsigned char* op8 = (unsigned char*)OUT + ((size_t)tg * 16 + l15) * 512 + 4 * g; const float inv8 = inv * OLAT_F8SCALE;
#pragma unroll
            for (int mt = 0; mt < 32; ++mt) *(unsigned*)(op8 + 16 * mt) = pk4_fp8(O[mt][0] * inv8, O[mt][1] * inv8, O[mt][2] * inv8, O[mt][3] * inv8); }
        else { bf16_t* op = OUT + ((size_t)tg * 16 + l15) * 512 + 4 * g;
#pragma unroll
        for (int mt = 0; mt < 32; ++mt) { u32x2 w; w.x = cvt_pk_bf16(O[mt][0] * inv, O[mt][1] * inv); w.y = cvt_pk_bf16(O[mt][2] * inv, O[mt][3] * inv); *(u32x2*)(op + 16 * mt) = w; } }
        if (w1) { LDS_WAIT(); int lane2 = F.lane; asm volatile("" : "+v"(lane2));
            for (int k = 0; k < 3; ++k) { const int it = F.gw + NGW * (3 * ((tg - F.gw) / NGW) + k); if (it < MOE_CONV_ITEMS) moe_conv_item(w1, w3, w2, ws, (LAS float*)wb, it, lane2); } }
    }
    LDS_WAIT();
}

__device__ __forceinline__ long tr_read8(const LAS unsigned char* p) { return __builtin_bit_cast(long, __builtin_amdgcn_ds_read_tr8_b64_v2i32((LAS i32x2*)p)); }
__device__ __forceinline__ void dsa_attn8_phase(const Frame& F, const unsigned char* QLAT, unsigned char* OUT, const unsigned char* QR, const unsigned char* KVb, const unsigned short* SEL, const float* w1, const float* w3, const float* w2, unsigned char* ws) {
    LAS unsigned char* wb = F.lds + F.wave * DSA_WBUF; LAS unsigned char* tails = wb + 16640;
    const int NGW = F.G * NWAVES;
    for (int tg = F.gw; tg < T; tg += NGW) {
        int lane = F.lane; asm volatile("" : "+v"(lane));
        const int l15 = lane & 15, g = lane >> 4;
        const int b = tg >> 14, t = tg & (SEQ - 1); const int nvalid = t + 1 < 256 ? t + 1 : 256, nsteps = (nvalid + 31) >> 5;
        i32x8 qf[5];
        { const unsigned char* qp = QLAT + ((size_t)tg * 16 + l15) * 512 + 32 * g;
#pragma unroll
          for (int kk = 0; kk < 4; ++kk) { const i32x4 lo = *(const i32x4*)(qp + 128 * kk), hi = *(const i32x4*)(qp + 128 * kk + 16); qf[kk] = (i32x8){lo[0], lo[1], lo[2], lo[3], hi[0], hi[1], hi[2], hi[3]}; }
          const i32x4 r = *(const i32x4*)(QR + ((size_t)tg * 16 + l15) * 64 + 16 * g); qf[4] = (i32x8){r[0], r[1], r[2], r[3], 0, 0, 0, 0}; }
        float m = -INFINITY, lsum = 0.f; f32x4 O[32];
#pragma unroll
        for (int mt = 0; mt < 32; ++mt) O[mt] = (f32x4){0.f, 0.f, 0.f, 0.f};
        const int dtau = (lane >> 2) & 1, dch = 16 * (4 * (lane >> 3) + (lane & 3));
        for (int st = 0; st < nsteps; ++st) {
            const int slot = 32 * st + (lane & 31);
            int idx = slot < nvalid ? (int)SEL[(size_t)tg * 256 + slot] : 0; idx = idx > t ? 0 : idx;
            const int row = b * SEQ + idx;
            LDS_WAIT();
#pragma unroll
            for (int p = 0; p < 16; ++p) { const int r0 = __builtin_amdgcn_readlane(row, p), r1 = __builtin_amdgcn_readlane(row, 16 + p); const int rr = dtau ? r1 : r0;
                glds16(KVb + (size_t)rr * 576 + dch, wb + p * 1040); }
#pragma unroll
            for (int p = 0; p < 2; ++p) glds16(KVb + (size_t)row * 576 + 512 + 16 * (2 * p + (lane >> 5)), tails + 1024 * p);
            VM_WAIT();
            f32x4 sacc[2] = {(f32x4){0.f, 0.f, 0.f, 0.f}, (f32x4){0.f, 0.f, 0.f, 0.f}};
            const LAS unsigned char* sb = wb + l15 * 1040 + 16 * (8 * (g >> 1) + 2 * (g & 1));
#pragma unroll
            for (int kk = 0; kk < 4; ++kk)
#pragma unroll
                for (int tu = 0; tu < 2; ++tu) { const i32x4 lo = *(const LAS i32x4*)(sb + 256 * kk + 64 * tu), hi = *(const LAS i32x4*)(sb + 256 * kk + 64 * tu + 16);
                    const i32x8 a = (i32x8){lo[0], lo[1], lo[2], lo[3], hi[0], hi[1], hi[2], hi[3]};
                    sacc[tu] = __builtin_amdgcn_mfma_scale_f32_16x16x128_f8f6f4(a, qf[kk], sacc[tu], 0, 0, 0, 0, 0, 0); }
#pragma unroll
            for (int tu = 0; tu < 2; ++tu) { const i32x4 lo = *(const LAS i32x4*)(tails + (g * 32 + 16 * tu + l15) * 16);
                const i32x8 a = (i32x8){lo[0], lo[1], lo[2], lo[3], 0, 0, 0, 0};
                sacc[tu] = __builtin_amdgcn_mfma_scale_f32_16x16x128_f8f6f4(a, qf[4], sacc[tu], 0, 0, 0, 0, 0, 0); }
            float s[8]; float tmax = -INFINITY;
#pragma unroll
            for (int tu = 0; tu < 2; ++tu)
#pragma unroll
                for (int i = 0; i < 4; ++i) { s[4 * tu + i] = (32 * st + 16 * tu + 4 * g + i) < nvalid ? sacc[tu][i] * (SCALE2_MLA / (QLAT_F8SCALE * KV_F8SCALE)) : -INFINITY; tmax = fmaxf(tmax, s[4 * tu + i]); }
            tmax = fmaxf(tmax, shx(tmax, 16, lane)); tmax = fmaxf(tmax, shx(tmax, 32, lane));
            const float mnew = fmaxf(m, tmax); const float alpha = __builtin_amdgcn_exp2f(m - mnew); m = mnew;
            const float mo = mnew - 8.0f;
            float p[8];
#pragma unroll
            for (int i = 0; i < 8; ++i) p[i] = __builtin_amdgcn_exp2f(s[i] - mo);
            lsum = lsum * alpha + (((p[0] + p[1]) + (p[2] + p[3])) + ((p[4] + p[5]) + (p[6] + p[7])));
            if (__any(alpha != 1.0f)) {
#pragma unroll
                for (int mt = 0; mt < 32; ++mt) O[mt] = O[mt] * alpha;
            }
            u32x2 pw; pw.x = pk4_fp8(p[0], p[1], p[2], p[3]); pw.y = pk4_fp8(p[4], p[5], p[6], p[7]); const long pb = __builtin_bit_cast(long, pw);
            const LAS unsigned char* trb = wb + (4 * g + ((l15 >> 1) & 3)) * 1040 + 64 * (l15 >> 3) + 8 * (l15 & 1);
#pragma unroll
            for (int mt = 0; mt < 32; ++mt) { const long a = tr_read8(trb + 128 * (mt >> 2) + 16 * (mt & 3)); O[mt] = __builtin_amdgcn_mfma_f32_16x16x32_fp8_fp8(a, pb, O[mt], 0, 0, 0); }
        }
        float lt = lsum + shx(lsum, 16, lane); lt += shx(lt, 32, lane); const float inv8 = (OLAT_F8SCALE / KV_F8SCALE) / lt;
        unsigned char* op8 = OUT + ((size_t)tg * 16 + l15) * 512 + 4 * g;
#pragma unroll
        for (int mt = 0; mt < 32; ++mt) *(unsigned*)(op8 + 16 * mt) = pk4_fp8(O[mt][0] * inv8, O[mt][1] * inv8, O[mt][2] * inv8, O[mt][3] * inv8);
        if (w1) { LDS_WAIT(); int lane2 = F.lane; asm volatile("" : "+v"(lane2));
            for (int k = 0; k < 3; ++k) { const int it = F.gw + NGW * (3 * ((tg - F.gw) / NGW) + k); if (it < MOE_CONV_ITEMS) moe_conv_item(w1, w3, w2, ws, (LAS float*)wb, it, lane2); } }
    }
    LDS_WAIT();
}

__device__ __forceinline__ void ln_router_phase(const Frame& F, const bf16_t* YH, bf16_t* XB, const float* g, const float* bb, const float* wr, int* TOKE, float* TOKG, int* TOKL) {
    LAS float* wl = (LAS float*)F.lds;
    for (int i = F.tid; i < DM * NEXP; i += NTHREADS) { const int d = i >> 3, e = i & 7; wl[e * DM + d] = wr[i]; }
    __syncthreads();
    const int NGW = F.G * NWAVES, lane = F.lane;
    u64 cnt64 = 0ull; int mine = 0;
    int j = 0;
    for (int m = F.gw; m < T; m += NGW, ++j) { f32x4 v[8];
        ln_load16(v, YH + (size_t)m * DM, lane); ln_core(v, g, bb, lane); ln_store8(v, (unsigned char*)XB + (size_t)m * DM, lane);
        float lg[8];
#pragma unroll
        for (int e = 0; e < 8; ++e) { float s = 0.f;
#pragma unroll
            for (int q = 0; q < 8; ++q) { const f32x4 w = *(const LAS f32x4*)(wl + e * DM + ln_col(lane, q)); s += (v[q][0] * w[0] + v[q][1] * w[1]) + (v[q][2] * w[2] + v[q][3] * w[3]); }
            lg[e] = wave_sum(s); }
        int e1 = 0; float v1 = lg[0];
#pragma unroll
        for (int e = 1; e < 8; ++e) if (lg[e] > v1) { v1 = lg[e]; e1 = e; }
        int e2 = -1; float v2 = -INFINITY;
#pragma unroll
        for (int e = 0; e < 8; ++e) if (e != e1 && lg[e] > v2) { v2 = lg[e]; e2 = e; }
        const float g1 = 1.0f / (1.0f + __expf(v2 - v1)), g2 = 1.0f - g1;
        const int r1 = (int)((cnt64 >> (8 * e1)) & 0xffull); cnt64 += 1ull << (8 * e1);
        const int r2 = (int)((cnt64 >> (8 * e2)) & 0xffull); cnt64 += 1ull << (8 * e2);
        if (lane == 0) { TOKE[2 * m] = e1; TOKE[2 * m + 1] = e2; TOKG[2 * m] = g1; TOKG[2 * m + 1] = g2; }
        if (lane == j) mine = e1 | (e2 << 4) | (r1 << 8) | (r2 << 16);
    }
    int basev = 0;
    if (lane < 8) { const unsigned c = (unsigned)((cnt64 >> (8 * lane)) & 0xffull); basev = (int)__hip_atomic_fetch_add(F.ctl + CW_CNT + lane, c, __ATOMIC_RELAXED, __HIP_MEMORY_SCOPE_AGENT); }
    const int e1 = mine & 15, e2 = (mine >> 4) & 15, r1 = (mine >> 8) & 255, r2 = (mine >> 16) & 255;
    const int b1 = __builtin_amdgcn_ds_bpermute(e1 << 2, basev), b2 = __builtin_amdgcn_ds_bpermute(e2 << 2, basev);
    if (lane < j) { const int m = F.gw + NGW * lane; TOKL[2 * m] = b1 + r1; TOKL[2 * m + 1] = b2 + r2; }
    __syncthreads();
}
__device__ __forceinline__ void moe_tiles(const Frame& F) {
    if (F.tid == 0) { int acc = 0;
        for (int e = 0; e < 8; ++e) { const unsigned c = __hip_atomic_load(F.ctl + CW_CNT + e, __ATOMIC_RELAXED, __HIP_MEMORY_SCOPE_AGENT); F.MISC[32 + e] = c; F.MISC[40 + e] = (unsigned)acc; acc += (int)((c + 255u) >> 8); F.MISC[20 + e] = (unsigned)acc; }
        F.MISC[28] = (unsigned)acc; }
    __syncthreads();
}
__device__ __forceinline__ void moe_gather_phase(const Frame& F, const bf16_t* XB, const int* TOKE, const float* TOKG, const int* TOKL, int* TOKS, float* SGATE, bf16_t* XG) {
    const int NGW = F.G * NWAVES, lane = F.lane;
    for (int m = F.gw; m < T; m += NGW) {
        const u32x4* src = (const u32x4*)((const unsigned char*)XB + (size_t)m * DM);
        const u32x4 a0 = src[lane], a1 = src[64 + lane];
#pragma unroll
        for (int k = 0; k < 2; ++k) { const int e = TOKE[2 * m + k], li = TOKL[2 * m + k]; const int slot = (int)F.MISC[40 + e] * 256 + li;
            u32x4* dst = (u32x4*)((unsigned char*)XG + (size_t)slot * DM); dst[lane] = a0; dst[64 + lane] = a1;
            if (lane == 0) { TOKS[2 * m + k] = slot; SGATE[slot] = TOKG[2 * m + k]; } }
    }
    for (int it = F.gw; it < 8 * 256; it += NGW) { const int e = it >> 8, r = it & 255; const int c = (int)F.MISC[32 + e]; const int ntile = (c + 255) >> 8; const int row = c + r;
        if (row < ntile * 256) { const int slot = (int)F.MISC[40 + e] * 256 + row; u32x4* dst = (u32x4*)((unsigned char*)XG + (size_t)slot * DM); const u32x4 z = {0u, 0u, 0u, 0u};
            dst[lane] = z; dst[64 + lane] = z; if (lane == 0) SGATE[slot] = 0.f; } }
}
__device__ __forceinline__ void moe_combine_ln_phase(const Frame& F, const bf16_t* YH, bf16_t* XB, const bf16_t* SOUT, const int* TOKS, const float* g1, const float* bb1, const float* g, const float* bb) {
    const int NGW = F.G * NWAVES, lane = F.lane;
    for (int m = F.gw; m < T; m += NGW) { f32x4 v[8];
        const bf16_t* s0 = SOUT + (size_t)TOKS[2 * m] * DM; const bf16_t* s1 = SOUT + (size_t)TOKS[2 * m + 1] * DM;
        ln_load16(v, YH + (size_t)m * DM, lane);
        ln_core(v, g1, bb1, lane);
#pragma unroll
        for (int j = 0; j < 4; ++j) { f32x4 a0, a1, c0, c1; pg8::unpack8(*(const u32x4*)(s0 + ln_col(lane, 2 * j)), a0, a1); pg8::unpack8(*(const u32x4*)(s1 + ln_col(lane, 2 * j)), c0, c1);
            v[2 * j] = v[2 * j] * ALPHA + (a0 + c0); v[2 * j + 1] = v[2 * j + 1] * ALPHA + (a1 + c1); }
        ln_core(v, g, bb, lane); ln_store16(v, XB + (size_t)m * DM, lane); }
}

#ifndef PHASES
#define PHASES 0xFFFFFFFFu
#endif
#define PH(k) if constexpr ((PHASES >> (k)) & 1u)
#ifndef DBL
#define DBL 0u
#endif
#define DB(k) if constexpr ((DBL >> (k)) & 1u)
__global__ void __launch_bounds__(NTHREADS, 2) mega_fwd(Args args) {
    extern __shared__ __attribute__((aligned(16))) unsigned char lds_raw[];
    Frame F;
    F.lds = (LAS unsigned char*)lds_raw; F.MISC = (volatile LAS unsigned*)(F.lds + MISC_OFF);
    F.tid = threadIdx.x; F.lane = F.tid & 63; F.wave = __builtin_amdgcn_readfirstlane(F.tid >> 6); F.gw = blockIdx.x * NWAVES + F.wave;
    unsigned char* ws = args.ws;
    F.ctl = (unsigned*)(ws + WS_CTL);
    if (F.tid < 64) F.MISC[F.tid] = 0u;
    __syncthreads();
    XcdBarrier bar = xcd_barrier_post(F.ctl + CW_BAR, F.MISC + 8);
#define REFRESH() do { F.lane = fresh_lane(); F.tid = F.wave * 64 + F.lane; } while (0)
#define GRID_BAR() do { xcd_barrier(bar, F.wave); REFRESH(); } while (0)
#define YH ((bf16_t*)args.out)
#define bx ((int)blockIdx.x)
#define WSP(T_, off) ((T_*)(ws + (off)))

    PH(0) {
        { LAS float* scr = (LAS float*)(F.lds + F.wave * 16384);
          constexpr int I_QKV = 32 * 40, I_SQ = 32 * 32, I_W13 = 32 * 88, I_W2 = 88 * 32, I_WP = 4 * 32, I_WIN = 32 * 75, I_WUV = 256;
          constexpr int I_TOTAL = I_QKV + I_SQ + 2 * I_W13 + I_W2 + 2 * I_SQ + 2 * I_WP + (F8_WIN_SPLIT ? 2 : 1) * I_WIN + I_SQ + I_WUV;
          for (int it = F.gw; it < I_TOTAL; it += F.G * NWAVES) {
              int r = it; bool hit = false; const float* W = nullptr; int N = 0, ldo = 0, kofs = 0, mode = 0, rlo = 0, rhi = 1 << 30; unsigned char* WT = nullptr; float f8 = 0.f;
#define PSEG(cnt, Wp, Nn, WTp, ld, md, f8v, lo, hi) if (!hit) { if (r < (cnt)) { W = (Wp); N = (Nn); WT = (unsigned char*)(WTp); ldo = (ld); mode = (md); f8 = (f8v); rlo = (lo); rhi = (hi); hit = true; } else r -= (cnt); }
              PSEG(I_QKV, (const float*)args.in[3], NQKV, ws + WS_WQKV, DM, 1, F8_QKV ? WQKV_F8SCALE : 0.f, 0, 1 << 30)
              PSEG(I_SQ, (const float*)args.in[5], DM, ws + WS_WO0, DM, 0, F8_WO0 ? WO_F8SCALE : 0.f, 0, 1 << 30)
              PSEG(I_W13, (const float*)args.in[6], FFN, ws + WS_W13, DM, 2, F8_FFN1 ? W13_F8SCALE : 0.f, 0, 1 << 30)
              PSEG(I_W13, (const float*)args.in[7], FFN, ws + WS_W13, DM, 3, F8_FFN1 ? W13_F8SCALE : 0.f, 0, 1 << 30)
              PSEG(I_W2, (const float*)args.in[8], DM, ws + WS_W2, FFN, 0, F8_FFN2 ? W2_F8SCALE : 0.f, 0, 1 << 30)
              PSEG(I_SQ, (const float*)args.in[21], DM, ws + WS_WG0, DM, 0, 0.f, 0, 1 << 30)
              PSEG(I_SQ, (const float*)args.in[21] + (size_t)DM * DM, DM, ws + WS_WG1, DM, 0, 0.f, 0, 1 << 30)
              PSEG(I_WP, (const float*)args.in[20], DM, ws + WS_WP0, 256, 0, 0.f, 0, 1 << 30)
              PSEG(I_WP, (const float*)args.in[20] + (size_t)256 * DM, DM, ws + WS_WP1, 256, 0, 0.f, 0, 1 << 30)
              if constexpr (F8_WIN_SPLIT) { PSEG(I_WIN, (const float*)args.in[9], 4752, ws + WS_WIN8, DM, 4, WIN_F8SCALE, 0, WIN_F8_TILES * 256)
                                            PSEG(I_WIN, (const float*)args.in[9], 4752, ws + WS_WIN, DM, 4, 0.f, WIN_F8_TILES * 256, NWIN) }
              else { PSEG(I_WIN, (const float*)args.in[9], 4752, ws + WS_WIN, DM, 4, F8_WIN ? WIN_F8SCALE : 0.f, 0, 1 << 30) }
              PSEG(I_SQ, (const float*)args.in[13], DM, ws + WS_WO1, DM, 0, F8_WO1 ? WO_F8SCALE : 0.f, 0, 1 << 30)
              if (!hit) { const int h = r >> 4; r &= 15;
                  W = (const float*)args.in[12] + (size_t)h * 512 * 128; N = 128; WT = ws + WS_WUV + (size_t)h * 128 * 1024 * (F8_LAT ? 1 : 2); ldo = 1024; kofs = 512 * (h & 1); f8 = F8_LAT ? WUV_F8SCALE : 0.f; }
#undef PSEG
              tr_item(W, N, (bf16_t*)WT, ldo, kofs, mode, scr, r, F.lane, f8, rlo, rhi); } }
        { bf16_t* wuv = WSP(bf16_t, WS_WUV); const u32x4 z = {0u, 0u, 0u, 0u};
          for (int i = bx * NTHREADS + F.tid; i < 2048 * 64; i += F.G * NTHREADS) { const int n = i >> 6, c8 = i & 63; const int h = n >> 7;
              if constexpr (F8_LAT) { if (c8 < 32) *(u32x4*)((unsigned char*)wuv + (size_t)n * 1024 + 512 * ((h & 1) ^ 1) + 16 * c8) = z; }
              else *(u32x4*)(wuv + (size_t)n * 1024 + 512 * ((h & 1) ^ 1) + 8 * c8) = z; } }
        cvt_linear(F, (const float*)args.in[11], WSP(bf16_t, WS_WUK), (size_t)16 * 512 * 128 / 8);
        if constexpr (F8_QKV) cvt_linear8(F, (const float*)args.in[0], WSP(unsigned char, WS_XBA), (size_t)T * DM / 8); else cvt_linear(F, (const float*)args.in[0], WSP(bf16_t, WS_XBA), (size_t)T * DM / 8);
        cvt_linear(F, (const float*)args.in[1], WSP(bf16_t, WS_PB), (size_t)2 * T * 256 / 8);
        rope_tables(F, (const int*)args.in[2], WSP(float, WS_TAB64), WSP(float, WS_TAB32));
    }
    GRID_BAR();
    PH(1) {
        constexpr int KD = F8_QKV ? DM / 2 : DM;
        pg8::Gemm g{WSP(bf16_t, WS_XBA), WSP(bf16_t, WS_WQKV), KD, KD, KD}; pg8::GridOrder<0, T / 256, NQKV / 256> S;
        pg8::EpiQKV E{ws, F8_QKV ? 1.0f / WQKV_F8SCALE : 1.0f}; pg8::gemm_phase<pg8::EpiQKV, pg8::GridOrder<0, T / 256, NQKV / 256>, F8_QKV>(F.lds, g, S, E, F.wave);
    }
    GRID_BAR();
    PH(2) swa_phase<F8_WO0>(F, WSP(bf16_t, WS_Q), WSP(bf16_t, WS_K), WSP(bf16_t, WS_VT), (const float*)args.in[4], WSP(unsigned char, WS_O8));
    GRID_BAR();
    PH(3) {
        constexpr int KD = F8_WO0 ? DM / 2 : DM;
        pg8::Gemm g{F8_WO0 ? WSP(bf16_t, WS_O8) : WSP(bf16_t, WS_Q), WSP(bf16_t, WS_WO0), KD, KD, KD}; pg8::GridOrder<0, T / 256, DM / 256> S;
        pg8::EpiRes<false> E{args.in[0], YH, F8_WO0 ? 1.0f / (O0_F8SCALE * WO_F8SCALE) : 1.0f}; pg8::gemm_phase<pg8::EpiRes<false>, pg8::GridOrder<0, T / 256, DM / 256>, F8_WO0, EPI_ALIGN_RES>(F.lds, g, S, E, F.wave);
    }
    GRID_BAR();
    PH(4) ln_phase<F8_FFN1>(F, YH, WSP(bf16_t, WS_XBB), WSP(unsigned char, WS_XBA), (const float*)args.in[18], (const float*)args.in[19]);
    GRID_BAR();
    PH(5) {
        constexpr int KD = F8_FFN1 ? DM / 2 : DM;
        pg8::Gemm g{F8_FFN1 ? WSP(bf16_t, WS_XBA) : WSP(bf16_t, WS_XBB), WSP(bf16_t, WS_W13), KD, KD, KD}; pg8::GridOrder<0, T / 256, 2 * FFN / 256> S;
        pg8::EpiSwiglu<F8_FFN2> E{WSP(bf16_t, WS_ACT), FFN, F8_FFN1 ? 1.0f / W13_F8SCALE : 1.0f, ACT_F8SCALE}; pg8::gemm_phase<pg8::EpiSwiglu<F8_FFN2>, pg8::GridOrder<0, T / 256, 2 * FFN / 256>, F8_FFN1>(F.lds, g, S, E, F.wave);
    }
    GRID_BAR();
    PH(6) {
        constexpr int KD = F8_FFN2 ? FFN / 2 : FFN;
        pg8::Gemm g{WSP(bf16_t, WS_ACT), WSP(bf16_t, WS_W2), KD, KD, KD}; pg8::GridOrder<0, T / 256, DM / 256> S;
        pg8::EpiRes<true> E{WSP(bf16_t, WS_XBB), YH, F8_FFN2 ? 1.0f / (ACT_F8SCALE * W2_F8SCALE) : 1.0f}; pg8::gemm_phase<pg8::EpiRes<true>, pg8::GridOrder<0, T / 256, DM / 256>, F8_FFN2, EPI_ALIGN_RES>(F.lds, g, S, E, F.wave);
    }
    GRID_BAR();
    PH(7) ln_phase<false>(F, YH, WSP(bf16_t, WS_XBA), nullptr, (const float*)args.in[18] + DM, (const float*)args.in[19] + DM);
    REFRESH();
    PH(7) {
        pg8::Gemm g{WSP(bf16_t, WS_PB), WSP(bf16_t, WS_WP0), 256, 256, 256}; pg8::GridOrder<0, T / 256, DM / 256> S;
        pg8::EpiBf16<false> E{WSP(bf16_t, WS_PP0), DM, 1.0f}; pg8::gemm_phase(F.lds, g, S, E, F.wave);
    }
    GRID_BAR();
    PH(8) {
        pg8::Gemm g{WSP(bf16_t, WS_XBA), WSP(bf16_t, WS_WG0), DM, DM, DM}; pg8::GridOrder<0, T / 256, DM / 256> S;
        pg8::EpiPle E{nullptr, ws, 0}; pg8::gemm_phase<pg8::EpiPle, pg8::GridOrder<0, T / 256, DM / 256>, false, EPI_ALIGN_RES>(F.lds, g, S, E, F.wave);
    }
    GRID_BAR();
    PH(9) {
        if constexpr (F8_WIN_SPLIT) {
            { static_assert((T / 256) * WIN_F8_TILES == 7 * pg8::GRID && (T / 256) * (NWIN / 256 - WIN_F8_TILES) == 5 * pg8::GRID / 2, "uneven deal: 7 rounds of e4m3 units, 2.5 rounds of bf16 units");
              pg8::Gemm g{WSP(bf16_t, WS_XB8), WSP(bf16_t, WS_WIN8), DM / 2, DM / 2, DM / 2}; pg8::GridOrder<4, T / 256, WIN_F8_TILES> S;
              pg8::EpiWin E{ws, 1.0f / WIN_F8SCALE, 0}; pg8::gemm_phase<pg8::EpiWin, pg8::GridOrder<4, T / 256, WIN_F8_TILES>, true>(F.lds, g, S, E, F.wave); }
            REFRESH();
            { pg8::Gemm g{WSP(bf16_t, WS_XBB), WSP(bf16_t, WS_WIN) + (size_t)WIN_F8_TILES * 256 * DM, DM, DM, DM}; pg8::GridOrder<0, T / 256, NWIN / 256 - WIN_F8_TILES> S;
              pg8::EpiWin E{ws, 1.0f, WIN_F8_TILES}; pg8::gemm_phase<pg8::EpiWin, pg8::GridOrder<0, T / 256, NWIN / 256 - WIN_F8_TILES>, false>(F.lds, g, S, E, F.wave); }
        } else {
        constexpr int KD = F8_WIN ? DM / 2 : DM;
        pg8::Gemm g{WSP(bf16_t, WS_XBB), WSP(bf16_t, WS_WIN), KD, KD, KD}; pg8::GridOrder<0, T / 256, NWIN / 256> S;
        pg8::EpiWin E{ws, F8_WIN ? 1.0f / WIN_F8SCALE : 1.0f, 0}; pg8::gemm_phase<pg8::EpiWin, pg8::GridOrder<0, T / 256, NWIN / 256>, F8_WIN>(F.lds, g, S, E, F.wave);
        }
    }
    GRID_BAR();
    PH(10) kvnorm_phase(F, WSP(float, WS_CRAW), (const float*)args.in[10], WSP(bf16_t, WS_KV));
    REFRESH();
    PH(11) {
        pg8::Gemm g{WSP(bf16_t, WS_QN), WSP(bf16_t, WS_WUK), DM, 128, 128}; pg8::GridOrder<1, T / 256, 8192 / 256> S;
        pg8::EpiBf16<F8_LAT> E{WSP(bf16_t, WS_QLAT), 8192, F8_LAT ? QLAT_F8SCALE : 1.0f}; pg8::gemm_phase(F.lds, g, S, E, F.wave);
    }
    REFRESH();
    DB(12) { topk_phase(F, WSP(bf16_t, WS_QI), WSP(bf16_t, WS_KIF), WSP(float, WS_WI), WSP(unsigned short, WS_SEL)); REFRESH(); }
    PH(12) topk_phase<true>(F, WSP(bf16_t, WS_QI), WSP(bf16_t, WS_KIF), WSP(float, WS_WI), WSP(unsigned short, WS_SEL));
    GRID_BAR();
    PH(13) { if constexpr (F8_KV && F8_LAT) dsa_attn8_phase(F, WSP(unsigned char, WS_QLAT), WSP(unsigned char, WS_QLAT), WSP(unsigned char, WS_QR), WSP(unsigned char, WS_KV), WSP(unsigned short, WS_SEL), nullptr, nullptr, nullptr, ws);
             else dsa_attn_phase(F, WSP(bf16_t, WS_QLAT), WSP(bf16_t, WS_QLAT), WSP(bf16_t, WS_QR), WSP(bf16_t, WS_KV), WSP(unsigned short, WS_SEL), (const float*)args.in[15], (const float*)args.in[16], (const float*)args.in[17], ws); }
    GRID_BAR();
    PH(14) {
        constexpr float dsc = F8_LAT ? 1.0f / (OLAT_F8SCALE * WUV_F8SCALE) : 1.0f;
        pg8::Gemm g{WSP(bf16_t, WS_QLAT), WSP(bf16_t, WS_WUV), F8_LAT ? 4096 : 8192, F8_LAT ? 512 : 1024, F8_LAT ? 512 : 1024}; pg8::GridOrder<F8_LAT ? 3 : 2, T / 256, DM / 256> S;
        pg8::EpiBf16<F8_WO1> E{WSP(bf16_t, WS_O2), DM, (F8_WO1 ? O2_F8SCALE : 1.0f) * dsc}; pg8::gemm_phase<pg8::EpiBf16<F8_WO1>, pg8::GridOrder<F8_LAT ? 3 : 2, T / 256, DM / 256>, F8_LAT>(F.lds, g, S, E, F.wave);
    }
    GRID_BAR();
    PH(15) {
        constexpr int KD = F8_WO1 ? DM / 2 : DM;
        pg8::Gemm g{WSP(bf16_t, WS_O2), WSP(bf16_t, WS_WO1), KD, KD, KD}; pg8::GridOrder<0, T / 256, DM / 256> S;
        pg8::EpiRes<true> E{WSP(bf16_t, WS_XBB), YH, F8_WO1 ? 1.0f / (O2_F8SCALE * WO_F8SCALE) : 1.0f}; pg8::gemm_phase<pg8::EpiRes<true>, pg8::GridOrder<0, T / 256, DM / 256>, F8_WO1, EPI_ALIGN_RES>(F.lds, g, S, E, F.wave);
    }
    GRID_BAR();
    PH(16) ln_router_phase(F, YH, WSP(bf16_t, WS_XBA), (const float*)args.in[18] + 2 * DM, (const float*)args.in[19] + 2 * DM, (const float*)args.in[14], WSP(int, WS_TOKE), WSP(float, WS_TOKG), WSP(int, WS_TOKL));
    REFRESH();
    GRID_BAR();
    PH(18) moe_tiles(F);
    REFRESH();
    PH(18) moe_gather_phase(F, WSP(bf16_t, WS_XBA), WSP(int, WS_TOKE), WSP(float, WS_TOKG), WSP(int, WS_TOKL), WSP(int, WS_TOKS), WSP(float, WS_SGATE), WSP(bf16_t, WS_XG));
    GRID_BAR();
    PH(19) {
        const int NTL = __builtin_amdgcn_readfirstlane((int)F.MISC[28]);
        {
            pg8::MoeOrder<false, 2 * MFFN / 256> S; S.tile0 = 0; S.ntl = NTL;
            pg8::Gemm g{WSP(bf16_t, WS_XG), WSP(bf16_t, WS_MW13), DM / 2, DM / 2, DM / 2};
            pg8::EpiSwiglu<true> E{WSP(bf16_t, WS_ACT2), MFFN, 1.0f / W13_F8SCALE, ACT_F8SCALE}; pg8::gemm_phase<pg8::EpiSwiglu<true>, pg8::MoeOrder<false, 2 * MFFN / 256>, true>(F.lds, g, S, E, F.wave);
        }
        GRID_BAR();
        {
            pg8::MoeOrder<true, DM / 256> S; S.tile0 = 0; S.ntl = NTL;
            pg8::Gemm g{WSP(bf16_t, WS_ACT2), WSP(bf16_t, WS_MW2), MFFN / 2, MFFN / 2, MFFN / 2};
            pg8::EpiMoeDown E{ws}; pg8::gemm_phase<pg8::EpiMoeDown, pg8::MoeOrder<true, DM / 256>, true>(F.lds, g, S, E, F.wave);
        }
        REFRESH();
        {
            pg8::GridOrderSkip<T / 256, DM / 256> S; S.skip = (NTL * (DM / 256)) % pg8::GRID;
            pg8::Gemm g{WSP(bf16_t, WS_PB) + (size_t)T * 256, WSP(bf16_t, WS_WP1), 256, 256, 256};
            pg8::EpiBf16<false> E{WSP(bf16_t, WS_PP1), DM, 1.0f}; pg8::gemm_phase(F.lds, g, S, E, F.wave);
        }
        GRID_BAR();
    }
    PH(20) moe_combine_ln_phase(F, YH, WSP(bf16_t, WS_XBB), WSP(bf16_t, WS_SOUT), WSP(int, WS_TOKS), (const float*)args.in[18] + 2 * DM, (const float*)args.in[19] + 2 * DM, (const float*)args.in[18] + 3 * DM, (const float*)args.in[19] + 3 * DM);
    GRID_BAR();
    PH(21) {
        pg8::Gemm g{WSP(bf16_t, WS_XBB), WSP(bf16_t, WS_WG1), DM, DM, DM}; pg8::GridOrder<0, T / 256, DM / 256> S;
        pg8::EpiPle E{args.out, ws, 1}; pg8::gemm_phase<pg8::EpiPle, pg8::GridOrder<0, T / 256, DM / 256>, false, EPI_ALIGN_RES>(F.lds, g, S, E, F.wave);
    }
}

#undef YH
#undef bx
extern "C" void kernel_launch(void* const* d_in, const int* in_sizes, int n_in, void* d_out, int out_size, void* d_ws, size_t ws_size, hipStream_t stream) {
    static int grid = 0;
    if (grid == 0) {
        if (n_in != 22 || out_size != T * DM || ws_size < WS_END) { fprintf(stderr, "kernel_launch: unexpected problem (n_in %d, out %d, ws %zu < %zu)\n", n_in, out_size, ws_size, (size_t)WS_END); grid = -1; return; }
        int dev = 0, cus = 0;
        if (hipGetDevice(&dev) != hipSuccess || hipDeviceGetAttribute(&cus, hipDeviceAttributeMultiprocessorCount, dev) != hipSuccess) { grid = -1; return; }
        if (hipFuncSetAttribute((const void*)mega_fwd, hipFuncAttributeMaxDynamicSharedMemorySize, LDS_BYTES) != hipSuccess) { fprintf(stderr, "kernel_launch: hipFuncSetAttribute failed\n"); grid = -1; return; }
        int per_cu = 0;
        if (hipOccupancyMaxActiveBlocksPerMultiprocessor(&per_cu, (const void*)mega_fwd, NTHREADS, LDS_BYTES) != hipSuccess || per_cu < 1) { fprintf(stderr, "kernel_launch: occupancy query says %d\n", per_cu); }
        (void)hipGetLastError();
        if (cus != pg8::GRID) { fprintf(stderr, "kernel_launch: built for %d CUs, device has %d\n", pg8::GRID, cus); grid = -1; return; }
        grid = cus;
    }
    if (grid < 0) return;
    (void)hipMemsetAsync((char*)d_ws + WS_CTL, 0, CTL_ZERO_BYTES, stream);
    Args a{};
    for (int i = 0; i < 22; ++i) a.in[i] = d_in[i];
    a.out = (float*)d_out; a.ws = (unsigned char*)d_ws;
    hipLaunchKernelGGL(mega_fwd, dim3(grid), dim3(NTHREADS), LDS_BYTES, stream, a);
}
```

```cpp
#include <hip/hip_runtime.h>
#include <cstdio>
#include <cstdint>

#define LAS __attribute__((address_space(3)))
#define GAS __attribute__((address_space(1)))
typedef unsigned short bf16_t;
typedef short bf16x8 __attribute__((ext_vector_type(8)));
typedef short bf16x4 __attribute__((ext_vector_type(4)));
typedef float f32x2 __attribute__((ext_vector_type(2)));
typedef float f32x4 __attribute__((ext_vector_type(4)));
typedef float f32x16 __attribute__((ext_vector_type(16)));
typedef unsigned u32x2 __attribute__((ext_vector_type(2)));
typedef unsigned u32x4 __attribute__((ext_vector_type(4)));
typedef unsigned long long u64;
typedef int i32x2 __attribute__((ext_vector_type(2)));
typedef int i32x4 __attribute__((ext_vector_type(4)));
typedef int i32x8 __attribute__((ext_vector_type(8)));

constexpr int T = 32768, SEQ = 16384, DM = 2048;
constexpr int FFN = 5632, MFFN = 7168, NEXP = 8;
constexpr int NQKV = 2560, NWIN = 4864;
constexpr float ALPHA = 1.41421356237309515f;
constexpr float LN_EPS = 1e-5f, RMS_EPS = 1e-6f;
constexpr float QSCALE_SWA = 0.18033688011112042f;
constexpr float SCALE2_MLA = 0.10411754627697264f;
constexpr float LOG2E = 1.4426950408889634f;
constexpr int NWAVES = 8, NTHREADS = 512;
constexpr float W13_F8SCALE = 32.0f;
constexpr bool F8_FFN1 = true, F8_FFN2 = true, F8_QKV = true, F8_WO0 = true, F8_WIN = false, F8_WO1 = true;
constexpr bool EPI_ALIGN_RES = true;
constexpr bool SWA_FRAG = true;
constexpr bool F8_LAT = true;
constexpr float QLAT_F8SCALE = 8.0f, OLAT_F8SCALE = 32.0f, WUV_F8SCALE = 16.0f;
constexpr bool F8_KV = true;
constexpr float KV_F8SCALE = 16.0f;
constexpr bool F8_WIN_SPLIT = true;
constexpr int WIN_F8_TILES = 14;
constexpr float WQKV_F8SCALE = 32.0f, WIN_F8SCALE = 32.0f, WO_F8SCALE = 64.0f, O0_F8SCALE = 16.0f, O2_F8SCALE = 32.0f;
constexpr float ACT_F8SCALE = 16.0f, W2_F8SCALE = 128.0f;

constexpr size_t MiB = 1u << 20;
constexpr size_t WS_CTL = 0, CTL_ZERO_BYTES = 1 * MiB;
constexpr size_t WS_WQKV = 2 * MiB, WS_WO0 = 12 * MiB, WS_W13 = 20 * MiB, WS_W2 = 64 * MiB, WS_WG0 = 86 * MiB, WS_WG1 = 94 * MiB, WS_WP0 = 102 * MiB, WS_WP1 = 103 * MiB,
                 WS_WIN = 104 * MiB, WS_WUK = 123 * MiB, WS_WUV = 125 * MiB, WS_WO1 = 129 * MiB;
constexpr size_t WS_TAB64 = 137 * MiB, WS_TAB32 = 145 * MiB, WS_PB = 149 * MiB, WS_XBA = 181 * MiB, WS_XBB = 309 * MiB;
constexpr size_t WS_TOKE = 437 * MiB;
constexpr size_t WS_TOKG = WS_TOKE + 256 * 1024;
constexpr size_t WS_TOKL = WS_TOKG + 256 * 1024;
constexpr size_t WS_TOKS = WS_TOKL + 256 * 1024;
constexpr size_t WS_SGATE = WS_TOKS + 256 * 1024;
constexpr size_t WS_WI = 439 * MiB, WS_SEL = 441 * MiB, WS_R = 458 * MiB;
constexpr size_t WS_Q = WS_R, WS_K = WS_R + 128 * MiB, WS_VT = WS_R + 144 * MiB, WS_ACT = WS_R + 160 * MiB, WS_PP0 = WS_R + 512 * MiB, WS_O8 = WS_R + 640 * MiB, WS_XB8 = WS_R + 704 * MiB  , WS_WIN8 = WS_R + 768 * MiB  ;
constexpr size_t WS_QN = WS_R, WS_QR = WS_R + 128 * MiB, WS_CRAW = WS_R + 192 * MiB, WS_KV = WS_R + 256 * MiB, WS_QI = WS_R + 292 * MiB, WS_KIF = WS_R + 356 * MiB,
                 WS_QLAT = WS_R + 360 * MiB, WS_O2 = WS_R + 872 * MiB;
constexpr size_t WS_MW13 = WS_R + 1128 * MiB, WS_MW2 = WS_R + 1352 * MiB, WS_XG = WS_R, WS_SOUT = WS_R + 136 * MiB, WS_ACT2 = WS_R + 404 * MiB  , WS_PP1 = WS_R + 884 * MiB;
constexpr size_t WS_END = WS_R + 1464 * MiB;
constexpr int MAXSLOTS = 67840;
constexpr int CHUNK_TILES = 272;
constexpr int CW_TMO = 0, CW_CNT = 64  , CW_BAR = 4096;

constexpr int LDS_BYTES = 155648;
constexpr int MISC_OFF = 150016;
constexpr int DSA_WBUF = 18688;

typedef __bf16 bf16x2_t __attribute__((ext_vector_type(2)));
__device__ __forceinline__ unsigned cvt_pk_bf16(float lo, float hi) { const f32x2 v = {lo, hi}; return __builtin_bit_cast(unsigned, __builtin_convertvector(v, bf16x2_t)); }
__device__ __forceinline__ float bf2f(unsigned short h) { return __uint_as_float(((unsigned)h) << 16); }
__device__ __forceinline__ float bflo(unsigned w) { return __uint_as_float(w << 16); }
__device__ __forceinline__ float bfhi(unsigned w) { return __uint_as_float(w & 0xffff0000u); }
__device__ __forceinline__ int fresh_lane() { unsigned m = ~0u; asm volatile("" : "+v"(m)); return (int)__builtin_amdgcn_mbcnt_hi(m, __builtin_amdgcn_mbcnt_lo(m, 0u)); }
__device__ __forceinline__ float shx(float v, int o, int lane) { return __int_as_float(__builtin_amdgcn_ds_bpermute((lane ^ o) << 2, __float_as_int(v))); }
__device__ __forceinline__ float wave_sum(float v) {
    const int l = fresh_lane();
#pragma unroll
    for (int o = 1; o < 64; o <<= 1) v += shx(v, o, l);
    return v;
}
__device__ __forceinline__ unsigned pk4_fp8(float a, float b, float c, float d) { unsigned w = 0u; w = (unsigned)__builtin_amdgcn_cvt_pk_fp8_f32(a, b, (int)w, false); w = (unsigned)__builtin_amdgcn_cvt_pk_fp8_f32(c, d, (int)w, true); return w; }
#define LDS_WAIT() asm volatile("s_waitcnt lgkmcnt(0)" ::: "memory")
#define VM_WAIT() asm volatile("s_waitcnt vmcnt(0)" ::: "memory")

namespace pg8 {
constexpr int BM = 256, BK = 64, HALF = 128, HTB = HALF * BK * 2, STAGE_BYTES = 8 * HTB, NXCD = 8, WGM = 8;
__host__ __device__ __forceinline__ int lds_byte(int r, int c) { const int st = (r >> 4) * 2 + (c >> 5), rr = r & 15, cc = c & 31, ob = rr * 64 + cc * 2; return st * 1024 + (ob ^ (((ob >> 9) & 1) << 5)); }
__host__ __device__ __forceinline__ void stage_rc(int b, int& R, int& C) { const int st = b / 1024, sb = b % 1024, swz = sb ^ (((sb >> 9) & 1) << 5); R = (st >> 1) * 16 + swz / 64; C = (st & 1) * 32 + (swz % 64) / 2; }
__host__ __device__ __forceinline__ int perm32(int rho) { const int n = rho >> 4, i = rho & 15; return 8 * (i >> 2) + 4 * n + (i & 3); }

struct Unit { int pm, pn, am, acol, bn; };
struct Gemm { const bf16_t* A; const bf16_t* Bt; int lda, ldb, K; };

constexpr int GRID = 256;
template <int MODE, int NM, int NN> struct GridOrder {
    __device__ __forceinline__ bool next(int i, Unit& u) const {
        constexpr int nwg = NM * NN;
        int L = i * GRID + (int)blockIdx.x;
        if constexpr (MODE == 4) {
            if (i >= 6) { if ((int)blockIdx.x < GRID / 2 || i >= 8) return false; L = 6 * GRID + ((int)blockIdx.x - GRID / 2) * 2 + (i - 6); } }
        if (L >= nwg) return false;
        int wgid = L; { constexpr int q = nwg / NXCD, r = nwg % NXCD; const int xcd = wgid % NXCD, off = wgid / NXCD; wgid = (xcd < r ? xcd * (q + 1) : r * (q + 1) + (xcd - r) * q) + off; }
        constexpr int nig = WGM * NN; const int gid = wgid / nig, fm = gid * WGM, gsz = (NM - fm) < WGM ? (NM - fm) : WGM;
        u.pm = fm + ((wgid % nig) % gsz); u.pn = (wgid % nig) / gsz; u.am = u.pm; u.bn = u.pn;
        u.acol = MODE == 1 ? (u.pn >> 1) * 128 : (MODE == 2 ? u.pn * 1024 : (MODE == 3 ? u.pn * 512 : 0));
        return true;
    }
};
template <int NM, int NN> struct GridOrderSkip {
    int skip;
    __device__ __forceinline__ bool next(int i, Unit& u) const {
        constexpr int nwg = NM * NN; const int nW = GRID - skip, br = (int)blockIdx.x - skip; if (br < 0) return false;
        const int L = i * nW + br; if (L >= nwg) return false;
        int wgid = L; { constexpr int q = nwg / NXCD, r = nwg % NXCD; const int xcd = wgid % NXCD, off = wgid / NXCD; wgid = (xcd < r ? xcd * (q + 1) : r * (q + 1) + (xcd - r) * q) + off; }
        constexpr int nig = WGM * NN; const int gid = wgid / nig, fm = gid * WGM, gsz = (NM - fm) < WGM ? (NM - fm) : WGM;
        u.pm = fm + ((wgid % nig) % gsz); u.pn = (wgid % nig) / gsz; u.am = u.pm; u.bn = u.pn; u.acol = 0;
        return true;
    }
};
template <bool DOWN, int NN> struct MoeOrder {
    int tile0, ntl;
    __device__ __forceinline__ bool next(int i, Unit& u) const {
        int pml, pn;
        if constexpr (!DOWN && NN % 8 == 0) {
            constexpr int NJ = NN / 8; const int x = (int)blockIdx.x & 7, q = i * (GRID / 8) + ((int)blockIdx.x >> 3); if (q >= ntl * NJ) return false;
            const int nfull = ntl >> 3; int m, j;
            if (q < nfull * 8 * NJ) { const int b = q / (8 * NJ), w = q - b * (8 * NJ); m = b * 8 + (w & 7); j = w >> 3; }
            else { const int g = ntl - nfull * 8, w = q - nfull * 8 * NJ; j = w / g; m = nfull * 8 + (w - j * g); }
            pml = m; pn = 8 * j + x;
        } else {
        const int L = i * GRID + (int)blockIdx.x; if (L >= ntl * NN) return false;
        constexpr int nig = WGM * NN; const int wgid = L, gid = wgid / nig, fm = gid * WGM, gsz = (ntl - fm) < WGM ? (ntl - fm) : WGM;
        pml = fm + ((wgid % nig) % gsz); pn = (wgid % nig) / gsz; }
        const int pmg = tile0 + pml;
        const u32x4 t0 = *(const LAS u32x4*)(MISC_OFF + 20 * 4), t1 = *(const LAS u32x4*)(MISC_OFF + 24 * 4);
        int e = (pmg >= (int)t0.x) + (pmg >= (int)t0.y) + (pmg >= (int)t0.z) + (pmg >= (int)t0.w) + (pmg >= (int)t1.x) + (pmg >= (int)t1.y) + (pmg >= (int)t1.z);
        e = __builtin_amdgcn_readfirstlane(e);
        u.pn = pn; u.bn = e * NN + pn; u.acol = 0;
        if (DOWN) { u.pm = pmg; u.am = pml; } else { u.pm = pml; u.am = pmg; }
        return true;
    }
};

__device__ __forceinline__ void stage16_s(const char* gbase, unsigned voff, unsigned lds_dst) { unsigned keep;
    asm volatile("s_mov_b32 %0, m0\n\ts_mov_b32 m0, %3\n\ts_nop 0\n\tglobal_load_lds_dwordx4 %1, %2\n\ts_mov_b32 m0, %0" : "=&s"(keep) : "v"(voff), "s"(gbase), "s"(lds_dst) : "memory"); }
template <class Epi, class Sched, bool FP8 = false, bool ALIGN = true>
__device__ __forceinline__ void gemm_phase(LAS unsigned char* lds, const Gemm g, const Sched& S, const Epi& E, int wave_) {
    int tid_ = wave_ * 64 + fresh_lane(); asm volatile("" : "+v"(tid_));
    const int tid = tid_, wid = __builtin_amdgcn_readfirstlane(tid >> 6), lane = tid & 63, wr = wid >> 2, wc = wid & 3, fr = lane & 15, fq = lane >> 4;
    int K_ = g.K; asm volatile("" : "+s"(K_));
    const int K = K_, nt = K / BK;
    unsigned voffA[2], voffB[2];
#pragma unroll
    for (int i = 0; i < 2; ++i) { int R, C; stage_rc(tid * 16 + i * 8192, R, C); const int Rb = (R & ~31) + perm32(R & 31);
        voffA[i] = (unsigned)(R * g.lda + C) * 2u; voffB[i] = (unsigned)(Rb * g.ldb + C) * 2u; }
    const size_t kstep = (size_t)(BK * 2);
    const size_t hstepA = (size_t)HALF * g.lda * 2, hstepB = (size_t)HALF * g.ldb * 2;
    const unsigned ldsw = (unsigned)wid * 1024u;
    const int aoff = lds_byte(wr * 64 + fr, fq * 8), boff = lds_byte(wc * 32 + fr, fq * 8);
#define PG8_SA(b, h) (((b) * 2 + (h)) * HTB)
#define PG8_SB(b, h) ((4 + (b) * 2 + (h)) * HTB)
#define PG8_STAGE(bufoff, gbase, voff) do { _Pragma("unroll") for (int _i = 0; _i < 2; ++_i) { \
        if constexpr (FP8) stage16_s((const char*)(gbase), (voff)[_i], (unsigned)(size_t)(lds + (bufoff) + ldsw + _i * 8192)); \
        else __builtin_amdgcn_global_load_lds((const unsigned*)((const char*)(gbase) + (voff)[_i]), (LAS unsigned*)(lds + (bufoff) + ldsw + _i * 8192), 16, 0, 0); } } while (0)
#define PG8_LDA(dst, b, h) do { _Pragma("unroll") for (int m = 0; m < 4; ++m) _Pragma("unroll") for (int k = 0; k < 2; ++k) dst[m][k] = *(const LAS bf16x8*)(lds + PG8_SA(b, h) + aoff + m * 2048 + k * 1024); } while (0)
#define PG8_LDB(dst, b, h) do { _Pragma("unroll") for (int n = 0; n < 2; ++n) _Pragma("unroll") for (int k = 0; k < 2; ++k) dst[n][k] = *(const LAS bf16x8*)(lds + PG8_SB(b, h) + boff + n * 2048 + k * 1024); } while (0)
#define PG8_MMA(ai, bj, At, Bt) do { __builtin_amdgcn_s_setprio(1); _Pragma("unroll") for (int m = 0; m < 4; ++m) _Pragma("unroll") for (int n = 0; n < 2; ++n) _Pragma("unroll") for (int k = 0; k < 2; ++k) \
        acc[ai][bj][m][n] = __builtin_amdgcn_mfma_f32_16x16x32_bf16(Bt[n][k], At[m][k], acc[ai][bj][m][n], 0, 0, 0); __builtin_amdgcn_s_setprio(0); } while (0)
#define PG8_LDA8(dst, b, h) do { _Pragma("unroll") for (int m = 0; m < 4; ++m) { const i32x4 lo_ = *(const LAS i32x4*)(lds + PG8_SA(b, h) + aoff + m * 2048), hi_ = *(const LAS i32x4*)(lds + PG8_SA(b, h) + aoff + m * 2048 + 1024); \
        dst[m] = __builtin_shufflevector(lo_, hi_, 0, 1, 2, 3, 4, 5, 6, 7); } } while (0)
#define PG8_LDB8(dst, b, h) do { _Pragma("unroll") for (int n = 0; n < 2; ++n) { const i32x4 lo_ = *(const LAS i32x4*)(lds + PG8_SB(b, h) + boff + n * 2048), hi_ = *(const LAS i32x4*)(lds + PG8_SB(b, h) + boff + n * 2048 + 1024); \
        dst[n] = __builtin_shufflevector(lo_, hi_, 0, 1, 2, 3, 4, 5, 6, 7); } } while (0)
#define PG8_MMA8(ai, bj, At, Bt) do { __builtin_amdgcn_s_setprio(1); _Pragma("unroll") for (int m = 0; m < 4; ++m) _Pragma("unroll") for (int n = 0; n < 2; ++n) \
        acc[ai][bj][m][n] = __builtin_amdgcn_mfma_scale_f32_16x16x128_f8f6f4(Bt[n], At[m], acc[ai][bj][m][n], 0, 0, 0, 0, 0, 0); __builtin_amdgcn_s_setprio(0); } while (0)
#define PG8_WAIT_V(n) asm volatile("s_waitcnt vmcnt(" #n ")" ::: "memory")
#define PG8_WAIT_L(n) asm volatile("s_waitcnt lgkmcnt(" #n ")" ::: "memory")
#define PG8_BAR __builtin_amdgcn_s_barrier()
#define PG8_SCHED __builtin_amdgcn_sched_barrier(0)
#define PG8_ABASE(u) ((const char*)g.A + ((size_t)(u).am * BM * g.lda + (size_t)(u).acol) * 2)
#define PG8_BBASE(u) ((const char*)g.Bt + (size_t)(u).bn * BM * g.ldb * 2)
    Unit cur, nxt; int ui = 0;
    if (!S.next(0, cur)) return;
    f32x4 acc[2][2][4][2];
#pragma unroll
    for (int a = 0; a < 2; ++a)
#pragma unroll
        for (int b = 0; b < 2; ++b)
#pragma unroll
            for (int m = 0; m < 4; ++m)
#pragma unroll
                for (int n = 0; n < 2; ++n) acc[a][b][m][n] = (f32x4){0.f, 0.f, 0.f, 0.f};
    bf16x8 At[4][2], B0[2][2], B1[2][2]; i32x8 At8[4], B08[2], B18[2];
    const char* cA = PG8_ABASE(cur); const char* cB = PG8_BBASE(cur);
    {
        PG8_STAGE(PG8_SB(0, 0), cB, voffB); PG8_STAGE(PG8_SB(0, 1), cB + hstepB, voffB); PG8_STAGE(PG8_SA(0, 0), cA, voffA); PG8_STAGE(PG8_SA(0, 1), cA + hstepA, voffA);
        if (wr == 1) PG8_BAR;
        PG8_WAIT_V(2); PG8_BAR;
        PG8_STAGE(PG8_SB(1, 0), cB + kstep, voffB); PG8_STAGE(PG8_SA(1, 0), cA + kstep, voffA); PG8_STAGE(PG8_SB(1, 1), cB + hstepB + kstep, voffB);
        PG8_WAIT_V(6); PG8_BAR;
    }
    for (;;) {
        const bool has_next = S.next(ui + 1, nxt);
        const char* nA = has_next ? PG8_ABASE(nxt) : cA; const char* nB = has_next ? PG8_BBASE(nxt) : cB;
        for (int t = 0; t < nt; t += 2) {
            const bool last = (t == nt - 2);
            const char* a1 = cA + (size_t)(t + 1) * kstep;
            const char* a2 = last ? nA : cA + (size_t)(t + 2) * kstep; const char* b2 = last ? nB : cB + (size_t)(t + 2) * kstep;
            const char* a3 = a2 + kstep; const char* b3 = b2 + kstep;
            if constexpr (FP8) {
            PG8_LDB8(B08, 0, 0); PG8_LDB8(B18, 0, 1); PG8_SCHED; PG8_LDA8(At8, 0, 0); PG8_STAGE(PG8_SA(1, 1), a1 + hstepA, voffA);
            PG8_WAIT_V(8); PG8_WAIT_L(0); PG8_BAR; PG8_MMA8(0, 0, At8, B08); PG8_MMA8(0, 1, At8, B18); PG8_BAR; PG8_SCHED;
            PG8_LDA8(At8, 0, 1); PG8_STAGE(PG8_SB(0, 0), b2, voffB); PG8_STAGE(PG8_SB(0, 1), b2 + hstepB, voffB); PG8_STAGE(PG8_SA(0, 0), a2, voffA);
            PG8_WAIT_V(8); PG8_WAIT_L(0); PG8_BAR; PG8_MMA8(1, 0, At8, B08); PG8_MMA8(1, 1, At8, B18); PG8_BAR; PG8_SCHED;
            PG8_LDB8(B08, 1, 0); PG8_LDB8(B18, 1, 1); PG8_SCHED; PG8_LDA8(At8, 1, 0); PG8_STAGE(PG8_SA(0, 1), a2 + hstepA, voffA);
            PG8_WAIT_V(8); PG8_WAIT_L(0); PG8_BAR; PG8_MMA8(0, 0, At8, B08); PG8_MMA8(0, 1, At8, B18); PG8_BAR; PG8_SCHED;
            PG8_LDA8(At8, 1, 1); PG8_STAGE(PG8_SB(1, 0), b3, voffB); PG8_STAGE(PG8_SB(1, 1), b3 + hstepB, voffB); PG8_STAGE(PG8_SA(1, 0), a3, voffA);
            PG8_WAIT_V(8); PG8_WAIT_L(0); PG8_BAR; PG8_MMA8(1, 0, At8, B08); PG8_MMA8(1, 1, At8, B18); PG8_BAR; PG8_SCHED;
            } else {
            PG8_LDB(B0, 0, 0); PG8_LDB(B1, 0, 1); PG8_SCHED; PG8_LDA(At, 0, 0); PG8_STAGE(PG8_SA(1, 1), a1 + hstepA, voffA);
            PG8_WAIT_V(8); PG8_WAIT_L(0); PG8_BAR; PG8_MMA(0, 0, At, B0); PG8_MMA(0, 1, At, B1); PG8_BAR; PG8_SCHED;
            PG8_LDA(At, 0, 1); PG8_STAGE(PG8_SB(0, 0), b2, voffB); PG8_STAGE(PG8_SB(0, 1), b2 + hstepB, voffB); PG8_STAGE(PG8_SA(0, 0), a2, voffA);
            PG8_WAIT_V(8); PG8_WAIT_L(0); PG8_BAR; PG8_MMA(1, 0, At, B0); PG8_MMA(1, 1, At, B1); PG8_BAR; PG8_SCHED;
            PG8_LDB(B0, 1, 0); PG8_LDB(B1, 1, 1); PG8_SCHED; PG8_LDA(At, 1, 0); PG8_STAGE(PG8_SA(0, 1), a2 + hstepA, voffA);
            PG8_WAIT_V(8); PG8_WAIT_L(0); PG8_BAR; PG8_MMA(0, 0, At, B0); PG8_MMA(0, 1, At, B1); PG8_BAR; PG8_SCHED;
            PG8_LDA(At, 1, 1); PG8_STAGE(PG8_SB(1, 0), b3, voffB); PG8_STAGE(PG8_SB(1, 1), b3 + hstepB, voffB); PG8_STAGE(PG8_SA(1, 0), a3, voffA);
            PG8_WAIT_V(8); PG8_WAIT_L(0); PG8_BAR; PG8_MMA(1, 0, At, B0); PG8_MMA(1, 1, At, B1); PG8_BAR; PG8_SCHED;
            }
        }
        if constexpr (ALIGN) { if (wr == 0) PG8_BAR; }
        { int fr_ = fr, fq_ = fq; asm volatile("" : "+v"(fr_), "+v"(fq_));
          E(acc, cur, wr, wc, fr_, fq_); }
        if (!has_next) break;
#pragma unroll
        for (int a = 0; a < 2; ++a)
#pragma unroll
            for (int b = 0; b < 2; ++b)
#pragma unroll
                for (int m = 0; m < 4; ++m)
#pragma unroll
                    for (int n = 0; n < 2; ++n) acc[a][b][m][n] = (f32x4){0.f, 0.f, 0.f, 0.f};
        cur = nxt; cA = nA; cB = nB; ++ui;
        if constexpr (ALIGN) { if (wr == 1) PG8_BAR; }
    }
    PG8_WAIT_V(0);
    if constexpr (!ALIGN) { if (wr == 0) PG8_BAR; }
    PG8_BAR;
#undef PG8_SA
#undef PG8_SB
#undef PG8_STAGE
#undef PG8_LDA
#undef PG8_LDB
#undef PG8_MMA
#undef PG8_LDA8
#undef PG8_LDB8
#undef PG8_MMA8
#undef PG8_WAIT_V
#undef PG8_WAIT_L
#undef PG8_BAR
#undef PG8_SCHED
#undef PG8_ABASE
#undef PG8_BBASE
}

#define EPI_ROW(ai, m) (u.pm * BM + (ai) * HALF + wr * 64 + (m) * 16 + fr)
#define EPI_COL(bj) (u.pn * BM + (bj) * HALF + wc * 32 + 8 * fq)
typedef f32x4 AccT[2][2][4][2];

__device__ __forceinline__ void rope4(f32x4& v0, f32x4& v1, const f32x4 cs0, const f32x4 cs1) {
    f32x4 o0, o1;
    o0[0] = v0[0] * cs0[0] - v0[1] * cs0[1]; o0[1] = v0[1] * cs0[0] + v0[0] * cs0[1];
    o0[2] = v0[2] * cs0[2] - v0[3] * cs0[3]; o0[3] = v0[3] * cs0[2] + v0[2] * cs0[3];
    o1[0] = v1[0] * cs1[0] - v1[1] * cs1[1]; o1[1] = v1[1] * cs1[0] + v1[0] * cs1[1];
    o1[2] = v1[2] * cs1[2] - v1[3] * cs1[3]; o1[3] = v1[3] * cs1[2] + v1[2] * cs1[3];
    v0 = o0; v1 = o1;
}
__device__ __forceinline__ u32x4 pack8(const f32x4 v0, const f32x4 v1) { u32x4 w; w.x = cvt_pk_bf16(v0[0], v0[1]); w.y = cvt_pk_bf16(v0[2], v0[3]); w.z = cvt_pk_bf16(v1[0], v1[1]); w.w = cvt_pk_bf16(v1[2], v1[3]); return w; }

__device__ __forceinline__ void unpack8(const u32x4 w, f32x4& a, f32x4& b) { a[0] = bflo(w.x); a[1] = bfhi(w.x); a[2] = bflo(w.y); a[3] = bfhi(w.y); b[0] = bflo(w.z); b[1] = bfhi(w.z); b[2] = bflo(w.w); b[3] = bfhi(w.w); }
__device__ __forceinline__ u32x2 pack8_fp8(const f32x4 v0, const f32x4 v1, float s) { u32x2 w; w.x = pk4_fp8(v0[0] * s, v0[1] * s, v0[2] * s, v0[3] * s); w.y = pk4_fp8(v1[0] * s, v1[1] * s, v1[2] * s, v1[3] * s); return w; }
template <bool OUT8> struct EpiBf16 {
    bf16_t* O; int ldc; float osc;
    __device__ __forceinline__ void operator()(const AccT& acc, const Unit& u, int wr, int wc, int fr, int fq) const {
#pragma unroll
        for (int ai = 0; ai < 2; ++ai)
#pragma unroll
            for (int m = 0; m < 4; ++m) {
#pragma unroll
                for (int bj = 0; bj < 2; ++bj) {
                    if constexpr (OUT8) *(u32x2*)((unsigned char*)O + (size_t)EPI_ROW(ai, m) * ldc + EPI_COL(bj)) = pack8_fp8(acc[ai][bj][m][0], acc[ai][bj][m][1], osc);
                    else *(u32x4*)(O + (size_t)EPI_ROW(ai, m) * ldc + EPI_COL(bj)) = pack8(acc[ai][bj][m][0] * osc, acc[ai][bj][m][1] * osc); } }
    }
};
struct EpiQKV {
    unsigned char* ws; float asc;
    __device__ __forceinline__ void operator()(const AccT& acc, const Unit& u, int wr, int wc, int fr, int fq) const {
        bf16_t* Q = (bf16_t*)(ws + WS_Q); bf16_t* Kb = (bf16_t*)(ws + WS_K); bf16_t* VT = (bf16_t*)(ws + WS_VT); const float* tab64 = (const float*)(ws + WS_TAB64);
        if (u.pn < 9) {
            bf16_t* base = u.pn < 8 ? Q : Kb; const int ldc = u.pn < 8 ? 2048 : 256; const int colt = u.pn < 8 ? u.pn * BM : 0; const float sc = (u.pn < 8 ? QSCALE_SWA : 1.0f) * asc;
#pragma unroll
            for (int ai = 0; ai < 2; ++ai)
#pragma unroll
                for (int m = 0; m < 4; ++m) { const int row = EPI_ROW(ai, m);
#pragma unroll
                    for (int bj = 0; bj < 2; ++bj) { const int cl = bj * HALF + wc * 32 + 8 * fq; const int i0 = (cl & 63) >> 1;
                        const f32x4 cs0 = *(const f32x4*)(tab64 + ((size_t)row * 32 + i0) * 2), cs1 = *(const f32x4*)(tab64 + ((size_t)row * 32 + i0) * 2 + 4);
                        f32x4 v0 = acc[ai][bj][m][0], v1 = acc[ai][bj][m][1]; rope4(v0, v1, cs0, cs1); v0 = v0 * sc; v1 = v1 * sc;
                        if constexpr (SWA_FRAG) {
                            const int b = row >> 14, s = row & (SEQ - 1), hh = (colt + cl) >> 6, c64 = cl & 63, kk = c64 >> 4, hf2 = (c64 >> 3) & 1, nh = u.pn < 8 ? 32 : 4;
                            *(u32x4*)(base + ((((size_t)(b * nh + hh) * 512 + (s >> 5)) * 4 + kk) * 64 + hf2 * 32 + (s & 31)) * 8) = pack8(v0, v1); }
                        else *(u32x4*)(base + (size_t)row * ldc + colt + cl) = pack8(v0, v1); } }
        } else {
#pragma unroll
            for (int ai = 0; ai < 2; ++ai)
#pragma unroll
                for (int m = 0; m < 4; ++m) { const int row = EPI_ROW(ai, m), b = row >> 14, s = row & (SEQ - 1);
#pragma unroll
                    for (int bj = 0; bj < 2; ++bj) { const int cl = bj * HALF + wc * 32 + 8 * fq, kvh = cl >> 6, d0 = cl & 63;
                        const u32x4 w = pack8(acc[ai][bj][m][0] * asc, acc[ai][bj][m][1] * asc);
                        if constexpr (SWA_FRAG) {
                            const int j = s & 31, c = j >> 4, jj = j & 15, hfv = (jj & 7) >> 2, e = (jj & 3) + ((jj >> 3) << 2), mt = d0 >> 5;
                            bf16_t* pf = VT + (((((size_t)(b * 4 + kvh) * 512 + (s >> 5)) * 2 + c) * 2 + mt) * 64 + hfv * 32 + (d0 & 31)) * 8 + e;
                            pf[0] = (bf16_t)(w.x & 0xffff); pf[8] = (bf16_t)(w.x >> 16); pf[16] = (bf16_t)(w.y & 0xffff); pf[24] = (bf16_t)(w.y >> 16);
                            pf[32] = (bf16_t)(w.z & 0xffff); pf[40] = (bf16_t)(w.z >> 16); pf[48] = (bf16_t)(w.w & 0xffff); pf[56] = (bf16_t)(w.w >> 16); }
                        else {
                        bf16_t* p = VT + ((size_t)(b * 4 + kvh) * 64 + d0) * SEQ + s;
                        p[0 * SEQ] = (bf16_t)(w.x & 0xffff); p[1 * SEQ] = (bf16_t)(w.x >> 16); p[2 * SEQ] = (bf16_t)(w.y & 0xffff); p[3 * SEQ] = (bf16_t)(w.y >> 16);
                        p[4 * SEQ] = (bf16_t)(w.z & 0xffff); p[5 * SEQ] = (bf16_t)(w.z >> 16); p[6 * SEQ] = (bf16_t)(w.w & 0xffff); p[7 * SEQ] = (bf16_t)(w.w >> 16); } } }
        }
    }
};
template <bool RES16> struct EpiRes {
    const void* res; bf16_t* out; float sc;
    __device__ __forceinline__ void operator()(const AccT& acc, const Unit& u, int wr, int wc, int fr, int fq) const {
#pragma unroll
        for (int ai = 0; ai < 2; ++ai)
#pragma unroll
            for (int m = 0; m < 4; ++m) { const size_t ro = (size_t)EPI_ROW(ai, m) * DM;
#pragma unroll
                for (int bj = 0; bj < 2; ++bj) { const size_t o = ro + EPI_COL(bj); f32x4 r0, r1;
                    if constexpr (RES16) unpack8(*(const u32x4*)((const bf16_t*)res + o), r0, r1);
                    else { r0 = *(const f32x4*)((const float*)res + o); r1 = *(const f32x4*)((const float*)res + o + 4); }
                    *(u32x4*)(out + o) = pack8(r0 * ALPHA + acc[ai][bj][m][0] * sc, r1 * ALPHA + acc[ai][bj][m][1] * sc); }
                asm volatile("" ::: "memory"); }
    }
};
__device__ __forceinline__ float silu_mul(float g, float uu) { return g * __builtin_amdgcn_rcpf(1.0f + __builtin_amdgcn_exp2f(-g * LOG2E)) * uu; }
template <bool OUT8> struct EpiSwiglu {
    bf16_t* O; int ldc; float sc; float osc;
    __device__ __forceinline__ void operator()(const AccT& acc, const Unit& u, int wr, int wc, int fr, int fq) const {
#pragma unroll
        for (int ai = 0; ai < 2; ++ai)
#pragma unroll
            for (int m = 0; m < 4; ++m) { f32x4 a0, a1;
#pragma unroll
                for (int j = 0; j < 4; ++j) { a0[j] = silu_mul(acc[ai][0][m][0][j] * sc, acc[ai][1][m][0][j] * sc); a1[j] = silu_mul(acc[ai][0][m][1][j] * sc, acc[ai][1][m][1][j] * sc); }
                if constexpr (OUT8) { u32x2 w8; w8.x = pk4_fp8(a0[0] * osc, a0[1] * osc, a0[2] * osc, a0[3] * osc); w8.y = pk4_fp8(a1[0] * osc, a1[1] * osc, a1[2] * osc, a1[3] * osc);
                    *(u32x2*)((unsigned char*)O + (size_t)EPI_ROW(ai, m) * ldc + u.pn * HALF + wc * 32 + 8 * fq) = w8; }
                else *(u32x4*)(O + (size_t)EPI_ROW(ai, m) * ldc + u.pn * HALF + wc * 32 + 8 * fq) = pack8(a0, a1); }
    }
};
struct EpiPle {
    float* outf; unsigned char* ws; int layer;
    __device__ __forceinline__ void operator()(const AccT& acc, const Unit& u, int wr, int wc, int fr, int fq) const {
        const bf16_t* pp = (const bf16_t*)(ws + (layer == 0 ? WS_PP0 : WS_PP1));
        const bf16_t* xres = (const bf16_t*)(ws + (layer == 0 ? WS_XBA : WS_XBB));
#pragma unroll
        for (int ai = 0; ai < 2; ++ai)
#pragma unroll
            for (int m = 0; m < 4; ++m) { const size_t ro = (size_t)EPI_ROW(ai, m) * DM;
#pragma unroll
                for (int bj = 0; bj < 2; ++bj) { const size_t o = ro + EPI_COL(bj);
                    f32x4 r0, r1, p0, p1; unpack8(*(const u32x4*)(xres + o), r0, r1); unpack8(*(const u32x4*)(pp + o), p0, p1);
                    f32x4 s0, s1;
#pragma unroll
                    for (int j = 0; j < 4; ++j) { s0[j] = __builtin_amdgcn_rcpf(1.0f + __builtin_amdgcn_exp2f(-acc[ai][bj][m][0][j] * LOG2E)); s1[j] = __builtin_amdgcn_rcpf(1.0f + __builtin_amdgcn_exp2f(-acc[ai][bj][m][1][j] * LOG2E)); }
                    const f32x4 o0 = r0 + s0 * p0, o1 = r1 + s1 * p1;
                    if (layer == 0) { *(u32x4*)((bf16_t*)(ws + WS_XBB) + o) = pack8(o0, o1);
                                      if constexpr (F8_WIN_SPLIT || F8_WIN) *(u32x2*)(ws + WS_XB8 + o) = pack8_fp8(o0, o1, 1.0f); }
                    else { *(f32x4*)(outf + o) = o0; *(f32x4*)(outf + o + 4) = o1; } }
                asm volatile("" ::: "memory"); }
    }
};
struct EpiWin {
    unsigned char* ws; float asc; int pn0;
    __device__ __forceinline__ void operator()(const AccT& acc, const Unit& u, int wr, int wc, int fr, int fq) const {
        bf16_t* QN = (bf16_t*)(ws + WS_QN); bf16_t* QR = (bf16_t*)(ws + WS_QR); float* CRAW = (float*)(ws + WS_CRAW); bf16_t* KV = (bf16_t*)(ws + WS_KV); bf16_t* QI = (bf16_t*)(ws + WS_QI);
        bf16_t* KIF = (bf16_t*)(ws + WS_KIF); float* WI = (float*)(ws + WS_WI); const float* tab64 = (const float*)(ws + WS_TAB64); const float* tab32 = (const float*)(ws + WS_TAB32);
        const int pn = u.pn + pn0;
#pragma unroll
        for (int ai = 0; ai < 2; ++ai)
#pragma unroll
            for (int m = 0; m < 4; ++m) { const int row = EPI_ROW(ai, m);
#pragma unroll
                for (int bj = 0; bj < 2; ++bj) { const int cl = bj * HALF + wc * 32 + 8 * fq; f32x4 v0 = acc[ai][bj][m][0] * asc, v1 = acc[ai][bj][m][1] * asc;
                    if (pn < 8) { *(u32x4*)(QN + (size_t)row * 2048 + pn * BM + cl) = pack8(v0, v1); }
                    else if (pn < 12) { const int i0 = (cl & 63) >> 1;
                        const f32x4 cs0 = *(const f32x4*)(tab64 + ((size_t)row * 32 + i0) * 2), cs1 = *(const f32x4*)(tab64 + ((size_t)row * 32 + i0) * 2 + 4);
                        rope4(v0, v1, cs0, cs1); if constexpr (F8_LAT) { v0 = v0 * QLAT_F8SCALE; v1 = v1 * QLAT_F8SCALE; }
                        if constexpr (F8_KV) *(u32x2*)((unsigned char*)QR + (size_t)row * 1024 + (pn - 8) * BM + cl) = pack8_fp8(v0, v1, 1.0f);
                        else *(u32x4*)(QR + (size_t)row * 1024 + (pn - 8) * BM + cl) = pack8(v0, v1); }
                    else if (pn < 14) { float* p = CRAW + (size_t)row * 512 + (pn - 12) * BM + cl; *(f32x4*)p = v0; *(f32x4*)(p + 4) = v1; }
                    else if (pn == 14) {
                        if (cl < 64) { const int i0 = cl >> 1;
                            const f32x4 cs0 = *(const f32x4*)(tab64 + ((size_t)row * 32 + i0) * 2), cs1 = *(const f32x4*)(tab64 + ((size_t)row * 32 + i0) * 2 + 4);
                            rope4(v0, v1, cs0, cs1);
                            if constexpr (F8_KV) *(u32x2*)((unsigned char*)KV + (size_t)row * 576 + 512 + cl) = pack8_fp8(v0, v1, KV_F8SCALE);
                            else *(u32x4*)(KV + (size_t)row * 576 + 512 + cl) = pack8(v0, v1); }
                        else if (cl < 128) { const int d8 = cl - 64;
                            if (d8 < 32) { const int i0 = d8 >> 1;
                                const f32x4 cs0 = *(const f32x4*)(tab32 + ((size_t)row * 16 + i0) * 2), cs1 = *(const f32x4*)(tab32 + ((size_t)row * 16 + i0) * 2 + 4);
                                rope4(v0, v1, cs0, cs1); }
                            const int b = row >> 14, s = row & (SEQ - 1), blk = s >> 5, j = s & 31, kk = d8 >> 4, hf = (d8 >> 3) & 1;
                            *(u32x4*)(KIF + ((size_t)((b * 512 + blk) * 4 + kk) * 64 + hf * 32 + j) * 8) = pack8(v0, v1); }
                        else if (cl < 144) { float* p = WI + (size_t)row * 16 + (cl - 128); *(f32x4*)p = v0; *(f32x4*)(p + 4) = v1; }
                    } else { const int cq = (pn - 15) * BM + cl, d8 = cq & 63;
                        if (d8 < 32) { const int i0 = d8 >> 1;
                            const f32x4 cs0 = *(const f32x4*)(tab32 + ((size_t)row * 16 + i0) * 2), cs1 = *(const f32x4*)(tab32 + ((size_t)row * 16 + i0) * 2 + 4);
                            rope4(v0, v1, cs0, cs1); }
                        *(u32x4*)(QI + (size_t)row * 1024 + cq) = pack8(v0, v1); }
                } }
    }
};
struct EpiMoeDown {
    unsigned char* ws;
    __device__ __forceinline__ void operator()(const AccT& acc, const Unit& u, int wr, int wc, int fr, int fq) const {
        bf16_t* O = (bf16_t*)(ws + WS_SOUT); const float* gate = (const float*)(ws + WS_SGATE);
#pragma unroll
        for (int ai = 0; ai < 2; ++ai)
#pragma unroll
            for (int m = 0; m < 4; ++m) { const int row = EPI_ROW(ai, m); const float gt = gate[row] * (1.0f / (ACT_F8SCALE * W2_F8SCALE)); bf16_t* rowp = O + (size_t)row * DM;
#pragma unroll
                for (int bj = 0; bj < 2; ++bj) *(u32x4*)(rowp + EPI_COL(bj)) = pack8(acc[ai][bj][m][0] * gt, acc[ai][bj][m][1] * gt); }
    }
};
}

#define XB_TMO      128
#define XB_XCNT(j)  (256  + 64 * (j))
#define XB_XSUB(j)  (1280 + 64 * (j))
#define XB_XGEN(j)  (2304 + 64 * (j))
#define XB_TOP      3328
#define XB_TOPGEN   3392
#define XCD_BAR_WORDS 3456
#define XB_SPIN_CAP (1u << 22)

__device__ __forceinline__ unsigned xb_ld(unsigned* p)              { return __hip_atomic_load(p, __ATOMIC_RELAXED, __HIP_MEMORY_SCOPE_AGENT); }
__device__ __forceinline__ unsigned xb_add(unsigned* p, unsigned v) { return __hip_atomic_fetch_add(p, v, __ATOMIC_RELAXED, __HIP_MEMORY_SCOPE_AGENT); }
__device__ __forceinline__ unsigned xb_xcc_id() { return (unsigned)__builtin_amdgcn_s_getreg((3 << 11) | 20) & 0xFu; }
#define XB_SPIN(cond, bar) do { unsigned _sp = 0; while (cond) { __builtin_amdgcn_s_sleep(1); \
    if ((++_sp & 255u) == 0u) { if (xb_ld(&(bar)[XB_TMO])) break; if (_sp > XB_SPIN_CAP) { atomicAdd(&(bar)[XB_TMO], 1u); break; } } } } while (0)

struct XcdBarrier { unsigned* bar; unsigned x; volatile LAS unsigned* st; };

__device__ __forceinline__ XcdBarrier xcd_barrier_post(unsigned* bar, volatile LAS unsigned* st) {
    XcdBarrier b; b.bar = bar; b.x = xb_xcc_id(); b.st = st;
    if (threadIdx.x == 0) (void)xb_add(&bar[XB_XCNT(b.x)], 1u);
    return b;
}
__device__ __forceinline__ void xcd_barrier_complete(unsigned* bar, unsigned x, unsigned& nloc, unsigned& nx) {
    const unsigned G = gridDim.x * gridDim.y * gridDim.z;
    unsigned sum, cnt, mine, sp = 0u;
    for (;;) {
        sum = 0u; cnt = 0u; mine = 0u;
#pragma unroll
        for (unsigned j = 0; j < 16; ++j) { const unsigned c = xb_ld(&bar[XB_XCNT(j)]); sum += c; cnt += (c > 0u) ? 1u : 0u; mine = (j == x) ? c : mine; }
        if (sum == G) break;
        __builtin_amdgcn_s_sleep(1);
        if ((++sp & 255u) == 0u) { if (xb_ld(&bar[XB_TMO])) break; if (sp > XB_SPIN_CAP) { atomicAdd(&bar[XB_TMO], 1u); break; } }
    }
    nloc = mine > 0u ? mine : 1u; nx = cnt > 0u ? cnt : 1u;
}
__device__ __forceinline__ void xcd_barrier(const XcdBarrier& b, int wave_) {
    asm volatile("s_waitcnt vmcnt(0)" ::: "memory");
    __syncthreads();
    int tl_ = wave_ * 64 + fresh_lane();
    if (tl_ == 0) {
        unsigned* bar = b.bar;
        __builtin_amdgcn_s_waitcnt(0);
        unsigned nloc = b.st[0], nx = b.st[1];
        if (nloc == 0u) { xcd_barrier_complete(bar, b.x, nloc, nx); b.st[0] = nloc; b.st[1] = nx; }
        const unsigned old = xb_add(&bar[XB_XSUB(b.x)], 1u);
        const unsigned gen = old / nloc;
        if (old + 1u == (gen + 1u) * nloc) {
            __builtin_amdgcn_fence(__ATOMIC_RELEASE, "agent");
            asm volatile("s_waitcnt vmcnt(0)" ::: "memory");
            const unsigned og = xb_add(&bar[XB_TOP], 1u);
            const unsigned tg = og / nx;
            if (og + 1u == (tg + 1u) * nx) xb_add(&bar[XB_TOPGEN], 1u);
            else XB_SPIN(xb_ld(&bar[XB_TOPGEN]) == tg, bar);
            __builtin_amdgcn_fence(__ATOMIC_ACQUIRE, "agent");
            xb_add(&bar[XB_XGEN(b.x)], 1u);
            asm volatile("s_waitcnt vmcnt(0)" ::: "memory");
        } else {
            XB_SPIN(xb_ld(&bar[XB_XGEN(b.x)]) == gen, bar);
            __builtin_amdgcn_fence(__ATOMIC_ACQUIRE, "agent");
            asm volatile("s_waitcnt vmcnt(0)" ::: "memory");
        }
    }
    __syncthreads();
}

struct Args { const void* in[22]; float* out; unsigned char* ws; };
struct Frame {
    LAS unsigned char* lds; volatile LAS unsigned* MISC; unsigned* ctl;
    int tid, lane, wave, gw; static constexpr int G = 256;
};
__device__ __forceinline__ void glds16(const void* g, LAS void* l) { __builtin_amdgcn_global_load_lds((const unsigned*)g, (LAS unsigned*)l, 16, 0, 0); }
__device__ __forceinline__ int mbcnt64(u64 m) { return (int)__builtin_amdgcn_mbcnt_hi((unsigned)(m >> 32), __builtin_amdgcn_mbcnt_lo((unsigned)m, 0u)); }

__device__ __forceinline__ int il64(int d) { return d < 32 ? 2 * d : 2 * (d - 32) + 1; }
__device__ __forceinline__ int il32(int d) { return d < 16 ? 2 * d : (d < 32 ? 2 * (d - 16) + 1 : d); }
__device__ __forceinline__ int map_row(int mode, int n) {
    if (mode == 1) return n < 2304 ? (n & ~63) + il64(n & 63) : n;
    if (mode == 2) return ((n >> 7) << 8) + (n & 127);
    if (mode == 3) return ((n >> 7) << 8) + 128 + (n & 127);
    if (mode == 4) {
        if (n < 3072) { const int h = n / 192, r = n - h * 192; return r < 128 ? h * 128 + r : 2048 + h * 64 + il64(r - 128); }
        if (n < 3584) return n;
        if (n < 3648) return 3584 + il64(n - 3584);
        if (n < 4672) { const int j = n - 3648; return 3840 + (j & ~63) + il32(j & 63); }
        if (n < 4736) return 3648 + il32(n - 4672);
        return 3712 + (n - 4736);
    }
    return n;
}
__device__ __forceinline__ void tr_item(const float* __restrict__ W, int N, bf16_t* WT, int ldo, int kofs, int mode, LAS float* scr, int item, int lane, float f8scale = 0.f, int rlo = 0, int rhi = 1 << 30) {
    const int nblk = (N + 63) >> 6, kb = item / nblk, nb = item - kb * nblk, k0 = 64 * kb, n0 = 64 * nb;
    const int nc = n0 + 4 * (lane & 15); const bool okr = nc < N; const float* wp = W + (size_t)(k0 + (lane >> 4)) * N + nc;
    f32x4 v[16];
#pragma unroll
    for (int i = 0; i < 16; ++i) v[i] = okr ? *(const f32x4*)(wp + (size_t)(4 * i) * N) : (f32x4){0.f, 0.f, 0.f, 0.f};
#pragma unroll
    for (int i = 0; i < 16; ++i) { const int k = 4 * i + (lane >> 4); *(LAS f32x4*)(scr + k * 64 + ((4 * (lane & 15) + 4 * (i >> 1)) & 63)) = v[i]; }
    LDS_WAIT();
    const int c = lane & 7;
#pragma unroll
    for (int j = 0; j < 8; ++j) { const int nl = (lane >> 3) + 8 * j, n = n0 + nl; const LAS float* s = scr + (8 * c) * 64 + ((nl + 4 * c) & 63);
        const int orow = map_row(mode, n); const bool okw = n < N && orow >= rlo && orow < rhi;
        if (f8scale > 0.f) { u32x2 o8; o8.x = pk4_fp8(s[0 * 64] * f8scale, s[1 * 64] * f8scale, s[2 * 64] * f8scale, s[3 * 64] * f8scale); o8.y = pk4_fp8(s[4 * 64] * f8scale, s[5 * 64] * f8scale, s[6 * 64] * f8scale, s[7 * 64] * f8scale);
            if (okw) *(u32x2*)((unsigned char*)WT + (size_t)orow * ldo + kofs + k0 + 8 * c) = o8; }
        else {
        u32x4 o; o.x = cvt_pk_bf16(s[0 * 64], s[1 * 64]); o.y = cvt_pk_bf16(s[2 * 64], s[3 * 64]); o.z = cvt_pk_bf16(s[4 * 64], s[5 * 64]); o.w = cvt_pk_bf16(s[6 * 64], s[7 * 64]);
        if (okw) *(u32x4*)(WT + (size_t)orow * ldo + kofs + k0 + 8 * c) = o; } }
    LDS_WAIT();
}
__device__ __forceinline__ void tr_matrix(const Frame& F, const float* W, int K, int N, bf16_t* WT, int ldo, int kofs, int mode, float f8scale = 0.f, int rlo = 0, int rhi = 1 << 30) {
    LAS float* scr = (LAS float*)(F.lds + F.wave * 16384);
    const int nitems = (K >> 6) * ((N + 63) >> 6), NGW = F.G * NWAVES;
    for (int it = F.gw; it < nitems; it += NGW) tr_item(W, N, WT, ldo, kofs, mode, scr, it, F.lane, f8scale, rlo, rhi);
}
__device__ __forceinline__ void cvt_linear(const Frame& F, const float* src, bf16_t* dst, size_t n8) {
    const size_t NT = (size_t)F.G * NTHREADS;
    for (size_t i = (size_t)blockIdx.x * NTHREADS + F.tid; i < n8; i += NT) { const f32x4 a = *(const f32x4*)(src + i * 8), b = *(const f32x4*)(src + i * 8 + 4); *(u32x4*)(dst + i * 8) = pg8::pack8(a, b); }
}
__device__ __forceinline__ void cvt_linear8(const Frame& F, const float* src, unsigned char* dst, size_t n8) {
    const size_t NT = (size_t)F.G * NTHREADS;
    for (size_t i = (size_t)blockIdx.x * NTHREADS + F.tid; i < n8; i += NT) { const f32x4 a = *(const f32x4*)(src + i * 8), b = *(const f32x4*)(src + i * 8 + 4); *(u32x2*)(dst + i * 8) = pg8::pack8_fp8(a, b, 1.0f); }
}
__device__ __forceinline__ void sincos_d(double ang, float& c, float& s) {
    const double n = __builtin_rint(ang * 0.6366197723675814);
    double r = __builtin_fma(-n, 1.5707963267948966, ang); r = __builtin_fma(-n, 6.123233995736766e-17, r);
    const double r2 = r * r;
    const double sp = r * (1.0 + r2 * (-1.0 / 6.0 + r2 * (1.0 / 120.0 + r2 * (-1.0 / 5040.0 + r2 * (1.0 / 362880.0 + r2 * (-1.0 / 39916800.0 + r2 * (1.0 / 6227020800.0)))))));
    const double cp = 1.0 + r2 * (-0.5 + r2 * (1.0 / 24.0 + r2 * (-1.0 / 720.0 + r2 * (1.0 / 40320.0 + r2 * (-1.0 / 3628800.0 + r2 * (1.0 / 479001600.0 + r2 * (-1.0 / 87178291200.0)))))));
    const int q = (int)((long long)n & 3);
    const float sf = (float)sp, cf = (float)cp;
    c = q == 0 ? cf : (q == 1 ? -sf : (q == 2 ? -cf : sf));
    s = q == 0 ? sf : (q == 1 ? cf : (q == 2 ? -sf : -cf));
}
__device__ __forceinline__ void rope_tables(const Frame& F, const int* pos, float* tab64, float* tab32) {
    const int NT = F.G * NTHREADS;
    for (int i = blockIdx.x * NTHREADS + F.tid; i < T * 48; i += NT) {
        const int t = i / 48, f = i - t * 48; const bool is64 = f < 32; const int fi = is64 ? f : f - 32;
        const double base = is64 ? 0.7498942093324559 : 0.5623413251903491;
        double inv = 1.0; for (int k = 0; k < fi; ++k) inv *= base;
        float c, s; sincos_d((double)pos[t] * inv, c, s);
        float* o = is64 ? tab64 + ((size_t)t * 32 + fi) * 2 : tab32 + ((size_t)t * 16 + fi) * 2; o[0] = c; o[1] = s;
    }
}

constexpr int MOE_CONV_ITEMS = 8 * 3 * 3584;
constexpr int TOPK_CONV = 11;
__device__ __forceinline__ void moe_conv_item(const float* w1, const float* w3, const float* w2, unsigned char* ws, LAS float* scr, int it, int lane) {
    const int e = it / (3 * 3584), r = it - e * (3 * 3584), mtx = r / 3584, sub = r - mtx * 3584;
    if (mtx < 2) tr_item((mtx == 0 ? w1 : w3) + (size_t)e * DM * MFFN, MFFN, (bf16_t*)(ws + WS_MW13 + (size_t)e * 2 * MFFN * DM), DM, 0, 2 + mtx, scr, sub, lane, W13_F8SCALE);
    else tr_item(w2 + (size_t)e * MFFN * DM, DM, (bf16_t*)(ws + WS_MW2 + (size_t)e * DM * MFFN), MFFN, 0, 0, scr, sub, lane, W2_F8SCALE);
}

__device__ __forceinline__ unsigned ln_col(int lane, int q) { return 8u * (unsigned)(lane & 63) + 512u * (unsigned)(q >> 1) + 4u * (unsigned)(q & 1); }
__device__ __forceinline__ void ln_load16(f32x4 (&v)[8], const bf16_t* row, int lane) {
#pragma unroll
    for (int j = 0; j < 4; ++j) pg8::unpack8(*(const u32x4*)(row + ln_col(lane, 2 * j)), v[2 * j], v[2 * j + 1]);
}
__device__ __forceinline__ void ln_store16(const f32x4 (&v)[8], bf16_t* row, int lane) {
#pragma unroll
    for (int j = 0; j < 4; ++j) *(u32x4*)(row + ln_col(lane, 2 * j)) = pg8::pack8(v[2 * j], v[2 * j + 1]);
}
__device__ __forceinline__ void ln_store8(const f32x4 (&v)[8], unsigned char* row, int lane) {
#pragma unroll
    for (int j = 0; j < 4; ++j) *(u32x2*)(row + ln_col(lane, 2 * j)) = pg8::pack8_fp8(v[2 * j], v[2 * j + 1], 1.0f);
}
__device__ __forceinline__ void ln_core(f32x4 (&v)[8], const float* g, const float* bb, int lane) {
    float s = 0.f;
#pragma unroll
    for (int j = 0; j < 8; ++j) s += (v[j][0] + v[j][1]) + (v[j][2] + v[j][3]);
    const float mean = wave_sum(s) * (1.0f / DM); float s2 = 0.f;
#pragma unroll
    for (int j = 0; j < 8; ++j) { v[j] = v[j] - mean; s2 += (v[j][0] * v[j][0] + v[j][1] * v[j][1]) + (v[j][2] * v[j][2] + v[j][3] * v[j][3]); }
    const float rstd = 1.0f / sqrtf(wave_sum(s2) * (1.0f / DM) + LN_EPS);
    int l2 = lane; asm volatile("" : "+v"(l2) :: "memory");
#pragma unroll
    for (int j = 0; j < 8; ++j) { const f32x4 gv = *(const f32x4*)(g + ln_col(l2, j)), bv = *(const f32x4*)(bb + ln_col(l2, j)); v[j] = v[j] * rstd * gv + bv; }
}
template <bool OUT8> __device__ __forceinline__ void ln_phase(const Frame& F, const bf16_t* YH, bf16_t* X16, unsigned char* X8, const float* g, const float* bb) {
    const int NGW = F.G * NWAVES;
    for (int m = F.gw; m < T; m += NGW) { f32x4 v[8];
        ln_load16(v, YH + (size_t)m * DM, F.lane); ln_core(v, g, bb, F.lane); ln_store16(v, X16 + (size_t)m * DM, F.lane);
        if constexpr (OUT8) ln_store8(v, X8 + (size_t)m * DM, F.lane); }
}

__device__ __forceinline__ int crow(int r, int hi) { return (r & 3) + 8 * (r >> 2) + 4 * hi; }
template <bool OUT8> __device__ __forceinline__ void swa_phase(const Frame& F, bf16_t* Q, const bf16_t* Kb, const bf16_t* VT, const float* sinks, unsigned char* O8) {
    const int lane = F.lane, l31 = lane & 31, hf = lane >> 5;
    for (int wi = blockIdx.x; wi < 4096; wi += F.G) {
        const int kvh = wi & 3, qsi = (wi >> 2) & 511, b = wi >> 11, h = kvh * 8 + F.wave, q0 = qsi * 32;
        const size_t row0 = (size_t)b * SEQ + q0;
        bf16x8 qf[4];
#pragma unroll
        for (int kk = 0; kk < 4; ++kk) { if constexpr (SWA_FRAG) qf[kk] = *(const bf16x8*)(Q + ((((size_t)(b * 32 + h) * 512 + qsi) * 4 + kk) * 64 + lane) * 8);
            else qf[kk] = *(const bf16x8*)(Q + (row0 + l31) * 2048 + h * 64 + 16 * kk + 8 * hf); }
        f32x16 sc[5];
#pragma unroll
        for (int kt = 0; kt < 5; ++kt) {
            int kpos = q0 - 128 + 32 * kt + l31; kpos = kpos < 0 ? 0 : kpos;
            const bf16_t* kp = Kb + ((size_t)b * SEQ + kpos) * 256 + kvh * 64 + 8 * hf;
            f32x16 a;
#pragma unroll
            for (int r = 0; r < 16; ++r) a[r] = 0.f;
            const int kblk = qsi - 4 + kt < 0 ? 0 : qsi - 4 + kt;
#pragma unroll
            for (int kk = 0; kk < 4; ++kk) { bf16x8 kf; if constexpr (SWA_FRAG) kf = *(const bf16x8*)(Kb + ((((size_t)(b * 4 + kvh) * 512 + kblk) * 4 + kk) * 64 + lane) * 8); else kf = *(const bf16x8*)(kp + 16 * kk);
                a = __builtin_amdgcn_mfma_f32_32x32x16_bf16(kf, qf[kk], a, 0, 0, 0); }
            sc[kt] = a;
        }
        const float sink2 = sinks[h] * LOG2E; const int qpos = q0 + l31;
        float mx = sink2;
#pragma unroll
        for (int kt = 0; kt < 5; ++kt)
#pragma unroll
            for (int r = 0; r < 16; ++r) { const int kpos = q0 - 128 + 32 * kt + crow(r, hf); const bool ok = kpos >= 0 && kpos <= qpos && (qpos - kpos) < 128;
                const float v = ok ? sc[kt][r] : -INFINITY; sc[kt][r] = v; mx = fmaxf(mx, v); }
        mx = fmaxf(mx, shx(mx, 32, lane));
        float sum = 0.f;
#pragma unroll
        for (int kt = 0; kt < 5; ++kt)
#pragma unroll
            for (int r = 0; r < 16; ++r) { const float p = __builtin_amdgcn_exp2f(sc[kt][r] - mx); sc[kt][r] = p; sum += p; }
        sum += shx(sum, 32, lane);
        const float inv = 1.0f / (sum + __builtin_amdgcn_exp2f(sink2 - mx));
        f32x16 o[2];
#pragma unroll
        for (int r = 0; r < 16; ++r) { o[0][r] = 0.f; o[1][r] = 0.f; }
#pragma unroll
        for (int kt = 0; kt < 5; ++kt)
#pragma unroll
            for (int c = 0; c < 2; ++c) {
                bf16x8 pb; { u32x4 w; w.x = cvt_pk_bf16(sc[kt][8 * c + 0], sc[kt][8 * c + 1]); w.y = cvt_pk_bf16(sc[kt][8 * c + 2], sc[kt][8 * c + 3]); w.z = cvt_pk_bf16(sc[kt][8 * c + 4], sc[kt][8 * c + 5]); w.w = cvt_pk_bf16(sc[kt][8 * c + 6], sc[kt][8 * c + 7]); pb = __builtin_bit_cast(bf16x8, w); }
                int kb = q0 - 128 + 32 * kt + 16 * c + 4 * hf; int kb0 = kb < 0 ? 0 : kb, kb1 = kb + 8 < 0 ? 0 : kb + 8;
#pragma unroll
                for (int mt = 0; mt < 2; ++mt) { bf16x8 va;
                    if constexpr (SWA_FRAG) { const int vblk = qsi - 4 + kt < 0 ? 0 : qsi - 4 + kt; va = *(const bf16x8*)(VT + (((((size_t)(b * 4 + kvh) * 512 + vblk) * 2 + c) * 2 + mt) * 64 + lane) * 8); }
                    else { const bf16_t* vp = VT + ((size_t)(b * 4 + kvh) * 64 + 32 * mt + l31) * SEQ;
                    const u32x2 v0 = *(const u32x2*)(vp + kb0), v1 = *(const u32x2*)(vp + kb1); u32x4 w; w.x = v0.x; w.y = v0.y; w.z = v1.x; w.w = v1.y; va = __builtin_bit_cast(bf16x8, w); }
                    o[mt] = __builtin_amdgcn_mfma_f32_32x32x16_bf16(va, pb, o[mt], 0, 0, 0); }
            }
        bf16_t* op = Q + (row0 + l31) * 2048 + h * 64; unsigned char* op8 = O8 + (row0 + l31) * 2048 + h * 64; const float inv8 = inv * O0_F8SCALE;
#pragma unroll
        for (int mt = 0; mt < 2; ++mt)
#pragma unroll
            for (int r4 = 0; r4 < 4; ++r4) {
                if constexpr (OUT8) *(unsigned*)(op8 + 32 * mt + 8 * r4 + 4 * hf) = pk4_fp8(o[mt][4 * r4] * inv8, o[mt][4 * r4 + 1] * inv8, o[mt][4 * r4 + 2] * inv8, o[mt][4 * r4 + 3] * inv8);
                else { u32x2 w; w.x = cvt_pk_bf16(o[mt][4 * r4] * inv, o[mt][4 * r4 + 1] * inv); w.y = cvt_pk_bf16(o[mt][4 * r4 + 2] * inv, o[mt][4 * r4 + 3] * inv);
                *(u32x2*)(op + 32 * mt + 8 * r4 + 4 * hf) = w; } }
    }
}

__device__ __forceinline__ void kvnorm_phase(const Frame& F, const float* CRAW, const float* gk, bf16_t* KV) {
    const int NGW = F.G * NWAVES;
    for (int m = F.gw; m < T; m += NGW) { const float* cr = CRAW + (size_t)m * 512;
        const f32x4 a = *(const f32x4*)(cr + 4 * F.lane), b = *(const f32x4*)(cr + 256 + 4 * F.lane);
        float s = (a[0] * a[0] + a[1] * a[1]) + (a[2] * a[2] + a[3] * a[3]) + (b[0] * b[0] + b[1] * b[1]) + (b[2] * b[2] + b[3] * b[3]);
        const float r = 1.0f / sqrtf(wave_sum(s) * (1.0f / 512.0f) + RMS_EPS);
        const f32x4 ga = *(const f32x4*)(gk + 4 * F.lane), gb = *(const f32x4*)(gk + 256 + 4 * F.lane);
        if constexpr (F8_KV) { const float r8 = r * KV_F8SCALE; unsigned char* kp = (unsigned char*)KV + (size_t)m * 576 + 4 * F.lane;
            *(unsigned*)kp = pk4_fp8(a[0] * r8 * ga[0], a[1] * r8 * ga[1], a[2] * r8 * ga[2], a[3] * r8 * ga[3]);
            *(unsigned*)(kp + 256) = pk4_fp8(b[0] * r8 * gb[0], b[1] * r8 * gb[1], b[2] * r8 * gb[2], b[3] * r8 * gb[3]); continue; }
        u32x2 w0, w1; w0.x = cvt_pk_bf16(a[0] * r * ga[0], a[1] * r * ga[1]); w0.y = cvt_pk_bf16(a[2] * r * ga[2], a[3] * r * ga[3]);
        w1.x = cvt_pk_bf16(b[0] * r * gb[0], b[1] * r * gb[1]); w1.y = cvt_pk_bf16(b[2] * r * gb[2], b[3] * r * gb[3]);
        *(u32x2*)(KV + (size_t)m * 576 + 4 * F.lane) = w0; *(u32x2*)(KV + (size_t)m * 576 + 256 + 4 * F.lane) = w1; }
}

__device__ __forceinline__ float relu1(float a) { return __builtin_amdgcn_fmed3f(a, 0.f, 3.0e38f); }
__device__ __forceinline__ unsigned f2key(float f) { const unsigned u = __float_as_uint(f); return u ^ ((unsigned)((int)u >> 31) | 0x80000000u); }
__device__ __forceinline__ float key2f(unsigned k) { const unsigned u = (k & 0x80000000u) ? (k ^ 0x80000000u) : ~k; return __uint_as_float(u); }
__device__ __forceinline__ unsigned compact256(LAS u64* buf, int n, int lane) {
    u64 e[8];
#pragma unroll
    for (int i = 0; i < 8; ++i) e[i] = (lane + 64 * i < n) ? buf[lane + 64 * i] : 0ull;
    unsigned thr = 0u;
    for (int bit = 31; bit >= 0; --bit) {
        const unsigned cand = thr | (1u << bit); int c = 0;
#pragma unroll
        for (int i = 0; i < 8; ++i) c += __popcll(__ballot((unsigned)(e[i] >> 32) >= cand));
        if (c >= 256) thr = cand;
    }
    int ngt = 0;
#pragma unroll
    for (int i = 0; i < 8; ++i) ngt += __popcll(__ballot((unsigned)(e[i] >> 32) > thr));
    int pos_gt = 0, pos_eq = ngt;
#pragma unroll
    for (int i = 0; i < 8; ++i) { const unsigned k = (unsigned)(e[i] >> 32); const bool gt = k > thr, eq = k == thr; const u64 mg = __ballot(gt), me = __ballot(eq);
        if (gt) buf[pos_gt + mbcnt64(mg)] = e[i];
        const int re = pos_eq + mbcnt64(me); if (eq && re < 256) buf[re] = e[i];
        pos_gt += __popcll(mg); pos_eq += __popcll(me); }
    return thr;
}
__device__ __forceinline__ unsigned compact_bound(LAS u64* buf, int n, int lane, unsigned lo, int& n_out) {
    u64 e[8]; unsigned mx = 0u;
#pragma unroll
    for (int i = 0; i < 8; ++i) { e[i] = (lane + 64 * i < n) ? buf[lane + 64 * i] : 0ull; const unsigned k = (unsigned)(e[i] >> 32); mx = k > mx ? k : mx; }
#pragma unroll
    for (int o = 1; o < 64; o <<= 1) { const unsigned t = (unsigned)__builtin_amdgcn_ds_bpermute((lane ^ o) << 2, (int)mx); mx = t > mx ? t : mx; }
    mx = (unsigned)__builtin_amdgcn_readfirstlane((int)mx);
    const unsigned diff = mx ^ lo; const int hb = diff ? 31 - __builtin_clz(diff) : 0;
    unsigned thr = hb >= 31 ? 0u : (lo & ~((2u << hb) - 1u)); int cge = n;
    for (int bit = hb; bit >= 0; --bit) {
        const unsigned cand = thr | (1u << bit); int c = 0;
#pragma unroll
        for (int i = 0; i < 8; ++i) c += __popcll(__ballot((unsigned)(e[i] >> 32) >= cand));
        if (c >= 256) { thr = cand; cge = c; if (c <= 288) break; }
    }
    int pos = 0;
#pragma unroll
    for (int i = 0; i < 8; ++i) { const bool ge = (unsigned)(e[i] >> 32) >= thr && (lane + 64 * i < n); const u64 mg = __ballot(ge);
        if (ge) buf[pos + mbcnt64(mg)] = e[i];
        pos += __popcll(mg); }
    n_out = pos;
    return thr;
}
template <bool CONV = false> __device__ __forceinline__ void topk_phase(const Frame& F, const bf16_t* QI, const bf16_t* KIF, const float* WI, unsigned short* SEL) {
    const int lane = F.lane, l31 = lane & 31, hf = lane >> 5, wave = F.wave;
    LAS u64* mybuf = (LAS u64*)F.lds + (size_t)(wave * 4) * 512;
    const unsigned lmask_lt = (1u << l31) - 1u; const int hfm = -hf;
    for (int pu = blockIdx.x; pu < 512; pu += F.G) {
        const int b = pu >> 8, pi = pu & 255;
        for (int half = 0; half < 2; ++half) {
            const int tq = half == 0 ? pi : 511 - pi, q0 = tq * 32, nsteps = tq + 1;
            const size_t trow0 = (size_t)b * SEQ + q0 + 4 * wave;
            bf16x8 aq[2][4]; float wq[2][16];
#pragma unroll
            for (int s = 0; s < 2; ++s) {
                const int qq = 2 * s + ((l31 >> 2) & 1), hd = 4 * (l31 >> 3) + (l31 & 3);
#pragma unroll
                for (int kk = 0; kk < 4; ++kk) aq[s][kk] = *(const bf16x8*)(QI + ((trow0 + qq) * 16 + hd) * 64 + 16 * kk + 8 * hf);
                const float* wp = WI + (trow0 + 2 * s + hf) * 16;
#pragma unroll
                for (int r4 = 0; r4 < 4; ++r4) { const f32x4 w = *(const f32x4*)(wp + 4 * r4); wq[s][4 * r4] = w[0]; wq[s][4 * r4 + 1] = w[1]; wq[s][4 * r4 + 2] = w[2]; wq[s][4 * r4 + 3] = w[3]; }
            }
            float psc0 = 0.f, psc1 = 0.f; int pix0 = 0, pix1 = 0; bool pv0 = false, pv1 = false;
            float thr0 = -INFINITY, thr1 = -INFINITY; int c0 = 0, c1 = 0, c2 = 0, c3 = 0; unsigned b0 = 0x007fffffu, b1 = 0x007fffffu, b2 = 0x007fffffu, b3 = 0x007fffffu;
            const bf16_t* kbase = KIF + (size_t)b * 512 * 4 * 64 * 8 + (size_t)lane * 8;
            bf16x8 k0[4], k1[4], k2[4], k3[4];
#pragma unroll
            for (int kk = 0; kk < 4; ++kk) { k0[kk] = *(const bf16x8*)(kbase + (size_t)(0 * 4 + kk) * 512); k1[kk] = *(const bf16x8*)(kbase + (size_t)((nsteps > 1 ? 1 : 0) * 4 + kk) * 512);
                k2[kk] = *(const bf16x8*)(kbase + (size_t)((nsteps > 2 ? 2 : nsteps - 1) * 4 + kk) * 512); k3[kk] = *(const bf16x8*)(kbase + (size_t)((nsteps > 3 ? 3 : nsteps - 1) * 4 + kk) * 512); }
#define TOPK_STEP(KB, STEP) { const int kidx = 32 * (STEP) + l31; \
    f32x16 a0_, a1_; _Pragma("unroll") for (int r = 0; r < 16; ++r) { a0_[r] = 0.f; a1_[r] = 0.f; } \
    _Pragma("unroll") for (int kk = 0; kk < 4; ++kk) a0_ = __builtin_amdgcn_mfma_f32_32x32x16_bf16(aq[0][kk], KB[kk], a0_, 0, 0, 0); \
    _Pragma("unroll") for (int kk = 0; kk < 4; ++kk) a1_ = __builtin_amdgcn_mfma_f32_32x32x16_bf16(aq[1][kk], KB[kk], a1_, 0, 0, 0); \
    { const int sn_ = (STEP) + 4 < nsteps ? (STEP) + 4 : nsteps - 1; _Pragma("unroll") for (int kk = 0; kk < 4; ++kk) KB[kk] = *(const bf16x8*)(kbase + (size_t)(sn_ * 4 + kk) * 512); }     \
    float sc0_ = 0.f, sc1_ = 0.f; \
    _Pragma("unroll") for (int r = 0; r < 16; ++r) sc0_ = fmaf(wq[0][r], relu1(a0_[r]), sc0_); \
    _Pragma("unroll") for (int r = 0; r < 16; ++r) sc1_ = fmaf(wq[1][r], relu1(a1_[r]), sc1_); \
    const int tql0_ = q0 + 4 * wave + hf; \
    const bool pass0_ = (sc0_ > thr0) && (kidx <= tql0_), pass1_ = (sc1_ > thr1) && (kidx <= tql0_ + 2); \
      \
    if (__ballot((pass0_ && pv0) || (pass1_ && pv1))) { TOPK_FLUSH(); } \
    psc0 = pass0_ ? sc0_ : psc0; pix0 = pass0_ ? kidx : pix0; pv0 = pv0 || pass0_; \
    psc1 = pass1_ ? sc1_ : psc1; pix1 = pass1_ ? kidx : pix1; pv1 = pv1 || pass1_; }
#define TOPK_FLUSH() { const u64 mask0_ = __ballot(pv0), mask1_ = __ballot(pv1); \
        if (mask0_) { const unsigned lo = (unsigned)mask0_, hi = (unsigned)(mask0_ >> 32); const int plo = __popc(lo), phi = __popc(hi); \
          const int rank = mbcnt64(mask0_) - (plo & hfm); const int cm = c0 + ((c1 - c0) & hfm); \
          if (pv0) mybuf[hf * 512 + cm + rank] = ((u64)f2key(psc0) << 32) | (unsigned)pix0; c0 += plo; c1 += phi; } \
        if (mask1_) { const unsigned lo = (unsigned)mask1_, hi = (unsigned)(mask1_ >> 32); const int plo = __popc(lo), phi = __popc(hi); \
          const int rank = mbcnt64(mask1_) - (plo & hfm); const int cm = c2 + ((c3 - c2) & hfm); \
          if (pv1) mybuf[(2 + hf) * 512 + cm + rank] = ((u64)f2key(psc1) << 32) | (unsigned)pix1; c2 += plo; c3 += phi; } \
        pv0 = false; pv1 = false; \
        const int cmx_ = max(max(c0, c1), max(c2, c3)); \
        if (cmx_ > 480) { \
        if (c0 > 480) { b0 = compact_bound(mybuf, c0, lane, b0, c0); const float nt = key2f(b0); thr0 = hf == 0 ? nt : thr0; } \
        if (c1 > 480) { b1 = compact_bound(mybuf + 512, c1, lane, b1, c1); const float nt = key2f(b1); thr0 = hf == 1 ? nt : thr0; } \
        if (c2 > 480) { b2 = compact_bound(mybuf + 1024, c2, lane, b2, c2); const float nt = key2f(b2); thr1 = hf == 0 ? nt : thr1; } \
        if (c3 > 480) { b3 = compact_bound(mybuf + 1536, c3, lane, b3, c3); const float nt = key2f(b3); thr1 = hf == 1 ? nt : thr1; } } }
            for (int st = 0; st < nsteps; st += 4) {
                TOPK_STEP(k0, st);
                if (st + 1 < nsteps) TOPK_STEP(k1, st + 1);
                if (st + 2 < nsteps) TOPK_STEP(k2, st + 2);
                if (st + 3 < nsteps) TOPK_STEP(k3, st + 3);
            }
            TOPK_FLUSH();
#undef TOPK_STEP
#undef TOPK_FLUSH
#pragma unroll
            for (int qi = 0; qi < 4; ++qi) {
                int c = qi == 0 ? c0 : (qi == 1 ? c1 : (qi == 2 ? c2 : c3)); LAS u64* bq = mybuf + qi * 512;
                if (c > 256) { (void)compact256(bq, c, lane); c = 256; }
                LDS_WAIT();
                unsigned short v[4];
#pragma unroll
                for (int j = 0; j < 4; ++j) { const int e = 4 * lane + j; v[j] = e < c ? (unsigned short)(bq[e] & 0xffffull) : (unsigned short)0xffff; }
                u32x2 w; w.x = (unsigned)v[0] | ((unsigned)v[1] << 16); w.y = (unsigned)v[2] | ((unsigned)v[3] << 16);
                *(u32x2*)(SEL + (trow0 + qi) * 256 + 4 * lane) = w;
            }
            LDS_WAIT();
            if constexpr (CONV) { int lane2 = F.lane; asm volatile("" : "+v"(lane2)); const int NGW = F.G * NWAVES, iter = 2 * ((pu - (int)blockIdx.x) / F.G) + half;
                typedef const unsigned char __attribute__((address_space(4))) kab_t;
                kab_t* ka = (kab_t*)__builtin_amdgcn_kernarg_segment_ptr();
                const float* w1 = *(const float* const __attribute__((address_space(4)))*)(ka + 15 * 8); const float* w3 = *(const float* const __attribute__((address_space(4)))*)(ka + 16 * 8);
                const float* w2 = *(const float* const __attribute__((address_space(4)))*)(ka + 17 * 8); unsigned char* ws = *(unsigned char* const __attribute__((address_space(4)))*)(ka + 23 * 8);
                for (int k = 0; k < TOPK_CONV; ++k) { const int it = F.gw + NGW * (TOPK_CONV * iter + k); if (it < MOE_CONV_ITEMS) moe_conv_item(w1, w3, w2, ws, (LAS float*)mybuf, it, lane2); } }
        }
    }
}

__device__ __forceinline__ bf16x4 tr_read16(const LAS unsigned char* p) { return __builtin_bit_cast(bf16x4, __builtin_amdgcn_ds_read_tr16_b64_v4i16((LAS bf16x4*)p)); }
__device__ __forceinline__ void dsa_attn_phase(const Frame& F, const bf16_t* QLAT, bf16_t* OUT, const bf16_t* QR, const bf16_t* KV, const unsigned short* SEL, const float* w1, const float* w3, const float* w2, unsigned char* ws) {
    LAS unsigned char* wb = F.lds + F.wave * DSA_WBUF; LAS unsigned char* tails = wb + 16640;
    const unsigned char* KVb = (const unsigned char*)KV;
    const int NGW = F.G * NWAVES;
    for (int tg = F.gw; tg < T; tg += NGW) {
        int lane = F.lane; asm volatile("" : "+v"(lane));
        const int l15 = lane & 15, g = lane >> 4;
        const int b = tg >> 14, t = tg & (SEQ - 1); const int nvalid = t + 1 < 256 ? t + 1 : 256, nsteps = (nvalid + 15) >> 4;
        bf16x8 qf[18];
#pragma unroll
        for (int kk = 0; kk < 16; ++kk) {
            if constexpr (F8_LAT) { const u32x2 w8 = *(const u32x2*)((const unsigned char*)QLAT + ((size_t)tg * 16 + l15) * 512 + 32 * kk + 8 * g);
                const f32x2 f0 = __builtin_amdgcn_cvt_pk_f32_fp8((int)w8.x, false), f1 = __builtin_amdgcn_cvt_pk_f32_fp8((int)w8.x, true), f2 = __builtin_amdgcn_cvt_pk_f32_fp8((int)w8.y, false), f3 = __builtin_amdgcn_cvt_pk_f32_fp8((int)w8.y, true);
                u32x4 wb16; wb16.x = cvt_pk_bf16(f0[0], f0[1]); wb16.y = cvt_pk_bf16(f1[0], f1[1]); wb16.z = cvt_pk_bf16(f2[0], f2[1]); wb16.w = cvt_pk_bf16(f3[0], f3[1]); qf[kk] = __builtin_bit_cast(bf16x8, wb16); }
            else qf[kk] = *(const bf16x8*)(QLAT + ((size_t)tg * 16 + l15) * 512 + 32 * kk + 8 * g); }
#pragma unroll
        for (int kk = 0; kk < 2; ++kk) qf[16 + kk] = *(const bf16x8*)(QR + ((size_t)tg * 16 + l15) * 64 + 32 * kk + 8 * g);
        float m = -INFINITY, lsum = 0.f; f32x4 O[32];
#pragma unroll
        for (int mt = 0; mt < 32; ++mt) O[mt] = (f32x4){0.f, 0.f, 0.f, 0.f};
        for (int st = 0; st < nsteps; ++st) {
            const int slot = 16 * st + l15;
            int idx = slot < nvalid ? (int)SEL[(size_t)tg * 256 + slot] : 0; idx = idx > t ? 0 : idx;
            const int row = b * SEQ + idx;
            LDS_WAIT();
#pragma unroll
            for (int r = 0; r < 16; ++r) { const int rr = __builtin_amdgcn_readlane(row, r); glds16(KVb + (size_t)rr * 1152 + 16 * lane, wb + r * 1040); }
#pragma unroll
            for (int p = 0; p < 2; ++p) glds16(KVb + (size_t)row * 1152 + 1024 + 16 * (4 * p + g), tails + 1024 * p);
            VM_WAIT();
            f32x4 sacc = (f32x4){0.f, 0.f, 0.f, 0.f};
#pragma unroll
            for (int kk = 0; kk < 16; ++kk) { const bf16x8 a = *(const LAS bf16x8*)(wb + l15 * 1040 + (4 * kk + g) * 16); sacc = __builtin_amdgcn_mfma_f32_16x16x32_bf16(a, qf[kk], sacc, 0, 0, 0); }
#pragma unroll
            for (int kk = 0; kk < 2; ++kk) { const bf16x8 a = *(const LAS bf16x8*)(tails + (4 * kk + g) * 256 + l15 * 16); sacc = __builtin_amdgcn_mfma_f32_16x16x32_bf16(a, qf[16 + kk], sacc, 0, 0, 0); }
            float s[4]; float tmax = -INFINITY;
#pragma unroll
            for (int i = 0; i < 4; ++i) { s[i] = (16 * st + 4 * g + i) < nvalid ? sacc[i] * (F8_LAT ? SCALE2_MLA / QLAT_F8SCALE : SCALE2_MLA) : -INFINITY; tmax = fmaxf(tmax, s[i]); }
            tmax = fmaxf(tmax, shx(tmax, 16, lane)); tmax = fmaxf(tmax, shx(tmax, 32, lane));
            const float mnew = fmaxf(m, tmax); const float alpha = __builtin_amdgcn_exp2f(m - mnew); m = mnew;
            float p[4];
#pragma unroll
            for (int i = 0; i < 4; ++i) p[i] = __builtin_amdgcn_exp2f(s[i] - mnew);
            lsum = lsum * alpha + ((p[0] + p[1]) + (p[2] + p[3]));
            if (__any(alpha != 1.0f)) {
#pragma unroll
                for (int mt = 0; mt < 32; ++mt) O[mt] = O[mt] * alpha;
            }
            u32x2 pw; pw.x = cvt_pk_bf16(p[0], p[1]); pw.y = cvt_pk_bf16(p[2], p[3]); const bf16x4 pb = __builtin_bit_cast(bf16x4, pw);
            const LAS unsigned char* trb = wb + (4 * g + (l15 >> 2)) * 1040 + (lane & 3) * 8;
#pragma unroll
            for (int mt = 0; mt < 32; ++mt) { const bf16x4 a = tr_read16(trb + mt * 32); O[mt] = __builtin_amdgcn_mfma_f32_16x16x16bf16_1k(a, pb, O[mt], 0, 0, 0); }
        }
        float lt = lsum + shx(lsum, 16, lane); lt += shx(lt, 32, lane); const float inv = 1.0f / lt;
        if constexpr (F8_LAT) { unsigned char* op8 = (unsigned char*)OUT + ((size_t)tg * 16 + l15) * 512 + 4 * g; const float inv8 = inv * OLAT_F8SCALE;
#pragma unroll
            for (int mt = 0; mt < 32; ++mt) *(unsigned*)(op8 + 16 * mt) = pk4_fp8(O[mt][0] * inv8, O[mt][1] * inv8, O[mt][2] * inv8, O[mt][3] * inv8); }
        else { bf16_t* op = OUT + ((size_t)tg * 16 + l15) * 512 + 4 * g;
#pragma unroll
        for (int mt = 0; mt < 32; ++mt) { u32x2 w; w.x = cvt_pk_bf16(O[mt][0] * inv, O[mt][1] * inv); w.y = cvt_pk_bf16(O[mt][2] * inv, O[mt][3] * inv); *(u32x2*)(op + 16 * mt) = w; } }
        if (w1) { LDS_WAIT(); int lane2 = F.lane; asm volatile("" : "+v"(lane2));
            for (int k = 0; k < 3; ++k) { const int it = F.gw + NGW * (3 * ((tg - F.gw) / NGW) + k); if (it < MOE_CONV_ITEMS) moe_conv_item(w1, w3, w2, ws, (LAS float*)wb, it, lane2); } }
    }
    LDS_WAIT();
}

__device__ __forceinline__ long tr_read8(const LAS unsigned char* p) { return __builtin_bit_cast(long, __builtin_amdgcn_ds_read_tr8_b64_v2i32((LAS i32x2*)p)); }
__device__ __forceinline__ void dsa_attn8_phase(const Frame& F, const unsigned char* QLAT, unsigned char* OUT, const unsigned char* QR, const unsigned char* KVb, const unsigned short* SEL, const float* w1, const float* w3, const float* w2, unsigned char* ws) {
    LAS unsigned char* wb = F.lds + F.wave * DSA_WBUF; LAS unsigned char* tails = wb + 16640;
    const int NGW = F.G * NWAVES;
    for (int tg = F.gw; tg < T; tg += NGW) {
        int lane = F.lane; asm volatile("" : "+v"(lane));
        const int l15 = lane & 15, g = lane >> 4;
        const int b = tg >> 14, t = tg & (SEQ - 1); const int nvalid = t + 1 < 256 ? t + 1 : 256, nsteps = (nvalid + 31) >> 5;
        i32x8 qf[5];
        { const unsigned char* qp = QLAT + ((size_t)tg * 16 + l15) * 512 + 32 * g;
#pragma unroll
          for (int kk = 0; kk < 4; ++kk) { const i32x4 lo = *(const i32x4*)(qp + 128 * kk), hi = *(const i32x4*)(qp + 128 * kk + 16); qf[kk] = (i32x8){lo[0], lo[1], lo[2], lo[3], hi[0], hi[1], hi[2], hi[3]}; }
          const i32x4 r = *(const i32x4*)(QR + ((size_t)tg * 16 + l15) * 64 + 16 * g); qf[4] = (i32x8){r[0], r[1], r[2], r[3], 0, 0, 0, 0}; }
        float m = -INFINITY, lsum = 0.f; f32x4 O[32];
#pragma unroll
        for (int mt = 0; mt < 32; ++mt) O[mt] = (f32x4){0.f, 0.f, 0.f, 0.f};
        const int dtau = (lane >> 2) & 1, dch = 16 * (4 * (lane >> 3) + (lane & 3));
        int s0, s1, s2, s3, s4, s5, s6, s7;
        { const unsigned short* sp = SEL + (size_t)tg * 256 + (lane & 31); const int l31 = lane & 31;
          s0 = l31 < nvalid ? (int)sp[0] : 0; s1 = 32 + l31 < nvalid ? (int)sp[32] : 0; s2 = 64 + l31 < nvalid ? (int)sp[64] : 0; s3 = 96 + l31 < nvalid ? (int)sp[96] : 0;
          s4 = 128 + l31 < nvalid ? (int)sp[128] : 0; s5 = 160 + l31 < nvalid ? (int)sp[160] : 0; s6 = 192 + l31 < nvalid ? (int)sp[192] : 0; s7 = 224 + l31 < nvalid ? (int)sp[224] : 0; }
        for (int st = 0; st < nsteps; ++st) {
            int idx = s0; s0 = s1; s1 = s2; s2 = s3; s3 = s4; s4 = s5; s5 = s6; s6 = s7; idx = idx > t ? 0 : idx;
            const int row = b * SEQ + idx;
            LDS_WAIT();
#pragma unroll
            for (int p = 0; p < 16; ++p) { const int r0 = __builtin_amdgcn_readlane(row, p), r1 = __builtin_amdgcn_readlane(row, 16 + p); const int rr = dtau ? r1 : r0;
                glds16(KVb + (size_t)rr * 576 + dch, wb + p * 1040); }
#pragma unroll
            for (int p = 0; p < 2; ++p) glds16(KVb + (size_t)row * 576 + 512 + 16 * (2 * p + (lane >> 5)), tails + 1024 * p);
            VM_WAIT();
            f32x4 sacc[2] = {(f32x4){0.f, 0.f, 0.f, 0.f}, (f32x4){0.f, 0.f, 0.f, 0.f}};
            const LAS unsigned char* sb = wb + l15 * 1040 + 16 * (8 * (g >> 1) + 2 * (g & 1));
#pragma unroll
            for (int kk = 0; kk < 4; ++kk)
#pragma unroll
                for (int tu = 0; tu < 2; ++tu) { const i32x4 lo = *(const LAS i32x4*)(sb + 256 * kk + 64 * tu), hi = *(const LAS i32x4*)(sb + 256 * kk + 64 * tu + 16);
                    const i32x8 a = (i32x8){lo[0], lo[1], lo[2], lo[3], hi[0], hi[1], hi[2], hi[3]};
                    sacc[tu] = __builtin_amdgcn_mfma_scale_f32_16x16x128_f8f6f4(a, qf[kk], sacc[tu], 0, 0, 0, 0, 0, 0); }
#pragma unroll
            for (int tu = 0; tu < 2; ++tu) { const i32x4 lo = *(const LAS i32x4*)(tails + (g * 32 + 16 * tu + l15) * 16);
                const i32x8 a = (i32x8){lo[0], lo[1], lo[2], lo[3], 0, 0, 0, 0};
                sacc[tu] = __builtin_amdgcn_mfma_scale_f32_16x16x128_f8f6f4(a, qf[4], sacc[tu], 0, 0, 0, 0, 0, 0); }
            float s[8]; float tmax = -INFINITY;
#pragma unroll
            for (int tu = 0; tu < 2; ++tu)
#pragma unroll
                for (int i = 0; i < 4; ++i) { s[4 * tu + i] = (32 * st + 16 * tu + 4 * g + i) < nvalid ? sacc[tu][i] * (SCALE2_MLA / (QLAT_F8SCALE * KV_F8SCALE)) : -INFINITY; tmax = fmaxf(tmax, s[4 * tu + i]); }
            tmax = fmaxf(tmax, shx(tmax, 16, lane)); tmax = fmaxf(tmax, shx(tmax, 32, lane));
            if (__any(tmax > m + 0.75f)) {
                const float mnew = fmaxf(m, tmax); const float alpha = __builtin_amdgcn_exp2f(m - mnew); m = mnew; lsum *= alpha;
#pragma unroll
                for (int mt = 0; mt < 32; ++mt) O[mt] = O[mt] * alpha;
            }
            const float mo = m - 8.0f;
            float p[8];
#pragma unroll
            for (int i = 0; i < 8; ++i) p[i] = __builtin_amdgcn_exp2f(s[i] - mo);
            lsum += (((p[0] + p[1]) + (p[2] + p[3])) + ((p[4] + p[5]) + (p[6] + p[7])));
            u32x2 pw; pw.x = pk4_fp8(p[0], p[1], p[2], p[3]); pw.y = pk4_fp8(p[4], p[5], p[6], p[7]); const long pb = __builtin_bit_cast(long, pw);
            const LAS unsigned char* trb = wb + (4 * g + ((l15 >> 1) & 3)) * 1040 + 64 * (l15 >> 3) + 8 * (l15 & 1);
#pragma unroll
            for (int mt = 0; mt < 32; ++mt) { const long a = tr_read8(trb + 128 * (mt >> 2) + 16 * (mt & 3)); O[mt] = __builtin_amdgcn_mfma_f32_16x16x32_fp8_fp8(a, pb, O[mt], 0, 0, 0); }
        }
        float lt = lsum + shx(lsum, 16, lane); lt += shx(lt, 32, lane); const float inv8 = (OLAT_F8SCALE / KV_F8SCALE) / lt;
        unsigned char* op8 = OUT + ((size_t)tg * 16 + l15) * 512 + 4 * g;
#pragma unroll
        for (int mt = 0; mt < 32; ++mt) *(unsigned*)(op8 + 16 * mt) = pk4_fp8(O[mt][0] * inv8, O[mt][1] * inv8, O[mt][2] * inv8, O[mt][3] * inv8);
        if (w1) { LDS_WAIT(); int lane2 = F.lane; asm volatile("" : "+v"(lane2));
            for (int k = 0; k < 3; ++k) { const int it = F.gw + NGW * (3 * ((tg - F.gw) / NGW) + k); if (it < MOE_CONV_ITEMS) moe_conv_item(w1, w3, w2, ws, (LAS float*)wb, it, lane2); } }
    }
    LDS_WAIT();
}

__device__ __forceinline__ void ln_router_phase(const Frame& F, const bf16_t* YH, bf16_t* XB, const float* g, const float* bb, const float* wr, int* TOKE, float* TOKG, int* TOKL) {
    LAS float* wl = (LAS float*)F.lds;
    for (int i = F.tid; i < DM * NEXP; i += NTHREADS) { const int d = i >> 3, e = i & 7; wl[e * DM + d] = wr[i]; }
    __syncthreads();
    const int NGW = F.G * NWAVES, lane = F.lane;
    u64 cnt64 = 0ull; int mine = 0;
    int j = 0;
    for (int m = F.gw; m < T; m += NGW, ++j) { f32x4 v[8];
        ln_load16(v, YH + (size_t)m * DM, lane); ln_core(v, g, bb, lane); ln_store8(v, (unsigned char*)XB + (size_t)m * DM, lane);
        float lg[8];
#pragma unroll
        for (int e = 0; e < 8; ++e) { float s = 0.f;
#pragma unroll
            for (int q = 0; q < 8; ++q) { const f32x4 w = *(const LAS f32x4*)(wl + e * DM + ln_col(lane, q)); s += (v[q][0] * w[0] + v[q][1] * w[1]) + (v[q][2] * w[2] + v[q][3] * w[3]); }
            lg[e] = wave_sum(s); }
        int e1 = 0; float v1 = lg[0];
#pragma unroll
        for (int e = 1; e < 8; ++e) if (lg[e] > v1) { v1 = lg[e]; e1 = e; }
        int e2 = -1; float v2 = -INFINITY;
#pragma unroll
        for (int e = 0; e < 8; ++e) if (e != e1 && lg[e] > v2) { v2 = lg[e]; e2 = e; }
        const float g1 = 1.0f / (1.0f + __expf(v2 - v1)), g2 = 1.0f - g1;
        const int r1 = (int)((cnt64 >> (8 * e1)) & 0xffull); cnt64 += 1ull << (8 * e1);
        const int r2 = (int)((cnt64 >> (8 * e2)) & 0xffull); cnt64 += 1ull << (8 * e2);
        if (lane == 0) { TOKE[2 * m] = e1; TOKE[2 * m + 1] = e2; TOKG[2 * m] = g1; TOKG[2 * m + 1] = g2; }
        if (lane == j) mine = e1 | (e2 << 4) | (r1 << 8) | (r2 << 16);
    }
    int basev = 0;
    if (lane < 8) { const unsigned c = (unsigned)((cnt64 >> (8 * lane)) & 0xffull); basev = (int)__hip_atomic_fetch_add(F.ctl + CW_CNT + lane, c, __ATOMIC_RELAXED, __HIP_MEMORY_SCOPE_AGENT); }
    const int e1 = mine & 15, e2 = (mine >> 4) & 15, r1 = (mine >> 8) & 255, r2 = (mine >> 16) & 255;
    const int b1 = __builtin_amdgcn_ds_bpermute(e1 << 2, basev), b2 = __builtin_amdgcn_ds_bpermute(e2 << 2, basev);
    if (lane < j) { const int m = F.gw + NGW * lane; TOKL[2 * m] = b1 + r1; TOKL[2 * m + 1] = b2 + r2; }
    __syncthreads();
}
__device__ __forceinline__ void moe_tiles(const Frame& F) {
    if (F.tid == 0) { int acc = 0;
        for (int e = 0; e < 8; ++e) { const unsigned c = __hip_atomic_load(F.ctl + CW_CNT + e, __ATOMIC_RELAXED, __HIP_MEMORY_SCOPE_AGENT); F.MISC[32 + e] = c; F.MISC[40 + e] = (unsigned)acc; acc += (int)((c + 255u) >> 8); F.MISC[20 + e] = (unsigned)acc; }
        F.MISC[28] = (unsigned)acc; }
    __syncthreads();
}
__device__ __forceinline__ void moe_gather_phase(const Frame& F, const bf16_t* XB, const int* TOKE, const float* TOKG, const int* TOKL, int* TOKS, float* SGATE, bf16_t* XG) {
    const int NGW = F.G * NWAVES, lane = F.lane;
    for (int m = F.gw; m < T; m += NGW) {
        const u32x4* src = (const u32x4*)((const unsigned char*)XB + (size_t)m * DM);
        const u32x4 a0 = src[lane], a1 = src[64 + lane];
#pragma unroll
        for (int k = 0; k < 2; ++k) { const int e = TOKE[2 * m + k], li = TOKL[2 * m + k]; const int slot = (int)F.MISC[40 + e] * 256 + li;
            u32x4* dst = (u32x4*)((unsigned char*)XG + (size_t)slot * DM); dst[lane] = a0; dst[64 + lane] = a1;
            if (lane == 0) { TOKS[2 * m + k] = slot; SGATE[slot] = TOKG[2 * m + k]; } }
    }
    for (int it = F.gw; it < 8 * 256; it += NGW) { const int e = it >> 8, r = it & 255; const int c = (int)F.MISC[32 + e]; const int ntile = (c + 255) >> 8; const int row = c + r;
        if (row < ntile * 256) { const int slot = (int)F.MISC[40 + e] * 256 + row; u32x4* dst = (u32x4*)((unsigned char*)XG + (size_t)slot * DM); const u32x4 z = {0u, 0u, 0u, 0u};
            dst[lane] = z; dst[64 + lane] = z; if (lane == 0) SGATE[slot] = 0.f; } }
}
__device__ __forceinline__ void moe_combine_ln_phase(const Frame& F, const bf16_t* YH, bf16_t* XB, const bf16_t* SOUT, const int* TOKS, const float* g1, const float* bb1, const float* g, const float* bb) {
    const int NGW = F.G * NWAVES, lane = F.lane;
    for (int m = F.gw; m < T; m += NGW) { f32x4 v[8];
        const bf16_t* s0 = SOUT + (size_t)TOKS[2 * m] * DM; const bf16_t* s1 = SOUT + (size_t)TOKS[2 * m + 1] * DM;
        ln_load16(v, YH + (size_t)m * DM, lane);
        ln_core(v, g1, bb1, lane);
#pragma unroll
        for (int j = 0; j < 4; ++j) { f32x4 a0, a1, c0, c1; pg8::unpack8(*(const u32x4*)(s0 + ln_col(lane, 2 * j)), a0, a1); pg8::unpack8(*(const u32x4*)(s1 + ln_col(lane, 2 * j)), c0, c1);
            v[2 * j] = v[2 * j] * ALPHA + (a0 + c0); v[2 * j + 1] = v[2 * j + 1] * ALPHA + (a1 + c1); }
        ln_core(v, g, bb, lane); ln_store16(v, XB + (size_t)m * DM, lane); }
}

#ifndef PHASES
#define PHASES 0xFFFFFFFFu
#endif
#define PH(k) if constexpr ((PHASES >> (k)) & 1u)
#ifndef DBL
#define DBL 0u
#endif
#define DB(k) if constexpr ((DBL >> (k)) & 1u)
__global__ void __launch_bounds__(NTHREADS, 2) mega_fwd(Args args) {
    extern __shared__ __attribute__((aligned(16))) unsigned char lds_raw[];
    Frame F;
    F.lds = (LAS unsigned char*)lds_raw; F.MISC = (volatile LAS unsigned*)(F.lds + MISC_OFF);
    F.tid = threadIdx.x; F.lane = F.tid & 63; F.wave = __builtin_amdgcn_readfirstlane(F.tid >> 6); F.gw = blockIdx.x * NWAVES + F.wave;
    unsigned char* ws = args.ws;
    F.ctl = (unsigned*)(ws + WS_CTL);
    if (F.tid < 64) F.MISC[F.tid] = 0u;
    __syncthreads();
    XcdBarrier bar = xcd_barrier_post(F.ctl + CW_BAR, F.MISC + 8);
#define REFRESH() do { F.lane = fresh_lane(); F.tid = F.wave * 64 + F.lane; } while (0)
#define GRID_BAR() do { xcd_barrier(bar, F.wave); REFRESH(); } while (0)
#define YH ((bf16_t*)args.out)
#define bx ((int)blockIdx.x)
#define WSP(T_, off) ((T_*)(ws + (off)))

    PH(0) {
        { LAS float* scr = (LAS float*)(F.lds + F.wave * 16384);
          constexpr int I_QKV = 32 * 40, I_SQ = 32 * 32, I_W13 = 32 * 88, I_W2 = 88 * 32, I_WP = 4 * 32, I_WIN = 32 * 75, I_WUV = 256;
          constexpr int I_TOTAL = I_QKV + I_SQ + 2 * I_W13 + I_W2 + 2 * I_SQ + 2 * I_WP + (F8_WIN_SPLIT ? 2 : 1) * I_WIN + I_SQ + I_WUV;
          for (int it = F.gw; it < I_TOTAL; it += F.G * NWAVES) {
              int r = it; bool hit = false; const float* W = nullptr; int N = 0, ldo = 0, kofs = 0, mode = 0, rlo = 0, rhi = 1 << 30; unsigned char* WT = nullptr; float f8 = 0.f;
#define PSEG(cnt, Wp, Nn, WTp, ld, md, f8v, lo, hi) if (!hit) { if (r < (cnt)) { W = (Wp); N = (Nn); WT = (unsigned char*)(WTp); ldo = (ld); mode = (md); f8 = (f8v); rlo = (lo); rhi = (hi); hit = true; } else r -= (cnt); }
              PSEG(I_QKV, (const float*)args.in[3], NQKV, ws + WS_WQKV, DM, 1, F8_QKV ? WQKV_F8SCALE : 0.f, 0, 1 << 30)
              PSEG(I_SQ, (const float*)args.in[5], DM, ws + WS_WO0, DM, 0, F8_WO0 ? WO_F8SCALE : 0.f, 0, 1 << 30)
              PSEG(I_W13, (const float*)args.in[6], FFN, ws + WS_W13, DM, 2, F8_FFN1 ? W13_F8SCALE : 0.f, 0, 1 << 30)
              PSEG(I_W13, (const float*)args.in[7], FFN, ws + WS_W13, DM, 3, F8_FFN1 ? W13_F8SCALE : 0.f, 0, 1 << 30)
              PSEG(I_W2, (const float*)args.in[8], DM, ws + WS_W2, FFN, 0, F8_FFN2 ? W2_F8SCALE : 0.f, 0, 1 << 30)
              PSEG(I_SQ, (const float*)args.in[21], DM, ws + WS_WG0, DM, 0, 0.f, 0, 1 << 30)
              PSEG(I_SQ, (const float*)args.in[21] + (size_t)DM * DM, DM, ws + WS_WG1, DM, 0, 0.f, 0, 1 << 30)
              PSEG(I_WP, (const float*)args.in[20], DM, ws + WS_WP0, 256, 0, 0.f, 0, 1 << 30)
              PSEG(I_WP, (const float*)args.in[20] + (size_t)256 * DM, DM, ws + WS_WP1, 256, 0, 0.f, 0, 1 << 30)
              if constexpr (F8_WIN_SPLIT) { PSEG(I_WIN, (const float*)args.in[9], 4752, ws + WS_WIN8, DM, 4, WIN_F8SCALE, 0, WIN_F8_TILES * 256)
                                            PSEG(I_WIN, (const float*)args.in[9], 4752, ws + WS_WIN, DM, 4, 0.f, WIN_F8_TILES * 256, NWIN) }
              else { PSEG(I_WIN, (const float*)args.in[9], 4752, ws + WS_WIN, DM, 4, F8_WIN ? WIN_F8SCALE : 0.f, 0, 1 << 30) }
              PSEG(I_SQ, (const float*)args.in[13], DM, ws + WS_WO1, DM, 0, F8_WO1 ? WO_F8SCALE : 0.f, 0, 1 << 30)
              if (!hit) { const int h = r >> 4; r &= 15;
                  W = (const float*)args.in[12] + (size_t)h * 512 * 128; N = 128; WT = ws + WS_WUV + (size_t)h * 128 * 1024 * (F8_LAT ? 1 : 2); ldo = 1024; kofs = 512 * (h & 1); f8 = F8_LAT ? WUV_F8SCALE : 0.f; }
#undef PSEG
              tr_item(W, N, (bf16_t*)WT, ldo, kofs, mode, scr, r, F.lane, f8, rlo, rhi); } }
        { bf16_t* wuv = WSP(bf16_t, WS_WUV); const u32x4 z = {0u, 0u, 0u, 0u};
          for (int i = bx * NTHREADS + F.tid; i < 2048 * 64; i += F.G * NTHREADS) { const int n = i >> 6, c8 = i & 63; const int h = n >> 7;
              if constexpr (F8_LAT) { if (c8 < 32) *(u32x4*)((unsigned char*)wuv + (size_t)n * 1024 + 512 * ((h & 1) ^ 1) + 16 * c8) = z; }
              else *(u32x4*)(wuv + (size_t)n * 1024 + 512 * ((h & 1) ^ 1) + 8 * c8) = z; } }
        cvt_linear(F, (const float*)args.in[11], WSP(bf16_t, WS_WUK), (size_t)16 * 512 * 128 / 8);
        if constexpr (F8_QKV) cvt_linear8(F, (const float*)args.in[0], WSP(unsigned char, WS_XBA), (size_t)T * DM / 8); else cvt_linear(F, (const float*)args.in[0], WSP(bf16_t, WS_XBA), (size_t)T * DM / 8);
        cvt_linear(F, (const float*)args.in[1], WSP(bf16_t, WS_PB), (size_t)2 * T * 256 / 8);
        rope_tables(F, (const int*)args.in[2], WSP(float, WS_TAB64), WSP(float, WS_TAB32));
    }
    GRID_BAR();
    PH(1) {
        constexpr int KD = F8_QKV ? DM / 2 : DM;
        pg8::Gemm g{WSP(bf16_t, WS_XBA), WSP(bf16_t, WS_WQKV), KD, KD, KD}; pg8::GridOrder<0, T / 256, NQKV / 256> S;
        pg8::EpiQKV E{ws, F8_QKV ? 1.0f / WQKV_F8SCALE : 1.0f}; pg8::gemm_phase<pg8::EpiQKV, pg8::GridOrder<0, T / 256, NQKV / 256>, F8_QKV>(F.lds, g, S, E, F.wave);
    }
    GRID_BAR();
    PH(2) swa_phase<F8_WO0>(F, WSP(bf16_t, WS_Q), WSP(bf16_t, WS_K), WSP(bf16_t, WS_VT), (const float*)args.in[4], WSP(unsigned char, WS_O8));
    GRID_BAR();
    PH(3) {
        constexpr int KD = F8_WO0 ? DM / 2 : DM;
        pg8::Gemm g{F8_WO0 ? WSP(bf16_t, WS_O8) : WSP(bf16_t, WS_Q), WSP(bf16_t, WS_WO0), KD, KD, KD}; pg8::GridOrder<0, T / 256, DM / 256> S;
        pg8::EpiRes<false> E{args.in[0], YH, F8_WO0 ? 1.0f / (O0_F8SCALE * WO_F8SCALE) : 1.0f}; pg8::gemm_phase<pg8::EpiRes<false>, pg8::GridOrder<0, T / 256, DM / 256>, F8_WO0, EPI_ALIGN_RES>(F.lds, g, S, E, F.wave);
    }
    GRID_BAR();
    PH(4) ln_phase<F8_FFN1>(F, YH, WSP(bf16_t, WS_XBB), WSP(unsigned char, WS_XBA), (const float*)args.in[18], (const float*)args.in[19]);
    GRID_BAR();
    PH(5) {
        constexpr int KD = F8_FFN1 ? DM / 2 : DM;
        pg8::Gemm g{F8_FFN1 ? WSP(bf16_t, WS_XBA) : WSP(bf16_t, WS_XBB), WSP(bf16_t, WS_W13), KD, KD, KD}; pg8::GridOrder<0, T / 256, 2 * FFN / 256> S;
        pg8::EpiSwiglu<F8_FFN2> E{WSP(bf16_t, WS_ACT), FFN, F8_FFN1 ? 1.0f / W13_F8SCALE : 1.0f, ACT_F8SCALE}; pg8::gemm_phase<pg8::EpiSwiglu<F8_FFN2>, pg8::GridOrder<0, T / 256, 2 * FFN / 256>, F8_FFN1>(F.lds, g, S, E, F.wave);
    }
    GRID_BAR();
    PH(6) {
        constexpr int KD = F8_FFN2 ? FFN / 2 : FFN;
        pg8::Gemm g{WSP(bf16_t, WS_ACT), WSP(bf16_t, WS_W2), KD, KD, KD}; pg8::GridOrder<0, T / 256, DM / 256> S;
        pg8::EpiRes<true> E{WSP(bf16_t, WS_XBB), YH, F8_FFN2 ? 1.0f / (ACT_F8SCALE * W2_F8SCALE) : 1.0f}; pg8::gemm_phase<pg8::EpiRes<true>, pg8::GridOrder<0, T / 256, DM / 256>, F8_FFN2, EPI_ALIGN_RES>(F.lds, g, S, E, F.wave);
    }
    GRID_BAR();
    PH(7) ln_phase<false>(F, YH, WSP(bf16_t, WS_XBA), nullptr, (const float*)args.in[18] + DM, (const float*)args.in[19] + DM);
    REFRESH();
    PH(7) {
        pg8::Gemm g{WSP(bf16_t, WS_PB), WSP(bf16_t, WS_WP0), 256, 256, 256}; pg8::GridOrder<0, T / 256, DM / 256> S;
        pg8::EpiBf16<false> E{WSP(bf16_t, WS_PP0), DM, 1.0f}; pg8::gemm_phase(F.lds, g, S, E, F.wave);
    }
    GRID_BAR();
    PH(8) {
        pg8::Gemm g{WSP(bf16_t, WS_XBA), WSP(bf16_t, WS_WG0), DM, DM, DM}; pg8::GridOrder<0, T / 256, DM / 256> S;
        pg8::EpiPle E{nullptr, ws, 0}; pg8::gemm_phase<pg8::EpiPle, pg8::GridOrder<0, T / 256, DM / 256>, false, EPI_ALIGN_RES>(F.lds, g, S, E, F.wave);
    }
    GRID_BAR();
    PH(9) {
        if constexpr (F8_WIN_SPLIT) {
            { static_assert((T / 256) * WIN_F8_TILES == 7 * pg8::GRID && (T / 256) * (NWIN / 256 - WIN_F8_TILES) == 5 * pg8::GRID / 2, "uneven deal: 7 rounds of e4m3 units, 2.5 rounds of bf16 units");
              pg8::Gemm g{WSP(bf16_t, WS_XB8), WSP(bf16_t, WS_WIN8), DM / 2, DM / 2, DM / 2}; pg8::GridOrder<4, T / 256, WIN_F8_TILES> S;
              pg8::EpiWin E{ws, 1.0f / WIN_F8SCALE, 0}; pg8::gemm_phase<pg8::EpiWin, pg8::GridOrder<4, T / 256, WIN_F8_TILES>, true>(F.lds, g, S, E, F.wave); }
            REFRESH();
            { pg8::Gemm g{WSP(bf16_t, WS_XBB), WSP(bf16_t, WS_WIN) + (size_t)WIN_F8_TILES * 256 * DM, DM, DM, DM}; pg8::GridOrder<0, T / 256, NWIN / 256 - WIN_F8_TILES> S;
              pg8::EpiWin E{ws, 1.0f, WIN_F8_TILES}; pg8::gemm_phase<pg8::EpiWin, pg8::GridOrder<0, T / 256, NWIN / 256 - WIN_F8_TILES>, false>(F.lds, g, S, E, F.wave); }
        } else {
        constexpr int KD = F8_WIN ? DM / 2 : DM;
        pg8::Gemm g{WSP(bf16_t, WS_XBB), WSP(bf16_t, WS_WIN), KD, KD, KD}; pg8::GridOrder<0, T / 256, NWIN / 256> S;
        pg8::EpiWin E{ws, F8_WIN ? 1.0f / WIN_F8SCALE : 1.0f, 0}; pg8::gemm_phase<pg8::EpiWin, pg8::GridOrder<0, T / 256, NWIN / 256>, F8_WIN>(F.lds, g, S, E, F.wave);
        }
    }
    GRID_BAR();
    PH(10) kvnorm_phase(F, WSP(float, WS_CRAW), (const float*)args.in[10], WSP(bf16_t, WS_KV));
    REFRESH();
    PH(11) {
        pg8::Gemm g{WSP(bf16_t, WS_QN), WSP(bf16_t, WS_WUK), DM, 128, 128}; pg8::GridOrder<1, T / 256, 8192 / 256> S;
        pg8::EpiBf16<F8_LAT> E{WSP(bf16_t, WS_QLAT), 8192, F8_LAT ? QLAT_F8SCALE : 1.0f}; pg8::gemm_phase(F.lds, g, S, E, F.wave);
    }
    REFRESH();
    DB(12) { topk_phase(F, WSP(bf16_t, WS_QI), WSP(bf16_t, WS_KIF), WSP(float, WS_WI), WSP(unsigned short, WS_SEL)); REFRESH(); }
    PH(12) topk_phase<true>(F, WSP(bf16_t, WS_QI), WSP(bf16_t, WS_KIF), WSP(float, WS_WI), WSP(unsigned short, WS_SEL));
    GRID_BAR();
    PH(13) { if constexpr (F8_KV && F8_LAT) dsa_attn8_phase(F, WSP(unsigned char, WS_QLAT), WSP(unsigned char, WS_QLAT), WSP(unsigned char, WS_QR), WSP(unsigned char, WS_KV), WSP(unsigned short, WS_SEL), nullptr, nullptr, nullptr, ws);
             else dsa_attn_phase(F, WSP(bf16_t, WS_QLAT), WSP(bf16_t, WS_QLAT), WSP(bf16_t, WS_QR), WSP(bf16_t, WS_KV), WSP(unsigned short, WS_SEL), (const float*)args.in[15], (const float*)args.in[16], (const float*)args.in[17], ws); }
    GRID_BAR();
    PH(14) {
        constexpr float dsc = F8_LAT ? 1.0f / (OLAT_F8SCALE * WUV_F8SCALE) : 1.0f;
        pg8::Gemm g{WSP(bf16_t, WS_QLAT), WSP(bf16_t, WS_WUV), F8_LAT ? 4096 : 8192, F8_LAT ? 512 : 1024, F8_LAT ? 512 : 1024}; pg8::GridOrder<F8_LAT ? 3 : 2, T / 256, DM / 256> S;
        pg8::EpiBf16<F8_WO1> E{WSP(bf16_t, WS_O2), DM, (F8_WO1 ? O2_F8SCALE : 1.0f) * dsc}; pg8::gemm_phase<pg8::EpiBf16<F8_WO1>, pg8::GridOrder<F8_LAT ? 3 : 2, T / 256, DM / 256>, F8_LAT>(F.lds, g, S, E, F.wave);
    }
    GRID_BAR();
    PH(15) {
        constexpr int KD = F8_WO1 ? DM / 2 : DM;
        pg8::Gemm g{WSP(bf16_t, WS_O2), WSP(bf16_t, WS_WO1), KD, KD, KD}; pg8::GridOrder<0, T / 256, DM / 256> S;
        pg8::EpiRes<true> E{WSP(bf16_t, WS_XBB), YH, F8_WO1 ? 1.0f / (O2_F8SCALE * WO_F8SCALE) : 1.0f}; pg8::gemm_phase<pg8::EpiRes<true>, pg8::GridOrder<0, T / 256, DM / 256>, F8_WO1, EPI_ALIGN_RES>(F.lds, g, S, E, F.wave);
    }
    GRID_BAR();
    PH(16) ln_router_phase(F, YH, WSP(bf16_t, WS_XBA), (const float*)args.in[18] + 2 * DM, (const float*)args.in[19] + 2 * DM, (const float*)args.in[14], WSP(int, WS_TOKE), WSP(float, WS_TOKG), WSP(int, WS_TOKL));
    REFRESH();
    GRID_BAR();
    PH(18) moe_tiles(F);
    REFRESH();
    PH(18) moe_gather_phase(F, WSP(bf16_t, WS_XBA), WSP(int, WS_TOKE), WSP(float, WS_TOKG), WSP(int, WS_TOKL), WSP(int, WS_TOKS), WSP(float, WS_SGATE), WSP(bf16_t, WS_XG));
    GRID_BAR();
    PH(19) {
        const int NTL = __builtin_amdgcn_readfirstlane((int)F.MISC[28]);
        {
            pg8::MoeOrder<false, 2 * MFFN / 256> S; S.tile0 = 0; S.ntl = NTL;
            pg8::Gemm g{WSP(bf16_t, WS_XG), WSP(bf16_t, WS_MW13), DM / 2, DM / 2, DM / 2};
            pg8::EpiSwiglu<true> E{WSP(bf16_t, WS_ACT2), MFFN, 1.0f / W13_F8SCALE, ACT_F8SCALE}; pg8::gemm_phase<pg8::EpiSwiglu<true>, pg8::MoeOrder<false, 2 * MFFN / 256>, true>(F.lds, g, S, E, F.wave);
        }
        GRID_BAR();
        {
            pg8::MoeOrder<true, DM / 256> S; S.tile0 = 0; S.ntl = NTL;
            pg8::Gemm g{WSP(bf16_t, WS_ACT2), WSP(bf16_t, WS_MW2), MFFN / 2, MFFN / 2, MFFN / 2};
            pg8::EpiMoeDown E{ws}; pg8::gemm_phase<pg8::EpiMoeDown, pg8::MoeOrder<true, DM / 256>, true>(F.lds, g, S, E, F.wave);
        }
        REFRESH();
        {
            pg8::GridOrderSkip<T / 256, DM / 256> S; S.skip = (NTL * (DM / 256)) % pg8::GRID;
            pg8::Gemm g{WSP(bf16_t, WS_PB) + (size_t)T * 256, WSP(bf16_t, WS_WP1), 256, 256, 256};
            pg8::EpiBf16<false> E{WSP(bf16_t, WS_PP1), DM, 1.0f}; pg8::gemm_phase(F.lds, g, S, E, F.wave);
        }
        GRID_BAR();
    }
    PH(20) moe_combine_ln_phase(F, YH, WSP(bf16_t, WS_XBB), WSP(bf16_t, WS_SOUT), WSP(int, WS_TOKS), (const float*)args.in[18] + 2 * DM, (const float*)args.in[19] + 2 * DM, (const float*)args.in[18] + 3 * DM, (const float*)args.in[19] + 3 * DM);
    GRID_BAR();
    PH(21) {
        pg8::Gemm g{WSP(bf16_t, WS_XBB), WSP(bf16_t, WS_WG1), DM, DM, DM}; pg8::GridOrder<0, T / 256, DM / 256> S;
        pg8::EpiPle E{args.out, ws, 1}; pg8::gemm_phase<pg8::EpiPle, pg8::GridOrder<0, T / 256, DM / 256>, false, EPI_ALIGN_RES>(F.lds, g, S, E, F.wave);
    }
}

#undef YH
#undef bx
extern "C" void kernel_launch(void* const* d_in, const int* in_sizes, int n_in, void* d_out, int out_size, void* d_ws, size_t ws_size, hipStream_t stream) {
    static int grid = 0;
    if (grid == 0) {
        if (n_in != 22 || out_size != T * DM || ws_size < WS_END) { fprintf(stderr, "kernel_launch: unexpected problem (n_in %d, out %d, ws %zu < %zu)\n", n_in, out_size, ws_size, (size_t)WS_END); grid = -1; return; }
        int dev = 0, cus = 0;
        if (hipGetDevice(&dev) != hipSuccess || hipDeviceGetAttribute(&cus, hipDeviceAttributeMultiprocessorCount, dev) != hipSuccess) { grid = -1; return; }
        if (hipFuncSetAttribute((const void*)mega_fwd, hipFuncAttributeMaxDynamicSharedMemorySize, LDS_BYTES) != hipSuccess) { fprintf(stderr, "kernel_launch: hipFuncSetAttribute failed\n"); grid = -1; return; }
        int per_cu = 0;
        if (hipOccupancyMaxActiveBlocksPerMultiprocessor(&per_cu, (const void*)mega_fwd, NTHREADS, LDS_BYTES) != hipSuccess || per_cu < 1) { fprintf(stderr, "kernel_launch: occupancy query says %d\n", per_cu); }
        (void)hipGetLastError();
        if (cus != pg8::GRID) { fprintf(stderr, "kernel_launch: built for %d CUs, device has %d\n", pg8::GRID, cus); grid = -1; return; }
        grid = cus;
    }
    if (grid < 0) return;
    (void)hipMemsetAsync((char*)d_ws + WS_CTL, 0, CTL_ZERO_BYTES, stream);
    Args a{};
    for (int i = 0; i < 22; ++i) a.in[i] = d_in[i];
    a.out = (float*)d_out; a.ws = (unsigned char*)d_ws;
    hipLaunchKernelGGL(mega_fwd, dim3(grid), dim3(NTHREADS), LDS_BYTES, stream, a);
}
```

```cpp
#include <hip/hip_runtime.h>
#include <cstdio>
#include <cstdint>

#define LAS __attribute__((address_space(3)))
#define GAS __attribute__((address_space(1)))
typedef unsigned short bf16_t;
typedef short bf16x8 __attribute__((ext_vector_type(8)));
typedef short bf16x4 __attribute__((ext_vector_type(4)));
typedef float f32x2 __attribute__((ext_vector_type(2)));
typedef float f32x4 __attribute__((ext_vector_type(4)));
typedef float f32x16 __attribute__((ext_vector_type(16)));
typedef unsigned u32x2 __attribute__((ext_vector_type(2)));
typedef unsigned u32x4 __attribute__((ext_vector_type(4)));
typedef unsigned long long u64;
typedef int i32x2 __attribute__((ext_vector_type(2)));
typedef int i32x4 __attribute__((ext_vector_type(4)));
typedef int i32x8 __attribute__((ext_vector_type(8)));

constexpr int T = 32768, SEQ = 16384, DM = 2048;
constexpr int FFN = 5632, MFFN = 7168, NEXP = 8;
constexpr int NQKV = 2560, NWIN = 4864;
constexpr float ALPHA = 1.41421356237309515f;
constexpr float LN_EPS = 1e-5f, RMS_EPS = 1e-6f;
constexpr float QSCALE_SWA = 0.18033688011112042f;
constexpr float SCALE2_MLA = 0.10411754627697264f;
constexpr float LOG2E = 1.4426950408889634f;
constexpr int NWAVES = 8, NTHREADS = 512;
constexpr float W13_F8SCALE = 32.0f;
constexpr bool F8_FFN1 = true, F8_FFN2 = true, F8_QKV = true, F8_WO0 = true, F8_WIN = false, F8_WO1 = true;
constexpr bool EPI_ALIGN_RES = true;
constexpr bool SWA_FRAG = true;
constexpr bool F8_LAT = true;
constexpr float QLAT_F8SCALE = 8.0f, OLAT_F8SCALE = 32.0f, WUV_F8SCALE = 16.0f;
constexpr bool F8_G0 = true, F8_G1 = false;
constexpr bool F8_KV = true;
constexpr float KV_F8SCALE = 16.0f;
constexpr bool F8_WIN_SPLIT = true;
constexpr int WIN_F8_TILES = 14;
constexpr float WQKV_F8SCALE = 32.0f, WIN_F8SCALE = 32.0f, WO_F8SCALE = 64.0f, O0_F8SCALE = 16.0f, O2_F8SCALE = 32.0f;
constexpr float ACT_F8SCALE = 16.0f, W2_F8SCALE = 128.0f;

constexpr size_t MiB = 1u << 20;
constexpr size_t WS_CTL = 0, CTL_ZERO_BYTES = 1 * MiB;
constexpr size_t WS_WQKV = 2 * MiB, WS_WO0 = 12 * MiB, WS_W13 = 20 * MiB, WS_W2 = 64 * MiB, WS_WG0 = 86 * MiB, WS_WG1 = 94 * MiB, WS_WP0 = 102 * MiB, WS_WP1 = 103 * MiB,
                 WS_WIN = 104 * MiB, WS_WUK = 123 * MiB, WS_WUV = 125 * MiB, WS_WO1 = 129 * MiB;
constexpr size_t WS_TAB64 = 137 * MiB, WS_TAB32 = 145 * MiB, WS_PB = 149 * MiB, WS_XBA = 181 * MiB, WS_XBB = 309 * MiB;
constexpr size_t WS_TOKE = 437 * MiB;
constexpr size_t WS_TOKG = WS_TOKE + 256 * 1024;
constexpr size_t WS_TOKL = WS_TOKG + 256 * 1024;
constexpr size_t WS_TOKS = WS_TOKL + 256 * 1024;
constexpr size_t WS_SGATE = WS_TOKS + 256 * 1024;
constexpr size_t WS_WI = 439 * MiB, WS_SEL = 441 * MiB, WS_R = 458 * MiB;
constexpr size_t WS_Q = WS_R, WS_K = WS_R + 128 * MiB, WS_VT = WS_R + 144 * MiB, WS_ACT = WS_R + 160 * MiB, WS_PP0 = WS_R + 512 * MiB, WS_O8 = WS_R + 640 * MiB, WS_XB8 = WS_R + 704 * MiB  , WS_WIN8 = WS_R + 768 * MiB  ;
constexpr size_t WS_QN = WS_R, WS_QR = WS_R + 128 * MiB, WS_CRAW = WS_R + 192 * MiB, WS_KV = WS_R + 256 * MiB, WS_QI = WS_R + 292 * MiB, WS_KIF = WS_R + 356 * MiB,
                 WS_QLAT = WS_R + 360 * MiB, WS_O2 = WS_R + 872 * MiB;
constexpr size_t WS_MW13 = WS_R + 1128 * MiB, WS_MW2 = WS_R + 1352 * MiB, WS_XG = WS_R, WS_SOUT = WS_R + 136 * MiB, WS_ACT2 = WS_R + 404 * MiB  , WS_PP1 = WS_R + 884 * MiB;
constexpr size_t WS_X28 = WS_O8  , WS_X58 = WS_ACT2  ;
constexpr size_t WS_END = WS_R + 1464 * MiB;
constexpr int MAXSLOTS = 67840;
constexpr int CHUNK_TILES = 272;
constexpr int CW_TMO = 0, CW_CNT = 64  , CW_BAR = 4096;

constexpr int LDS_BYTES = 155648;
constexpr int MISC_OFF = 150016;
constexpr int DSA_WBUF = 18688;

typedef __bf16 bf16x2_t __attribute__((ext_vector_type(2)));
__device__ __forceinline__ unsigned cvt_pk_bf16(float lo, float hi) { const f32x2 v = {lo, hi}; return __builtin_bit_cast(unsigned, __builtin_convertvector(v, bf16x2_t)); }
__device__ __forceinline__ float bf2f(unsigned short h) { return __uint_as_float(((unsigned)h) << 16); }
__device__ __forceinline__ float bflo(unsigned w) { return __uint_as_float(w << 16); }
__device__ __forceinline__ float bfhi(unsigned w) { return __uint_as_float(w & 0xffff0000u); }
__device__ __forceinline__ int fresh_lane() { unsigned m = ~0u; asm volatile("" : "+v"(m)); return (int)__builtin_amdgcn_mbcnt_hi(m, __builtin_amdgcn_mbcnt_lo(m, 0u)); }
__device__ __forceinline__ float shx(float v, int o, int lane) { return __int_as_float(__builtin_amdgcn_ds_bpermute((lane ^ o) << 2, __float_as_int(v))); }
__device__ __forceinline__ float wave_sum(float v) {
    const int l = fresh_lane();
#pragma unroll
    for (int o = 1; o < 64; o <<= 1) v += shx(v, o, l);
    return v;
}
__device__ __forceinline__ unsigned pk4_fp8(float a, float b, float c, float d) { unsigned w = 0u; w = (unsigned)__builtin_amdgcn_cvt_pk_fp8_f32(a, b, (int)w, false); w = (unsigned)__builtin_amdgcn_cvt_pk_fp8_f32(c, d, (int)w, true); return w; }
#define LDS_WAIT() asm volatile("s_waitcnt lgkmcnt(0)" ::: "memory")
#define VM_WAIT() asm volatile("s_waitcnt vmcnt(0)" ::: "memory")

namespace pg8 {
constexpr int BM = 256, BK = 64, HALF = 128, HTB = HALF * BK * 2, STAGE_BYTES = 8 * HTB, NXCD = 8, WGM = 8;
__host__ __device__ __forceinline__ int lds_byte(int r, int c) { const int st = (r >> 4) * 2 + (c >> 5), rr = r & 15, cc = c & 31, ob = rr * 64 + cc * 2; return st * 1024 + (ob ^ (((ob >> 9) & 1) << 5)); }
__host__ __device__ __forceinline__ void stage_rc(int b, int& R, int& C) { const int st = b / 1024, sb = b % 1024, swz = sb ^ (((sb >> 9) & 1) << 5); R = (st >> 1) * 16 + swz / 64; C = (st & 1) * 32 + (swz % 64) / 2; }
__host__ __device__ __forceinline__ int perm32(int rho) { const int n = rho >> 4, i = rho & 15; return 8 * (i >> 2) + 4 * n + (i & 3); }

struct Unit { int pm, pn, am, acol, bn; };
struct Gemm { const bf16_t* A; const bf16_t* Bt; int lda, ldb, K; };

constexpr int GRID = 256;
template <int MODE, int NM, int NN> struct GridOrder {
    __device__ __forceinline__ bool next(int i, Unit& u) const {
        constexpr int nwg = NM * NN;
        int L = i * GRID + (int)blockIdx.x;
        if constexpr (MODE == 4) {
            if (i >= 6) { if ((int)blockIdx.x < GRID / 2 || i >= 8) return false; L = 6 * GRID + ((int)blockIdx.x - GRID / 2) * 2 + (i - 6); } }
        if (L >= nwg) return false;
        int wgid = L; { constexpr int q = nwg / NXCD, r = nwg % NXCD; const int xcd = wgid % NXCD, off = wgid / NXCD; wgid = (xcd < r ? xcd * (q + 1) : r * (q + 1) + (xcd - r) * q) + off; }
        constexpr int nig = WGM * NN; const int gid = wgid / nig, fm = gid * WGM, gsz = (NM - fm) < WGM ? (NM - fm) : WGM;
        u.pm = fm + ((wgid % nig) % gsz); u.pn = (wgid % nig) / gsz; u.am = u.pm; u.bn = u.pn;
        u.acol = MODE == 1 ? (u.pn >> 1) * 128 : (MODE == 2 ? u.pn * 1024 : (MODE == 3 ? u.pn * 512 : 0));
        return true;
    }
};
template <int NM, int NN> struct GridOrderSkip {
    int skip;
    __device__ __forceinline__ bool next(int i, Unit& u) const {
        constexpr int nwg = NM * NN; const int nW = GRID - skip, br = (int)blockIdx.x - skip; if (br < 0) return false;
        const int L = i * nW + br; if (L >= nwg) return false;
        int wgid = L; { constexpr int q = nwg / NXCD, r = nwg % NXCD; const int xcd = wgid % NXCD, off = wgid / NXCD; wgid = (xcd < r ? xcd * (q + 1) : r * (q + 1) + (xcd - r) * q) + off; }
        constexpr int nig = WGM * NN; const int gid = wgid / nig, fm = gid * WGM, gsz = (NM - fm) < WGM ? (NM - fm) : WGM;
        u.pm = fm + ((wgid % nig) % gsz); u.pn = (wgid % nig) / gsz; u.am = u.pm; u.bn = u.pn; u.acol = 0;
        return true;
    }
};
template <bool DOWN, int NN> struct MoeOrder {
    int tile0, ntl;
    __device__ __forceinline__ bool next(int i, Unit& u) const {
        int pml, pn;
        if constexpr (!DOWN && NN % 8 == 0) {
            constexpr int NJ = NN / 8; const int x = (int)blockIdx.x & 7, q = i * (GRID / 8) + ((int)blockIdx.x >> 3); if (q >= ntl * NJ) return false;
            const int nfull = ntl >> 3; int m, j;
            if (q < nfull * 8 * NJ) { const int b = q / (8 * NJ), w = q - b * (8 * NJ); m = b * 8 + (w & 7); j = w >> 3; }
            else { const int g = ntl - nfull * 8, w = q - nfull * 8 * NJ; j = w / g; m = nfull * 8 + (w - j * g); }
            pml = m; pn = 8 * j + x;
        } else {
        const int L = i * GRID + (int)blockIdx.x; if (L >= ntl * NN) return false;
        constexpr int nig = WGM * NN; const int wgid = L, gid = wgid / nig, fm = gid * WGM, gsz = (ntl - fm) < WGM ? (ntl - fm) : WGM;
        pml = fm + ((wgid % nig) % gsz); pn = (wgid % nig) / gsz; }
        const int pmg = tile0 + pml;
        const u32x4 t0 = *(const LAS u32x4*)(MISC_OFF + 20 * 4), t1 = *(const LAS u32x4*)(MISC_OFF + 24 * 4);
        int e = (pmg >= (int)t0.x) + (pmg >= (int)t0.y) + (pmg >= (int)t0.z) + (pmg >= (int)t0.w) + (pmg >= (int)t1.x) + (pmg >= (int)t1.y) + (pmg >= (int)t1.z);
        e = __builtin_amdgcn_readfirstlane(e);
        u.pn = pn; u.bn = e * NN + pn; u.acol = 0;
        if (DOWN) { u.pm = pmg; u.am = pml; } else { u.pm = pml; u.am = pmg; }
        return true;
    }
};

__device__ __forceinline__ void stage16_s(const char* gbase, unsigned voff, unsigned lds_dst) { unsigned keep;
    asm volatile("s_mov_b32 %0, m0\n\ts_mov_b32 m0, %3\n\ts_nop 0\n\tglobal_load_lds_dwordx4 %1, %2\n\ts_mov_b32 m0, %0" : "=&s"(keep) : "v"(voff), "s"(gbase), "s"(lds_dst) : "memory"); }
template <class Epi, class Sched, bool FP8 = false, bool ALIGN = true>
__device__ __forceinline__ void gemm_phase(LAS unsigned char* lds, const Gemm g, const Sched& S, const Epi& E, int wave_) {
    int tid_ = wave_ * 64 + fresh_lane(); asm volatile("" : "+v"(tid_));
    const int tid = tid_, wid = __builtin_amdgcn_readfirstlane(tid >> 6), lane = tid & 63, wr = wid >> 2, wc = wid & 3, fr = lane & 15, fq = lane >> 4;
    int K_ = g.K; asm volatile("" : "+s"(K_));
    const int K = K_, nt = K / BK;
    unsigned voffA[2], voffB[2];
#pragma unroll
    for (int i = 0; i < 2; ++i) { int R, C; stage_rc(tid * 16 + i * 8192, R, C); const int Rb = (R & ~31) + perm32(R & 31);
        voffA[i] = (unsigned)(R * g.lda + C) * 2u; voffB[i] = (unsigned)(Rb * g.ldb + C) * 2u; }
    const size_t kstep = (size_t)(BK * 2);
    const size_t hstepA = (size_t)HALF * g.lda * 2, hstepB = (size_t)HALF * g.ldb * 2;
    const unsigned ldsw = (unsigned)wid * 1024u;
    const int aoff = lds_byte(wr * 64 + fr, fq * 8), boff = lds_byte(wc * 32 + fr, fq * 8);
#define PG8_SA(b, h) (((b) * 2 + (h)) * HTB)
#define PG8_SB(b, h) ((4 + (b) * 2 + (h)) * HTB)
#define PG8_STAGE(bufoff, gbase, voff) do { _Pragma("unroll") for (int _i = 0; _i < 2; ++_i) { \
        if constexpr (FP8) stage16_s((const char*)(gbase), (voff)[_i], (unsigned)(size_t)(lds + (bufoff) + ldsw + _i * 8192)); \
        else __builtin_amdgcn_global_load_lds((const unsigned*)((const char*)(gbase) + (voff)[_i]), (LAS unsigned*)(lds + (bufoff) + ldsw + _i * 8192), 16, 0, 0); } } while (0)
#define PG8_LDA(dst, b, h) do { _Pragma("unroll") for (int m = 0; m < 4; ++m) _Pragma("unroll") for (int k = 0; k < 2; ++k) dst[m][k] = *(const LAS bf16x8*)(lds + PG8_SA(b, h) + aoff + m * 2048 + k * 1024); } while (0)
#define PG8_LDB(dst, b, h) do { _Pragma("unroll") for (int n = 0; n < 2; ++n) _Pragma("unroll") for (int k = 0; k < 2; ++k) dst[n][k] = *(const LAS bf16x8*)(lds + PG8_SB(b, h) + boff + n * 2048 + k * 1024); } while (0)
#define PG8_MMA(ai, bj, At, Bt) do { __builtin_amdgcn_s_setprio(1); _Pragma("unroll") for (int m = 0; m < 4; ++m) _Pragma("unroll") for (int n = 0; n < 2; ++n) _Pragma("unroll") for (int k = 0; k < 2; ++k) \
        acc[ai][bj][m][n] = __builtin_amdgcn_mfma_f32_16x16x32_bf16(Bt[n][k], At[m][k], acc[ai][bj][m][n], 0, 0, 0); __builtin_amdgcn_s_setprio(0); } while (0)
#define PG8_LDA8(dst, b, h) do { _Pragma("unroll") for (int m = 0; m < 4; ++m) { const i32x4 lo_ = *(const LAS i32x4*)(lds + PG8_SA(b, h) + aoff + m * 2048), hi_ = *(const LAS i32x4*)(lds + PG8_SA(b, h) + aoff + m * 2048 + 1024); \
        dst[m] = __builtin_shufflevector(lo_, hi_, 0, 1, 2, 3, 4, 5, 6, 7); } } while (0)
#define PG8_LDB8(dst, b, h) do { _Pragma("unroll") for (int n = 0; n < 2; ++n) { const i32x4 lo_ = *(const LAS i32x4*)(lds + PG8_SB(b, h) + boff + n * 2048), hi_ = *(const LAS i32x4*)(lds + PG8_SB(b, h) + boff + n * 2048 + 1024); \
        dst[n] = __builtin_shufflevector(lo_, hi_, 0, 1, 2, 3, 4, 5, 6, 7); } } while (0)
#define PG8_MMA8(ai, bj, At, Bt) do { __builtin_amdgcn_s_setprio(1); _Pragma("unroll") for (int m = 0; m < 4; ++m) _Pragma("unroll") for (int n = 0; n < 2; ++n) \
        acc[ai][bj][m][n] = __builtin_amdgcn_mfma_scale_f32_16x16x128_f8f6f4(Bt[n], At[m], acc[ai][bj][m][n], 0, 0, 0, 0, 0, 0); __builtin_amdgcn_s_setprio(0); } while (0)
#define PG8_WAIT_V(n) asm volatile("s_waitcnt vmcnt(" #n ")" ::: "memory")
#define PG8_WAIT_L(n) asm volatile("s_waitcnt lgkmcnt(" #n ")" ::: "memory")
#define PG8_BAR __builtin_amdgcn_s_barrier()
#define PG8_SCHED __builtin_amdgcn_sched_barrier(0)
#define PG8_ABASE(u) ((const char*)g.A + ((size_t)(u).am * BM * g.lda + (size_t)(u).acol) * 2)
#define PG8_BBASE(u) ((const char*)g.Bt + (size_t)(u).bn * BM * g.ldb * 2)
    Unit cur, nxt; int ui = 0;
    if (!S.next(0, cur)) return;
    f32x4 acc[2][2][4][2];
#pragma unroll
    for (int a = 0; a < 2; ++a)
#pragma unroll
        for (int b = 0; b < 2; ++b)
#pragma unroll
            for (int m = 0; m < 4; ++m)
#pragma unroll
                for (int n = 0; n < 2; ++n) acc[a][b][m][n] = (f32x4){0.f, 0.f, 0.f, 0.f};
    bf16x8 At[4][2], B0[2][2], B1[2][2]; i32x8 At8[4], B08[2], B18[2];
    const char* cA = PG8_ABASE(cur); const char* cB = PG8_BBASE(cur);
    {
        PG8_STAGE(PG8_SB(0, 0), cB, voffB); PG8_STAGE(PG8_SB(0, 1), cB + hstepB, voffB); PG8_STAGE(PG8_SA(0, 0), cA, voffA); PG8_STAGE(PG8_SA(0, 1), cA + hstepA, voffA);
        if (wr == 1) PG8_BAR;
        PG8_WAIT_V(2); PG8_BAR;
        PG8_STAGE(PG8_SB(1, 0), cB + kstep, voffB); PG8_STAGE(PG8_SA(1, 0), cA + kstep, voffA); PG8_STAGE(PG8_SB(1, 1), cB + hstepB + kstep, voffB);
        PG8_WAIT_V(6); PG8_BAR;
    }
    for (;;) {
        const bool has_next = S.next(ui + 1, nxt);
        const char* nA = has_next ? PG8_ABASE(nxt) : cA; const char* nB = has_next ? PG8_BBASE(nxt) : cB;
        for (int t = 0; t < nt; t += 2) {
            const bool last = (t == nt - 2);
            const char* a1 = cA + (size_t)(t + 1) * kstep;
            const char* a2 = last ? nA : cA + (size_t)(t + 2) * kstep; const char* b2 = last ? nB : cB + (size_t)(t + 2) * kstep;
            const char* a3 = a2 + kstep; const char* b3 = b2 + kstep;
            if constexpr (FP8) {
            PG8_LDB8(B08, 0, 0); PG8_LDB8(B18, 0, 1); PG8_SCHED; PG8_LDA8(At8, 0, 0); PG8_STAGE(PG8_SA(1, 1), a1 + hstepA, voffA);
            PG8_WAIT_V(8); PG8_WAIT_L(0); PG8_BAR; PG8_MMA8(0, 0, At8, B08); PG8_MMA8(0, 1, At8, B18); PG8_BAR; PG8_SCHED;
            PG8_LDA8(At8, 0, 1); PG8_STAGE(PG8_SB(0, 0), b2, voffB); PG8_STAGE(PG8_SB(0, 1), b2 + hstepB, voffB); PG8_STAGE(PG8_SA(0, 0), a2, voffA);
            PG8_WAIT_V(8); PG8_WAIT_L(0); PG8_BAR; PG8_MMA8(1, 0, At8, B08); PG8_MMA8(1, 1, At8, B18); PG8_BAR; PG8_SCHED;
            PG8_LDB8(B08, 1, 0); PG8_LDB8(B18, 1, 1); PG8_SCHED; PG8_LDA8(At8, 1, 0); PG8_STAGE(PG8_SA(0, 1), a2 + hstepA, voffA);
            PG8_WAIT_V(8); PG8_WAIT_L(0); PG8_BAR; PG8_MMA8(0, 0, At8, B08); PG8_MMA8(0, 1, At8, B18); PG8_BAR; PG8_SCHED;
            PG8_LDA8(At8, 1, 1); PG8_STAGE(PG8_SB(1, 0), b3, voffB); PG8_STAGE(PG8_SB(1, 1), b3 + hstepB, voffB); PG8_STAGE(PG8_SA(1, 0), a3, voffA);
            PG8_WAIT_V(8); PG8_WAIT_L(0); PG8_BAR; PG8_MMA8(1, 0, At8, B08); PG8_MMA8(1, 1, At8, B18); PG8_BAR; PG8_SCHED;
            } else {
            PG8_LDB(B0, 0, 0); PG8_LDB(B1, 0, 1); PG8_SCHED; PG8_LDA(At, 0, 0); PG8_STAGE(PG8_SA(1, 1), a1 + hstepA, voffA);
            PG8_WAIT_V(8); PG8_WAIT_L(0); PG8_BAR; PG8_MMA(0, 0, At, B0); PG8_MMA(0, 1, At, B1); PG8_BAR; PG8_SCHED;
            PG8_LDA(At, 0, 1); PG8_STAGE(PG8_SB(0, 0), b2, voffB); PG8_STAGE(PG8_SB(0, 1), b2 + hstepB, voffB); PG8_STAGE(PG8_SA(0, 0), a2, voffA);
            PG8_WAIT_V(8); PG8_WAIT_L(0); PG8_BAR; PG8_MMA(1, 0, At, B0); PG8_MMA(1, 1, At, B1); PG8_BAR; PG8_SCHED;
            PG8_LDB(B0, 1, 0); PG8_LDB(B1, 1, 1); PG8_SCHED; PG8_LDA(At, 1, 0); PG8_STAGE(PG8_SA(0, 1), a2 + hstepA, voffA);
            PG8_WAIT_V(8); PG8_WAIT_L(0); PG8_BAR; PG8_MMA(0, 0, At, B0); PG8_MMA(0, 1, At, B1); PG8_BAR; PG8_SCHED;
            PG8_LDA(At, 1, 1); PG8_STAGE(PG8_SB(1, 0), b3, voffB); PG8_STAGE(PG8_SB(1, 1), b3 + hstepB, voffB); PG8_STAGE(PG8_SA(1, 0), a3, voffA);
            PG8_WAIT_V(8); PG8_WAIT_L(0); PG8_BAR; PG8_MMA(1, 0, At, B0); PG8_MMA(1, 1, At, B1); PG8_BAR; PG8_SCHED;
            }
        }
        if constexpr (ALIGN) { if (wr == 0) PG8_BAR; }
        { int fr_ = fr, fq_ = fq; asm volatile("" : "+v"(fr_), "+v"(fq_));
          E(acc, cur, wr, wc, fr_, fq_); }
        if (!has_next) break;
#pragma unroll
        for (int a = 0; a < 2; ++a)
#pragma unroll
            for (int b = 0; b < 2; ++b)
#pragma unroll
                for (int m = 0; m < 4; ++m)
#pragma unroll
                    for (int n = 0; n < 2; ++n) acc[a][b][m][n] = (f32x4){0.f, 0.f, 0.f, 0.f};
        cur = nxt; cA = nA; cB = nB; ++ui;
        if constexpr (ALIGN) { if (wr == 1) PG8_BAR; }
    }
    PG8_WAIT_V(0);
    if constexpr (!ALIGN) { if (wr == 0) PG8_BAR; }
    PG8_BAR;
#undef PG8_SA
#undef PG8_SB
#undef PG8_STAGE
#undef PG8_LDA
#undef PG8_LDB
#undef PG8_MMA
#undef PG8_LDA8
#undef PG8_LDB8
#undef PG8_MMA8
#undef PG8_WAIT_V
#undef PG8_WAIT_L
#undef PG8_BAR
#undef PG8_SCHED
#undef PG8_ABASE
#undef PG8_BBASE
}

#define EPI_ROW(ai, m) (u.pm * BM + (ai) * HALF + wr * 64 + (m) * 16 + fr)
#define EPI_COL(bj) (u.pn * BM + (bj) * HALF + wc * 32 + 8 * fq)
typedef f32x4 AccT[2][2][4][2];

__device__ __forceinline__ void rope4(f32x4& v0, f32x4& v1, const f32x4 cs0, const f32x4 cs1) {
    f32x4 o0, o1;
    o0[0] = v0[0] * cs0[0] - v0[1] * cs0[1]; o0[1] = v0[1] * cs0[0] + v0[0] * cs0[1];
    o0[2] = v0[2] * cs0[2] - v0[3] * cs0[3]; o0[3] = v0[3] * cs0[2] + v0[2] * cs0[3];
    o1[0] = v1[0] * cs1[0] - v1[1] * cs1[1]; o1[1] = v1[1] * cs1[0] + v1[0] * cs1[1];
    o1[2] = v1[2] * cs1[2] - v1[3] * cs1[3]; o1[3] = v1[3] * cs1[2] + v1[2] * cs1[3];
    v0 = o0; v1 = o1;
}
__device__ __forceinline__ u32x4 pack8(const f32x4 v0, const f32x4 v1) { u32x4 w; w.x = cvt_pk_bf16(v0[0], v0[1]); w.y = cvt_pk_bf16(v0[2], v0[3]); w.z = cvt_pk_bf16(v1[0], v1[1]); w.w = cvt_pk_bf16(v1[2], v1[3]); return w; }

__device__ __forceinline__ void unpack8(const u32x4 w, f32x4& a, f32x4& b) { a[0] = bflo(w.x); a[1] = bfhi(w.x); a[2] = bflo(w.y); a[3] = bfhi(w.y); b[0] = bflo(w.z); b[1] = bfhi(w.z); b[2] = bflo(w.w); b[3] = bfhi(w.w); }
__device__ __forceinline__ u32x2 pack8_fp8(const f32x4 v0, const f32x4 v1, float s) { u32x2 w; w.x = pk4_fp8(v0[0] * s, v0[1] * s, v0[2] * s, v0[3] * s); w.y = pk4_fp8(v1[0] * s, v1[1] * s, v1[2] * s, v1[3] * s); return w; }
template <bool OUT8> struct EpiBf16 {
    bf16_t* O; int ldc; float osc;
    __device__ __forceinline__ void operator()(const AccT& acc, const Unit& u, int wr, int wc, int fr, int fq) const {
#pragma unroll
        for (int ai = 0; ai < 2; ++ai)
#pragma unroll
            for (int m = 0; m < 4; ++m) {
#pragma unroll
                for (int bj = 0; bj < 2; ++bj) {
                    if constexpr (OUT8) *(u32x2*)((unsigned char*)O + (size_t)EPI_ROW(ai, m) * ldc + EPI_COL(bj)) = pack8_fp8(acc[ai][bj][m][0], acc[ai][bj][m][1], osc);
                    else *(u32x4*)(O + (size_t)EPI_ROW(ai, m) * ldc + EPI_COL(bj)) = pack8(acc[ai][bj][m][0] * osc, acc[ai][bj][m][1] * osc); } }
    }
};
struct EpiQKV {
    unsigned char* ws; float asc;
    __device__ __forceinline__ void operator()(const AccT& acc, const Unit& u, int wr, int wc, int fr, int fq) const {
        bf16_t* Q = (bf16_t*)(ws + WS_Q); bf16_t* Kb = (bf16_t*)(ws + WS_K); bf16_t* VT = (bf16_t*)(ws + WS_VT); const float* tab64 = (const float*)(ws + WS_TAB64);
        if (u.pn < 9) {
            bf16_t* base = u.pn < 8 ? Q : Kb; const int ldc = u.pn < 8 ? 2048 : 256; const int colt = u.pn < 8 ? u.pn * BM : 0; const float sc = (u.pn < 8 ? QSCALE_SWA : 1.0f) * asc;
#pragma unroll
            for (int ai = 0; ai < 2; ++ai)
#pragma unroll
                for (int m = 0; m < 4; ++m) { const int row = EPI_ROW(ai, m);
#pragma unroll
                    for (int bj = 0; bj < 2; ++bj) { const int cl = bj * HALF + wc * 32 + 8 * fq; const int i0 = (cl & 63) >> 1;
                        const f32x4 cs0 = *(const f32x4*)(tab64 + ((size_t)row * 32 + i0) * 2), cs1 = *(const f32x4*)(tab64 + ((size_t)row * 32 + i0) * 2 + 4);
                        f32x4 v0 = acc[ai][bj][m][0], v1 = acc[ai][bj][m][1]; rope4(v0, v1, cs0, cs1); v0 = v0 * sc; v1 = v1 * sc;
                        if constexpr (SWA_FRAG) {
                            const int b = row >> 14, s = row & (SEQ - 1), hh = (colt + cl) >> 6, c64 = cl & 63, kk = c64 >> 4, hf2 = (c64 >> 3) & 1, nh = u.pn < 8 ? 32 : 4;
                            *(u32x4*)(base + ((((size_t)(b * nh + hh) * 512 + (s >> 5)) * 4 + kk) * 64 + hf2 * 32 + (s & 31)) * 8) = pack8(v0, v1); }
                        else *(u32x4*)(base + (size_t)row * ldc + colt + cl) = pack8(v0, v1); } }
        } else {
#pragma unroll
            for (int ai = 0; ai < 2; ++ai)
#pragma unroll
                for (int m = 0; m < 4; ++m) { const int row = EPI_ROW(ai, m), b = row >> 14, s = row & (SEQ - 1);
#pragma unroll
                    for (int bj = 0; bj < 2; ++bj) { const int cl = bj * HALF + wc * 32 + 8 * fq, kvh = cl >> 6, d0 = cl & 63;
                        const u32x4 w = pack8(acc[ai][bj][m][0] * asc, acc[ai][bj][m][1] * asc);
                        if constexpr (SWA_FRAG) {
                            const int j = s & 31, c = j >> 4, jj = j & 15, hfv = (jj & 7) >> 2, e = (jj & 3) + ((jj >> 3) << 2), mt = d0 >> 5;
                            bf16_t* pf = VT + (((((size_t)(b * 4 + kvh) * 512 + (s >> 5)) * 2 + c) * 2 + mt) * 64 + hfv * 32 + (d0 & 31)) * 8 + e;
                            pf[0] = (bf16_t)(w.x & 0xffff); pf[8] = (bf16_t)(w.x >> 16); pf[16] = (bf16_t)(w.y & 0xffff); pf[24] = (bf16_t)(w.y >> 16);
                            pf[32] = (bf16_t)(w.z & 0xffff); pf[40] = (bf16_t)(w.z >> 16); pf[48] = (bf16_t)(w.w & 0xffff); pf[56] = (bf16_t)(w.w >> 16); }
                        else {
                        bf16_t* p = VT + ((size_t)(b * 4 + kvh) * 64 + d0) * SEQ + s;
                        p[0 * SEQ] = (bf16_t)(w.x & 0xffff); p[1 * SEQ] = (bf16_t)(w.x >> 16); p[2 * SEQ] = (bf16_t)(w.y & 0xffff); p[3 * SEQ] = (bf16_t)(w.y >> 16);
                        p[4 * SEQ] = (bf16_t)(w.z & 0xffff); p[5 * SEQ] = (bf16_t)(w.z >> 16); p[6 * SEQ] = (bf16_t)(w.w & 0xffff); p[7 * SEQ] = (bf16_t)(w.w >> 16); } } }
        }
    }
};
template <bool RES16> struct EpiRes {
    const void* res; bf16_t* out; float sc;
    __device__ __forceinline__ void operator()(const AccT& acc, const Unit& u, int wr, int wc, int fr, int fq) const {
#pragma unroll
        for (int ai = 0; ai < 2; ++ai)
#pragma unroll
            for (int m = 0; m < 4; ++m) { const size_t ro = (size_t)EPI_ROW(ai, m) * DM;
#pragma unroll
                for (int bj = 0; bj < 2; ++bj) { const size_t o = ro + EPI_COL(bj); f32x4 r0, r1;
                    if constexpr (RES16) unpack8(*(const u32x4*)((const bf16_t*)res + o), r0, r1);
                    else { r0 = *(const f32x4*)((const float*)res + o); r1 = *(const f32x4*)((const float*)res + o + 4); }
                    *(u32x4*)(out + o) = pack8(r0 * ALPHA + acc[ai][bj][m][0] * sc, r1 * ALPHA + acc[ai][bj][m][1] * sc); }
                asm volatile("" ::: "memory"); }
    }
};
__device__ __forceinline__ float silu_mul(float g, float uu) { return g * __builtin_amdgcn_rcpf(1.0f + __builtin_amdgcn_exp2f(-g * LOG2E)) * uu; }
template <bool OUT8> struct EpiSwiglu {
    bf16_t* O; int ldc; float sc; float osc;
    __device__ __forceinline__ void operator()(const AccT& acc, const Unit& u, int wr, int wc, int fr, int fq) const {
#pragma unroll
        for (int ai = 0; ai < 2; ++ai)
#pragma unroll
            for (int m = 0; m < 4; ++m) { f32x4 a0, a1;
#pragma unroll
                for (int j = 0; j < 4; ++j) { a0[j] = silu_mul(acc[ai][0][m][0][j] * sc, acc[ai][1][m][0][j] * sc); a1[j] = silu_mul(acc[ai][0][m][1][j] * sc, acc[ai][1][m][1][j] * sc); }
                if constexpr (OUT8) { u32x2 w8; w8.x = pk4_fp8(a0[0] * osc, a0[1] * osc, a0[2] * osc, a0[3] * osc); w8.y = pk4_fp8(a1[0] * osc, a1[1] * osc, a1[2] * osc, a1[3] * osc);
                    *(u32x2*)((unsigned char*)O + (size_t)EPI_ROW(ai, m) * ldc + u.pn * HALF + wc * 32 + 8 * fq) = w8; }
                else *(u32x4*)(O + (size_t)EPI_ROW(ai, m) * ldc + u.pn * HALF + wc * 32 + 8 * fq) = pack8(a0, a1); }
    }
};
struct EpiPle {
    float* outf; unsigned char* ws; int layer; float nls;
    __device__ __forceinline__ void operator()(const AccT& acc, const Unit& u, int wr, int wc, int fr, int fq) const {
        const bf16_t* pp = (const bf16_t*)(ws + (layer == 0 ? WS_PP0 : WS_PP1));
        const bf16_t* xres = (const bf16_t*)(ws + (layer == 0 ? WS_XBA : WS_XBB));
#pragma unroll
        for (int ai = 0; ai < 2; ++ai)
#pragma unroll
            for (int m = 0; m < 4; ++m) { const unsigned ro = (unsigned)EPI_ROW(ai, m) * (unsigned)DM;
#pragma unroll
                for (int bj = 0; bj < 2; ++bj) { const unsigned o = ro + (unsigned)EPI_COL(bj);
                    f32x4 r0, r1, p0, p1; unpack8(*(const u32x4*)(xres + o), r0, r1); unpack8(*(const u32x4*)(pp + o), p0, p1);
                    f32x4 s0, s1;
#pragma unroll
                    for (int j = 0; j < 4; ++j) { s0[j] = __builtin_amdgcn_rcpf(1.0f + __builtin_amdgcn_exp2f(acc[ai][bj][m][0][j] * nls)); s1[j] = __builtin_amdgcn_rcpf(1.0f + __builtin_amdgcn_exp2f(acc[ai][bj][m][1][j] * nls)); }
                    const f32x4 o0 = r0 + s0 * p0, o1 = r1 + s1 * p1;
                    if (layer == 0) { *(u32x4*)((bf16_t*)(ws + WS_XBB) + o) = pack8(o0, o1);
                                      if constexpr (F8_WIN_SPLIT || F8_WIN) *(u32x2*)(ws + WS_XB8 + o) = pack8_fp8(o0, o1, 1.0f); }
                    else { *(f32x4*)(outf + o) = o0; *(f32x4*)(outf + o + 4) = o1; } }
                asm volatile("" ::: "memory"); }
    }
};
struct EpiWin {
    unsigned char* ws; float asc; int pn0;
    __device__ __forceinline__ void operator()(const AccT& acc, const Unit& u, int wr, int wc, int fr, int fq) const {
        bf16_t* QN = (bf16_t*)(ws + WS_QN); bf16_t* QR = (bf16_t*)(ws + WS_QR); float* CRAW = (float*)(ws + WS_CRAW); bf16_t* KV = (bf16_t*)(ws + WS_KV); bf16_t* QI = (bf16_t*)(ws + WS_QI);
        bf16_t* KIF = (bf16_t*)(ws + WS_KIF); float* WI = (float*)(ws + WS_WI); const float* tab64 = (const float*)(ws + WS_TAB64); const float* tab32 = (const float*)(ws + WS_TAB32);
        const int pn = u.pn + pn0;
#pragma unroll
        for (int ai = 0; ai < 2; ++ai)
#pragma unroll
            for (int m = 0; m < 4; ++m) { const int row = EPI_ROW(ai, m);
#pragma unroll
                for (int bj = 0; bj < 2; ++bj) { const int cl = bj * HALF + wc * 32 + 8 * fq; f32x4 v0 = acc[ai][bj][m][0] * asc, v1 = acc[ai][bj][m][1] * asc;
                    if (pn < 8) { *(u32x4*)(QN + (size_t)row * 2048 + pn * BM + cl) = pack8(v0, v1); }
                    else if (pn < 12) { const int i0 = (cl & 63) >> 1;
                        const f32x4 cs0 = *(const f32x4*)(tab64 + ((size_t)row * 32 + i0) * 2), cs1 = *(const f32x4*)(tab64 + ((size_t)row * 32 + i0) * 2 + 4);
                        rope4(v0, v1, cs0, cs1); if constexpr (F8_LAT) { v0 = v0 * QLAT_F8SCALE; v1 = v1 * QLAT_F8SCALE; }
                        if constexpr (F8_KV) *(u32x2*)((unsigned char*)QR + (size_t)row * 1024 + (pn - 8) * BM + cl) = pack8_fp8(v0, v1, 1.0f);
                        else *(u32x4*)(QR + (size_t)row * 1024 + (pn - 8) * BM + cl) = pack8(v0, v1); }
                    else if (pn < 14) { float* p = CRAW + (size_t)row * 512 + (pn - 12) * BM + cl; *(f32x4*)p = v0; *(f32x4*)(p + 4) = v1; }
                    else if (pn == 14) {
                        if (cl < 64) { const int i0 = cl >> 1;
                            const f32x4 cs0 = *(const f32x4*)(tab64 + ((size_t)row * 32 + i0) * 2), cs1 = *(const f32x4*)(tab64 + ((size_t)row * 32 + i0) * 2 + 4);
                            rope4(v0, v1, cs0, cs1);
                            if constexpr (F8_KV) *(u32x2*)((unsigned char*)KV + (size_t)row * 576 + 512 + cl) = pack8_fp8(v0, v1, KV_F8SCALE);
                            else *(u32x4*)(KV + (size_t)row * 576 + 512 + cl) = pack8(v0, v1); }
                        else if (cl < 128) { const int d8 = cl - 64;
                            if (d8 < 32) { const int i0 = d8 >> 1;
                                const f32x4 cs0 = *(const f32x4*)(tab32 + ((size_t)row * 16 + i0) * 2), cs1 = *(const f32x4*)(tab32 + ((size_t)row * 16 + i0) * 2 + 4);
                                rope4(v0, v1, cs0, cs1); }
                            const int b = row >> 14, s = row & (SEQ - 1), blk = s >> 5, j = s & 31, kk = d8 >> 4, hf = (d8 >> 3) & 1;
                            *(u32x4*)(KIF + ((size_t)((b * 512 + blk) * 4 + kk) * 64 + hf * 32 + j) * 8) = pack8(v0, v1); }
                        else if (cl < 144) { float* p = WI + (size_t)row * 16 + (cl - 128); *(f32x4*)p = v0; *(f32x4*)(p + 4) = v1; }
                    } else { const int cq = (pn - 15) * BM + cl, d8 = cq & 63;
                        if (d8 < 32) { const int i0 = d8 >> 1;
                            const f32x4 cs0 = *(const f32x4*)(tab32 + ((size_t)row * 16 + i0) * 2), cs1 = *(const f32x4*)(tab32 + ((size_t)row * 16 + i0) * 2 + 4);
                            rope4(v0, v1, cs0, cs1); }
                        *(u32x4*)(QI + (size_t)row * 1024 + cq) = pack8(v0, v1); }
                } }
    }
};
struct EpiMoeDown {
    unsigned char* ws;
    __device__ __forceinline__ void operator()(const AccT& acc, const Unit& u, int wr, int wc, int fr, int fq) const {
        bf16_t* O = (bf16_t*)(ws + WS_SOUT); const float* gate = (const float*)(ws + WS_SGATE);
#pragma unroll
        for (int ai = 0; ai < 2; ++ai)
#pragma unroll
            for (int m = 0; m < 4; ++m) { const int row = EPI_ROW(ai, m); const float gt = gate[row] * (1.0f / (ACT_F8SCALE * W2_F8SCALE)); bf16_t* rowp = O + (size_t)row * DM;
#pragma unroll
                for (int bj = 0; bj < 2; ++bj) *(u32x4*)(rowp + EPI_COL(bj)) = pack8(acc[ai][bj][m][0] * gt, acc[ai][bj][m][1] * gt); }
    }
};
}

#define XB_TMO      128
#define XB_XCNT(j)  (256  + 64 * (j))
#define XB_XSUB(j)  (1280 + 64 * (j))
#define XB_XGEN(j)  (2304 + 64 * (j))
#define XB_TOP      3328
#define XB_TOPGEN   3392
#define XCD_BAR_WORDS 3456
#define XB_SPIN_CAP (1u << 22)

__device__ __forceinline__ unsigned xb_ld(unsigned* p)              { return __hip_atomic_load(p, __ATOMIC_RELAXED, __HIP_MEMORY_SCOPE_AGENT); }
__device__ __forceinline__ unsigned xb_add(unsigned* p, unsigned v) { return __hip_atomic_fetch_add(p, v, __ATOMIC_RELAXED, __HIP_MEMORY_SCOPE_AGENT); }
__device__ __forceinline__ unsigned xb_xcc_id() { return (unsigned)__builtin_amdgcn_s_getreg((3 << 11) | 20) & 0xFu; }
#define XB_SPIN(cond, bar) do { unsigned _sp = 0; while (cond) { __builtin_amdgcn_s_sleep(1); \
    if ((++_sp & 255u) == 0u) { if (xb_ld(&(bar)[XB_TMO])) break; if (_sp > XB_SPIN_CAP) { atomicAdd(&(bar)[XB_TMO], 1u); break; } } } } while (0)

struct XcdBarrier { unsigned* bar; unsigned x; volatile LAS unsigned* st; };

__device__ __forceinline__ XcdBarrier xcd_barrier_post(unsigned* bar, volatile LAS unsigned* st) {
    XcdBarrier b; b.bar = bar; b.x = xb_xcc_id(); b.st = st;
    if (threadIdx.x == 0) (void)xb_add(&bar[XB_XCNT(b.x)], 1u);
    return b;
}
__device__ __forceinline__ void xcd_barrier_complete(unsigned* bar, unsigned x, unsigned& nloc, unsigned& nx) {
    const unsigned G = gridDim.x * gridDim.y * gridDim.z;
    unsigned sum, cnt, mine, sp = 0u;
    for (;;) {
        sum = 0u; cnt = 0u; mine = 0u;
#pragma unroll
        for (unsigned j = 0; j < 16; ++j) { const unsigned c = xb_ld(&bar[XB_XCNT(j)]); sum += c; cnt += (c > 0u) ? 1u : 0u; mine = (j == x) ? c : mine; }
        if (sum == G) break;
        __builtin_amdgcn_s_sleep(1);
        if ((++sp & 255u) == 0u) { if (xb_ld(&bar[XB_TMO])) break; if (sp > XB_SPIN_CAP) { atomicAdd(&bar[XB_TMO], 1u); break; } }
    }
    nloc = mine > 0u ? mine : 1u; nx = cnt > 0u ? cnt : 1u;
}
__device__ __forceinline__ void xcd_barrier(const XcdBarrier& b, int wave_) {
    asm volatile("s_waitcnt vmcnt(0)" ::: "memory");
    __syncthreads();
    int tl_ = wave_ * 64 + fresh_lane();
    if (tl_ == 0) {
        unsigned* bar = b.bar;
        __builtin_amdgcn_s_waitcnt(0);
        unsigned nloc = b.st[0], nx = b.st[1];
        if (nloc == 0u) { xcd_barrier_complete(bar, b.x, nloc, nx); b.st[0] = nloc; b.st[1] = nx; }
        const unsigned old = xb_add(&bar[XB_XSUB(b.x)], 1u);
        const unsigned gen = old / nloc;
        if (old + 1u == (gen + 1u) * nloc) {
            __builtin_amdgcn_fence(__ATOMIC_RELEASE, "agent");
            asm volatile("s_waitcnt vmcnt(0)" ::: "memory");
            const unsigned og = xb_add(&bar[XB_TOP], 1u);
            const unsigned tg = og / nx;
            if (og + 1u == (tg + 1u) * nx) xb_add(&bar[XB_TOPGEN], 1u);
            else XB_SPIN(xb_ld(&bar[XB_TOPGEN]) == tg, bar);
            __builtin_amdgcn_fence(__ATOMIC_ACQUIRE, "agent");
            xb_add(&bar[XB_XGEN(b.x)], 1u);
            asm volatile("s_waitcnt vmcnt(0)" ::: "memory");
        } else {
            XB_SPIN(xb_ld(&bar[XB_XGEN(b.x)]) == gen, bar);
            __builtin_amdgcn_fence(__ATOMIC_ACQUIRE, "agent");
            asm volatile("s_waitcnt vmcnt(0)" ::: "memory");
        }
    }
    __syncthreads();
}

struct Args { const void* in[22]; float* out; unsigned char* ws; };
struct Frame {
    LAS unsigned char* lds; volatile LAS unsigned* MISC; unsigned* ctl;
    int tid, lane, wave, gw; static constexpr int G = 256;
};
__device__ __forceinline__ void glds16(const void* g, LAS void* l) { __builtin_amdgcn_global_load_lds((const unsigned*)g, (LAS unsigned*)l, 16, 0, 0); }
__device__ __forceinline__ int mbcnt64(u64 m) { return (int)__builtin_amdgcn_mbcnt_hi((unsigned)(m >> 32), __builtin_amdgcn_mbcnt_lo((unsigned)m, 0u)); }

__device__ __forceinline__ int il64(int d) { return d < 32 ? 2 * d : 2 * (d - 32) + 1; }
__device__ __forceinline__ int il32(int d) { return d < 16 ? 2 * d : (d < 32 ? 2 * (d - 16) + 1 : d); }
__device__ __forceinline__ int map_row(int mode, int n) {
    if (mode == 1) return n < 2304 ? (n & ~63) + il64(n & 63) : n;
    if (mode == 2) return ((n >> 7) << 8) + (n & 127);
    if (mode == 3) return ((n >> 7) << 8) + 128 + (n & 127);
    if (mode == 4) {
        if (n < 3072) { const int h = n / 192, r = n - h * 192; return r < 128 ? h * 128 + r : 2048 + h * 64 + il64(r - 128); }
        if (n < 3584) return n;
        if (n < 3648) return 3584 + il64(n - 3584);
        if (n < 4672) { const int j = n - 3648; return 3840 + (j & ~63) + il32(j & 63); }
        if (n < 4736) return 3648 + il32(n - 4672);
        return 3712 + (n - 4736);
    }
    return n;
}
__device__ __forceinline__ void tr_item(const float* __restrict__ W, int N, bf16_t* WT, int ldo, int kofs, int mode, LAS float* scr, int item, int lane, float f8scale = 0.f, int rlo = 0, int rhi = 1 << 30) {
    const int nblk = (N + 63) >> 6, kb = item / nblk, nb = item - kb * nblk, k0 = 64 * kb, n0 = 64 * nb;
    const int nc = n0 + 4 * (lane & 15); const bool okr = nc < N; const float* wp = W + (size_t)(k0 + (lane >> 4)) * N + nc;
    f32x4 v[16];
#pragma unroll
    for (int i = 0; i < 16; ++i) v[i] = okr ? *(const f32x4*)(wp + (size_t)(4 * i) * N) : (f32x4){0.f, 0.f, 0.f, 0.f};
#pragma unroll
    for (int i = 0; i < 16; ++i) { const int k = 4 * i + (lane >> 4); *(LAS f32x4*)(scr + k * 64 + ((4 * (lane & 15) + 4 * (i >> 1)) & 63)) = v[i]; }
    LDS_WAIT();
    const int c = lane & 7;
#pragma unroll
    for (int j = 0; j < 8; ++j) { const int nl = (lane >> 3) + 8 * j, n = n0 + nl; const LAS float* s = scr + (8 * c) * 64 + ((nl + 4 * c) & 63);
        const int orow = map_row(mode, n); const bool okw = n < N && orow >= rlo && orow < rhi;
        if (f8scale > 0.f) { u32x2 o8; o8.x = pk4_fp8(s[0 * 64] * f8scale, s[1 * 64] * f8scale, s[2 * 64] * f8scale, s[3 * 64] * f8scale); o8.y = pk4_fp8(s[4 * 64] * f8scale, s[5 * 64] * f8scale, s[6 * 64] * f8scale, s[7 * 64] * f8scale);
            if (okw) *(u32x2*)((unsigned char*)WT + (size_t)orow * ldo + kofs + k0 + 8 * c) = o8; }
        else {
        u32x4 o; o.x = cvt_pk_bf16(s[0 * 64], s[1 * 64]); o.y = cvt_pk_bf16(s[2 * 64], s[3 * 64]); o.z = cvt_pk_bf16(s[4 * 64], s[5 * 64]); o.w = cvt_pk_bf16(s[6 * 64], s[7 * 64]);
        if (okw) *(u32x4*)(WT + (size_t)orow * ldo + kofs + k0 + 8 * c) = o; } }
    LDS_WAIT();
}
__device__ __forceinline__ void tr_matrix(const Frame& F, const float* W, int K, int N, bf16_t* WT, int ldo, int kofs, int mode, float f8scale = 0.f, int rlo = 0, int rhi = 1 << 30) {
    LAS float* scr = (LAS float*)(F.lds + F.wave * 16384);
    const int nitems = (K >> 6) * ((N + 63) >> 6), NGW = F.G * NWAVES;
    for (int it = F.gw; it < nitems; it += NGW) tr_item(W, N, WT, ldo, kofs, mode, scr, it, F.lane, f8scale, rlo, rhi);
}
__device__ __forceinline__ void cvt_linear(const Frame& F, const float* src, bf16_t* dst, size_t n8) {
    const size_t NT = (size_t)F.G * NTHREADS;
    for (size_t i = (size_t)blockIdx.x * NTHREADS + F.tid; i < n8; i += NT) { const f32x4 a = *(const f32x4*)(src + i * 8), b = *(const f32x4*)(src + i * 8 + 4); *(u32x4*)(dst + i * 8) = pg8::pack8(a, b); }
}
__device__ __forceinline__ void cvt_linear8(const Frame& F, const float* src, unsigned char* dst, size_t n8) {
    const size_t NT = (size_t)F.G * NTHREADS;
    for (size_t i = (size_t)blockIdx.x * NTHREADS + F.tid; i < n8; i += NT) { const f32x4 a = *(const f32x4*)(src + i * 8), b = *(const f32x4*)(src + i * 8 + 4); *(u32x2*)(dst + i * 8) = pg8::pack8_fp8(a, b, 1.0f); }
}
__device__ __forceinline__ void sincos_d(double ang, float& c, float& s) {
    const double n = __builtin_rint(ang * 0.6366197723675814);
    double r = __builtin_fma(-n, 1.5707963267948966, ang); r = __builtin_fma(-n, 6.123233995736766e-17, r);
    const double r2 = r * r;
    const double sp = r * (1.0 + r2 * (-1.0 / 6.0 + r2 * (1.0 / 120.0 + r2 * (-1.0 / 5040.0 + r2 * (1.0 / 362880.0 + r2 * (-1.0 / 39916800.0 + r2 * (1.0 / 6227020800.0)))))));
    const double cp = 1.0 + r2 * (-0.5 + r2 * (1.0 / 24.0 + r2 * (-1.0 / 720.0 + r2 * (1.0 / 40320.0 + r2 * (-1.0 / 3628800.0 + r2 * (1.0 / 479001600.0 + r2 * (-1.0 / 87178291200.0)))))));
    const int q = (int)((long long)n & 3);
    const float sf = (float)sp, cf = (float)cp;
    c = q == 0 ? cf : (q == 1 ? -sf : (q == 2 ? -cf : sf));
    s = q == 0 ? sf : (q == 1 ? cf : (q == 2 ? -sf : -cf));
}
__device__ __forceinline__ void rope_tables(const Frame& F, const int* pos, float* tab64, float* tab32) {
    const int NT = F.G * NTHREADS;
    for (int i = blockIdx.x * NTHREADS + F.tid; i < T * 48; i += NT) {
        const int t = i / 48, f = i - t * 48; const bool is64 = f < 32; const int fi = is64 ? f : f - 32;
        const double base = is64 ? 0.7498942093324559 : 0.5623413251903491;
        double inv = 1.0; for (int k = 0; k < fi; ++k) inv *= base;
        float c, s; sincos_d((double)pos[t] * inv, c, s);
        float* o = is64 ? tab64 + ((size_t)t * 32 + fi) * 2 : tab32 + ((size_t)t * 16 + fi) * 2; o[0] = c; o[1] = s;
    }
}

constexpr int MOE_CONV_ITEMS = 8 * 3 * 3584;
constexpr int TOPK_CONV = 11;
__device__ __forceinline__ void moe_conv_item(const float* w1, const float* w3, const float* w2, unsigned char* ws, LAS float* scr, int it, int lane) {
    const int e = it / (3 * 3584), r = it - e * (3 * 3584), mtx = r / 3584, sub = r - mtx * 3584;
    if (mtx < 2) tr_item((mtx == 0 ? w1 : w3) + (size_t)e * DM * MFFN, MFFN, (bf16_t*)(ws + WS_MW13 + (size_t)e * 2 * MFFN * DM), DM, 0, 2 + mtx, scr, sub, lane, W13_F8SCALE);
    else tr_item(w2 + (size_t)e * MFFN * DM, DM, (bf16_t*)(ws + WS_MW2 + (size_t)e * DM * MFFN), MFFN, 0, 0, scr, sub, lane, W2_F8SCALE);
}

__device__ __forceinline__ unsigned ln_col(int lane, int q) { return 8u * (unsigned)(lane & 63) + 512u * (unsigned)(q >> 1) + 4u * (unsigned)(q & 1); }
__device__ __forceinline__ void ln_load16(f32x4 (&v)[8], const bf16_t* row, int lane) {
#pragma unroll
    for (int j = 0; j < 4; ++j) pg8::unpack8(*(const u32x4*)(row + ln_col(lane, 2 * j)), v[2 * j], v[2 * j + 1]);
}
__device__ __forceinline__ void ln_store16(const f32x4 (&v)[8], bf16_t* row, int lane) {
#pragma unroll
    for (int j = 0; j < 4; ++j) *(u32x4*)(row + ln_col(lane, 2 * j)) = pg8::pack8(v[2 * j], v[2 * j + 1]);
}
__device__ __forceinline__ void ln_store8(const f32x4 (&v)[8], unsigned char* row, int lane) {
#pragma unroll
    for (int j = 0; j < 4; ++j) *(u32x2*)(row + ln_col(lane, 2 * j)) = pg8::pack8_fp8(v[2 * j], v[2 * j + 1], 1.0f);
}
__device__ __forceinline__ void ln_core(f32x4 (&v)[8], const float* g, const float* bb, int lane) {
    float s = 0.f;
#pragma unroll
    for (int j = 0; j < 8; ++j) s += (v[j][0] + v[j][1]) + (v[j][2] + v[j][3]);
    const float mean = wave_sum(s) * (1.0f / DM); float s2 = 0.f;
#pragma unroll
    for (int j = 0; j < 8; ++j) { v[j] = v[j] - mean; s2 += (v[j][0] * v[j][0] + v[j][1] * v[j][1]) + (v[j][2] * v[j][2] + v[j][3] * v[j][3]); }
    const float rstd = 1.0f / sqrtf(wave_sum(s2) * (1.0f / DM) + LN_EPS);
    int l2 = lane; asm volatile("" : "+v"(l2) :: "memory");
#pragma unroll
    for (int j = 0; j < 8; ++j) { const f32x4 gv = *(const f32x4*)(g + ln_col(l2, j)), bv = *(const f32x4*)(bb + ln_col(l2, j)); v[j] = v[j] * rstd * gv + bv; }
}
template <bool OUT8> __device__ __forceinline__ void ln_phase(const Frame& F, const bf16_t* YH, bf16_t* X16, unsigned char* X8, const float* g, const float* bb) {
    const int NGW = F.G * NWAVES;
    for (int m = F.gw; m < T; m += NGW) { f32x4 v[8];
        ln_load16(v, YH + (size_t)m * DM, F.lane); ln_core(v, g, bb, F.lane); ln_store16(v, X16 + (size_t)m * DM, F.lane);
        if constexpr (OUT8) ln_store8(v, X8 + (size_t)m * DM, F.lane); }
}

__device__ __forceinline__ int crow(int r, int hi) { return (r & 3) + 8 * (r >> 2) + 4 * hi; }
template <bool OUT8> __device__ __forceinline__ void swa_phase(const Frame& F, bf16_t* Q, const bf16_t* Kb, const bf16_t* VT, const float* sinks, unsigned char* O8) {
    const int lane = F.lane, l31 = lane & 31, hf = lane >> 5;
    for (int wi = blockIdx.x; wi < 4096; wi += F.G) {
        const int kvh = wi & 3, qsi = (wi >> 2) & 511, b = wi >> 11, h = kvh * 8 + F.wave, q0 = qsi * 32;
        const size_t row0 = (size_t)b * SEQ + q0;
        bf16x8 qf[4];
#pragma unroll
        for (int kk = 0; kk < 4; ++kk) { if constexpr (SWA_FRAG) qf[kk] = *(const bf16x8*)(Q + ((((size_t)(b * 32 + h) * 512 + qsi) * 4 + kk) * 64 + lane) * 8);
            else qf[kk] = *(const bf16x8*)(Q + (row0 + l31) * 2048 + h * 64 + 16 * kk + 8 * hf); }
        f32x16 sc[5];
#pragma unroll
        for (int kt = 0; kt < 5; ++kt) {
            int kpos = q0 - 128 + 32 * kt + l31; kpos = kpos < 0 ? 0 : kpos;
            const bf16_t* kp = Kb + ((size_t)b * SEQ + kpos) * 256 + kvh * 64 + 8 * hf;
            f32x16 a;
#pragma unroll
            for (int r = 0; r < 16; ++r) a[r] = 0.f;
            const int kblk = qsi - 4 + kt < 0 ? 0 : qsi - 4 + kt;
#pragma unroll
            for (int kk = 0; kk < 4; ++kk) { bf16x8 kf; if constexpr (SWA_FRAG) kf = *(const bf16x8*)(Kb + ((((size_t)(b * 4 + kvh) * 512 + kblk) * 4 + kk) * 64 + lane) * 8); else kf = *(const bf16x8*)(kp + 16 * kk);
                a = __builtin_amdgcn_mfma_f32_32x32x16_bf16(kf, qf[kk], a, 0, 0, 0); }
            sc[kt] = a;
        }
        int l31m = l31, hfm = hf; asm volatile("" : "+v"(l31m), "+v"(hfm));
        const float sink2 = sinks[h] * LOG2E; const int qpos = q0 + l31m;
        float mx = sink2;
#pragma unroll
        for (int kt = 0; kt < 5; ++kt)
#pragma unroll
            for (int r = 0; r < 16; ++r) { const int kpos = q0 - 128 + 32 * kt + crow(r, hfm); const bool ok = kpos >= 0 && kpos <= qpos && (qpos - kpos) < 128;
                const float v = ok ? sc[kt][r] : -INFINITY; sc[kt][r] = v; mx = fmaxf(mx, v); }
        mx = fmaxf(mx, shx(mx, 32, lane));
        float sum = 0.f;
#pragma unroll
        for (int kt = 0; kt < 5; ++kt)
#pragma unroll
            for (int r = 0; r < 16; ++r) { const float p = __builtin_amdgcn_exp2f(sc[kt][r] - mx); sc[kt][r] = p; sum += p; }
        sum += shx(sum, 32, lane);
        const float inv = 1.0f / (sum + __builtin_amdgcn_exp2f(sink2 - mx));
        f32x16 o[2];
#pragma unroll
        for (int r = 0; r < 16; ++r) { o[0][r] = 0.f; o[1][r] = 0.f; }
#pragma unroll
        for (int kt = 0; kt < 5; ++kt)
#pragma unroll
            for (int c = 0; c < 2; ++c) {
                bf16x8 pb; { u32x4 w; w.x = cvt_pk_bf16(sc[kt][8 * c + 0], sc[kt][8 * c + 1]); w.y = cvt_pk_bf16(sc[kt][8 * c + 2], sc[kt][8 * c + 3]); w.z = cvt_pk_bf16(sc[kt][8 * c + 4], sc[kt][8 * c + 5]); w.w = cvt_pk_bf16(sc[kt][8 * c + 6], sc[kt][8 * c + 7]); pb = __builtin_bit_cast(bf16x8, w); }
                int kb = q0 - 128 + 32 * kt + 16 * c + 4 * hf; int kb0 = kb < 0 ? 0 : kb, kb1 = kb + 8 < 0 ? 0 : kb + 8;
#pragma unroll
                for (int mt = 0; mt < 2; ++mt) { bf16x8 va;
                    if constexpr (SWA_FRAG) { const int vblk = qsi - 4 + kt < 0 ? 0 : qsi - 4 + kt; va = *(const bf16x8*)(VT + (((((size_t)(b * 4 + kvh) * 512 + vblk) * 2 + c) * 2 + mt) * 64 + lane) * 8); }
                    else { const bf16_t* vp = VT + ((size_t)(b * 4 + kvh) * 64 + 32 * mt + l31) * SEQ;
                    const u32x2 v0 = *(const u32x2*)(vp + kb0), v1 = *(const u32x2*)(vp + kb1); u32x4 w; w.x = v0.x; w.y = v0.y; w.z = v1.x; w.w = v1.y; va = __builtin_bit_cast(bf16x8, w); }
                    o[mt] = __builtin_amdgcn_mfma_f32_32x32x16_bf16(va, pb, o[mt], 0, 0, 0); }
            }
        bf16_t* op = Q + (row0 + l31) * 2048 + h * 64; unsigned char* op8 = O8 + (row0 + l31) * 2048 + h * 64; const float inv8 = inv * O0_F8SCALE;
#pragma unroll
        for (int mt = 0; mt < 2; ++mt)
#pragma unroll
            for (int r4 = 0; r4 < 4; ++r4) {
                if constexpr (OUT8) *(unsigned*)(op8 + 32 * mt + 8 * r4 + 4 * hf) = pk4_fp8(o[mt][4 * r4] * inv8, o[mt][4 * r4 + 1] * inv8, o[mt][4 * r4 + 2] * inv8, o[mt][4 * r4 + 3] * inv8);
                else { u32x2 w; w.x = cvt_pk_bf16(o[mt][4 * r4] * inv, o[mt][4 * r4 + 1] * inv); w.y = cvt_pk_bf16(o[mt][4 * r4 + 2] * inv, o[mt][4 * r4 + 3] * inv);
                *(u32x2*)(op + 32 * mt + 8 * r4 + 4 * hf) = w; } }
    }
}

__device__ __forceinline__ void kvnorm_phase(const Frame& F, const float* CRAW, const float* gk, bf16_t* KV) {
    const int NGW = F.G * NWAVES;
    for (int m = F.gw; m < T; m += NGW) { const float* cr = CRAW + (size_t)m * 512;
        const f32x4 a = *(const f32x4*)(cr + 4 * F.lane), b = *(const f32x4*)(cr + 256 + 4 * F.lane);
        float s = (a[0] * a[0] + a[1] * a[1]) + (a[2] * a[2] + a[3] * a[3]) + (b[0] * b[0] + b[1] * b[1]) + (b[2] * b[2] + b[3] * b[3]);
        const float r = 1.0f / sqrtf(wave_sum(s) * (1.0f / 512.0f) + RMS_EPS);
        const f32x4 ga = *(const f32x4*)(gk + 4 * F.lane), gb = *(const f32x4*)(gk + 256 + 4 * F.lane);
        if constexpr (F8_KV) { const float r8 = r * KV_F8SCALE; unsigned char* kp = (unsigned char*)KV + (size_t)m * 576 + 4 * F.lane;
            *(unsigned*)kp = pk4_fp8(a[0] * r8 * ga[0], a[1] * r8 * ga[1], a[2] * r8 * ga[2], a[3] * r8 * ga[3]);
            *(unsigned*)(kp + 256) = pk4_fp8(b[0] * r8 * gb[0], b[1] * r8 * gb[1], b[2] * r8 * gb[2], b[3] * r8 * gb[3]); continue; }
        u32x2 w0, w1; w0.x = cvt_pk_bf16(a[0] * r * ga[0], a[1] * r * ga[1]); w0.y = cvt_pk_bf16(a[2] * r * ga[2], a[3] * r * ga[3]);
        w1.x = cvt_pk_bf16(b[0] * r * gb[0], b[1] * r * gb[1]); w1.y = cvt_pk_bf16(b[2] * r * gb[2], b[3] * r * gb[3]);
        *(u32x2*)(KV + (size_t)m * 576 + 4 * F.lane) = w0; *(u32x2*)(KV + (size_t)m * 576 + 256 + 4 * F.lane) = w1; }
}

__device__ __forceinline__ float relu1(float a) { return __builtin_amdgcn_fmed3f(a, 0.f, 3.0e38f); }
__device__ __forceinline__ unsigned f2key(float f) { const unsigned u = __float_as_uint(f); return u ^ ((unsigned)((int)u >> 31) | 0x80000000u); }
__device__ __forceinline__ float key2f(unsigned k) { const unsigned u = (k & 0x80000000u) ? (k ^ 0x80000000u) : ~k; return __uint_as_float(u); }
__device__ __forceinline__ unsigned compact256(LAS u64* buf, int n, int lane) {
    u64 e[8];
#pragma unroll
    for (int i = 0; i < 8; ++i) e[i] = (lane + 64 * i < n) ? buf[lane + 64 * i] : 0ull;
    unsigned thr = 0u;
    for (int bit = 31; bit >= 0; --bit) {
        const unsigned cand = thr | (1u << bit); int c = 0;
#pragma unroll
        for (int i = 0; i < 8; ++i) c += __popcll(__ballot((unsigned)(e[i] >> 32) >= cand));
        if (c >= 256) thr = cand;
    }
    int ngt = 0;
#pragma unroll
    for (int i = 0; i < 8; ++i) ngt += __popcll(__ballot((unsigned)(e[i] >> 32) > thr));
    int pos_gt = 0, pos_eq = ngt;
#pragma unroll
    for (int i = 0; i < 8; ++i) { const unsigned k = (unsigned)(e[i] >> 32); const bool gt = k > thr, eq = k == thr; const u64 mg = __ballot(gt), me = __ballot(eq);
        if (gt) buf[pos_gt + mbcnt64(mg)] = e[i];
        const int re = pos_eq + mbcnt64(me); if (eq && re < 256) buf[re] = e[i];
        pos_gt += __popcll(mg); pos_eq += __popcll(me); }
    return thr;
}
__device__ __forceinline__ unsigned compact_bound(LAS u64* buf, int n, int lane, unsigned lo, int& n_out) {
    u64 e[8]; unsigned mx = 0u;
#pragma unroll
    for (int i = 0; i < 8; ++i) { e[i] = (lane + 64 * i < n) ? buf[lane + 64 * i] : 0ull; const unsigned k = (unsigned)(e[i] >> 32); mx = k > mx ? k : mx; }
#pragma unroll
    for (int o = 1; o < 64; o <<= 1) { const unsigned t = (unsigned)__builtin_amdgcn_ds_bpermute((lane ^ o) << 2, (int)mx); mx = t > mx ? t : mx; }
    mx = (unsigned)__builtin_amdgcn_readfirstlane((int)mx);
    const unsigned diff = mx ^ lo; const int hb = diff ? 31 - __builtin_clz(diff) : 0;
    unsigned thr = hb >= 31 ? 0u : (lo & ~((2u << hb) - 1u)); int cge = n;
    for (int bit = hb; bit >= 0; --bit) {
        const unsigned cand = thr | (1u << bit); int c = 0;
#pragma unroll
        for (int i = 0; i < 8; ++i) c += __popcll(__ballot((unsigned)(e[i] >> 32) >= cand));
        if (c >= 256) { thr = cand; cge = c; if (c <= 288) break; }
    }
    int pos = 0;
#pragma unroll
    for (int i = 0; i < 8; ++i) { const bool ge = (unsigned)(e[i] >> 32) >= thr && (lane + 64 * i < n); const u64 mg = __ballot(ge);
        if (ge) buf[pos + mbcnt64(mg)] = e[i];
        pos += __popcll(mg); }
    n_out = pos;
    return thr;
}
template <bool CONV = false> __device__ __forceinline__ void topk_phase(const Frame& F, const bf16_t* QI, const bf16_t* KIF, const float* WI, unsigned short* SEL) {
    const int lane = F.lane, l31 = lane & 31, hf = lane >> 5, wave = F.wave;
    LAS u64* mybuf = (LAS u64*)F.lds + (size_t)(wave * 4) * 512;
    const unsigned lmask_lt = (1u << l31) - 1u; const int hfm = -hf;
    for (int pu = blockIdx.x; pu < 512; pu += F.G) {
        const int b = pu >> 8, pi = pu & 255;
        for (int half = 0; half < 2; ++half) {
            const int tq = half == 0 ? pi : 511 - pi, q0 = tq * 32, nsteps = tq + 1;
            const size_t trow0 = (size_t)b * SEQ + q0 + 4 * wave;
            bf16x8 aq[2][4]; float wq[2][16];
#pragma unroll
            for (int s = 0; s < 2; ++s) {
                const int qq = 2 * s + ((l31 >> 2) & 1), hd = 4 * (l31 >> 3) + (l31 & 3);
#pragma unroll
                for (int kk = 0; kk < 4; ++kk) aq[s][kk] = *(const bf16x8*)(QI + ((trow0 + qq) * 16 + hd) * 64 + 16 * kk + 8 * hf);
                const float* wp = WI + (trow0 + 2 * s + hf) * 16;
#pragma unroll
                for (int r4 = 0; r4 < 4; ++r4) { const f32x4 w = *(const f32x4*)(wp + 4 * r4); wq[s][4 * r4] = w[0]; wq[s][4 * r4 + 1] = w[1]; wq[s][4 * r4 + 2] = w[2]; wq[s][4 * r4 + 3] = w[3]; }
            }
            float psc0 = 0.f, psc1 = 0.f; int pix0 = 0, pix1 = 0; bool pv0 = false, pv1 = false;
            float thr0 = -INFINITY, thr1 = -INFINITY; int c0 = 0, c1 = 0, c2 = 0, c3 = 0; unsigned b0 = 0x007fffffu, b1 = 0x007fffffu, b2 = 0x007fffffu, b3 = 0x007fffffu;
            const bf16_t* kbase = KIF + (size_t)b * 512 * 4 * 64 * 8 + (size_t)lane * 8;
            bf16x8 k0[4], k1[4], k2[4], k3[4];
#pragma unroll
            for (int kk = 0; kk < 4; ++kk) { k0[kk] = *(const bf16x8*)(kbase + (size_t)(0 * 4 + kk) * 512); k1[kk] = *(const bf16x8*)(kbase + (size_t)((nsteps > 1 ? 1 : 0) * 4 + kk) * 512);
                k2[kk] = *(const bf16x8*)(kbase + (size_t)((nsteps > 2 ? 2 : nsteps - 1) * 4 + kk) * 512); k3[kk] = *(const bf16x8*)(kbase + (size_t)((nsteps > 3 ? 3 : nsteps - 1) * 4 + kk) * 512); }
#define TOPK_STEP(KB, STEP) { const int kidx = 32 * (STEP) + l31; \
    f32x16 a0_, a1_; _Pragma("unroll") for (int r = 0; r < 16; ++r) { a0_[r] = 0.f; a1_[r] = 0.f; } \
    _Pragma("unroll") for (int kk = 0; kk < 4; ++kk) a0_ = __builtin_amdgcn_mfma_f32_32x32x16_bf16(aq[0][kk], KB[kk], a0_, 0, 0, 0); \
    _Pragma("unroll") for (int kk = 0; kk < 4; ++kk) a1_ = __builtin_amdgcn_mfma_f32_32x32x16_bf16(aq[1][kk], KB[kk], a1_, 0, 0, 0); \
    { const int sn_ = (STEP) + 4 < nsteps ? (STEP) + 4 : nsteps - 1; _Pragma("unroll") for (int kk = 0; kk < 4; ++kk) KB[kk] = *(const bf16x8*)(kbase + (size_t)(sn_ * 4 + kk) * 512); }     \
    float sc0_ = 0.f, sc1_ = 0.f; \
    _Pragma("unroll") for (int r = 0; r < 16; ++r) sc0_ = fmaf(wq[0][r], relu1(a0_[r]), sc0_); \
    _Pragma("unroll") for (int r = 0; r < 16; ++r) sc1_ = fmaf(wq[1][r], relu1(a1_[r]), sc1_); \
    const int tql0_ = q0 + 4 * wave + hf; \
    const bool pass0_ = (sc0_ > thr0) && (kidx <= tql0_), pass1_ = (sc1_ > thr1) && (kidx <= tql0_ + 2); \
      \
    if (__ballot((pass0_ && pv0) || (pass1_ && pv1))) { TOPK_FLUSH(); } \
    psc0 = pass0_ ? sc0_ : psc0; pix0 = pass0_ ? kidx : pix0; pv0 = pv0 || pass0_; \
    psc1 = pass1_ ? sc1_ : psc1; pix1 = pass1_ ? kidx : pix1; pv1 = pv1 || pass1_; }
#define TOPK_FLUSH() { const u64 mask0_ = __ballot(pv0), mask1_ = __ballot(pv1); \
        if (mask0_) { const unsigned lo = (unsigned)mask0_, hi = (unsigned)(mask0_ >> 32); const int plo = __popc(lo), phi = __popc(hi); \
          const int rank = mbcnt64(mask0_) - (plo & hfm); const int cm = c0 + ((c1 - c0) & hfm); \
          if (pv0) mybuf[hf * 512 + cm + rank] = ((u64)f2key(psc0) << 32) | (unsigned)pix0; c0 += plo; c1 += phi; } \
        if (mask1_) { const unsigned lo = (unsigned)mask1_, hi = (unsigned)(mask1_ >> 32); const int plo = __popc(lo), phi = __popc(hi); \
          const int rank = mbcnt64(mask1_) - (plo & hfm); const int cm = c2 + ((c3 - c2) & hfm); \
          if (pv1) mybuf[(2 + hf) * 512 + cm + rank] = ((u64)f2key(psc1) << 32) | (unsigned)pix1; c2 += plo; c3 += phi; } \
        pv0 = false; pv1 = false; \
        const int cmx_ = max(max(c0, c1), max(c2, c3)); \
        if (cmx_ > 480) { \
        if (c0 > 480) { b0 = compact_bound(mybuf, c0, lane, b0, c0); const float nt = key2f(b0); thr0 = hf == 0 ? nt : thr0; } \
        if (c1 > 480) { b1 = compact_bound(mybuf + 512, c1, lane, b1, c1); const float nt = key2f(b1); thr0 = hf == 1 ? nt : thr0; } \
        if (c2 > 480) { b2 = compact_bound(mybuf + 1024, c2, lane, b2, c2); const float nt = key2f(b2); thr1 = hf == 0 ? nt : thr1; } \
        if (c3 > 480) { b3 = compact_bound(mybuf + 1536, c3, lane, b3, c3); const float nt = key2f(b3); thr1 = hf == 1 ? nt : thr1; } } }
            for (int st = 0; st < nsteps; st += 4) {
                TOPK_STEP(k0, st);
                if (st + 1 < nsteps) TOPK_STEP(k1, st + 1);
                if (st + 2 < nsteps) TOPK_STEP(k2, st + 2);
                if (st + 3 < nsteps) TOPK_STEP(k3, st + 3);
            }
            TOPK_FLUSH();
#undef TOPK_STEP
#undef TOPK_FLUSH
#pragma unroll
            for (int qi = 0; qi < 4; ++qi) {
                int c = qi == 0 ? c0 : (qi == 1 ? c1 : (qi == 2 ? c2 : c3)); LAS u64* bq = mybuf + qi * 512;
                if (c > 256) { (void)compact256(bq, c, lane); c = 256; }
                LDS_WAIT();
                unsigned short v[4];
#pragma unroll
                for (int j = 0; j < 4; ++j) { const int e = 4 * lane + j; v[j] = e < c ? (unsigned short)(bq[e] & 0xffffull) : (unsigned short)0xffff; }
                u32x2 w; w.x = (unsigned)v[0] | ((unsigned)v[1] << 16); w.y = (unsigned)v[2] | ((unsigned)v[3] << 16);
                *(u32x2*)(SEL + (trow0 + qi) * 256 + 4 * lane) = w;
            }
            LDS_WAIT();
            if constexpr (CONV) { int lane2 = F.lane; asm volatile("" : "+v"(lane2)); const int NGW = F.G * NWAVES, iter = 2 * ((pu - (int)blockIdx.x) / F.G) + half;
                typedef const unsigned char __attribute__((address_space(4))) kab_t;
                kab_t* ka = (kab_t*)__builtin_amdgcn_kernarg_segment_ptr();
                const float* w1 = *(const float* const __attribute__((address_space(4)))*)(ka + 15 * 8); const float* w3 = *(const float* const __attribute__((address_space(4)))*)(ka + 16 * 8);
                const float* w2 = *(const float* const __attribute__((address_space(4)))*)(ka + 17 * 8); unsigned char* ws = *(unsigned char* const __attribute__((address_space(4)))*)(ka + 23 * 8);
#pragma unroll 1
                for (int k = 0; k < TOPK_CONV; ++k) { const int it = F.gw + NGW * (TOPK_CONV * iter + k); if (it < MOE_CONV_ITEMS) moe_conv_item(w1, w3, w2, ws, (LAS float*)mybuf, it, lane2); } }
        }
    }
}

__device__ __forceinline__ bf16x4 tr_read16(const LAS unsigned char* p) { return __builtin_bit_cast(bf16x4, __builtin_amdgcn_ds_read_tr16_b64_v4i16((LAS bf16x4*)p)); }
__device__ __forceinline__ void dsa_attn_phase(const Frame& F, const bf16_t* QLAT, bf16_t* OUT, const bf16_t* QR, const bf16_t* KV, const unsigned short* SEL, const float* w1, const float* w3, const float* w2, unsigned char* ws) {
    LAS unsigned char* wb = F.lds + F.wave * DSA_WBUF; LAS unsigned char* tails = wb + 16640;
    const unsigned char* KVb = (const unsigned char*)KV;
    const int NGW = F.G * NWAVES;
    for (int tg = F.gw; tg < T; tg += NGW) {
        int lane = F.lane; asm volatile("" : "+v"(lane));
        const int l15 = lane & 15, g = lane >> 4;
        const int b = tg >> 14, t = tg & (SEQ - 1); const int nvalid = t + 1 < 256 ? t + 1 : 256, nsteps = (nvalid + 15) >> 4;
        bf16x8 qf[18];
#pragma unroll
        for (int kk = 0; kk < 16; ++kk) {
            if constexpr (F8_LAT) { const u32x2 w8 = *(const u32x2*)((const unsigned char*)QLAT + ((size_t)tg * 16 + l15) * 512 + 32 * kk + 8 * g);
                const f32x2 f0 = __builtin_amdgcn_cvt_pk_f32_fp8((int)w8.x, false), f1 = __builtin_amdgcn_cvt_pk_f32_fp8((int)w8.x, true), f2 = __builtin_amdgcn_cvt_pk_f32_fp8((int)w8.y, false), f3 = __builtin_amdgcn_cvt_pk_f32_fp8((int)w8.y, true);
                u32x4 wb16; wb16.x = cvt_pk_bf16(f0[0], f0[1]); wb16.y = cvt_pk_bf16(f1[0], f1[1]); wb16.z = cvt_pk_bf16(f2[0], f2[1]); wb16.w = cvt_pk_bf16(f3[0], f3[1]); qf[kk] = __builtin_bit_cast(bf16x8, wb16); }
            else qf[kk] = *(const bf16x8*)(QLAT + ((size_t)tg * 16 + l15) * 512 + 32 * kk + 8 * g); }
#pragma unroll
        for (int kk = 0; kk < 2; ++kk) qf[16 + kk] = *(const bf16x8*)(QR + ((size_t)tg * 16 + l15) * 64 + 32 * kk + 8 * g);
        float m = -INFINITY, lsum = 0.f; f32x4 O[32];
#pragma unroll
        for (int mt = 0; mt < 32; ++mt) O[mt] = (f32x4){0.f, 0.f, 0.f, 0.f};
        for (int st = 0; st < nsteps; ++st) {
            const int slot = 16 * st + l15;
            int idx = slot < nvalid ? (int)SEL[(size_t)tg * 256 + slot] : 0; idx = idx > t ? 0 : idx;
            const int row = b * SEQ + idx;
            LDS_WAIT();
#pragma unroll
            for (int r = 0; r < 16; ++r) { const int rr = __builtin_amdgcn_readlane(row, r); glds16(KVb + (size_t)rr * 1152 + 16 * lane, wb + r * 1040); }
#pragma unroll
            for (int p = 0; p < 2; ++p) glds16(KVb + (size_t)row * 1152 + 1024 + 16 * (4 * p + g), tails + 1024 * p);
            VM_WAIT();
            f32x4 sacc = (f32x4){0.f, 0.f, 0.f, 0.f};
#pragma unroll
            for (int kk = 0; kk < 16; ++kk) { const bf16x8 a = *(const LAS bf16x8*)(wb + l15 * 1040 + (4 * kk + g) * 16); sacc = __builtin_amdgcn_mfma_f32_16x16x32_bf16(a, qf[kk], sacc, 0, 0, 0); }
#pragma unroll
            for (int kk = 0; kk < 2; ++kk) { const bf16x8 a = *(const LAS bf16x8*)(tails + (4 * kk + g) * 256 + l15 * 16); sacc = __builtin_amdgcn_mfma_f32_16x16x32_bf16(a, qf[16 + kk], sacc, 0, 0, 0); }
            float s[4]; float tmax = -INFINITY;
#pragma unroll
            for (int i = 0; i < 4; ++i) { s[i] = (16 * st + 4 * g + i) < nvalid ? sacc[i] * (F8_LAT ? SCALE2_MLA / QLAT_F8SCALE : SCALE2_MLA) : -INFINITY; tmax = fmaxf(tmax, s[i]); }
            tmax = fmaxf(tmax, shx(tmax, 16, lane)); tmax = fmaxf(tmax, shx(tmax, 32, lane));
            const float mnew = fmaxf(m, tmax); const float alpha = __builtin_amdgcn_exp2f(m - mnew); m = mnew;
            float p[4];
#pragma unroll
            for (int i = 0; i < 4; ++i) p[i] = __builtin_amdgcn_exp2f(s[i] - mnew);
            lsum = lsum * alpha + ((p[0] + p[1]) + (p[2] + p[3]));
            if (__any(alpha != 1.0f)) {
#pragma unroll
                for (int mt = 0; mt < 32; ++mt) O[mt] = O[mt] * alpha;
            }
            u32x2 pw; pw.x = cvt_pk_bf16(p[0], p[1]); pw.y = cvt_pk_bf16(p[2], p[3]); const bf16x4 pb = __builtin_bit_cast(bf16x4, pw);
            const LAS unsigned char* trb = wb + (4 * g + (l15 >> 2)) * 1040 + (lane & 3) * 8;
#pragma unroll
            for (int mt = 0; mt < 32; ++mt) { const bf16x4 a = tr_read16(trb + mt * 32); O[mt] = __builtin_amdgcn_mfma_f32_16x16x16bf16_1k(a, pb, O[mt], 0, 0, 0); }
        }
        float lt = lsum + shx(lsum, 16, lane); lt += shx(lt, 32, lane); const float inv = 1.0f / lt;
        if constexpr (F8_LAT) { unsigned char* op8 = (unsigned char*)OUT + ((size_t)tg * 16 + l15) * 512 + 4 * g; const float inv8 = inv * OLAT_F8SCALE;
#pragma unroll
            for (int mt = 0; mt < 32; ++mt) *(unsigned*)(op8 + 16 * mt) = pk4_fp8(O[mt][0] * inv8, O[mt][1] * inv8, O[mt][2] * inv8, O[mt][3] * inv8); }
        else { bf16_t* op = OUT + ((size_t)tg * 16 + l15) * 512 + 4 * g;
#pragma unroll
        for (int mt = 0; mt < 32; ++mt) { u32x2 w; w.x = cvt_pk_bf16(O[mt][0] * inv, O[mt][1] * inv); w.y = cvt_pk_bf16(O[mt][2] * inv, O[mt][3] * inv); *(u32x2*)(op + 16 * mt) = w; } }
        if (w1) { LDS_WAIT(); int lane2 = F.lane; asm volatile("" : "+v"(lane2));
            for (int k = 0; k < 3; ++k) { const int it = F.gw + NGW * (3 * ((tg - F.gw) / NGW) + k); if (it < MOE_CONV_ITEMS) moe_conv_item(w1, w3, w2, ws, (LAS float*)wb, it, lane2); } }
    }
    LDS_WAIT();
}

__device__ __forceinline__ long tr_read8(const LAS unsigned char* p) { return __builtin_bit_cast(long, __builtin_amdgcn_ds_read_tr8_b64_v2i32((LAS i32x2*)p)); }
__device__ __forceinline__ void dsa_attn8_phase(const Frame& F, const unsigned char* QLAT, unsigned char* OUT, const unsigned char* QR, const unsigned char* KVb, const unsigned short* SEL, const float* w1, const float* w3, const float* w2, unsigned char* ws) {
    LAS unsigned char* wb = F.lds + F.wave * DSA_WBUF; LAS unsigned char* tails = wb + 16640;
    const int NGW = F.G * NWAVES;
    for (int tg = F.gw; tg < T; tg += NGW) {
        int lane = F.lane; asm volatile("" : "+v"(lane));
        const int l15 = lane & 15, g = lane >> 4;
        const int b = tg >> 14, t = tg & (SEQ - 1); const int nvalid = t + 1 < 256 ? t + 1 : 256, nsteps = (nvalid + 31) >> 5;
        i32x8 qf[5];
        { const unsigned char* qp = QLAT + ((size_t)tg * 16 + l15) * 512 + 32 * g;
#pragma unroll
          for (int kk = 0; kk < 4; ++kk) { const i32x4 lo = *(const i32x4*)(qp + 128 * kk), hi = *(const i32x4*)(qp + 128 * kk + 16); qf[kk] = (i32x8){lo[0], lo[1], lo[2], lo[3], hi[0], hi[1], hi[2], hi[3]}; }
          const i32x4 r = *(const i32x4*)(QR + ((size_t)tg * 16 + l15) * 64 + 16 * g); qf[4] = (i32x8){r[0], r[1], r[2], r[3], 0, 0, 0, 0}; }
        float m = -INFINITY, lsum = 0.f; f32x4 O[32];
#pragma unroll
        for (int mt = 0; mt < 32; ++mt) O[mt] = (f32x4){0.f, 0.f, 0.f, 0.f};
        const int dtau = (lane >> 2) & 1, dch = 16 * (4 * (lane >> 3) + (lane & 3));
        int s0, s1, s2, s3, s4, s5, s6, s7;
        { const unsigned short* sp = SEL + (size_t)tg * 256 + (lane & 31); const int l31 = lane & 31;
          s0 = l31 < nvalid ? (int)sp[0] : 0; s1 = 32 + l31 < nvalid ? (int)sp[32] : 0; s2 = 64 + l31 < nvalid ? (int)sp[64] : 0; s3 = 96 + l31 < nvalid ? (int)sp[96] : 0;
          s4 = 128 + l31 < nvalid ? (int)sp[128] : 0; s5 = 160 + l31 < nvalid ? (int)sp[160] : 0; s6 = 192 + l31 < nvalid ? (int)sp[192] : 0; s7 = 224 + l31 < nvalid ? (int)sp[224] : 0; }
        for (int st = 0; st < nsteps; ++st) {
            int idx = s0; s0 = s1; s1 = s2; s2 = s3; s3 = s4; s4 = s5; s5 = s6; s6 = s7; idx = idx > t ? 0 : idx;
            const int row = b * SEQ + idx;
            LDS_WAIT();
#pragma unroll
            for (int p = 0; p < 16; ++p) { const int r0 = __builtin_amdgcn_readlane(row, p), r1 = __builtin_amdgcn_readlane(row, 16 + p); const int rr = dtau ? r1 : r0;
                glds16(KVb + (size_t)rr * 576 + dch, wb + p * 1040); }
#pragma unroll
            for (int p = 0; p < 2; ++p) glds16(KVb + (size_t)row * 576 + 512 + 16 * (2 * p + (lane >> 5)), tails + 1024 * p);
            VM_WAIT();
            f32x4 sacc[2] = {(f32x4){0.f, 0.f, 0.f, 0.f}, (f32x4){0.f, 0.f, 0.f, 0.f}};
            const LAS unsigned char* sb = wb + l15 * 1040 + 16 * (8 * (g >> 1) + 2 * (g & 1));
#pragma unroll
            for (int kk = 0; kk < 4; ++kk)
#pragma unroll
                for (int tu = 0; tu < 2; ++tu) { const i32x4 lo = *(const LAS i32x4*)(sb + 256 * kk + 64 * tu), hi = *(const LAS i32x4*)(sb + 256 * kk + 64 * tu + 16);
                    const i32x8 a = (i32x8){lo[0], lo[1], lo[2], lo[3], hi[0], hi[1], hi[2], hi[3]};
                    sacc[tu] = __builtin_amdgcn_mfma_scale_f32_16x16x128_f8f6f4(a, qf[kk], sacc[tu], 0, 0, 0, 0, 0, 0); }
#pragma unroll
            for (int tu = 0; tu < 2; ++tu) { const i32x4 lo = *(const LAS i32x4*)(tails + (g * 32 + 16 * tu + l15) * 16);
                const i32x8 a = (i32x8){lo[0], lo[1], lo[2], lo[3], 0, 0, 0, 0};
                sacc[tu] = __builtin_amdgcn_mfma_scale_f32_16x16x128_f8f6f4(a, qf[4], sacc[tu], 0, 0, 0, 0, 0, 0); }
            float s[8]; float tmax = -INFINITY;
#pragma unroll
            for (int tu = 0; tu < 2; ++tu)
#pragma unroll
                for (int i = 0; i < 4; ++i) { s[4 * tu + i] = (32 * st + 16 * tu + 4 * g + i) < nvalid ? sacc[tu][i] * (SCALE2_MLA / (QLAT_F8SCALE * KV_F8SCALE)) : -INFINITY; tmax = fmaxf(tmax, s[4 * tu + i]); }
            tmax = fmaxf(tmax, shx(tmax, 16, lane)); tmax = fmaxf(tmax, shx(tmax, 32, lane));
            if (__any(tmax > m + 0.75f)) {
                const float mnew = fmaxf(m, tmax); const float alpha = __builtin_amdgcn_exp2f(m - mnew); m = mnew; lsum *= alpha;
#pragma unroll
                for (int mt = 0; mt < 32; ++mt) O[mt] = O[mt] * alpha;
            }
            const float mo = m - 8.0f;
            float p[8];
#pragma unroll
            for (int i = 0; i < 8; ++i) p[i] = __builtin_amdgcn_exp2f(s[i] - mo);
            lsum += (((p[0] + p[1]) + (p[2] + p[3])) + ((p[4] + p[5]) + (p[6] + p[7])));
            u32x2 pw; pw.x = pk4_fp8(p[0], p[1], p[2], p[3]); pw.y = pk4_fp8(p[4], p[5], p[6], p[7]); const long pb = __builtin_bit_cast(long, pw);
            const LAS unsigned char* trb = wb + (4 * g + ((l15 >> 1) & 3)) * 1040 + 64 * (l15 >> 3) + 8 * (l15 & 1);
#pragma unroll
            for (int mt = 0; mt < 32; ++mt) { const long a = tr_read8(trb + 128 * (mt >> 2) + 16 * (mt & 3)); O[mt] = __builtin_amdgcn_mfma_f32_16x16x32_fp8_fp8(a, pb, O[mt], 0, 0, 0); }
        }
        float lt = lsum + shx(lsum, 16, lane); lt += shx(lt, 32, lane); const float inv8 = (OLAT_F8SCALE / KV_F8SCALE) / lt;
        unsigned char* op8 = OUT + ((size_t)tg * 16 + l15) * 512 + 4 * g;
#pragma unroll
        for (int mt = 0; mt < 32; ++mt) *(unsigned*)(op8 + 16 * mt) = pk4_fp8(O[mt][0] * inv8, O[mt][1] * inv8, O[mt][2] * inv8, O[mt][3] * inv8);
        if (w1) { LDS_WAIT(); int lane2 = F.lane; asm volatile("" : "+v"(lane2));
            for (int k = 0; k < 3; ++k) { const int it = F.gw + NGW * (3 * ((tg - F.gw) / NGW) + k); if (it < MOE_CONV_ITEMS) moe_conv_item(w1, w3, w2, ws, (LAS float*)wb, it, lane2); } }
    }
    LDS_WAIT();
}

__device__ __forceinline__ void ln_router_phase(const Frame& F, const bf16_t* YH, bf16_t* XB, const float* g, const float* bb, const float* wr, int* TOKE, float* TOKG, int* TOKL) {
    LAS float* wl = (LAS float*)F.lds;
    for (int i = F.tid; i < DM * NEXP; i += NTHREADS) { const int d = i >> 3, e = i & 7; wl[e * DM + d] = wr[i]; }
    __syncthreads();
    const int NGW = F.G * NWAVES, lane = F.lane;
    u64 cnt64 = 0ull; int mine = 0;
    int j = 0;
    for (int m = F.gw; m < T; m += NGW, ++j) { f32x4 v[8];
        ln_load16(v, YH + (size_t)m * DM, lane); ln_core(v, g, bb, lane); ln_store8(v, (unsigned char*)XB + (size_t)m * DM, lane);
        float lg[8];
#pragma unroll
        for (int e = 0; e < 8; ++e) { float s = 0.f;
#pragma unroll
            for (int q = 0; q < 8; ++q) { const f32x4 w = *(const LAS f32x4*)(wl + e * DM + ln_col(lane, q)); s += (v[q][0] * w[0] + v[q][1] * w[1]) + (v[q][2] * w[2] + v[q][3] * w[3]); }
            lg[e] = wave_sum(s); }
        int e1 = 0; float v1 = lg[0];
#pragma unroll
        for (int e = 1; e < 8; ++e) if (lg[e] > v1) { v1 = lg[e]; e1 = e; }
        int e2 = -1; float v2 = -INFINITY;
#pragma unroll
        for (int e = 0; e < 8; ++e) if (e != e1 && lg[e] > v2) { v2 = lg[e]; e2 = e; }
        const float g1 = 1.0f / (1.0f + __expf(v2 - v1)), g2 = 1.0f - g1;
        const int r1 = (int)((cnt64 >> (8 * e1)) & 0xffull); cnt64 += 1ull << (8 * e1);
        const int r2 = (int)((cnt64 >> (8 * e2)) & 0xffull); cnt64 += 1ull << (8 * e2);
        if (lane == 0) { TOKE[2 * m] = e1; TOKE[2 * m + 1] = e2; TOKG[2 * m] = g1; TOKG[2 * m + 1] = g2; }
        if (lane == j) mine = e1 | (e2 << 4) | (r1 << 8) | (r2 << 16);
    }
    int basev = 0;
    if (lane < 8) { const unsigned c = (unsigned)((cnt64 >> (8 * lane)) & 0xffull); basev = (int)__hip_atomic_fetch_add(F.ctl + CW_CNT + lane, c, __ATOMIC_RELAXED, __HIP_MEMORY_SCOPE_AGENT); }
    const int e1 = mine & 15, e2 = (mine >> 4) & 15, r1 = (mine >> 8) & 255, r2 = (mine >> 16) & 255;
    const int b1 = __builtin_amdgcn_ds_bpermute(e1 << 2, basev), b2 = __builtin_amdgcn_ds_bpermute(e2 << 2, basev);
    if (lane < j) { const int m = F.gw + NGW * lane; TOKL[2 * m] = b1 + r1; TOKL[2 * m + 1] = b2 + r2; }
    __syncthreads();
}
__device__ __forceinline__ void moe_tiles(const Frame& F) {
    if (F.tid == 0) { int acc = 0;
        for (int e = 0; e < 8; ++e) { const unsigned c = __hip_atomic_load(F.ctl + CW_CNT + e, __ATOMIC_RELAXED, __HIP_MEMORY_SCOPE_AGENT); F.MISC[32 + e] = c; F.MISC[40 + e] = (unsigned)acc; acc += (int)((c + 255u) >> 8); F.MISC[20 + e] = (unsigned)acc; }
        F.MISC[28] = (unsigned)acc; }
    __syncthreads();
}
__device__ __forceinline__ void moe_gather_phase(const Frame& F, const bf16_t* XB, const int* TOKE, const float* TOKG, const int* TOKL, int* TOKS, float* SGATE, bf16_t* XG) {
    const int NGW = F.G * NWAVES, lane = F.lane;
    for (int m = F.gw; m < T; m += NGW) {
        const u32x4* src = (const u32x4*)((const unsigned char*)XB + (size_t)m * DM);
        const u32x4 a0 = src[lane], a1 = src[64 + lane];
#pragma unroll
        for (int k = 0; k < 2; ++k) { const int e = TOKE[2 * m + k], li = TOKL[2 * m + k]; const int slot = (int)F.MISC[40 + e] * 256 + li;
            u32x4* dst = (u32x4*)((unsigned char*)XG + (size_t)slot * DM); dst[lane] = a0; dst[64 + lane] = a1;
            if (lane == 0) { TOKS[2 * m + k] = slot; SGATE[slot] = TOKG[2 * m + k]; } }
    }
    for (int it = F.gw; it < 8 * 256; it += NGW) { const int e = it >> 8, r = it & 255; const int c = (int)F.MISC[32 + e]; const int ntile = (c + 255) >> 8; const int row = c + r;
        if (row < ntile * 256) { const int slot = (int)F.MISC[40 + e] * 256 + row; u32x4* dst = (u32x4*)((unsigned char*)XG + (size_t)slot * DM); const u32x4 z = {0u, 0u, 0u, 0u};
            dst[lane] = z; dst[64 + lane] = z; if (lane == 0) SGATE[slot] = 0.f; } }
}
__device__ __forceinline__ void moe_combine_ln_phase(const Frame& F, const bf16_t* YH, bf16_t* XB, unsigned char* X8, const bf16_t* SOUT, const int* TOKS, const float* g1, const float* bb1, const float* g, const float* bb) {
    const int NGW = F.G * NWAVES, lane = F.lane;
    for (int m = F.gw; m < T; m += NGW) { f32x4 v[8];
        const int t0 = __builtin_amdgcn_readfirstlane(TOKS[2 * m]), t1 = __builtin_amdgcn_readfirstlane(TOKS[2 * m + 1]);
        const bf16_t* s0 = SOUT + (size_t)t0 * DM; const bf16_t* s1 = SOUT + (size_t)t1 * DM;
        ln_load16(v, YH + (size_t)m * DM, lane);
        ln_core(v, g1, bb1, lane);
#pragma unroll
        for (int j = 0; j < 4; ++j) { f32x4 a0, a1, c0, c1; pg8::unpack8(*(const u32x4*)(s0 + ln_col(lane, 2 * j)), a0, a1); pg8::unpack8(*(const u32x4*)(s1 + ln_col(lane, 2 * j)), c0, c1);
            v[2 * j] = v[2 * j] * ALPHA + (a0 + c0); v[2 * j + 1] = v[2 * j + 1] * ALPHA + (a1 + c1); }
        ln_core(v, g, bb, lane); ln_store16(v, XB + (size_t)m * DM, lane); if constexpr (F8_G1) { int ls = lane; asm volatile("" : "+v"(ls)); ln_store8(v, X8 + (size_t)m * DM, ls); } }
}

#ifndef PHASES
#define PHASES 0xFFFFFFFFu
#endif
#define PH(k) if constexpr ((PHASES >> (k)) & 1u)
#ifndef DBL
#define DBL 0u
#endif
#define DB(k) if constexpr ((DBL >> (k)) & 1u)
__global__ void __launch_bounds__(NTHREADS, 2) mega_fwd(Args args) {
    extern __shared__ __attribute__((aligned(16))) unsigned char lds_raw[];
    Frame F;
    F.lds = (LAS unsigned char*)lds_raw; F.MISC = (volatile LAS unsigned*)(F.lds + MISC_OFF);
    F.tid = threadIdx.x; F.lane = F.tid & 63; F.wave = __builtin_amdgcn_readfirstlane(F.tid >> 6); F.gw = blockIdx.x * NWAVES + F.wave;
    unsigned char* ws = args.ws;
    F.ctl = (unsigned*)(ws + WS_CTL);
    if (F.tid < 64) F.MISC[F.tid] = 0u;
    __syncthreads();
    XcdBarrier bar = xcd_barrier_post(F.ctl + CW_BAR, F.MISC + 8);
#define REFRESH() do { F.lane = fresh_lane(); F.tid = F.wave * 64 + F.lane; } while (0)
#define GRID_BAR() do { xcd_barrier(bar, F.wave); REFRESH(); } while (0)
#define YH ((bf16_t*)args.out)
#define bx ((int)blockIdx.x)
#define WSP(T_, off) ((T_*)(ws + (off)))

    PH(0) {
        { LAS float* scr = (LAS float*)(F.lds + F.wave * 16384);
          constexpr int I_QKV = 32 * 40, I_SQ = 32 * 32, I_W13 = 32 * 88, I_W2 = 88 * 32, I_WP = 4 * 32, I_WIN = 32 * 75, I_WUV = 256;
          constexpr int I_TOTAL = I_QKV + I_SQ + 2 * I_W13 + I_W2 + 2 * I_SQ + 2 * I_WP + (F8_WIN_SPLIT ? 2 : 1) * I_WIN + I_SQ + I_WUV;
          for (int it = F.gw; it < I_TOTAL; it += F.G * NWAVES) {
              int r = it; bool hit = false; const float* W = nullptr; int N = 0, ldo = 0, kofs = 0, mode = 0, rlo = 0, rhi = 1 << 30; unsigned char* WT = nullptr; float f8 = 0.f;
#define PSEG(cnt, Wp, Nn, WTp, ld, md, f8v, lo, hi) if (!hit) { if (r < (cnt)) { W = (Wp); N = (Nn); WT = (unsigned char*)(WTp); ldo = (ld); mode = (md); f8 = (f8v); rlo = (lo); rhi = (hi); hit = true; } else r -= (cnt); }
              PSEG(I_QKV, (const float*)args.in[3], NQKV, ws + WS_WQKV, DM, 1, F8_QKV ? WQKV_F8SCALE : 0.f, 0, 1 << 30)
              PSEG(I_SQ, (const float*)args.in[5], DM, ws + WS_WO0, DM, 0, F8_WO0 ? WO_F8SCALE : 0.f, 0, 1 << 30)
              PSEG(I_W13, (const float*)args.in[6], FFN, ws + WS_W13, DM, 2, F8_FFN1 ? W13_F8SCALE : 0.f, 0, 1 << 30)
              PSEG(I_W13, (const float*)args.in[7], FFN, ws + WS_W13, DM, 3, F8_FFN1 ? W13_F8SCALE : 0.f, 0, 1 << 30)
              PSEG(I_W2, (const float*)args.in[8], DM, ws + WS_W2, FFN, 0, F8_FFN2 ? W2_F8SCALE : 0.f, 0, 1 << 30)
              PSEG(I_SQ, (const float*)args.in[21], DM, ws + WS_WG0, DM, 0, F8_G0 ? WO_F8SCALE : 0.f, 0, 1 << 30)
              PSEG(I_SQ, (const float*)args.in[21] + (size_t)DM * DM, DM, ws + WS_WG1, DM, 0, F8_G1 ? WO_F8SCALE : 0.f, 0, 1 << 30)
              PSEG(I_WP, (const float*)args.in[20], DM, ws + WS_WP0, 256, 0, 0.f, 0, 1 << 30)
              PSEG(I_WP, (const float*)args.in[20] + (size_t)256 * DM, DM, ws + WS_WP1, 256, 0, 0.f, 0, 1 << 30)
              if constexpr (F8_WIN_SPLIT) { PSEG(I_WIN, (const float*)args.in[9], 4752, ws + WS_WIN8, DM, 4, WIN_F8SCALE, 0, WIN_F8_TILES * 256)
                                            PSEG(I_WIN, (const float*)args.in[9], 4752, ws + WS_WIN, DM, 4, 0.f, WIN_F8_TILES * 256, NWIN) }
              else { PSEG(I_WIN, (const float*)args.in[9], 4752, ws + WS_WIN, DM, 4, F8_WIN ? WIN_F8SCALE : 0.f, 0, 1 << 30) }
              PSEG(I_SQ, (const float*)args.in[13], DM, ws + WS_WO1, DM, 0, F8_WO1 ? WO_F8SCALE : 0.f, 0, 1 << 30)
              if (!hit) { const int h = r >> 4; r &= 15;
                  W = (const float*)args.in[12] + (size_t)h * 512 * 128; N = 128; WT = ws + WS_WUV + (size_t)h * 128 * 1024 * (F8_LAT ? 1 : 2); ldo = 1024; kofs = 512 * (h & 1); f8 = F8_LAT ? WUV_F8SCALE : 0.f; }
#undef PSEG
              tr_item(W, N, (bf16_t*)WT, ldo, kofs, mode, scr, r, F.lane, f8, rlo, rhi); } }
        { bf16_t* wuv = WSP(bf16_t, WS_WUV); const u32x4 z = {0u, 0u, 0u, 0u};
          for (int i = bx * NTHREADS + F.tid; i < 2048 * 64; i += F.G * NTHREADS) { const int n = i >> 6, c8 = i & 63; const int h = n >> 7;
              if constexpr (F8_LAT) { if (c8 < 32) *(u32x4*)((unsigned char*)wuv + (size_t)n * 1024 + 512 * ((h & 1) ^ 1) + 16 * c8) = z; }
              else *(u32x4*)(wuv + (size_t)n * 1024 + 512 * ((h & 1) ^ 1) + 8 * c8) = z; } }
        cvt_linear(F, (const float*)args.in[11], WSP(bf16_t, WS_WUK), (size_t)16 * 512 * 128 / 8);
        if constexpr (F8_QKV) cvt_linear8(F, (const float*)args.in[0], WSP(unsigned char, WS_XBA), (size_t)T * DM / 8); else cvt_linear(F, (const float*)args.in[0], WSP(bf16_t, WS_XBA), (size_t)T * DM / 8);
        cvt_linear(F, (const float*)args.in[1], WSP(bf16_t, WS_PB), (size_t)2 * T * 256 / 8);
        rope_tables(F, (const int*)args.in[2], WSP(float, WS_TAB64), WSP(float, WS_TAB32));
    }
    GRID_BAR();
    PH(1) {
        constexpr int KD = F8_QKV ? DM / 2 : DM;
        pg8::Gemm g{WSP(bf16_t, WS_XBA), WSP(bf16_t, WS_WQKV), KD, KD, KD}; pg8::GridOrder<0, T / 256, NQKV / 256> S;
        pg8::EpiQKV E{ws, F8_QKV ? 1.0f / WQKV_F8SCALE : 1.0f}; pg8::gemm_phase<pg8::EpiQKV, pg8::GridOrder<0, T / 256, NQKV / 256>, F8_QKV>(F.lds, g, S, E, F.wave);
    }
    GRID_BAR();
    PH(2) swa_phase<F8_WO0>(F, WSP(bf16_t, WS_Q), WSP(bf16_t, WS_K), WSP(bf16_t, WS_VT), (const float*)args.in[4], WSP(unsigned char, WS_O8));
    GRID_BAR();
    PH(3) {
        constexpr int KD = F8_WO0 ? DM / 2 : DM;
        pg8::Gemm g{F8_WO0 ? WSP(bf16_t, WS_O8) : WSP(bf16_t, WS_Q), WSP(bf16_t, WS_WO0), KD, KD, KD}; pg8::GridOrder<0, T / 256, DM / 256> S;
        pg8::EpiRes<false> E{args.in[0], YH, F8_WO0 ? 1.0f / (O0_F8SCALE * WO_F8SCALE) : 1.0f}; pg8::gemm_phase<pg8::EpiRes<false>, pg8::GridOrder<0, T / 256, DM / 256>, F8_WO0, EPI_ALIGN_RES>(F.lds, g, S, E, F.wave);
    }
    GRID_BAR();
    PH(4) ln_phase<F8_FFN1>(F, YH, WSP(bf16_t, WS_XBB), WSP(unsigned char, WS_XBA), (const float*)args.in[18], (const float*)args.in[19]);
    GRID_BAR();
    PH(5) {
        constexpr int KD = F8_FFN1 ? DM / 2 : DM;
        pg8::Gemm g{F8_FFN1 ? WSP(bf16_t, WS_XBA) : WSP(bf16_t, WS_XBB), WSP(bf16_t, WS_W13), KD, KD, KD}; pg8::GridOrder<0, T / 256, 2 * FFN / 256> S;
        pg8::EpiSwiglu<F8_FFN2> E{WSP(bf16_t, WS_ACT), FFN, F8_FFN1 ? 1.0f / W13_F8SCALE : 1.0f, ACT_F8SCALE}; pg8::gemm_phase<pg8::EpiSwiglu<F8_FFN2>, pg8::GridOrder<0, T / 256, 2 * FFN / 256>, F8_FFN1>(F.lds, g, S, E, F.wave);
    }
    GRID_BAR();
    PH(6) {
        constexpr int KD = F8_FFN2 ? FFN / 2 : FFN;
        pg8::Gemm g{WSP(bf16_t, WS_ACT), WSP(bf16_t, WS_W2), KD, KD, KD}; pg8::GridOrder<0, T / 256, DM / 256> S;
        pg8::EpiRes<true> E{WSP(bf16_t, WS_XBB), YH, F8_FFN2 ? 1.0f / (ACT_F8SCALE * W2_F8SCALE) : 1.0f}; pg8::gemm_phase<pg8::EpiRes<true>, pg8::GridOrder<0, T / 256, DM / 256>, F8_FFN2, EPI_ALIGN_RES>(F.lds, g, S, E, F.wave);
    }
    GRID_BAR();
    PH(7) ln_phase<F8_G0>(F, YH, WSP(bf16_t, WS_XBA), F8_G0 ? WSP(unsigned char, WS_X28) : nullptr, (const float*)args.in[18] + DM, (const float*)args.in[19] + DM);
    REFRESH();
    PH(7) {
        pg8::Gemm g{WSP(bf16_t, WS_PB), WSP(bf16_t, WS_WP0), 256, 256, 256}; pg8::GridOrder<0, T / 256, DM / 256> S;
        pg8::EpiBf16<false> E{WSP(bf16_t, WS_PP0), DM, 1.0f}; pg8::gemm_phase(F.lds, g, S, E, F.wave);
    }
    GRID_BAR();
    PH(8) {
        constexpr int K2 = F8_G0 ? DM / 2 : DM;
        pg8::Gemm g{F8_G0 ? WSP(bf16_t, WS_X28) : WSP(bf16_t, WS_XBA), WSP(bf16_t, WS_WG0), K2, K2, K2}; pg8::GridOrder<0, T / 256, DM / 256> S;
        pg8::EpiPle E{nullptr, ws, 0, F8_G0 ? -LOG2E / WO_F8SCALE : -LOG2E}; pg8::gemm_phase<pg8::EpiPle, pg8::GridOrder<0, T / 256, DM / 256>, F8_G0, EPI_ALIGN_RES>(F.lds, g, S, E, F.wave);
    }
    GRID_BAR();
    PH(9) {
        if constexpr (F8_WIN_SPLIT) {
            { static_assert((T / 256) * WIN_F8_TILES == 7 * pg8::GRID && (T / 256) * (NWIN / 256 - WIN_F8_TILES) == 5 * pg8::GRID / 2, "uneven deal: 7 rounds of e4m3 units, 2.5 rounds of bf16 units");
              pg8::Gemm g{WSP(bf16_t, WS_XB8), WSP(bf16_t, WS_WIN8), DM / 2, DM / 2, DM / 2}; pg8::GridOrder<4, T / 256, WIN_F8_TILES> S;
              pg8::EpiWin E{ws, 1.0f / WIN_F8SCALE, 0}; pg8::gemm_phase<pg8::EpiWin, pg8::GridOrder<4, T / 256, WIN_F8_TILES>, true>(F.lds, g, S, E, F.wave); }
            REFRESH();
            { pg8::Gemm g{WSP(bf16_t, WS_XBB), WSP(bf16_t, WS_WIN) + (size_t)WIN_F8_TILES * 256 * DM, DM, DM, DM}; pg8::GridOrder<0, T / 256, NWIN / 256 - WIN_F8_TILES> S;
              pg8::EpiWin E{ws, 1.0f, WIN_F8_TILES}; pg8::gemm_phase<pg8::EpiWin, pg8::GridOrder<0, T / 256, NWIN / 256 - WIN_F8_TILES>, false>(F.lds, g, S, E, F.wave); }
        } else {
        constexpr int KD = F8_WIN ? DM / 2 : DM;
        pg8::Gemm g{WSP(bf16_t, WS_XBB), WSP(bf16_t, WS_WIN), KD, KD, KD}; pg8::GridOrder<0, T / 256, NWIN / 256> S;
        pg8::EpiWin E{ws, F8_WIN ? 1.0f / WIN_F8SCALE : 1.0f, 0}; pg8::gemm_phase<pg8::EpiWin, pg8::GridOrder<0, T / 256, NWIN / 256>, F8_WIN>(F.lds, g, S, E, F.wave);
        }
    }
    GRID_BAR();
    PH(10) kvnorm_phase(F, WSP(float, WS_CRAW), (const float*)args.in[10], WSP(bf16_t, WS_KV));
    REFRESH();
    PH(11) {
        pg8::Gemm g{WSP(bf16_t, WS_QN), WSP(bf16_t, WS_WUK), DM, 128, 128}; pg8::GridOrder<1, T / 256, 8192 / 256> S;
        pg8::EpiBf16<F8_LAT> E{WSP(bf16_t, WS_QLAT), 8192, F8_LAT ? QLAT_F8SCALE : 1.0f}; pg8::gemm_phase(F.lds, g, S, E, F.wave);
    }
    REFRESH();
    DB(12) { topk_phase(F, WSP(bf16_t, WS_QI), WSP(bf16_t, WS_KIF), WSP(float, WS_WI), WSP(unsigned short, WS_SEL)); REFRESH(); }
    PH(12) topk_phase<true>(F, WSP(bf16_t, WS_QI), WSP(bf16_t, WS_KIF), WSP(float, WS_WI), WSP(unsigned short, WS_SEL));
    GRID_BAR();
    PH(13) { if constexpr (F8_KV && F8_LAT) dsa_attn8_phase(F, WSP(unsigned char, WS_QLAT), WSP(unsigned char, WS_QLAT), WSP(unsigned char, WS_QR), WSP(unsigned char, WS_KV), WSP(unsigned short, WS_SEL), nullptr, nullptr, nullptr, ws);
             else dsa_attn_phase(F, WSP(bf16_t, WS_QLAT), WSP(bf16_t, WS_QLAT), WSP(bf16_t, WS_QR), WSP(bf16_t, WS_KV), WSP(unsigned short, WS_SEL), (const float*)args.in[15], (const float*)args.in[16], (const float*)args.in[17], ws); }
    GRID_BAR();
    PH(14) {
        constexpr float dsc = F8_LAT ? 1.0f / (OLAT_F8SCALE * WUV_F8SCALE) : 1.0f;
        pg8::Gemm g{WSP(bf16_t, WS_QLAT), WSP(bf16_t, WS_WUV), F8_LAT ? 4096 : 8192, F8_LAT ? 512 : 1024, F8_LAT ? 512 : 1024}; pg8::GridOrder<F8_LAT ? 3 : 2, T / 256, DM / 256> S;
        pg8::EpiBf16<F8_WO1> E{WSP(bf16_t, WS_O2), DM, (F8_WO1 ? O2_F8SCALE : 1.0f) * dsc}; pg8::gemm_phase<pg8::EpiBf16<F8_WO1>, pg8::GridOrder<F8_LAT ? 3 : 2, T / 256, DM / 256>, F8_LAT>(F.lds, g, S, E, F.wave);
    }
    GRID_BAR();
    PH(15) {
        constexpr int KD = F8_WO1 ? DM / 2 : DM;
        pg8::Gemm g{WSP(bf16_t, WS_O2), WSP(bf16_t, WS_WO1), KD, KD, KD}; pg8::GridOrder<0, T / 256, DM / 256> S;
        pg8::EpiRes<true> E{WSP(bf16_t, WS_XBB), YH, F8_WO1 ? 1.0f / (O2_F8SCALE * WO_F8SCALE) : 1.0f}; pg8::gemm_phase<pg8::EpiRes<true>, pg8::GridOrder<0, T / 256, DM / 256>, F8_WO1, EPI_ALIGN_RES>(F.lds, g, S, E, F.wave);
    }
    GRID_BAR();
    PH(16) ln_router_phase(F, YH, WSP(bf16_t, WS_XBA), (const float*)args.in[18] + 2 * DM, (const float*)args.in[19] + 2 * DM, (const float*)args.in[14], WSP(int, WS_TOKE), WSP(float, WS_TOKG), WSP(int, WS_TOKL));
    REFRESH();
    GRID_BAR();
    PH(18) moe_tiles(F);
    REFRESH();
    PH(18) moe_gather_phase(F, WSP(bf16_t, WS_XBA), WSP(int, WS_TOKE), WSP(float, WS_TOKG), WSP(int, WS_TOKL), WSP(int, WS_TOKS), WSP(float, WS_SGATE), WSP(bf16_t, WS_XG));
    GRID_BAR();
    PH(19) {
        const int NTL = __builtin_amdgcn_readfirstlane((int)F.MISC[28]);
        {
            pg8::MoeOrder<false, 2 * MFFN / 256> S; S.tile0 = 0; S.ntl = NTL;
            pg8::Gemm g{WSP(bf16_t, WS_XG), WSP(bf16_t, WS_MW13), DM / 2, DM / 2, DM / 2};
            pg8::EpiSwiglu<true> E{WSP(bf16_t, WS_ACT2), MFFN, 1.0f / W13_F8SCALE, ACT_F8SCALE}; pg8::gemm_phase<pg8::EpiSwiglu<true>, pg8::MoeOrder<false, 2 * MFFN / 256>, true>(F.lds, g, S, E, F.wave);
        }
        GRID_BAR();
        {
            pg8::MoeOrder<true, DM / 256> S; S.tile0 = 0; S.ntl = NTL;
            pg8::Gemm g{WSP(bf16_t, WS_ACT2), WSP(bf16_t, WS_MW2), MFFN / 2, MFFN / 2, MFFN / 2};
            pg8::EpiMoeDown E{ws}; pg8::gemm_phase<pg8::EpiMoeDown, pg8::MoeOrder<true, DM / 256>, true>(F.lds, g, S, E, F.wave);
        }
        REFRESH();
        {
            pg8::GridOrderSkip<T / 256, DM / 256> S; S.skip = (NTL * (DM / 256)) % pg8::GRID;
            pg8::Gemm g{WSP(bf16_t, WS_PB) + (size_t)T * 256, WSP(bf16_t, WS_WP1), 256, 256, 256};
            pg8::EpiBf16<false> E{WSP(bf16_t, WS_PP1), DM, 1.0f}; pg8::gemm_phase(F.lds, g, S, E, F.wave);
        }
        GRID_BAR();
    }
    PH(20) moe_combine_ln_phase(F, YH, WSP(bf16_t, WS_XBB), WSP(unsigned char, WS_X58), WSP(bf16_t, WS_SOUT), WSP(int, WS_TOKS), (const float*)args.in[18] + 2 * DM, (const float*)args.in[19] + 2 * DM, (const float*)args.in[18] + 3 * DM, (const float*)args.in[19] + 3 * DM);
    GRID_BAR();
    PH(21) {
        constexpr int K2 = F8_G1 ? DM / 2 : DM;
        pg8::Gemm g{F8_G1 ? WSP(bf16_t, WS_X58) : WSP(bf16_t, WS_XBB), WSP(bf16_t, WS_WG1), K2, K2, K2}; pg8::GridOrder<0, T / 256, DM / 256> S;
        pg8::EpiPle E{args.out, ws, 1, F8_G1 ? -LOG2E / WO_F8SCALE : -LOG2E}; pg8::gemm_phase<pg8::EpiPle, pg8::GridOrder<0, T / 256, DM / 256>, F8_G1, EPI_ALIGN_RES>(F.lds, g, S, E, F.wave);
    }
}

#undef YH
#undef bx
extern "C" void kernel_launch(void* const* d_in, const int* in_sizes, int n_in, void* d_out, int out_size, void* d_ws, size_t ws_size, hipStream_t stream) {
    static int grid = 0;
    if (grid == 0) {
        if (n_in != 22 || out_size != T * DM || ws_size < WS_END) { fprintf(stderr, "kernel_launch: unexpected problem (n_in %d, out %d, ws %zu < %zu)\n", n_in, out_size, ws_size, (size_t)WS_END); grid = -1; return; }
        int dev = 0, cus = 0;
        if (hipGetDevice(&dev) != hipSuccess || hipDeviceGetAttribute(&cus, hipDeviceAttributeMultiprocessorCount, dev) != hipSuccess) { grid = -1; return; }
        if (hipFuncSetAttribute((const void*)mega_fwd, hipFuncAttributeMaxDynamicSharedMemorySize, LDS_BYTES) != hipSuccess) { fprintf(stderr, "kernel_launch: hipFuncSetAttribute failed\n"); grid = -1; return; }
        int per_cu = 0;
        if (hipOccupancyMaxActiveBlocksPerMultiprocessor(&per_cu, (const void*)mega_fwd, NTHREADS, LDS_BYTES) != hipSuccess || per_cu < 1) { fprintf(stderr, "kernel_launch: occupancy query says %d\n", per_cu); }
        (void)hipGetLastError();
        if (cus != pg8::GRID) { fprintf(stderr, "kernel_launch: built for %d CUs, device has %d\n", pg8::GRID, cus); grid = -1; return; }
        grid = cus;
    }
    if (grid < 0) return;
    (void)hipMemsetAsync((char*)d_ws + WS_CTL, 0, CTL_ZERO_BYTES, stream);
    Args a{};
    for (int i = 0; i < 22; ++i) a.in[i] = d_in[i];
    a.out = (float*)d_out; a.ws = (unsigned char*)d_ws;
    hipLaunchKernelGGL(mega_fwd, dim3(grid), dim3(NTHREADS), LDS_BYTES, stream, a);
}
```

```cpp
#include <hip/hip_runtime.h>
#include <cstdio>
#include <cstdint>

#define LAS __attribute__((address_space(3)))
#define GAS __attribute__((address_space(1)))
typedef unsigned short bf16_t;
typedef short bf16x8 __attribute__((ext_vector_type(8)));
typedef short bf16x4 __attribute__((ext_vector_type(4)));
typedef float f32x2 __attribute__((ext_vector_type(2)));
typedef float f32x4 __attribute__((ext_vector_type(4)));
typedef float f32x16 __attribute__((ext_vector_type(16)));
typedef unsigned u32x2 __attribute__((ext_vector_type(2)));
typedef unsigned u32x4 __attribute__((ext_vector_type(4)));
typedef unsigned long long u64;
typedef int i32x2 __attribute__((ext_vector_type(2)));
typedef int i32x4 __attribute__((ext_vector_type(4)));
typedef int i32x8 __attribute__((ext_vector_type(8)));

constexpr int T = 32768, SEQ = 16384, DM = 2048;
constexpr int FFN = 5632, MFFN = 7168, NEXP = 8;
constexpr int NQKV = 2560, NWIN = 4864;
constexpr float ALPHA = 1.41421356237309515f;
constexpr float LN_EPS = 1e-5f, RMS_EPS = 1e-6f;
constexpr float QSCALE_SWA = 0.18033688011112042f;
constexpr float SCALE2_MLA = 0.10411754627697264f;
constexpr float LOG2E = 1.4426950408889634f;
constexpr int NWAVES = 8, NTHREADS = 512;
constexpr float W13_F8SCALE = 32.0f;
constexpr bool F8_FFN1 = true, F8_FFN2 = true, F8_QKV = true, F8_WO0 = true, F8_WIN = false, F8_WO1 = true;
constexpr bool EPI_ALIGN_RES = true;
constexpr bool SWA_FRAG = true;
constexpr bool F8_LAT = true;
constexpr float QLAT_F8SCALE = 8.0f, OLAT_F8SCALE = 32.0f, WUV_F8SCALE = 16.0f;
constexpr bool F8_G0 = true, F8_G1 = false;
constexpr bool F8_KV = true;
constexpr float KV_F8SCALE = 16.0f;
constexpr bool F8_WIN_SPLIT = true;
constexpr int WIN_F8_TILES = 14;
constexpr float WQKV_F8SCALE = 32.0f, WIN_F8SCALE = 32.0f, WO_F8SCALE = 64.0f, O0_F8SCALE = 16.0f, O2_F8SCALE = 32.0f;
constexpr float ACT_F8SCALE = 16.0f, W2_F8SCALE = 128.0f;

constexpr size_t MiB = 1u << 20;
constexpr size_t WS_CTL = 0, CTL_ZERO_BYTES = 1 * MiB;
constexpr size_t WS_WQKV = 2 * MiB, WS_WO0 = 12 * MiB, WS_W13 = 20 * MiB, WS_W2 = 64 * MiB, WS_WG0 = 86 * MiB, WS_WG1 = 94 * MiB, WS_WP0 = 102 * MiB, WS_WP1 = 103 * MiB,
                 WS_WIN = 104 * MiB, WS_WUK = 123 * MiB, WS_WUV = 125 * MiB, WS_WO1 = 129 * MiB;
constexpr size_t WS_TAB64 = 137 * MiB, WS_TAB32 = 145 * MiB, WS_PB = 149 * MiB, WS_XBA = 181 * MiB, WS_XBB = 309 * MiB;
constexpr size_t WS_TOKE = 437 * MiB;
constexpr size_t WS_TOKG = WS_TOKE + 256 * 1024;
constexpr size_t WS_TOKL = WS_TOKG + 256 * 1024;
constexpr size_t WS_TOKS = WS_TOKL + 256 * 1024;
constexpr size_t WS_SGATE = WS_TOKS + 256 * 1024;
constexpr size_t WS_WI = 439 * MiB, WS_SEL = 441 * MiB, WS_R = 458 * MiB;
constexpr size_t WS_Q = WS_R, WS_K = WS_R + 128 * MiB, WS_VT = WS_R + 144 * MiB, WS_ACT = WS_R + 160 * MiB, WS_PP0 = WS_R + 512 * MiB, WS_O8 = WS_R + 640 * MiB, WS_XB8 = WS_R + 704 * MiB  , WS_WIN8 = WS_R + 768 * MiB  ;
constexpr size_t WS_QN = WS_R, WS_QR = WS_R + 128 * MiB, WS_CRAW = WS_R + 192 * MiB, WS_KV = WS_R + 256 * MiB, WS_QI = WS_R + 292 * MiB, WS_KIF = WS_R + 356 * MiB,
                 WS_QLAT = WS_R + 360 * MiB, WS_O2 = WS_R + 872 * MiB;
constexpr size_t WS_MW13 = WS_R + 1128 * MiB, WS_MW2 = WS_R + 1352 * MiB, WS_XG = WS_R, WS_SOUT = WS_R + 136 * MiB, WS_ACT2 = WS_R + 404 * MiB  , WS_PP1 = WS_R + 884 * MiB;
constexpr size_t WS_X28 = WS_O8  , WS_X58 = WS_ACT2  ;
constexpr size_t WS_END = WS_R + 1464 * MiB;
constexpr int MAXSLOTS = 67840;
constexpr int CHUNK_TILES = 272;
constexpr int CW_TMO = 0, CW_CNT = 64  , CW_BAR = 4096;

constexpr int LDS_BYTES = 155648;
constexpr int MISC_OFF = 150016;
constexpr int DSA_WBUF = 18688;

typedef __bf16 bf16x2_t __attribute__((ext_vector_type(2)));
__device__ __forceinline__ unsigned cvt_pk_bf16(float lo, float hi) { const f32x2 v = {lo, hi}; return __builtin_bit_cast(unsigned, __builtin_convertvector(v, bf16x2_t)); }
__device__ __forceinline__ float bf2f(unsigned short h) { return __uint_as_float(((unsigned)h) << 16); }
__device__ __forceinline__ float bflo(unsigned w) { return __uint_as_float(w << 16); }
__device__ __forceinline__ float bfhi(unsigned w) { return __uint_as_float(w & 0xffff0000u); }
__device__ __forceinline__ int fresh_lane() { unsigned m = ~0u; asm volatile("" : "+v"(m)); return (int)__builtin_amdgcn_mbcnt_hi(m, __builtin_amdgcn_mbcnt_lo(m, 0u)); }
__device__ __forceinline__ float shx(float v, int o, int lane) { return __int_as_float(__builtin_amdgcn_ds_bpermute((lane ^ o) << 2, __float_as_int(v))); }
__device__ __forceinline__ float wave_sum(float v) {
    const int l = fresh_lane();
#pragma unroll
    for (int o = 1; o < 64; o <<= 1) v += shx(v, o, l);
    return v;
}
__device__ __forceinline__ unsigned pk4_fp8(float a, float b, float c, float d) { unsigned w = 0u; w = (unsigned)__builtin_amdgcn_cvt_pk_fp8_f32(a, b, (int)w, false); w = (unsigned)__builtin_amdgcn_cvt_pk_fp8_f32(c, d, (int)w, true); return w; }
#define LDS_WAIT() asm volatile("s_waitcnt lgkmcnt(0)" ::: "memory")
#define VM_WAIT() asm volatile("s_waitcnt vmcnt(0)" ::: "memory")

namespace pg8 {
constexpr int BM = 256, BK = 64, HALF = 128, HTB = HALF * BK * 2, STAGE_BYTES = 8 * HTB, NXCD = 8, WGM = 8;
__host__ __device__ __forceinline__ int lds_byte(int r, int c) { const int st = (r >> 4) * 2 + (c >> 5), rr = r & 15, cc = c & 31, ob = rr * 64 + cc * 2; return st * 1024 + (ob ^ (((ob >> 9) & 1) << 5)); }
__host__ __device__ __forceinline__ void stage_rc(int b, int& R, int& C) { const int st = b / 1024, sb = b % 1024, swz = sb ^ (((sb >> 9) & 1) << 5); R = (st >> 1) * 16 + swz / 64; C = (st & 1) * 32 + (swz % 64) / 2; }
__host__ __device__ __forceinline__ int perm32(int rho) { const int n = rho >> 4, i = rho & 15; return 8 * (i >> 2) + 4 * n + (i & 3); }

struct Unit { int pm, pn, am, acol, bn; };
struct Gemm { const bf16_t* A; const bf16_t* Bt; int lda, ldb, K; };

constexpr int GRID = 256;
template <int MODE, int NM, int NN> struct GridOrder {
    __device__ __forceinline__ bool next(int i, Unit& u) const {
        constexpr int nwg = NM * NN;
        int L = i * GRID + (int)blockIdx.x;
        if constexpr (MODE == 4) {
            if (i >= 6) { if ((int)blockIdx.x < GRID / 2 || i >= 8) return false; L = 6 * GRID + ((int)blockIdx.x - GRID / 2) * 2 + (i - 6); } }
        if (L >= nwg) return false;
        int wgid = L; { constexpr int q = nwg / NXCD, r = nwg % NXCD; const int xcd = wgid % NXCD, off = wgid / NXCD; wgid = (xcd < r ? xcd * (q + 1) : r * (q + 1) + (xcd - r) * q) + off; }
        constexpr int nig = WGM * NN; const int gid = wgid / nig, fm = gid * WGM, gsz = (NM - fm) < WGM ? (NM - fm) : WGM;
        u.pm = fm + ((wgid % nig) % gsz); u.pn = (wgid % nig) / gsz; u.am = u.pm; u.bn = u.pn;
        u.acol = MODE == 1 ? (u.pn >> 1) * 128 : (MODE == 2 ? u.pn * 1024 : (MODE == 3 ? u.pn * 512 : 0));
        return true;
    }
};
template <int NM, int NN> struct GridOrderSkip {
    int skip;
    __device__ __forceinline__ bool next(int i, Unit& u) const {
        constexpr int nwg = NM * NN; const int nW = GRID - skip, br = (int)blockIdx.x - skip; if (br < 0) return false;
        const int L = i * nW + br; if (L >= nwg) return false;
        int wgid = L; { constexpr int q = nwg / NXCD, r = nwg % NXCD; const int xcd = wgid % NXCD, off = wgid / NXCD; wgid = (xcd < r ? xcd * (q + 1) : r * (q + 1) + (xcd - r) * q) + off; }
        constexpr int nig = WGM * NN; const int gid = wgid / nig, fm = gid * WGM, gsz = (NM - fm) < WGM ? (NM - fm) : WGM;
        u.pm = fm + ((wgid % nig) % gsz); u.pn = (wgid % nig) / gsz; u.am = u.pm; u.bn = u.pn; u.acol = 0;
        return true;
    }
};
template <bool DOWN, int NN> struct MoeOrder {
    int tile0, ntl;
    __device__ __forceinline__ bool next(int i, Unit& u) const {
        int pml, pn;
        if constexpr (!DOWN && NN % 8 == 0) {
            constexpr int NJ = NN / 8; const int x = (int)blockIdx.x & 7, q = i * (GRID / 8) + ((int)blockIdx.x >> 3); if (q >= ntl * NJ) return false;
            const int nfull = ntl >> 3; int m, j;
            if (q < nfull * 8 * NJ) { const int b = q / (8 * NJ), w = q - b * (8 * NJ); m = b * 8 + (w & 7); j = w >> 3; }
            else { const int g = ntl - nfull * 8, w = q - nfull * 8 * NJ; j = w / g; m = nfull * 8 + (w - j * g); }
            pml = m; pn = 8 * j + x;
        } else {
        const int L = i * GRID + (int)blockIdx.x; if (L >= ntl * NN) return false;
        constexpr int nig = WGM * NN; const int wgid = L, gid = wgid / nig, fm = gid * WGM, gsz = (ntl - fm) < WGM ? (ntl - fm) : WGM;
        pml = fm + ((wgid % nig) % gsz); pn = (wgid % nig) / gsz; }
        const int pmg = tile0 + pml;
        const u32x4 t0 = *(const LAS u32x4*)(MISC_OFF + 20 * 4), t1 = *(const LAS u32x4*)(MISC_OFF + 24 * 4);
        int e = (pmg >= (int)t0.x) + (pmg >= (int)t0.y) + (pmg >= (int)t0.z) + (pmg >= (int)t0.w) + (pmg >= (int)t1.x) + (pmg >= (int)t1.y) + (pmg >= (int)t1.z);
        e = __builtin_amdgcn_readfirstlane(e);
        u.pn = pn; u.bn = e * NN + pn; u.acol = 0;
        if (DOWN) { u.pm = pmg; u.am = pml; } else { u.pm = pml; u.am = pmg; }
        return true;
    }
};

__device__ __forceinline__ void stage16_s(const char* gbase, unsigned voff, unsigned lds_dst) { unsigned keep;
    asm volatile("s_mov_b32 %0, m0\n\ts_mov_b32 m0, %3\n\ts_nop 0\n\tglobal_load_lds_dwordx4 %1, %2\n\ts_mov_b32 m0, %0" : "=&s"(keep) : "v"(voff), "s"(gbase), "s"(lds_dst) : "memory"); }
template <class Epi, class Sched, bool FP8 = false, bool ALIGN = true>
__device__ __forceinline__ void gemm_phase(LAS unsigned char* lds, const Gemm g, const Sched& S, const Epi& E, int wave_) {
    int tid_ = wave_ * 64 + fresh_lane(); asm volatile("" : "+v"(tid_));
    const int tid = tid_, wid = __builtin_amdgcn_readfirstlane(tid >> 6), lane = tid & 63, wr = wid >> 2, wc = wid & 3, fr = lane & 15, fq = lane >> 4;
    int K_ = g.K; asm volatile("" : "+s"(K_));
    const int K = K_, nt = K / BK;
    unsigned voffA[2], voffB[2];
#pragma unroll
    for (int i = 0; i < 2; ++i) { int R, C; stage_rc(tid * 16 + i * 8192, R, C); const int Rb = (R & ~31) + perm32(R & 31);
        voffA[i] = (unsigned)(R * g.lda + C) * 2u; voffB[i] = (unsigned)(Rb * g.ldb + C) * 2u; }
    const size_t kstep = (size_t)(BK * 2);
    const size_t hstepA = (size_t)HALF * g.lda * 2, hstepB = (size_t)HALF * g.ldb * 2;
    const unsigned ldsw = (unsigned)wid * 1024u;
    const int aoff = lds_byte(wr * 64 + fr, fq * 8), boff = lds_byte(wc * 32 + fr, fq * 8);
#define PG8_SA(b, h) (((b) * 2 + (h)) * HTB)
#define PG8_SB(b, h) ((4 + (b) * 2 + (h)) * HTB)
#define PG8_STAGE(bufoff, gbase, voff) do { _Pragma("unroll") for (int _i = 0; _i < 2; ++_i) { \
        if constexpr (FP8) stage16_s((const char*)(gbase), (voff)[_i], (unsigned)(size_t)(lds + (bufoff) + ldsw + _i * 8192)); \
        else __builtin_amdgcn_global_load_lds((const unsigned*)((const char*)(gbase) + (voff)[_i]), (LAS unsigned*)(lds + (bufoff) + ldsw + _i * 8192), 16, 0, 0); } } while (0)
#define PG8_LDA(dst, b, h) do { _Pragma("unroll") for (int m = 0; m < 4; ++m) _Pragma("unroll") for (int k = 0; k < 2; ++k) dst[m][k] = *(const LAS bf16x8*)(lds + PG8_SA(b, h) + aoff + m * 2048 + k * 1024); } while (0)
#define PG8_LDB(dst, b, h) do { _Pragma("unroll") for (int n = 0; n < 2; ++n) _Pragma("unroll") for (int k = 0; k < 2; ++k) dst[n][k] = *(const LAS bf16x8*)(lds + PG8_SB(b, h) + boff + n * 2048 + k * 1024); } while (0)
#define PG8_MMA(ai, bj, At, Bt) do { __builtin_amdgcn_s_setprio(1); _Pragma("unroll") for (int m = 0; m < 4; ++m) _Pragma("unroll") for (int n = 0; n < 2; ++n) _Pragma("unroll") for (int k = 0; k < 2; ++k) \
        acc[ai][bj][m][n] = __builtin_amdgcn_mfma_f32_16x16x32_bf16(Bt[n][k], At[m][k], acc[ai][bj][m][n], 0, 0, 0); __builtin_amdgcn_s_setprio(0); } while (0)
#define PG8_LDA8(dst, b, h) do { _Pragma("unroll") for (int m = 0; m < 4; ++m) { const i32x4 lo_ = *(const LAS i32x4*)(lds + PG8_SA(b, h) + aoff + m * 2048), hi_ = *(const LAS i32x4*)(lds + PG8_SA(b, h) + aoff + m * 2048 + 1024); \
        dst[m] = __builtin_shufflevector(lo_, hi_, 0, 1, 2, 3, 4, 5, 6, 7); } } while (0)
#define PG8_LDB8(dst, b, h) do { _Pragma("unroll") for (int n = 0; n < 2; ++n) { const i32x4 lo_ = *(const LAS i32x4*)(lds + PG8_SB(b, h) + boff + n * 2048), hi_ = *(const LAS i32x4*)(lds + PG8_SB(b, h) + boff + n * 2048 + 1024); \
        dst[n] = __builtin_shufflevector(lo_, hi_, 0, 1, 2, 3, 4, 5, 6, 7); } } while (0)
#define PG8_MMA8(ai, bj, At, Bt) do { __builtin_amdgcn_s_setprio(1); _Pragma("unroll") for (int m = 0; m < 4; ++m) _Pragma("unroll") for (int n = 0; n < 2; ++n) \
        acc[ai][bj][m][n] = __builtin_amdgcn_mfma_scale_f32_16x16x128_f8f6f4(Bt[n], At[m], acc[ai][bj][m][n], 0, 0, 0, 0, 0, 0); __builtin_amdgcn_s_setprio(0); } while (0)
#define PG8_WAIT_V(n) asm volatile("s_waitcnt vmcnt(" #n ")" ::: "memory")
#define PG8_WAIT_L(n) asm volatile("s_waitcnt lgkmcnt(" #n ")" ::: "memory")
#define PG8_BAR __builtin_amdgcn_s_barrier()
#define PG8_SCHED __builtin_amdgcn_sched_barrier(0)
#define PG8_ABASE(u) ((const char*)g.A + ((size_t)(u).am * BM * g.lda + (size_t)(u).acol) * 2)
#define PG8_BBASE(u) ((const char*)g.Bt + (size_t)(u).bn * BM * g.ldb * 2)
    Unit cur, nxt; int ui = 0;
    if (!S.next(0, cur)) return;
    f32x4 acc[2][2][4][2];
#pragma unroll
    for (int a = 0; a < 2; ++a)
#pragma unroll
        for (int b = 0; b < 2; ++b)
#pragma unroll
            for (int m = 0; m < 4; ++m)
#pragma unroll
                for (int n = 0; n < 2; ++n) acc[a][b][m][n] = (f32x4){0.f, 0.f, 0.f, 0.f};
    bf16x8 At[4][2], B0[2][2], B1[2][2]; i32x8 At8[4], B08[2], B18[2];
    const char* cA = PG8_ABASE(cur); const char* cB = PG8_BBASE(cur);
    {
        PG8_STAGE(PG8_SB(0, 0), cB, voffB); PG8_STAGE(PG8_SB(0, 1), cB + hstepB, voffB); PG8_STAGE(PG8_SA(0, 0), cA, voffA); PG8_STAGE(PG8_SA(0, 1), cA + hstepA, voffA);
        if (wr == 1) PG8_BAR;
        PG8_WAIT_V(2); PG8_BAR;
        PG8_STAGE(PG8_SB(1, 0), cB + kstep, voffB); PG8_STAGE(PG8_SA(1, 0), cA + kstep, voffA); PG8_STAGE(PG8_SB(1, 1), cB + hstepB + kstep, voffB);
        PG8_WAIT_V(6); PG8_BAR;
    }
    for (;;) {
        const bool has_next = S.next(ui + 1, nxt);
        const char* nA = has_next ? PG8_ABASE(nxt) : cA; const char* nB = has_next ? PG8_BBASE(nxt) : cB;
        for (int t = 0; t < nt; t += 2) {
            const bool last = (t == nt - 2);
            const char* a1 = cA + (size_t)(t + 1) * kstep;
            const char* a2 = last ? nA : cA + (size_t)(t + 2) * kstep; const char* b2 = last ? nB : cB + (size_t)(t + 2) * kstep;
            const char* a3 = a2 + kstep; const char* b3 = b2 + kstep;
            if constexpr (FP8) {
            PG8_LDB8(B08, 0, 0); PG8_LDB8(B18, 0, 1); PG8_SCHED; PG8_LDA8(At8, 0, 0); PG8_STAGE(PG8_SA(1, 1), a1 + hstepA, voffA);
            PG8_WAIT_V(8); PG8_WAIT_L(0); PG8_BAR; PG8_MMA8(0, 0, At8, B08); PG8_MMA8(0, 1, At8, B18); PG8_BAR; PG8_SCHED;
            PG8_LDA8(At8, 0, 1); PG8_STAGE(PG8_SB(0, 0), b2, voffB); PG8_STAGE(PG8_SB(0, 1), b2 + hstepB, voffB); PG8_STAGE(PG8_SA(0, 0), a2, voffA);
            PG8_WAIT_V(8); PG8_WAIT_L(0); PG8_BAR; PG8_MMA8(1, 0, At8, B08); PG8_MMA8(1, 1, At8, B18); PG8_BAR; PG8_SCHED;
            PG8_LDB8(B08, 1, 0); PG8_LDB8(B18, 1, 1); PG8_SCHED; PG8_LDA8(At8, 1, 0); PG8_STAGE(PG8_SA(0, 1), a2 + hstepA, voffA);
            PG8_WAIT_V(8); PG8_WAIT_L(0); PG8_BAR; PG8_MMA8(0, 0, At8, B08); PG8_MMA8(0, 1, At8, B18); PG8_BAR; PG8_SCHED;
            PG8_LDA8(At8, 1, 1); PG8_STAGE(PG8_SB(1, 0), b3, voffB); PG8_STAGE(PG8_SB(1, 1), b3 + hstepB, voffB); PG8_STAGE(PG8_SA(1, 0), a3, voffA);
            PG8_WAIT_V(8); PG8_WAIT_L(0); PG8_BAR; PG8_MMA8(1, 0, At8, B08); PG8_MMA8(1, 1, At8, B18); PG8_BAR; PG8_SCHED;
            } else {
            PG8_LDB(B0, 0, 0); PG8_LDB(B1, 0, 1); PG8_SCHED; PG8_LDA(At, 0, 0); PG8_STAGE(PG8_SA(1, 1), a1 + hstepA, voffA);
            PG8_WAIT_V(8); PG8_WAIT_L(0); PG8_BAR; PG8_MMA(0, 0, At, B0); PG8_MMA(0, 1, At, B1); PG8_BAR; PG8_SCHED;
            PG8_LDA(At, 0, 1); PG8_STAGE(PG8_SB(0, 0), b2, voffB); PG8_STAGE(PG8_SB(0, 1), b2 + hstepB, voffB); PG8_STAGE(PG8_SA(0, 0), a2, voffA);
            PG8_WAIT_V(8); PG8_WAIT_L(0); PG8_BAR; PG8_MMA(1, 0, At, B0); PG8_MMA(1, 1, At, B1); PG8_BAR; PG8_SCHED;
            PG8_LDB(B0, 1, 0); PG8_LDB(B1, 1, 1); PG8_SCHED; PG8_LDA(At, 1, 0); PG8_STAGE(PG8_SA(0, 1), a2 + hstepA, voffA);
            PG8_WAIT_V(8); PG8_WAIT_L(0); PG8_BAR; PG8_MMA(0, 0, At, B0); PG8_MMA(0, 1, At, B1); PG8_BAR; PG8_SCHED;
            PG8_LDA(At, 1, 1); PG8_STAGE(PG8_SB(1, 0), b3, voffB); PG8_STAGE(PG8_SB(1, 1), b3 + hstepB, voffB); PG8_STAGE(PG8_SA(1, 0), a3, voffA);
            PG8_WAIT_V(8); PG8_WAIT_L(0); PG8_BAR; PG8_MMA(1, 0, At, B0); PG8_MMA(1, 1, At, B1); PG8_BAR; PG8_SCHED;
            }
        }
        if constexpr (ALIGN) { if (wr == 0) PG8_BAR; }
        { int fr_ = fr, fq_ = fq; asm volatile("" : "+v"(fr_), "+v"(fq_));
          E(acc, cur, wr, wc, fr_, fq_); }
        if (!has_next) break;
#pragma unroll
        for (int a = 0; a < 2; ++a)
#pragma unroll
            for (int b = 0; b < 2; ++b)
#pragma unroll
                for (int m = 0; m < 4; ++m)
#pragma unroll
                    for (int n = 0; n < 2; ++n) acc[a][b][m][n] = (f32x4){0.f, 0.f, 0.f, 0.f};
        cur = nxt; cA = nA; cB = nB; ++ui;
        if constexpr (ALIGN) { if (wr == 1) PG8_BAR; }
    }
    PG8_WAIT_V(0);
    if constexpr (!ALIGN) { if (wr == 0) PG8_BAR; }
    PG8_BAR;
#undef PG8_SA
#undef PG8_SB
#undef PG8_STAGE
#undef PG8_LDA
#undef PG8_LDB
#undef PG8_MMA
#undef PG8_LDA8
#undef PG8_LDB8
#undef PG8_MMA8
#undef PG8_WAIT_V
#undef PG8_WAIT_L
#undef PG8_BAR
#undef PG8_SCHED
#undef PG8_ABASE
#undef PG8_BBASE
}

#define EPI_ROW(ai, m) (u.pm * BM + (ai) * HALF + wr * 64 + (m) * 16 + fr)
#define EPI_COL(bj) (u.pn * BM + (bj) * HALF + wc * 32 + 8 * fq)
typedef f32x4 AccT[2][2][4][2];

__device__ __forceinline__ void rope4(f32x4& v0, f32x4& v1, const f32x4 cs0, const f32x4 cs1) {
    f32x4 o0, o1;
    o0[0] = v0[0] * cs0[0] - v0[1] * cs0[1]; o0[1] = v0[1] * cs0[0] + v0[0] * cs0[1];
    o0[2] = v0[2] * cs0[2] - v0[3] * cs0[3]; o0[3] = v0[3] * cs0[2] + v0[2] * cs0[3];
    o1[0] = v1[0] * cs1[0] - v1[1] * cs1[1]; o1[1] = v1[1] * cs1[0] + v1[0] * cs1[1];
    o1[2] = v1[2] * cs1[2] - v1[3] * cs1[3]; o1[3] = v1[3] * cs1[2] + v1[2] * cs1[3];
    v0 = o0; v1 = o1;
}
__device__ __forceinline__ u32x4 pack8(const f32x4 v0, const f32x4 v1) { u32x4 w; w.x = cvt_pk_bf16(v0[0], v0[1]); w.y = cvt_pk_bf16(v0[2], v0[3]); w.z = cvt_pk_bf16(v1[0], v1[1]); w.w = cvt_pk_bf16(v1[2], v1[3]); return w; }

__device__ __forceinline__ void unpack8(const u32x4 w, f32x4& a, f32x4& b) { a[0] = bflo(w.x); a[1] = bfhi(w.x); a[2] = bflo(w.y); a[3] = bfhi(w.y); b[0] = bflo(w.z); b[1] = bfhi(w.z); b[2] = bflo(w.w); b[3] = bfhi(w.w); }
__device__ __forceinline__ u32x2 pack8_fp8(const f32x4 v0, const f32x4 v1, float s) { u32x2 w; w.x = pk4_fp8(v0[0] * s, v0[1] * s, v0[2] * s, v0[3] * s); w.y = pk4_fp8(v1[0] * s, v1[1] * s, v1[2] * s, v1[3] * s); return w; }
template <bool OUT8> struct EpiBf16 {
    bf16_t* O; int ldc; float osc;
    __device__ __forceinline__ void operator()(const AccT& acc, const Unit& u, int wr, int wc, int fr, int fq) const {
#pragma unroll
        for (int ai = 0; ai < 2; ++ai)
#pragma unroll
            for (int m = 0; m < 4; ++m) {
#pragma unroll
                for (int bj = 0; bj < 2; ++bj) {
                    if constexpr (OUT8) *(u32x2*)((unsigned char*)O + (size_t)EPI_ROW(ai, m) * ldc + EPI_COL(bj)) = pack8_fp8(acc[ai][bj][m][0], acc[ai][bj][m][1], osc);
                    else *(u32x4*)(O + (size_t)EPI_ROW(ai, m) * ldc + EPI_COL(bj)) = pack8(acc[ai][bj][m][0] * osc, acc[ai][bj][m][1] * osc); } }
    }
};
struct EpiQKV {
    unsigned char* ws; float asc;
    __device__ __forceinline__ void operator()(const AccT& acc, const Unit& u, int wr, int wc, int fr, int fq) const {
        bf16_t* Q = (bf16_t*)(ws + WS_Q); bf16_t* Kb = (bf16_t*)(ws + WS_K); bf16_t* VT = (bf16_t*)(ws + WS_VT); const float* tab64 = (const float*)(ws + WS_TAB64);
        if (u.pn < 9) {
            bf16_t* base = u.pn < 8 ? Q : Kb; const int ldc = u.pn < 8 ? 2048 : 256; const int colt = u.pn < 8 ? u.pn * BM : 0; const float sc = (u.pn < 8 ? QSCALE_SWA : 1.0f) * asc;
#pragma unroll
            for (int ai = 0; ai < 2; ++ai)
#pragma unroll
                for (int m = 0; m < 4; ++m) { const int row = EPI_ROW(ai, m);
#pragma unroll
                    for (int bj = 0; bj < 2; ++bj) { const int cl = bj * HALF + wc * 32 + 8 * fq; const int i0 = (cl & 63) >> 1;
                        const f32x4 cs0 = *(const f32x4*)(tab64 + ((size_t)row * 32 + i0) * 2), cs1 = *(const f32x4*)(tab64 + ((size_t)row * 32 + i0) * 2 + 4);
                        f32x4 v0 = acc[ai][bj][m][0], v1 = acc[ai][bj][m][1]; rope4(v0, v1, cs0, cs1); v0 = v0 * sc; v1 = v1 * sc;
                        if constexpr (SWA_FRAG) {
                            const int b = row >> 14, s = row & (SEQ - 1), hh = (colt + cl) >> 6, c64 = cl & 63, kk = c64 >> 4, hf2 = (c64 >> 3) & 1, nh = u.pn < 8 ? 32 : 4;
                            *(u32x4*)(base + ((((size_t)(b * nh + hh) * 512 + (s >> 5)) * 4 + kk) * 64 + hf2 * 32 + (s & 31)) * 8) = pack8(v0, v1); }
                        else *(u32x4*)(base + (size_t)row * ldc + colt + cl) = pack8(v0, v1); } }
        } else {
#pragma unroll
            for (int ai = 0; ai < 2; ++ai)
#pragma unroll
                for (int m = 0; m < 4; ++m) { const int row = EPI_ROW(ai, m), b = row >> 14, s = row & (SEQ - 1);
#pragma unroll
                    for (int bj = 0; bj < 2; ++bj) { const int cl = bj * HALF + wc * 32 + 8 * fq, kvh = cl >> 6, d0 = cl & 63;
                        const u32x4 w = pack8(acc[ai][bj][m][0] * asc, acc[ai][bj][m][1] * asc);
                        if constexpr (SWA_FRAG) {
                            const int j = s & 31, c = j >> 4, jj = j & 15, hfv = (jj & 7) >> 2, e = (jj & 3) + ((jj >> 3) << 2), mt = d0 >> 5;
                            bf16_t* pf = VT + (((((size_t)(b * 4 + kvh) * 512 + (s >> 5)) * 2 + c) * 2 + mt) * 64 + hfv * 32 + (d0 & 31)) * 8 + e;
                            pf[0] = (bf16_t)(w.x & 0xffff); pf[8] = (bf16_t)(w.x >> 16); pf[16] = (bf16_t)(w.y & 0xffff); pf[24] = (bf16_t)(w.y >> 16);
                            pf[32] = (bf16_t)(w.z & 0xffff); pf[40] = (bf16_t)(w.z >> 16); pf[48] = (bf16_t)(w.w & 0xffff); pf[56] = (bf16_t)(w.w >> 16); }
                        else {
                        bf16_t* p = VT + ((size_t)(b * 4 + kvh) * 64 + d0) * SEQ + s;
                        p[0 * SEQ] = (bf16_t)(w.x & 0xffff); p[1 * SEQ] = (bf16_t)(w.x >> 16); p[2 * SEQ] = (bf16_t)(w.y & 0xffff); p[3 * SEQ] = (bf16_t)(w.y >> 16);
                        p[4 * SEQ] = (bf16_t)(w.z & 0xffff); p[5 * SEQ] = (bf16_t)(w.z >> 16); p[6 * SEQ] = (bf16_t)(w.w & 0xffff); p[7 * SEQ] = (bf16_t)(w.w >> 16); } } }
        }
    }
};
template <bool RES16> struct EpiRes {
    const void* res; bf16_t* out; float sc;
    __device__ __forceinline__ void operator()(const AccT& acc, const Unit& u, int wr, int wc, int fr, int fq) const {
#pragma unroll
        for (int ai = 0; ai < 2; ++ai)
#pragma unroll
            for (int m = 0; m < 4; ++m) { const size_t ro = (size_t)EPI_ROW(ai, m) * DM;
#pragma unroll
                for (int bj = 0; bj < 2; ++bj) { const size_t o = ro + EPI_COL(bj); f32x4 r0, r1;
                    if constexpr (RES16) unpack8(*(const u32x4*)((const bf16_t*)res + o), r0, r1);
                    else { r0 = *(const f32x4*)((const float*)res + o); r1 = *(const f32x4*)((const float*)res + o + 4); }
                    *(u32x4*)(out + o) = pack8(r0 * ALPHA + acc[ai][bj][m][0] * sc, r1 * ALPHA + acc[ai][bj][m][1] * sc); }
                asm volatile("" ::: "memory"); }
    }
};
__device__ __forceinline__ float silu_mul(float g, float uu) { return g * __builtin_amdgcn_rcpf(1.0f + __builtin_amdgcn_exp2f(-g * LOG2E)) * uu; }
template <bool OUT8> struct EpiSwiglu {
    bf16_t* O; int ldc; float sc; float osc;
    __device__ __forceinline__ void operator()(const AccT& acc, const Unit& u, int wr, int wc, int fr, int fq) const {
#pragma unroll
        for (int ai = 0; ai < 2; ++ai)
#pragma unroll
            for (int m = 0; m < 4; ++m) { f32x4 a0, a1;
#pragma unroll
                for (int j = 0; j < 4; ++j) { a0[j] = silu_mul(acc[ai][0][m][0][j] * sc, acc[ai][1][m][0][j] * sc); a1[j] = silu_mul(acc[ai][0][m][1][j] * sc, acc[ai][1][m][1][j] * sc); }
                if constexpr (OUT8) { u32x2 w8; w8.x = pk4_fp8(a0[0] * osc, a0[1] * osc, a0[2] * osc, a0[3] * osc); w8.y = pk4_fp8(a1[0] * osc, a1[1] * osc, a1[2] * osc, a1[3] * osc);
                    *(u32x2*)((unsigned char*)O + (size_t)EPI_ROW(ai, m) * ldc + u.pn * HALF + wc * 32 + 8 * fq) = w8; }
                else *(u32x4*)(O + (size_t)EPI_ROW(ai, m) * ldc + u.pn * HALF + wc * 32 + 8 * fq) = pack8(a0, a1); }
    }
};
struct EpiPle {
    float* outf; unsigned char* ws; int layer; float nls;
    __device__ __forceinline__ void operator()(const AccT& acc, const Unit& u, int wr, int wc, int fr, int fq) const {
        const bf16_t* pp = (const bf16_t*)(ws + (layer == 0 ? WS_PP0 : WS_PP1));
        const bf16_t* xres = (const bf16_t*)(ws + (layer == 0 ? WS_XBA : WS_XBB));
#pragma unroll
        for (int ai = 0; ai < 2; ++ai)
#pragma unroll
            for (int m = 0; m < 4; ++m) { const unsigned ro = (unsigned)EPI_ROW(ai, m) * (unsigned)DM;
#pragma unroll
                for (int bj = 0; bj < 2; ++bj) { const unsigned o = ro + (unsigned)EPI_COL(bj);
                    f32x4 r0, r1, p0, p1; unpack8(*(const u32x4*)(xres + o), r0, r1); unpack8(*(const u32x4*)(pp + o), p0, p1);
                    f32x4 s0, s1;
#pragma unroll
                    for (int j = 0; j < 4; ++j) { s0[j] = __builtin_amdgcn_rcpf(1.0f + __builtin_amdgcn_exp2f(acc[ai][bj][m][0][j] * nls)); s1[j] = __builtin_amdgcn_rcpf(1.0f + __builtin_amdgcn_exp2f(acc[ai][bj][m][1][j] * nls)); }
                    const f32x4 o0 = r0 + s0 * p0, o1 = r1 + s1 * p1;
                    if (layer == 0) { *(u32x4*)((bf16_t*)(ws + WS_XBB) + o) = pack8(o0, o1);
                                      if constexpr (F8_WIN_SPLIT || F8_WIN) *(u32x2*)(ws + WS_XB8 + o) = pack8_fp8(o0, o1, 1.0f); }
                    else { *(f32x4*)(outf + o) = o0; *(f32x4*)(outf + o + 4) = o1; } }
                asm volatile("" ::: "memory"); }
    }
};
struct EpiWin {
    unsigned char* ws; float asc; int pn0;
    __device__ __forceinline__ void operator()(const AccT& acc, const Unit& u, int wr, int wc, int fr, int fq) const {
        bf16_t* QN = (bf16_t*)(ws + WS_QN); bf16_t* QR = (bf16_t*)(ws + WS_QR); float* CRAW = (float*)(ws + WS_CRAW); bf16_t* KV = (bf16_t*)(ws + WS_KV); bf16_t* QI = (bf16_t*)(ws + WS_QI);
        bf16_t* KIF = (bf16_t*)(ws + WS_KIF); float* WI = (float*)(ws + WS_WI); const float* tab64 = (const float*)(ws + WS_TAB64); const float* tab32 = (const float*)(ws + WS_TAB32);
        const int pn = u.pn + pn0;
#pragma unroll
        for (int ai = 0; ai < 2; ++ai)
#pragma unroll
            for (int m = 0; m < 4; ++m) { const int row = EPI_ROW(ai, m);
#pragma unroll
                for (int bj = 0; bj < 2; ++bj) { const int cl = bj * HALF + wc * 32 + 8 * fq; f32x4 v0 = acc[ai][bj][m][0] * asc, v1 = acc[ai][bj][m][1] * asc;
                    if (pn < 8) { *(u32x4*)(QN + (size_t)row * 2048 + pn * BM + cl) = pack8(v0, v1); }
                    else if (pn < 12) { const int i0 = (cl & 63) >> 1;
                        const f32x4 cs0 = *(const f32x4*)(tab64 + ((size_t)row * 32 + i0) * 2), cs1 = *(const f32x4*)(tab64 + ((size_t)row * 32 + i0) * 2 + 4);
                        rope4(v0, v1, cs0, cs1); if constexpr (F8_LAT) { v0 = v0 * QLAT_F8SCALE; v1 = v1 * QLAT_F8SCALE; }
                        if constexpr (F8_KV) *(u32x2*)((unsigned char*)QR + (size_t)row * 1024 + (pn - 8) * BM + cl) = pack8_fp8(v0, v1, 1.0f);
                        else *(u32x4*)(QR + (size_t)row * 1024 + (pn - 8) * BM + cl) = pack8(v0, v1); }
                    else if (pn < 14) { float* p = CRAW + (size_t)row * 512 + (pn - 12) * BM + cl; *(f32x4*)p = v0; *(f32x4*)(p + 4) = v1; }
                    else if (pn == 14) {
                        if (cl < 64) { const int i0 = cl >> 1;
                            const f32x4 cs0 = *(const f32x4*)(tab64 + ((size_t)row * 32 + i0) * 2), cs1 = *(const f32x4*)(tab64 + ((size_t)row * 32 + i0) * 2 + 4);
                            rope4(v0, v1, cs0, cs1);
                            if constexpr (F8_KV) *(u32x2*)((unsigned char*)KV + (size_t)row * 576 + 512 + cl) = pack8_fp8(v0, v1, KV_F8SCALE);
                            else *(u32x4*)(KV + (size_t)row * 576 + 512 + cl) = pack8(v0, v1); }
                        else if (cl < 128) { const int d8 = cl - 64;
                            if (d8 < 32) { const int i0 = d8 >> 1;
                                const f32x4 cs0 = *(const f32x4*)(tab32 + ((size_t)row * 16 + i0) * 2), cs1 = *(const f32x4*)(tab32 + ((size_t)row * 16 + i0) * 2 + 4);
                                rope4(v0, v1, cs0, cs1); }
                            const int b = row >> 14, s = row & (SEQ - 1), blk = s >> 5, j = s & 31, kk = d8 >> 4, hf = (d8 >> 3) & 1;
                            *(u32x4*)(KIF + ((size_t)((b * 512 + blk) * 4 + kk) * 64 + hf * 32 + j) * 8) = pack8(v0, v1); }
                        else if (cl < 144) { float* p = WI + (size_t)row * 16 + (cl - 128); *(f32x4*)p = v0; *(f32x4*)(p + 4) = v1; }
                    } else { const int cq = (pn - 15) * BM + cl, d8 = cq & 63;
                        if (d8 < 32) { const int i0 = d8 >> 1;
                            const f32x4 cs0 = *(const f32x4*)(tab32 + ((size_t)row * 16 + i0) * 2), cs1 = *(const f32x4*)(tab32 + ((size_t)row * 16 + i0) * 2 + 4);
                            rope4(v0, v1, cs0, cs1); }
                        *(u32x4*)(QI + (size_t)row * 1024 + cq) = pack8(v0, v1); }
                } }
    }
};
struct EpiMoeDown {
    unsigned char* ws;
    __device__ __forceinline__ void operator()(const AccT& acc, const Unit& u, int wr, int wc, int fr, int fq) const {
        bf16_t* O = (bf16_t*)(ws + WS_SOUT); const float* gate = (const float*)(ws + WS_SGATE);
#pragma unroll
        for (int ai = 0; ai < 2; ++ai)
#pragma unroll
            for (int m = 0; m < 4; ++m) { const int row = EPI_ROW(ai, m); const float gt = gate[row] * (1.0f / (ACT_F8SCALE * W2_F8SCALE)); bf16_t* rowp = O + (size_t)row * DM;
#pragma unroll
                for (int bj = 0; bj < 2; ++bj) *(u32x4*)(rowp + EPI_COL(bj)) = pack8(acc[ai][bj][m][0] * gt, acc[ai][bj][m][1] * gt); }
    }
};
}

#define XB_TMO      128
#define XB_XCNT(j)  (256  + 64 * (j))
#define XB_XSUB(j)  (1280 + 64 * (j))
#define XB_XGEN(j)  (2304 + 64 * (j))
#define XB_TOP      3328
#define XB_TOPGEN   3392
#define XCD_BAR_WORDS 3456
#define XB_SPIN_CAP (1u << 22)

__device__ __forceinline__ unsigned xb_ld(unsigned* p)              { return __hip_atomic_load(p, __ATOMIC_RELAXED, __HIP_MEMORY_SCOPE_AGENT); }
__device__ __forceinline__ unsigned xb_add(unsigned* p, unsigned v) { return __hip_atomic_fetch_add(p, v, __ATOMIC_RELAXED, __HIP_MEMORY_SCOPE_AGENT); }
__device__ __forceinline__ unsigned xb_xcc_id() { return (unsigned)__builtin_amdgcn_s_getreg((3 << 11) | 20) & 0xFu; }
#define XB_SPIN(cond, bar) do { unsigned _sp = 0; while (cond) { __builtin_amdgcn_s_sleep(1); \
    if ((++_sp & 255u) == 0u) { if (xb_ld(&(bar)[XB_TMO])) break; if (_sp > XB_SPIN_CAP) { atomicAdd(&(bar)[XB_TMO], 1u); break; } } } } while (0)

struct XcdBarrier { unsigned* bar; unsigned x; volatile LAS unsigned* st; };

__device__ __forceinline__ XcdBarrier xcd_barrier_post(unsigned* bar, volatile LAS unsigned* st) {
    XcdBarrier b; b.bar = bar; b.x = xb_xcc_id(); b.st = st;
    if (threadIdx.x == 0) (void)xb_add(&bar[XB_XCNT(b.x)], 1u);
    return b;
}
__device__ __forceinline__ void xcd_barrier_complete(unsigned* bar, unsigned x, unsigned& nloc, unsigned& nx) {
    const unsigned G = gridDim.x * gridDim.y * gridDim.z;
    unsigned sum, cnt, mine, sp = 0u;
    for (;;) {
        sum = 0u; cnt = 0u; mine = 0u;
#pragma unroll
        for (unsigned j = 0; j < 16; ++j) { const unsigned c = xb_ld(&bar[XB_XCNT(j)]); sum += c; cnt += (c > 0u) ? 1u : 0u; mine = (j == x) ? c : mine; }
        if (sum == G) break;
        __builtin_amdgcn_s_sleep(1);
        if ((++sp & 255u) == 0u) { if (xb_ld(&bar[XB_TMO])) break; if (sp > XB_SPIN_CAP) { atomicAdd(&bar[XB_TMO], 1u); break; } }
    }
    nloc = mine > 0u ? mine : 1u; nx = cnt > 0u ? cnt : 1u;
}
__device__ __forceinline__ void xcd_barrier(const XcdBarrier& b, int wave_) {
    asm volatile("s_waitcnt vmcnt(0)" ::: "memory");
    __syncthreads();
    int tl_ = wave_ * 64 + fresh_lane();
    if (tl_ == 0) {
        unsigned* bar = b.bar;
        __builtin_amdgcn_s_waitcnt(0);
        unsigned nloc = b.st[0], nx = b.st[1];
        if (nloc == 0u) { xcd_barrier_complete(bar, b.x, nloc, nx); b.st[0] = nloc; b.st[1] = nx; }
        const unsigned old = xb_add(&bar[XB_XSUB(b.x)], 1u);
        const unsigned gen = old / nloc;
        if (old + 1u == (gen + 1u) * nloc) {
            __builtin_amdgcn_fence(__ATOMIC_RELEASE, "agent");
            asm volatile("s_waitcnt vmcnt(0)" ::: "memory");
            const unsigned og = xb_add(&bar[XB_TOP], 1u);
            const unsigned tg = og / nx;
            if (og + 1u == (tg + 1u) * nx) xb_add(&bar[XB_TOPGEN], 1u);
            else XB_SPIN(xb_ld(&bar[XB_TOPGEN]) == tg, bar);
            __builtin_amdgcn_fence(__ATOMIC_ACQUIRE, "agent");
            xb_add(&bar[XB_XGEN(b.x)], 1u);
            asm volatile("s_waitcnt vmcnt(0)" ::: "memory");
        } else {
            XB_SPIN(xb_ld(&bar[XB_XGEN(b.x)]) == gen, bar);
            __builtin_amdgcn_fence(__ATOMIC_ACQUIRE, "agent");
            asm volatile("s_waitcnt vmcnt(0)" ::: "memory");
        }
    }
    __syncthreads();
}

struct Args { const void* in[22]; float* out; unsigned char* ws; };
struct Frame {
    LAS unsigned char* lds; volatile LAS unsigned* MISC; unsigned* ctl;
    int tid, lane, wave, gw; static constexpr int G = 256;
};
__device__ __forceinline__ void glds16(const void* g, LAS void* l) { __builtin_amdgcn_global_load_lds((const unsigned*)g, (LAS unsigned*)l, 16, 0, 0); }
__device__ __forceinline__ int mbcnt64(u64 m) { return (int)__builtin_amdgcn_mbcnt_hi((unsigned)(m >> 32), __builtin_amdgcn_mbcnt_lo((unsigned)m, 0u)); }

__device__ __forceinline__ int il64(int d) { return d < 32 ? 2 * d : 2 * (d - 32) + 1; }
__device__ __forceinline__ int il32(int d) { return d < 16 ? 2 * d : (d < 32 ? 2 * (d - 16) + 1 : d); }
__device__ __forceinline__ int map_row(int mode, int n) {
    if (mode == 1) return n < 2304 ? (n & ~63) + il64(n & 63) : n;
    if (mode == 2) return ((n >> 7) << 8) + (n & 127);
    if (mode == 3) return ((n >> 7) << 8) + 128 + (n & 127);
    if (mode == 4) {
        if (n < 3072) { const int h = n / 192, r = n - h * 192; return r < 128 ? h * 128 + r : 2048 + h * 64 + il64(r - 128); }
        if (n < 3584) return n;
        if (n < 3648) return 3584 + il64(n - 3584);
        if (n < 4672) { const int j = n - 3648; return 3840 + (j & ~63) + il32(j & 63); }
        if (n < 4736) return 3648 + il32(n - 4672);
        return 3712 + (n - 4736);
    }
    return n;
}
__device__ __forceinline__ void tr_item(const float* __restrict__ W, int N, bf16_t* WT, int ldo, int kofs, int mode, LAS float* scr, int item, int lane, float f8scale = 0.f, int rlo = 0, int rhi = 1 << 30) {
    const int nblk = (N + 63) >> 6, kb = item / nblk, nb = item - kb * nblk, k0 = 64 * kb, n0 = 64 * nb;
    const int nc = n0 + 4 * (lane & 15); const bool okr = nc < N; const float* wp = W + (size_t)(k0 + (lane >> 4)) * N + nc;
    f32x4 v[16];
#pragma unroll
    for (int i = 0; i < 16; ++i) v[i] = okr ? *(const f32x4*)(wp + (size_t)(4 * i) * N) : (f32x4){0.f, 0.f, 0.f, 0.f};
#pragma unroll
    for (int i = 0; i < 16; ++i) { const int k = 4 * i + (lane >> 4); *(LAS f32x4*)(scr + k * 64 + ((4 * (lane & 15) + 4 * (i >> 1)) & 63)) = v[i]; }
    LDS_WAIT();
    const int c = lane & 7;
#pragma unroll
    for (int j = 0; j < 8; ++j) { const int nl = (lane >> 3) + 8 * j, n = n0 + nl; const LAS float* s = scr + (8 * c) * 64 + ((nl + 4 * c) & 63);
        const int orow = map_row(mode, n); const bool okw = n < N && orow >= rlo && orow < rhi;
        if (f8scale > 0.f) { u32x2 o8; o8.x = pk4_fp8(s[0 * 64] * f8scale, s[1 * 64] * f8scale, s[2 * 64] * f8scale, s[3 * 64] * f8scale); o8.y = pk4_fp8(s[4 * 64] * f8scale, s[5 * 64] * f8scale, s[6 * 64] * f8scale, s[7 * 64] * f8scale);
            if (okw) *(u32x2*)((unsigned char*)WT + (size_t)orow * ldo + kofs + k0 + 8 * c) = o8; }
        else {
        u32x4 o; o.x = cvt_pk_bf16(s[0 * 64], s[1 * 64]); o.y = cvt_pk_bf16(s[2 * 64], s[3 * 64]); o.z = cvt_pk_bf16(s[4 * 64], s[5 * 64]); o.w = cvt_pk_bf16(s[6 * 64], s[7 * 64]);
        if (okw) *(u32x4*)(WT + (size_t)orow * ldo + kofs + k0 + 8 * c) = o; } }
    LDS_WAIT();
}
__device__ __forceinline__ void tr_matrix(const Frame& F, const float* W, int K, int N, bf16_t* WT, int ldo, int kofs, int mode, float f8scale = 0.f, int rlo = 0, int rhi = 1 << 30) {
    LAS float* scr = (LAS float*)(F.lds + F.wave * 16384);
    const int nitems = (K >> 6) * ((N + 63) >> 6), NGW = F.G * NWAVES;
    for (int it = F.gw; it < nitems; it += NGW) tr_item(W, N, WT, ldo, kofs, mode, scr, it, F.lane, f8scale, rlo, rhi);
}
__device__ __forceinline__ void cvt_linear(const Frame& F, const float* src, bf16_t* dst, size_t n8) {
    const size_t NT = (size_t)F.G * NTHREADS;
    for (size_t i = (size_t)blockIdx.x * NTHREADS + F.tid; i < n8; i += NT) { const f32x4 a = *(const f32x4*)(src + i * 8), b = *(const f32x4*)(src + i * 8 + 4); *(u32x4*)(dst + i * 8) = pg8::pack8(a, b); }
}
__device__ __forceinline__ void cvt_linear8(const Frame& F, const float* src, unsigned char* dst, size_t n8) {
    const size_t NT = (size_t)F.G * NTHREADS;
    for (size_t i = (size_t)blockIdx.x * NTHREADS + F.tid; i < n8; i += NT) { const f32x4 a = *(const f32x4*)(src + i * 8), b = *(const f32x4*)(src + i * 8 + 4); *(u32x2*)(dst + i * 8) = pg8::pack8_fp8(a, b, 1.0f); }
}
__device__ __forceinline__ void sincos_d(double ang, float& c, float& s) {
    const double n = __builtin_rint(ang * 0.6366197723675814);
    double r = __builtin_fma(-n, 1.5707963267948966, ang); r = __builtin_fma(-n, 6.123233995736766e-17, r);
    const double r2 = r * r;
    const double sp = r * (1.0 + r2 * (-1.0 / 6.0 + r2 * (1.0 / 120.0 + r2 * (-1.0 / 5040.0 + r2 * (1.0 / 362880.0 + r2 * (-1.0 / 39916800.0 + r2 * (1.0 / 6227020800.0)))))));
    const double cp = 1.0 + r2 * (-0.5 + r2 * (1.0 / 24.0 + r2 * (-1.0 / 720.0 + r2 * (1.0 / 40320.0 + r2 * (-1.0 / 3628800.0 + r2 * (1.0 / 479001600.0 + r2 * (-1.0 / 87178291200.0)))))));
    const int q = (int)((long long)n & 3);
    const float sf = (float)sp, cf = (float)cp;
    c = q == 0 ? cf : (q == 1 ? -sf : (q == 2 ? -cf : sf));
    s = q == 0 ? sf : (q == 1 ? cf : (q == 2 ? -sf : -cf));
}
__device__ __forceinline__ void rope_tables(const Frame& F, const int* pos, float* tab64, float* tab32) {
    const int NT = F.G * NTHREADS;
    for (int i = blockIdx.x * NTHREADS + F.tid; i < T * 48; i += NT) {
        const int t = i / 48, f = i - t * 48; const bool is64 = f < 32; const int fi = is64 ? f : f - 32;
        const double base = is64 ? 0.7498942093324559 : 0.5623413251903491;
        double inv = 1.0; for (int k = 0; k < fi; ++k) inv *= base;
        float c, s; sincos_d((double)pos[t] * inv, c, s);
        float* o = is64 ? tab64 + ((size_t)t * 32 + fi) * 2 : tab32 + ((size_t)t * 16 + fi) * 2; o[0] = c; o[1] = s;
    }
}

constexpr int MOE_CONV_ITEMS = 8 * 3 * 3584;
constexpr int TOPK_CONV = 11;
__device__ __forceinline__ void moe_conv_item(const float* w1, const float* w3, const float* w2, unsigned char* ws, LAS float* scr, int it, int lane) {
    const int e = it / (3 * 3584), r = it - e * (3 * 3584), mtx = r / 3584, sub = r - mtx * 3584;
    if (mtx < 2) tr_item((mtx == 0 ? w1 : w3) + (size_t)e * DM * MFFN, MFFN, (bf16_t*)(ws + WS_MW13 + (size_t)e * 2 * MFFN * DM), DM, 0, 2 + mtx, scr, sub, lane, W13_F8SCALE);
    else tr_item(w2 + (size_t)e * MFFN * DM, DM, (bf16_t*)(ws + WS_MW2 + (size_t)e * DM * MFFN), MFFN, 0, 0, scr, sub, lane, W2_F8SCALE);
}

__device__ __forceinline__ unsigned ln_col(int lane, int q) { return 8u * (unsigned)(lane & 63) + 512u * (unsigned)(q >> 1) + 4u * (unsigned)(q & 1); }
__device__ __forceinline__ void ln_load16(f32x4 (&v)[8], const bf16_t* row, int lane) {
#pragma unroll
    for (int j = 0; j < 4; ++j) pg8::unpack8(*(const u32x4*)(row + ln_col(lane, 2 * j)), v[2 * j], v[2 * j + 1]);
}
__device__ __forceinline__ void ln_store16(const f32x4 (&v)[8], bf16_t* row, int lane) {
#pragma unroll
    for (int j = 0; j < 4; ++j) *(u32x4*)(row + ln_col(lane, 2 * j)) = pg8::pack8(v[2 * j], v[2 * j + 1]);
}
__device__ __forceinline__ void ln_store8(const f32x4 (&v)[8], unsigned char* row, int lane) {
#pragma unroll
    for (int j = 0; j < 4; ++j) *(u32x2*)(row + ln_col(lane, 2 * j)) = pg8::pack8_fp8(v[2 * j], v[2 * j + 1], 1.0f);
}
__device__ __forceinline__ void ln_core(f32x4 (&v)[8], const float* g, const float* bb, int lane) {
    float s = 0.f;
#pragma unroll
    for (int j = 0; j < 8; ++j) s += (v[j][0] + v[j][1]) + (v[j][2] + v[j][3]);
    const float mean = wave_sum(s) * (1.0f / DM); float s2 = 0.f;
#pragma unroll
    for (int j = 0; j < 8; ++j) { v[j] = v[j] - mean; s2 += (v[j][0] * v[j][0] + v[j][1] * v[j][1]) + (v[j][2] * v[j][2] + v[j][3] * v[j][3]); }
    const float rstd = 1.0f / sqrtf(wave_sum(s2) * (1.0f / DM) + LN_EPS);
    int l2 = lane; asm volatile("" : "+v"(l2) :: "memory");
#pragma unroll
    for (int j = 0; j < 8; ++j) { const f32x4 gv = *(const f32x4*)(g + ln_col(l2, j)), bv = *(const f32x4*)(bb + ln_col(l2, j)); v[j] = v[j] * rstd * gv + bv; }
}
template <bool OUT8> __device__ __forceinline__ void ln_phase(const Frame& F, const bf16_t* YH, bf16_t* X16, unsigned char* X8, const float* g, const float* bb) {
    const int NGW = F.G * NWAVES;
    for (int m = F.gw; m < T; m += NGW) { f32x4 v[8];
        ln_load16(v, YH + (size_t)m * DM, F.lane); ln_core(v, g, bb, F.lane); ln_store16(v, X16 + (size_t)m * DM, F.lane);
        if constexpr (OUT8) ln_store8(v, X8 + (size_t)m * DM, F.lane); }
}

__device__ __forceinline__ int crow(int r, int hi) { return (r & 3) + 8 * (r >> 2) + 4 * hi; }
template <bool OUT8> __device__ __forceinline__ void swa_phase(const Frame& F, bf16_t* Q, const bf16_t* Kb, const bf16_t* VT, const float* sinks, unsigned char* O8) {
    const int lane = F.lane, l31 = lane & 31, hf = lane >> 5;
    for (int wi = blockIdx.x; wi < 4096; wi += F.G) {
        const int kvh = wi & 3, qsi = (wi >> 2) & 511, b = wi >> 11, h = kvh * 8 + F.wave, q0 = qsi * 32;
        const size_t row0 = (size_t)b * SEQ + q0;
        bf16x8 qf[4];
#pragma unroll
        for (int kk = 0; kk < 4; ++kk) { if constexpr (SWA_FRAG) qf[kk] = *(const bf16x8*)(Q + ((((size_t)(b * 32 + h) * 512 + qsi) * 4 + kk) * 64 + lane) * 8);
            else qf[kk] = *(const bf16x8*)(Q + (row0 + l31) * 2048 + h * 64 + 16 * kk + 8 * hf); }
        bf16x8 kf[5][4];
#pragma unroll
        for (int kt = 0; kt < 5; ++kt) {
            int kpos = q0 - 128 + 32 * kt + l31; kpos = kpos < 0 ? 0 : kpos;
            const bf16_t* kp = Kb + ((size_t)b * SEQ + kpos) * 256 + kvh * 64 + 8 * hf;
            const int kblk = qsi - 4 + kt < 0 ? 0 : qsi - 4 + kt;
#pragma unroll
            for (int kk = 0; kk < 4; ++kk) { if constexpr (SWA_FRAG) kf[kt][kk] = *(const bf16x8*)(Kb + ((((size_t)(b * 4 + kvh) * 512 + kblk) * 4 + kk) * 64 + lane) * 8); else kf[kt][kk] = *(const bf16x8*)(kp + 16 * kk); }
        }
        asm volatile("" ::: "memory");
        f32x16 sc[5];
#pragma unroll
        for (int kt = 0; kt < 5; ++kt) {
            f32x16 a;
#pragma unroll
            for (int r = 0; r < 16; ++r) a[r] = 0.f;
#pragma unroll
            for (int kk = 0; kk < 4; ++kk) a = __builtin_amdgcn_mfma_f32_32x32x16_bf16(kf[kt][kk], qf[kk], a, 0, 0, 0);
            sc[kt] = a;
        }
        bf16x8 vf[5][2][2];
#pragma unroll
        for (int kt = 0; kt < 5; ++kt)
#pragma unroll
            for (int c = 0; c < 2; ++c) {
                int kb = q0 - 128 + 32 * kt + 16 * c + 4 * hf; int kb0 = kb < 0 ? 0 : kb, kb1 = kb + 8 < 0 ? 0 : kb + 8;
#pragma unroll
                for (int mt = 0; mt < 2; ++mt) {
                    if constexpr (SWA_FRAG) { const int vblk = qsi - 4 + kt < 0 ? 0 : qsi - 4 + kt; vf[kt][c][mt] = *(const bf16x8*)(VT + (((((size_t)(b * 4 + kvh) * 512 + vblk) * 2 + c) * 2 + mt) * 64 + lane) * 8); }
                    else { const bf16_t* vp = VT + ((size_t)(b * 4 + kvh) * 64 + 32 * mt + l31) * SEQ;
                    const u32x2 v0 = *(const u32x2*)(vp + kb0), v1 = *(const u32x2*)(vp + kb1); u32x4 w; w.x = v0.x; w.y = v0.y; w.z = v1.x; w.w = v1.y; vf[kt][c][mt] = __builtin_bit_cast(bf16x8, w); } }
            }
        asm volatile("" ::: "memory");
        const float sink2 = sinks[h] * LOG2E; const int qpos = q0 + l31;
        float mx = sink2;
#pragma unroll
        for (int kt = 0; kt < 5; ++kt)
#pragma unroll
            for (int r = 0; r < 16; ++r) { const int kpos = q0 - 128 + 32 * kt + crow(r, hf); const bool ok = kpos >= 0 && kpos <= qpos && (qpos - kpos) < 128;
                const float v = ok ? sc[kt][r] : -INFINITY; sc[kt][r] = v; mx = fmaxf(mx, v); }
        mx = fmaxf(mx, shx(mx, 32, lane));
        float sum = 0.f;
#pragma unroll
        for (int kt = 0; kt < 5; ++kt)
#pragma unroll
            for (int r = 0; r < 16; ++r) { const float p = __builtin_amdgcn_exp2f(sc[kt][r] - mx); sc[kt][r] = p; sum += p; }
        sum += shx(sum, 32, lane);
        const float inv = 1.0f / (sum + __builtin_amdgcn_exp2f(sink2 - mx));
        f32x16 o[2];
#pragma unroll
        for (int r = 0; r < 16; ++r) { o[0][r] = 0.f; o[1][r] = 0.f; }
#pragma unroll
        for (int kt = 0; kt < 5; ++kt)
#pragma unroll
            for (int c = 0; c < 2; ++c) {
                bf16x8 pb; { u32x4 w; w.x = cvt_pk_bf16(sc[kt][8 * c + 0], sc[kt][8 * c + 1]); w.y = cvt_pk_bf16(sc[kt][8 * c + 2], sc[kt][8 * c + 3]); w.z = cvt_pk_bf16(sc[kt][8 * c + 4], sc[kt][8 * c + 5]); w.w = cvt_pk_bf16(sc[kt][8 * c + 6], sc[kt][8 * c + 7]); pb = __builtin_bit_cast(bf16x8, w); }
#pragma unroll
                for (int mt = 0; mt < 2; ++mt) o[mt] = __builtin_amdgcn_mfma_f32_32x32x16_bf16(vf[kt][c][mt], pb, o[mt], 0, 0, 0);
            }
        bf16_t* op = Q + (row0 + l31) * 2048 + h * 64; unsigned char* op8 = O8 + (row0 + l31) * 2048 + h * 64; const float inv8 = inv * O0_F8SCALE;
#pragma unroll
        for (int mt = 0; mt < 2; ++mt)
#pragma unroll
            for (int r4 = 0; r4 < 4; ++r4) {
                if constexpr (OUT8) *(unsigned*)(op8 + 32 * mt + 8 * r4 + 4 * hf) = pk4_fp8(o[mt][4 * r4] * inv8, o[mt][4 * r4 + 1] * inv8, o[mt][4 * r4 + 2] * inv8, o[mt][4 * r4 + 3] * inv8);
                else { u32x2 w; w.x = cvt_pk_bf16(o[mt][4 * r4] * inv, o[mt][4 * r4 + 1] * inv); w.y = cvt_pk_bf16(o[mt][4 * r4 + 2] * inv, o[mt][4 * r4 + 3] * inv);
                *(u32x2*)(op + 32 * mt + 8 * r4 + 4 * hf) = w; } }
    }
}

__device__ __forceinline__ void kvnorm_phase(const Frame& F, const float* CRAW, const float* gk, bf16_t* KV) {
    const int NGW = F.G * NWAVES;
    for (int m = F.gw; m < T; m += NGW) { const float* cr = CRAW + (size_t)m * 512;
        const f32x4 a = *(const f32x4*)(cr + 4 * F.lane), b = *(const f32x4*)(cr + 256 + 4 * F.lane);
        float s = (a[0] * a[0] + a[1] * a[1]) + (a[2] * a[2] + a[3] * a[3]) + (b[0] * b[0] + b[1] * b[1]) + (b[2] * b[2] + b[3] * b[3]);
        const float r = 1.0f / sqrtf(wave_sum(s) * (1.0f / 512.0f) + RMS_EPS);
        const f32x4 ga = *(const f32x4*)(gk + 4 * F.lane), gb = *(const f32x4*)(gk + 256 + 4 * F.lane);
        if constexpr (F8_KV) { const float r8 = r * KV_F8SCALE; unsigned char* kp = (unsigned char*)KV + (size_t)m * 576 + 4 * F.lane;
            *(unsigned*)kp = pk4_fp8(a[0] * r8 * ga[0], a[1] * r8 * ga[1], a[2] * r8 * ga[2], a[3] * r8 * ga[3]);
            *(unsigned*)(kp + 256) = pk4_fp8(b[0] * r8 * gb[0], b[1] * r8 * gb[1], b[2] * r8 * gb[2], b[3] * r8 * gb[3]); continue; }
        u32x2 w0, w1; w0.x = cvt_pk_bf16(a[0] * r * ga[0], a[1] * r * ga[1]); w0.y = cvt_pk_bf16(a[2] * r * ga[2], a[3] * r * ga[3]);
        w1.x = cvt_pk_bf16(b[0] * r * gb[0], b[1] * r * gb[1]); w1.y = cvt_pk_bf16(b[2] * r * gb[2], b[3] * r * gb[3]);
        *(u32x2*)(KV + (size_t)m * 576 + 4 * F.lane) = w0; *(u32x2*)(KV + (size_t)m * 576 + 256 + 4 * F.lane) = w1; }
}

__device__ __forceinline__ float relu1(float a) { return __builtin_amdgcn_fmed3f(a, 0.f, 3.0e38f); }
__device__ __forceinline__ unsigned f2key(float f) { const unsigned u = __float_as_uint(f); return u ^ ((unsigned)((int)u >> 31) | 0x80000000u); }
__device__ __forceinline__ float key2f(unsigned k) { const unsigned u = (k & 0x80000000u) ? (k ^ 0x80000000u) : ~k; return __uint_as_float(u); }
__device__ __forceinline__ unsigned compact256(LAS u64* buf, int n, int lane) {
    u64 e[8];
#pragma unroll
    for (int i = 0; i < 8; ++i) e[i] = (lane + 64 * i < n) ? buf[lane + 64 * i] : 0ull;
    unsigned thr = 0u;
    for (int bit = 31; bit >= 0; --bit) {
        const unsigned cand = thr | (1u << bit); int c = 0;
#pragma unroll
        for (int i = 0; i < 8; ++i) c += __popcll(__ballot((unsigned)(e[i] >> 32) >= cand));
        if (c >= 256) thr = cand;
    }
    int ngt = 0;
#pragma unroll
    for (int i = 0; i < 8; ++i) ngt += __popcll(__ballot((unsigned)(e[i] >> 32) > thr));
    int pos_gt = 0, pos_eq = ngt;
#pragma unroll
    for (int i = 0; i < 8; ++i) { const unsigned k = (unsigned)(e[i] >> 32); const bool gt = k > thr, eq = k == thr; const u64 mg = __ballot(gt), me = __ballot(eq);
        if (gt) buf[pos_gt + mbcnt64(mg)] = e[i];
        const int re = pos_eq + mbcnt64(me); if (eq && re < 256) buf[re] = e[i];
        pos_gt += __popcll(mg); pos_eq += __popcll(me); }
    return thr;
}
__device__ __forceinline__ unsigned compact_bound(LAS u64* buf, int n, int lane, unsigned lo, int& n_out) {
    u64 e[8]; unsigned mx = 0u;
#pragma unroll
    for (int i = 0; i < 8; ++i) { e[i] = (lane + 64 * i < n) ? buf[lane + 64 * i] : 0ull; const unsigned k = (unsigned)(e[i] >> 32); mx = k > mx ? k : mx; }
#pragma unroll
    for (int o = 1; o < 64; o <<= 1) { const unsigned t = (unsigned)__builtin_amdgcn_ds_bpermute((lane ^ o) << 2, (int)mx); mx = t > mx ? t : mx; }
    mx = (unsigned)__builtin_amdgcn_readfirstlane((int)mx);
    const unsigned diff = mx ^ lo; const int hb = diff ? 31 - __builtin_clz(diff) : 0;
    unsigned thr = hb >= 31 ? 0u : (lo & ~((2u << hb) - 1u)); int cge = n;
    for (int bit = hb; bit >= 0; --bit) {
        const unsigned cand = thr | (1u << bit); int c = 0;
#pragma unroll
        for (int i = 0; i < 8; ++i) c += __popcll(__ballot((unsigned)(e[i] >> 32) >= cand));
        if (c >= 256) { thr = cand; cge = c; if (c <= 288) break; }
    }
    int pos = 0;
#pragma unroll
    for (int i = 0; i < 8; ++i) { const bool ge = (unsigned)(e[i] >> 32) >= thr && (lane + 64 * i < n); const u64 mg = __ballot(ge);
        if (ge) buf[pos + mbcnt64(mg)] = e[i];
        pos += __popcll(mg); }
    n_out = pos;
    return thr;
}
template <bool CONV = false> __device__ __forceinline__ void topk_phase(const Frame& F, const bf16_t* QI, const bf16_t* KIF, const float* WI, unsigned short* SEL) {
    const int lane = F.lane, l31 = lane & 31, hf = lane >> 5, wave = F.wave;
    LAS u64* mybuf = (LAS u64*)F.lds + (size_t)(wave * 4) * 512;
    const unsigned lmask_lt = (1u << l31) - 1u; const int hfm = -hf;
    for (int pu = blockIdx.x; pu < 512; pu += F.G) {
        const int b = pu >> 8, pi = pu & 255;
        for (int half = 0; half < 2; ++half) {
            const int tq = half == 0 ? pi : 511 - pi, q0 = tq * 32, nsteps = tq + 1;
            const size_t trow0 = (size_t)b * SEQ + q0 + 4 * wave;
            bf16x8 aq[2][4]; float wq[2][16];
#pragma unroll
            for (int s = 0; s < 2; ++s) {
                const int qq = 2 * s + ((l31 >> 2) & 1), hd = 4 * (l31 >> 3) + (l31 & 3);
#pragma unroll
                for (int kk = 0; kk < 4; ++kk) aq[s][kk] = *(const bf16x8*)(QI + ((trow0 + qq) * 16 + hd) * 64 + 16 * kk + 8 * hf);
                const float* wp = WI + (trow0 + 2 * s + hf) * 16;
#pragma unroll
                for (int r4 = 0; r4 < 4; ++r4) { const f32x4 w = *(const f32x4*)(wp + 4 * r4); wq[s][4 * r4] = w[0]; wq[s][4 * r4 + 1] = w[1]; wq[s][4 * r4 + 2] = w[2]; wq[s][4 * r4 + 3] = w[3]; }
            }
            float psc0 = 0.f, psc1 = 0.f; int pix0 = 0, pix1 = 0; bool pv0 = false, pv1 = false;
            float thr0 = -INFINITY, thr1 = -INFINITY; int c0 = 0, c1 = 0, c2 = 0, c3 = 0; unsigned b0 = 0x007fffffu, b1 = 0x007fffffu, b2 = 0x007fffffu, b3 = 0x007fffffu;
            const bf16_t* kbase = KIF + (size_t)b * 512 * 4 * 64 * 8 + (size_t)lane * 8;
            bf16x8 k0[4], k1[4], k2[4], k3[4];
#pragma unroll
            for (int kk = 0; kk < 4; ++kk) { k0[kk] = *(const bf16x8*)(kbase + (size_t)(0 * 4 + kk) * 512); k1[kk] = *(const bf16x8*)(kbase + (size_t)((nsteps > 1 ? 1 : 0) * 4 + kk) * 512);
                k2[kk] = *(const bf16x8*)(kbase + (size_t)((nsteps > 2 ? 2 : nsteps - 1) * 4 + kk) * 512); k3[kk] = *(const bf16x8*)(kbase + (size_t)((nsteps > 3 ? 3 : nsteps - 1) * 4 + kk) * 512); }
#define TOPK_STEP(KB, STEP) { const int kidx = 32 * (STEP) + l31; \
    f32x16 a0_, a1_; _Pragma("unroll") for (int r = 0; r < 16; ++r) { a0_[r] = 0.f; a1_[r] = 0.f; } \
    _Pragma("unroll") for (int kk = 0; kk < 4; ++kk) a0_ = __builtin_amdgcn_mfma_f32_32x32x16_bf16(aq[0][kk], KB[kk], a0_, 0, 0, 0); \
    _Pragma("unroll") for (int kk = 0; kk < 4; ++kk) a1_ = __builtin_amdgcn_mfma_f32_32x32x16_bf16(aq[1][kk], KB[kk], a1_, 0, 0, 0); \
    { const int sn_ = (STEP) + 4 < nsteps ? (STEP) + 4 : nsteps - 1; _Pragma("unroll") for (int kk = 0; kk < 4; ++kk) KB[kk] = *(const bf16x8*)(kbase + (size_t)(sn_ * 4 + kk) * 512); }     \
    float sc0_ = 0.f, sc1_ = 0.f; \
    _Pragma("unroll") for (int r = 0; r < 16; ++r) sc0_ = fmaf(wq[0][r], relu1(a0_[r]), sc0_); \
    _Pragma("unroll") for (int r = 0; r < 16; ++r) sc1_ = fmaf(wq[1][r], relu1(a1_[r]), sc1_); \
    const int tql0_ = q0 + 4 * wave + hf; \
    const bool pass0_ = (sc0_ > thr0) && (kidx <= tql0_), pass1_ = (sc1_ > thr1) && (kidx <= tql0_ + 2); \
      \
    if (__ballot((pass0_ && pv0) || (pass1_ && pv1))) { TOPK_FLUSH(); } \
    psc0 = pass0_ ? sc0_ : psc0; pix0 = pass0_ ? kidx : pix0; pv0 = pv0 || pass0_; \
    psc1 = pass1_ ? sc1_ : psc1; pix1 = pass1_ ? kidx : pix1; pv1 = pv1 || pass1_; }
#define TOPK_FLUSH() { const u64 mask0_ = __ballot(pv0), mask1_ = __ballot(pv1); \
        if (mask0_) { const unsigned lo = (unsigned)mask0_, hi = (unsigned)(mask0_ >> 32); const int plo = __popc(lo), phi = __popc(hi); \
          const int rank = mbcnt64(mask0_) - (plo & hfm); const int cm = c0 + ((c1 - c0) & hfm); \
          if (pv0) mybuf[hf * 512 + cm + rank] = ((u64)f2key(psc0) << 32) | (unsigned)pix0; c0 += plo; c1 += phi; } \
        if (mask1_) { const unsigned lo = (unsigned)mask1_, hi = (unsigned)(mask1_ >> 32); const int plo = __popc(lo), phi = __popc(hi); \
          const int rank = mbcnt64(mask1_) - (plo & hfm); const int cm = c2 + ((c3 - c2) & hfm); \
          if (pv1) mybuf[(2 + hf) * 512 + cm + rank] = ((u64)f2key(psc1) << 32) | (unsigned)pix1; c2 += plo; c3 += phi; } \
        pv0 = false; pv1 = false; \
        const int cmx_ = max(max(c0, c1), max(c2, c3)); \
        if (cmx_ > 480) { \
        if (c0 > 480) { b0 = compact_bound(mybuf, c0, lane, b0, c0); const float nt = key2f(b0); thr0 = hf == 0 ? nt : thr0; } \
        if (c1 > 480) { b1 = compact_bound(mybuf + 512, c1, lane, b1, c1); const float nt = key2f(b1); thr0 = hf == 1 ? nt : thr0; } \
        if (c2 > 480) { b2 = compact_bound(mybuf + 1024, c2, lane, b2, c2); const float nt = key2f(b2); thr1 = hf == 0 ? nt : thr1; } \
        if (c3 > 480) { b3 = compact_bound(mybuf + 1536, c3, lane, b3, c3); const float nt = key2f(b3); thr1 = hf == 1 ? nt : thr1; } } }
            for (int st = 0; st < nsteps; st += 4) {
                TOPK_STEP(k0, st);
                if (st + 1 < nsteps) TOPK_STEP(k1, st + 1);
                if (st + 2 < nsteps) TOPK_STEP(k2, st + 2);
                if (st + 3 < nsteps) TOPK_STEP(k3, st + 3);
            }
            TOPK_FLUSH();
#undef TOPK_STEP
#undef TOPK_FLUSH
#pragma unroll
            for (int qi = 0; qi < 4; ++qi) {
                int c = qi == 0 ? c0 : (qi == 1 ? c1 : (qi == 2 ? c2 : c3)); LAS u64* bq = mybuf + qi * 512;
                if (c > 256) { (void)compact256(bq, c, lane); c = 256; }
                LDS_WAIT();
                unsigned short v[4];
#pragma unroll
                for (int j = 0; j < 4; ++j) { const int e = 4 * lane + j; v[j] = e < c ? (unsigned short)(bq[e] & 0xffffull) : (unsigned short)0xffff; }
                u32x2 w; w.x = (unsigned)v[0] | ((unsigned)v[1] << 16); w.y = (unsigned)v[2] | ((unsigned)v[3] << 16);
                *(u32x2*)(SEL + (trow0 + qi) * 256 + 4 * lane) = w;
            }
            LDS_WAIT();
            if constexpr (CONV) { int lane2 = F.lane; asm volatile("" : "+v"(lane2)); const int NGW = F.G * NWAVES, iter = 2 * ((pu - (int)blockIdx.x) / F.G) + half;
                typedef const unsigned char __attribute__((address_space(4))) kab_t;
                kab_t* ka = (kab_t*)__builtin_amdgcn_kernarg_segment_ptr();
                const float* w1 = *(const float* const __attribute__((address_space(4)))*)(ka + 15 * 8); const float* w3 = *(const float* const __attribute__((address_space(4)))*)(ka + 16 * 8);
                const float* w2 = *(const float* const __attribute__((address_space(4)))*)(ka + 17 * 8); unsigned char* ws = *(unsigned char* const __attribute__((address_space(4)))*)(ka + 23 * 8);
#pragma unroll 1
                for (int k = 0; k < TOPK_CONV; ++k) { const int it = F.gw + NGW * (TOPK_CONV * iter + k); if (it < MOE_CONV_ITEMS) moe_conv_item(w1, w3, w2, ws, (LAS float*)mybuf, it, lane2); } }
        }
    }
}

__device__ __forceinline__ bf16x4 tr_read16(const LAS unsigned char* p) { return __builtin_bit_cast(bf16x4, __builtin_amdgcn_ds_read_tr16_b64_v4i16((LAS bf16x4*)p)); }
__device__ __forceinline__ void dsa_attn_phase(const Frame& F, const bf16_t* QLAT, bf16_t* OUT, const bf16_t* QR, const bf16_t* KV, const unsigned short* SEL, const float* w1, const float* w3, const float* w2, unsigned char* ws) {
    LAS unsigned char* wb = F.lds + F.wave * DSA_WBUF; LAS unsigned char* tails = wb + 16640;
    const unsigned char* KVb = (const unsigned char*)KV;
    const int NGW = F.G * NWAVES;
    for (int tg = F.gw; tg < T; tg += NGW) {
        int lane = F.lane; asm volatile("" : "+v"(lane));
        const int l15 = lane & 15, g = lane >> 4;
        const int b = tg >> 14, t = tg & (SEQ - 1); const int nvalid = t + 1 < 256 ? t + 1 : 256, nsteps = (nvalid + 15) >> 4;
        bf16x8 qf[18];
#pragma unroll
        for (int kk = 0; kk < 16; ++kk) {
            if constexpr (F8_LAT) { const u32x2 w8 = *(const u32x2*)((const unsigned char*)QLAT + ((size_t)tg * 16 + l15) * 512 + 32 * kk + 8 * g);
                const f32x2 f0 = __builtin_amdgcn_cvt_pk_f32_fp8((int)w8.x, false), f1 = __builtin_amdgcn_cvt_pk_f32_fp8((int)w8.x, true), f2 = __builtin_amdgcn_cvt_pk_f32_fp8((int)w8.y, false), f3 = __builtin_amdgcn_cvt_pk_f32_fp8((int)w8.y, true);
                u32x4 wb16; wb16.x = cvt_pk_bf16(f0[0], f0[1]); wb16.y = cvt_pk_bf16(f1[0], f1[1]); wb16.z = cvt_pk_bf16(f2[0], f2[1]); wb16.w = cvt_pk_bf16(f3[0], f3[1]); qf[kk] = __builtin_bit_cast(bf16x8, wb16); }
            else qf[kk] = *(const bf16x8*)(QLAT + ((size_t)tg * 16 + l15) * 512 + 32 * kk + 8 * g); }
#pragma unroll
        for (int kk = 0; kk < 2; ++kk) qf[16 + kk] = *(const bf16x8*)(QR + ((size_t)tg * 16 + l15) * 64 + 32 * kk + 8 * g);
        float m = -INFINITY, lsum = 0.f; f32x4 O[32];
#pragma unroll
        for (int mt = 0; mt < 32; ++mt) O[mt] = (f32x4){0.f, 0.f, 0.f, 0.f};
        for (int st = 0; st < nsteps; ++st) {
            const int slot = 16 * st + l15;
            int idx = slot < nvalid ? (int)SEL[(size_t)tg * 256 + slot] : 0; idx = idx > t ? 0 : idx;
            const int row = b * SEQ + idx;
            LDS_WAIT();
#pragma unroll
            for (int r = 0; r < 16; ++r) { const int rr = __builtin_amdgcn_readlane(row, r); glds16(KVb + (size_t)rr * 1152 + 16 * lane, wb + r * 1040); }
#pragma unroll
            for (int p = 0; p < 2; ++p) glds16(KVb + (size_t)row * 1152 + 1024 + 16 * (4 * p + g), tails + 1024 * p);
            VM_WAIT();
            f32x4 sacc = (f32x4){0.f, 0.f, 0.f, 0.f};
#pragma unroll
            for (int kk = 0; kk < 16; ++kk) { const bf16x8 a = *(const LAS bf16x8*)(wb + l15 * 1040 + (4 * kk + g) * 16); sacc = __builtin_amdgcn_mfma_f32_16x16x32_bf16(a, qf[kk], sacc, 0, 0, 0); }
#pragma unroll
            for (int kk = 0; kk < 2; ++kk) { const bf16x8 a = *(const LAS bf16x8*)(tails + (4 * kk + g) * 256 + l15 * 16); sacc = __builtin_amdgcn_mfma_f32_16x16x32_bf16(a, qf[16 + kk], sacc, 0, 0, 0); }
            float s[4]; float tmax = -INFINITY;
#pragma unroll
            for (int i = 0; i < 4; ++i) { s[i] = (16 * st + 4 * g + i) < nvalid ? sacc[i] * (F8_LAT ? SCALE2_MLA / QLAT_F8SCALE : SCALE2_MLA) : -INFINITY; tmax = fmaxf(tmax, s[i]); }
            tmax = fmaxf(tmax, shx(tmax, 16, lane)); tmax = fmaxf(tmax, shx(tmax, 32, lane));
            const float mnew = fmaxf(m, tmax); const float alpha = __builtin_amdgcn_exp2f(m - mnew); m = mnew;
            float p[4];
#pragma unroll
            for (int i = 0; i < 4; ++i) p[i] = __builtin_amdgcn_exp2f(s[i] - mnew);
            lsum = lsum * alpha + ((p[0] + p[1]) + (p[2] + p[3]));
            if (__any(alpha != 1.0f)) {
#pragma unroll
                for (int mt = 0; mt < 32; ++mt) O[mt] = O[mt] * alpha;
            }
            u32x2 pw; pw.x = cvt_pk_bf16(p[0], p[1]); pw.y = cvt_pk_bf16(p[2], p[3]); const bf16x4 pb = __builtin_bit_cast(bf16x4, pw);
            const LAS unsigned char* trb = wb + (4 * g + (l15 >> 2)) * 1040 + (lane & 3) * 8;
#pragma unroll
            for (int mt = 0; mt < 32; ++mt) { const bf16x4 a = tr_read16(trb + mt * 32); O[mt] = __builtin_amdgcn_mfma_f32_16x16x16bf16_1k(a, pb, O[mt], 0, 0, 0); }
        }
        float lt = lsum + shx(lsum, 16, lane); lt += shx(lt, 32, lane); const float inv = 1.0f / lt;
        if constexpr (F8_LAT) { unsigned char* op8 = (unsigned char*)OUT + ((size_t)tg * 16 + l15) * 512 + 4 * g; const float inv8 = inv * OLAT_F8SCALE;
#pragma unroll
            for (int mt = 0; mt < 32; ++mt) *(unsigned*)(op8 + 16 * mt) = pk4_fp8(O[mt][0] * inv8, O[mt][1] * inv8, O[mt][2] * inv8, O[mt][3] * inv8); }
        else { bf16_t* op = OUT + ((size_t)tg * 16 + l15) * 512 + 4 * g;
#pragma unroll
        for (int mt = 0; mt < 32; ++mt) { u32x2 w; w.x = cvt_pk_bf16(O[mt][0] * inv, O[mt][1] * inv); w.y = cvt_pk_bf16(O[mt][2] * inv, O[mt][3] * inv); *(u32x2*)(op + 16 * mt) = w; } }
        if (w1) { LDS_WAIT(); int lane2 = F.lane; asm volatile("" : "+v"(lane2));
            for (int k = 0; k < 3; ++k) { const int it = F.gw + NGW * (3 * ((tg - F.gw) / NGW) + k); if (it < MOE_CONV_ITEMS) moe_conv_item(w1, w3, w2, ws, (LAS float*)wb, it, lane2); } }
    }
    LDS_WAIT();
}

__device__ __forceinline__ long tr_read8(const LAS unsigned char* p) { return __builtin_bit_cast(long, __builtin_amdgcn_ds_read_tr8_b64_v2i32((LAS i32x2*)p)); }
__device__ __forceinline__ void dsa_attn8_phase(const Frame& F, const unsigned char* QLAT, unsigned char* OUT, const unsigned char* QR, const unsigned char* KVb, const unsigned short* SEL, const float* w1, const float* w3, const float* w2, unsigned char* ws) {
    LAS unsigned char* wb = F.lds + F.wave * DSA_WBUF; LAS unsigned char* tails = wb + 16640;
    const int NGW = F.G * NWAVES;
    for (int tg = F.gw; tg < T; tg += NGW) {
        int lane = F.lane; asm volatile("" : "+v"(lane));
        const int l15 = lane & 15, g = lane >> 4;
        const int b = tg >> 14, t = tg & (SEQ - 1); const int nvalid = t + 1 < 256 ? t + 1 : 256, nsteps = (nvalid + 31) >> 5;
        i32x8 qf[5];
        { const unsigned char* qp = QLAT + ((size_t)tg * 16 + l15) * 512 + 32 * g;
#pragma unroll
          for (int kk = 0; kk < 4; ++kk) { const i32x4 lo = *(const i32x4*)(qp + 128 * kk), hi = *(const i32x4*)(qp + 128 * kk + 16); qf[kk] = (i32x8){lo[0], lo[1], lo[2], lo[3], hi[0], hi[1], hi[2], hi[3]}; }
          const i32x4 r = *(const i32x4*)(QR + ((size_t)tg * 16 + l15) * 64 + 16 * g); qf[4] = (i32x8){r[0], r[1], r[2], r[3], 0, 0, 0, 0}; }
        float m = -INFINITY, lsum = 0.f; f32x4 O[32];
#pragma unroll
        for (int mt = 0; mt < 32; ++mt) O[mt] = (f32x4){0.f, 0.f, 0.f, 0.f};
        const int dtau = (lane >> 2) & 1, dch = 16 * (4 * (lane >> 3) + (lane & 3));
        int s0, s1, s2, s3, s4, s5, s6, s7;
        { const unsigned short* sp = SEL + (size_t)tg * 256 + (lane & 31); const int l31 = lane & 31;
          s0 = l31 < nvalid ? (int)sp[0] : 0; s1 = 32 + l31 < nvalid ? (int)sp[32] : 0; s2 = 64 + l31 < nvalid ? (int)sp[64] : 0; s3 = 96 + l31 < nvalid ? (int)sp[96] : 0;
          s4 = 128 + l31 < nvalid ? (int)sp[128] : 0; s5 = 160 + l31 < nvalid ? (int)sp[160] : 0; s6 = 192 + l31 < nvalid ? (int)sp[192] : 0; s7 = 224 + l31 < nvalid ? (int)sp[224] : 0; }
        for (int st = 0; st < nsteps; ++st) {
            int idx = s0; s0 = s1; s1 = s2; s2 = s3; s3 = s4; s4 = s5; s5 = s6; s6 = s7; idx = idx > t ? 0 : idx;
            const int row = b * SEQ + idx;
            LDS_WAIT();
#pragma unroll
            for (int p = 0; p < 16; ++p) { const int r0 = __builtin_amdgcn_readlane(row, p), r1 = __builtin_amdgcn_readlane(row, 16 + p); const int rr = dtau ? r1 : r0;
                glds16(KVb + (size_t)rr * 576 + dch, wb + p * 1040); }
#pragma unroll
            for (int p = 0; p < 2; ++p) glds16(KVb + (size_t)row * 576 + 512 + 16 * (2 * p + (lane >> 5)), tails + 1024 * p);
            VM_WAIT();
            f32x4 sacc[2] = {(f32x4){0.f, 0.f, 0.f, 0.f}, (f32x4){0.f, 0.f, 0.f, 0.f}};
            const LAS unsigned char* sb = wb + l15 * 1040 + 16 * (8 * (g >> 1) + 2 * (g & 1));
#pragma unroll
            for (int kk = 0; kk < 4; ++kk)
#pragma unroll
                for (int tu = 0; tu < 2; ++tu) { const i32x4 lo = *(const LAS i32x4*)(sb + 256 * kk + 64 * tu), hi = *(const LAS i32x4*)(sb + 256 * kk + 64 * tu + 16);
                    const i32x8 a = (i32x8){lo[0], lo[1], lo[2], lo[3], hi[0], hi[1], hi[2], hi[3]};
                    sacc[tu] = __builtin_amdgcn_mfma_scale_f32_16x16x128_f8f6f4(a, qf[kk], sacc[tu], 0, 0, 0, 0, 0, 0); }
#pragma unroll
            for (int tu = 0; tu < 2; ++tu) { const i32x4 lo = *(const LAS i32x4*)(tails + (g * 32 + 16 * tu + l15) * 16);
                const i32x8 a = (i32x8){lo[0], lo[1], lo[2], lo[3], 0, 0, 0, 0};
                sacc[tu] = __builtin_amdgcn_mfma_scale_f32_16x16x128_f8f6f4(a, qf[4], sacc[tu], 0, 0, 0, 0, 0, 0); }
            float s[8]; float tmax = -INFINITY;
#pragma unroll
            for (int tu = 0; tu < 2; ++tu)
#pragma unroll
                for (int i = 0; i < 4; ++i) { s[4 * tu + i] = (32 * st + 16 * tu + 4 * g + i) < nvalid ? sacc[tu][i] * (SCALE2_MLA / (QLAT_F8SCALE * KV_F8SCALE)) : -INFINITY; tmax = fmaxf(tmax, s[4 * tu + i]); }
            tmax = fmaxf(tmax, shx(tmax, 16, lane)); tmax = fmaxf(tmax, shx(tmax, 32, lane));
            if (__any(tmax > m + 0.75f)) {
                const float mnew = fmaxf(m, tmax); const float alpha = __builtin_amdgcn_exp2f(m - mnew); m = mnew; lsum *= alpha;
#pragma unroll
                for (int mt = 0; mt < 32; ++mt) O[mt] = O[mt] * alpha;
            }
            const float mo = m - 8.0f;
            float p[8];
#pragma unroll
            for (int i = 0; i < 8; ++i) p[i] = __builtin_amdgcn_exp2f(s[i] - mo);
            lsum += (((p[0] + p[1]) + (p[2] + p[3])) + ((p[4] + p[5]) + (p[6] + p[7])));
            u32x2 pw; pw.x = pk4_fp8(p[0], p[1], p[2], p[3]); pw.y = pk4_fp8(p[4], p[5], p[6], p[7]); const long pb = __builtin_bit_cast(long, pw);
            const LAS unsigned char* trb = wb + (4 * g + ((l15 >> 1) & 3)) * 1040 + 64 * (l15 >> 3) + 8 * (l15 & 1);
#pragma unroll
            for (int mt = 0; mt < 32; ++mt) { const long a = tr_read8(trb + 128 * (mt >> 2) + 16 * (mt & 3)); O[mt] = __builtin_amdgcn_mfma_f32_16x16x32_fp8_fp8(a, pb, O[mt], 0, 0, 0); }
        }
        float lt = lsum + shx(lsum, 16, lane); lt += shx(lt, 32, lane); const float inv8 = (OLAT_F8SCALE / KV_F8SCALE) / lt;
        unsigned char* op8 = OUT + ((size_t)tg * 16 + l15) * 512 + 4 * g;
#pragma unroll
        for (int mt = 0; mt < 32; ++mt) *(unsigned*)(op8 + 16 * mt) = pk4_fp8(O[mt][0] * inv8, O[mt][1] * inv8, O[mt][2] * inv8, O[mt][3] * inv8);
        if (w1) { LDS_WAIT(); int lane2 = F.lane; asm volatile("" : "+v"(lane2));
            for (int k = 0; k < 3; ++k) { const int it = F.gw + NGW * (3 * ((tg - F.gw) / NGW) + k); if (it < MOE_CONV_ITEMS) moe_conv_item(w1, w3, w2, ws, (LAS float*)wb, it, lane2); } }
    }
    LDS_WAIT();
}

__device__ __forceinline__ void ln_router_phase(const Frame& F, const bf16_t* YH, bf16_t* XB, const float* g, const float* bb, const float* wr, int* TOKE, float* TOKG, int* TOKL) {
    LAS float* wl = (LAS float*)F.lds;
    for (int i = F.tid; i < DM * NEXP; i += NTHREADS) { const int d = i >> 3, e = i & 7; wl[e * DM + d] = wr[i]; }
    __syncthreads();
    const int NGW = F.G * NWAVES, lane = F.lane;
    u64 cnt64 = 0ull; int mine = 0;
    int j = 0;
    for (int m = F.gw; m < T; m += NGW, ++j) { f32x4 v[8];
        ln_load16(v, YH + (size_t)m * DM, lane); ln_core(v, g, bb, lane); ln_store8(v, (unsigned char*)XB + (size_t)m * DM, lane);
        float lg[8];
#pragma unroll
        for (int e = 0; e < 8; ++e) { float s = 0.f;
#pragma unroll
            for (int q = 0; q < 8; ++q) { const f32x4 w = *(const LAS f32x4*)(wl + e * DM + ln_col(lane, q)); s += (v[q][0] * w[0] + v[q][1] * w[1]) + (v[q][2] * w[2] + v[q][3] * w[3]); }
            lg[e] = wave_sum(s); }
        int e1 = 0; float v1 = lg[0];
#pragma unroll
        for (int e = 1; e < 8; ++e) if (lg[e] > v1) { v1 = lg[e]; e1 = e; }
        int e2 = -1; float v2 = -INFINITY;
#pragma unroll
        for (int e = 0; e < 8; ++e) if (e != e1 && lg[e] > v2) { v2 = lg[e]; e2 = e; }
        const float g1 = 1.0f / (1.0f + __expf(v2 - v1)), g2 = 1.0f - g1;
        const int r1 = (int)((cnt64 >> (8 * e1)) & 0xffull); cnt64 += 1ull << (8 * e1);
        const int r2 = (int)((cnt64 >> (8 * e2)) & 0xffull); cnt64 += 1ull << (8 * e2);
        if (lane == 0) { TOKE[2 * m] = e1; TOKE[2 * m + 1] = e2; TOKG[2 * m] = g1; TOKG[2 * m + 1] = g2; }
        if (lane == j) mine = e1 | (e2 << 4) | (r1 << 8) | (r2 << 16);
    }
    int basev = 0;
    if (lane < 8) { const unsigned c = (unsigned)((cnt64 >> (8 * lane)) & 0xffull); basev = (int)__hip_atomic_fetch_add(F.ctl + CW_CNT + lane, c, __ATOMIC_RELAXED, __HIP_MEMORY_SCOPE_AGENT); }
    const int e1 = mine & 15, e2 = (mine >> 4) & 15, r1 = (mine >> 8) & 255, r2 = (mine >> 16) & 255;
    const int b1 = __builtin_amdgcn_ds_bpermute(e1 << 2, basev), b2 = __builtin_amdgcn_ds_bpermute(e2 << 2, basev);
    if (lane < j) { const int m = F.gw + NGW * lane; TOKL[2 * m] = b1 + r1; TOKL[2 * m + 1] = b2 + r2; }
    __syncthreads();
}
__device__ __forceinline__ void moe_tiles(const Frame& F) {
    if (F.tid == 0) { int acc = 0;
        for (int e = 0; e < 8; ++e) { const unsigned c = __hip_atomic_load(F.ctl + CW_CNT + e, __ATOMIC_RELAXED, __HIP_MEMORY_SCOPE_AGENT); F.MISC[32 + e] = c; F.MISC[40 + e] = (unsigned)acc; acc += (int)((c + 255u) >> 8); F.MISC[20 + e] = (unsigned)acc; }
        F.MISC[28] = (unsigned)acc; }
    __syncthreads();
}
__device__ __forceinline__ void moe_gather_phase(const Frame& F, const bf16_t* XB, const int* TOKE, const float* TOKG, const int* TOKL, int* TOKS, float* SGATE, bf16_t* XG) {
    const int NGW = F.G * NWAVES, lane = F.lane;
    for (int m = F.gw; m < T; m += NGW) {
        const u32x4* src = (const u32x4*)((const unsigned char*)XB + (size_t)m * DM);
        const u32x4 a0 = src[lane], a1 = src[64 + lane];
#pragma unroll
        for (int k = 0; k < 2; ++k) { const int e = TOKE[2 * m + k], li = TOKL[2 * m + k]; const int slot = (int)F.MISC[40 + e] * 256 + li;
            u32x4* dst = (u32x4*)((unsigned char*)XG + (size_t)slot * DM); dst[lane] = a0; dst[64 + lane] = a1;
            if (lane == 0) { TOKS[2 * m + k] = slot; SGATE[slot] = TOKG[2 * m + k]; } }
    }
    for (int it = F.gw; it < 8 * 256; it += NGW) { const int e = it >> 8, r = it & 255; const int c = (int)F.MISC[32 + e]; const int ntile = (c + 255) >> 8; const int row = c + r;
        if (row < ntile * 256) { const int slot = (int)F.MISC[40 + e] * 256 + row; u32x4* dst = (u32x4*)((unsigned char*)XG + (size_t)slot * DM); const u32x4 z = {0u, 0u, 0u, 0u};
            dst[lane] = z; dst[64 + lane] = z; if (lane == 0) SGATE[slot] = 0.f; } }
}
__device__ __forceinline__ void moe_combine_ln_phase(const Frame& F, const bf16_t* YH, bf16_t* XB, unsigned char* X8, const bf16_t* SOUT, const int* TOKS, const float* g1, const float* bb1, const float* g, const float* bb) {
    const int NGW = F.G * NWAVES, lane = F.lane;
    for (int m = F.gw; m < T; m += NGW) { f32x4 v[8];
        const int t0 = __builtin_amdgcn_readfirstlane(TOKS[2 * m]), t1 = __builtin_amdgcn_readfirstlane(TOKS[2 * m + 1]);
        const bf16_t* s0 = SOUT + (size_t)t0 * DM; const bf16_t* s1 = SOUT + (size_t)t1 * DM;
        ln_load16(v, YH + (size_t)m * DM, lane);
        ln_core(v, g1, bb1, lane);
#pragma unroll
        for (int j = 0; j < 4; ++j) { f32x4 a0, a1, c0, c1; pg8::unpack8(*(const u32x4*)(s0 + ln_col(lane, 2 * j)), a0, a1); pg8::unpack8(*(const u32x4*)(s1 + ln_col(lane, 2 * j)), c0, c1);
            v[2 * j] = v[2 * j] * ALPHA + (a0 + c0); v[2 * j + 1] = v[2 * j + 1] * ALPHA + (a1 + c1); }
        ln_core(v, g, bb, lane); ln_store16(v, XB + (size_t)m * DM, lane); if constexpr (F8_G1) { int ls = lane; asm volatile("" : "+v"(ls)); ln_store8(v, X8 + (size_t)m * DM, ls); } }
}

#ifndef PHASES
#define PHASES 0xFFFFFFFFu
#endif
#define PH(k) if constexpr ((PHASES >> (k)) & 1u)
#ifndef DBL
#define DBL 0u
#endif
#define DB(k) if constexpr ((DBL >> (k)) & 1u)
__global__ void __launch_bounds__(NTHREADS, 2) mega_fwd(Args args) {
    extern __shared__ __attribute__((aligned(16))) unsigned char lds_raw[];
    Frame F;
    F.lds = (LAS unsigned char*)lds_raw; F.MISC = (volatile LAS unsigned*)(F.lds + MISC_OFF);
    F.tid = threadIdx.x; F.lane = F.tid & 63; F.wave = __builtin_amdgcn_readfirstlane(F.tid >> 6); F.gw = blockIdx.x * NWAVES + F.wave;
    unsigned char* ws = args.ws;
    F.ctl = (unsigned*)(ws + WS_CTL);
    if (F.tid < 64) F.MISC[F.tid] = 0u;
    __syncthreads();
    XcdBarrier bar = xcd_barrier_post(F.ctl + CW_BAR, F.MISC + 8);
#define REFRESH() do { F.lane = fresh_lane(); F.tid = F.wave * 64 + F.lane; } while (0)
#define GRID_BAR() do { xcd_barrier(bar, F.wave); REFRESH(); } while (0)
#define YH ((bf16_t*)args.out)
#define bx ((int)blockIdx.x)
#define WSP(T_, off) ((T_*)(ws + (off)))

    PH(0) {
        { LAS float* scr = (LAS float*)(F.lds + F.wave * 16384);
          constexpr int I_QKV = 32 * 40, I_SQ = 32 * 32, I_W13 = 32 * 88, I_W2 = 88 * 32, I_WP = 4 * 32, I_WIN = 32 * 75, I_WUV = 256;
          constexpr int I_TOTAL = I_QKV + I_SQ + 2 * I_W13 + I_W2 + 2 * I_SQ + 2 * I_WP + (F8_WIN_SPLIT ? 2 : 1) * I_WIN + I_SQ + I_WUV;
          for (int it = F.gw; it < I_TOTAL; it += F.G * NWAVES) {
              int r = it; bool hit = false; const float* W = nullptr; int N = 0, ldo = 0, kofs = 0, mode = 0, rlo = 0, rhi = 1 << 30; unsigned char* WT = nullptr; float f8 = 0.f;
#define PSEG(cnt, Wp, Nn, WTp, ld, md, f8v, lo, hi) if (!hit) { if (r < (cnt)) { W = (Wp); N = (Nn); WT = (unsigned char*)(WTp); ldo = (ld); mode = (md); f8 = (f8v); rlo = (lo); rhi = (hi); hit = true; } else r -= (cnt); }
              PSEG(I_QKV, (const float*)args.in[3], NQKV, ws + WS_WQKV, DM, 1, F8_QKV ? WQKV_F8SCALE : 0.f, 0, 1 << 30)
              PSEG(I_SQ, (const float*)args.in[5], DM, ws + WS_WO0, DM, 0, F8_WO0 ? WO_F8SCALE : 0.f, 0, 1 << 30)
              PSEG(I_W13, (const float*)args.in[6], FFN, ws + WS_W13, DM, 2, F8_FFN1 ? W13_F8SCALE : 0.f, 0, 1 << 30)
              PSEG(I_W13, (const float*)args.in[7], FFN, ws + WS_W13, DM, 3, F8_FFN1 ? W13_F8SCALE : 0.f, 0, 1 << 30)
              PSEG(I_W2, (const float*)args.in[8], DM, ws + WS_W2, FFN, 0, F8_FFN2 ? W2_F8SCALE : 0.f, 0, 1 << 30)
              PSEG(I_SQ, (const float*)args.in[21], DM, ws + WS_WG0, DM, 0, F8_G0 ? WO_F8SCALE : 0.f, 0, 1 << 30)
              PSEG(I_SQ, (const float*)args.in[21] + (size_t)DM * DM, DM, ws + WS_WG1, DM, 0, F8_G1 ? WO_F8SCALE : 0.f, 0, 1 << 30)
              PSEG(I_WP, (const float*)args.in[20], DM, ws + WS_WP0, 256, 0, 0.f, 0, 1 << 30)
              PSEG(I_WP, (const float*)args.in[20] + (size_t)256 * DM, DM, ws + WS_WP1, 256, 0, 0.f, 0, 1 << 30)
              if constexpr (F8_WIN_SPLIT) { PSEG(I_WIN, (const float*)args.in[9], 4752, ws + WS_WIN8, DM, 4, WIN_F8SCALE, 0, WIN_F8_TILES * 256)
                                            PSEG(I_WIN, (const float*)args.in[9], 4752, ws + WS_WIN, DM, 4, 0.f, WIN_F8_TILES * 256, NWIN) }
              else { PSEG(I_WIN, (const float*)args.in[9], 4752, ws + WS_WIN, DM, 4, F8_WIN ? WIN_F8SCALE : 0.f, 0, 1 << 30) }
              PSEG(I_SQ, (const float*)args.in[13], DM, ws + WS_WO1, DM, 0, F8_WO1 ? WO_F8SCALE : 0.f, 0, 1 << 30)
              if (!hit) { const int h = r >> 4; r &= 15;
                  W = (const float*)args.in[12] + (size_t)h * 512 * 128; N = 128; WT = ws + WS_WUV + (size_t)h * 128 * 1024 * (F8_LAT ? 1 : 2); ldo = 1024; kofs = 512 * (h & 1); f8 = F8_LAT ? WUV_F8SCALE : 0.f; }
#undef PSEG
              tr_item(W, N, (bf16_t*)WT, ldo, kofs, mode, scr, r, F.lane, f8, rlo, rhi); } }
        { bf16_t* wuv = WSP(bf16_t, WS_WUV); const u32x4 z = {0u, 0u, 0u, 0u};
          for (int i = bx * NTHREADS + F.tid; i < 2048 * 64; i += F.G * NTHREADS) { const int n = i >> 6, c8 = i & 63; const int h = n >> 7;
              if constexpr (F8_LAT) { if (c8 < 32) *(u32x4*)((unsigned char*)wuv + (size_t)n * 1024 + 512 * ((h & 1) ^ 1) + 16 * c8) = z; }
              else *(u32x4*)(wuv + (size_t)n * 1024 + 512 * ((h & 1) ^ 1) + 8 * c8) = z; } }
        cvt_linear(F, (const float*)args.in[11], WSP(bf16_t, WS_WUK), (size_t)16 * 512 * 128 / 8);
        if constexpr (F8_QKV) cvt_linear8(F, (const float*)args.in[0], WSP(unsigned char, WS_XBA), (size_t)T * DM / 8); else cvt_linear(F, (const float*)args.in[0], WSP(bf16_t, WS_XBA), (size_t)T * DM / 8);
        cvt_linear(F, (const float*)args.in[1], WSP(bf16_t, WS_PB), (size_t)2 * T * 256 / 8);
        rope_tables(F, (const int*)args.in[2], WSP(float, WS_TAB64), WSP(float, WS_TAB32));
    }
    GRID_BAR();
    PH(1) {
        constexpr int KD = F8_QKV ? DM / 2 : DM;
        pg8::Gemm g{WSP(bf16_t, WS_XBA), WSP(bf16_t, WS_WQKV), KD, KD, KD}; pg8::GridOrder<0, T / 256, NQKV / 256> S;
        pg8::EpiQKV E{ws, F8_QKV ? 1.0f / WQKV_F8SCALE : 1.0f}; pg8::gemm_phase<pg8::EpiQKV, pg8::GridOrder<0, T / 256, NQKV / 256>, F8_QKV>(F.lds, g, S, E, F.wave);
    }
    GRID_BAR();
    PH(2) swa_phase<F8_WO0>(F, WSP(bf16_t, WS_Q), WSP(bf16_t, WS_K), WSP(bf16_t, WS_VT), (const float*)args.in[4], WSP(unsigned char, WS_O8));
    GRID_BAR();
    PH(3) {
        constexpr int KD = F8_WO0 ? DM / 2 : DM;
        pg8::Gemm g{F8_WO0 ? WSP(bf16_t, WS_O8) : WSP(bf16_t, WS_Q), WSP(bf16_t, WS_WO0), KD, KD, KD}; pg8::GridOrder<0, T / 256, DM / 256> S;
        pg8::EpiRes<false> E{args.in[0], YH, F8_WO0 ? 1.0f / (O0_F8SCALE * WO_F8SCALE) : 1.0f}; pg8::gemm_phase<pg8::EpiRes<false>, pg8::GridOrder<0, T / 256, DM / 256>, F8_WO0, EPI_ALIGN_RES>(F.lds, g, S, E, F.wave);
    }
    GRID_BAR();
    PH(4) ln_phase<F8_FFN1>(F, YH, WSP(bf16_t, WS_XBB), WSP(unsigned char, WS_XBA), (const float*)args.in[18], (const float*)args.in[19]);
    GRID_BAR();
    PH(5) {
        constexpr int KD = F8_FFN1 ? DM / 2 : DM;
        pg8::Gemm g{F8_FFN1 ? WSP(bf16_t, WS_XBA) : WSP(bf16_t, WS_XBB), WSP(bf16_t, WS_W13), KD, KD, KD}; pg8::GridOrder<0, T / 256, 2 * FFN / 256> S;
        pg8::EpiSwiglu<F8_FFN2> E{WSP(bf16_t, WS_ACT), FFN, F8_FFN1 ? 1.0f / W13_F8SCALE : 1.0f, ACT_F8SCALE}; pg8::gemm_phase<pg8::EpiSwiglu<F8_FFN2>, pg8::GridOrder<0, T / 256, 2 * FFN / 256>, F8_FFN1>(F.lds, g, S, E, F.wave);
    }
    GRID_BAR();
    PH(6) {
        constexpr int KD = F8_FFN2 ? FFN / 2 : FFN;
        pg8::Gemm g{WSP(bf16_t, WS_ACT), WSP(bf16_t, WS_W2), KD, KD, KD}; pg8::GridOrder<0, T / 256, DM / 256> S;
        pg8::EpiRes<true> E{WSP(bf16_t, WS_XBB), YH, F8_FFN2 ? 1.0f / (ACT_F8SCALE * W2_F8SCALE) : 1.0f}; pg8::gemm_phase<pg8::EpiRes<true>, pg8::GridOrder<0, T / 256, DM / 256>, F8_FFN2, EPI_ALIGN_RES>(F.lds, g, S, E, F.wave);
    }
    GRID_BAR();
    PH(7) ln_phase<F8_G0>(F, YH, WSP(bf16_t, WS_XBA), F8_G0 ? WSP(unsigned char, WS_X28) : nullptr, (const float*)args.in[18] + DM, (const float*)args.in[19] + DM);
    REFRESH();
    PH(7) {
        pg8::Gemm g{WSP(bf16_t, WS_PB), WSP(bf16_t, WS_WP0), 256, 256, 256}; pg8::GridOrder<0, T / 256, DM / 256> S;
        pg8::EpiBf16<false> E{WSP(bf16_t, WS_PP0), DM, 1.0f}; pg8::gemm_phase(F.lds, g, S, E, F.wave);
    }
    GRID_BAR();
    PH(8) {
        constexpr int K2 = F8_G0 ? DM / 2 : DM;
        pg8::Gemm g{F8_G0 ? WSP(bf16_t, WS_X28) : WSP(bf16_t, WS_XBA), WSP(bf16_t, WS_WG0), K2, K2, K2}; pg8::GridOrder<0, T / 256, DM / 256> S;
        pg8::EpiPle E{nullptr, ws, 0, F8_G0 ? -LOG2E / WO_F8SCALE : -LOG2E}; pg8::gemm_phase<pg8::EpiPle, pg8::GridOrder<0, T / 256, DM / 256>, F8_G0, EPI_ALIGN_RES>(F.lds, g, S, E, F.wave);
    }
    GRID_BAR();
    PH(9) {
        if constexpr (F8_WIN_SPLIT) {
            { static_assert((T / 256) * WIN_F8_TILES == 7 * pg8::GRID && (T / 256) * (NWIN / 256 - WIN_F8_TILES) == 5 * pg8::GRID / 2, "uneven deal: 7 rounds of e4m3 units, 2.5 rounds of bf16 units");
              pg8::Gemm g{WSP(bf16_t, WS_XB8), WSP(bf16_t, WS_WIN8), DM / 2, DM / 2, DM / 2}; pg8::GridOrder<4, T / 256, WIN_F8_TILES> S;
              pg8::EpiWin E{ws, 1.0f / WIN_F8SCALE, 0}; pg8::gemm_phase<pg8::EpiWin, pg8::GridOrder<4, T / 256, WIN_F8_TILES>, true>(F.lds, g, S, E, F.wave); }
            REFRESH();
            { pg8::Gemm g{WSP(bf16_t, WS_XBB), WSP(bf16_t, WS_WIN) + (size_t)WIN_F8_TILES * 256 * DM, DM, DM, DM}; pg8::GridOrder<0, T / 256, NWIN / 256 - WIN_F8_TILES> S;
              pg8::EpiWin E{ws, 1.0f, WIN_F8_TILES}; pg8::gemm_phase<pg8::EpiWin, pg8::GridOrder<0, T / 256, NWIN / 256 - WIN_F8_TILES>, false>(F.lds, g, S, E, F.wave); }
        } else {
        constexpr int KD = F8_WIN ? DM / 2 : DM;
        pg8::Gemm g{WSP(bf16_t, WS_XBB), WSP(bf16_t, WS_WIN), KD, KD, KD}; pg8::GridOrder<0, T / 256, NWIN / 256> S;
        pg8::EpiWin E{ws, F8_WIN ? 1.0f / WIN_F8SCALE : 1.0f, 0}; pg8::gemm_phase<pg8::EpiWin, pg8::GridOrder<0, T / 256, NWIN / 256>, F8_WIN>(F.lds, g, S, E, F.wave);
        }
    }
    GRID_BAR();
    PH(10) kvnorm_phase(F, WSP(float, WS_CRAW), (const float*)args.in[10], WSP(bf16_t, WS_KV));
    REFRESH();
    PH(11) {
        pg8::Gemm g{WSP(bf16_t, WS_QN), WSP(bf16_t, WS_WUK), DM, 128, 128}; pg8::GridOrder<1, T / 256, 8192 / 256> S;
        pg8::EpiBf16<F8_LAT> E{WSP(bf16_t, WS_QLAT), 8192, F8_LAT ? QLAT_F8SCALE : 1.0f}; pg8::gemm_phase(F.lds, g, S, E, F.wave);
    }
    REFRESH();
    DB(12) { topk_phase(F, WSP(bf16_t, WS_QI), WSP(bf16_t, WS_KIF), WSP(float, WS_WI), WSP(unsigned short, WS_SEL)); REFRESH(); }
    PH(12) topk_phase<true>(F, WSP(bf16_t, WS_QI), WSP(bf16_t, WS_KIF), WSP(float, WS_WI), WSP(unsigned short, WS_SEL));
    GRID_BAR();
    PH(13) { if constexpr (F8_KV && F8_LAT) dsa_attn8_phase(F, WSP(unsigned char, WS_QLAT), WSP(unsigned char, WS_QLAT), WSP(unsigned char, WS_QR), WSP(unsigned char, WS_KV), WSP(unsigned short, WS_SEL), nullptr, nullptr, nullptr, ws);
             else dsa_attn_phase(F, WSP(bf16_t, WS_QLAT), WSP(bf16_t, WS_QLAT), WSP(bf16_t, WS_QR), WSP(bf16_t, WS_KV), WSP(unsigned short, WS_SEL), (const float*)args.in[15], (const float*)args.in[16], (const float*)args.in[17], ws); }
    GRID_BAR();
    PH(14) {
        constexpr float dsc = F8_LAT ? 1.0f / (OLAT_F8SCALE * WUV_F8SCALE) : 1.0f;
        pg8::Gemm g{WSP(bf16_t, WS_QLAT), WSP(bf16_t, WS_WUV), F8_LAT ? 4096 : 8192, F8_LAT ? 512 : 1024, F8_LAT ? 512 : 1024}; pg8::GridOrder<F8_LAT ? 3 : 2, T / 256, DM / 256> S;
        pg8::EpiBf16<F8_WO1> E{WSP(bf16_t, WS_O2), DM, (F8_WO1 ? O2_F8SCALE : 1.0f) * dsc}; pg8::gemm_phase<pg8::EpiBf16<F8_WO1>, pg8::GridOrder<F8_LAT ? 3 : 2, T / 256, DM / 256>, F8_LAT>(F.lds, g, S, E, F.wave);
    }
    GRID_BAR();
    PH(15) {
        constexpr int KD = F8_WO1 ? DM / 2 : DM;
        pg8::Gemm g{WSP(bf16_t, WS_O2), WSP(bf16_t, WS_WO1), KD, KD, KD}; pg8::GridOrder<0, T / 256, DM / 256> S;
        pg8::EpiRes<true> E{WSP(bf16_t, WS_XBB), YH, F8_WO1 ? 1.0f / (O2_F8SCALE * WO_F8SCALE) : 1.0f}; pg8::gemm_phase<pg8::EpiRes<true>, pg8::GridOrder<0, T / 256, DM / 256>, F8_WO1, EPI_ALIGN_RES>(F.lds, g, S, E, F.wave);
    }
    GRID_BAR();
    PH(16) ln_router_phase(F, YH, WSP(bf16_t, WS_XBA), (const float*)args.in[18] + 2 * DM, (const float*)args.in[19] + 2 * DM, (const float*)args.in[14], WSP(int, WS_TOKE), WSP(float, WS_TOKG), WSP(int, WS_TOKL));
    REFRESH();
    GRID_BAR();
    PH(18) moe_tiles(F);
    REFRESH();
    PH(18) moe_gather_phase(F, WSP(bf16_t, WS_XBA), WSP(int, WS_TOKE), WSP(float, WS_TOKG), WSP(int, WS_TOKL), WSP(int, WS_TOKS), WSP(float, WS_SGATE), WSP(bf16_t, WS_XG));
    GRID_BAR();
    PH(19) {
        const int NTL = __builtin_amdgcn_readfirstlane((int)F.MISC[28]);
        {
            pg8::MoeOrder<false, 2 * MFFN / 256> S; S.tile0 = 0; S.ntl = NTL;
            pg8::Gemm g{WSP(bf16_t, WS_XG), WSP(bf16_t, WS_MW13), DM / 2, DM / 2, DM / 2};
            pg8::EpiSwiglu<true> E{WSP(bf16_t, WS_ACT2), MFFN, 1.0f / W13_F8SCALE, ACT_F8SCALE}; pg8::gemm_phase<pg8::EpiSwiglu<true>, pg8::MoeOrder<false, 2 * MFFN / 256>, true>(F.lds, g, S, E, F.wave);
        }
        GRID_BAR();
        {
            pg8::MoeOrder<true, DM / 256> S; S.tile0 = 0; S.ntl = NTL;
            pg8::Gemm g{WSP(bf16_t, WS_ACT2), WSP(bf16_t, WS_MW2), MFFN / 2, MFFN / 2, MFFN / 2};
            pg8::EpiMoeDown E{ws}; pg8::gemm_phase<pg8::EpiMoeDown, pg8::MoeOrder<true, DM / 256>, true>(F.lds, g, S, E, F.wave);
        }
        REFRESH();
        {
            pg8::GridOrderSkip<T / 256, DM / 256> S; S.skip = (NTL * (DM / 256)) % pg8::GRID;
            pg8::Gemm g{WSP(bf16_t, WS_PB) + (size_t)T * 256, WSP(bf16_t, WS_WP1), 256, 256, 256};
            pg8::EpiBf16<false> E{WSP(bf16_t, WS_PP1), DM, 1.0f}; pg8::gemm_phase(F.lds, g, S, E, F.wave);
        }
        GRID_BAR();
    }
    PH(20) moe_combine_ln_phase(F, YH, WSP(bf16_t, WS_XBB), WSP(unsigned char, WS_X58), WSP(bf16_t, WS_SOUT), WSP(int, WS_TOKS), (const float*)args.in[18] + 2 * DM, (const float*)args.in[19] + 2 * DM, (const float*)args.in[18] + 3 * DM, (const float*)args.in[19] + 3 * DM);
    GRID_BAR();
    PH(21) {
        constexpr int K2 = F8_G1 ? DM / 2 : DM;
        pg8::Gemm g{F8_G1 ? WSP(bf16_t, WS_X58) : WSP(bf16_t, WS_XBB), WSP(bf16_t, WS_WG1), K2, K2, K2}; pg8::GridOrder<0, T / 256, DM / 256> S;
        pg8::EpiPle E{args.out, ws, 1, F8_G1 ? -LOG2E / WO_F8SCALE : -LOG2E}; pg8::gemm_phase<pg8::EpiPle, pg8::GridOrder<0, T / 256, DM / 256>, F8_G1, EPI_ALIGN_RES>(F.lds, g, S, E, F.wave);
    }
}

#undef YH
#undef bx
extern "C" void kernel_launch(void* const* d_in, const int* in_sizes, int n_in, void* d_out, int out_size, void* d_ws, size_t ws_size, hipStream_t stream) {
    static int grid = 0;
    if (grid == 0) {
        if (n_in != 22 || out_size != T * DM || ws_size < WS_END) { fprintf(stderr, "kernel_launch: unexpected problem (n_in %d, out %d, ws %zu < %zu)\n", n_in, out_size, ws_size, (size_t)WS_END); grid = -1; return; }
        int dev = 0, cus = 0;
        if (hipGetDevice(&dev) != hipSuccess || hipDeviceGetAttribute(&cus, hipDeviceAttributeMultiprocessorCount, dev) != hipSuccess) { grid = -1; return; }
        if (hipFuncSetAttribute((const void*)mega_fwd, hipFuncAttributeMaxDynamicSharedMemorySize, LDS_BYTES) != hipSuccess) { fprintf(stderr, "kernel_launch: hipFuncSetAttribute failed\n"); grid = -1; return; }
        int per_cu = 0;
        if (hipOccupancyMaxActiveBlocksPerMultiprocessor(&per_cu, (const void*)mega_fwd, NTHREADS, LDS_BYTES) != hipSuccess || per_cu < 1) { fprintf(stderr, "kernel_launch: occupancy query says %d\n", per_cu); }
        (void)hipGetLastError();
        if (cus != pg8::GRID) { fprintf(stderr, "kernel_launch: built for %d CUs, device has %d\n", pg8::GRID, cus); grid = -1; return; }
        grid = cus;
    }
    if (grid < 0) return;
    (void)hipMemsetAsync((char*)d_ws + WS_CTL, 0, CTL_ZERO_BYTES, stream);
    Args a{};
    for (int i = 0; i < 22; ++i) a.in[i] = d_in[i];
    a.out = (float*)d_out; a.ws = (unsigned char*)d_ws;
    hipLaunchKernelGGL(mega_fwd, dim3(grid), dim3(NTHREADS), LDS_BYTES, stream, a);
}
```

```cpp
#include <hip/hip_runtime.h>
#include <cstdio>
#include <cstdint>

#define LAS __attribute__((address_space(3)))
#define GAS __attribute__((address_space(1)))
typedef unsigned short bf16_t;
typedef short bf16x8 __attribute__((ext_vector_type(8)));
typedef short bf16x4 __attribute__((ext_vector_type(4)));
typedef float f32x2 __attribute__((ext_vector_type(2)));
typedef float f32x4 __attribute__((ext_vector_type(4)));
typedef float f32x16 __attribute__((ext_vector_type(16)));
typedef unsigned u32x2 __attribute__((ext_vector_type(2)));
typedef unsigned u32x4 __attribute__((ext_vector_type(4)));
typedef unsigned long long u64;
typedef int i32x2 __attribute__((ext_vector_type(2)));
typedef int i32x4 __attribute__((ext_vector_type(4)));
typedef int i32x8 __attribute__((ext_vector_type(8)));

constexpr int T = 32768, SEQ = 16384, DM = 2048;
constexpr int FFN = 5632, MFFN = 7168, NEXP = 8;
constexpr int NQKV = 2560, NWIN = 4864;
constexpr float ALPHA = 1.41421356237309515f;
constexpr float LN_EPS = 1e-5f, RMS_EPS = 1e-6f;
constexpr float QSCALE_SWA = 0.18033688011112042f;
constexpr float SCALE2_MLA = 0.10411754627697264f;
constexpr float LOG2E = 1.4426950408889634f;
constexpr int NWAVES = 8, NTHREADS = 512;
constexpr float W13_F8SCALE = 32.0f;
constexpr bool F8_FFN1 = true, F8_FFN2 = true, F8_QKV = true, F8_WO0 = true, F8_WIN = false, F8_WO1 = true;
constexpr bool EPI_ALIGN_RES = true;
constexpr bool SWA_FRAG = true;
constexpr bool F8_LAT = true;
constexpr float QLAT_F8SCALE = 8.0f, OLAT_F8SCALE = 32.0f, WUV_F8SCALE = 16.0f;
constexpr bool F8_G0 = true, F8_G1 = false;
constexpr bool F8_KV = true;
constexpr float KV_F8SCALE = 16.0f;
constexpr bool F8_WIN_SPLIT = true;
constexpr int WIN_F8_TILES = 14;
constexpr float WQKV_F8SCALE = 32.0f, WIN_F8SCALE = 32.0f, WO_F8SCALE = 64.0f, O0_F8SCALE = 16.0f, O2_F8SCALE = 32.0f;
constexpr float ACT_F8SCALE = 16.0f, W2_F8SCALE = 128.0f;

constexpr size_t MiB = 1u << 20;
constexpr size_t WS_CTL = 0, CTL_ZERO_BYTES = 1 * MiB;
constexpr size_t WS_WQKV = 2 * MiB, WS_WO0 = 12 * MiB, WS_W13 = 20 * MiB, WS_W2 = 64 * MiB, WS_WG0 = 86 * MiB, WS_WG1 = 94 * MiB, WS_WP0 = 102 * MiB, WS_WP1 = 103 * MiB,
                 WS_WIN = 104 * MiB, WS_WUK = 123 * MiB, WS_WUV = 125 * MiB, WS_WO1 = 129 * MiB;
constexpr size_t WS_TAB64 = 137 * MiB, WS_TAB32 = 145 * MiB, WS_PB = 149 * MiB, WS_XBA = 181 * MiB, WS_XBB = 309 * MiB;
constexpr size_t WS_TOKE = 437 * MiB;
constexpr size_t WS_TOKG = WS_TOKE + 256 * 1024;
constexpr size_t WS_TOKL = WS_TOKG + 256 * 1024;
constexpr size_t WS_TOKS = WS_TOKL + 256 * 1024;
constexpr size_t WS_SGATE = WS_TOKS + 256 * 1024;
constexpr size_t WS_WI = 439 * MiB, WS_SEL = 441 * MiB, WS_R = 458 * MiB;
constexpr size_t WS_Q = WS_R, WS_K = WS_R + 128 * MiB, WS_VT = WS_R + 144 * MiB, WS_ACT = WS_R + 160 * MiB, WS_PP0 = WS_R + 512 * MiB, WS_O8 = WS_R + 640 * MiB, WS_XB8 = WS_R + 704 * MiB  , WS_WIN8 = WS_R + 768 * MiB  ;
constexpr size_t WS_QN = WS_R, WS_QR = WS_R + 128 * MiB, WS_CRAW = WS_R + 192 * MiB, WS_KV = WS_R + 256 * MiB, WS_QI = WS_R + 292 * MiB, WS_KIF = WS_R + 356 * MiB,
                 WS_QLAT = WS_R + 360 * MiB, WS_O2 = WS_R + 872 * MiB;
constexpr size_t WS_MW13 = WS_R + 1128 * MiB, WS_MW2 = WS_R + 1352 * MiB, WS_XG = WS_R, WS_SOUT = WS_R + 136 * MiB, WS_ACT2 = WS_R + 404 * MiB  , WS_PP1 = WS_R + 884 * MiB;
constexpr size_t WS_X28 = WS_O8  , WS_X58 = WS_ACT2  ;
constexpr size_t WS_END = WS_R + 1464 * MiB;
constexpr int MAXSLOTS = 67840;
constexpr int CHUNK_TILES = 272;
constexpr int CW_TMO = 0, CW_CNT = 64  , CW_BAR = 4096;

constexpr int LDS_BYTES = 155648;
constexpr int MISC_OFF = 150016;
constexpr int DSA_WBUF = 18688;

typedef __bf16 bf16x2_t __attribute__((ext_vector_type(2)));
__device__ __forceinline__ unsigned cvt_pk_bf16(float lo, float hi) { const f32x2 v = {lo, hi}; return __builtin_bit_cast(unsigned, __builtin_convertvector(v, bf16x2_t)); }
__device__ __forceinline__ float bf2f(unsigned short h) { return __uint_as_float(((unsigned)h) << 16); }
__device__ __forceinline__ float bflo(unsigned w) { return __uint_as_float(w << 16); }
__device__ __forceinline__ float bfhi(unsigned w) { return __uint_as_float(w & 0xffff0000u); }
__device__ __forceinline__ int fresh_lane() { unsigned m = ~0u; asm volatile("" : "+v"(m)); return (int)__builtin_amdgcn_mbcnt_hi(m, __builtin_amdgcn_mbcnt_lo(m, 0u)); }
__device__ __forceinline__ float shx(float v, int o, int lane) { return __int_as_float(__builtin_amdgcn_ds_bpermute((lane ^ o) << 2, __float_as_int(v))); }
__device__ __forceinline__ float wave_sum(float v) {
    const int l = fresh_lane();
#pragma unroll
    for (int o = 1; o < 64; o <<= 1) v += shx(v, o, l);
    return v;
}
__device__ __forceinline__ unsigned pk4_fp8(float a, float b, float c, float d) { unsigned w = 0u; w = (unsigned)__builtin_amdgcn_cvt_pk_fp8_f32(a, b, (int)w, false); w = (unsigned)__builtin_amdgcn_cvt_pk_fp8_f32(c, d, (int)w, true); return w; }
#define LDS_WAIT() asm volatile("s_waitcnt lgkmcnt(0)" ::: "memory")
#define VM_WAIT() asm volatile("s_waitcnt vmcnt(0)" ::: "memory")

namespace pg8 {
constexpr int BM = 256, BK = 64, HALF = 128, HTB = HALF * BK * 2, STAGE_BYTES = 8 * HTB, NXCD = 8, WGM = 8;
__host__ __device__ __forceinline__ int lds_byte(int r, int c) { const int st = (r >> 4) * 2 + (c >> 5), rr = r & 15, cc = c & 31, ob = rr * 64 + cc * 2; return st * 1024 + (ob ^ (((ob >> 9) & 1) << 5)); }
__host__ __device__ __forceinline__ void stage_rc(int b, int& R, int& C) { const int st = b / 1024, sb = b % 1024, swz = sb ^ (((sb >> 9) & 1) << 5); R = (st >> 1) * 16 + swz / 64; C = (st & 1) * 32 + (swz % 64) / 2; }
__host__ __device__ __forceinline__ int perm32(int rho) { const int n = rho >> 4, i = rho & 15; return 8 * (i >> 2) + 4 * n + (i & 3); }

struct Unit { int pm, pn, am, acol, bn; };
struct Gemm { const bf16_t* A; const bf16_t* Bt; int lda, ldb, K; };

constexpr int GRID = 256;
template <int MODE, int NM, int NN> struct GridOrder {
    __device__ __forceinline__ bool next(int i, Unit& u) const {
        constexpr int nwg = NM * NN;
        int L = i * GRID + (int)blockIdx.x;
        if constexpr (MODE == 4) {
            if (i >= 6) { if ((int)blockIdx.x < GRID / 2 || i >= 8) return false; L = 6 * GRID + ((int)blockIdx.x - GRID / 2) * 2 + (i - 6); } }
        if (L >= nwg) return false;
        int wgid = L; { constexpr int q = nwg / NXCD, r = nwg % NXCD; const int xcd = wgid % NXCD, off = wgid / NXCD; wgid = (xcd < r ? xcd * (q + 1) : r * (q + 1) + (xcd - r) * q) + off; }
        constexpr int nig = WGM * NN; const int gid = wgid / nig, fm = gid * WGM, gsz = (NM - fm) < WGM ? (NM - fm) : WGM;
        u.pm = fm + ((wgid % nig) % gsz); u.pn = (wgid % nig) / gsz; u.am = u.pm; u.bn = u.pn;
        u.acol = MODE == 1 ? (u.pn >> 1) * 128 : (MODE == 2 ? u.pn * 1024 : (MODE == 3 ? u.pn * 512 : 0));
        return true;
    }
};
template <int NM, int NN> struct GridOrderSkip {
    int skip;
    __device__ __forceinline__ bool next(int i, Unit& u) const {
        constexpr int nwg = NM * NN; const int nW = GRID - skip, br = (int)blockIdx.x - skip; if (br < 0) return false;
        const int L = i * nW + br; if (L >= nwg) return false;
        int wgid = L; { constexpr int q = nwg / NXCD, r = nwg % NXCD; const int xcd = wgid % NXCD, off = wgid / NXCD; wgid = (xcd < r ? xcd * (q + 1) : r * (q + 1) + (xcd - r) * q) + off; }
        constexpr int nig = WGM * NN; const int gid = wgid / nig, fm = gid * WGM, gsz = (NM - fm) < WGM ? (NM - fm) : WGM;
        u.pm = fm + ((wgid % nig) % gsz); u.pn = (wgid % nig) / gsz; u.am = u.pm; u.bn = u.pn; u.acol = 0;
        return true;
    }
};
template <bool DOWN, int NN> struct MoeOrder {
    int tile0, ntl;
    __device__ __forceinline__ bool next(int i, Unit& u) const {
        int pml, pn;
        if constexpr (!DOWN && NN % 8 == 0) {
            constexpr int NJ = NN / 8; const int x = (int)blockIdx.x & 7, q = i * (GRID / 8) + ((int)blockIdx.x >> 3); if (q >= ntl * NJ) return false;
            const int nfull = ntl >> 3; int m, j;
            if (q < nfull * 8 * NJ) { const int b = q / (8 * NJ), w = q - b * (8 * NJ); m = b * 8 + (w & 7); j = w >> 3; }
            else { const int g = ntl - nfull * 8, w = q - nfull * 8 * NJ; j = w / g; m = nfull * 8 + (w - j * g); }
            pml = m; pn = 8 * j + x;
        } else {
        const int L = i * GRID + (int)blockIdx.x; if (L >= ntl * NN) return false;
        constexpr int nig = WGM * NN; const int wgid = L, gid = wgid / nig, fm = gid * WGM, gsz = (ntl - fm) < WGM ? (ntl - fm) : WGM;
        pml = fm + ((wgid % nig) % gsz); pn = (wgid % nig) / gsz; }
        const int pmg = tile0 + pml;
        const u32x4 t0 = *(const LAS u32x4*)(MISC_OFF + 20 * 4), t1 = *(const LAS u32x4*)(MISC_OFF + 24 * 4);
        int e = (pmg >= (int)t0.x) + (pmg >= (int)t0.y) + (pmg >= (int)t0.z) + (pmg >= (int)t0.w) + (pmg >= (int)t1.x) + (pmg >= (int)t1.y) + (pmg >= (int)t1.z);
        e = __builtin_amdgcn_readfirstlane(e);
        u.pn = pn; u.bn = e * NN + pn; u.acol = 0;
        if (DOWN) { u.pm = pmg; u.am = pml; } else { u.pm = pml; u.am = pmg; }
        return true;
    }
};

__device__ __forceinline__ void stage16_s(const char* gbase, unsigned voff, unsigned lds_dst) { unsigned keep;
    asm volatile("s_mov_b32 %0, m0\n\ts_mov_b32 m0, %3\n\ts_nop 0\n\tglobal_load_lds_dwordx4 %1, %2\n\ts_mov_b32 m0, %0" : "=&s"(keep) : "v"(voff), "s"(gbase), "s"(lds_dst) : "memory"); }
template <class Epi, class Sched, bool FP8 = false, bool ALIGN = true>
__device__ __forceinline__ void gemm_phase(LAS unsigned char* lds, const Gemm g, const Sched& S, const Epi& E, int wave_) {
    int tid_ = wave_ * 64 + fresh_lane(); asm volatile("" : "+v"(tid_));
    const int tid = tid_, wid = __builtin_amdgcn_readfirstlane(tid >> 6), lane = tid & 63, wr = wid >> 2, wc = wid & 3, fr = lane & 15, fq = lane >> 4;
    int K_ = g.K; asm volatile("" : "+s"(K_));
    const int K = K_, nt = K / BK;
    unsigned voffA[2], voffB[2];
#pragma unroll
    for (int i = 0; i < 2; ++i) { int R, C; stage_rc(tid * 16 + i * 8192, R, C); const int Rb = (R & ~31) + perm32(R & 31);
        voffA[i] = (unsigned)(R * g.lda + C) * 2u; voffB[i] = (unsigned)(Rb * g.ldb + C) * 2u; }
    const size_t kstep = (size_t)(BK * 2);
    const size_t hstepA = (size_t)HALF * g.lda * 2, hstepB = (size_t)HALF * g.ldb * 2;
    const unsigned ldsw = (unsigned)wid * 1024u;
    const int aoff = lds_byte(wr * 64 + fr, fq * 8), boff = lds_byte(wc * 32 + fr, fq * 8);
#define PG8_SA(b, h) (((b) * 2 + (h)) * HTB)
#define PG8_SB(b, h) ((4 + (b) * 2 + (h)) * HTB)
#define PG8_STAGE(bufoff, gbase, voff) do { _Pragma("unroll") for (int _i = 0; _i < 2; ++_i) { \
        if constexpr (FP8) stage16_s((const char*)(gbase), (voff)[_i], (unsigned)(size_t)(lds + (bufoff) + ldsw + _i * 8192)); \
        else __builtin_amdgcn_global_load_lds((const unsigned*)((const char*)(gbase) + (voff)[_i]), (LAS unsigned*)(lds + (bufoff) + ldsw + _i * 8192), 16, 0, 0); } } while (0)
#define PG8_LDA(dst, b, h) do { _Pragma("unroll") for (int m = 0; m < 4; ++m) _Pragma("unroll") for (int k = 0; k < 2; ++k) dst[m][k] = *(const LAS bf16x8*)(lds + PG8_SA(b, h) + aoff + m * 2048 + k * 1024); } while (0)
#define PG8_LDB(dst, b, h) do { _Pragma("unroll") for (int n = 0; n < 2; ++n) _Pragma("unroll") for (int k = 0; k < 2; ++k) dst[n][k] = *(const LAS bf16x8*)(lds + PG8_SB(b, h) + boff + n * 2048 + k * 1024); } while (0)
#define PG8_MMA(ai, bj, At, Bt) do { __builtin_amdgcn_s_setprio(1); _Pragma("unroll") for (int m = 0; m < 4; ++m) _Pragma("unroll") for (int n = 0; n < 2; ++n) _Pragma("unroll") for (int k = 0; k < 2; ++k) \
        acc[ai][bj][m][n] = __builtin_amdgcn_mfma_f32_16x16x32_bf16(Bt[n][k], At[m][k], acc[ai][bj][m][n], 0, 0, 0); __builtin_amdgcn_s_setprio(0); } while (0)
#define PG8_LDA8(dst, b, h) do { _Pragma("unroll") for (int m = 0; m < 4; ++m) { const i32x4 lo_ = *(const LAS i32x4*)(lds + PG8_SA(b, h) + aoff + m * 2048), hi_ = *(const LAS i32x4*)(lds + PG8_SA(b, h) + aoff + m * 2048 + 1024); \
        dst[m] = __builtin_shufflevector(lo_, hi_, 0, 1, 2, 3, 4, 5, 6, 7); } } while (0)
#define PG8_LDB8(dst, b, h) do { _Pragma("unroll") for (int n = 0; n < 2; ++n) { const i32x4 lo_ = *(const LAS i32x4*)(lds + PG8_SB(b, h) + boff + n * 2048), hi_ = *(const LAS i32x4*)(lds + PG8_SB(b, h) + boff + n * 2048 + 1024); \
        dst[n] = __builtin_shufflevector(lo_, hi_, 0, 1, 2, 3, 4, 5, 6, 7); } } while (0)
#define PG8_MMA8(ai, bj, At, Bt) do { __builtin_amdgcn_s_setprio(1); _Pragma("unroll") for (int m = 0; m < 4; ++m) _Pragma("unroll") for (int n = 0; n < 2; ++n) \
        acc[ai][bj][m][n] = __builtin_amdgcn_mfma_scale_f32_16x16x128_f8f6f4(Bt[n], At[m], acc[ai][bj][m][n], 0, 0, 0, 0, 0, 0); __builtin_amdgcn_s_setprio(0); } while (0)
#define PG8_WAIT_V(n) asm volatile("s_waitcnt vmcnt(" #n ")" ::: "memory")
#define PG8_WAIT_L(n) asm volatile("s_waitcnt lgkmcnt(" #n ")" ::: "memory")
#define PG8_BAR __builtin_amdgcn_s_barrier()
#define PG8_SCHED __builtin_amdgcn_sched_barrier(0)
#define PG8_ABASE(u) ((const char*)g.A + ((size_t)(u).am * BM * g.lda + (size_t)(u).acol) * 2)
#define PG8_BBASE(u) ((const char*)g.Bt + (size_t)(u).bn * BM * g.ldb * 2)
    Unit cur, nxt; int ui = 0;
    if (!S.next(0, cur)) return;
    f32x4 acc[2][2][4][2];
#pragma unroll
    for (int a = 0; a < 2; ++a)
#pragma unroll
        for (int b = 0; b < 2; ++b)
#pragma unroll
            for (int m = 0; m < 4; ++m)
#pragma unroll
                for (int n = 0; n < 2; ++n) acc[a][b][m][n] = (f32x4){0.f, 0.f, 0.f, 0.f};
    bf16x8 At[4][2], B0[2][2], B1[2][2]; i32x8 At8[4], B08[2], B18[2];
    const char* cA = PG8_ABASE(cur); const char* cB = PG8_BBASE(cur);
    {
        PG8_STAGE(PG8_SB(0, 0), cB, voffB); PG8_STAGE(PG8_SB(0, 1), cB + hstepB, voffB); PG8_STAGE(PG8_SA(0, 0), cA, voffA); PG8_STAGE(PG8_SA(0, 1), cA + hstepA, voffA);
        if (wr == 1) PG8_BAR;
        PG8_WAIT_V(2); PG8_BAR;
        PG8_STAGE(PG8_SB(1, 0), cB + kstep, voffB); PG8_STAGE(PG8_SA(1, 0), cA + kstep, voffA); PG8_STAGE(PG8_SB(1, 1), cB + hstepB + kstep, voffB);
        PG8_WAIT_V(6); PG8_BAR;
    }
    for (;;) {
        const bool has_next = S.next(ui + 1, nxt);
        const char* nA = has_next ? PG8_ABASE(nxt) : cA; const char* nB = has_next ? PG8_BBASE(nxt) : cB;
        for (int t = 0; t < nt; t += 2) {
            const bool last = (t == nt - 2);
            const char* a1 = cA + (size_t)(t + 1) * kstep;
            const char* a2 = last ? nA : cA + (size_t)(t + 2) * kstep; const char* b2 = last ? nB : cB + (size_t)(t + 2) * kstep;
            const char* a3 = a2 + kstep; const char* b3 = b2 + kstep;
            if constexpr (FP8) {
            PG8_LDB8(B08, 0, 0); PG8_LDB8(B18, 0, 1); PG8_SCHED; PG8_LDA8(At8, 0, 0); PG8_STAGE(PG8_SA(1, 1), a1 + hstepA, voffA);
            PG8_WAIT_V(8); PG8_WAIT_L(0); PG8_BAR; PG8_MMA8(0, 0, At8, B08); PG8_MMA8(0, 1, At8, B18); PG8_BAR; PG8_SCHED;
            PG8_LDA8(At8, 0, 1); PG8_STAGE(PG8_SB(0, 0), b2, voffB); PG8_STAGE(PG8_SB(0, 1), b2 + hstepB, voffB); PG8_STAGE(PG8_SA(0, 0), a2, voffA);
            PG8_WAIT_V(8); PG8_WAIT_L(0); PG8_BAR; PG8_MMA8(1, 0, At8, B08); PG8_MMA8(1, 1, At8, B18); PG8_BAR; PG8_SCHED;
            PG8_LDB8(B08, 1, 0); PG8_LDB8(B18, 1, 1); PG8_SCHED; PG8_LDA8(At8, 1, 0); PG8_STAGE(PG8_SA(0, 1), a2 + hstepA, voffA);
            PG8_WAIT_V(8); PG8_WAIT_L(0); PG8_BAR; PG8_MMA8(0, 0, At8, B08); PG8_MMA8(0, 1, At8, B18); PG8_BAR; PG8_SCHED;
            PG8_LDA8(At8, 1, 1); PG8_STAGE(PG8_SB(1, 0), b3, voffB); PG8_STAGE(PG8_SB(1, 1), b3 + hstepB, voffB); PG8_STAGE(PG8_SA(1, 0), a3, voffA);
            PG8_WAIT_V(8); PG8_WAIT_L(0); PG8_BAR; PG8_MMA8(1, 0, At8, B08); PG8_MMA8(1, 1, At8, B18); PG8_BAR; PG8_SCHED;
            } else {
            PG8_LDB(B0, 0, 0); PG8_LDB(B1, 0, 1); PG8_SCHED; PG8_LDA(At, 0, 0); PG8_STAGE(PG8_SA(1, 1), a1 + hstepA, voffA);
            PG8_WAIT_V(8); PG8_WAIT_L(0); PG8_BAR; PG8_MMA(0, 0, At, B0); PG8_MMA(0, 1, At, B1); PG8_BAR; PG8_SCHED;
            PG8_LDA(At, 0, 1); PG8_STAGE(PG8_SB(0, 0), b2, voffB); PG8_STAGE(PG8_SB(0, 1), b2 + hstepB, voffB); PG8_STAGE(PG8_SA(0, 0), a2, voffA);
            PG8_WAIT_V(8); PG8_WAIT_L(0); PG8_BAR; PG8_MMA(1, 0, At, B0); PG8_MMA(1, 1, At, B1); PG8_BAR; PG8_SCHED;
            PG8_LDB(B0, 1, 0); PG8_LDB(B1, 1, 1); PG8_SCHED; PG8_LDA(At, 1, 0); PG8_STAGE(PG8_SA(0, 1), a2 + hstepA, voffA);
            PG8_WAIT_V(8); PG8_WAIT_L(0); PG8_BAR; PG8_MMA(0, 0, At, B0); PG8_MMA(0, 1, At, B1); PG8_BAR; PG8_SCHED;
            PG8_LDA(At, 1, 1); PG8_STAGE(PG8_SB(1, 0), b3, voffB); PG8_STAGE(PG8_SB(1, 1), b3 + hstepB, voffB); PG8_STAGE(PG8_SA(1, 0), a3, voffA);
            PG8_WAIT_V(8); PG8_WAIT_L(0); PG8_BAR; PG8_MMA(1, 0, At, B0); PG8_MMA(1, 1, At, B1); PG8_BAR; PG8_SCHED;
            }
        }
        if constexpr (ALIGN) { if (wr == 0) PG8_BAR; }
        { int fr_ = fr, fq_ = fq; asm volatile("" : "+v"(fr_), "+v"(fq_));
          E(acc, cur, wr, wc, fr_, fq_); }
        if (!has_next) break;
#pragma unroll
        for (int a = 0; a < 2; ++a)
#pragma unroll
            for (int b = 0; b < 2; ++b)
#pragma unroll
                for (int m = 0; m < 4; ++m)
#pragma unroll
                    for (int n = 0; n < 2; ++n) acc[a][b][m][n] = (f32x4){0.f, 0.f, 0.f, 0.f};
        cur = nxt; cA = nA; cB = nB; ++ui;
        if constexpr (ALIGN) { if (wr == 1) PG8_BAR; }
    }
    PG8_WAIT_V(0);
    if constexpr (!ALIGN) { if (wr == 0) PG8_BAR; }
    PG8_BAR;
#undef PG8_SA
#undef PG8_SB
#undef PG8_STAGE
#undef PG8_LDA
#undef PG8_LDB
#undef PG8_MMA
#undef PG8_LDA8
#undef PG8_LDB8
#undef PG8_MMA8
#undef PG8_WAIT_V
#undef PG8_WAIT_L
#undef PG8_BAR
#undef PG8_SCHED
#undef PG8_ABASE
#undef PG8_BBASE
}

#define EPI_ROW(ai, m) (u.pm * BM + (ai) * HALF + wr * 64 + (m) * 16 + fr)
#define EPI_COL(bj) (u.pn * BM + (bj) * HALF + wc * 32 + 8 * fq)
typedef f32x4 AccT[2][2][4][2];

__device__ __forceinline__ void rope4(f32x4& v0, f32x4& v1, const f32x4 cs0, const f32x4 cs1) {
    f32x4 o0, o1;
    o0[0] = v0[0] * cs0[0] - v0[1] * cs0[1]; o0[1] = v0[1] * cs0[0] + v0[0] * cs0[1];
    o0[2] = v0[2] * cs0[2] - v0[3] * cs0[3]; o0[3] = v0[3] * cs0[2] + v0[2] * cs0[3];
    o1[0] = v1[0] * cs1[0] - v1[1] * cs1[1]; o1[1] = v1[1] * cs1[0] + v1[0] * cs1[1];
    o1[2] = v1[2] * cs1[2] - v1[3] * cs1[3]; o1[3] = v1[3] * cs1[2] + v1[2] * cs1[3];
    v0 = o0; v1 = o1;
}
__device__ __forceinline__ u32x4 pack8(const f32x4 v0, const f32x4 v1) { u32x4 w; w.x = cvt_pk_bf16(v0[0], v0[1]); w.y = cvt_pk_bf16(v0[2], v0[3]); w.z = cvt_pk_bf16(v1[0], v1[1]); w.w = cvt_pk_bf16(v1[2], v1[3]); return w; }

__device__ __forceinline__ void unpack8(const u32x4 w, f32x4& a, f32x4& b) { a[0] = bflo(w.x); a[1] = bfhi(w.x); a[2] = bflo(w.y); a[3] = bfhi(w.y); b[0] = bflo(w.z); b[1] = bfhi(w.z); b[2] = bflo(w.w); b[3] = bfhi(w.w); }
__device__ __forceinline__ u32x2 pack8_fp8(const f32x4 v0, const f32x4 v1, float s) { u32x2 w; w.x = pk4_fp8(v0[0] * s, v0[1] * s, v0[2] * s, v0[3] * s); w.y = pk4_fp8(v1[0] * s, v1[1] * s, v1[2] * s, v1[3] * s); return w; }
template <bool OUT8> struct EpiBf16 {
    bf16_t* O; int ldc; float osc;
    __device__ __forceinline__ void operator()(const AccT& acc, const Unit& u, int wr, int wc, int fr, int fq) const {
#pragma unroll
        for (int ai = 0; ai < 2; ++ai)
#pragma unroll
            for (int m = 0; m < 4; ++m) {
#pragma unroll
                for (int bj = 0; bj < 2; ++bj) {
                    if constexpr (OUT8) *(u32x2*)((unsigned char*)O + (size_t)EPI_ROW(ai, m) * ldc + EPI_COL(bj)) = pack8_fp8(acc[ai][bj][m][0], acc[ai][bj][m][1], osc);
                    else *(u32x4*)(O + (size_t)EPI_ROW(ai, m) * ldc + EPI_COL(bj)) = pack8(acc[ai][bj][m][0] * osc, acc[ai][bj][m][1] * osc); } }
    }
};
struct EpiQKV {
    unsigned char* ws; float asc;
    __device__ __forceinline__ void operator()(const AccT& acc, const Unit& u, int wr, int wc, int fr, int fq) const {
        bf16_t* Q = (bf16_t*)(ws + WS_Q); bf16_t* Kb = (bf16_t*)(ws + WS_K); bf16_t* VT = (bf16_t*)(ws + WS_VT); const float* tab64 = (const float*)(ws + WS_TAB64);
        if (u.pn < 9) {
            bf16_t* base = u.pn < 8 ? Q : Kb; const int ldc = u.pn < 8 ? 2048 : 256; const int colt = u.pn < 8 ? u.pn * BM : 0; const float sc = (u.pn < 8 ? QSCALE_SWA : 1.0f) * asc;
#pragma unroll
            for (int ai = 0; ai < 2; ++ai)
#pragma unroll
                for (int m = 0; m < 4; ++m) { const int row = EPI_ROW(ai, m);
#pragma unroll
                    for (int bj = 0; bj < 2; ++bj) { const int cl = bj * HALF + wc * 32 + 8 * fq; const int i0 = (cl & 63) >> 1;
                        const f32x4 cs0 = *(const f32x4*)(tab64 + ((size_t)row * 32 + i0) * 2), cs1 = *(const f32x4*)(tab64 + ((size_t)row * 32 + i0) * 2 + 4);
                        f32x4 v0 = acc[ai][bj][m][0], v1 = acc[ai][bj][m][1]; rope4(v0, v1, cs0, cs1); v0 = v0 * sc; v1 = v1 * sc;
                        if constexpr (SWA_FRAG) {
                            const int b = row >> 14, s = row & (SEQ - 1), hh = (colt + cl) >> 6, c64 = cl & 63, kk = c64 >> 4, hf2 = (c64 >> 3) & 1, nh = u.pn < 8 ? 32 : 4;
                            *(u32x4*)(base + ((((size_t)(b * nh + hh) * 512 + (s >> 5)) * 4 + kk) * 64 + hf2 * 32 + (s & 31)) * 8) = pack8(v0, v1); }
                        else *(u32x4*)(base + (size_t)row * ldc + colt + cl) = pack8(v0, v1); } }
        } else {
#pragma unroll
            for (int ai = 0; ai < 2; ++ai)
#pragma unroll
                for (int m = 0; m < 4; ++m) { const int row = EPI_ROW(ai, m), b = row >> 14, s = row & (SEQ - 1);
#pragma unroll
                    for (int bj = 0; bj < 2; ++bj) { const int cl = bj * HALF + wc * 32 + 8 * fq, kvh = cl >> 6, d0 = cl & 63;
                        const u32x4 w = pack8(acc[ai][bj][m][0] * asc, acc[ai][bj][m][1] * asc);
                        if constexpr (SWA_FRAG) {
                            const int j = s & 31, c = j >> 4, jj = j & 15, hfv = (jj & 7) >> 2, e = (jj & 3) + ((jj >> 3) << 2), mt = d0 >> 5;
                            bf16_t* pf = VT + (((((size_t)(b * 4 + kvh) * 512 + (s >> 5)) * 2 + c) * 2 + mt) * 64 + hfv * 32 + (d0 & 31)) * 8 + e;
                            pf[0] = (bf16_t)(w.x & 0xffff); pf[8] = (bf16_t)(w.x >> 16); pf[16] = (bf16_t)(w.y & 0xffff); pf[24] = (bf16_t)(w.y >> 16);
                            pf[32] = (bf16_t)(w.z & 0xffff); pf[40] = (bf16_t)(w.z >> 16); pf[48] = (bf16_t)(w.w & 0xffff); pf[56] = (bf16_t)(w.w >> 16); }
                        else {
                        bf16_t* p = VT + ((size_t)(b * 4 + kvh) * 64 + d0) * SEQ + s;
                        p[0 * SEQ] = (bf16_t)(w.x & 0xffff); p[1 * SEQ] = (bf16_t)(w.x >> 16); p[2 * SEQ] = (bf16_t)(w.y & 0xffff); p[3 * SEQ] = (bf16_t)(w.y >> 16);
                        p[4 * SEQ] = (bf16_t)(w.z & 0xffff); p[5 * SEQ] = (bf16_t)(w.z >> 16); p[6 * SEQ] = (bf16_t)(w.w & 0xffff); p[7 * SEQ] = (bf16_t)(w.w >> 16); } } }
        }
    }
};
template <bool RES16> struct EpiRes {
    const void* res; bf16_t* out; float sc;
    __device__ __forceinline__ void operator()(const AccT& acc, const Unit& u, int wr, int wc, int fr, int fq) const {
#pragma unroll
        for (int ai = 0; ai < 2; ++ai)
#pragma unroll
            for (int m = 0; m < 4; ++m) { const size_t ro = (size_t)EPI_ROW(ai, m) * DM;
#pragma unroll
                for (int bj = 0; bj < 2; ++bj) { const size_t o = ro + EPI_COL(bj); f32x4 r0, r1;
                    if constexpr (RES16) unpack8(*(const u32x4*)((const bf16_t*)res + o), r0, r1);
                    else { r0 = *(const f32x4*)((const float*)res + o); r1 = *(const f32x4*)((const float*)res + o + 4); }
                    *(u32x4*)(out + o) = pack8(r0 * ALPHA + acc[ai][bj][m][0] * sc, r1 * ALPHA + acc[ai][bj][m][1] * sc); }
                asm volatile("" ::: "memory"); }
    }
};
__device__ __forceinline__ float silu_mul(float g, float uu) { return g * __builtin_amdgcn_rcpf(1.0f + __builtin_amdgcn_exp2f(-g * LOG2E)) * uu; }
template <bool OUT8> struct EpiSwiglu {
    bf16_t* O; int ldc; float sc; float osc;
    __device__ __forceinline__ void operator()(const AccT& acc, const Unit& u, int wr, int wc, int fr, int fq) const {
#pragma unroll
        for (int ai = 0; ai < 2; ++ai)
#pragma unroll
            for (int m = 0; m < 4; ++m) { f32x4 a0, a1;
#pragma unroll
                for (int j = 0; j < 4; ++j) { a0[j] = silu_mul(acc[ai][0][m][0][j] * sc, acc[ai][1][m][0][j] * sc); a1[j] = silu_mul(acc[ai][0][m][1][j] * sc, acc[ai][1][m][1][j] * sc); }
                if constexpr (OUT8) { u32x2 w8; w8.x = pk4_fp8(a0[0] * osc, a0[1] * osc, a0[2] * osc, a0[3] * osc); w8.y = pk4_fp8(a1[0] * osc, a1[1] * osc, a1[2] * osc, a1[3] * osc);
                    *(u32x2*)((unsigned char*)O + (size_t)EPI_ROW(ai, m) * ldc + u.pn * HALF + wc * 32 + 8 * fq) = w8; }
                else *(u32x4*)(O + (size_t)EPI_ROW(ai, m) * ldc + u.pn * HALF + wc * 32 + 8 * fq) = pack8(a0, a1); }
    }
};
struct EpiPle {
    float* outf; unsigned char* ws; int layer; float nls;
    __device__ __forceinline__ void operator()(const AccT& acc, const Unit& u, int wr, int wc, int fr, int fq) const {
        const bf16_t* pp = (const bf16_t*)(ws + (layer == 0 ? WS_PP0 : WS_PP1));
        const bf16_t* xres = (const bf16_t*)(ws + (layer == 0 ? WS_XBA : WS_XBB));
#pragma unroll
        for (int ai = 0; ai < 2; ++ai)
#pragma unroll
            for (int m = 0; m < 4; ++m) { const unsigned ro = (unsigned)EPI_ROW(ai, m) * (unsigned)DM;
#pragma unroll
                for (int bj = 0; bj < 2; ++bj) { const unsigned o = ro + (unsigned)EPI_COL(bj);
                    f32x4 r0, r1, p0, p1; unpack8(*(const u32x4*)(xres + o), r0, r1); unpack8(*(const u32x4*)(pp + o), p0, p1);
                    f32x4 s0, s1;
#pragma unroll
                    for (int j = 0; j < 4; ++j) { s0[j] = __builtin_amdgcn_rcpf(1.0f + __builtin_amdgcn_exp2f(acc[ai][bj][m][0][j] * nls)); s1[j] = __builtin_amdgcn_rcpf(1.0f + __builtin_amdgcn_exp2f(acc[ai][bj][m][1][j] * nls)); }
                    const f32x4 o0 = r0 + s0 * p0, o1 = r1 + s1 * p1;
                    if (layer == 0) { *(u32x4*)((bf16_t*)(ws + WS_XBB) + o) = pack8(o0, o1);
                                      if constexpr (F8_WIN_SPLIT || F8_WIN) *(u32x2*)(ws + WS_XB8 + o) = pack8_fp8(o0, o1, 1.0f); }
                    else { *(f32x4*)(outf + o) = o0; *(f32x4*)(outf + o + 4) = o1; } }
                asm volatile("" ::: "memory"); }
    }
};
struct EpiWin {
    unsigned char* ws; float asc; int pn0;
    __device__ __forceinline__ void operator()(const AccT& acc, const Unit& u, int wr, int wc, int fr, int fq) const {
        bf16_t* QN = (bf16_t*)(ws + WS_QN); bf16_t* QR = (bf16_t*)(ws + WS_QR); float* CRAW = (float*)(ws + WS_CRAW); bf16_t* KV = (bf16_t*)(ws + WS_KV); bf16_t* QI = (bf16_t*)(ws + WS_QI);
        bf16_t* KIF = (bf16_t*)(ws + WS_KIF); float* WI = (float*)(ws + WS_WI); const float* tab64 = (const float*)(ws + WS_TAB64); const float* tab32 = (const float*)(ws + WS_TAB32);
        const int pn = u.pn + pn0;
#pragma unroll
        for (int ai = 0; ai < 2; ++ai)
#pragma unroll
            for (int m = 0; m < 4; ++m) { const int row = EPI_ROW(ai, m);
#pragma unroll
                for (int bj = 0; bj < 2; ++bj) { const int cl = bj * HALF + wc * 32 + 8 * fq; f32x4 v0 = acc[ai][bj][m][0] * asc, v1 = acc[ai][bj][m][1] * asc;
                    if (pn < 8) { *(u32x4*)(QN + (size_t)row * 2048 + pn * BM + cl) = pack8(v0, v1); }
                    else if (pn < 12) { const int i0 = (cl & 63) >> 1;
                        const f32x4 cs0 = *(const f32x4*)(tab64 + ((size_t)row * 32 + i0) * 2), cs1 = *(const f32x4*)(tab64 + ((size_t)row * 32 + i0) * 2 + 4);
                        rope4(v0, v1, cs0, cs1); if constexpr (F8_LAT) { v0 = v0 * QLAT_F8SCALE; v1 = v1 * QLAT_F8SCALE; }
                        if constexpr (F8_KV) *(u32x2*)((unsigned char*)QR + (size_t)row * 1024 + (pn - 8) * BM + cl) = pack8_fp8(v0, v1, 1.0f);
                        else *(u32x4*)(QR + (size_t)row * 1024 + (pn - 8) * BM + cl) = pack8(v0, v1); }
                    else if (pn < 14) { float* p = CRAW + (size_t)row * 512 + (pn - 12) * BM + cl; *(f32x4*)p = v0; *(f32x4*)(p + 4) = v1; }
                    else if (pn == 14) {
                        if (cl < 64) { const int i0 = cl >> 1;
                            const f32x4 cs0 = *(const f32x4*)(tab64 + ((size_t)row * 32 + i0) * 2), cs1 = *(const f32x4*)(tab64 + ((size_t)row * 32 + i0) * 2 + 4);
                            rope4(v0, v1, cs0, cs1);
                            if constexpr (F8_KV) *(u32x2*)((unsigned char*)KV + (size_t)row * 576 + 512 + cl) = pack8_fp8(v0, v1, KV_F8SCALE);
                            else *(u32x4*)(KV + (size_t)row * 576 + 512 + cl) = pack8(v0, v1); }
                        else if (cl < 128) { const int d8 = cl - 64;
                            if (d8 < 32) { const int i0 = d8 >> 1;
                                const f32x4 cs0 = *(const f32x4*)(tab32 + ((size_t)row * 16 + i0) * 2), cs1 = *(const f32x4*)(tab32 + ((size_t)row * 16 + i0) * 2 + 4);
                                rope4(v0, v1, cs0, cs1); }
                            const int b = row >> 14, s = row & (SEQ - 1), blk = s >> 5, j = s & 31, kk = d8 >> 4, hf = (d8 >> 3) & 1;
                            *(u32x4*)(KIF + ((size_t)((b * 512 + blk) * 4 + kk) * 64 + hf * 32 + j) * 8) = pack8(v0, v1); }
                        else if (cl < 144) { float* p = WI + (size_t)row * 16 + (cl - 128); *(f32x4*)p = v0; *(f32x4*)(p + 4) = v1; }
                    } else { const int cq = (pn - 15) * BM + cl, d8 = cq & 63;
                        if (d8 < 32) { const int i0 = d8 >> 1;
                            const f32x4 cs0 = *(const f32x4*)(tab32 + ((size_t)row * 16 + i0) * 2), cs1 = *(const f32x4*)(tab32 + ((size_t)row * 16 + i0) * 2 + 4);
                            rope4(v0, v1, cs0, cs1); }
                        *(u32x4*)(QI + (size_t)row * 1024 + cq) = pack8(v0, v1); }
                } }
    }
};
struct EpiMoeDown {
    unsigned char* ws;
    __device__ __forceinline__ void operator()(const AccT& acc, const Unit& u, int wr, int wc, int fr, int fq) const {
        bf16_t* O = (bf16_t*)(ws + WS_SOUT); const float* gate = (const float*)(ws + WS_SGATE);
#pragma unroll
        for (int ai = 0; ai < 2; ++ai)
#pragma unroll
            for (int m = 0; m < 4; ++m) { const int row = EPI_ROW(ai, m); const float gt = gate[row] * (1.0f / (ACT_F8SCALE * W2_F8SCALE)); bf16_t* rowp = O + (size_t)row * DM;
#pragma unroll
                for (int bj = 0; bj < 2; ++bj) *(u32x4*)(rowp + EPI_COL(bj)) = pack8(acc[ai][bj][m][0] * gt, acc[ai][bj][m][1] * gt); }
    }
};
}

#define XB_TMO      128
#define XB_XCNT(j)  (256  + 64 * (j))
#define XB_XSUB(j)  (1280 + 64 * (j))
#define XB_XGEN(j)  (2304 + 64 * (j))
#define XB_TOP      3328
#define XB_TOPGEN   3392
#define XCD_BAR_WORDS 3456
#define XB_SPIN_CAP (1u << 22)

__device__ __forceinline__ unsigned xb_ld(unsigned* p)              { return __hip_atomic_load(p, __ATOMIC_RELAXED, __HIP_MEMORY_SCOPE_AGENT); }
__device__ __forceinline__ unsigned xb_add(unsigned* p, unsigned v) { return __hip_atomic_fetch_add(p, v, __ATOMIC_RELAXED, __HIP_MEMORY_SCOPE_AGENT); }
__device__ __forceinline__ unsigned xb_xcc_id() { return (unsigned)__builtin_amdgcn_s_getreg((3 << 11) | 20) & 0xFu; }
#define XB_SPIN(cond, bar) do { unsigned _sp = 0; while (cond) { __builtin_amdgcn_s_sleep(1); \
    if ((++_sp & 255u) == 0u) { if (xb_ld(&(bar)[XB_TMO])) break; if (_sp > XB_SPIN_CAP) { atomicAdd(&(bar)[XB_TMO], 1u); break; } } } } while (0)

struct XcdBarrier { unsigned* bar; unsigned x; volatile LAS unsigned* st; };

__device__ __forceinline__ XcdBarrier xcd_barrier_post(unsigned* bar, volatile LAS unsigned* st) {
    XcdBarrier b; b.bar = bar; b.x = xb_xcc_id(); b.st = st;
    if (threadIdx.x == 0) (void)xb_add(&bar[XB_XCNT(b.x)], 1u);
    return b;
}
__device__ __forceinline__ void xcd_barrier_complete(unsigned* bar, unsigned x, unsigned& nloc, unsigned& nx) {
    const unsigned G = gridDim.x * gridDim.y * gridDim.z;
    unsigned sum, cnt, mine, sp = 0u;
    for (;;) {
        sum = 0u; cnt = 0u; mine = 0u;
#pragma unroll
        for (unsigned j = 0; j < 16; ++j) { const unsigned c = xb_ld(&bar[XB_XCNT(j)]); sum += c; cnt += (c > 0u) ? 1u : 0u; mine = (j == x) ? c : mine; }
        if (sum == G) break;
        __builtin_amdgcn_s_sleep(1);
        if ((++sp & 255u) == 0u) { if (xb_ld(&bar[XB_TMO])) break; if (sp > XB_SPIN_CAP) { atomicAdd(&bar[XB_TMO], 1u); break; } }
    }
    nloc = mine > 0u ? mine : 1u; nx = cnt > 0u ? cnt : 1u;
}
__device__ __forceinline__ void xcd_barrier(const XcdBarrier& b, int wave_) {
    asm volatile("s_waitcnt vmcnt(0)" ::: "memory");
    __syncthreads();
    int tl_ = wave_ * 64 + fresh_lane();
    if (tl_ == 0) {
        unsigned* bar = b.bar;
        __builtin_amdgcn_s_waitcnt(0);
        unsigned nloc = b.st[0], nx = b.st[1];
        if (nloc == 0u) { xcd_barrier_complete(bar, b.x, nloc, nx); b.st[0] = nloc; b.st[1] = nx; }
        const unsigned old = xb_add(&bar[XB_XSUB(b.x)], 1u);
        const unsigned gen = old / nloc;
        if (old + 1u == (gen + 1u) * nloc) {
            __builtin_amdgcn_fence(__ATOMIC_RELEASE, "agent");
            asm volatile("s_waitcnt vmcnt(0)" ::: "memory");
            const unsigned og = xb_add(&bar[XB_TOP], 1u);
            const unsigned tg = og / nx;
            if (og + 1u == (tg + 1u) * nx) xb_add(&bar[XB_TOPGEN], 1u);
            else XB_SPIN(xb_ld(&bar[XB_TOPGEN]) == tg, bar);
            __builtin_amdgcn_fence(__ATOMIC_ACQUIRE, "agent");
            xb_add(&bar[XB_XGEN(b.x)], 1u);
            asm volatile("s_waitcnt vmcnt(0)" ::: "memory");
        } else {
            XB_SPIN(xb_ld(&bar[XB_XGEN(b.x)]) == gen, bar);
            __builtin_amdgcn_fence(__ATOMIC_ACQUIRE, "agent");
            asm volatile("s_waitcnt vmcnt(0)" ::: "memory");
        }
    }
    __syncthreads();
}

struct Args { const void* in[22]; float* out; unsigned char* ws; };
struct Frame {
    LAS unsigned char* lds; volatile LAS unsigned* MISC; unsigned* ctl;
    int tid, lane, wave, gw; static constexpr int G = 256;
};
__device__ __forceinline__ void glds16(const void* g, LAS void* l) { __builtin_amdgcn_global_load_lds((const unsigned*)g, (LAS unsigned*)l, 16, 0, 0); }
__device__ __forceinline__ int mbcnt64(u64 m) { return (int)__builtin_amdgcn_mbcnt_hi((unsigned)(m >> 32), __builtin_amdgcn_mbcnt_lo((unsigned)m, 0u)); }

__device__ __forceinline__ int il64(int d) { return d < 32 ? 2 * d : 2 * (d - 32) + 1; }
__device__ __forceinline__ int il32(int d) { return d < 16 ? 2 * d : (d < 32 ? 2 * (d - 16) + 1 : d); }
__device__ __forceinline__ int map_row(int mode, int n) {
    if (mode == 1) return n < 2304 ? (n & ~63) + il64(n & 63) : n;
    if (mode == 2) return ((n >> 7) << 8) + (n & 127);
    if (mode == 3) return ((n >> 7) << 8) + 128 + (n & 127);
    if (mode == 4) {
        if (n < 3072) { const int h = n / 192, r = n - h * 192; return r < 128 ? h * 128 + r : 2048 + h * 64 + il64(r - 128); }
        if (n < 3584) return n;
        if (n < 3648) return 3584 + il64(n - 3584);
        if (n < 4672) { const int j = n - 3648; return 3840 + (j & ~63) + il32(j & 63); }
        if (n < 4736) return 3648 + il32(n - 4672);
        return 3712 + (n - 4736);
    }
    return n;
}
__device__ __forceinline__ void tr_item(const float* __restrict__ W, int N, bf16_t* WT, int ldo, int kofs, int mode, LAS float* scr, int item, int lane, float f8scale = 0.f, int rlo = 0, int rhi = 1 << 30) {
    const int nblk = (N + 63) >> 6, kb = item / nblk, nb = item - kb * nblk, k0 = 64 * kb, n0 = 64 * nb;
    const int nc = n0 + 4 * (lane & 15); const bool okr = nc < N; const float* wp = W + (size_t)(k0 + (lane >> 4)) * N + nc;
    f32x4 v[16];
#pragma unroll
    for (int i = 0; i < 16; ++i) v[i] = okr ? *(const f32x4*)(wp + (size_t)(4 * i) * N) : (f32x4){0.f, 0.f, 0.f, 0.f};
#pragma unroll
    for (int i = 0; i < 16; ++i) { const int k = 4 * i + (lane >> 4); *(LAS f32x4*)(scr + k * 64 + ((4 * (lane & 15) + 4 * (i >> 1)) & 63)) = v[i]; }
    LDS_WAIT();
    const int c = lane & 7;
#pragma unroll
    for (int j = 0; j < 8; ++j) { const int nl = (lane >> 3) + 8 * j, n = n0 + nl; const LAS float* s = scr + (8 * c) * 64 + ((nl + 4 * c) & 63);
        const int orow = map_row(mode, n); const bool okw = n < N && orow >= rlo && orow < rhi;
        if (f8scale > 0.f) { u32x2 o8; o8.x = pk4_fp8(s[0 * 64] * f8scale, s[1 * 64] * f8scale, s[2 * 64] * f8scale, s[3 * 64] * f8scale); o8.y = pk4_fp8(s[4 * 64] * f8scale, s[5 * 64] * f8scale, s[6 * 64] * f8scale, s[7 * 64] * f8scale);
            if (okw) *(u32x2*)((unsigned char*)WT + (size_t)orow * ldo + kofs + k0 + 8 * c) = o8; }
        else {
        u32x4 o; o.x = cvt_pk_bf16(s[0 * 64], s[1 * 64]); o.y = cvt_pk_bf16(s[2 * 64], s[3 * 64]); o.z = cvt_pk_bf16(s[4 * 64], s[5 * 64]); o.w = cvt_pk_bf16(s[6 * 64], s[7 * 64]);
        if (okw) *(u32x4*)(WT + (size_t)orow * ldo + kofs + k0 + 8 * c) = o; } }
    LDS_WAIT();
}
__device__ __forceinline__ void tr_matrix(const Frame& F, const float* W, int K, int N, bf16_t* WT, int ldo, int kofs, int mode, float f8scale = 0.f, int rlo = 0, int rhi = 1 << 30) {
    LAS float* scr = (LAS float*)(F.lds + F.wave * 16384);
    const int nitems = (K >> 6) * ((N + 63) >> 6), NGW = F.G * NWAVES;
    for (int it = F.gw; it < nitems; it += NGW) tr_item(W, N, WT, ldo, kofs, mode, scr, it, F.lane, f8scale, rlo, rhi);
}
__device__ __forceinline__ void cvt_linear(const Frame& F, const float* src, bf16_t* dst, size_t n8) {
    const size_t NT = (size_t)F.G * NTHREADS;
    for (size_t i = (size_t)blockIdx.x * NTHREADS + F.tid; i < n8; i += NT) { const f32x4 a = *(const f32x4*)(src + i * 8), b = *(const f32x4*)(src + i * 8 + 4); *(u32x4*)(dst + i * 8) = pg8::pack8(a, b); }
}
__device__ __forceinline__ void cvt_linear8(const Frame& F, const float* src, unsigned char* dst, size_t n8) {
    const size_t NT = (size_t)F.G * NTHREADS;
    for (size_t i = (size_t)blockIdx.x * NTHREADS + F.tid; i < n8; i += NT) { const f32x4 a = *(const f32x4*)(src + i * 8), b = *(const f32x4*)(src + i * 8 + 4); *(u32x2*)(dst + i * 8) = pg8::pack8_fp8(a, b, 1.0f); }
}
__device__ __forceinline__ void sincos_d(double ang, float& c, float& s) {
    const double n = __builtin_rint(ang * 0.6366197723675814);
    double r = __builtin_fma(-n, 1.5707963267948966, ang); r = __builtin_fma(-n, 6.123233995736766e-17, r);
    const double r2 = r * r;
    const double sp = r * (1.0 + r2 * (-1.0 / 6.0 + r2 * (1.0 / 120.0 + r2 * (-1.0 / 5040.0 + r2 * (1.0 / 362880.0 + r2 * (-1.0 / 39916800.0 + r2 * (1.0 / 6227020800.0)))))));
    const double cp = 1.0 + r2 * (-0.5 + r2 * (1.0 / 24.0 + r2 * (-1.0 / 720.0 + r2 * (1.0 / 40320.0 + r2 * (-1.0 / 3628800.0 + r2 * (1.0 / 479001600.0 + r2 * (-1.0 / 87178291200.0)))))));
    const int q = (int)((long long)n & 3);
    const float sf = (float)sp, cf = (float)cp;
    c = q == 0 ? cf : (q == 1 ? -sf : (q == 2 ? -cf : sf));
    s = q == 0 ? sf : (q == 1 ? cf : (q == 2 ? -sf : -cf));
}
__device__ __forceinline__ void rope_tables(const Frame& F, const int* pos, float* tab64, float* tab32) {
    const int NT = F.G * NTHREADS;
    for (int i = blockIdx.x * NTHREADS + F.tid; i < T * 48; i += NT) {
        const int t = i / 48, f = i - t * 48; const bool is64 = f < 32; const int fi = is64 ? f : f - 32;
        const double base = is64 ? 0.7498942093324559 : 0.5623413251903491;
        double inv = 1.0; for (int k = 0; k < fi; ++k) inv *= base;
        float c, s; sincos_d((double)pos[t] * inv, c, s);
        float* o = is64 ? tab64 + ((size_t)t * 32 + fi) * 2 : tab32 + ((size_t)t * 16 + fi) * 2; o[0] = c; o[1] = s;
    }
}

constexpr int MOE_CONV_ITEMS = 8 * 3 * 3584;
constexpr int TOPK_CONV = 11;
__device__ __forceinline__ void moe_conv_item(const float* w1, const float* w3, const float* w2, unsigned char* ws, LAS float* scr, int it, int lane) {
    const int e = it / (3 * 3584), r = it - e * (3 * 3584), mtx = r / 3584, sub = r - mtx * 3584;
    if (mtx < 2) tr_item((mtx == 0 ? w1 : w3) + (size_t)e * DM * MFFN, MFFN, (bf16_t*)(ws + WS_MW13 + (size_t)e * 2 * MFFN * DM), DM, 0, 2 + mtx, scr, sub, lane, W13_F8SCALE);
    else tr_item(w2 + (size_t)e * MFFN * DM, DM, (bf16_t*)(ws + WS_MW2 + (size_t)e * DM * MFFN), MFFN, 0, 0, scr, sub, lane, W2_F8SCALE);
}

__device__ __forceinline__ unsigned ln_col(int lane, int q) { return 8u * (unsigned)(lane & 63) + 512u * (unsigned)(q >> 1) + 4u * (unsigned)(q & 1); }
__device__ __forceinline__ void ln_load16(f32x4 (&v)[8], const bf16_t* row, int lane) {
#pragma unroll
    for (int j = 0; j < 4; ++j) pg8::unpack8(*(const u32x4*)(row + ln_col(lane, 2 * j)), v[2 * j], v[2 * j + 1]);
}
__device__ __forceinline__ void ln_store16(const f32x4 (&v)[8], bf16_t* row, int lane) {
#pragma unroll
    for (int j = 0; j < 4; ++j) *(u32x4*)(row + ln_col(lane, 2 * j)) = pg8::pack8(v[2 * j], v[2 * j + 1]);
}
__device__ __forceinline__ void ln_store8(const f32x4 (&v)[8], unsigned char* row, int lane) {
#pragma unroll
    for (int j = 0; j < 4; ++j) *(u32x2*)(row + ln_col(lane, 2 * j)) = pg8::pack8_fp8(v[2 * j], v[2 * j + 1], 1.0f);
}
__device__ __forceinline__ void ln_core(f32x4 (&v)[8], const float* g, const float* bb, int lane) {
    float s = 0.f;
#pragma unroll
    for (int j = 0; j < 8; ++j) s += (v[j][0] + v[j][1]) + (v[j][2] + v[j][3]);
    const float mean = wave_sum(s) * (1.0f / DM); float s2 = 0.f;
#pragma unroll
    for (int j = 0; j < 8; ++j) { v[j] = v[j] - mean; s2 += (v[j][0] * v[j][0] + v[j][1] * v[j][1]) + (v[j][2] * v[j][2] + v[j][3] * v[j][3]); }
    const float rstd = 1.0f / sqrtf(wave_sum(s2) * (1.0f / DM) + LN_EPS);
    int l2 = lane; asm volatile("" : "+v"(l2) :: "memory");
#pragma unroll
    for (int j = 0; j < 8; ++j) { const f32x4 gv = *(const f32x4*)(g + ln_col(l2, j)), bv = *(const f32x4*)(bb + ln_col(l2, j)); v[j] = v[j] * rstd * gv + bv; }
}
template <bool OUT8> __device__ __forceinline__ void ln_phase(const Frame& F, const bf16_t* YH, bf16_t* X16, unsigned char* X8, const float* g, const float* bb) {
    const int NGW = F.G * NWAVES;
    for (int m = F.gw; m < T; m += NGW) { f32x4 v[8];
        ln_load16(v, YH + (size_t)m * DM, F.lane); ln_core(v, g, bb, F.lane); ln_store16(v, X16 + (size_t)m * DM, F.lane);
        if constexpr (OUT8) ln_store8(v, X8 + (size_t)m * DM, F.lane); }
}

__device__ __forceinline__ int crow(int r, int hi) { return (r & 3) + 8 * (r >> 2) + 4 * hi; }
template <bool OUT8> __device__ __forceinline__ void swa_phase(const Frame& F, bf16_t* Q, const bf16_t* Kb, const bf16_t* VT, const float* sinks, unsigned char* O8) {
    const int lane = F.lane, l31 = lane & 31, hf = lane >> 5;
    for (int wi = blockIdx.x; wi < 4096; wi += F.G) {
        const int kvh = wi & 3, qsi = (wi >> 2) & 511, b = wi >> 11, h = kvh * 8 + F.wave, q0 = qsi * 32;
        const size_t row0 = (size_t)b * SEQ + q0;
        bf16x8 qf[4];
#pragma unroll
        for (int kk = 0; kk < 4; ++kk) { if constexpr (SWA_FRAG) qf[kk] = *(const bf16x8*)(Q + ((((size_t)(b * 32 + h) * 512 + qsi) * 4 + kk) * 64 + lane) * 8);
            else qf[kk] = *(const bf16x8*)(Q + (row0 + l31) * 2048 + h * 64 + 16 * kk + 8 * hf); }
        bf16x8 kf[5][4];
#pragma unroll
        for (int kt = 0; kt < 5; ++kt) {
            int kpos = q0 - 128 + 32 * kt + l31; kpos = kpos < 0 ? 0 : kpos;
            const bf16_t* kp = Kb + ((size_t)b * SEQ + kpos) * 256 + kvh * 64 + 8 * hf;
            const int kblk = qsi - 4 + kt < 0 ? 0 : qsi - 4 + kt;
#pragma unroll
            for (int kk = 0; kk < 4; ++kk) { if constexpr (SWA_FRAG) kf[kt][kk] = *(const bf16x8*)(Kb + ((((size_t)(b * 4 + kvh) * 512 + kblk) * 4 + kk) * 64 + lane) * 8); else kf[kt][kk] = *(const bf16x8*)(kp + 16 * kk); }
        }
        asm volatile("" ::: "memory");
        f32x16 sc[5];
#pragma unroll
        for (int kt = 0; kt < 5; ++kt) {
            f32x16 a;
#pragma unroll
            for (int r = 0; r < 16; ++r) a[r] = 0.f;
#pragma unroll
            for (int kk = 0; kk < 4; ++kk) a = __builtin_amdgcn_mfma_f32_32x32x16_bf16(kf[kt][kk], qf[kk], a, 0, 0, 0);
            sc[kt] = a;
        }
        bf16x8 vf[5][2][2];
#pragma unroll
        for (int kt = 0; kt < 5; ++kt)
#pragma unroll
            for (int c = 0; c < 2; ++c) {
                int kb = q0 - 128 + 32 * kt + 16 * c + 4 * hf; int kb0 = kb < 0 ? 0 : kb, kb1 = kb + 8 < 0 ? 0 : kb + 8;
#pragma unroll
                for (int mt = 0; mt < 2; ++mt) {
                    if constexpr (SWA_FRAG) { const int vblk = qsi - 4 + kt < 0 ? 0 : qsi - 4 + kt; vf[kt][c][mt] = *(const bf16x8*)(VT + (((((size_t)(b * 4 + kvh) * 512 + vblk) * 2 + c) * 2 + mt) * 64 + lane) * 8); }
                    else { const bf16_t* vp = VT + ((size_t)(b * 4 + kvh) * 64 + 32 * mt + l31) * SEQ;
                    const u32x2 v0 = *(const u32x2*)(vp + kb0), v1 = *(const u32x2*)(vp + kb1); u32x4 w; w.x = v0.x; w.y = v0.y; w.z = v1.x; w.w = v1.y; vf[kt][c][mt] = __builtin_bit_cast(bf16x8, w); } }
            }
        asm volatile("" ::: "memory");
        const float sink2 = sinks[h] * LOG2E; const int qpos = q0 + l31;
        float mx = sink2;
#pragma unroll
        for (int kt = 0; kt < 5; ++kt)
#pragma unroll
            for (int r = 0; r < 16; ++r) { const int kpos = q0 - 128 + 32 * kt + crow(r, hf); const bool ok = kpos >= 0 && kpos <= qpos && (qpos - kpos) < 128;
                const float v = ok ? sc[kt][r] : -INFINITY; sc[kt][r] = v; mx = fmaxf(mx, v); }
        mx = fmaxf(mx, shx(mx, 32, lane));
        float sum = 0.f;
#pragma unroll
        for (int kt = 0; kt < 5; ++kt)
#pragma unroll
            for (int r = 0; r < 16; ++r) { const float p = __builtin_amdgcn_exp2f(sc[kt][r] - mx); sc[kt][r] = p; sum += p; }
        sum += shx(sum, 32, lane);
        const float inv = 1.0f / (sum + __builtin_amdgcn_exp2f(sink2 - mx));
        f32x16 o[2];
#pragma unroll
        for (int r = 0; r < 16; ++r) { o[0][r] = 0.f; o[1][r] = 0.f; }
#pragma unroll
        for (int kt = 0; kt < 5; ++kt)
#pragma unroll
            for (int c = 0; c < 2; ++c) {
                bf16x8 pb; { u32x4 w; w.x = cvt_pk_bf16(sc[kt][8 * c + 0], sc[kt][8 * c + 1]); w.y = cvt_pk_bf16(sc[kt][8 * c + 2], sc[kt][8 * c + 3]); w.z = cvt_pk_bf16(sc[kt][8 * c + 4], sc[kt][8 * c + 5]); w.w = cvt_pk_bf16(sc[kt][8 * c + 6], sc[kt][8 * c + 7]); pb = __builtin_bit_cast(bf16x8, w); }
#pragma unroll
                for (int mt = 0; mt < 2; ++mt) o[mt] = __builtin_amdgcn_mfma_f32_32x32x16_bf16(vf[kt][c][mt], pb, o[mt], 0, 0, 0);
            }
        bf16_t* op = Q + (row0 + l31) * 2048 + h * 64; unsigned char* op8 = O8 + (row0 + l31) * 2048 + h * 64; const float inv8 = inv * O0_F8SCALE;
        if constexpr (OUT8) {
#pragma unroll
            for (int mt = 0; mt < 2; ++mt) { unsigned w[4];
#pragma unroll
                for (int r4 = 0; r4 < 4; ++r4) w[r4] = pk4_fp8(o[mt][4 * r4] * inv8, o[mt][4 * r4 + 1] * inv8, o[mt][4 * r4 + 2] * inv8, o[mt][4 * r4 + 3] * inv8);
                const auto s02 = __builtin_amdgcn_permlane32_swap(w[0], w[2], false, false), s13 = __builtin_amdgcn_permlane32_swap(w[1], w[3], false, false);
                u32x4 st; st.x = s02[0]; st.y = s02[1]; st.z = s13[0]; st.w = s13[1];
                *(u32x4*)(op8 + 32 * mt + 16 * hf) = st; }
        } else
#pragma unroll
        for (int mt = 0; mt < 2; ++mt)
#pragma unroll
            for (int r4 = 0; r4 < 4; ++r4) {
                if constexpr (OUT8) *(unsigned*)(op8 + 32 * mt + 8 * r4 + 4 * hf) = pk4_fp8(o[mt][4 * r4] * inv8, o[mt][4 * r4 + 1] * inv8, o[mt][4 * r4 + 2] * inv8, o[mt][4 * r4 + 3] * inv8);
                else { u32x2 w; w.x = cvt_pk_bf16(o[mt][4 * r4] * inv, o[mt][4 * r4 + 1] * inv); w.y = cvt_pk_bf16(o[mt][4 * r4 + 2] * inv, o[mt][4 * r4 + 3] * inv);
                *(u32x2*)(op + 32 * mt + 8 * r4 + 4 * hf) = w; } }
    }
}

__device__ __forceinline__ void kvnorm_phase(const Frame& F, const float* CRAW, const float* gk, bf16_t* KV) {
    const int NGW = F.G * NWAVES;
    for (int m = F.gw; m < T; m += NGW) { const float* cr = CRAW + (size_t)m * 512;
        const f32x4 a = *(const f32x4*)(cr + 4 * F.lane), b = *(const f32x4*)(cr + 256 + 4 * F.lane);
        float s = (a[0] * a[0] + a[1] * a[1]) + (a[2] * a[2] + a[3] * a[3]) + (b[0] * b[0] + b[1] * b[1]) + (b[2] * b[2] + b[3] * b[3]);
        const float r = 1.0f / sqrtf(wave_sum(s) * (1.0f / 512.0f) + RMS_EPS);
        const f32x4 ga = *(const f32x4*)(gk + 4 * F.lane), gb = *(const f32x4*)(gk + 256 + 4 * F.lane);
        if constexpr (F8_KV) { const float r8 = r * KV_F8SCALE; unsigned char* kp = (unsigned char*)KV + (size_t)m * 576 + 4 * F.lane;
            *(unsigned*)kp = pk4_fp8(a[0] * r8 * ga[0], a[1] * r8 * ga[1], a[2] * r8 * ga[2], a[3] * r8 * ga[3]);
            *(unsigned*)(kp + 256) = pk4_fp8(b[0] * r8 * gb[0], b[1] * r8 * gb[1], b[2] * r8 * gb[2], b[3] * r8 * gb[3]); continue; }
        u32x2 w0, w1; w0.x = cvt_pk_bf16(a[0] * r * ga[0], a[1] * r * ga[1]); w0.y = cvt_pk_bf16(a[2] * r * ga[2], a[3] * r * ga[3]);
        w1.x = cvt_pk_bf16(b[0] * r * gb[0], b[1] * r * gb[1]); w1.y = cvt_pk_bf16(b[2] * r * gb[2], b[3] * r * gb[3]);
        *(u32x2*)(KV + (size_t)m * 576 + 4 * F.lane) = w0; *(u32x2*)(KV + (size_t)m * 576 + 256 + 4 * F.lane) = w1; }
}

__device__ __forceinline__ float relu1(float a) { return __builtin_amdgcn_fmed3f(a, 0.f, 3.0e38f); }
__device__ __forceinline__ unsigned f2key(float f) { const unsigned u = __float_as_uint(f); return u ^ ((unsigned)((int)u >> 31) | 0x80000000u); }
__device__ __forceinline__ float key2f(unsigned k) { const unsigned u = (k & 0x80000000u) ? (k ^ 0x80000000u) : ~k; return __uint_as_float(u); }
__device__ __forceinline__ unsigned compact256(LAS u64* buf, int n, int lane) {
    u64 e[8];
#pragma unroll
    for (int i = 0; i < 8; ++i) e[i] = (lane + 64 * i < n) ? buf[lane + 64 * i] : 0ull;
    unsigned thr = 0u;
    for (int bit = 31; bit >= 0; --bit) {
        const unsigned cand = thr | (1u << bit); int c = 0;
#pragma unroll
        for (int i = 0; i < 8; ++i) c += __popcll(__ballot((unsigned)(e[i] >> 32) >= cand));
        if (c >= 256) thr = cand;
    }
    int ngt = 0;
#pragma unroll
    for (int i = 0; i < 8; ++i) ngt += __popcll(__ballot((unsigned)(e[i] >> 32) > thr));
    int pos_gt = 0, pos_eq = ngt;
#pragma unroll
    for (int i = 0; i < 8; ++i) { const unsigned k = (unsigned)(e[i] >> 32); const bool gt = k > thr, eq = k == thr; const u64 mg = __ballot(gt), me = __ballot(eq);
        if (gt) buf[pos_gt + mbcnt64(mg)] = e[i];
        const int re = pos_eq + mbcnt64(me); if (eq && re < 256) buf[re] = e[i];
        pos_gt += __popcll(mg); pos_eq += __popcll(me); }
    return thr;
}
__device__ __forceinline__ unsigned compact_bound(LAS u64* buf, int n, int lane, unsigned lo, int& n_out) {
    u64 e[8]; unsigned mx = 0u;
#pragma unroll
    for (int i = 0; i < 8; ++i) { e[i] = (lane + 64 * i < n) ? buf[lane + 64 * i] : 0ull; const unsigned k = (unsigned)(e[i] >> 32); mx = k > mx ? k : mx; }
#pragma unroll
    for (int o = 1; o < 64; o <<= 1) { const unsigned t = (unsigned)__builtin_amdgcn_ds_bpermute((lane ^ o) << 2, (int)mx); mx = t > mx ? t : mx; }
    mx = (unsigned)__builtin_amdgcn_readfirstlane((int)mx);
    const unsigned diff = mx ^ lo; const int hb = diff ? 31 - __builtin_clz(diff) : 0;
    unsigned thr = hb >= 31 ? 0u : (lo & ~((2u << hb) - 1u)); int cge = n;
    for (int bit = hb; bit >= 0; --bit) {
        const unsigned cand = thr | (1u << bit); int c = 0;
#pragma unroll
        for (int i = 0; i < 8; ++i) c += __popcll(__ballot((unsigned)(e[i] >> 32) >= cand));
        if (c >= 256) { thr = cand; cge = c; if (c <= 288) break; }
    }
    int pos = 0;
#pragma unroll
    for (int i = 0; i < 8; ++i) { const bool ge = (unsigned)(e[i] >> 32) >= thr && (lane + 64 * i < n); const u64 mg = __ballot(ge);
        if (ge) buf[pos + mbcnt64(mg)] = e[i];
        pos += __popcll(mg); }
    n_out = pos;
    return thr;
}
template <bool CONV = false> __device__ __forceinline__ void topk_phase(const Frame& F, const bf16_t* QI, const bf16_t* KIF, const float* WI, unsigned short* SEL) {
    const int lane = F.lane, l31 = lane & 31, hf = lane >> 5, wave = F.wave;
    LAS u64* mybuf = (LAS u64*)F.lds + (size_t)(wave * 4) * 512;
    const unsigned lmask_lt = (1u << l31) - 1u; const int hfm = -hf;
    for (int pu = blockIdx.x; pu < 512; pu += F.G) {
        const int b = pu >> 8, pi = pu & 255;
        for (int half = 0; half < 2; ++half) {
            const int tq = half == 0 ? pi : 511 - pi, q0 = tq * 32, nsteps = tq + 1;
            const size_t trow0 = (size_t)b * SEQ + q0 + 4 * wave;
            bf16x8 aq[2][4]; float wq[2][16];
#pragma unroll
            for (int s = 0; s < 2; ++s) {
                const int qq = 2 * s + ((l31 >> 2) & 1), hd = 4 * (l31 >> 3) + (l31 & 3);
#pragma unroll
                for (int kk = 0; kk < 4; ++kk) aq[s][kk] = *(const bf16x8*)(QI + ((trow0 + qq) * 16 + hd) * 64 + 16 * kk + 8 * hf);
                const float* wp = WI + (trow0 + 2 * s + hf) * 16;
#pragma unroll
                for (int r4 = 0; r4 < 4; ++r4) { const f32x4 w = *(const f32x4*)(wp + 4 * r4); wq[s][4 * r4] = w[0]; wq[s][4 * r4 + 1] = w[1]; wq[s][4 * r4 + 2] = w[2]; wq[s][4 * r4 + 3] = w[3]; }
            }
            float psc0 = 0.f, psc1 = 0.f; int pix0 = 0, pix1 = 0; bool pv0 = false, pv1 = false;
            float thr0 = -INFINITY, thr1 = -INFINITY; int c0 = 0, c1 = 0, c2 = 0, c3 = 0; unsigned b0 = 0x007fffffu, b1 = 0x007fffffu, b2 = 0x007fffffu, b3 = 0x007fffffu;
            const bf16_t* kbase = KIF + (size_t)b * 512 * 4 * 64 * 8 + (size_t)lane * 8;
            bf16x8 k0[4], k1[4], k2[4], k3[4];
#pragma unroll
            for (int kk = 0; kk < 4; ++kk) { k0[kk] = *(const bf16x8*)(kbase + (size_t)(0 * 4 + kk) * 512); k1[kk] = *(const bf16x8*)(kbase + (size_t)((nsteps > 1 ? 1 : 0) * 4 + kk) * 512);
                k2[kk] = *(const bf16x8*)(kbase + (size_t)((nsteps > 2 ? 2 : nsteps - 1) * 4 + kk) * 512); k3[kk] = *(const bf16x8*)(kbase + (size_t)((nsteps > 3 ? 3 : nsteps - 1) * 4 + kk) * 512); }
#define TOPK_STEP(KB, STEP) { const int kidx = 32 * (STEP) + l31; \
    f32x16 a0_, a1_; _Pragma("unroll") for (int r = 0; r < 16; ++r) { a0_[r] = 0.f; a1_[r] = 0.f; } \
    _Pragma("unroll") for (int kk = 0; kk < 4; ++kk) a0_ = __builtin_amdgcn_mfma_f32_32x32x16_bf16(aq[0][kk], KB[kk], a0_, 0, 0, 0); \
    _Pragma("unroll") for (int kk = 0; kk < 4; ++kk) a1_ = __builtin_amdgcn_mfma_f32_32x32x16_bf16(aq[1][kk], KB[kk], a1_, 0, 0, 0); \
    { const int sn_ = (STEP) + 4 < nsteps ? (STEP) + 4 : nsteps - 1; _Pragma("unroll") for (int kk = 0; kk < 4; ++kk) KB[kk] = *(const bf16x8*)(kbase + (size_t)(sn_ * 4 + kk) * 512); }     \
    float sc0_ = 0.f, sc1_ = 0.f; \
    _Pragma("unroll") for (int r = 0; r < 16; ++r) sc0_ = fmaf(wq[0][r], relu1(a0_[r]), sc0_); \
    _Pragma("unroll") for (int r = 0; r < 16; ++r) sc1_ = fmaf(wq[1][r], relu1(a1_[r]), sc1_); \
    const int tql0_ = q0 + 4 * wave + hf; \
    const bool pass0_ = (sc0_ > thr0) && (kidx <= tql0_), pass1_ = (sc1_ > thr1) && (kidx <= tql0_ + 2); \
      \
    if (__ballot((pass0_ && pv0) || (pass1_ && pv1))) { TOPK_FLUSH(); } \
    psc0 = pass0_ ? sc0_ : psc0; pix0 = pass0_ ? kidx : pix0; pv0 = pv0 || pass0_; \
    psc1 = pass1_ ? sc1_ : psc1; pix1 = pass1_ ? kidx : pix1; pv1 = pv1 || pass1_; }
#define TOPK_FLUSH() { const u64 mask0_ = __ballot(pv0), mask1_ = __ballot(pv1); \
        if (mask0_) { const unsigned lo = (unsigned)mask0_, hi = (unsigned)(mask0_ >> 32); const int plo = __popc(lo), phi = __popc(hi); \
          const int rank = mbcnt64(mask0_) - (plo & hfm); const int cm = c0 + ((c1 - c0) & hfm); \
          if (pv0) mybuf[hf * 512 + cm + rank] = ((u64)f2key(psc0) << 32) | (unsigned)pix0; c0 += plo; c1 += phi; } \
        if (mask1_) { const unsigned lo = (unsigned)mask1_, hi = (unsigned)(mask1_ >> 32); const int plo = __popc(lo), phi = __popc(hi); \
          const int rank = mbcnt64(mask1_) - (plo & hfm); const int cm = c2 + ((c3 - c2) & hfm); \
          if (pv1) mybuf[(2 + hf) * 512 + cm + rank] = ((u64)f2key(psc1) << 32) | (unsigned)pix1; c2 += plo; c3 += phi; } \
        pv0 = false; pv1 = false; \
        const int cmx_ = max(max(c0, c1), max(c2, c3)); \
        if (cmx_ > 480) { \
        if (c0 > 480) { b0 = compact_bound(mybuf, c0, lane, b0, c0); const float nt = key2f(b0); thr0 = hf == 0 ? nt : thr0; } \
        if (c1 > 480) { b1 = compact_bound(mybuf + 512, c1, lane, b1, c1); const float nt = key2f(b1); thr0 = hf == 1 ? nt : thr0; } \
        if (c2 > 480) { b2 = compact_bound(mybuf + 1024, c2, lane, b2, c2); const float nt = key2f(b2); thr1 = hf == 0 ? nt : thr1; } \
        if (c3 > 480) { b3 = compact_bound(mybuf + 1536, c3, lane, b3, c3); const float nt = key2f(b3); thr1 = hf == 1 ? nt : thr1; } } }
            for (int st = 0; st < nsteps; st += 4) {
                TOPK_STEP(k0, st);
                if (st + 1 < nsteps) TOPK_STEP(k1, st + 1);
                if (st + 2 < nsteps) TOPK_STEP(k2, st + 2);
                if (st + 3 < nsteps) TOPK_STEP(k3, st + 3);
            }
            TOPK_FLUSH();
#undef TOPK_STEP
#undef TOPK_FLUSH
#pragma unroll
            for (int qi = 0; qi < 4; ++qi) {
                int c = qi == 0 ? c0 : (qi == 1 ? c1 : (qi == 2 ? c2 : c3)); LAS u64* bq = mybuf + qi * 512;
                if (c > 256) { (void)compact256(bq, c, lane); c = 256; }
                LDS_WAIT();
                unsigned short v[4];
#pragma unroll
                for (int j = 0; j < 4; ++j) { const int e = 4 * lane + j; v[j] = e < c ? (unsigned short)(bq[e] & 0xffffull) : (unsigned short)0xffff; }
                u32x2 w; w.x = (unsigned)v[0] | ((unsigned)v[1] << 16); w.y = (unsigned)v[2] | ((unsigned)v[3] << 16);
                *(u32x2*)(SEL + (trow0 + qi) * 256 + 4 * lane) = w;
            }
            LDS_WAIT();
            if constexpr (CONV) { int lane2 = F.lane; asm volatile("" : "+v"(lane2)); const int NGW = F.G * NWAVES, iter = 2 * ((pu - (int)blockIdx.x) / F.G) + half;
                typedef const unsigned char __attribute__((address_space(4))) kab_t;
                kab_t* ka = (kab_t*)__builtin_amdgcn_kernarg_segment_ptr();
                const float* w1 = *(const float* const __attribute__((address_space(4)))*)(ka + 15 * 8); const float* w3 = *(const float* const __attribute__((address_space(4)))*)(ka + 16 * 8);
                const float* w2 = *(const float* const __attribute__((address_space(4)))*)(ka + 17 * 8); unsigned char* ws = *(unsigned char* const __attribute__((address_space(4)))*)(ka + 23 * 8);
#pragma unroll 1
                for (int k = 0; k < TOPK_CONV; ++k) { const int it = F.gw + NGW * (TOPK_CONV * iter + k); if (it < MOE_CONV_ITEMS) moe_conv_item(w1, w3, w2, ws, (LAS float*)mybuf, it, lane2); } }
        }
    }
}

__device__ __forceinline__ bf16x4 tr_read16(const LAS unsigned char* p) { return __builtin_bit_cast(bf16x4, __builtin_amdgcn_ds_read_tr16_b64_v4i16((LAS bf16x4*)p)); }
__device__ __forceinline__ void dsa_attn_phase(const Frame& F, const bf16_t* QLAT, bf16_t* OUT, const bf16_t* QR, const bf16_t* KV, const unsigned short* SEL, const float* w1, const float* w3, const float* w2, unsigned char* ws) {
    LAS unsigned char* wb = F.lds + F.wave * DSA_WBUF; LAS unsigned char* tails = wb + 16640;
    const unsigned char* KVb = (const unsigned char*)KV;
    const int NGW = F.G * NWAVES;
    for (int tg = F.gw; tg < T; tg += NGW) {
        int lane = F.lane; asm volatile("" : "+v"(lane));
        const int l15 = lane & 15, g = lane >> 4;
        const int b = tg >> 14, t = tg & (SEQ - 1); const int nvalid = t + 1 < 256 ? t + 1 : 256, nsteps = (nvalid + 15) >> 4;
        bf16x8 qf[18];
#pragma unroll
        for (int kk = 0; kk < 16; ++kk) {
            if constexpr (F8_LAT) { const u32x2 w8 = *(const u32x2*)((const unsigned char*)QLAT + ((size_t)tg * 16 + l15) * 512 + 32 * kk + 8 * g);
                const f32x2 f0 = __builtin_amdgcn_cvt_pk_f32_fp8((int)w8.x, false), f1 = __builtin_amdgcn_cvt_pk_f32_fp8((int)w8.x, true), f2 = __builtin_amdgcn_cvt_pk_f32_fp8((int)w8.y, false), f3 = __builtin_amdgcn_cvt_pk_f32_fp8((int)w8.y, true);
                u32x4 wb16; wb16.x = cvt_pk_bf16(f0[0], f0[1]); wb16.y = cvt_pk_bf16(f1[0], f1[1]); wb16.z = cvt_pk_bf16(f2[0], f2[1]); wb16.w = cvt_pk_bf16(f3[0], f3[1]); qf[kk] = __builtin_bit_cast(bf16x8, wb16); }
            else qf[kk] = *(const bf16x8*)(QLAT + ((size_t)tg * 16 + l15) * 512 + 32 * kk + 8 * g); }
#pragma unroll
        for (int kk = 0; kk < 2; ++kk) qf[16 + kk] = *(const bf16x8*)(QR + ((size_t)tg * 16 + l15) * 64 + 32 * kk + 8 * g);
        float m = -INFINITY, lsum = 0.f; f32x4 O[32];
#pragma unroll
        for (int mt = 0; mt < 32; ++mt) O[mt] = (f32x4){0.f, 0.f, 0.f, 0.f};
        for (int st = 0; st < nsteps; ++st) {
            const int slot = 16 * st + l15;
            int idx = slot < nvalid ? (int)SEL[(size_t)tg * 256 + slot] : 0; idx = idx > t ? 0 : idx;
            const int row = b * SEQ + idx;
            LDS_WAIT();
#pragma unroll
            for (int r = 0; r < 16; ++r) { const int rr = __builtin_amdgcn_readlane(row, r); glds16(KVb + (size_t)rr * 1152 + 16 * lane, wb + r * 1040); }
#pragma unroll
            for (int p = 0; p < 2; ++p) glds16(KVb + (size_t)row * 1152 + 1024 + 16 * (4 * p + g), tails + 1024 * p);
            VM_WAIT();
            f32x4 sacc = (f32x4){0.f, 0.f, 0.f, 0.f};
#pragma unroll
            for (int kk = 0; kk < 16; ++kk) { const bf16x8 a = *(const LAS bf16x8*)(wb + l15 * 1040 + (4 * kk + g) * 16); sacc = __builtin_amdgcn_mfma_f32_16x16x32_bf16(a, qf[kk], sacc, 0, 0, 0); }
#pragma unroll
            for (int kk = 0; kk < 2; ++kk) { const bf16x8 a = *(const LAS bf16x8*)(tails + (4 * kk + g) * 256 + l15 * 16); sacc = __builtin_amdgcn_mfma_f32_16x16x32_bf16(a, qf[16 + kk], sacc, 0, 0, 0); }
            float s[4]; float tmax = -INFINITY;
#pragma unroll
            for (int i = 0; i < 4; ++i) { s[i] = (16 * st + 4 * g + i) < nvalid ? sacc[i] * (F8_LAT ? SCALE2_MLA / QLAT_F8SCALE : SCALE2_MLA) : -INFINITY; tmax = fmaxf(tmax, s[i]); }
            tmax = fmaxf(tmax, shx(tmax, 16, lane)); tmax = fmaxf(tmax, shx(tmax, 32, lane));
            const float mnew = fmaxf(m, tmax); const float alpha = __builtin_amdgcn_exp2f(m - mnew); m = mnew;
            float p[4];
#pragma unroll
            for (int i = 0; i < 4; ++i) p[i] = __builtin_amdgcn_exp2f(s[i] - mnew);
            lsum = lsum * alpha + ((p[0] + p[1]) + (p[2] + p[3]));
            if (__any(alpha != 1.0f)) {
#pragma unroll
                for (int mt = 0; mt < 32; ++mt) O[mt] = O[mt] * alpha;
            }
            u32x2 pw; pw.x = cvt_pk_bf16(p[0], p[1]); pw.y = cvt_pk_bf16(p[2], p[3]); const bf16x4 pb = __builtin_bit_cast(bf16x4, pw);
            const LAS unsigned char* trb = wb + (4 * g + (l15 >> 2)) * 1040 + (lane & 3) * 8;
#pragma unroll
            for (int mt = 0; mt < 32; ++mt) { const bf16x4 a = tr_read16(trb + mt * 32); O[mt] = __builtin_amdgcn_mfma_f32_16x16x16bf16_1k(a, pb, O[mt], 0, 0, 0); }
        }
        float lt = lsum + shx(lsum, 16, lane); lt += shx(lt, 32, lane); const float inv = 1.0f / lt;
        if constexpr (F8_LAT) { unsigned char* op8 = (unsigned char*)OUT + ((size_t)tg * 16 + l15) * 512 + 4 * g; const float inv8 = inv * OLAT_F8SCALE;
#pragma unroll
            for (int mt = 0; mt < 32; ++mt) *(unsigned*)(op8 + 16 * mt) = pk4_fp8(O[mt][0] * inv8, O[mt][1] * inv8, O[mt][2] * inv8, O[mt][3] * inv8); }
        else { bf16_t* op = OUT + ((size_t)tg * 16 + l15) * 512 + 4 * g;
#pragma unroll
        for (int mt = 0; mt < 32; ++mt) { u32x2 w; w.x = cvt_pk_bf16(O[mt][0] * inv, O[mt][1] * inv); w.y = cvt_pk_bf16(O[mt][2] * inv, O[mt][3] * inv); *(u32x2*)(op + 16 * mt) = w; } }
        if (w1) { LDS_WAIT(); int lane2 = F.lane; asm volatile("" : "+v"(lane2));
            for (int k = 0; k < 3; ++k) { const int it = F.gw + NGW * (3 * ((tg - F.gw) / NGW) + k); if (it < MOE_CONV_ITEMS) moe_conv_item(w1, w3, w2, ws, (LAS float*)wb, it, lane2); } }
    }
    LDS_WAIT();
}

__device__ __forceinline__ long tr_read8(const LAS unsigned char* p) { return __builtin_bit_cast(long, __builtin_amdgcn_ds_read_tr8_b64_v2i32((LAS i32x2*)p)); }
__device__ __forceinline__ void dsa_attn8_phase(const Frame& F, const unsigned char* QLAT, unsigned char* OUT, const unsigned char* QR, const unsigned char* KVb, const unsigned short* SEL, const float* w1, const float* w3, const float* w2, unsigned char* ws) {
    LAS unsigned char* wb = F.lds + F.wave * DSA_WBUF; LAS unsigned char* tails = wb + 16640;
    const int NGW = F.G * NWAVES;
    for (int tg = F.gw; tg < T; tg += NGW) {
        int lane = F.lane; asm volatile("" : "+v"(lane));
        const int l15 = lane & 15, g = lane >> 4;
        const int b = tg >> 14, t = tg & (SEQ - 1); const int nvalid = t + 1 < 256 ? t + 1 : 256, nsteps = (nvalid + 31) >> 5;
        i32x8 qf[5];
        { const unsigned char* qp = QLAT + ((size_t)tg * 16 + l15) * 512 + 32 * g;
#pragma unroll
          for (int kk = 0; kk < 4; ++kk) { const i32x4 lo = *(const i32x4*)(qp + 128 * kk), hi = *(const i32x4*)(qp + 128 * kk + 16); qf[kk] = (i32x8){lo[0], lo[1], lo[2], lo[3], hi[0], hi[1], hi[2], hi[3]}; }
          const i32x4 r = *(const i32x4*)(QR + ((size_t)tg * 16 + l15) * 64 + 16 * g); qf[4] = (i32x8){r[0], r[1], r[2], r[3], 0, 0, 0, 0}; }
        float m = -INFINITY, lsum = 0.f; f32x4 O[32];
#pragma unroll
        for (int mt = 0; mt < 32; ++mt) O[mt] = (f32x4){0.f, 0.f, 0.f, 0.f};
        const int dtau = (lane >> 2) & 1, dch = 16 * (4 * (lane >> 3) + (lane & 3));
        int s0, s1, s2, s3, s4, s5, s6, s7;
        { const unsigned short* sp = SEL + (size_t)tg * 256 + (lane & 31); const int l31 = lane & 31;
          s0 = l31 < nvalid ? (int)sp[0] : 0; s1 = 32 + l31 < nvalid ? (int)sp[32] : 0; s2 = 64 + l31 < nvalid ? (int)sp[64] : 0; s3 = 96 + l31 < nvalid ? (int)sp[96] : 0;
          s4 = 128 + l31 < nvalid ? (int)sp[128] : 0; s5 = 160 + l31 < nvalid ? (int)sp[160] : 0; s6 = 192 + l31 < nvalid ? (int)sp[192] : 0; s7 = 224 + l31 < nvalid ? (int)sp[224] : 0; }
        for (int st = 0; st < nsteps; ++st) {
            int idx = s0; s0 = s1; s1 = s2; s2 = s3; s3 = s4; s4 = s5; s5 = s6; s6 = s7; idx = idx > t ? 0 : idx;
            const int row = b * SEQ + idx;
            LDS_WAIT();
#pragma unroll
            for (int p = 0; p < 16; ++p) { const int r0 = __builtin_amdgcn_readlane(row, p), r1 = __builtin_amdgcn_readlane(row, 16 + p); const int rr = dtau ? r1 : r0;
                glds16(KVb + (size_t)rr * 576 + dch, wb + p * 1040); }
#pragma unroll
            for (int p = 0; p < 2; ++p) glds16(KVb + (size_t)row * 576 + 512 + 16 * (2 * p + (lane >> 5)), tails + 1024 * p);
            VM_WAIT();
            f32x4 sacc[2] = {(f32x4){0.f, 0.f, 0.f, 0.f}, (f32x4){0.f, 0.f, 0.f, 0.f}};
            const LAS unsigned char* sb = wb + l15 * 1040 + 16 * (8 * (g >> 1) + 2 * (g & 1));
#pragma unroll
            for (int kk = 0; kk < 4; ++kk)
#pragma unroll
                for (int tu = 0; tu < 2; ++tu) { const i32x4 lo = *(const LAS i32x4*)(sb + 256 * kk + 64 * tu), hi = *(const LAS i32x4*)(sb + 256 * kk + 64 * tu + 16);
                    const i32x8 a = (i32x8){lo[0], lo[1], lo[2], lo[3], hi[0], hi[1], hi[2], hi[3]};
                    sacc[tu] = __builtin_amdgcn_mfma_scale_f32_16x16x128_f8f6f4(a, qf[kk], sacc[tu], 0, 0, 0, 0, 0, 0); }
#pragma unroll
            for (int tu = 0; tu < 2; ++tu) { const i32x4 lo = *(const LAS i32x4*)(tails + (g * 32 + 16 * tu + l15) * 16);
                const i32x8 a = (i32x8){lo[0], lo[1], lo[2], lo[3], 0, 0, 0, 0};
                sacc[tu] = __builtin_amdgcn_mfma_scale_f32_16x16x128_f8f6f4(a, qf[4], sacc[tu], 0, 0, 0, 0, 0, 0); }
            float s[8]; float tmax = -INFINITY;
#pragma unroll
            for (int tu = 0; tu < 2; ++tu)
#pragma unroll
                for (int i = 0; i < 4; ++i) { s[4 * tu + i] = (32 * st + 16 * tu + 4 * g + i) < nvalid ? sacc[tu][i] * (SCALE2_MLA / (QLAT_F8SCALE * KV_F8SCALE)) : -INFINITY; tmax = fmaxf(tmax, s[4 * tu + i]); }
            tmax = fmaxf(tmax, shx(tmax, 16, lane)); tmax = fmaxf(tmax, shx(tmax, 32, lane));
            if (__any(tmax > m + 0.75f)) {
                const float mnew = fmaxf(m, tmax); const float alpha = __builtin_amdgcn_exp2f(m - mnew); m = mnew; lsum *= alpha;
#pragma unroll
                for (int mt = 0; mt < 32; ++mt) O[mt] = O[mt] * alpha;
            }
            const float mo = m - 8.0f;
            float p[8];
#pragma unroll
            for (int i = 0; i < 8; ++i) p[i] = __builtin_amdgcn_exp2f(s[i] - mo);
            lsum += (((p[0] + p[1]) + (p[2] + p[3])) + ((p[4] + p[5]) + (p[6] + p[7])));
            u32x2 pw; pw.x = pk4_fp8(p[0], p[1], p[2], p[3]); pw.y = pk4_fp8(p[4], p[5], p[6], p[7]); const long pb = __builtin_bit_cast(long, pw);
            const LAS unsigned char* trb = wb + (4 * g + ((l15 >> 1) & 3)) * 1040 + 64 * (l15 >> 3) + 8 * (l15 & 1);
#pragma unroll
            for (int mt = 0; mt < 32; ++mt) { const long a = tr_read8(trb + 128 * (mt >> 2) + 16 * (mt & 3)); O[mt] = __builtin_amdgcn_mfma_f32_16x16x32_fp8_fp8(a, pb, O[mt], 0, 0, 0); }
        }
        float lt = lsum + shx(lsum, 16, lane); lt += shx(lt, 32, lane); const float inv8 = (OLAT_F8SCALE / KV_F8SCALE) / lt;
        unsigned char* op8 = OUT + ((size_t)tg * 16 + l15) * 512 + 4 * g;
#pragma unroll
        for (int mt = 0; mt < 32; ++mt) *(unsigned*)(op8 + 16 * mt) = pk4_fp8(O[mt][0] * inv8, O[mt][1] * inv8, O[mt][2] * inv8, O[mt][3] * inv8);
        if (w1) { LDS_WAIT(); int lane2 = F.lane; asm volatile("" : "+v"(lane2));
            for (int k = 0; k < 3; ++k) { const int it = F.gw + NGW * (3 * ((tg - F.gw) / NGW) + k); if (it < MOE_CONV_ITEMS) moe_conv_item(w1, w3, w2, ws, (LAS float*)wb, it, lane2); } }
    }
    LDS_WAIT();
}

__device__ __forceinline__ void ln_router_phase(const Frame& F, const bf16_t* YH, bf16_t* XB, const float* g, const float* bb, const float* wr, int* TOKE, float* TOKG, int* TOKL) {
    LAS float* wl = (LAS float*)F.lds;
    for (int i = F.tid; i < DM * NEXP; i += NTHREADS) { const int d = i >> 3, e = i & 7; wl[e * DM + d] = wr[i]; }
    __syncthreads();
    const int NGW = F.G * NWAVES, lane = F.lane;
    u64 cnt64 = 0ull; int mine = 0;
    int j = 0;
    for (int m = F.gw; m < T; m += NGW, ++j) { f32x4 v[8];
        ln_load16(v, YH + (size_t)m * DM, lane); ln_core(v, g, bb, lane); ln_store8(v, (unsigned char*)XB + (size_t)m * DM, lane);
        float lg[8];
#pragma unroll
        for (int e = 0; e < 8; ++e) { float s = 0.f;
#pragma unroll
            for (int q = 0; q < 8; ++q) { const f32x4 w = *(const LAS f32x4*)(wl + e * DM + ln_col(lane, q)); s += (v[q][0] * w[0] + v[q][1] * w[1]) + (v[q][2] * w[2] + v[q][3] * w[3]); }
            lg[e] = wave_sum(s); }
        int e1 = 0; float v1 = lg[0];
#pragma unroll
        for (int e = 1; e < 8; ++e) if (lg[e] > v1) { v1 = lg[e]; e1 = e; }
        int e2 = -1; float v2 = -INFINITY;
#pragma unroll
        for (int e = 0; e < 8; ++e) if (e != e1 && lg[e] > v2) { v2 = lg[e]; e2 = e; }
        const float g1 = 1.0f / (1.0f + __expf(v2 - v1)), g2 = 1.0f - g1;
        const int r1 = (int)((cnt64 >> (8 * e1)) & 0xffull); cnt64 += 1ull << (8 * e1);
        const int r2 = (int)((cnt64 >> (8 * e2)) & 0xffull); cnt64 += 1ull << (8 * e2);
        if (lane == 0) { TOKE[2 * m] = e1; TOKE[2 * m + 1] = e2; TOKG[2 * m] = g1; TOKG[2 * m + 1] = g2; }
        if (lane == j) mine = e1 | (e2 << 4) | (r1 << 8) | (r2 << 16);
    }
    int basev = 0;
    if (lane < 8) { const unsigned c = (unsigned)((cnt64 >> (8 * lane)) & 0xffull); basev = (int)__hip_atomic_fetch_add(F.ctl + CW_CNT + lane, c, __ATOMIC_RELAXED, __HIP_MEMORY_SCOPE_AGENT); }
    const int e1 = mine & 15, e2 = (mine >> 4) & 15, r1 = (mine >> 8) & 255, r2 = (mine >> 16) & 255;
    const int b1 = __builtin_amdgcn_ds_bpermute(e1 << 2, basev), b2 = __builtin_amdgcn_ds_bpermute(e2 << 2, basev);
    if (lane < j) { const int m = F.gw + NGW * lane; TOKL[2 * m] = b1 + r1; TOKL[2 * m + 1] = b2 + r2; }
    __syncthreads();
}
__device__ __forceinline__ void moe_tiles(const Frame& F) {
    if (F.tid == 0) { int acc = 0;
        for (int e = 0; e < 8; ++e) { const unsigned c = __hip_atomic_load(F.ctl + CW_CNT + e, __ATOMIC_RELAXED, __HIP_MEMORY_SCOPE_AGENT); F.MISC[32 + e] = c; F.MISC[40 + e] = (unsigned)acc; acc += (int)((c + 255u) >> 8); F.MISC[20 + e] = (unsigned)acc; }
        F.MISC[28] = (unsigned)acc; }
    __syncthreads();
}
__device__ __forceinline__ void moe_gather_phase(const Frame& F, const bf16_t* XB, const int* TOKE, const float* TOKG, const int* TOKL, int* TOKS, float* SGATE, bf16_t* XG) {
    const int NGW = F.G * NWAVES, lane = F.lane;
    for (int m = F.gw; m < T; m += NGW) {
        const u32x4* src = (const u32x4*)((const unsigned char*)XB + (size_t)m * DM);
        const u32x4 a0 = src[lane], a1 = src[64 + lane];
#pragma unroll
        for (int k = 0; k < 2; ++k) { const int e = TOKE[2 * m + k], li = TOKL[2 * m + k]; const int slot = (int)F.MISC[40 + e] * 256 + li;
            u32x4* dst = (u32x4*)((unsigned char*)XG + (size_t)slot * DM); dst[lane] = a0; dst[64 + lane] = a1;
            if (lane == 0) { TOKS[2 * m + k] = slot; SGATE[slot] = TOKG[2 * m + k]; } }
    }
    for (int it = F.gw; it < 8 * 256; it += NGW) { const int e = it >> 8, r = it & 255; const int c = (int)F.MISC[32 + e]; const int ntile = (c + 255) >> 8; const int row = c + r;
        if (row < ntile * 256) { const int slot = (int)F.MISC[40 + e] * 256 + row; u32x4* dst = (u32x4*)((unsigned char*)XG + (size_t)slot * DM); const u32x4 z = {0u, 0u, 0u, 0u};
            dst[lane] = z; dst[64 + lane] = z; if (lane == 0) SGATE[slot] = 0.f; } }
}
__device__ __forceinline__ void moe_combine_ln_phase(const Frame& F, const bf16_t* YH, bf16_t* XB, unsigned char* X8, const bf16_t* SOUT, const int* TOKS, const float* g1, const float* bb1, const float* g, const float* bb) {
    const int NGW = F.G * NWAVES, lane = F.lane;
    for (int m = F.gw; m < T; m += NGW) { f32x4 v[8];
        const int t0 = __builtin_amdgcn_readfirstlane(TOKS[2 * m]), t1 = __builtin_amdgcn_readfirstlane(TOKS[2 * m + 1]);
        const bf16_t* s0 = SOUT + (size_t)t0 * DM; const bf16_t* s1 = SOUT + (size_t)t1 * DM;
        ln_load16(v, YH + (size_t)m * DM, lane);
        ln_core(v, g1, bb1, lane);
#pragma unroll
        for (int j = 0; j < 4; ++j) { f32x4 a0, a1, c0, c1; pg8::unpack8(*(const u32x4*)(s0 + ln_col(lane, 2 * j)), a0, a1); pg8::unpack8(*(const u32x4*)(s1 + ln_col(lane, 2 * j)), c0, c1);
            v[2 * j] = v[2 * j] * ALPHA + (a0 + c0); v[2 * j + 1] = v[2 * j + 1] * ALPHA + (a1 + c1); }
        ln_core(v, g, bb, lane); ln_store16(v, XB + (size_t)m * DM, lane); if constexpr (F8_G1) { int ls = lane; asm volatile("" : "+v"(ls)); ln_store8(v, X8 + (size_t)m * DM, ls); } }
}

#ifndef PHASES
#define PHASES 0xFFFFFFFFu
#endif
#define PH(k) if constexpr ((PHASES >> (k)) & 1u)
#ifndef DBL
#define DBL 0u
#endif
#define DB(k) if constexpr ((DBL >> (k)) & 1u)
__global__ void __launch_bounds__(NTHREADS, 2) mega_fwd(Args args) {
    extern __shared__ __attribute__((aligned(16))) unsigned char lds_raw[];
    Frame F;
    F.lds = (LAS unsigned char*)lds_raw; F.MISC = (volatile LAS unsigned*)(F.lds + MISC_OFF);
    F.tid = threadIdx.x; F.lane = F.tid & 63; F.wave = __builtin_amdgcn_readfirstlane(F.tid >> 6); F.gw = blockIdx.x * NWAVES + F.wave;
    unsigned char* ws = args.ws;
    F.ctl = (unsigned*)(ws + WS_CTL);
    if (F.tid < 64) F.MISC[F.tid] = 0u;
    __syncthreads();
    XcdBarrier bar = xcd_barrier_post(F.ctl + CW_BAR, F.MISC + 8);
#define REFRESH() do { F.lane = fresh_lane(); F.tid = F.wave * 64 + F.lane; } while (0)
#define GRID_BAR() do { xcd_barrier(bar, F.wave); REFRESH(); } while (0)
#define YH ((bf16_t*)args.out)
#define bx ((int)blockIdx.x)
#define WSP(T_, off) ((T_*)(ws + (off)))

    PH(0) {
        { LAS float* scr = (LAS float*)(F.lds + F.wave * 16384);
          constexpr int I_QKV = 32 * 40, I_SQ = 32 * 32, I_W13 = 32 * 88, I_W2 = 88 * 32, I_WP = 4 * 32, I_WIN = 32 * 75, I_WUV = 256;
          constexpr int I_TOTAL = I_QKV + I_SQ + 2 * I_W13 + I_W2 + 2 * I_SQ + 2 * I_WP + (F8_WIN_SPLIT ? 2 : 1) * I_WIN + I_SQ + I_WUV;
          for (int it = F.gw; it < I_TOTAL; it += F.G * NWAVES) {
              int r = it; bool hit = false; const float* W = nullptr; int N = 0, ldo = 0, kofs = 0, mode = 0, rlo = 0, rhi = 1 << 30; unsigned char* WT = nullptr; float f8 = 0.f;
#define PSEG(cnt, Wp, Nn, WTp, ld, md, f8v, lo, hi) if (!hit) { if (r < (cnt)) { W = (Wp); N = (Nn); WT = (unsigned char*)(WTp); ldo = (ld); mode = (md); f8 = (f8v); rlo = (lo); rhi = (hi); hit = true; } else r -= (cnt); }
              PSEG(I_QKV, (const float*)args.in[3], NQKV, ws + WS_WQKV, DM, 1, F8_QKV ? WQKV_F8SCALE : 0.f, 0, 1 << 30)
              PSEG(I_SQ, (const float*)args.in[5], DM, ws + WS_WO0, DM, 0, F8_WO0 ? WO_F8SCALE : 0.f, 0, 1 << 30)
              PSEG(I_W13, (const float*)args.in[6], FFN, ws + WS_W13, DM, 2, F8_FFN1 ? W13_F8SCALE : 0.f, 0, 1 << 30)
              PSEG(I_W13, (const float*)args.in[7], FFN, ws + WS_W13, DM, 3, F8_FFN1 ? W13_F8SCALE : 0.f, 0, 1 << 30)
              PSEG(I_W2, (const float*)args.in[8], DM, ws + WS_W2, FFN, 0, F8_FFN2 ? W2_F8SCALE : 0.f, 0, 1 << 30)
              PSEG(I_SQ, (const float*)args.in[21], DM, ws + WS_WG0, DM, 0, F8_G0 ? WO_F8SCALE : 0.f, 0, 1 << 30)
              PSEG(I_SQ, (const float*)args.in[21] + (size_t)DM * DM, DM, ws + WS_WG1, DM, 0, F8_G1 ? WO_F8SCALE : 0.f, 0, 1 << 30)
              PSEG(I_WP, (const float*)args.in[20], DM, ws + WS_WP0, 256, 0, 0.f, 0, 1 << 30)
              PSEG(I_WP, (const float*)args.in[20] + (size_t)256 * DM, DM, ws + WS_WP1, 256, 0, 0.f, 0, 1 << 30)
              if constexpr (F8_WIN_SPLIT) { PSEG(I_WIN, (const float*)args.in[9], 4752, ws + WS_WIN8, DM, 4, WIN_F8SCALE, 0, WIN_F8_TILES * 256)
                                            PSEG(I_WIN, (const float*)args.in[9], 4752, ws + WS_WIN, DM, 4, 0.f, WIN_F8_TILES * 256, NWIN) }
              else { PSEG(I_WIN, (const float*)args.in[9], 4752, ws + WS_WIN, DM, 4, F8_WIN ? WIN_F8SCALE : 0.f, 0, 1 << 30) }
              PSEG(I_SQ, (const float*)args.in[13], DM, ws + WS_WO1, DM, 0, F8_WO1 ? WO_F8SCALE : 0.f, 0, 1 << 30)
              if (!hit) { const int h = r >> 4; r &= 15;
                  W = (const float*)args.in[12] + (size_t)h * 512 * 128; N = 128; WT = ws + WS_WUV + (size_t)h * 128 * 1024 * (F8_LAT ? 1 : 2); ldo = 1024; kofs = 512 * (h & 1); f8 = F8_LAT ? WUV_F8SCALE : 0.f; }
#undef PSEG
              tr_item(W, N, (bf16_t*)WT, ldo, kofs, mode, scr, r, F.lane, f8, rlo, rhi); } }
        { bf16_t* wuv = WSP(bf16_t, WS_WUV); const u32x4 z = {0u, 0u, 0u, 0u};
          for (int i = bx * NTHREADS + F.tid; i < 2048 * 64; i += F.G * NTHREADS) { const int n = i >> 6, c8 = i & 63; const int h = n >> 7;
              if constexpr (F8_LAT) { if (c8 < 32) *(u32x4*)((unsigned char*)wuv + (size_t)n * 1024 + 512 * ((h & 1) ^ 1) + 16 * c8) = z; }
              else *(u32x4*)(wuv + (size_t)n * 1024 + 512 * ((h & 1) ^ 1) + 8 * c8) = z; } }
        cvt_linear(F, (const float*)args.in[11], WSP(bf16_t, WS_WUK), (size_t)16 * 512 * 128 / 8);
        if constexpr (F8_QKV) cvt_linear8(F, (const float*)args.in[0], WSP(unsigned char, WS_XBA), (size_t)T * DM / 8); else cvt_linear(F, (const float*)args.in[0], WSP(bf16_t, WS_XBA), (size_t)T * DM / 8);
        cvt_linear(F, (const float*)args.in[1], WSP(bf16_t, WS_PB), (size_t)2 * T * 256 / 8);
        rope_tables(F, (const int*)args.in[2], WSP(float, WS_TAB64), WSP(float, WS_TAB32));
    }
    GRID_BAR();
    PH(1) {
        constexpr int KD = F8_QKV ? DM / 2 : DM;
        pg8::Gemm g{WSP(bf16_t, WS_XBA), WSP(bf16_t, WS_WQKV), KD, KD, KD}; pg8::GridOrder<0, T / 256, NQKV / 256> S;
        pg8::EpiQKV E{ws, F8_QKV ? 1.0f / WQKV_F8SCALE : 1.0f}; pg8::gemm_phase<pg8::EpiQKV, pg8::GridOrder<0, T / 256, NQKV / 256>, F8_QKV>(F.lds, g, S, E, F.wave);
    }
    GRID_BAR();
    PH(2) swa_phase<F8_WO0>(F, WSP(bf16_t, WS_Q), WSP(bf16_t, WS_K), WSP(bf16_t, WS_VT), (const float*)args.in[4], WSP(unsigned char, WS_O8));
    GRID_BAR();
    PH(3) {
        constexpr int KD = F8_WO0 ? DM / 2 : DM;
        pg8::Gemm g{F8_WO0 ? WSP(bf16_t, WS_O8) : WSP(bf16_t, WS_Q), WSP(bf16_t, WS_WO0), KD, KD, KD}; pg8::GridOrder<0, T / 256, DM / 256> S;
        pg8::EpiRes<false> E{args.in[0], YH, F8_WO0 ? 1.0f / (O0_F8SCALE * WO_F8SCALE) : 1.0f}; pg8::gemm_phase<pg8::EpiRes<false>, pg8::GridOrder<0, T / 256, DM / 256>, F8_WO0, EPI_ALIGN_RES>(F.lds, g, S, E, F.wave);
    }
    GRID_BAR();
    PH(4) ln_phase<F8_FFN1>(F, YH, WSP(bf16_t, WS_XBB), WSP(unsigned char, WS_XBA), (const float*)args.in[18], (const float*)args.in[19]);
    GRID_BAR();
    PH(5) {
        constexpr int KD = F8_FFN1 ? DM / 2 : DM;
        pg8::Gemm g{F8_FFN1 ? WSP(bf16_t, WS_XBA) : WSP(bf16_t, WS_XBB), WSP(bf16_t, WS_W13), KD, KD, KD}; pg8::GridOrder<0, T / 256, 2 * FFN / 256> S;
        pg8::EpiSwiglu<F8_FFN2> E{WSP(bf16_t, WS_ACT), FFN, F8_FFN1 ? 1.0f / W13_F8SCALE : 1.0f, ACT_F8SCALE}; pg8::gemm_phase<pg8::EpiSwiglu<F8_FFN2>, pg8::GridOrder<0, T / 256, 2 * FFN / 256>, F8_FFN1>(F.lds, g, S, E, F.wave);
    }
    GRID_BAR();
    PH(6) {
        constexpr int KD = F8_FFN2 ? FFN / 2 : FFN;
        pg8::Gemm g{WSP(bf16_t, WS_ACT), WSP(bf16_t, WS_W2), KD, KD, KD}; pg8::GridOrder<0, T / 256, DM / 256> S;
        pg8::EpiRes<true> E{WSP(bf16_t, WS_XBB), YH, F8_FFN2 ? 1.0f / (ACT_F8SCALE * W2_F8SCALE) : 1.0f}; pg8::gemm_phase<pg8::EpiRes<true>, pg8::GridOrder<0, T / 256, DM / 256>, F8_FFN2, EPI_ALIGN_RES>(F.lds, g, S, E, F.wave);
    }
    GRID_BAR();
    PH(7) ln_phase<F8_G0>(F, YH, WSP(bf16_t, WS_XBA), F8_G0 ? WSP(unsigned char, WS_X28) : nullptr, (const float*)args.in[18] + DM, (const float*)args.in[19] + DM);
    REFRESH();
    PH(7) {
        pg8::Gemm g{WSP(bf16_t, WS_PB), WSP(bf16_t, WS_WP0), 256, 256, 256}; pg8::GridOrder<0, T / 256, DM / 256> S;
        pg8::EpiBf16<false> E{WSP(bf16_t, WS_PP0), DM, 1.0f}; pg8::gemm_phase(F.lds, g, S, E, F.wave);
    }
    GRID_BAR();
    PH(8) {
        constexpr int K2 = F8_G0 ? DM / 2 : DM;
        pg8::Gemm g{F8_G0 ? WSP(bf16_t, WS_X28) : WSP(bf16_t, WS_XBA), WSP(bf16_t, WS_WG0), K2, K2, K2}; pg8::GridOrder<0, T / 256, DM / 256> S;
        pg8::EpiPle E{nullptr, ws, 0, F8_G0 ? -LOG2E / WO_F8SCALE : -LOG2E}; pg8::gemm_phase<pg8::EpiPle, pg8::GridOrder<0, T / 256, DM / 256>, F8_G0, EPI_ALIGN_RES>(F.lds, g, S, E, F.wave);
    }
    GRID_BAR();
    PH(9) {
        if constexpr (F8_WIN_SPLIT) {
            { static_assert((T / 256) * WIN_F8_TILES == 7 * pg8::GRID && (T / 256) * (NWIN / 256 - WIN_F8_TILES) == 5 * pg8::GRID / 2, "uneven deal: 7 rounds of e4m3 units, 2.5 rounds of bf16 units");
              pg8::Gemm g{WSP(bf16_t, WS_XB8), WSP(bf16_t, WS_WIN8), DM / 2, DM / 2, DM / 2}; pg8::GridOrder<4, T / 256, WIN_F8_TILES> S;
              pg8::EpiWin E{ws, 1.0f / WIN_F8SCALE, 0}; pg8::gemm_phase<pg8::EpiWin, pg8::GridOrder<4, T / 256, WIN_F8_TILES>, true>(F.lds, g, S, E, F.wave); }
            REFRESH();
            { pg8::Gemm g{WSP(bf16_t, WS_XBB), WSP(bf16_t, WS_WIN) + (size_t)WIN_F8_TILES * 256 * DM, DM, DM, DM}; pg8::GridOrder<0, T / 256, NWIN / 256 - WIN_F8_TILES> S;
              pg8::EpiWin E{ws, 1.0f, WIN_F8_TILES}; pg8::gemm_phase<pg8::EpiWin, pg8::GridOrder<0, T / 256, NWIN / 256 - WIN_F8_TILES>, false>(F.lds, g, S, E, F.wave); }
        } else {
        constexpr int KD = F8_WIN ? DM / 2 : DM;
        pg8::Gemm g{WSP(bf16_t, WS_XBB), WSP(bf16_t, WS_WIN), KD, KD, KD}; pg8::GridOrder<0, T / 256, NWIN / 256> S;
        pg8::EpiWin E{ws, F8_WIN ? 1.0f / WIN_F8SCALE : 1.0f, 0}; pg8::gemm_phase<pg8::EpiWin, pg8::GridOrder<0, T / 256, NWIN / 256>, F8_WIN>(F.lds, g, S, E, F.wave);
        }
    }
    GRID_BAR();
    PH(10) kvnorm_phase(F, WSP(float, WS_CRAW), (const float*)args.in[10], WSP(bf16_t, WS_KV));
    REFRESH();
    PH(11) {
        pg8::Gemm g{WSP(bf16_t, WS_QN), WSP(bf16_t, WS_WUK), DM, 128, 128}; pg8::GridOrder<1, T / 256, 8192 / 256> S;
        pg8::EpiBf16<F8_LAT> E{WSP(bf16_t, WS_QLAT), 8192, F8_LAT ? QLAT_F8SCALE : 1.0f}; pg8::gemm_phase(F.lds, g, S, E, F.wave);
    }
    REFRESH();
    DB(12) { topk_phase(F, WSP(bf16_t, WS_QI), WSP(bf16_t, WS_KIF), WSP(float, WS_WI), WSP(unsigned short, WS_SEL)); REFRESH(); }
    PH(12) topk_phase<true>(F, WSP(bf16_t, WS_QI), WSP(bf16_t, WS_KIF), WSP(float, WS_WI), WSP(unsigned short, WS_SEL));
    GRID_BAR();
    PH(13) { if constexpr (F8_KV && F8_LAT) dsa_attn8_phase(F, WSP(unsigned char, WS_QLAT), WSP(unsigned char, WS_QLAT), WSP(unsigned char, WS_QR), WSP(unsigned char, WS_KV), WSP(unsigned short, WS_SEL), nullptr, nullptr, nullptr, ws);
             else dsa_attn_phase(F, WSP(bf16_t, WS_QLAT), WSP(bf16_t, WS_QLAT), WSP(bf16_t, WS_QR), WSP(bf16_t, WS_KV), WSP(unsigned short, WS_SEL), (const float*)args.in[15], (const float*)args.in[16], (const float*)args.in[17], ws); }
    GRID_BAR();
    PH(14) {
        constexpr float dsc = F8_LAT ? 1.0f / (OLAT_F8SCALE * WUV_F8SCALE) : 1.0f;
        pg8::Gemm g{WSP(bf16_t, WS_QLAT), WSP(bf16_t, WS_WUV), F8_LAT ? 4096 : 8192, F8_LAT ? 512 : 1024, F8_LAT ? 512 : 1024}; pg8::GridOrder<F8_LAT ? 3 : 2, T / 256, DM / 256> S;
        pg8::EpiBf16<F8_WO1> E{WSP(bf16_t, WS_O2), DM, (F8_WO1 ? O2_F8SCALE : 1.0f) * dsc}; pg8::gemm_phase<pg8::EpiBf16<F8_WO1>, pg8::GridOrder<F8_LAT ? 3 : 2, T / 256, DM / 256>, F8_LAT>(F.lds, g, S, E, F.wave);
    }
    GRID_BAR();
    PH(15) {
        constexpr int KD = F8_WO1 ? DM / 2 : DM;
        pg8::Gemm g{WSP(bf16_t, WS_O2), WSP(bf16_t, WS_WO1), KD, KD, KD}; pg8::GridOrder<0, T / 256, DM / 256> S;
        pg8::EpiRes<true> E{WSP(bf16_t, WS_XBB), YH, F8_WO1 ? 1.0f / (O2_F8SCALE * WO_F8SCALE) : 1.0f}; pg8::gemm_phase<pg8::EpiRes<true>, pg8::GridOrder<0, T / 256, DM / 256>, F8_WO1, EPI_ALIGN_RES>(F.lds, g, S, E, F.wave);
    }
    GRID_BAR();
    PH(16) ln_router_phase(F, YH, WSP(bf16_t, WS_XBA), (const float*)args.in[18] + 2 * DM, (const float*)args.in[19] + 2 * DM, (const float*)args.in[14], WSP(int, WS_TOKE), WSP(float, WS_TOKG), WSP(int, WS_TOKL));
    REFRESH();
    GRID_BAR();
    PH(18) moe_tiles(F);
    REFRESH();
    PH(18) moe_gather_phase(F, WSP(bf16_t, WS_XBA), WSP(int, WS_TOKE), WSP(float, WS_TOKG), WSP(int, WS_TOKL), WSP(int, WS_TOKS), WSP(float, WS_SGATE), WSP(bf16_t, WS_XG));
    GRID_BAR();
    PH(19) {
        const int NTL = __builtin_amdgcn_readfirstlane((int)F.MISC[28]);
        {
            pg8::MoeOrder<false, 2 * MFFN / 256> S; S.tile0 = 0; S.ntl = NTL;
            pg8::Gemm g{WSP(bf16_t, WS_XG), WSP(bf16_t, WS_MW13), DM / 2, DM / 2, DM / 2};
            pg8::EpiSwiglu<true> E{WSP(bf16_t, WS_ACT2), MFFN, 1.0f / W13_F8SCALE, ACT_F8SCALE}; pg8::gemm_phase<pg8::EpiSwiglu<true>, pg8::MoeOrder<false, 2 * MFFN / 256>, true>(F.lds, g, S, E, F.wave);
        }
        GRID_BAR();
        {
            pg8::MoeOrder<true, DM / 256> S; S.tile0 = 0; S.ntl = NTL;
            pg8::Gemm g{WSP(bf16_t, WS_ACT2), WSP(bf16_t, WS_MW2), MFFN / 2, MFFN / 2, MFFN / 2};
            pg8::EpiMoeDown E{ws}; pg8::gemm_phase<pg8::EpiMoeDown, pg8::MoeOrder<true, DM / 256>, true>(F.lds, g, S, E, F.wave);
        }
        REFRESH();
        {
            pg8::GridOrderSkip<T / 256, DM / 256> S; S.skip = (NTL * (DM / 256)) % pg8::GRID;
            pg8::Gemm g{WSP(bf16_t, WS_PB) + (size_t)T * 256, WSP(bf16_t, WS_WP1), 256, 256, 256};
            pg8::EpiBf16<false> E{WSP(bf16_t, WS_PP1), DM, 1.0f}; pg8::gemm_phase(F.lds, g, S, E, F.wave);
        }
        GRID_BAR();
    }
    PH(20) moe_combine_ln_phase(F, YH, WSP(bf16_t, WS_XBB), WSP(unsigned char, WS_X58), WSP(bf16_t, WS_SOUT), WSP(int, WS_TOKS), (const float*)args.in[18] + 2 * DM, (const float*)args.in[19] + 2 * DM, (const float*)args.in[18] + 3 * DM, (const float*)args.in[19] + 3 * DM);
    GRID_BAR();
    PH(21) {
        constexpr int K2 = F8_G1 ? DM / 2 : DM;
        pg8::Gemm g{F8_G1 ? WSP(bf16_t, WS_X58) : WSP(bf16_t, WS_XBB), WSP(bf16_t, WS_WG1), K2, K2, K2}; pg8::GridOrder<0, T / 256, DM / 256> S;
        pg8::EpiPle E{args.out, ws, 1, F8_G1 ? -LOG2E / WO_F8SCALE : -LOG2E}; pg8::gemm_phase<pg8::EpiPle, pg8::GridOrder<0, T / 256, DM / 256>, F8_G1, EPI_ALIGN_RES>(F.lds, g, S, E, F.wave);
    }
}

#undef YH
#undef bx
extern "C" void kernel_launch(void* const* d_in, const int* in_sizes, int n_in, void* d_out, int out_size, void* d_ws, size_t ws_size, hipStream_t stream) {
    static int grid = 0;
    if (grid == 0) {
        if (n_in != 22 || out_size != T * DM || ws_size < WS_END) { fprintf(stderr, "kernel_launch: unexpected problem (n_in %d, out %d, ws %zu < %zu)\n", n_in, out_size, ws_size, (size_t)WS_END); grid = -1; return; }
        int dev = 0, cus = 0;
        if (hipGetDevice(&dev) != hipSuccess || hipDeviceGetAttribute(&cus, hipDeviceAttributeMultiprocessorCount, dev) != hipSuccess) { grid = -1; return; }
        if (hipFuncSetAttribute((const void*)mega_fwd, hipFuncAttributeMaxDynamicSharedMemorySize, LDS_BYTES) != hipSuccess) { fprintf(stderr, "kernel_launch: hipFuncSetAttribute failed\n"); grid = -1; return; }
        int per_cu = 0;
        if (hipOccupancyMaxActiveBlocksPerMultiprocessor(&per_cu, (const void*)mega_fwd, NTHREADS, LDS_BYTES) != hipSuccess || per_cu < 1) { fprintf(stderr, "kernel_launch: occupancy query says %d\n", per_cu); }
        (void)hipGetLastError();
        if (cus != pg8::GRID) { fprintf(stderr, "kernel_launch: built for %d CUs, device has %d\n", pg8::GRID, cus); grid = -1; return; }
        grid = cus;
    }
    if (grid < 0) return;
    (void)hipMemsetAsync((char*)d_ws + WS_CTL, 0, CTL_ZERO_BYTES, stream);
    Args a{};
    for (int i = 0; i < 22; ++i) a.in[i] = d_in[i];
    a.out = (float*)d_out; a.ws = (unsigned char*)d_ws;
    hipLaunchKernelGGL(mega_fwd, dim3(grid), dim3(NTHREADS), LDS_BYTES, stream, a);
}
```

```cpp
#include <hip/hip_runtime.h>
#include <cstdio>
#include <cstdint>

#define LAS __attribute__((address_space(3)))
#define GAS __attribute__((address_space(1)))
typedef unsigned short bf16_t;
typedef short bf16x8 __attribute__((ext_vector_type(8)));
typedef short bf16x4 __attribute__((ext_vector_type(4)));
typedef float f32x2 __attribute__((ext_vector_type(2)));
typedef float f32x4 __attribute__((ext_vector_type(4)));
typedef float f32x16 __attribute__((ext_vector_type(16)));
typedef unsigned u32x2 __attribute__((ext_vector_type(2)));
typedef unsigned u32x4 __attribute__((ext_vector_type(4)));
typedef unsigned long long u64;
typedef int i32x2 __attribute__((ext_vector_type(2)));
typedef int i32x4 __attribute__((ext_vector_type(4)));
typedef int i32x8 __attribute__((ext_vector_type(8)));

constexpr int T = 32768, SEQ = 16384, DM = 2048;
constexpr int FFN = 5632, MFFN = 7168, NEXP = 8;
constexpr int NQKV = 2560, NWIN = 4864;
constexpr float ALPHA = 1.41421356237309515f;
constexpr float LN_EPS = 1e-5f, RMS_EPS = 1e-6f;
constexpr float QSCALE_SWA = 0.18033688011112042f;
constexpr float SCALE2_MLA = 0.10411754627697264f;
constexpr float LOG2E = 1.4426950408889634f;
constexpr int NWAVES = 8, NTHREADS = 512;
constexpr float W13_F8SCALE = 32.0f;
constexpr bool F8_FFN1 = true, F8_FFN2 = true, F8_QKV = true, F8_WO0 = true, F8_WIN = false, F8_WO1 = true;
constexpr bool EPI_ALIGN_RES = true;
constexpr bool SWA_FRAG = true;
constexpr bool F8_LAT = true;
constexpr float QLAT_F8SCALE = 8.0f, OLAT_F8SCALE = 32.0f, WUV_F8SCALE = 16.0f;
constexpr bool F8_G0 = true, F8_G1 = false;
constexpr bool F8_KV = true;
constexpr float KV_F8SCALE = 16.0f;
constexpr bool F8_WIN_SPLIT = true;
constexpr int WIN_F8_TILES = 14;
constexpr float WQKV_F8SCALE = 32.0f, WIN_F8SCALE = 32.0f, WO_F8SCALE = 64.0f, O0_F8SCALE = 16.0f, O2_F8SCALE = 32.0f;
constexpr float ACT_F8SCALE = 16.0f, W2_F8SCALE = 128.0f;

constexpr size_t MiB = 1u << 20;
constexpr size_t WS_CTL = 0, CTL_ZERO_BYTES = 1 * MiB;
constexpr size_t WS_WQKV = 2 * MiB, WS_WO0 = 12 * MiB, WS_W13 = 20 * MiB, WS_W2 = 64 * MiB, WS_WG0 = 86 * MiB, WS_WG1 = 94 * MiB, WS_WP0 = 102 * MiB, WS_WP1 = 103 * MiB,
                 WS_WIN = 104 * MiB, WS_WUK = 123 * MiB, WS_WUV = 125 * MiB, WS_WO1 = 129 * MiB;
constexpr size_t WS_TAB64 = 137 * MiB, WS_TAB32 = 145 * MiB, WS_PB = 149 * MiB, WS_XBA = 181 * MiB, WS_XBB = 309 * MiB;
constexpr size_t WS_TOKE = 437 * MiB;
constexpr size_t WS_TOKG = WS_TOKE + 256 * 1024;
constexpr size_t WS_TOKL = WS_TOKG + 256 * 1024;
constexpr size_t WS_TOKS = WS_TOKL + 256 * 1024;
constexpr size_t WS_SGATE = WS_TOKS + 256 * 1024;
constexpr size_t WS_WI = 439 * MiB, WS_SEL = 441 * MiB, WS_R = 458 * MiB;
constexpr size_t WS_Q = WS_R, WS_K = WS_R + 128 * MiB, WS_VT = WS_R + 144 * MiB, WS_ACT = WS_R + 160 * MiB, WS_PP0 = WS_R + 512 * MiB, WS_O8 = WS_R + 640 * MiB, WS_XB8 = WS_R + 704 * MiB  , WS_WIN8 = WS_R + 768 * MiB  ;
constexpr size_t WS_QN = WS_R, WS_QR = WS_R + 128 * MiB, WS_CRAW = WS_R + 192 * MiB, WS_KV = WS_R + 256 * MiB, WS_QI = WS_R + 292 * MiB, WS_KIF = WS_R + 356 * MiB,
                 WS_QLAT = WS_R + 360 * MiB, WS_O2 = WS_R + 872 * MiB;
constexpr size_t WS_MW13 = WS_R + 1128 * MiB, WS_MW2 = WS_R + 1352 * MiB, WS_XG = WS_R, WS_SOUT = WS_R + 136 * MiB, WS_ACT2 = WS_R + 404 * MiB  , WS_PP1 = WS_R + 884 * MiB;
constexpr size_t WS_X28 = WS_O8  , WS_X58 = WS_ACT2  ;
constexpr size_t WS_END = WS_R + 1464 * MiB;
constexpr int MAXSLOTS = 67840;
constexpr int CHUNK_TILES = 272;
constexpr int CW_TMO = 0, CW_CNT = 64  , CW_BAR = 4096;

constexpr int LDS_BYTES = 155648;
constexpr int MISC_OFF = 150016;
constexpr int DSA_WBUF = 18688;

typedef __bf16 bf16x2_t __attribute__((ext_vector_type(2)));
__device__ __forceinline__ unsigned cvt_pk_bf16(float lo, float hi) { const f32x2 v = {lo, hi}; return __builtin_bit_cast(unsigned, __builtin_convertvector(v, bf16x2_t)); }
__device__ __forceinline__ float bf2f(unsigned short h) { return __uint_as_float(((unsigned)h) << 16); }
__device__ __forceinline__ float bflo(unsigned w) { return __uint_as_float(w << 16); }
__device__ __forceinline__ float bfhi(unsigned w) { return __uint_as_float(w & 0xffff0000u); }
__device__ __forceinline__ int fresh_lane() { unsigned m = ~0u; asm volatile("" : "+v"(m)); return (int)__builtin_amdgcn_mbcnt_hi(m, __builtin_amdgcn_mbcnt_lo(m, 0u)); }
__device__ __forceinline__ float shx(float v, int o, int lane) { return __int_as_float(__builtin_amdgcn_ds_bpermute((lane ^ o) << 2, __float_as_int(v))); }
__device__ __forceinline__ float wave_sum(float v) {
    const int l = fresh_lane();
#pragma unroll
    for (int o = 1; o < 64; o <<= 1) v += shx(v, o, l);
    return v;
}
__device__ __forceinline__ unsigned pk4_fp8(float a, float b, float c, float d) { unsigned w = 0u; w = (unsigned)__builtin_amdgcn_cvt_pk_fp8_f32(a, b, (int)w, false); w = (unsigned)__builtin_amdgcn_cvt_pk_fp8_f32(c, d, (int)w, true); return w; }
#define LDS_WAIT() asm volatile("s_waitcnt lgkmcnt(0)" ::: "memory")
#define VM_WAIT() asm volatile("s_waitcnt vmcnt(0)" ::: "memory")

namespace pg8 {
constexpr int BM = 256, BK = 64, HALF = 128, HTB = HALF * BK * 2, STAGE_BYTES = 8 * HTB, NXCD = 8, WGM = 8;
__host__ __device__ __forceinline__ int lds_byte(int r, int c) { const int st = (r >> 4) * 2 + (c >> 5), rr = r & 15, cc = c & 31, ob = rr * 64 + cc * 2; return st * 1024 + (ob ^ (((ob >> 9) & 1) << 5)); }
__host__ __device__ __forceinline__ void stage_rc(int b, int& R, int& C) { const int st = b / 1024, sb = b % 1024, swz = sb ^ (((sb >> 9) & 1) << 5); R = (st >> 1) * 16 + swz / 64; C = (st & 1) * 32 + (swz % 64) / 2; }
__host__ __device__ __forceinline__ int perm32(int rho) { const int n = rho >> 4, i = rho & 15; return 8 * (i >> 2) + 4 * n + (i & 3); }

struct Unit { int pm, pn, am, acol, bn; };
struct Gemm { const bf16_t* A; const bf16_t* Bt; int lda, ldb, K; };

constexpr int GRID = 256;
template <int MODE, int NM, int NN> struct GridOrder {
    __device__ __forceinline__ bool next(int i, Unit& u) const {
        constexpr int nwg = NM * NN;
        int L = i * GRID + (int)blockIdx.x;
        if constexpr (MODE == 4) {
            if (i >= 6) { if ((int)blockIdx.x < GRID / 2 || i >= 8) return false; L = 6 * GRID + ((int)blockIdx.x - GRID / 2) * 2 + (i - 6); } }
        if (L >= nwg) return false;
        int wgid = L; { constexpr int q = nwg / NXCD, r = nwg % NXCD; const int xcd = wgid % NXCD, off = wgid / NXCD; wgid = (xcd < r ? xcd * (q + 1) : r * (q + 1) + (xcd - r) * q) + off; }
        constexpr int nig = WGM * NN; const int gid = wgid / nig, fm = gid * WGM, gsz = (NM - fm) < WGM ? (NM - fm) : WGM;
        u.pm = fm + ((wgid % nig) % gsz); u.pn = (wgid % nig) / gsz; u.am = u.pm; u.bn = u.pn;
        u.acol = MODE == 1 ? (u.pn >> 1) * 128 : (MODE == 2 ? u.pn * 1024 : (MODE == 3 ? u.pn * 512 : 0));
        return true;
    }
};
template <int NM, int NN> struct GridOrderSkip {
    int skip;
    __device__ __forceinline__ bool next(int i, Unit& u) const {
        constexpr int nwg = NM * NN; const int nW = GRID - skip, br = (int)blockIdx.x - skip; if (br < 0) return false;
        const int L = i * nW + br; if (L >= nwg) return false;
        int wgid = L; { constexpr int q = nwg / NXCD, r = nwg % NXCD; const int xcd = wgid % NXCD, off = wgid / NXCD; wgid = (xcd < r ? xcd * (q + 1) : r * (q + 1) + (xcd - r) * q) + off; }
        constexpr int nig = WGM * NN; const int gid = wgid / nig, fm = gid * WGM, gsz = (NM - fm) < WGM ? (NM - fm) : WGM;
        u.pm = fm + ((wgid % nig) % gsz); u.pn = (wgid % nig) / gsz; u.am = u.pm; u.bn = u.pn; u.acol = 0;
        return true;
    }
};
template <bool DOWN, int NN> struct MoeOrder {
    int tile0, ntl;
    __device__ __forceinline__ bool next(int i, Unit& u) const {
        int pml, pn;
        if constexpr (!DOWN && NN % 8 == 0) {
            constexpr int NJ = NN / 8; const int x = (int)blockIdx.x & 7, q = i * (GRID / 8) + ((int)blockIdx.x >> 3); if (q >= ntl * NJ) return false;
            const int nfull = ntl >> 3; int m, j;
            if (q < nfull * 8 * NJ) { const int b = q / (8 * NJ), w = q - b * (8 * NJ); m = b * 8 + (w & 7); j = w >> 3; }
            else { const int g = ntl - nfull * 8, w = q - nfull * 8 * NJ; j = w / g; m = nfull * 8 + (w - j * g); }
            pml = m; pn = 8 * j + x;
        } else {
        const int L = i * GRID + (int)blockIdx.x; if (L >= ntl * NN) return false;
        constexpr int nig = WGM * NN; const int wgid = L, gid = wgid / nig, fm = gid * WGM, gsz = (ntl - fm) < WGM ? (ntl - fm) : WGM;
        pml = fm + ((wgid % nig) % gsz); pn = (wgid % nig) / gsz; }
        const int pmg = tile0 + pml;
        const u32x4 t0 = *(const LAS u32x4*)(MISC_OFF + 20 * 4), t1 = *(const LAS u32x4*)(MISC_OFF + 24 * 4);
        int e = (pmg >= (int)t0.x) + (pmg >= (int)t0.y) + (pmg >= (int)t0.z) + (pmg >= (int)t0.w) + (pmg >= (int)t1.x) + (pmg >= (int)t1.y) + (pmg >= (int)t1.z);
        e = __builtin_amdgcn_readfirstlane(e);
        u.pn = pn; u.bn = e * NN + pn; u.acol = 0;
        if (DOWN) { u.pm = pmg; u.am = pml; } else { u.pm = pml; u.am = pmg; }
        return true;
    }
};

__device__ __forceinline__ void stage16_s(const char* gbase, unsigned voff, unsigned lds_dst) { unsigned keep;
    asm volatile("s_mov_b32 %0, m0\n\ts_mov_b32 m0, %3\n\ts_nop 0\n\tglobal_load_lds_dwordx4 %1, %2\n\ts_mov_b32 m0, %0" : "=&s"(keep) : "v"(voff), "s"(gbase), "s"(lds_dst) : "memory"); }
template <class Epi, class Sched, bool FP8 = false, bool ALIGN = true>
__device__ __forceinline__ void gemm_phase(LAS unsigned char* lds, const Gemm g, const Sched& S, const Epi& E, int wave_) {
    int tid_ = wave_ * 64 + fresh_lane(); asm volatile("" : "+v"(tid_));
    const int tid = tid_, wid = __builtin_amdgcn_readfirstlane(tid >> 6), lane = tid & 63, wr = wid >> 2, wc = wid & 3, fr = lane & 15, fq = lane >> 4;
    int K_ = g.K; asm volatile("" : "+s"(K_));
    const int K = K_, nt = K / BK;
    unsigned voffA[2], voffB[2];
#pragma unroll
    for (int i = 0; i < 2; ++i) { int R, C; stage_rc(tid * 16 + i * 8192, R, C); const int Rb = (R & ~31) + perm32(R & 31);
        voffA[i] = (unsigned)(R * g.lda + C) * 2u; voffB[i] = (unsigned)(Rb * g.ldb + C) * 2u; }
    const size_t kstep = (size_t)(BK * 2);
    const size_t hstepA = (size_t)HALF * g.lda * 2, hstepB = (size_t)HALF * g.ldb * 2;
    const unsigned ldsw = (unsigned)wid * 1024u;
    const int aoff = lds_byte(wr * 64 + fr, fq * 8), boff = lds_byte(wc * 32 + fr, fq * 8);
#define PG8_SA(b, h) (((b) * 2 + (h)) * HTB)
#define PG8_SB(b, h) ((4 + (b) * 2 + (h)) * HTB)
#define PG8_STAGE(bufoff, gbase, voff) do { _Pragma("unroll") for (int _i = 0; _i < 2; ++_i) { \
        if constexpr (FP8) stage16_s((const char*)(gbase), (voff)[_i], (unsigned)(size_t)(lds + (bufoff) + ldsw + _i * 8192)); \
        else __builtin_amdgcn_global_load_lds((const unsigned*)((const char*)(gbase) + (voff)[_i]), (LAS unsigned*)(lds + (bufoff) + ldsw + _i * 8192), 16, 0, 0); } } while (0)
#define PG8_LDA(dst, b, h) do { _Pragma("unroll") for (int m = 0; m < 4; ++m) _Pragma("unroll") for (int k = 0; k < 2; ++k) dst[m][k] = *(const LAS bf16x8*)(lds + PG8_SA(b, h) + aoff + m * 2048 + k * 1024); } while (0)
#define PG8_LDB(dst, b, h) do { _Pragma("unroll") for (int n = 0; n < 2; ++n) _Pragma("unroll") for (int k = 0; k < 2; ++k) dst[n][k] = *(const LAS bf16x8*)(lds + PG8_SB(b, h) + boff + n * 2048 + k * 1024); } while (0)
#define PG8_MMA(ai, bj, At, Bt) do { __builtin_amdgcn_s_setprio(1); _Pragma("unroll") for (int m = 0; m < 4; ++m) _Pragma("unroll") for (int n = 0; n < 2; ++n) _Pragma("unroll") for (int k = 0; k < 2; ++k) \
        acc[ai][bj][m][n] = __builtin_amdgcn_mfma_f32_16x16x32_bf16(Bt[n][k], At[m][k], acc[ai][bj][m][n], 0, 0, 0); __builtin_amdgcn_s_setprio(0); } while (0)
#define PG8_LDA8(dst, b, h) do { _Pragma("unroll") for (int m = 0; m < 4; ++m) { const i32x4 lo_ = *(const LAS i32x4*)(lds + PG8_SA(b, h) + aoff + m * 2048), hi_ = *(const LAS i32x4*)(lds + PG8_SA(b, h) + aoff + m * 2048 + 1024); \
        dst[m] = __builtin_shufflevector(lo_, hi_, 0, 1, 2, 3, 4, 5, 6, 7); } } while (0)
#define PG8_LDB8(dst, b, h) do { _Pragma("unroll") for (int n = 0; n < 2; ++n) { const i32x4 lo_ = *(const LAS i32x4*)(lds + PG8_SB(b, h) + boff + n * 2048), hi_ = *(const LAS i32x4*)(lds + PG8_SB(b, h) + boff + n * 2048 + 1024); \
        dst[n] = __builtin_shufflevector(lo_, hi_, 0, 1, 2, 3, 4, 5, 6, 7); } } while (0)
#define PG8_MMA8(ai, bj, At, Bt) do { __builtin_amdgcn_s_setprio(1); _Pragma("unroll") for (int m = 0; m < 4; ++m) _Pragma("unroll") for (int n = 0; n < 2; ++n) \
        acc[ai][bj][m][n] = __builtin_amdgcn_mfma_scale_f32_16x16x128_f8f6f4(Bt[n], At[m], acc[ai][bj][m][n], 0, 0, 0, 0, 0, 0); __builtin_amdgcn_s_setprio(0); } while (0)
#define PG8_WAIT_V(n) asm volatile("s_waitcnt vmcnt(" #n ")" ::: "memory")
#define PG8_WAIT_L(n) asm volatile("s_waitcnt lgkmcnt(" #n ")" ::: "memory")
#define PG8_BAR __builtin_amdgcn_s_barrier()
#define PG8_SCHED __builtin_amdgcn_sched_barrier(0)
#define PG8_ABASE(u) ((const char*)g.A + ((size_t)(u).am * BM * g.lda + (size_t)(u).acol) * 2)
#define PG8_BBASE(u) ((const char*)g.Bt + (size_t)(u).bn * BM * g.ldb * 2)
    Unit cur, nxt; int ui = 0;
    if (!S.next(0, cur)) return;
    f32x4 acc[2][2][4][2];
#pragma unroll
    for (int a = 0; a < 2; ++a)
#pragma unroll
        for (int b = 0; b < 2; ++b)
#pragma unroll
            for (int m = 0; m < 4; ++m)
#pragma unroll
                for (int n = 0; n < 2; ++n) acc[a][b][m][n] = (f32x4){0.f, 0.f, 0.f, 0.f};
    bf16x8 At[4][2], B0[2][2], B1[2][2]; i32x8 At8[4], B08[2], B18[2];
    const char* cA = PG8_ABASE(cur); const char* cB = PG8_BBASE(cur);
    {
        PG8_STAGE(PG8_SB(0, 0), cB, voffB); PG8_STAGE(PG8_SB(0, 1), cB + hstepB, voffB); PG8_STAGE(PG8_SA(0, 0), cA, voffA); PG8_STAGE(PG8_SA(0, 1), cA + hstepA, voffA);
        if (wr == 1) PG8_BAR;
        PG8_WAIT_V(2); PG8_BAR;
        PG8_STAGE(PG8_SB(1, 0), cB + kstep, voffB); PG8_STAGE(PG8_SA(1, 0), cA + kstep, voffA); PG8_STAGE(PG8_SB(1, 1), cB + hstepB + kstep, voffB);
        PG8_WAIT_V(6); PG8_BAR;
    }
    for (;;) {
        const bool has_next = S.next(ui + 1, nxt);
        const char* nA = has_next ? PG8_ABASE(nxt) : cA; const char* nB = has_next ? PG8_BBASE(nxt) : cB;
        for (int t = 0; t < nt; t += 2) {
            const bool last = (t == nt - 2);
            const char* a1 = cA + (size_t)(t + 1) * kstep;
            const char* a2 = last ? nA : cA + (size_t)(t + 2) * kstep; const char* b2 = last ? nB : cB + (size_t)(t + 2) * kstep;
            const char* a3 = a2 + kstep; const char* b3 = b2 + kstep;
            if constexpr (FP8) {
            PG8_LDB8(B08, 0, 0); PG8_LDB8(B18, 0, 1); PG8_SCHED; PG8_LDA8(At8, 0, 0); PG8_STAGE(PG8_SA(1, 1), a1 + hstepA, voffA);
            PG8_WAIT_V(8); PG8_WAIT_L(0); PG8_BAR; PG8_MMA8(0, 0, At8, B08); PG8_MMA8(0, 1, At8, B18); PG8_BAR; PG8_SCHED;
            PG8_LDA8(At8, 0, 1); PG8_STAGE(PG8_SB(0, 0), b2, voffB); PG8_STAGE(PG8_SB(0, 1), b2 + hstepB, voffB); PG8_STAGE(PG8_SA(0, 0), a2, voffA);
            PG8_WAIT_V(8); PG8_WAIT_L(0); PG8_BAR; PG8_MMA8(1, 0, At8, B08); PG8_MMA8(1, 1, At8, B18); PG8_BAR; PG8_SCHED;
            PG8_LDB8(B08, 1, 0); PG8_LDB8(B18, 1, 1); PG8_SCHED; PG8_LDA8(At8, 1, 0); PG8_STAGE(PG8_SA(0, 1), a2 + hstepA, voffA);
            PG8_WAIT_V(8); PG8_WAIT_L(0); PG8_BAR; PG8_MMA8(0, 0, At8, B08); PG8_MMA8(0, 1, At8, B18); PG8_BAR; PG8_SCHED;
            PG8_LDA8(At8, 1, 1); PG8_STAGE(PG8_SB(1, 0), b3, voffB); PG8_STAGE(PG8_SB(1, 1), b3 + hstepB, voffB); PG8_STAGE(PG8_SA(1, 0), a3, voffA);
            PG8_WAIT_V(8); PG8_WAIT_L(0); PG8_BAR; PG8_MMA8(1, 0, At8, B08); PG8_MMA8(1, 1, At8, B18); PG8_BAR; PG8_SCHED;
            } else {
            PG8_LDB(B0, 0, 0); PG8_LDB(B1, 0, 1); PG8_SCHED; PG8_LDA(At, 0, 0); PG8_STAGE(PG8_SA(1, 1), a1 + hstepA, voffA);
            PG8_WAIT_V(8); PG8_WAIT_L(0); PG8_BAR; PG8_MMA(0, 0, At, B0); PG8_MMA(0, 1, At, B1); PG8_BAR; PG8_SCHED;
            PG8_LDA(At, 0, 1); PG8_STAGE(PG8_SB(0, 0), b2, voffB); PG8_STAGE(PG8_SB(0, 1), b2 + hstepB, voffB); PG8_STAGE(PG8_SA(0, 0), a2, voffA);
            PG8_WAIT_V(8); PG8_WAIT_L(0); PG8_BAR; PG8_MMA(1, 0, At, B0); PG8_MMA(1, 1, At, B1); PG8_BAR; PG8_SCHED;
            PG8_LDB(B0, 1, 0); PG8_LDB(B1, 1, 1); PG8_SCHED; PG8_LDA(At, 1, 0); PG8_STAGE(PG8_SA(0, 1), a2 + hstepA, voffA);
            PG8_WAIT_V(8); PG8_WAIT_L(0); PG8_BAR; PG8_MMA(0, 0, At, B0); PG8_MMA(0, 1, At, B1); PG8_BAR; PG8_SCHED;
            PG8_LDA(At, 1, 1); PG8_STAGE(PG8_SB(1, 0), b3, voffB); PG8_STAGE(PG8_SB(1, 1), b3 + hstepB, voffB); PG8_STAGE(PG8_SA(1, 0), a3, voffA);
            PG8_WAIT_V(8); PG8_WAIT_L(0); PG8_BAR; PG8_MMA(1, 0, At, B0); PG8_MMA(1, 1, At, B1); PG8_BAR; PG8_SCHED;
            }
        }
        if constexpr (ALIGN) { if (wr == 0) PG8_BAR; }
        { int fr_ = fr, fq_ = fq; asm volatile("" : "+v"(fr_), "+v"(fq_));
          E(acc, cur, wr, wc, fr_, fq_); }
        if (!has_next) break;
#pragma unroll
        for (int a = 0; a < 2; ++a)
#pragma unroll
            for (int b = 0; b < 2; ++b)
#pragma unroll
                for (int m = 0; m < 4; ++m)
#pragma unroll
                    for (int n = 0; n < 2; ++n) acc[a][b][m][n] = (f32x4){0.f, 0.f, 0.f, 0.f};
        cur = nxt; cA = nA; cB = nB; ++ui;
        if constexpr (ALIGN) { if (wr == 1) PG8_BAR; }
    }
    PG8_WAIT_V(0);
    if constexpr (!ALIGN) { if (wr == 0) PG8_BAR; }
    PG8_BAR;
#undef PG8_SA
#undef PG8_SB
#undef PG8_STAGE
#undef PG8_LDA
#undef PG8_LDB
#undef PG8_MMA
#undef PG8_LDA8
#undef PG8_LDB8
#undef PG8_MMA8
#undef PG8_WAIT_V
#undef PG8_WAIT_L
#undef PG8_BAR
#undef PG8_SCHED
#undef PG8_ABASE
#undef PG8_BBASE
}

#define EPI_ROW(ai, m) (u.pm * BM + (ai) * HALF + wr * 64 + (m) * 16 + fr)
#define EPI_COL(bj) (u.pn * BM + (bj) * HALF + wc * 32 + 8 * fq)
typedef f32x4 AccT[2][2][4][2];

__device__ __forceinline__ void rope4(f32x4& v0, f32x4& v1, const f32x4 cs0, const f32x4 cs1) {
    f32x4 o0, o1;
    o0[0] = v0[0] * cs0[0] - v0[1] * cs0[1]; o0[1] = v0[1] * cs0[0] + v0[0] * cs0[1];
    o0[2] = v0[2] * cs0[2] - v0[3] * cs0[3]; o0[3] = v0[3] * cs0[2] + v0[2] * cs0[3];
    o1[0] = v1[0] * cs1[0] - v1[1] * cs1[1]; o1[1] = v1[1] * cs1[0] + v1[0] * cs1[1];
    o1[2] = v1[2] * cs1[2] - v1[3] * cs1[3]; o1[3] = v1[3] * cs1[2] + v1[2] * cs1[3];
    v0 = o0; v1 = o1;
}
__device__ __forceinline__ u32x4 pack8(const f32x4 v0, const f32x4 v1) { u32x4 w; w.x = cvt_pk_bf16(v0[0], v0[1]); w.y = cvt_pk_bf16(v0[2], v0[3]); w.z = cvt_pk_bf16(v1[0], v1[1]); w.w = cvt_pk_bf16(v1[2], v1[3]); return w; }

__device__ __forceinline__ void unpack8(const u32x4 w, f32x4& a, f32x4& b) { a[0] = bflo(w.x); a[1] = bfhi(w.x); a[2] = bflo(w.y); a[3] = bfhi(w.y); b[0] = bflo(w.z); b[1] = bfhi(w.z); b[2] = bflo(w.w); b[3] = bfhi(w.w); }
__device__ __forceinline__ u32x2 pack8_fp8(const f32x4 v0, const f32x4 v1, float s) { u32x2 w; w.x = pk4_fp8(v0[0] * s, v0[1] * s, v0[2] * s, v0[3] * s); w.y = pk4_fp8(v1[0] * s, v1[1] * s, v1[2] * s, v1[3] * s); return w; }
template <bool OUT8> struct EpiBf16 {
    bf16_t* O; int ldc; float osc;
    __device__ __forceinline__ void operator()(const AccT& acc, const Unit& u, int wr, int wc, int fr, int fq) const {
#pragma unroll
        for (int ai = 0; ai < 2; ++ai)
#pragma unroll
            for (int m = 0; m < 4; ++m) {
#pragma unroll
                for (int bj = 0; bj < 2; ++bj) {
                    if constexpr (OUT8) *(u32x2*)((unsigned char*)O + (size_t)EPI_ROW(ai, m) * ldc + EPI_COL(bj)) = pack8_fp8(acc[ai][bj][m][0], acc[ai][bj][m][1], osc);
                    else *(u32x4*)(O + (size_t)EPI_ROW(ai, m) * ldc + EPI_COL(bj)) = pack8(acc[ai][bj][m][0] * osc, acc[ai][bj][m][1] * osc); } }
    }
};
struct EpiQKV {
    unsigned char* ws; float asc;
    __device__ __forceinline__ void operator()(const AccT& acc, const Unit& u, int wr, int wc, int fr, int fq) const {
        bf16_t* Q = (bf16_t*)(ws + WS_Q); bf16_t* Kb = (bf16_t*)(ws + WS_K); bf16_t* VT = (bf16_t*)(ws + WS_VT); const float* tab64 = (const float*)(ws + WS_TAB64);
        if (u.pn < 9) {
            bf16_t* base = u.pn < 8 ? Q : Kb; const int ldc = u.pn < 8 ? 2048 : 256; const int colt = u.pn < 8 ? u.pn * BM : 0; const float sc = (u.pn < 8 ? QSCALE_SWA : 1.0f) * asc;
#pragma unroll
            for (int ai = 0; ai < 2; ++ai)
#pragma unroll
                for (int m = 0; m < 4; ++m) { const int row = EPI_ROW(ai, m);
#pragma unroll
                    for (int bj = 0; bj < 2; ++bj) { const int cl = bj * HALF + wc * 32 + 8 * fq; const int i0 = (cl & 63) >> 1;
                        const f32x4 cs0 = *(const f32x4*)(tab64 + ((size_t)row * 32 + i0) * 2), cs1 = *(const f32x4*)(tab64 + ((size_t)row * 32 + i0) * 2 + 4);
                        f32x4 v0 = acc[ai][bj][m][0], v1 = acc[ai][bj][m][1]; rope4(v0, v1, cs0, cs1); v0 = v0 * sc; v1 = v1 * sc;
                        if constexpr (SWA_FRAG) {
                            const int b = row >> 14, s = row & (SEQ - 1), hh = (colt + cl) >> 6, c64 = cl & 63, kk = c64 >> 4, hf2 = (c64 >> 3) & 1, nh = u.pn < 8 ? 32 : 4;
                            *(u32x4*)(base + ((((size_t)(b * nh + hh) * 512 + (s >> 5)) * 4 + kk) * 64 + hf2 * 32 + (s & 31)) * 8) = pack8(v0, v1); }
                        else *(u32x4*)(base + (size_t)row * ldc + colt + cl) = pack8(v0, v1); } }
        } else {
#pragma unroll
            for (int ai = 0; ai < 2; ++ai)
#pragma unroll
                for (int m = 0; m < 4; ++m) { const int row = EPI_ROW(ai, m), b = row >> 14, s = row & (SEQ - 1);
#pragma unroll
                    for (int bj = 0; bj < 2; ++bj) { const int cl = bj * HALF + wc * 32 + 8 * fq, kvh = cl >> 6, d0 = cl & 63;
                        const u32x4 w = pack8(acc[ai][bj][m][0] * asc, acc[ai][bj][m][1] * asc);
                        if constexpr (SWA_FRAG) {
                            const int j = s & 31, c = j >> 4, jj = j & 15, hfv = (jj & 7) >> 2, e = (jj & 3) + ((jj >> 3) << 2), mt = d0 >> 5;
                            bf16_t* pf = VT + (((((size_t)(b * 4 + kvh) * 512 + (s >> 5)) * 2 + c) * 2 + mt) * 64 + hfv * 32 + (d0 & 31)) * 8 + e;
                            pf[0] = (bf16_t)(w.x & 0xffff); pf[8] = (bf16_t)(w.x >> 16); pf[16] = (bf16_t)(w.y & 0xffff); pf[24] = (bf16_t)(w.y >> 16);
                            pf[32] = (bf16_t)(w.z & 0xffff); pf[40] = (bf16_t)(w.z >> 16); pf[48] = (bf16_t)(w.w & 0xffff); pf[56] = (bf16_t)(w.w >> 16); }
                        else {
                        bf16_t* p = VT + ((size_t)(b * 4 + kvh) * 64 + d0) * SEQ + s;
                        p[0 * SEQ] = (bf16_t)(w.x & 0xffff); p[1 * SEQ] = (bf16_t)(w.x >> 16); p[2 * SEQ] = (bf16_t)(w.y & 0xffff); p[3 * SEQ] = (bf16_t)(w.y >> 16);
                        p[4 * SEQ] = (bf16_t)(w.z & 0xffff); p[5 * SEQ] = (bf16_t)(w.z >> 16); p[6 * SEQ] = (bf16_t)(w.w & 0xffff); p[7 * SEQ] = (bf16_t)(w.w >> 16); } } }
        }
    }
};
template <bool RES16> struct EpiRes {
    const void* res; bf16_t* out; float sc;
    __device__ __forceinline__ void operator()(const AccT& acc, const Unit& u, int wr, int wc, int fr, int fq) const {
#pragma unroll
        for (int ai = 0; ai < 2; ++ai)
#pragma unroll
            for (int m = 0; m < 4; ++m) { const size_t ro = (size_t)EPI_ROW(ai, m) * DM;
#pragma unroll
                for (int bj = 0; bj < 2; ++bj) { const size_t o = ro + EPI_COL(bj); f32x4 r0, r1;
                    if constexpr (RES16) unpack8(*(const u32x4*)((const bf16_t*)res + o), r0, r1);
                    else { r0 = *(const f32x4*)((const float*)res + o); r1 = *(const f32x4*)((const float*)res + o + 4); }
                    *(u32x4*)(out + o) = pack8(r0 * ALPHA + acc[ai][bj][m][0] * sc, r1 * ALPHA + acc[ai][bj][m][1] * sc); }
                asm volatile("" ::: "memory"); }
    }
};
__device__ __forceinline__ float silu_mul(float g, float uu) { return g * __builtin_amdgcn_rcpf(1.0f + __builtin_amdgcn_exp2f(-g * LOG2E)) * uu; }
template <bool OUT8> struct EpiSwiglu {
    bf16_t* O; int ldc; float sc; float osc;
    __device__ __forceinline__ void operator()(const AccT& acc, const Unit& u, int wr, int wc, int fr, int fq) const {
#pragma unroll
        for (int ai = 0; ai < 2; ++ai)
#pragma unroll
            for (int m = 0; m < 4; ++m) { f32x4 a0, a1;
#pragma unroll
                for (int j = 0; j < 4; ++j) { a0[j] = silu_mul(acc[ai][0][m][0][j] * sc, acc[ai][1][m][0][j] * sc); a1[j] = silu_mul(acc[ai][0][m][1][j] * sc, acc[ai][1][m][1][j] * sc); }
                if constexpr (OUT8) { u32x2 w8; w8.x = pk4_fp8(a0[0] * osc, a0[1] * osc, a0[2] * osc, a0[3] * osc); w8.y = pk4_fp8(a1[0] * osc, a1[1] * osc, a1[2] * osc, a1[3] * osc);
                    *(u32x2*)((unsigned char*)O + (size_t)EPI_ROW(ai, m) * ldc + u.pn * HALF + wc * 32 + 8 * fq) = w8; }
                else *(u32x4*)(O + (size_t)EPI_ROW(ai, m) * ldc + u.pn * HALF + wc * 32 + 8 * fq) = pack8(a0, a1); }
    }
};
struct EpiPle {
    float* outf; unsigned char* ws; int layer; float nls;
    __device__ __forceinline__ void operator()(const AccT& acc, const Unit& u, int wr, int wc, int fr, int fq) const {
        const bf16_t* pp = (const bf16_t*)(ws + (layer == 0 ? WS_PP0 : WS_PP1));
        const bf16_t* xres = (const bf16_t*)(ws + (layer == 0 ? WS_XBA : WS_XBB));
#pragma unroll
        for (int ai = 0; ai < 2; ++ai)
#pragma unroll
            for (int m = 0; m < 4; ++m) { const unsigned ro = (unsigned)EPI_ROW(ai, m) * (unsigned)DM;
#pragma unroll
                for (int bj = 0; bj < 2; ++bj) { const unsigned o = ro + (unsigned)EPI_COL(bj);
                    f32x4 r0, r1, p0, p1; unpack8(*(const u32x4*)(xres + o), r0, r1); unpack8(*(const u32x4*)(pp + o), p0, p1);
                    f32x4 s0, s1;
#pragma unroll
                    for (int j = 0; j < 4; ++j) { s0[j] = __builtin_amdgcn_rcpf(1.0f + __builtin_amdgcn_exp2f(acc[ai][bj][m][0][j] * nls)); s1[j] = __builtin_amdgcn_rcpf(1.0f + __builtin_amdgcn_exp2f(acc[ai][bj][m][1][j] * nls)); }
                    const f32x4 o0 = r0 + s0 * p0, o1 = r1 + s1 * p1;
                    if (layer == 0) { *(u32x4*)((bf16_t*)(ws + WS_XBB) + o) = pack8(o0, o1);
                                      if constexpr (F8_WIN_SPLIT || F8_WIN) *(u32x2*)(ws + WS_XB8 + o) = pack8_fp8(o0, o1, 1.0f); }
                    else { *(f32x4*)(outf + o) = o0; *(f32x4*)(outf + o + 4) = o1; } }
                asm volatile("" ::: "memory"); }
    }
};
struct EpiWin {
    unsigned char* ws; float asc; int pn0;
    __device__ __forceinline__ void operator()(const AccT& acc, const Unit& u, int wr, int wc, int fr, int fq) const {
        bf16_t* QN = (bf16_t*)(ws + WS_QN); bf16_t* QR = (bf16_t*)(ws + WS_QR); float* CRAW = (float*)(ws + WS_CRAW); bf16_t* KV = (bf16_t*)(ws + WS_KV); bf16_t* QI = (bf16_t*)(ws + WS_QI);
        bf16_t* KIF = (bf16_t*)(ws + WS_KIF); float* WI = (float*)(ws + WS_WI); const float* tab64 = (const float*)(ws + WS_TAB64); const float* tab32 = (const float*)(ws + WS_TAB32);
        const int pn = u.pn + pn0;
#pragma unroll
        for (int ai = 0; ai < 2; ++ai)
#pragma unroll
            for (int m = 0; m < 4; ++m) { const int row = EPI_ROW(ai, m);
#pragma unroll
                for (int bj = 0; bj < 2; ++bj) { const int cl = bj * HALF + wc * 32 + 8 * fq; f32x4 v0 = acc[ai][bj][m][0] * asc, v1 = acc[ai][bj][m][1] * asc;
                    if (pn < 8) { *(u32x4*)(QN + (size_t)row * 2048 + pn * BM + cl) = pack8(v0, v1); }
                    else if (pn < 12) { const int i0 = (cl & 63) >> 1;
                        const f32x4 cs0 = *(const f32x4*)(tab64 + ((size_t)row * 32 + i0) * 2), cs1 = *(const f32x4*)(tab64 + ((size_t)row * 32 + i0) * 2 + 4);
                        rope4(v0, v1, cs0, cs1); if constexpr (F8_LAT) { v0 = v0 * QLAT_F8SCALE; v1 = v1 * QLAT_F8SCALE; }
                        if constexpr (F8_KV) *(u32x2*)((unsigned char*)QR + (size_t)row * 1024 + (pn - 8) * BM + cl) = pack8_fp8(v0, v1, 1.0f);
                        else *(u32x4*)(QR + (size_t)row * 1024 + (pn - 8) * BM + cl) = pack8(v0, v1); }
                    else if (pn < 14) { float* p = CRAW + (size_t)row * 512 + (pn - 12) * BM + cl; *(f32x4*)p = v0; *(f32x4*)(p + 4) = v1; }
                    else if (pn == 14) {
                        if (cl < 64) { const int i0 = cl >> 1;
                            const f32x4 cs0 = *(const f32x4*)(tab64 + ((size_t)row * 32 + i0) * 2), cs1 = *(const f32x4*)(tab64 + ((size_t)row * 32 + i0) * 2 + 4);
                            rope4(v0, v1, cs0, cs1);
                            if constexpr (F8_KV) *(u32x2*)((unsigned char*)KV + (size_t)row * 576 + 512 + cl) = pack8_fp8(v0, v1, KV_F8SCALE);
                            else *(u32x4*)(KV + (size_t)row * 576 + 512 + cl) = pack8(v0, v1); }
                        else if (cl < 128) { const int d8 = cl - 64;
                            if (d8 < 32) { const int i0 = d8 >> 1;
                                const f32x4 cs0 = *(const f32x4*)(tab32 + ((size_t)row * 16 + i0) * 2), cs1 = *(const f32x4*)(tab32 + ((size_t)row * 16 + i0) * 2 + 4);
                                rope4(v0, v1, cs0, cs1); }
                            const int b = row >> 14, s = row & (SEQ - 1), blk = s >> 5, j = s & 31, kk = d8 >> 4, hf = (d8 >> 3) & 1;
                            *(u32x4*)(KIF + ((size_t)((b * 512 + blk) * 4 + kk) * 64 + hf * 32 + j) * 8) = pack8(v0, v1); }
                        else if (cl < 144) { float* p = WI + (size_t)row * 16 + (cl - 128); *(f32x4*)p = v0; *(f32x4*)(p + 4) = v1; }
                    } else { const int cq = (pn - 15) * BM + cl, d8 = cq & 63;
                        if (d8 < 32) { const int i0 = d8 >> 1;
                            const f32x4 cs0 = *(const f32x4*)(tab32 + ((size_t)row * 16 + i0) * 2), cs1 = *(const f32x4*)(tab32 + ((size_t)row * 16 + i0) * 2 + 4);
                            rope4(v0, v1, cs0, cs1); }
                        *(u32x4*)(QI + (size_t)row * 1024 + cq) = pack8(v0, v1); }
                } }
    }
};
struct EpiMoeDown {
    unsigned char* ws;
    __device__ __forceinline__ void operator()(const AccT& acc, const Unit& u, int wr, int wc, int fr, int fq) const {
        bf16_t* O = (bf16_t*)(ws + WS_SOUT); const float* gate = (const float*)(ws + WS_SGATE);
#pragma unroll
        for (int ai = 0; ai < 2; ++ai)
#pragma unroll
            for (int m = 0; m < 4; ++m) { const int row = EPI_ROW(ai, m); const float gt = gate[row] * (1.0f / (ACT_F8SCALE * W2_F8SCALE)); bf16_t* rowp = O + (size_t)row * DM;
#pragma unroll
                for (int bj = 0; bj < 2; ++bj) *(u32x4*)(rowp + EPI_COL(bj)) = pack8(acc[ai][bj][m][0] * gt, acc[ai][bj][m][1] * gt); }
    }
};
}

#define XB_TMO      128
#define XB_XCNT(j)  (256  + 64 * (j))
#define XB_XSUB(j)  (1280 + 64 * (j))
#define XB_XGEN(j)  (2304 + 64 * (j))
#define XB_TOP      3328
#define XB_TOPGEN   3392
#define XCD_BAR_WORDS 3456
#define XB_SPIN_CAP (1u << 22)

__device__ __forceinline__ unsigned xb_ld(unsigned* p)              { return __hip_atomic_load(p, __ATOMIC_RELAXED, __HIP_MEMORY_SCOPE_AGENT); }
__device__ __forceinline__ unsigned xb_add(unsigned* p, unsigned v) { return __hip_atomic_fetch_add(p, v, __ATOMIC_RELAXED, __HIP_MEMORY_SCOPE_AGENT); }
__device__ __forceinline__ unsigned xb_xcc_id() { return (unsigned)__builtin_amdgcn_s_getreg((3 << 11) | 20) & 0xFu; }
#define XB_SPIN(cond, bar) do { unsigned _sp = 0; while (cond) { __builtin_amdgcn_s_sleep(1); \
    if ((++_sp & 255u) == 0u) { if (xb_ld(&(bar)[XB_TMO])) break; if (_sp > XB_SPIN_CAP) { atomicAdd(&(bar)[XB_TMO], 1u); break; } } } } while (0)

struct XcdBarrier { unsigned* bar; unsigned x; volatile LAS unsigned* st; };

__device__ __forceinline__ XcdBarrier xcd_barrier_post(unsigned* bar, volatile LAS unsigned* st) {
    XcdBarrier b; b.bar = bar; b.x = xb_xcc_id(); b.st = st;
    if (threadIdx.x == 0) (void)xb_add(&bar[XB_XCNT(b.x)], 1u);
    return b;
}
__device__ __forceinline__ void xcd_barrier_complete(unsigned* bar, unsigned x, unsigned& nloc, unsigned& nx) {
    const unsigned G = gridDim.x * gridDim.y * gridDim.z;
    unsigned sum, cnt, mine, sp = 0u;
    for (;;) {
        sum = 0u; cnt = 0u; mine = 0u;
#pragma unroll
        for (unsigned j = 0; j < 16; ++j) { const unsigned c = xb_ld(&bar[XB_XCNT(j)]); sum += c; cnt += (c > 0u) ? 1u : 0u; mine = (j == x) ? c : mine; }
        if (sum == G) break;
        __builtin_amdgcn_s_sleep(1);
        if ((++sp & 255u) == 0u) { if (xb_ld(&bar[XB_TMO])) break; if (sp > XB_SPIN_CAP) { atomicAdd(&bar[XB_TMO], 1u); break; } }
    }
    nloc = mine > 0u ? mine : 1u; nx = cnt > 0u ? cnt : 1u;
}
__device__ __forceinline__ void xcd_barrier(const XcdBarrier& b, int wave_) {
    asm volatile("s_waitcnt vmcnt(0)" ::: "memory");
    __syncthreads();
    int tl_ = wave_ * 64 + fresh_lane();
    if (tl_ == 0) {
        unsigned* bar = b.bar;
        __builtin_amdgcn_s_waitcnt(0);
        unsigned nloc = b.st[0], nx = b.st[1];
        if (nloc == 0u) { xcd_barrier_complete(bar, b.x, nloc, nx); b.st[0] = nloc; b.st[1] = nx; }
        const unsigned old = xb_add(&bar[XB_XSUB(b.x)], 1u);
        const unsigned gen = old / nloc;
        if (old + 1u == (gen + 1u) * nloc) {
            __builtin_amdgcn_fence(__ATOMIC_RELEASE, "agent");
            asm volatile("s_waitcnt vmcnt(0)" ::: "memory");
            const unsigned og = xb_add(&bar[XB_TOP], 1u);
            const unsigned tg = og / nx;
            if (og + 1u == (tg + 1u) * nx) xb_add(&bar[XB_TOPGEN], 1u);
            else XB_SPIN(xb_ld(&bar[XB_TOPGEN]) == tg, bar);
            __builtin_amdgcn_fence(__ATOMIC_ACQUIRE, "agent");
            xb_add(&bar[XB_XGEN(b.x)], 1u);
            asm volatile("s_waitcnt vmcnt(0)" ::: "memory");
        } else {
            XB_SPIN(xb_ld(&bar[XB_XGEN(b.x)]) == gen, bar);
            __builtin_amdgcn_fence(__ATOMIC_ACQUIRE, "agent");
            asm volatile("s_waitcnt vmcnt(0)" ::: "memory");
        }
    }
    __syncthreads();
}

struct Args { const void* in[22]; float* out; unsigned char* ws; };
struct Frame {
    LAS unsigned char* lds; volatile LAS unsigned* MISC; unsigned* ctl;
    int tid, lane, wave, gw; static constexpr int G = 256;
};
__device__ __forceinline__ void glds16(const void* g, LAS void* l) { __builtin_amdgcn_global_load_lds((const unsigned*)g, (LAS unsigned*)l, 16, 0, 0); }
__device__ __forceinline__ int mbcnt64(u64 m) { return (int)__builtin_amdgcn_mbcnt_hi((unsigned)(m >> 32), __builtin_amdgcn_mbcnt_lo((unsigned)m, 0u)); }

__device__ __forceinline__ int il64(int d) { return d < 32 ? 2 * d : 2 * (d - 32) + 1; }
__device__ __forceinline__ int il32(int d) { return d < 16 ? 2 * d : (d < 32 ? 2 * (d - 16) + 1 : d); }
__device__ __forceinline__ int map_row(int mode, int n) {
    if (mode == 1) return n < 2304 ? (n & ~63) + il64(n & 63) : n;
    if (mode == 2) return ((n >> 7) << 8) + (n & 127);
    if (mode == 3) return ((n >> 7) << 8) + 128 + (n & 127);
    if (mode == 4) {
        if (n < 3072) { const int h = n / 192, r = n - h * 192; return r < 128 ? h * 128 + r : 2048 + h * 64 + il64(r - 128); }
        if (n < 3584) return n;
        if (n < 3648) return 3584 + il64(n - 3584);
        if (n < 4672) { const int j = n - 3648; return 3840 + (j & ~63) + il32(j & 63); }
        if (n < 4736) return 3648 + il32(n - 4672);
        return 3712 + (n - 4736);
    }
    return n;
}
__device__ __forceinline__ void tr_item(const float* __restrict__ W, int N, bf16_t* WT, int ldo, int kofs, int mode, LAS float* scr, int item, int lane, float f8scale = 0.f, int rlo = 0, int rhi = 1 << 30) {
    const int nblk = (N + 63) >> 6, kb = item / nblk, nb = item - kb * nblk, k0 = 64 * kb, n0 = 64 * nb;
    const int nc = n0 + 4 * (lane & 15); const bool okr = nc < N; const float* wp = W + (size_t)(k0 + (lane >> 4)) * N + nc;
    f32x4 v[16];
#pragma unroll
    for (int i = 0; i < 16; ++i) v[i] = okr ? *(const f32x4*)(wp + (size_t)(4 * i) * N) : (f32x4){0.f, 0.f, 0.f, 0.f};
#pragma unroll
    for (int i = 0; i < 16; ++i) { const int k = 4 * i + (lane >> 4); *(LAS f32x4*)(scr + k * 64 + ((4 * (lane & 15) + 4 * (i >> 1)) & 63)) = v[i]; }
    LDS_WAIT();
    const int c = lane & 7;
#pragma unroll
    for (int j = 0; j < 8; ++j) { const int nl = (lane >> 3) + 8 * j, n = n0 + nl; const LAS float* s = scr + (8 * c) * 64 + ((nl + 4 * c) & 63);
        const int orow = map_row(mode, n); const bool okw = n < N && orow >= rlo && orow < rhi;
        if (f8scale > 0.f) { u32x2 o8; o8.x = pk4_fp8(s[0 * 64] * f8scale, s[1 * 64] * f8scale, s[2 * 64] * f8scale, s[3 * 64] * f8scale); o8.y = pk4_fp8(s[4 * 64] * f8scale, s[5 * 64] * f8scale, s[6 * 64] * f8scale, s[7 * 64] * f8scale);
            if (okw) *(u32x2*)((unsigned char*)WT + (size_t)orow * ldo + kofs + k0 + 8 * c) = o8; }
        else {
        u32x4 o; o.x = cvt_pk_bf16(s[0 * 64], s[1 * 64]); o.y = cvt_pk_bf16(s[2 * 64], s[3 * 64]); o.z = cvt_pk_bf16(s[4 * 64], s[5 * 64]); o.w = cvt_pk_bf16(s[6 * 64], s[7 * 64]);
        if (okw) *(u32x4*)(WT + (size_t)orow * ldo + kofs + k0 + 8 * c) = o; } }
    LDS_WAIT();
}
__device__ __forceinline__ void tr_matrix(const Frame& F, const float* W, int K, int N, bf16_t* WT, int ldo, int kofs, int mode, float f8scale = 0.f, int rlo = 0, int rhi = 1 << 30) {
    LAS float* scr = (LAS float*)(F.lds + F.wave * 16384);
    const int nitems = (K >> 6) * ((N + 63) >> 6), NGW = F.G * NWAVES;
    for (int it = F.gw; it < nitems; it += NGW) tr_item(W, N, WT, ldo, kofs, mode, scr, it, F.lane, f8scale, rlo, rhi);
}
__device__ __forceinline__ void cvt_linear(const Frame& F, const float* src, bf16_t* dst, size_t n8) {
    const size_t NT = (size_t)F.G * NTHREADS;
    for (size_t i = (size_t)blockIdx.x * NTHREADS + F.tid; i < n8; i += NT) { const f32x4 a = *(const f32x4*)(src + i * 8), b = *(const f32x4*)(src + i * 8 + 4); *(u32x4*)(dst + i * 8) = pg8::pack8(a, b); }
}
__device__ __forceinline__ void cvt_linear8(const Frame& F, const float* src, unsigned char* dst, size_t n8) {
    const size_t NT = (size_t)F.G * NTHREADS;
    for (size_t i = (size_t)blockIdx.x * NTHREADS + F.tid; i < n8; i += NT) { const f32x4 a = *(const f32x4*)(src + i * 8), b = *(const f32x4*)(src + i * 8 + 4); *(u32x2*)(dst + i * 8) = pg8::pack8_fp8(a, b, 1.0f); }
}
__device__ __forceinline__ void sincos_d(double ang, float& c, float& s) {
    const double n = __builtin_rint(ang * 0.6366197723675814);
    double r = __builtin_fma(-n, 1.5707963267948966, ang); r = __builtin_fma(-n, 6.123233995736766e-17, r);
    const double r2 = r * r;
    const double sp = r * (1.0 + r2 * (-1.0 / 6.0 + r2 * (1.0 / 120.0 + r2 * (-1.0 / 5040.0 + r2 * (1.0 / 362880.0 + r2 * (-1.0 / 39916800.0 + r2 * (1.0 / 6227020800.0)))))));
    const double cp = 1.0 + r2 * (-0.5 + r2 * (1.0 / 24.0 + r2 * (-1.0 / 720.0 + r2 * (1.0 / 40320.0 + r2 * (-1.0 / 3628800.0 + r2 * (1.0 / 479001600.0 + r2 * (-1.0 / 87178291200.0)))))));
    const int q = (int)((long long)n & 3);
    const float sf = (float)sp, cf = (float)cp;
    c = q == 0 ? cf : (q == 1 ? -sf : (q == 2 ? -cf : sf));
    s = q == 0 ? sf : (q == 1 ? cf : (q == 2 ? -sf : -cf));
}
__device__ __forceinline__ void rope_tables(const Frame& F, const int* pos, float* tab64, float* tab32) {
    const int NT = F.G * NTHREADS;
    for (int i = blockIdx.x * NTHREADS + F.tid; i < T * 48; i += NT) {
        const int t = i / 48, f = i - t * 48; const bool is64 = f < 32; const int fi = is64 ? f : f - 32;
        const double base = is64 ? 0.7498942093324559 : 0.5623413251903491;
        double inv = 1.0; for (int k = 0; k < fi; ++k) inv *= base;
        float c, s; sincos_d((double)pos[t] * inv, c, s);
        float* o = is64 ? tab64 + ((size_t)t * 32 + fi) * 2 : tab32 + ((size_t)t * 16 + fi) * 2; o[0] = c; o[1] = s;
    }
}

constexpr int MOE_CONV_ITEMS = 8 * 3 * 3584;
constexpr int TOPK_CONV = 11;
__device__ __forceinline__ void moe_conv_item(const float* w1, const float* w3, const float* w2, unsigned char* ws, LAS float* scr, int it, int lane) {
    const int e = it / (3 * 3584), r = it - e * (3 * 3584), mtx = r / 3584, sub = r - mtx * 3584;
    if (mtx < 2) tr_item((mtx == 0 ? w1 : w3) + (size_t)e * DM * MFFN, MFFN, (bf16_t*)(ws + WS_MW13 + (size_t)e * 2 * MFFN * DM), DM, 0, 2 + mtx, scr, sub, lane, W13_F8SCALE);
    else tr_item(w2 + (size_t)e * MFFN * DM, DM, (bf16_t*)(ws + WS_MW2 + (size_t)e * DM * MFFN), MFFN, 0, 0, scr, sub, lane, W2_F8SCALE);
}

__device__ __forceinline__ unsigned ln_col(int lane, int q) { return 8u * (unsigned)(lane & 63) + 512u * (unsigned)(q >> 1) + 4u * (unsigned)(q & 1); }
__device__ __forceinline__ void ln_load16(f32x4 (&v)[8], const bf16_t* row, int lane) {
#pragma unroll
    for (int j = 0; j < 4; ++j) pg8::unpack8(*(const u32x4*)(row + ln_col(lane, 2 * j)), v[2 * j], v[2 * j + 1]);
}
__device__ __forceinline__ void ln_store16(const f32x4 (&v)[8], bf16_t* row, int lane) {
#pragma unroll
    for (int j = 0; j < 4; ++j) *(u32x4*)(row + ln_col(lane, 2 * j)) = pg8::pack8(v[2 * j], v[2 * j + 1]);
}
__device__ __forceinline__ void ln_store8(const f32x4 (&v)[8], unsigned char* row, int lane) {
#pragma unroll
    for (int j = 0; j < 4; ++j) *(u32x2*)(row + ln_col(lane, 2 * j)) = pg8::pack8_fp8(v[2 * j], v[2 * j + 1], 1.0f);
}
__device__ __forceinline__ void ln_core(f32x4 (&v)[8], const float* g, const float* bb, int lane) {
    float s = 0.f;
#pragma unroll
    for (int j = 0; j < 8; ++j) s += (v[j][0] + v[j][1]) + (v[j][2] + v[j][3]);
    const float mean = wave_sum(s) * (1.0f / DM); float s2 = 0.f;
#pragma unroll
    for (int j = 0; j < 8; ++j) { v[j] = v[j] - mean; s2 += (v[j][0] * v[j][0] + v[j][1] * v[j][1]) + (v[j][2] * v[j][2] + v[j][3] * v[j][3]); }
    const float rstd = 1.0f / sqrtf(wave_sum(s2) * (1.0f / DM) + LN_EPS);
    int l2 = lane; asm volatile("" : "+v"(l2) :: "memory");
#pragma unroll
    for (int j = 0; j < 8; ++j) { const f32x4 gv = *(const f32x4*)(g + ln_col(l2, j)), bv = *(const f32x4*)(bb + ln_col(l2, j)); v[j] = v[j] * rstd * gv + bv; }
}
template <bool OUT8> __device__ __forceinline__ void ln_phase(const Frame& F, const bf16_t* YH, bf16_t* X16, unsigned char* X8, const float* g, const float* bb) {
    const int NGW = F.G * NWAVES;
    for (int m = F.gw; m < T; m += NGW) { f32x4 v[8];
        ln_load16(v, YH + (size_t)m * DM, F.lane); ln_core(v, g, bb, F.lane); ln_store16(v, X16 + (size_t)m * DM, F.lane);
        if constexpr (OUT8) ln_store8(v, X8 + (size_t)m * DM, F.lane); }
}

__device__ __forceinline__ int crow(int r, int hi) { return (r & 3) + 8 * (r >> 2) + 4 * hi; }
template <bool OUT8> __device__ __forceinline__ void swa_phase(const Frame& F, bf16_t* Q, const bf16_t* Kb, const bf16_t* VT, const float* sinks, unsigned char* O8) {
    const int lane = F.lane, l31 = lane & 31, hf = lane >> 5;
    for (int wi = blockIdx.x; wi < 4096; wi += F.G) {
        const int kvh = wi & 3, qsi = (wi >> 2) & 511, b = wi >> 11, h = kvh * 8 + F.wave, q0 = qsi * 32;
        const size_t row0 = (size_t)b * SEQ + q0;
        bf16x8 qf[4];
#pragma unroll
        for (int kk = 0; kk < 4; ++kk) { if constexpr (SWA_FRAG) qf[kk] = *(const bf16x8*)(Q + ((((size_t)(b * 32 + h) * 512 + qsi) * 4 + kk) * 64 + lane) * 8);
            else qf[kk] = *(const bf16x8*)(Q + (row0 + l31) * 2048 + h * 64 + 16 * kk + 8 * hf); }
        bf16x8 kf[5][4];
#pragma unroll
        for (int kt = 0; kt < 5; ++kt) {
            int kpos = q0 - 128 + 32 * kt + l31; kpos = kpos < 0 ? 0 : kpos;
            const bf16_t* kp = Kb + ((size_t)b * SEQ + kpos) * 256 + kvh * 64 + 8 * hf;
            const int kblk = qsi - 4 + kt < 0 ? 0 : qsi - 4 + kt;
#pragma unroll
            for (int kk = 0; kk < 4; ++kk) { if constexpr (SWA_FRAG) kf[kt][kk] = *(const bf16x8*)(Kb + ((((size_t)(b * 4 + kvh) * 512 + kblk) * 4 + kk) * 64 + lane) * 8); else kf[kt][kk] = *(const bf16x8*)(kp + 16 * kk); }
        }
        asm volatile("" ::: "memory");
        f32x16 sc[5];
#pragma unroll
        for (int kt = 0; kt < 5; ++kt) {
            f32x16 a;
#pragma unroll
            for (int r = 0; r < 16; ++r) a[r] = 0.f;
#pragma unroll
            for (int kk = 0; kk < 4; ++kk) a = __builtin_amdgcn_mfma_f32_32x32x16_bf16(kf[kt][kk], qf[kk], a, 0, 0, 0);
            sc[kt] = a;
        }
        bf16x8 vf[5][2][2];
#pragma unroll
        for (int kt = 0; kt < 5; ++kt)
#pragma unroll
            for (int c = 0; c < 2; ++c) {
                int kb = q0 - 128 + 32 * kt + 16 * c + 4 * hf; int kb0 = kb < 0 ? 0 : kb, kb1 = kb + 8 < 0 ? 0 : kb + 8;
#pragma unroll
                for (int mt = 0; mt < 2; ++mt) {
                    if constexpr (SWA_FRAG) { const int vblk = qsi - 4 + kt < 0 ? 0 : qsi - 4 + kt; vf[kt][c][mt] = *(const bf16x8*)(VT + (((((size_t)(b * 4 + kvh) * 512 + vblk) * 2 + c) * 2 + mt) * 64 + lane) * 8); }
                    else { const bf16_t* vp = VT + ((size_t)(b * 4 + kvh) * 64 + 32 * mt + l31) * SEQ;
                    const u32x2 v0 = *(const u32x2*)(vp + kb0), v1 = *(const u32x2*)(vp + kb1); u32x4 w; w.x = v0.x; w.y = v0.y; w.z = v1.x; w.w = v1.y; vf[kt][c][mt] = __builtin_bit_cast(bf16x8, w); } }
            }
        asm volatile("" ::: "memory");
        const float sink2 = sinks[h] * LOG2E; const int qpos = q0 + l31;
        float mx = sink2;
#pragma unroll
        for (int kt = 0; kt < 5; ++kt)
#pragma unroll
            for (int r = 0; r < 16; ++r) { const int kpos = q0 - 128 + 32 * kt + crow(r, hf); const bool ok = kpos >= 0 && kpos <= qpos && (qpos - kpos) < 128;
                const float v = ok ? sc[kt][r] : -INFINITY; sc[kt][r] = v; mx = fmaxf(mx, v); }
        mx = fmaxf(mx, shx(mx, 32, lane));
        float sum = 0.f;
#pragma unroll
        for (int kt = 0; kt < 5; ++kt)
#pragma unroll
            for (int r = 0; r < 16; ++r) { const float p = __builtin_amdgcn_exp2f(sc[kt][r] - mx); sc[kt][r] = p; sum += p; }
        sum += shx(sum, 32, lane);
        const float inv = 1.0f / (sum + __builtin_amdgcn_exp2f(sink2 - mx));
        f32x16 o[2];
#pragma unroll
        for (int r = 0; r < 16; ++r) { o[0][r] = 0.f; o[1][r] = 0.f; }
#pragma unroll
        for (int kt = 0; kt < 5; ++kt)
#pragma unroll
            for (int c = 0; c < 2; ++c) {
                bf16x8 pb; { u32x4 w; w.x = cvt_pk_bf16(sc[kt][8 * c + 0], sc[kt][8 * c + 1]); w.y = cvt_pk_bf16(sc[kt][8 * c + 2], sc[kt][8 * c + 3]); w.z = cvt_pk_bf16(sc[kt][8 * c + 4], sc[kt][8 * c + 5]); w.w = cvt_pk_bf16(sc[kt][8 * c + 6], sc[kt][8 * c + 7]); pb = __builtin_bit_cast(bf16x8, w); }
#pragma unroll
                for (int mt = 0; mt < 2; ++mt) o[mt] = __builtin_amdgcn_mfma_f32_32x32x16_bf16(vf[kt][c][mt], pb, o[mt], 0, 0, 0);
            }
        bf16_t* op = Q + (row0 + l31) * 2048 + h * 64; unsigned char* op8 = O8 + (row0 + l31) * 2048 + h * 64; const float inv8 = inv * O0_F8SCALE;
        if constexpr (OUT8) {
#pragma unroll
            for (int mt = 0; mt < 2; ++mt) { unsigned w[4];
#pragma unroll
                for (int r4 = 0; r4 < 4; ++r4) w[r4] = pk4_fp8(o[mt][4 * r4] * inv8, o[mt][4 * r4 + 1] * inv8, o[mt][4 * r4 + 2] * inv8, o[mt][4 * r4 + 3] * inv8);
                const auto s02 = __builtin_amdgcn_permlane32_swap(w[0], w[2], false, false), s13 = __builtin_amdgcn_permlane32_swap(w[1], w[3], false, false);
                u32x4 st; st.x = s02[0]; st.y = s02[1]; st.z = s13[0]; st.w = s13[1];
                *(u32x4*)(op8 + 32 * mt + 16 * hf) = st; }
        } else
#pragma unroll
        for (int mt = 0; mt < 2; ++mt)
#pragma unroll
            for (int r4 = 0; r4 < 4; ++r4) {
                if constexpr (OUT8) *(unsigned*)(op8 + 32 * mt + 8 * r4 + 4 * hf) = pk4_fp8(o[mt][4 * r4] * inv8, o[mt][4 * r4 + 1] * inv8, o[mt][4 * r4 + 2] * inv8, o[mt][4 * r4 + 3] * inv8);
                else { u32x2 w; w.x = cvt_pk_bf16(o[mt][4 * r4] * inv, o[mt][4 * r4 + 1] * inv); w.y = cvt_pk_bf16(o[mt][4 * r4 + 2] * inv, o[mt][4 * r4 + 3] * inv);
                *(u32x2*)(op + 32 * mt + 8 * r4 + 4 * hf) = w; } }
    }
}

__device__ __forceinline__ void kvnorm_phase(const Frame& F, const float* CRAW, const float* gk, bf16_t* KV) {
    const int NGW = F.G * NWAVES;
    for (int m = F.gw; m < T; m += NGW) { const float* cr = CRAW + (size_t)m * 512;
        const f32x4 a = *(const f32x4*)(cr + 4 * F.lane), b = *(const f32x4*)(cr + 256 + 4 * F.lane);
        float s = (a[0] * a[0] + a[1] * a[1]) + (a[2] * a[2] + a[3] * a[3]) + (b[0] * b[0] + b[1] * b[1]) + (b[2] * b[2] + b[3] * b[3]);
        const float r = 1.0f / sqrtf(wave_sum(s) * (1.0f / 512.0f) + RMS_EPS);
        const f32x4 ga = *(const f32x4*)(gk + 4 * F.lane), gb = *(const f32x4*)(gk + 256 + 4 * F.lane);
        if constexpr (F8_KV) { const float r8 = r * KV_F8SCALE; unsigned char* kp = (unsigned char*)KV + (size_t)m * 576 + 4 * F.lane;
            *(unsigned*)kp = pk4_fp8(a[0] * r8 * ga[0], a[1] * r8 * ga[1], a[2] * r8 * ga[2], a[3] * r8 * ga[3]);
            *(unsigned*)(kp + 256) = pk4_fp8(b[0] * r8 * gb[0], b[1] * r8 * gb[1], b[2] * r8 * gb[2], b[3] * r8 * gb[3]); continue; }
        u32x2 w0, w1; w0.x = cvt_pk_bf16(a[0] * r * ga[0], a[1] * r * ga[1]); w0.y = cvt_pk_bf16(a[2] * r * ga[2], a[3] * r * ga[3]);
        w1.x = cvt_pk_bf16(b[0] * r * gb[0], b[1] * r * gb[1]); w1.y = cvt_pk_bf16(b[2] * r * gb[2], b[3] * r * gb[3]);
        *(u32x2*)(KV + (size_t)m * 576 + 4 * F.lane) = w0; *(u32x2*)(KV + (size_t)m * 576 + 256 + 4 * F.lane) = w1; }
}

__device__ __forceinline__ float relu1(float a) { return __builtin_amdgcn_fmed3f(a, 0.f, 3.0e38f); }
__device__ __forceinline__ unsigned f2key(float f) { const unsigned u = __float_as_uint(f); return u ^ ((unsigned)((int)u >> 31) | 0x80000000u); }
__device__ __forceinline__ float key2f(unsigned k) { const unsigned u = (k & 0x80000000u) ? (k ^ 0x80000000u) : ~k; return __uint_as_float(u); }
__device__ __forceinline__ unsigned compact256(LAS u64* buf, int n, int lane) {
    u64 e[8];
#pragma unroll
    for (int i = 0; i < 8; ++i) e[i] = (lane + 64 * i < n) ? buf[lane + 64 * i] : 0ull;
    unsigned thr = 0u;
    for (int bit = 31; bit >= 0; --bit) {
        const unsigned cand = thr | (1u << bit); int c = 0;
#pragma unroll
        for (int i = 0; i < 8; ++i) c += __popcll(__ballot((unsigned)(e[i] >> 32) >= cand));
        if (c >= 256) thr = cand;
    }
    int ngt = 0;
#pragma unroll
    for (int i = 0; i < 8; ++i) ngt += __popcll(__ballot((unsigned)(e[i] >> 32) > thr));
    int pos_gt = 0, pos_eq = ngt;
#pragma unroll
    for (int i = 0; i < 8; ++i) { const unsigned k = (unsigned)(e[i] >> 32); const bool gt = k > thr, eq = k == thr; const u64 mg = __ballot(gt), me = __ballot(eq);
        if (gt) buf[pos_gt + mbcnt64(mg)] = e[i];
        const int re = pos_eq + mbcnt64(me); if (eq && re < 256) buf[re] = e[i];
        pos_gt += __popcll(mg); pos_eq += __popcll(me); }
    return thr;
}
__device__ __forceinline__ unsigned compact_bound(LAS u64* buf, int n, int lane, unsigned lo, int& n_out) {
    u64 e[8]; unsigned mx = 0u;
#pragma unroll
    for (int i = 0; i < 8; ++i) { e[i] = (lane + 64 * i < n) ? buf[lane + 64 * i] : 0ull; const unsigned k = (unsigned)(e[i] >> 32); mx = k > mx ? k : mx; }
#pragma unroll
    for (int o = 1; o < 64; o <<= 1) { const unsigned t = (unsigned)__builtin_amdgcn_ds_bpermute((lane ^ o) << 2, (int)mx); mx = t > mx ? t : mx; }
    mx = (unsigned)__builtin_amdgcn_readfirstlane((int)mx);
    const unsigned diff = mx ^ lo; const int hb = diff ? 31 - __builtin_clz(diff) : 0;
    unsigned thr = hb >= 31 ? 0u : (lo & ~((2u << hb) - 1u)); int cge = n;
    for (int bit = hb; bit >= 0; --bit) {
        const unsigned cand = thr | (1u << bit); int c = 0;
#pragma unroll
        for (int i = 0; i < 8; ++i) c += __popcll(__ballot((unsigned)(e[i] >> 32) >= cand));
        if (c >= 256) { thr = cand; cge = c; if (c <= 288) break; }
    }
    int pos = 0;
#pragma unroll
    for (int i = 0; i < 8; ++i) { const bool ge = (unsigned)(e[i] >> 32) >= thr && (lane + 64 * i < n); const u64 mg = __ballot(ge);
        if (ge) buf[pos + mbcnt64(mg)] = e[i];
        pos += __popcll(mg); }
    n_out = pos;
    return thr;
}
template <bool CONV = false> __device__ __forceinline__ void topk_phase(const Frame& F, const bf16_t* QI, const bf16_t* KIF, const float* WI, unsigned short* SEL) {
    const int lane = F.lane, l31 = lane & 31, hf = lane >> 5, wave = F.wave;
    LAS u64* mybuf = (LAS u64*)F.lds + (size_t)(wave * 4) * 512;
    const unsigned lmask_lt = (1u << l31) - 1u; const int hfm = -hf;
    for (int pu = blockIdx.x; pu < 512; pu += F.G) {
        const int b = pu >> 8, pi = pu & 255;
        for (int half = 0; half < 2; ++half) {
            const int tq = half == 0 ? pi : 511 - pi, q0 = tq * 32, nsteps = tq + 1;
            const size_t trow0 = (size_t)b * SEQ + q0 + 4 * wave;
            bf16x8 aq[2][4]; float wq[2][16];
#pragma unroll
            for (int s = 0; s < 2; ++s) {
                const int qq = 2 * s + ((l31 >> 2) & 1), hd = 4 * (l31 >> 3) + (l31 & 3);
#pragma unroll
                for (int kk = 0; kk < 4; ++kk) aq[s][kk] = *(const bf16x8*)(QI + ((trow0 + qq) * 16 + hd) * 64 + 16 * kk + 8 * hf);
                const float* wp = WI + (trow0 + 2 * s + hf) * 16;
#pragma unroll
                for (int r4 = 0; r4 < 4; ++r4) { const f32x4 w = *(const f32x4*)(wp + 4 * r4); wq[s][4 * r4] = w[0]; wq[s][4 * r4 + 1] = w[1]; wq[s][4 * r4 + 2] = w[2]; wq[s][4 * r4 + 3] = w[3]; }
            }
            float psc0 = 0.f, psc1 = 0.f; int pix0 = 0, pix1 = 0; bool pv0 = false, pv1 = false;
            float thr0 = -INFINITY, thr1 = -INFINITY; int c0 = 0, c1 = 0, c2 = 0, c3 = 0; unsigned b0 = 0x007fffffu, b1 = 0x007fffffu, b2 = 0x007fffffu, b3 = 0x007fffffu;
            const bf16_t* kbase = KIF + (size_t)b * 512 * 4 * 64 * 8 + (size_t)lane * 8;
            bf16x8 k0[4], k1[4], k2[4], k3[4];
#pragma unroll
            for (int kk = 0; kk < 4; ++kk) { k0[kk] = *(const bf16x8*)(kbase + (size_t)(0 * 4 + kk) * 512); k1[kk] = *(const bf16x8*)(kbase + (size_t)((nsteps > 1 ? 1 : 0) * 4 + kk) * 512);
                k2[kk] = *(const bf16x8*)(kbase + (size_t)((nsteps > 2 ? 2 : nsteps - 1) * 4 + kk) * 512); k3[kk] = *(const bf16x8*)(kbase + (size_t)((nsteps > 3 ? 3 : nsteps - 1) * 4 + kk) * 512); }
#define TOPK_STEP(KB, STEP) { const int kidx = 32 * (STEP) + l31; \
    f32x16 a0_, a1_; _Pragma("unroll") for (int r = 0; r < 16; ++r) { a0_[r] = 0.f; a1_[r] = 0.f; } \
    _Pragma("unroll") for (int kk = 0; kk < 4; ++kk) a0_ = __builtin_amdgcn_mfma_f32_32x32x16_bf16(aq[0][kk], KB[kk], a0_, 0, 0, 0); \
    _Pragma("unroll") for (int kk = 0; kk < 4; ++kk) a1_ = __builtin_amdgcn_mfma_f32_32x32x16_bf16(aq[1][kk], KB[kk], a1_, 0, 0, 0); \
    { const int sn_ = (STEP) + 4 < nsteps ? (STEP) + 4 : nsteps - 1; _Pragma("unroll") for (int kk = 0; kk < 4; ++kk) KB[kk] = *(const bf16x8*)(kbase + (size_t)(sn_ * 4 + kk) * 512); }     \
    float sc0_ = 0.f, sc1_ = 0.f; \
    _Pragma("unroll") for (int r = 0; r < 16; ++r) sc0_ = fmaf(wq[0][r], relu1(a0_[r]), sc0_); \
    _Pragma("unroll") for (int r = 0; r < 16; ++r) sc1_ = fmaf(wq[1][r], relu1(a1_[r]), sc1_); \
    const int tql0_ = q0 + 4 * wave + hf; \
    const bool pass0_ = (sc0_ > thr0) && (kidx <= tql0_), pass1_ = (sc1_ > thr1) && (kidx <= tql0_ + 2); \
      \
    if (__ballot((pass0_ && pv0) || (pass1_ && pv1))) { TOPK_FLUSH(); } \
    psc0 = pass0_ ? sc0_ : psc0; pix0 = pass0_ ? kidx : pix0; pv0 = pv0 || pass0_; \
    psc1 = pass1_ ? sc1_ : psc1; pix1 = pass1_ ? kidx : pix1; pv1 = pv1 || pass1_; }
#define TOPK_FLUSH() { const u64 mask0_ = __ballot(pv0), mask1_ = __ballot(pv1); \
        if (mask0_) { const unsigned lo = (unsigned)mask0_, hi = (unsigned)(mask0_ >> 32); const int plo = __popc(lo), phi = __popc(hi); \
          const int rank = mbcnt64(mask0_) - (plo & hfm); const int cm = c0 + ((c1 - c0) & hfm); \
          if (pv0) mybuf[hf * 512 + cm + rank] = ((u64)f2key(psc0) << 32) | (unsigned)pix0; c0 += plo; c1 += phi; } \
        if (mask1_) { const unsigned lo = (unsigned)mask1_, hi = (unsigned)(mask1_ >> 32); const int plo = __popc(lo), phi = __popc(hi); \
          const int rank = mbcnt64(mask1_) - (plo & hfm); const int cm = c2 + ((c3 - c2) & hfm); \
          if (pv1) mybuf[(2 + hf) * 512 + cm + rank] = ((u64)f2key(psc1) << 32) | (unsigned)pix1; c2 += plo; c3 += phi; } \
        pv0 = false; pv1 = false; \
        const int cmx_ = max(max(c0, c1), max(c2, c3)); \
        if (cmx_ > 480) { \
        if (c0 > 480) { b0 = compact_bound(mybuf, c0, lane, b0, c0); const float nt = key2f(b0); thr0 = hf == 0 ? nt : thr0; } \
        if (c1 > 480) { b1 = compact_bound(mybuf + 512, c1, lane, b1, c1); const float nt = key2f(b1); thr0 = hf == 1 ? nt : thr0; } \
        if (c2 > 480) { b2 = compact_bound(mybuf + 1024, c2, lane, b2, c2); const float nt = key2f(b2); thr1 = hf == 0 ? nt : thr1; } \
        if (c3 > 480) { b3 = compact_bound(mybuf + 1536, c3, lane, b3, c3); const float nt = key2f(b3); thr1 = hf == 1 ? nt : thr1; } } }
            for (int st = 0; st < nsteps; st += 4) {
                TOPK_STEP(k0, st);
                if (st + 1 < nsteps) TOPK_STEP(k1, st + 1);
                if (st + 2 < nsteps) TOPK_STEP(k2, st + 2);
                if (st + 3 < nsteps) TOPK_STEP(k3, st + 3);
            }
            TOPK_FLUSH();
#undef TOPK_STEP
#undef TOPK_FLUSH
#pragma unroll
            for (int qi = 0; qi < 4; ++qi) {
                int c = qi == 0 ? c0 : (qi == 1 ? c1 : (qi == 2 ? c2 : c3)); LAS u64* bq = mybuf + qi * 512;
                if (c > 256) { (void)compact256(bq, c, lane); c = 256; }
                LDS_WAIT();
                unsigned short v[4];
#pragma unroll
                for (int j = 0; j < 4; ++j) { const int e = 4 * lane + j; v[j] = e < c ? (unsigned short)(bq[e] & 0xffffull) : (unsigned short)0xffff; }
                u32x2 w; w.x = (unsigned)v[0] | ((unsigned)v[1] << 16); w.y = (unsigned)v[2] | ((unsigned)v[3] << 16);
                *(u32x2*)(SEL + (trow0 + qi) * 256 + 4 * lane) = w;
            }
            LDS_WAIT();
            if constexpr (CONV) { int lane2 = F.lane; asm volatile("" : "+v"(lane2)); const int NGW = F.G * NWAVES, iter = 2 * ((pu - (int)blockIdx.x) / F.G) + half;
                typedef const unsigned char __attribute__((address_space(4))) kab_t;
                kab_t* ka = (kab_t*)__builtin_amdgcn_kernarg_segment_ptr();
                const float* w1 = *(const float* const __attribute__((address_space(4)))*)(ka + 15 * 8); const float* w3 = *(const float* const __attribute__((address_space(4)))*)(ka + 16 * 8);
                const float* w2 = *(const float* const __attribute__((address_space(4)))*)(ka + 17 * 8); unsigned char* ws = *(unsigned char* const __attribute__((address_space(4)))*)(ka + 23 * 8);
#pragma unroll 1
                for (int k = 0; k < TOPK_CONV; ++k) { const int it = F.gw + NGW * (TOPK_CONV * iter + k); if (it < MOE_CONV_ITEMS) moe_conv_item(w1, w3, w2, ws, (LAS float*)mybuf, it, lane2); } }
        }
    }
}

__device__ __forceinline__ bf16x4 tr_read16(const LAS unsigned char* p) { return __builtin_bit_cast(bf16x4, __builtin_amdgcn_ds_read_tr16_b64_v4i16((LAS bf16x4*)p)); }
__device__ __forceinline__ void dsa_attn_phase(const Frame& F, const bf16_t* QLAT, bf16_t* OUT, const bf16_t* QR, const bf16_t* KV, const unsigned short* SEL, const float* w1, const float* w3, const float* w2, unsigned char* ws) {
    LAS unsigned char* wb = F.lds + F.wave * DSA_WBUF; LAS unsigned char* tails = wb + 16640;
    const unsigned char* KVb = (const unsigned char*)KV;
    const int NGW = F.G * NWAVES;
    for (int tg = F.gw; tg < T; tg += NGW) {
        int lane = F.lane; asm volatile("" : "+v"(lane));
        const int l15 = lane & 15, g = lane >> 4;
        const int b = tg >> 14, t = tg & (SEQ - 1); const int nvalid = t + 1 < 256 ? t + 1 : 256, nsteps = (nvalid + 15) >> 4;
        bf16x8 qf[18];
#pragma unroll
        for (int kk = 0; kk < 16; ++kk) {
            if constexpr (F8_LAT) { const u32x2 w8 = *(const u32x2*)((const unsigned char*)QLAT + ((size_t)tg * 16 + l15) * 512 + 32 * kk + 8 * g);
                const f32x2 f0 = __builtin_amdgcn_cvt_pk_f32_fp8((int)w8.x, false), f1 = __builtin_amdgcn_cvt_pk_f32_fp8((int)w8.x, true), f2 = __builtin_amdgcn_cvt_pk_f32_fp8((int)w8.y, false), f3 = __builtin_amdgcn_cvt_pk_f32_fp8((int)w8.y, true);
                u32x4 wb16; wb16.x = cvt_pk_bf16(f0[0], f0[1]); wb16.y = cvt_pk_bf16(f1[0], f1[1]); wb16.z = cvt_pk_bf16(f2[0], f2[1]); wb16.w = cvt_pk_bf16(f3[0], f3[1]); qf[kk] = __builtin_bit_cast(bf16x8, wb16); }
            else qf[kk] = *(const bf16x8*)(QLAT + ((size_t)tg * 16 + l15) * 512 + 32 * kk + 8 * g); }
#pragma unroll
        for (int kk = 0; kk < 2; ++kk) qf[16 + kk] = *(const bf16x8*)(QR + ((size_t)tg * 16 + l15) * 64 + 32 * kk + 8 * g);
        float m = -INFINITY, lsum = 0.f; f32x4 O[32];
#pragma unroll
        for (int mt = 0; mt < 32; ++mt) O[mt] = (f32x4){0.f, 0.f, 0.f, 0.f};
        for (int st = 0; st < nsteps; ++st) {
            const int slot = 16 * st + l15;
            int idx = slot < nvalid ? (int)SEL[(size_t)tg * 256 + slot] : 0; idx = idx > t ? 0 : idx;
            const int row = b * SEQ + idx;
            LDS_WAIT();
#pragma unroll
            for (int r = 0; r < 16; ++r) { const int rr = __builtin_amdgcn_readlane(row, r); glds16(KVb + (size_t)rr * 1152 + 16 * lane, wb + r * 1040); }
#pragma unroll
            for (int p = 0; p < 2; ++p) glds16(KVb + (size_t)row * 1152 + 1024 + 16 * (4 * p + g), tails + 1024 * p);
            VM_WAIT();
            f32x4 sacc = (f32x4){0.f, 0.f, 0.f, 0.f};
#pragma unroll
            for (int kk = 0; kk < 16; ++kk) { const bf16x8 a = *(const LAS bf16x8*)(wb + l15 * 1040 + (4 * kk + g) * 16); sacc = __builtin_amdgcn_mfma_f32_16x16x32_bf16(a, qf[kk], sacc, 0, 0, 0); }
#pragma unroll
            for (int kk = 0; kk < 2; ++kk) { const bf16x8 a = *(const LAS bf16x8*)(tails + (4 * kk + g) * 256 + l15 * 16); sacc = __builtin_amdgcn_mfma_f32_16x16x32_bf16(a, qf[16 + kk], sacc, 0, 0, 0); }
            float s[4]; float tmax = -INFINITY;
#pragma unroll
            for (int i = 0; i < 4; ++i) { s[i] = (16 * st + 4 * g + i) < nvalid ? sacc[i] * (F8_LAT ? SCALE2_MLA / QLAT_F8SCALE : SCALE2_MLA) : -INFINITY; tmax = fmaxf(tmax, s[i]); }
            tmax = fmaxf(tmax, shx(tmax, 16, lane)); tmax = fmaxf(tmax, shx(tmax, 32, lane));
            const float mnew = fmaxf(m, tmax); const float alpha = __builtin_amdgcn_exp2f(m - mnew); m = mnew;
            float p[4];
#pragma unroll
            for (int i = 0; i < 4; ++i) p[i] = __builtin_amdgcn_exp2f(s[i] - mnew);
            lsum = lsum * alpha + ((p[0] + p[1]) + (p[2] + p[3]));
            if (__any(alpha != 1.0f)) {
#pragma unroll
                for (int mt = 0; mt < 32; ++mt) O[mt] = O[mt] * alpha;
            }
            u32x2 pw; pw.x = cvt_pk_bf16(p[0], p[1]); pw.y = cvt_pk_bf16(p[2], p[3]); const bf16x4 pb = __builtin_bit_cast(bf16x4, pw);
            const LAS unsigned char* trb = wb + (4 * g + (l15 >> 2)) * 1040 + (lane & 3) * 8;
#pragma unroll
            for (int mt = 0; mt < 32; ++mt) { const bf16x4 a = tr_read16(trb + mt * 32); O[mt] = __builtin_amdgcn_mfma_f32_16x16x16bf16_1k(a, pb, O[mt], 0, 0, 0); }
        }
        float lt = lsum + shx(lsum, 16, lane); lt += shx(lt, 32, lane); const float inv = 1.0f / lt;
        if constexpr (F8_LAT) { unsigned char* op8 = (unsigned char*)OUT + ((size_t)tg * 16 + l15) * 512 + 4 * g; const float inv8 = inv * OLAT_F8SCALE;
#pragma unroll
            for (int mt = 0; mt < 32; ++mt) *(unsigned*)(op8 + 16 * mt) = pk4_fp8(O[mt][0] * inv8, O[mt][1] * inv8, O[mt][2] * inv8, O[mt][3] * inv8); }
        else { bf16_t* op = OUT + ((size_t)tg * 16 + l15) * 512 + 4 * g;
#pragma unroll
        for (int mt = 0; mt < 32; ++mt) { u32x2 w; w.x = cvt_pk_bf16(O[mt][0] * inv, O[mt][1] * inv); w.y = cvt_pk_bf16(O[mt][2] * inv, O[mt][3] * inv); *(u32x2*)(op + 16 * mt) = w; } }
        if (w1) { LDS_WAIT(); int lane2 = F.lane; asm volatile("" : "+v"(lane2));
            for (int k = 0; k < 3; ++k) { const int it = F.gw + NGW * (3 * ((tg - F.gw) / NGW) + k); if (it < MOE_CONV_ITEMS) moe_conv_item(w1, w3, w2, ws, (LAS float*)wb, it, lane2); } }
    }
    LDS_WAIT();
}

__device__ __forceinline__ long tr_read8(const LAS unsigned char* p) { return __builtin_bit_cast(long, __builtin_amdgcn_ds_read_tr8_b64_v2i32((LAS i32x2*)p)); }
__device__ __forceinline__ void dsa_attn8_phase(const Frame& F, const unsigned char* QLAT, unsigned char* OUT, const unsigned char* QR, const unsigned char* KVb, const unsigned short* SEL, const float* w1, const float* w3, const float* w2, unsigned char* ws) {
    LAS unsigned char* wb = F.lds + F.wave * DSA_WBUF; LAS unsigned char* tails = wb + 16640;
    const int NGW = F.G * NWAVES;
    for (int tg = F.gw; tg < T; tg += NGW) {
        int lane = F.lane; asm volatile("" : "+v"(lane));
        const int l15 = lane & 15, g = lane >> 4;
        const int b = tg >> 14, t = tg & (SEQ - 1); const int nvalid = t + 1 < 256 ? t + 1 : 256, nsteps = (nvalid + 31) >> 5;
        i32x8 qf[5];
        { const unsigned char* qp = QLAT + ((size_t)tg * 16 + l15) * 512 + 32 * g;
#pragma unroll
          for (int kk = 0; kk < 4; ++kk) { const i32x4 lo = *(const i32x4*)(qp + 128 * kk), hi = *(const i32x4*)(qp + 128 * kk + 16); qf[kk] = (i32x8){lo[0], lo[1], lo[2], lo[3], hi[0], hi[1], hi[2], hi[3]}; }
          const i32x4 r = *(const i32x4*)(QR + ((size_t)tg * 16 + l15) * 64 + 16 * g); qf[4] = (i32x8){r[0], r[1], r[2], r[3], 0, 0, 0, 0}; }
        float m = -INFINITY, lsum = 0.f; f32x4 O[32];
#pragma unroll
        for (int mt = 0; mt < 32; ++mt) O[mt] = (f32x4){0.f, 0.f, 0.f, 0.f};
        const int dtau = (lane >> 2) & 1, dch = 16 * (4 * (lane >> 3) + (lane & 3));
        int s0, s1, s2, s3, s4, s5, s6, s7;
        { const unsigned short* sp = SEL + (size_t)tg * 256 + (lane & 31); const int l31 = lane & 31;
          s0 = l31 < nvalid ? (int)sp[0] : 0; s1 = 32 + l31 < nvalid ? (int)sp[32] : 0; s2 = 64 + l31 < nvalid ? (int)sp[64] : 0; s3 = 96 + l31 < nvalid ? (int)sp[96] : 0;
          s4 = 128 + l31 < nvalid ? (int)sp[128] : 0; s5 = 160 + l31 < nvalid ? (int)sp[160] : 0; s6 = 192 + l31 < nvalid ? (int)sp[192] : 0; s7 = 224 + l31 < nvalid ? (int)sp[224] : 0; }
        for (int st = 0; st < nsteps; ++st) {
            int idx = s0; s0 = s1; s1 = s2; s2 = s3; s3 = s4; s4 = s5; s5 = s6; s6 = s7; idx = idx > t ? 0 : idx;
            const int row = b * SEQ + idx;
            LDS_WAIT();
#pragma unroll
            for (int p = 0; p < 16; ++p) { const int r0 = __builtin_amdgcn_readlane(row, p), r1 = __builtin_amdgcn_readlane(row, 16 + p); const int rr = dtau ? r1 : r0;
                glds16(KVb + (size_t)rr * 576 + dch, wb + p * 1040); }
#pragma unroll
            for (int p = 0; p < 2; ++p) glds16(KVb + (size_t)row * 576 + 512 + 16 * (2 * p + (lane >> 5)), tails + 1024 * p);
            VM_WAIT();
            f32x4 sacc[2] = {(f32x4){0.f, 0.f, 0.f, 0.f}, (f32x4){0.f, 0.f, 0.f, 0.f}};
            const LAS unsigned char* sb = wb + l15 * 1040 + 16 * (8 * (g >> 1) + 2 * (g & 1));
#pragma unroll
            for (int kk = 0; kk < 4; ++kk)
#pragma unroll
                for (int tu = 0; tu < 2; ++tu) { const i32x4 lo = *(const LAS i32x4*)(sb + 256 * kk + 64 * tu), hi = *(const LAS i32x4*)(sb + 256 * kk + 64 * tu + 16);
                    const i32x8 a = (i32x8){lo[0], lo[1], lo[2], lo[3], hi[0], hi[1], hi[2], hi[3]};
                    sacc[tu] = __builtin_amdgcn_mfma_scale_f32_16x16x128_f8f6f4(a, qf[kk], sacc[tu], 0, 0, 0, 0, 0, 0); }
#pragma unroll
            for (int tu = 0; tu < 2; ++tu) { const i32x4 lo = *(const LAS i32x4*)(tails + (g * 32 + 16 * tu + l15) * 16);
                const i32x8 a = (i32x8){lo[0], lo[1], lo[2], lo[3], 0, 0, 0, 0};
                sacc[tu] = __builtin_amdgcn_mfma_scale_f32_16x16x128_f8f6f4(a, qf[4], sacc[tu], 0, 0, 0, 0, 0, 0); }
            float s[8]; float tmax = -INFINITY;
#pragma unroll
            for (int tu = 0; tu < 2; ++tu)
#pragma unroll
                for (int i = 0; i < 4; ++i) { s[4 * tu + i] = (32 * st + 16 * tu + 4 * g + i) < nvalid ? sacc[tu][i] * (SCALE2_MLA / (QLAT_F8SCALE * KV_F8SCALE)) : -INFINITY; tmax = fmaxf(tmax, s[4 * tu + i]); }
            tmax = fmaxf(tmax, shx(tmax, 16, lane)); tmax = fmaxf(tmax, shx(tmax, 32, lane));
            if (__any(tmax > m + 0.75f)) {
                const float mnew = fmaxf(m, tmax); const float alpha = __builtin_amdgcn_exp2f(m - mnew); m = mnew; lsum *= alpha;
#pragma unroll
                for (int mt = 0; mt < 32; ++mt) O[mt] = O[mt] * alpha;
            }
            const float mo = m - 8.0f;
            float p[8];
#pragma unroll
            for (int i = 0; i < 8; ++i) p[i] = __builtin_amdgcn_exp2f(s[i] - mo);
            lsum += (((p[0] + p[1]) + (p[2] + p[3])) + ((p[4] + p[5]) + (p[6] + p[7])));
            u32x2 pw; pw.x = pk4_fp8(p[0], p[1], p[2], p[3]); pw.y = pk4_fp8(p[4], p[5], p[6], p[7]); const long pb = __builtin_bit_cast(long, pw);
            const LAS unsigned char* trb = wb + (4 * g + ((l15 >> 1) & 3)) * 1040 + 64 * (l15 >> 3) + 8 * (l15 & 1);
#pragma unroll
            for (int mt = 0; mt < 32; ++mt) { const long a = tr_read8(trb + 128 * (mt >> 2) + 16 * (mt & 3)); O[mt] = __builtin_amdgcn_mfma_f32_16x16x32_fp8_fp8(a, pb, O[mt], 0, 0, 0); }
        }
        float lt = lsum + shx(lsum, 16, lane); lt += shx(lt, 32, lane); const float inv8 = (OLAT_F8SCALE / KV_F8SCALE) / lt;
        unsigned char* op8 = OUT + ((size_t)tg * 16 + l15) * 512 + 16 * g;
#pragma unroll
        for (int a = 0; a < 8; ++a) { unsigned w[4];
#pragma unroll
            for (int mm = 0; mm < 4; ++mm) w[mm] = pk4_fp8(O[4 * a + mm][0] * inv8, O[4 * a + mm][1] * inv8, O[4 * a + mm][2] * inv8, O[4 * a + mm][3] * inv8);
            { const auto s0 = __builtin_amdgcn_permlane32_swap(w[0], w[2], false, false), s1 = __builtin_amdgcn_permlane32_swap(w[1], w[3], false, false); w[0] = s0[0]; w[2] = s0[1]; w[1] = s1[0]; w[3] = s1[1]; }
            { const auto s0 = __builtin_amdgcn_permlane16_swap(w[0], w[1], false, false), s1 = __builtin_amdgcn_permlane16_swap(w[2], w[3], false, false); w[0] = s0[0]; w[1] = s0[1]; w[2] = s1[0]; w[3] = s1[1]; }
            u32x4 st; st.x = w[0]; st.y = w[1]; st.z = w[2]; st.w = w[3];
            *(u32x4*)(op8 + 64 * a) = st; }
        if (w1) { LDS_WAIT(); int lane2 = F.lane; asm volatile("" : "+v"(lane2));
            for (int k = 0; k < 3; ++k) { const int it = F.gw + NGW * (3 * ((tg - F.gw) / NGW) + k); if (it < MOE_CONV_ITEMS) moe_conv_item(w1, w3, w2, ws, (LAS float*)wb, it, lane2); } }
    }
    LDS_WAIT();
}

__device__ __forceinline__ void ln_router_phase(const Frame& F, const bf16_t* YH, bf16_t* XB, const float* g, const float* bb, const float* wr, int* TOKE, float* TOKG, int* TOKL) {
    LAS float* wl = (LAS float*)F.lds;
    for (int i = F.tid; i < DM * NEXP; i += NTHREADS) { const int d = i >> 3, e = i & 7; wl[e * DM + d] = wr[i]; }
    __syncthreads();
    const int NGW = F.G * NWAVES, lane = F.lane;
    u64 cnt64 = 0ull; int mine = 0;
    int j = 0;
    for (int m = F.gw; m < T; m += NGW, ++j) { f32x4 v[8];
        ln_load16(v, YH + (size_t)m * DM, lane); ln_core(v, g, bb, lane); ln_store8(v, (unsigned char*)XB + (size_t)m * DM, lane);
        float lg[8];
#pragma unroll
        for (int e = 0; e < 8; ++e) { float s = 0.f;
#pragma unroll
            for (int q = 0; q < 8; ++q) { const f32x4 w = *(const LAS f32x4*)(wl + e * DM + ln_col(lane, q)); s += (v[q][0] * w[0] + v[q][1] * w[1]) + (v[q][2] * w[2] + v[q][3] * w[3]); }
            lg[e] = wave_sum(s); }
        int e1 = 0; float v1 = lg[0];
#pragma unroll
        for (int e = 1; e < 8; ++e) if (lg[e] > v1) { v1 = lg[e]; e1 = e; }
        int e2 = -1; float v2 = -INFINITY;
#pragma unroll
        for (int e = 0; e < 8; ++e) if (e != e1 && lg[e] > v2) { v2 = lg[e]; e2 = e; }
        const float g1 = 1.0f / (1.0f + __expf(v2 - v1)), g2 = 1.0f - g1;
        const int r1 = (int)((cnt64 >> (8 * e1)) & 0xffull); cnt64 += 1ull << (8 * e1);
        const int r2 = (int)((cnt64 >> (8 * e2)) & 0xffull); cnt64 += 1ull << (8 * e2);
        if (lane == 0) { TOKE[2 * m] = e1; TOKE[2 * m + 1] = e2; TOKG[2 * m] = g1; TOKG[2 * m + 1] = g2; }
        if (lane == j) mine = e1 | (e2 << 4) | (r1 << 8) | (r2 << 16);
    }
    int basev = 0;
    if (lane < 8) { const unsigned c = (unsigned)((cnt64 >> (8 * lane)) & 0xffull); basev = (int)__hip_atomic_fetch_add(F.ctl + CW_CNT + lane, c, __ATOMIC_RELAXED, __HIP_MEMORY_SCOPE_AGENT); }
    const int e1 = mine & 15, e2 = (mine >> 4) & 15, r1 = (mine >> 8) & 255, r2 = (mine >> 16) & 255;
    const int b1 = __builtin_amdgcn_ds_bpermute(e1 << 2, basev), b2 = __builtin_amdgcn_ds_bpermute(e2 << 2, basev);
    if (lane < j) { const int m = F.gw + NGW * lane; TOKL[2 * m] = b1 + r1; TOKL[2 * m + 1] = b2 + r2; }
    __syncthreads();
}
__device__ __forceinline__ void moe_tiles(const Frame& F) {
    if (F.tid == 0) { int acc = 0;
        for (int e = 0; e < 8; ++e) { const unsigned c = __hip_atomic_load(F.ctl + CW_CNT + e, __ATOMIC_RELAXED, __HIP_MEMORY_SCOPE_AGENT); F.MISC[32 + e] = c; F.MISC[40 + e] = (unsigned)acc; acc += (int)((c + 255u) >> 8); F.MISC[20 + e] = (unsigned)acc; }
        F.MISC[28] = (unsigned)acc; }
    __syncthreads();
}
__device__ __forceinline__ void moe_gather_phase(const Frame& F, const bf16_t* XB, const int* TOKE, const float* TOKG, const int* TOKL, int* TOKS, float* SGATE, bf16_t* XG) {
    const int NGW = F.G * NWAVES, lane = F.lane;
    for (int m = F.gw; m < T; m += NGW) {
        const u32x4* src = (const u32x4*)((const unsigned char*)XB + (size_t)m * DM);
        const u32x4 a0 = src[lane], a1 = src[64 + lane];
#pragma unroll
        for (int k = 0; k < 2; ++k) { const int e = TOKE[2 * m + k], li = TOKL[2 * m + k]; const int slot = (int)F.MISC[40 + e] * 256 + li;
            u32x4* dst = (u32x4*)((unsigned char*)XG + (size_t)slot * DM); dst[lane] = a0; dst[64 + lane] = a1;
            if (lane == 0) { TOKS[2 * m + k] = slot; SGATE[slot] = TOKG[2 * m + k]; } }
    }
    for (int it = F.gw; it < 8 * 256; it += NGW) { const int e = it >> 8, r = it & 255; const int c = (int)F.MISC[32 + e]; const int ntile = (c + 255) >> 8; const int row = c + r;
        if (row < ntile * 256) { const int slot = (int)F.MISC[40 + e] * 256 + row; u32x4* dst = (u32x4*)((unsigned char*)XG + (size_t)slot * DM); const u32x4 z = {0u, 0u, 0u, 0u};
            dst[lane] = z; dst[64 + lane] = z; if (lane == 0) SGATE[slot] = 0.f; } }
}
__device__ __forceinline__ void moe_combine_ln_phase(const Frame& F, const bf16_t* YH, bf16_t* XB, unsigned char* X8, const bf16_t* SOUT, const int* TOKS, const float* g1, const float* bb1, const float* g, const float* bb) {
    const int NGW = F.G * NWAVES, lane = F.lane;
    for (int m = F.gw; m < T; m += NGW) { f32x4 v[8];
        const int t0 = __builtin_amdgcn_readfirstlane(TOKS[2 * m]), t1 = __builtin_amdgcn_readfirstlane(TOKS[2 * m + 1]);
        const bf16_t* s0 = SOUT + (size_t)t0 * DM; const bf16_t* s1 = SOUT + (size_t)t1 * DM;
        ln_load16(v, YH + (size_t)m * DM, lane);
        ln_core(v, g1, bb1, lane);
#pragma unroll
        for (int j = 0; j < 4; ++j) { f32x4 a0, a1, c0, c1; pg8::unpack8(*(const u32x4*)(s0 + ln_col(lane, 2 * j)), a0, a1); pg8::unpack8(*(const u32x4*)(s1 + ln_col(lane, 2 * j)), c0, c1);
            v[2 * j] = v[2 * j] * ALPHA + (a0 + c0); v[2 * j + 1] = v[2 * j + 1] * ALPHA + (a1 + c1); }
        ln_core(v, g, bb, lane); ln_store16(v, XB + (size_t)m * DM, lane); if constexpr (F8_G1) { int ls = lane; asm volatile("" : "+v"(ls)); ln_store8(v, X8 + (size_t)m * DM, ls); } }
}

#ifndef PHASES
#define PHASES 0xFFFFFFFFu
#endif
#define PH(k) if constexpr ((PHASES >> (k)) & 1u)
#ifndef DBL
#define DBL 0u
#endif
#define DB(k) if constexpr ((DBL >> (k)) & 1u)
__global__ void __launch_bounds__(NTHREADS, 2) mega_fwd(Args args) {
    extern __shared__ __attribute__((aligned(16))) unsigned char lds_raw[];
    Frame F;
    F.lds = (LAS unsigned char*)lds_raw; F.MISC = (volatile LAS unsigned*)(F.lds + MISC_OFF);
    F.tid = threadIdx.x; F.lane = F.tid & 63; F.wave = __builtin_amdgcn_readfirstlane(F.tid >> 6); F.gw = blockIdx.x * NWAVES + F.wave;
    unsigned char* ws = args.ws;
    F.ctl = (unsigned*)(ws + WS_CTL);
    if (F.tid < 64) F.MISC[F.tid] = 0u;
    __syncthreads();
    XcdBarrier bar = xcd_barrier_post(F.ctl + CW_BAR, F.MISC + 8);
#define REFRESH() do { F.lane = fresh_lane(); F.tid = F.wave * 64 + F.lane; } while (0)
#define GRID_BAR() do { xcd_barrier(bar, F.wave); REFRESH(); } while (0)
#define YH ((bf16_t*)args.out)
#define bx ((int)blockIdx.x)
#define WSP(T_, off) ((T_*)(ws + (off)))

    PH(0) {
        { LAS float* scr = (LAS float*)(F.lds + F.wave * 16384);
          constexpr int I_QKV = 32 * 40, I_SQ = 32 * 32, I_W13 = 32 * 88, I_W2 = 88 * 32, I_WP = 4 * 32, I_WIN = 32 * 75, I_WUV = 256;
          constexpr int I_TOTAL = I_QKV + I_SQ + 2 * I_W13 + I_W2 + 2 * I_SQ + 2 * I_WP + (F8_WIN_SPLIT ? 2 : 1) * I_WIN + I_SQ + I_WUV;
          for (int it = F.gw; it < I_TOTAL; it += F.G * NWAVES) {
              int r = it; bool hit = false; const float* W = nullptr; int N = 0, ldo = 0, kofs = 0, mode = 0, rlo = 0, rhi = 1 << 30; unsigned char* WT = nullptr; float f8 = 0.f;
#define PSEG(cnt, Wp, Nn, WTp, ld, md, f8v, lo, hi) if (!hit) { if (r < (cnt)) { W = (Wp); N = (Nn); WT = (unsigned char*)(WTp); ldo = (ld); mode = (md); f8 = (f8v); rlo = (lo); rhi = (hi); hit = true; } else r -= (cnt); }
              PSEG(I_QKV, (const float*)args.in[3], NQKV, ws + WS_WQKV, DM, 1, F8_QKV ? WQKV_F8SCALE : 0.f, 0, 1 << 30)
              PSEG(I_SQ, (const float*)args.in[5], DM, ws + WS_WO0, DM, 0, F8_WO0 ? WO_F8SCALE : 0.f, 0, 1 << 30)
              PSEG(I_W13, (const float*)args.in[6], FFN, ws + WS_W13, DM, 2, F8_FFN1 ? W13_F8SCALE : 0.f, 0, 1 << 30)
              PSEG(I_W13, (const float*)args.in[7], FFN, ws + WS_W13, DM, 3, F8_FFN1 ? W13_F8SCALE : 0.f, 0, 1 << 30)
              PSEG(I_W2, (const float*)args.in[8], DM, ws + WS_W2, FFN, 0, F8_FFN2 ? W2_F8SCALE : 0.f, 0, 1 << 30)
              PSEG(I_SQ, (const float*)args.in[21], DM, ws + WS_WG0, DM, 0, F8_G0 ? WO_F8SCALE : 0.f, 0, 1 << 30)
              PSEG(I_SQ, (const float*)args.in[21] + (size_t)DM * DM, DM, ws + WS_WG1, DM, 0, F8_G1 ? WO_F8SCALE : 0.f, 0, 1 << 30)
              PSEG(I_WP, (const float*)args.in[20], DM, ws + WS_WP0, 256, 0, 0.f, 0, 1 << 30)
              PSEG(I_WP, (const float*)args.in[20] + (size_t)256 * DM, DM, ws + WS_WP1, 256, 0, 0.f, 0, 1 << 30)
              if constexpr (F8_WIN_SPLIT) { PSEG(I_WIN, (const float*)args.in[9], 4752, ws + WS_WIN8, DM, 4, WIN_F8SCALE, 0, WIN_F8_TILES * 256)
                                            PSEG(I_WIN, (const float*)args.in[9], 4752, ws + WS_WIN, DM, 4, 0.f, WIN_F8_TILES * 256, NWIN) }
              else { PSEG(I_WIN, (const float*)args.in[9], 4752, ws + WS_WIN, DM, 4, F8_WIN ? WIN_F8SCALE : 0.f, 0, 1 << 30) }
              PSEG(I_SQ, (const float*)args.in[13], DM, ws + WS_WO1, DM, 0, F8_WO1 ? WO_F8SCALE : 0.f, 0, 1 << 30)
              if (!hit) { const int h = r >> 4; r &= 15;
                  W = (const float*)args.in[12] + (size_t)h * 512 * 128; N = 128; WT = ws + WS_WUV + (size_t)h * 128 * 1024 * (F8_LAT ? 1 : 2); ldo = 1024; kofs = 512 * (h & 1); f8 = F8_LAT ? WUV_F8SCALE : 0.f; }
#undef PSEG
              tr_item(W, N, (bf16_t*)WT, ldo, kofs, mode, scr, r, F.lane, f8, rlo, rhi); } }
        { bf16_t* wuv = WSP(bf16_t, WS_WUV); const u32x4 z = {0u, 0u, 0u, 0u};
          for (int i = bx * NTHREADS + F.tid; i < 2048 * 64; i += F.G * NTHREADS) { const int n = i >> 6, c8 = i & 63; const int h = n >> 7;
              if constexpr (F8_LAT) { if (c8 < 32) *(u32x4*)((unsigned char*)wuv + (size_t)n * 1024 + 512 * ((h & 1) ^ 1) + 16 * c8) = z; }
              else *(u32x4*)(wuv + (size_t)n * 1024 + 512 * ((h & 1) ^ 1) + 8 * c8) = z; } }
        cvt_linear(F, (const float*)args.in[11], WSP(bf16_t, WS_WUK), (size_t)16 * 512 * 128 / 8);
        if constexpr (F8_QKV) cvt_linear8(F, (const float*)args.in[0], WSP(unsigned char, WS_XBA), (size_t)T * DM / 8); else cvt_linear(F, (const float*)args.in[0], WSP(bf16_t, WS_XBA), (size_t)T * DM / 8);
        cvt_linear(F, (const float*)args.in[1], WSP(bf16_t, WS_PB), (size_t)2 * T * 256 / 8);
        rope_tables(F, (const int*)args.in[2], WSP(float, WS_TAB64), WSP(float, WS_TAB32));
    }
    GRID_BAR();
    PH(1) {
        constexpr int KD = F8_QKV ? DM / 2 : DM;
        pg8::Gemm g{WSP(bf16_t, WS_XBA), WSP(bf16_t, WS_WQKV), KD, KD, KD}; pg8::GridOrder<0, T / 256, NQKV / 256> S;
        pg8::EpiQKV E{ws, F8_QKV ? 1.0f / WQKV_F8SCALE : 1.0f}; pg8::gemm_phase<pg8::EpiQKV, pg8::GridOrder<0, T / 256, NQKV / 256>, F8_QKV>(F.lds, g, S, E, F.wave);
    }
    GRID_BAR();
    PH(2) swa_phase<F8_WO0>(F, WSP(bf16_t, WS_Q), WSP(bf16_t, WS_K), WSP(bf16_t, WS_VT), (const float*)args.in[4], WSP(unsigned char, WS_O8));
    GRID_BAR();
    PH(3) {
        constexpr int KD = F8_WO0 ? DM / 2 : DM;
        pg8::Gemm g{F8_WO0 ? WSP(bf16_t, WS_O8) : WSP(bf16_t, WS_Q), WSP(bf16_t, WS_WO0), KD, KD, KD}; pg8::GridOrder<0, T / 256, DM / 256> S;
        pg8::EpiRes<false> E{args.in[0], YH, F8_WO0 ? 1.0f / (O0_F8SCALE * WO_F8SCALE) : 1.0f}; pg8::gemm_phase<pg8::EpiRes<false>, pg8::GridOrder<0, T / 256, DM / 256>, F8_WO0, EPI_ALIGN_RES>(F.lds, g, S, E, F.wave);
    }
    GRID_BAR();
    PH(4) ln_phase<F8_FFN1>(F, YH, WSP(bf16_t, WS_XBB), WSP(unsigned char, WS_XBA), (const float*)args.in[18], (const float*)args.in[19]);
    GRID_BAR();
    PH(5) {
        constexpr int KD = F8_FFN1 ? DM / 2 : DM;
        pg8::Gemm g{F8_FFN1 ? WSP(bf16_t, WS_XBA) : WSP(bf16_t, WS_XBB), WSP(bf16_t, WS_W13), KD, KD, KD}; pg8::GridOrder<0, T / 256, 2 * FFN / 256> S;
        pg8::EpiSwiglu<F8_FFN2> E{WSP(bf16_t, WS_ACT), FFN, F8_FFN1 ? 1.0f / W13_F8SCALE : 1.0f, ACT_F8SCALE}; pg8::gemm_phase<pg8::EpiSwiglu<F8_FFN2>, pg8::GridOrder<0, T / 256, 2 * FFN / 256>, F8_FFN1>(F.lds, g, S, E, F.wave);
    }
    GRID_BAR();
    PH(6) {
        constexpr int KD = F8_FFN2 ? FFN / 2 : FFN;
        pg8::Gemm g{WSP(bf16_t, WS_ACT), WSP(bf16_t, WS_W2), KD, KD, KD}; pg8::GridOrder<0, T / 256, DM / 256> S;
        pg8::EpiRes<true> E{WSP(bf16_t, WS_XBB), YH, F8_FFN2 ? 1.0f / (ACT_F8SCALE * W2_F8SCALE) : 1.0f}; pg8::gemm_phase<pg8::EpiRes<true>, pg8::GridOrder<0, T / 256, DM / 256>, F8_FFN2, EPI_ALIGN_RES>(F.lds, g, S, E, F.wave);
    }
    GRID_BAR();
    PH(7) ln_phase<F8_G0>(F, YH, WSP(bf16_t, WS_XBA), F8_G0 ? WSP(unsigned char, WS_X28) : nullptr, (const float*)args.in[18] + DM, (const float*)args.in[19] + DM);
    REFRESH();
    PH(7) {
        pg8::Gemm g{WSP(bf16_t, WS_PB), WSP(bf16_t, WS_WP0), 256, 256, 256}; pg8::GridOrder<0, T / 256, DM / 256> S;
        pg8::EpiBf16<false> E{WSP(bf16_t, WS_PP0), DM, 1.0f}; pg8::gemm_phase(F.lds, g, S, E, F.wave);
    }
    GRID_BAR();
    PH(8) {
        constexpr int K2 = F8_G0 ? DM / 2 : DM;
        pg8::Gemm g{F8_G0 ? WSP(bf16_t, WS_X28) : WSP(bf16_t, WS_XBA), WSP(bf16_t, WS_WG0), K2, K2, K2}; pg8::GridOrder<0, T / 256, DM / 256> S;
        pg8::EpiPle E{nullptr, ws, 0, F8_G0 ? -LOG2E / WO_F8SCALE : -LOG2E}; pg8::gemm_phase<pg8::EpiPle, pg8::GridOrder<0, T / 256, DM / 256>, F8_G0, EPI_ALIGN_RES>(F.lds, g, S, E, F.wave);
    }
    GRID_BAR();
    PH(9) {
        if constexpr (F8_WIN_SPLIT) {
            { static_assert((T / 256) * WIN_F8_TILES == 7 * pg8::GRID && (T / 256) * (NWIN / 256 - WIN_F8_TILES) == 5 * pg8::GRID / 2, "uneven deal: 7 rounds of e4m3 units, 2.5 rounds of bf16 units");
              pg8::Gemm g{WSP(bf16_t, WS_XB8), WSP(bf16_t, WS_WIN8), DM / 2, DM / 2, DM / 2}; pg8::GridOrder<4, T / 256, WIN_F8_TILES> S;
              pg8::EpiWin E{ws, 1.0f / WIN_F8SCALE, 0}; pg8::gemm_phase<pg8::EpiWin, pg8::GridOrder<4, T / 256, WIN_F8_TILES>, true>(F.lds, g, S, E, F.wave); }
            REFRESH();
            { pg8::Gemm g{WSP(bf16_t, WS_XBB), WSP(bf16_t, WS_WIN) + (size_t)WIN_F8_TILES * 256 * DM, DM, DM, DM}; pg8::GridOrder<0, T / 256, NWIN / 256 - WIN_F8_TILES> S;
              pg8::EpiWin E{ws, 1.0f, WIN_F8_TILES}; pg8::gemm_phase<pg8::EpiWin, pg8::GridOrder<0, T / 256, NWIN / 256 - WIN_F8_TILES>, false>(F.lds, g, S, E, F.wave); }
        } else {
        constexpr int KD = F8_WIN ? DM / 2 : DM;
        pg8::Gemm g{WSP(bf16_t, WS_XBB), WSP(bf16_t, WS_WIN), KD, KD, KD}; pg8::GridOrder<0, T / 256, NWIN / 256> S;
        pg8::EpiWin E{ws, F8_WIN ? 1.0f / WIN_F8SCALE : 1.0f, 0}; pg8::gemm_phase<pg8::EpiWin, pg8::GridOrder<0, T / 256, NWIN / 256>, F8_WIN>(F.lds, g, S, E, F.wave);
        }
    }
    GRID_BAR();
    PH(10) kvnorm_phase(F, WSP(float, WS_CRAW), (const float*)args.in[10], WSP(bf16_t, WS_KV));
    REFRESH();
    PH(11) {
        pg8::Gemm g{WSP(bf16_t, WS_QN), WSP(bf16_t, WS_WUK), DM, 128, 128}; pg8::GridOrder<1, T / 256, 8192 / 256> S;
        pg8::EpiBf16<F8_LAT> E{WSP(bf16_t, WS_QLAT), 8192, F8_LAT ? QLAT_F8SCALE : 1.0f}; pg8::gemm_phase(F.lds, g, S, E, F.wave);
    }
    REFRESH();
    DB(12) { topk_phase(F, WSP(bf16_t, WS_QI), WSP(bf16_t, WS_KIF), WSP(float, WS_WI), WSP(unsigned short, WS_SEL)); REFRESH(); }
    PH(12) topk_phase<true>(F, WSP(bf16_t, WS_QI), WSP(bf16_t, WS_KIF), WSP(float, WS_WI), WSP(unsigned short, WS_SEL));
    GRID_BAR();
    PH(13) { if constexpr (F8_KV && F8_LAT) dsa_attn8_phase(F, WSP(unsigned char, WS_QLAT), WSP(unsigned char, WS_QLAT), WSP(unsigned char, WS_QR), WSP(unsigned char, WS_KV), WSP(unsigned short, WS_SEL), nullptr, nullptr, nullptr, ws);
             else dsa_attn_phase(F, WSP(bf16_t, WS_QLAT), WSP(bf16_t, WS_QLAT), WSP(bf16_t, WS_QR), WSP(bf16_t, WS_KV), WSP(unsigned short, WS_SEL), (const float*)args.in[15], (const float*)args.in[16], (const float*)args.in[17], ws); }
    GRID_BAR();
    PH(14) {
        constexpr float dsc = F8_LAT ? 1.0f / (OLAT_F8SCALE * WUV_F8SCALE) : 1.0f;
        pg8::Gemm g{WSP(bf16_t, WS_QLAT), WSP(bf16_t, WS_WUV), F8_LAT ? 4096 : 8192, F8_LAT ? 512 : 1024, F8_LAT ? 512 : 1024}; pg8::GridOrder<F8_LAT ? 3 : 2, T / 256, DM / 256> S;
        pg8::EpiBf16<F8_WO1> E{WSP(bf16_t, WS_O2), DM, (F8_WO1 ? O2_F8SCALE : 1.0f) * dsc}; pg8::gemm_phase<pg8::EpiBf16<F8_WO1>, pg8::GridOrder<F8_LAT ? 3 : 2, T / 256, DM / 256>, F8_LAT>(F.lds, g, S, E, F.wave);
    }
    GRID_BAR();
    PH(15) {
        constexpr int KD = F8_WO1 ? DM / 2 : DM;
        pg8::Gemm g{WSP(bf16_t, WS_O2), WSP(bf16_t, WS_WO1), KD, KD, KD}; pg8::GridOrder<0, T / 256, DM / 256> S;
        pg8::EpiRes<true> E{WSP(bf16_t, WS_XBB), YH, F8_WO1 ? 1.0f / (O2_F8SCALE * WO_F8SCALE) : 1.0f}; pg8::gemm_phase<pg8::EpiRes<true>, pg8::GridOrder<0, T / 256, DM / 256>, F8_WO1, EPI_ALIGN_RES>(F.lds, g, S, E, F.wave);
    }
    GRID_BAR();
    PH(16) ln_router_phase(F, YH, WSP(bf16_t, WS_XBA), (const float*)args.in[18] + 2 * DM, (const float*)args.in[19] + 2 * DM, (const float*)args.in[14], WSP(int, WS_TOKE), WSP(float, WS_TOKG), WSP(int, WS_TOKL));
    REFRESH();
    GRID_BAR();
    PH(18) moe_tiles(F);
    REFRESH();
    PH(18) moe_gather_phase(F, WSP(bf16_t, WS_XBA), WSP(int, WS_TOKE), WSP(float, WS_TOKG), WSP(int, WS_TOKL), WSP(int, WS_TOKS), WSP(float, WS_SGATE), WSP(bf16_t, WS_XG));
    GRID_BAR();
    PH(19) {
        const int NTL = __builtin_amdgcn_readfirstlane((int)F.MISC[28]);
        {
            pg8::MoeOrder<false, 2 * MFFN / 256> S; S.tile0 = 0; S.ntl = NTL;
            pg8::Gemm g{WSP(bf16_t, WS_XG), WSP(bf16_t, WS_MW13), DM / 2, DM / 2, DM / 2};
            pg8::EpiSwiglu<true> E{WSP(bf16_t, WS_ACT2), MFFN, 1.0f / W13_F8SCALE, ACT_F8SCALE}; pg8::gemm_phase<pg8::EpiSwiglu<true>, pg8::MoeOrder<false, 2 * MFFN / 256>, true>(F.lds, g, S, E, F.wave);
        }
        GRID_BAR();
        {
            pg8::MoeOrder<true, DM / 256> S; S.tile0 = 0; S.ntl = NTL;
            pg8::Gemm g{WSP(bf16_t, WS_ACT2), WSP(bf16_t, WS_MW2), MFFN / 2, MFFN / 2, MFFN / 2};
            pg8::EpiMoeDown E{ws}; pg8::gemm_phase<pg8::EpiMoeDown, pg8::MoeOrder<true, DM / 256>, true>(F.lds, g, S, E, F.wave);
        }
        REFRESH();
        {
            pg8::GridOrderSkip<T / 256, DM / 256> S; S.skip = (NTL * (DM / 256)) % pg8::GRID;
            pg8::Gemm g{WSP(bf16_t, WS_PB) + (size_t)T * 256, WSP(bf16_t, WS_WP1), 256, 256, 256};
            pg8::EpiBf16<false> E{WSP(bf16_t, WS_PP1), DM, 1.0f}; pg8::gemm_phase(F.lds, g, S, E, F.wave);
        }
        GRID_BAR();
    }
    PH(20) moe_combine_ln_phase(F, YH, WSP(bf16_t, WS_XBB), WSP(unsigned char, WS_X58), WSP(bf16_t, WS_SOUT), WSP(int, WS_TOKS), (const float*)args.in[18] + 2 * DM, (const float*)args.in[19] + 2 * DM, (const float*)args.in[18] + 3 * DM, (const float*)args.in[19] + 3 * DM);
    GRID_BAR();
    PH(21) {
        constexpr int K2 = F8_G1 ? DM / 2 : DM;
        pg8::Gemm g{F8_G1 ? WSP(bf16_t, WS_X58) : WSP(bf16_t, WS_XBB), WSP(bf16_t, WS_WG1), K2, K2, K2}; pg8::GridOrder<0, T / 256, DM / 256> S;
        pg8::EpiPle E{args.out, ws, 1, F8_G1 ? -LOG2E / WO_F8SCALE : -LOG2E}; pg8::gemm_phase<pg8::EpiPle, pg8::GridOrder<0, T / 256, DM / 256>, F8_G1, EPI_ALIGN_RES>(F.lds, g, S, E, F.wave);
    }
}

#undef YH
#undef bx
extern "C" void kernel_launch(void* const* d_in, const int* in_sizes, int n_in, void* d_out, int out_size, void* d_ws, size_t ws_size, hipStream_t stream) {
    static int grid = 0;
    if (grid == 0) {
        if (n_in != 22 || out_size != T * DM || ws_size < WS_END) { fprintf(stderr, "kernel_launch: unexpected problem (n_in %d, out %d, ws %zu < %zu)\n", n_in, out_size, ws_size, (size_t)WS_END); grid = -1; return; }
        int dev = 0, cus = 0;
        if (hipGetDevice(&dev) != hipSuccess || hipDeviceGetAttribute(&cus, hipDeviceAttributeMultiprocessorCount, dev) != hipSuccess) { grid = -1; return; }
        if (hipFuncSetAttribute((const void*)mega_fwd, hipFuncAttributeMaxDynamicSharedMemorySize, LDS_BYTES) != hipSuccess) { fprintf(stderr, "kernel_launch: hipFuncSetAttribute failed\n"); grid = -1; return; }
        int per_cu = 0;
        if (hipOccupancyMaxActiveBlocksPerMultiprocessor(&per_cu, (const void*)mega_fwd, NTHREADS, LDS_BYTES) != hipSuccess || per_cu < 1) { fprintf(stderr, "kernel_launch: occupancy query says %d\n", per_cu); }
        (void)hipGetLastError();
        if (cus != pg8::GRID) { fprintf(stderr, "kernel_launch: built for %d CUs, device has %d\n", pg8::GRID, cus); grid = -1; return; }
        grid = cus;
    }
    if (grid < 0) return;
    (void)hipMemsetAsync((char*)d_ws + WS_CTL, 0, CTL_ZERO_BYTES, stream);
    Args a{};
    for (int i = 0; i < 22; ++i) a.in[i] = d_in[i];
    a.out = (float*)d_out; a.ws = (unsigned char*)d_ws;
    hipLaunchKernelGGL(mega_fwd, dim3(grid), dim3(NTHREADS), LDS_BYTES, stream, a);
}
```
